# Optimizing an MI355X kernel written in HIP

```python
import numpy as np
import jax
import jax.numpy as jnp
from jax import lax


D_MODEL = 2048
BATCH = 2
SEQ = 4096
DEPTH = 1

MEM_LEN = 256
RMS_EPS = 1e-6
MLA_HEADS = 16
Q_LORA = 512
KV_LORA = 256
NOPE_DIM = 128
ROPE_DIM = 64
V_DIM = 128
QK_DIM = NOPE_DIM + ROPE_DIM
MLA_WIDTH = MLA_HEADS * V_DIM
ROPE_BASE = 10000.0
Q_BLOCK = 128
RWKV_HEAD = 64
RWKV_HEADS = D_MODEL // RWKV_HEAD
RWKV_WIDTH = RWKV_HEADS * RWKV_HEAD
DECAY_LORA = 96
ICLR_LORA = 96
GATE_LORA = 256
SHIFT_WIDTH = 3
LNX_EPS = 64e-5
CROSS_HEADS = 4
CROSS_HEAD_DIM = 128
CROSS_WIDTH = CROSS_HEADS * CROSS_HEAD_DIM
N_GROUPS = 4
EXPERTS_PER_GROUP = 8
TOP_K_IN_GROUP = 2
D_EXPERT = 512

MLA_IN_SPLITS = (Q_LORA, KV_LORA, ROPE_DIM)
RWKV_IN_SPLITS = (RWKV_WIDTH, RWKV_WIDTH, RWKV_WIDTH, DECAY_LORA, DECAY_LORA, ICLR_LORA, ICLR_LORA, GATE_LORA)
MLA_IN = Q_LORA + KV_LORA + ROPE_DIM
RWKV_IN = 3 * RWKV_WIDTH + 2 * DECAY_LORA + 2 * ICLR_LORA + GATE_LORA
GATE_IN = 2 * D_MODEL
IN_WIDTH = MLA_IN + RWKV_IN + GATE_IN

kernel_name = 'hybrid_mla_rwkv7_hmoe_encoder_block'


def _split_cols(z, sizes):
    idx = np.cumsum(np.array(sizes))[:-1].tolist()
    return jnp.split(z, idx, axis=-1)


def rms_norm(x, g):
    xf = x.astype(jnp.float32)
    y = xf * lax.rsqrt(jnp.mean(xf * xf, axis=-1, keepdims=True) + RMS_EPS)
    return (y * g.astype(jnp.float32)).astype(x.dtype)


def rope(x, positions):
    half = ROPE_DIM // 2
    inv_freq = ROPE_BASE ** (-jnp.arange(half, dtype=jnp.float32) * (2.0 / ROPE_DIM))
    ang = positions.astype(jnp.float32)[..., None] * inv_freq
    ang = ang.reshape(ang.shape[:2] + (1,) * (x.ndim - 3) + (half,))
    cos, sin = jnp.cos(ang), jnp.sin(ang)
    xf = x.astype(jnp.float32)
    x1, x2 = xf[..., :half], xf[..., half:]
    return jnp.concatenate([x1 * cos - x2 * sin, x2 * cos + x1 * sin], axis=-1).astype(x.dtype)


def centred_shift(z, w):
    zp = jnp.pad(z, ((0, 0), (1, 1), (0, 0)))
    return zp[:, :-2] * w[0] + zp[:, 1:-1] * w[1] + zp[:, 2:] * w[2]


def mla_branch(z_mla, positions, g_q, w_uq, g_kv, w_ukv):
    bsz, seq, _ = z_mla.shape
    c_q, c_kv, k_r = _split_cols(z_mla, MLA_IN_SPLITS)
    q = (rms_norm(c_q, g_q) @ w_uq).reshape(bsz, seq, MLA_HEADS, QK_DIM)
    q_nope = q[..., :NOPE_DIM]
    q_rope = rope(q[..., NOPE_DIM:], positions)
    kv = (rms_norm(c_kv, g_kv) @ w_ukv).reshape(bsz, seq, MLA_HEADS, NOPE_DIM + V_DIM)
    k_nope, v = kv[..., :NOPE_DIM], kv[..., NOPE_DIM:]
    k_rope = rope(k_r, positions)
    scale = QK_DIM ** -0.5
    nblk = seq // Q_BLOCK
    qn_blk = jnp.swapaxes(q_nope.reshape(bsz, nblk, Q_BLOCK, MLA_HEADS, NOPE_DIM), 0, 1)
    qr_blk = jnp.swapaxes(q_rope.reshape(bsz, nblk, Q_BLOCK, MLA_HEADS, ROPE_DIM), 0, 1)

    def attend(blk):
        qn, qr = blk
        s = jnp.einsum('bqhd,bkhd->bhqk', qn, k_nope) + jnp.einsum('bqhr,bkr->bhqk', qr, k_rope)
        p = jax.nn.softmax(s.astype(jnp.float32) * scale, axis=-1).astype(v.dtype)
        return jnp.einsum('bhqk,bkhd->bqhd', p, v)

    o = lax.map(attend, (qn_blk, qr_blk))
    return jnp.swapaxes(o, 0, 1).reshape(bsz, seq, MLA_WIDTH)


def rwkv7_scan(r, w, k, v, a, b, reverse):
    bsz, _, nh, hd = r.shape

    def step(state, inp):
        r_t, w_t, k_t, v_t, a_t, b_t = inp
        sa = jnp.einsum('bhvk,bhk->bhv', state, a_t)
        state = state * w_t[:, :, None, :] + sa[..., None] * b_t[:, :, None, :] + v_t[..., None] * k_t[:, :, None, :]
        return state, jnp.einsum('bhvk,bhk->bhv', state, r_t)

    xs = tuple(jnp.swapaxes(t, 0, 1) for t in (r, w, k, v, a, b))
    s0 = jnp.zeros((bsz, nh, hd, hd), jnp.float32)
    _, ys = lax.scan(step, s0, xs, reverse=reverse)
    return jnp.swapaxes(ys, 0, 1)


def rwkv7_branch(z_rwkv, shift_conv, w0_f, w2_f, w0_b, w2_b, a0_f, a2_f, a0_b, a2_b, g2, k_k, k_a, r_k, lnx_g, lnx_b):
    bsz, seq, _ = z_rwkv.shape
    z = centred_shift(z_rwkv, shift_conv)
    r, k, v, xw_f, xw_b, xa_f, xa_b, xg = _split_cols(z, RWKV_IN_SPLITS)

    def heads(t):
        return t.reshape(bsz, seq, RWKV_HEADS, RWKV_HEAD).astype(jnp.float32)

    r_h, v_h, k_h = heads(r), heads(v), heads(k)
    kk = heads(k * k_k)
    kk = kk * lax.rsqrt(jnp.sum(kk * kk, axis=-1, keepdims=True) + 1e-12)
    k_a_h = k_a.reshape(RWKV_HEADS, RWKV_HEAD).astype(jnp.float32)
    r_k_f = r_k.astype(jnp.float32)
    g = jax.nn.sigmoid(xg) @ g2
    outs = []
    for xw, w0, w2, xa, a0, a2, rev in ((xw_f, w0_f, w2_f, xa_f, a0_f, a2_f, False),
                                         (xw_b, w0_b, w2_b, xa_b, a0_b, a2_b, True)):
        w_log = -jax.nn.softplus(-(w0 + jnp.tanh(xw) @ w2)) - 0.5
        decay = jnp.exp(-jnp.exp(heads(w_log)))
        a = jax.nn.sigmoid(heads(a0 + xa @ a2))
        k_d = k_h * (1.0 + (a - 1.0) * k_a_h)
        y_d = rwkv7_scan(r_h, decay, k_d, v_h, -kk, kk * a, rev)
        bonus = jnp.sum(r_h * k_d * r_k_f, axis=-1, keepdims=True) * v_h
        outs.append(y_d + bonus)
    y = outs[0] + outs[1]
    mu = jnp.mean(y, axis=-1, keepdims=True)
    var = jnp.mean(jnp.square(y - mu), axis=-1, keepdims=True)
    y = ((y - mu) * lax.rsqrt(var + LNX_EPS)).reshape(bsz, seq, RWKV_WIDTH)
    y = y * lnx_g.astype(jnp.float32) + lnx_b.astype(jnp.float32)
    return (y * g.astype(jnp.float32)).astype(z_rwkv.dtype)


def memory_cross_attention(h_n, mem, g_mem, wq_c, wkv_c, wo_c):
    bsz, seq, _ = h_n.shape
    m_len = mem.shape[1]
    q = (h_n @ wq_c).reshape(bsz, seq, CROSS_HEADS, CROSS_HEAD_DIM)
    kv = (rms_norm(mem, g_mem) @ wkv_c).reshape(bsz, m_len, 2, CROSS_HEADS, CROSS_HEAD_DIM)
    k, v = kv[:, :, 0], kv[:, :, 1]
    s = jnp.einsum('bqhd,bmhd->bhqm', q, k).astype(jnp.float32) * (CROSS_HEAD_DIM ** -0.5)
    p = jax.nn.softmax(s, axis=-1).astype(v.dtype)
    o = jnp.einsum('bhqm,bmhd->bqhd', p, v).reshape(bsz, seq, CROSS_WIDTH)
    return o @ wo_c


def hierarchical_moe(n, w_rg, b_rg, w_re, b_re, w_eg, w_eu, w_ed):
    bsz, seq, dm = n.shape
    t = n.reshape(bsz * seq, dm)
    tf = t.astype(jnp.float32)
    g_prob = jax.nn.softmax(tf @ w_rg.astype(jnp.float32) + b_rg.astype(jnp.float32), axis=-1)
    p_group, g_idx = lax.top_k(g_prob, 1)
    g_onehot = jax.nn.one_hot(g_idx[:, 0], N_GROUPS, dtype=jnp.float32)
    e_logits_all = jnp.einsum('nd,gde->nge', tf, w_re.astype(jnp.float32)) + b_re.astype(jnp.float32)
    e_logits = jnp.einsum('ng,nge->ne', g_onehot, e_logits_all)
    e_prob = jax.nn.softmax(e_logits, axis=-1)
    p_top, e_idx = lax.top_k(e_prob, TOP_K_IN_GROUP)
    p_top = p_top / jnp.sum(p_top, axis=-1, keepdims=True)
    w_tok = p_group * p_top
    within = jnp.einsum('nk,nke->ne', w_tok, jax.nn.one_hot(e_idx, EXPERTS_PER_GROUP, dtype=jnp.float32))
    combine = (g_onehot[:, :, None] * within[:, None, :]).astype(t.dtype)
    y = jnp.zeros_like(t)
    for gi in range(N_GROUPS):
        hid = jax.nn.silu(jnp.einsum('nd,edf->nef', t, w_eg[gi])) * jnp.einsum('nd,edf->nef', t, w_eu[gi])
        y = y + jnp.einsum('nef,efd->nd', hid * combine[:, gi, :, None], w_ed[gi])
    return y.reshape(bsz, seq, dm)


def setup_inputs(seed: int = 0) -> dict:
    key = jax.random.key(seed)
    keys = jax.random.split(key, 64)
    counter = [0]

    def nrm(shape, scale):
        k = keys[counter[0]]
        counter[0] += 1
        return scale * jax.random.normal(k, shape, jnp.float32)

    def gain(shape):
        return 1.0 + nrm(shape, 0.1)

    L = DEPTH
    E = EXPERTS_PER_GROUP
    x = nrm((BATCH, SEQ, D_MODEL), 1.0)
    mem = nrm((BATCH, MEM_LEN, D_MODEL), 1.0)
    positions = jnp.broadcast_to(jnp.arange(SEQ, dtype=jnp.int32)[None, :], (BATCH, SEQ))
    return {
        'x': x,
        'mem': mem,
        'positions': positions,
        'g_mix': gain((L, D_MODEL)),
        'w_in': nrm((L, D_MODEL, IN_WIDTH), D_MODEL ** -0.5),
        'g_q': gain((L, Q_LORA)),
        'w_uq': nrm((L, Q_LORA, MLA_HEADS * QK_DIM), Q_LORA ** -0.5),
        'g_kv': gain((L, KV_LORA)),
        'w_ukv': nrm((L, KV_LORA, MLA_HEADS * (NOPE_DIM + V_DIM)), KV_LORA ** -0.5),
        'shift_conv': jnp.array([0.25, 0.5, 0.25], jnp.float32)[None, :, None] + nrm((L, SHIFT_WIDTH, RWKV_IN), 0.05),
        'w0_f': nrm((L, RWKV_WIDTH), 0.5),
        'w2_f': nrm((L, DECAY_LORA, RWKV_WIDTH), 0.5 * DECAY_LORA ** -0.5),
        'w0_b': nrm((L, RWKV_WIDTH), 0.5),
        'w2_b': nrm((L, DECAY_LORA, RWKV_WIDTH), 0.5 * DECAY_LORA ** -0.5),
        'a0_f': nrm((L, RWKV_WIDTH), 0.5),
        'a2_f': nrm((L, ICLR_LORA, RWKV_WIDTH), 0.5 * ICLR_LORA ** -0.5),
        'a0_b': nrm((L, RWKV_WIDTH), 0.5),
        'a2_b': nrm((L, ICLR_LORA, RWKV_WIDTH), 0.5 * ICLR_LORA ** -0.5),
        'g2': nrm((L, GATE_LORA, RWKV_WIDTH), GATE_LORA ** -0.5),
        'k_k': gain((L, RWKV_WIDTH)),
        'k_a': 0.5 + nrm((L, RWKV_WIDTH), 0.1),
        'r_k': nrm((L, RWKV_HEADS, RWKV_HEAD), 0.5),
        'lnx_g': gain((L, RWKV_WIDTH)),
        'lnx_b': nrm((L, RWKV_WIDTH), 0.01),
        'w_up_mla': nrm((L, MLA_WIDTH, D_MODEL), MLA_WIDTH ** -0.5),
        'w_up_rwkv': nrm((L, RWKV_WIDTH, D_MODEL), RWKV_WIDTH ** -0.5),
        'w_out': nrm((L, D_MODEL, D_MODEL), D_MODEL ** -0.5),
        'g_cross': gain((L, D_MODEL)),
        'g_mem': gain((L, D_MODEL)),
        'wq_c': nrm((L, D_MODEL, CROSS_WIDTH), D_MODEL ** -0.5),
        'wkv_c': nrm((L, D_MODEL, 2 * CROSS_WIDTH), D_MODEL ** -0.5),
        'wo_c': nrm((L, CROSS_WIDTH, D_MODEL), CROSS_WIDTH ** -0.5),
        'g_ffn': gain((L, D_MODEL)),
        'w_rg': nrm((L, D_MODEL, N_GROUPS), D_MODEL ** -0.5),
        'b_rg': nrm((L, N_GROUPS), 0.01),
        'w_re': nrm((L, N_GROUPS, D_MODEL, E), D_MODEL ** -0.5),
        'b_re': nrm((L, N_GROUPS, E), 0.01),
        'w_eg': nrm((L, N_GROUPS, E, D_MODEL, D_EXPERT), D_MODEL ** -0.5),
        'w_eu': nrm((L, N_GROUPS, E, D_MODEL, D_EXPERT), D_MODEL ** -0.5),
        'w_ed': nrm((L, N_GROUPS, E, D_EXPERT, D_MODEL), D_EXPERT ** -0.5),
        'g_final': gain((D_MODEL,)),
    }


def reference(x, mem, positions, g_mix, w_in, g_q, w_uq, g_kv, w_ukv, shift_conv,
              w0_f, w2_f, w0_b, w2_b, a0_f, a2_f, a0_b, a2_b, g2, k_k, k_a, r_k,
              lnx_g, lnx_b, w_up_mla, w_up_rwkv, w_out, g_cross, g_mem, wq_c, wkv_c,
              wo_c, g_ffn, w_rg, b_rg, w_re, b_re, w_eg, w_eu, w_ed, g_final):
    h = x
    for l in range(DEPTH):
        n = rms_norm(h, g_mix[l])
        z = n @ w_in[l]
        z_mla, z_rwkv, z_gate = _split_cols(z, (MLA_IN, RWKV_IN, GATE_IN))
        o_mla = mla_branch(z_mla, positions, g_q[l], w_uq[l], g_kv[l], w_ukv[l])
        o_rwkv = rwkv7_branch(z_rwkv, shift_conv[l], w0_f[l], w2_f[l], w0_b[l], w2_b[l],
                              a0_f[l], a2_f[l], a0_b[l], a2_b[l], g2[l], k_k[l], k_a[l],
                              r_k[l], lnx_g[l], lnx_b[l])
        gate_mla, gate_rwkv = jnp.split(jax.nn.sigmoid(z_gate), 2, axis=-1)
        merged = gate_mla * (o_mla @ w_up_mla[l]) + gate_rwkv * (o_rwkv @ w_up_rwkv[l])
        h = h + merged @ w_out[l]
        h = h + memory_cross_attention(rms_norm(h, g_cross[l]), mem, g_mem[l], wq_c[l], wkv_c[l], wo_c[l])
        h = h + hierarchical_moe(rms_norm(h, g_ffn[l]), w_rg[l], b_rg[l], w_re[l], b_re[l],
                                 w_eg[l], w_eu[l], w_ed[l])
    return rms_norm(h, g_final)
```

```cpp
#include <hip/hip_runtime.h>
#include <cstdio>
#include <cstdint>

#ifndef EN_RWKV
#define EN_RWKV 1
#endif
#ifndef EN_MLA
#define EN_MLA 1
#endif
#ifndef EN_CROSS
#define EN_CROSS 1
#endif
#ifndef EN_MOE
#define EN_MOE 1
#endif
#ifndef N_LAUNCH_SPLIT
#define N_LAUNCH_SPLIT 0
#endif

#define GAS __attribute__((address_space(1)))
#define LAS __attribute__((address_space(3)))
typedef unsigned short bf16;
typedef short bf16x8 __attribute__((ext_vector_type(8)));
typedef short s16x4 __attribute__((ext_vector_type(4)));
typedef float f32x4 __attribute__((ext_vector_type(4)));
typedef float f32x2 __attribute__((ext_vector_type(2)));
typedef float f32x16 __attribute__((ext_vector_type(16)));
typedef unsigned u32x4 __attribute__((ext_vector_type(4)));
typedef unsigned u32x2 __attribute__((ext_vector_type(2)));

constexpr int DM = 2048, NB = 2, SEQ = 4096, MT = NB * SEQ;
constexpr int MEMLEN = 256;
constexpr int QLORA = 512, KVLORA = 256, ROPE = 64, NOPE = 128, VDIM = 128, QKD = 192, MH = 16;
constexpr int RW = 2048, RH = 32, RHD = 64, DLORA = 96, GLORA = 256;
constexpr int MLA_IN = 832, RWKV_IN = 6784, GATE_IN = 4096, IN_W = MLA_IN + RWKV_IN + GATE_IN;
constexpr int CH = 4, CHD = 128, CW = 512;
constexpr int NG = 4, EPG = 8, NE = 32, DE = 512;
constexpr float RMS_EPS = 1e-6f, LNX_EPS = 64e-5f;
constexpr int G1_N = 12032;
constexpr int ZM_LD = 1024, ZR_LD = 6144, ZL_LD = 768, ZG_LD = 4096, LA_LD = 768;
constexpr int MOE_SLOTS = 2 * MT + NE * 256;

constexpr size_t MiB = 1u << 20;
constexpr size_t WS_CTL = 0, CTL_BYTES = 1 * MiB;
constexpr size_t WS_WUQ = 1 * MiB;
constexpr size_t WS_WUKV = 4 * MiB;
constexpr size_t WS_W2F = 6 * MiB;
constexpr size_t WS_G2 = 10 * MiB;
constexpr size_t WS_WUPM = 11 * MiB, WS_WUPR = 19 * MiB, WS_WOUT = 27 * MiB;
constexpr size_t WS_WQC = 35 * MiB;
constexpr size_t WS_WKVC = 37 * MiB;
constexpr size_t WS_WOC = 41 * MiB;
constexpr size_t WS_WIN = 43 * MiB;
constexpr size_t WS_MISC = 90 * MiB;
constexpr size_t WS_ROPE = WS_MISC;
constexpr size_t WS_MEMN = WS_MISC + 2 * MiB;
constexpr size_t WS_KVC = WS_MISC + 4 * MiB;
constexpr size_t WS_RSTD = WS_MISC + 5 * MiB;
constexpr size_t WS_WR = WS_RSTD + 256 * 1024;
constexpr size_t WS_LIST = WS_MISC + 6 * MiB;
constexpr size_t WS_ROUTE = WS_MISC + 7 * MiB;
constexpr size_t WS_SLOTW = WS_MISC + 8 * MiB;
constexpr size_t WS_XB = 100 * MiB;
constexpr size_t WS_ZMLA = 132 * MiB;
constexpr size_t WS_ZLORA = 148 * MiB;
constexpr size_t WS_LORAA = 160 * MiB;
constexpr size_t WS_ZRKV = 172 * MiB;
constexpr size_t WS_ZGATE = 268 * MiB;
constexpr size_t WS_Q = 332 * MiB;
constexpr size_t WS_K = 380 * MiB;
constexpr size_t WS_V = 428 * MiB;
constexpr size_t WS_WLF = 460 * MiB, WS_WLB = 492 * MiB, WS_ICF = 524 * MiB, WS_ICB = 556 * MiB;
constexpr size_t WS_G = 588 * MiB;
constexpr size_t WS_END = 620 * MiB;
constexpr size_t WS_YF = WS_WIN, WS_YB = WS_ZMLA, WS_ORWKV = WS_Q, WS_MERGED = WS_K, WS_QSLAB = WS_K  , WS_OC = WS_ZGATE;
constexpr size_t WS_WGU = WS_WLF, WS_WD = WS_ZRKV, WS_HID = WS_ZGATE, WS_YBUF = WS_Q;
constexpr size_t WS_OMLA = WS_XB, WS_H1B = WS_XB, WS_N3 = WS_XB;

constexpr int CW_BAR = 4096;
constexpr int CW_CNT = 16384;

constexpr int RING_BYTES = 155648;
constexpr int LDSCTL_OFF = RING_BYTES, MISC_OFF = LDSCTL_OFF + 320;
constexpr int LDS_BYTES = 157696;

#define LDS_WAIT() asm volatile("s_waitcnt lgkmcnt(0)" ::: "memory")
#define VM_WAIT() asm volatile("s_waitcnt vmcnt(0)" ::: "memory")
typedef __bf16 bf16x2_t __attribute__((ext_vector_type(2)));
__device__ __forceinline__ unsigned cvt_pk_bf16(float lo, float hi) { f32x2 v = {lo, hi}; bf16x2_t b = __builtin_convertvector(v, bf16x2_t); return __builtin_bit_cast(unsigned, b); }
__device__ __forceinline__ float bf2f(unsigned short b) { return __builtin_bit_cast(float, ((unsigned)b) << 16); }
__device__ __forceinline__ float bflo(unsigned w) { return __builtin_bit_cast(float, w << 16); }
__device__ __forceinline__ float bfhi(unsigned w) { return __builtin_bit_cast(float, w & 0xffff0000u); }
__device__ __forceinline__ unsigned short f2bf(float f) { return (unsigned short)(cvt_pk_bf16(f, 0.f) & 0xffffu); }
__device__ __forceinline__ float sigmoidf_(float x) { return __builtin_amdgcn_rcpf(1.0f + __builtin_amdgcn_exp2f(-1.4426950408889634f * x)); }
template <int CTRL> __device__ __forceinline__ float dpp_add_(float v) {
    return v + __builtin_bit_cast(float, __builtin_amdgcn_update_dpp(0, __builtin_bit_cast(int, v), CTRL, 0xF, 0xF, false));
}
__device__ __forceinline__ float wave_sum(float v) {
    v = dpp_add_<0xB1>(v); v = dpp_add_<0x4E>(v); v = dpp_add_<0x141>(v); v = dpp_add_<0x140>(v);
    const int iv = __builtin_bit_cast(int, v);
    const float s0 = __builtin_bit_cast(float, __builtin_amdgcn_readlane(iv, 0)), s1 = __builtin_bit_cast(float, __builtin_amdgcn_readlane(iv, 16));
    const float s2 = __builtin_bit_cast(float, __builtin_amdgcn_readlane(iv, 32)), s3 = __builtin_bit_cast(float, __builtin_amdgcn_readlane(iv, 48));
    return (s0 + s1) + (s2 + s3);
}

#define XB_TMO      128
#define XB_XCNT(j)  (256  + 64 * (j))
#define XB_XSUB(j)  (1280 + 64 * (j))
#define XB_XGEN(j)  (2304 + 64 * (j))
#define XB_TOP      3328
#define XB_TOPGEN   3392
#define XCD_BAR_WORDS 3456
#define XB_SPIN_CAP (1u << 18)
__device__ __forceinline__ unsigned xb_ld(unsigned* p)              { return __hip_atomic_load(p, __ATOMIC_RELAXED, __HIP_MEMORY_SCOPE_AGENT); }
__device__ __forceinline__ unsigned xb_add(unsigned* p, unsigned v) { return __hip_atomic_fetch_add(p, v, __ATOMIC_RELAXED, __HIP_MEMORY_SCOPE_AGENT); }
__device__ __forceinline__ unsigned xb_xcc_id() { return (unsigned)__builtin_amdgcn_s_getreg((3 << 11) | 20) & 0xFu; }
#define XB_SPIN(cond, bar) do { unsigned _sp = 0; while (cond) { __builtin_amdgcn_s_sleep(1); \
    if ((++_sp & 255u) == 0u) { if (xb_ld(&(bar)[XB_TMO])) break; if (_sp > XB_SPIN_CAP) { atomicAdd(&(bar)[XB_TMO], 1u); break; } } } } while (0)
struct XcdBarrier { unsigned* bar; unsigned x; volatile LAS unsigned* st; };
__device__ __forceinline__ XcdBarrier xcd_barrier_post(unsigned* bar, volatile LAS unsigned* st) {
    XcdBarrier b; b.bar = bar; b.x = xb_xcc_id(); b.st = st;
    if (threadIdx.x == 0) (void)xb_add(&bar[XB_XCNT(b.x)], 1u);
    return b;
}
__device__ __forceinline__ void xcd_barrier_complete(unsigned* bar, unsigned x, unsigned& nloc, unsigned& nx) {
    const unsigned G = gridDim.x * gridDim.y * gridDim.z;
    unsigned sum, cnt, mine, sp = 0u;
    for (;;) {
        sum = 0u; cnt = 0u; mine = 0u;
#pragma unroll
        for (unsigned j = 0; j < 16; ++j) { const unsigned c = xb_ld(&bar[XB_XCNT(j)]); sum += c; cnt += (c > 0u) ? 1u : 0u; mine = (j == x) ? c : mine; }
        if (sum == G) break;
        __builtin_amdgcn_s_sleep(1);
        if ((++sp & 255u) == 0u) { if (xb_ld(&bar[XB_TMO])) break; if (sp > XB_SPIN_CAP) { atomicAdd(&bar[XB_TMO], 1u); break; } }
    }
    nloc = mine > 0u ? mine : 1u; nx = cnt > 0u ? cnt : 1u;
}
__device__ __forceinline__ void xcd_barrier(const XcdBarrier& b) {
    asm volatile("s_waitcnt vmcnt(0)" ::: "memory");
    __syncthreads();
    if (threadIdx.x == 0) {
        unsigned* bar = b.bar;
        __builtin_amdgcn_s_waitcnt(0);
        unsigned nloc = b.st[0], nx = b.st[1];
        if (nloc == 0u) { xcd_barrier_complete(bar, b.x, nloc, nx); b.st[0] = nloc; b.st[1] = nx; }
        const unsigned old = xb_add(&bar[XB_XSUB(b.x)], 1u);
        const unsigned gen = old / nloc;
        if (old + 1u == (gen + 1u) * nloc) {
            __builtin_amdgcn_fence(__ATOMIC_RELEASE, "agent");
            asm volatile("s_waitcnt vmcnt(0)" ::: "memory");
            const unsigned og = xb_add(&bar[XB_TOP], 1u);
            const unsigned tg = og / nx;
            if (og + 1u == (tg + 1u) * nx) xb_add(&bar[XB_TOPGEN], 1u);
            else XB_SPIN(xb_ld(&bar[XB_TOPGEN]) == tg, bar);
            __builtin_amdgcn_fence(__ATOMIC_ACQUIRE, "agent");
            xb_add(&bar[XB_XGEN(b.x)], 1u);
            asm volatile("s_waitcnt vmcnt(0)" ::: "memory");
        } else {
            XB_SPIN(xb_ld(&bar[XB_XGEN(b.x)]) == gen, bar);
            __builtin_amdgcn_fence(__ATOMIC_ACQUIRE, "agent");
            asm volatile("s_waitcnt vmcnt(0)" ::: "memory");
        }
    }
    __syncthreads();
}

namespace pg8 {
constexpr int BM = 256, BK = 64, HALF = 128, HTB = HALF * BK * 2, STAGE_BYTES = 8 * HTB, NXCD = 8, WGM = 8;
__host__ __device__ __forceinline__ int lds_byte(int r, int c) { const int st = (r >> 4) * 2 + (c >> 5), rr = r & 15, cc = c & 31, ob = rr * 64 + cc * 2; return st * 1024 + (ob ^ (((ob >> 9) & 1) << 5)); }
__host__ __device__ __forceinline__ void stage_rc(int b, int& R, int& C) { const int st = b / 1024, sb = b % 1024, swz = sb ^ (((sb >> 9) & 1) << 5); R = (st >> 1) * 16 + swz / 64; C = (st & 1) * 32 + (swz % 64) / 2; }
__host__ __device__ __forceinline__ int perm32(int rho) { const int n = rho >> 4, i = rho & 15; return 8 * (i >> 2) + 4 * n + (i & 3); }

struct Unit { int pm, pn; const char* Ab; const char* Bb; int aux0, aux1; };

struct StaticOrder {
    static constexpr bool GATHER = false;
    int nM, nN, nwg, G, c; const char* A; const char* Bt; int lda, ldb;
    __device__ void init(const bf16* A_, int lda_, const bf16* Bt_, int ldb_, int M, int N, int G_, int c_) { A = (const char*)A_; Bt = (const char*)Bt_; lda = lda_; ldb = ldb_; nM = M / BM; nN = N / BM; nwg = nM * nN; G = G_; c = c_; }
    __device__ __forceinline__ bool next(int i, Unit& u) const {
        const long L = (long)i * G + c; if (L >= nwg) return false;
        int wgid = (int)L; { const int q = nwg / NXCD, r = nwg % NXCD, xcd = wgid % NXCD, off = wgid / NXCD; wgid = (xcd < r ? xcd * (q + 1) : r * (q + 1) + (xcd - r) * q) + off; }
        const int nig = WGM * nN, gid = wgid / nig, fm = gid * WGM, gsz = (nM - fm) < WGM ? (nM - fm) : WGM;
        u.pm = fm + ((wgid % nig) % gsz); u.pn = (wgid % nig) / gsz; u.Ab = A + (size_t)u.pm * BM * lda * 2; u.Bb = Bt + (size_t)u.pn * BM * ldb * 2; u.aux0 = 0; u.aux1 = 0; return true;
    }
    __device__ __forceinline__ unsigned arow(const Unit& u, int r) const { return (unsigned)r; }
};

#define PG8_ACC f32x4 (&acc)[2][2][4][2]
template <class Epi, class Sched>
__device__ __forceinline__ void gemm_phase(LAS unsigned char* lds, const int K, const int lda, const int ldb, const Sched& S, const Epi& E) {
    const int tid = threadIdx.x, wid = __builtin_amdgcn_readfirstlane(tid >> 6), lane = tid & 63, wr = wid >> 2, wc = wid & 3, fr = lane & 15, fq = lane >> 4;
    const int nt = K / BK;
    int sR[2], sC[2]; unsigned voffB[2];
#pragma unroll
    for (int i = 0; i < 2; ++i) { stage_rc(tid * 16 + i * 8192, sR[i], sC[i]); const int Rb = Epi::PERM ? ((sR[i] & ~31) + perm32(sR[i] & 31)) : sR[i];
        voffB[i] = (unsigned)(Rb * ldb + sC[i]) * 2u; }
    const size_t kstep = (size_t)(BK * 2);
    const size_t hstepB = (size_t)HALF * ldb * 2;
    const unsigned ldsw = (unsigned)wid * 1024u;
    const int aoff = lds_byte(wr * 64 + fr, fq * 8), boff = lds_byte(wc * 32 + fr, fq * 8);
#define PG8_SA(b, h) (((b) * 2 + (h)) * HTB)
#define PG8_SB(b, h) ((4 + (b) * 2 + (h)) * HTB)
#define PG8_STAGE(bufoff, gbase, voff) do { _Pragma("unroll") for (int _i = 0; _i < 2; ++_i) \
        __builtin_amdgcn_global_load_lds((const unsigned*)((const char*)(gbase) + (voff)[_i]), (LAS unsigned*)(lds + (bufoff) + ldsw + _i * 8192), 16, 0, 0); } while (0)
#define PG8_LDA(dst, b, h) do { _Pragma("unroll") for (int m = 0; m < 4; ++m) _Pragma("unroll") for (int k = 0; k < 2; ++k) dst[m][k] = *(const LAS bf16x8*)(lds + PG8_SA(b, h) + aoff + m * 2048 + k * 1024); } while (0)
#define PG8_LDB(dst, b, h) do { _Pragma("unroll") for (int n = 0; n < 2; ++n) _Pragma("unroll") for (int k = 0; k < 2; ++k) dst[n][k] = *(const LAS bf16x8*)(lds + PG8_SB(b, h) + boff + n * 2048 + k * 1024); } while (0)
#define PG8_MMA(ai, bj, At, Bt) do { __builtin_amdgcn_s_setprio(1); _Pragma("unroll") for (int m = 0; m < 4; ++m) _Pragma("unroll") for (int n = 0; n < 2; ++n) _Pragma("unroll") for (int k = 0; k < 2; ++k) \
        acc[ai][bj][m][n] = __builtin_amdgcn_mfma_f32_16x16x32_bf16(Bt[n][k], At[m][k], acc[ai][bj][m][n], 0, 0, 0); __builtin_amdgcn_s_setprio(0); } while (0)
#define PG8_WAIT_V(n) asm volatile("s_waitcnt vmcnt(" #n ")" ::: "memory")
#define PG8_WAIT_L(n) asm volatile("s_waitcnt lgkmcnt(" #n ")" ::: "memory")
#define PG8_BAR __builtin_amdgcn_s_barrier()
#define PG8_SCHED __builtin_amdgcn_sched_barrier(0)
#define PG8_SETVA(dst, u) do { _Pragma("unroll") for (int _h = 0; _h < 2; ++_h) _Pragma("unroll") for (int _i = 0; _i < 2; ++_i) \
        dst[_h][_i] = (S.arow(u, _h * HALF + sR[_i]) * (unsigned)lda + (unsigned)sC[_i]) * 2u; } while (0)
    Unit cur, nxt; int ui = 0;
    if (!S.next(0, cur)) return;
    f32x4 acc[2][2][4][2];
#pragma unroll
    for (int a = 0; a < 2; ++a)
#pragma unroll
        for (int b = 0; b < 2; ++b)
#pragma unroll
            for (int m = 0; m < 4; ++m)
#pragma unroll
                for (int n = 0; n < 2; ++n) acc[a][b][m][n] = (f32x4){0.f, 0.f, 0.f, 0.f};
    bf16x8 At[4][2], B0[2][2], B1[2][2];
    constexpr bool GA = Sched::GATHER;
    unsigned vA[2][2], nvA[2][2];
    PG8_SETVA(vA, cur);
    const char* cA = cur.Ab; const char* cB = cur.Bb;
    PG8_STAGE(PG8_SB(0, 0), cB, voffB); PG8_STAGE(PG8_SA(0, 0), cA, vA[0]); PG8_STAGE(PG8_SB(0, 1), cB + hstepB, voffB); PG8_STAGE(PG8_SA(0, 1), cA, vA[1]);
    if (wr == 1) PG8_BAR;
    PG8_WAIT_V(4); PG8_BAR;
    PG8_STAGE(PG8_SB(1, 0), cB + kstep, voffB); PG8_STAGE(PG8_SA(1, 0), cA + kstep, vA[0]); PG8_STAGE(PG8_SB(1, 1), cB + hstepB + kstep, voffB);
    PG8_WAIT_V(6); PG8_BAR;
    for (;;) {
        const bool has_next = S.next(ui + 1, nxt);
        const char* nA = cA; const char* nB = cB;
        if (has_next) { nA = nxt.Ab; nB = nxt.Bb; if (GA) PG8_SETVA(nvA, nxt); }
        else if (GA) {
#pragma unroll
            for (int h = 0; h < 2; ++h)
#pragma unroll
                for (int i = 0; i < 2; ++i) nvA[h][i] = vA[h][i]; }
#pragma unroll 1
        for (int t = 0; t < nt; t += 2) {
            const bool last = (t == nt - 2);
            const char* a1 = cA + (size_t)(t + 1) * kstep;
            const char* a2 = last ? nA : cA + (size_t)(t + 2) * kstep; const char* b2 = last ? nB : cB + (size_t)(t + 2) * kstep;
            const char* a3 = a2 + kstep; const char* b3 = b2 + kstep;
            unsigned s2[2][2];
#pragma unroll
            for (int h = 0; h < 2; ++h)
#pragma unroll
                for (int i = 0; i < 2; ++i) s2[h][i] = (GA && last) ? nvA[h][i] : vA[h][i];
            PG8_LDB(B0, 0, 0); PG8_SCHED; PG8_LDA(At, 0, 0); PG8_STAGE(PG8_SA(1, 1), a1, vA[1]);
            PG8_WAIT_L(8); PG8_BAR; PG8_WAIT_L(0); PG8_MMA(0, 0, At, B0); PG8_BAR; PG8_SCHED;
            PG8_LDB(B1, 0, 1); PG8_STAGE(PG8_SB(0, 0), b2, voffB);
            PG8_BAR; PG8_WAIT_L(0); PG8_MMA(0, 1, At, B1); PG8_BAR;
            PG8_LDA(At, 0, 1); PG8_STAGE(PG8_SA(0, 0), a2, s2[0]);
            PG8_BAR; PG8_WAIT_L(0); PG8_MMA(1, 0, At, B0); PG8_BAR; PG8_SCHED;
            PG8_STAGE(PG8_SB(0, 1), b2 + hstepB, voffB);
            PG8_WAIT_V(6); PG8_BAR; PG8_MMA(1, 1, At, B1); PG8_BAR;
            PG8_LDB(B0, 1, 0); PG8_SCHED; PG8_LDA(At, 1, 0); PG8_STAGE(PG8_SA(0, 1), a2, s2[1]);
            PG8_WAIT_L(8); PG8_BAR; PG8_WAIT_L(0); PG8_MMA(0, 0, At, B0); PG8_BAR; PG8_SCHED;
            PG8_LDB(B1, 1, 1); PG8_STAGE(PG8_SB(1, 0), b3, voffB);
            PG8_BAR; PG8_WAIT_L(0); PG8_MMA(0, 1, At, B1); PG8_BAR;
            PG8_LDA(At, 1, 1); PG8_STAGE(PG8_SA(1, 0), a3, s2[0]);
            PG8_BAR; PG8_WAIT_L(0); PG8_MMA(1, 0, At, B0); PG8_BAR; PG8_SCHED;
            PG8_STAGE(PG8_SB(1, 1), b3 + hstepB, voffB);
            PG8_WAIT_V(6); PG8_BAR; PG8_MMA(1, 1, At, B1); PG8_BAR;
        }
        { int fr_e = fr, fq_e = fq; asm volatile("" : "+v"(fr_e), "+v"(fq_e));
          E(acc, cur, wr, wc, fr_e, fq_e); }
        if (!has_next) break;
#pragma unroll
        for (int a = 0; a < 2; ++a)
#pragma unroll
            for (int b = 0; b < 2; ++b)
#pragma unroll
                for (int m = 0; m < 4; ++m)
#pragma unroll
                    for (int n = 0; n < 2; ++n) acc[a][b][m][n] = (f32x4){0.f, 0.f, 0.f, 0.f};
        cur = nxt; cA = nA; cB = nB; ++ui;
        if (GA) {
#pragma unroll
        for (int h = 0; h < 2; ++h)
#pragma unroll
            for (int i = 0; i < 2; ++i) vA[h][i] = nvA[h][i]; }
    }
    PG8_WAIT_V(0);
    if (wr == 0) PG8_BAR;
    PG8_BAR;
#undef PG8_SA
#undef PG8_SB
#undef PG8_STAGE
#undef PG8_LDA
#undef PG8_LDB
#undef PG8_MMA
#undef PG8_WAIT_V
#undef PG8_WAIT_L
#undef PG8_BAR
#undef PG8_SCHED
#undef PG8_SETVA
}
#define EPI_FOR(ai, m, bj) _Pragma("unroll") for (int ai = 0; ai < 2; ++ai) _Pragma("unroll") for (int m = 0; m < 4; ++m) _Pragma("unroll") for (int bj = 0; bj < 2; ++bj)
__device__ __forceinline__ u32x4 pack8(f32x4 v0, f32x4 v1) { u32x4 w; w.x = cvt_pk_bf16(v0[0], v0[1]); w.y = cvt_pk_bf16(v0[2], v0[3]); w.z = cvt_pk_bf16(v1[0], v1[1]); w.w = cvt_pk_bf16(v1[2], v1[3]); return w; }
}
using pg8::Unit;

struct EpiG1 {
    static constexpr bool PERM = true;
    const float* rstd; bf16 *zmla, *zrkv, *zlora, *zgate;
    __device__ __forceinline__ void operator()(const PG8_ACC, const Unit& u, int wr, int wc, int fr, int fq) const {
        bf16* base; int ld, c0;
        if (u.pn < 4) { base = zmla; ld = ZM_LD; c0 = u.pn * 256; } else if (u.pn < 28) { base = zrkv; ld = ZR_LD; c0 = (u.pn - 4) * 256; }
        else if (u.pn < 31) { base = zlora; ld = ZL_LD; c0 = (u.pn - 28) * 256; } else { base = zgate; ld = ZG_LD; c0 = (u.pn - 31) * 256; }
        const int col0 = c0 + wc * 32 + 8 * fq;
        EPI_FOR(ai, m, bj) { const int row = u.pm * 256 + ai * 128 + wr * 64 + m * 16 + fr; const float rs = rstd[row];
            *(u32x4*)(base + (size_t)row * ld + col0 + bj * 128) = pg8::pack8(acc[ai][bj][m][0] * rs, acc[ai][bj][m][1] * rs); }
    }
};
struct EpiPlain {
    static constexpr bool PERM = true;
    bf16* O; int ld; const float* rstd; float scale;
    __device__ __forceinline__ void operator()(const PG8_ACC, const Unit& u, int wr, int wc, int fr, int fq) const {
        const int col0 = u.pn * 256 + wc * 32 + 8 * fq;
        EPI_FOR(ai, m, bj) { const int row = u.pm * 256 + ai * 128 + wr * 64 + m * 16 + fr; const float rs = (rstd ? rstd[row] : 1.f) * scale;
            *(u32x4*)(O + (size_t)row * ld + col0 + bj * 128) = pg8::pack8(acc[ai][bj][m][0] * rs, acc[ai][bj][m][1] * rs); }
    }
};
constexpr float QSCALE = 0.07216878364870322f * 1.4426950408889634f;
constexpr float CSCALE = 0.08838834764831845f * 1.4426950408889634f;
struct EpiQ {
    static constexpr bool PERM = true;
    bf16* Q; const float* rstd; const float* cs;
    __device__ __forceinline__ void operator()(const PG8_ACC, const Unit& u, int wr, int wc, int fr, int fq) const {
        EPI_FOR(ai, m, bj) { const int row = u.pm * 256 + ai * 128 + wr * 64 + m * 16 + fr; const int col = u.pn * 256 + bj * 128 + wc * 32 + 8 * fq;
            const float rs = rstd[row] * QSCALE; f32x4 v0 = acc[ai][bj][m][0] * rs, v1 = acc[ai][bj][m][1] * rs;
            const int cih = col % QKD;
            if (cih >= NOPE) { const int i0 = (cih - NOPE) >> 1; const f32x4* t = (const f32x4*)(cs + ((size_t)row * 32 + i0) * 2);
                const f32x4 a = t[0], b = t[1];
                f32x4 r0, r1;
                r0[0] = v0[0] * a[0] - v0[1] * a[1]; r0[1] = v0[1] * a[0] + v0[0] * a[1]; r0[2] = v0[2] * a[2] - v0[3] * a[3]; r0[3] = v0[3] * a[2] + v0[2] * a[3];
                r1[0] = v1[0] * b[0] - v1[1] * b[1]; r1[1] = v1[1] * b[0] + v1[0] * b[1]; r1[2] = v1[2] * b[2] - v1[3] * b[3]; r1[3] = v1[3] * b[2] + v1[2] * b[3];
                v0 = r0; v1 = r1; }
            *(u32x4*)(Q + (size_t)row * (MH * QKD) + col) = pg8::pack8(v0, v1); }
    }
};
struct EpiKV {
    static constexpr bool PERM = true;
    bf16* Kb; bf16* Vb; const float* rstd;
    __device__ __forceinline__ void operator()(const PG8_ACC, const Unit& u, int wr, int wc, int fr, int fq) const {
        const int c = wc * 32 + 8 * fq;
        EPI_FOR(ai, m, bj) { const int row = u.pm * 256 + ai * 128 + wr * 64 + m * 16 + fr; const float rs = rstd[row];
            bf16* dst = bj == 0 ? Kb + (size_t)row * (MH * QKD) + u.pn * QKD + c : Vb + (size_t)row * (MH * VDIM) + u.pn * VDIM + c;
            *(u32x4*)dst = pg8::pack8(acc[ai][bj][m][0] * rs, acc[ai][bj][m][1] * rs); }
    }
};
template <int MODE> struct EpiLora {
    static constexpr bool PERM = true;
    bf16* O; const float* bias;
    __device__ __forceinline__ void operator()(const PG8_ACC, const Unit& u, int wr, int wc, int fr, int fq) const {
        EPI_FOR(ai, m, bj) { const int row = u.pm * 256 + ai * 128 + wr * 64 + m * 16 + fr; const int col = u.pn * 256 + bj * 128 + wc * 32 + 8 * fq;
            f32x4 v0 = acc[ai][bj][m][0], v1 = acc[ai][bj][m][1];
            if (MODE != 2) { const f32x4 b0 = *(const f32x4*)(bias + col), b1 = *(const f32x4*)(bias + col + 4);
#pragma unroll
                for (int j = 0; j < 4; ++j) { float s0 = sigmoidf_(v0[j] + b0[j]), s1 = sigmoidf_(v1[j] + b1[j]);
                    if (MODE == 0) { s0 *= -0.8750394f; s1 *= -0.8750394f; }
                    v0[j] = s0; v1[j] = s1; } }
            *(u32x4*)(O + (size_t)row * RW + col) = pg8::pack8(v0, v1); }
    }
};
template <int SECOND> struct EpiUp {
    static constexpr bool PERM = true;
    bf16* O; const bf16* zg; int goff;
    __device__ __forceinline__ void operator()(const PG8_ACC, const Unit& u, int wr, int wc, int fr, int fq) const {
        EPI_FOR(ai, m, bj) { const int row = u.pm * 256 + ai * 128 + wr * 64 + m * 16 + fr; const int col = u.pn * 256 + bj * 128 + wc * 32 + 8 * fq;
            const u32x4 g = *(const u32x4*)(zg + (size_t)row * ZG_LD + goff + col);
            f32x4 v0 = acc[ai][bj][m][0], v1 = acc[ai][bj][m][1];
            v0[0] *= sigmoidf_(bflo(g.x)); v0[1] *= sigmoidf_(bfhi(g.x)); v0[2] *= sigmoidf_(bflo(g.y)); v0[3] *= sigmoidf_(bfhi(g.y));
            v1[0] *= sigmoidf_(bflo(g.z)); v1[1] *= sigmoidf_(bfhi(g.z)); v1[2] *= sigmoidf_(bflo(g.w)); v1[3] *= sigmoidf_(bfhi(g.w));
            bf16* dst = O + (size_t)row * DM + col;
            if (SECOND) { const u32x4 p = *(const u32x4*)dst;
                v0[0] += bflo(p.x); v0[1] += bfhi(p.x); v0[2] += bflo(p.y); v0[3] += bfhi(p.y); v1[0] += bflo(p.z); v1[1] += bfhi(p.z); v1[2] += bflo(p.w); v1[3] += bfhi(p.w); }
            *(u32x4*)dst = pg8::pack8(v0, v1); }
    }
};
struct EpiResid {
    static constexpr bool PERM = true;
    const float* base; float* out;
    __device__ __forceinline__ void operator()(const PG8_ACC, const Unit& u, int wr, int wc, int fr, int fq) const {
        EPI_FOR(ai, m, bj) { const int row = u.pm * 256 + ai * 128 + wr * 64 + m * 16 + fr; const int col = u.pn * 256 + bj * 128 + wc * 32 + 8 * fq;
            const size_t o = (size_t)row * DM + col; const f32x4 b0 = *(const f32x4*)(base + o), b1 = *(const f32x4*)(base + o + 4);
            *(f32x4*)(out + o) = b0 + acc[ai][bj][m][0]; *(f32x4*)(out + o + 4) = b1 + acc[ai][bj][m][1]; }
    }
};

struct SplitKOrder {
    static constexpr bool GATHER = false;
    const char* A; const char* Bt; int G, c;
    __device__ __forceinline__ bool next(int i, Unit& u) const {
        const int L = i * G + c; if (L >= 32 * 2 * 4) return false;
        const int ks = L & 3, pn = (L >> 2) & 1, pm = L >> 3;
        u.pm = pm; u.pn = pn; u.aux0 = ks; u.aux1 = 0; u.Ab = A + ((size_t)pm * 256 * DM + ks * 512) * 2; u.Bb = Bt + ((size_t)pn * 256 * DM + ks * 512) * 2; return true;
    }
    __device__ __forceinline__ unsigned arow(const Unit&, int r) const { return (unsigned)r; }
};
struct EpiSlab {
    static constexpr bool PERM = true;
    float* slab;
    __device__ __forceinline__ void operator()(const PG8_ACC, const Unit& u, int wr, int wc, int fr, int fq) const {
        float* base = slab + (size_t)u.aux0 * MT * CW;
        EPI_FOR(ai, m, bj) { const int row = u.pm * 256 + ai * 128 + wr * 64 + m * 16 + fr; const int col = u.pn * 256 + bj * 128 + wc * 32 + 8 * fq;
            float* d = base + (size_t)row * CW + col; *(f32x4*)d = acc[ai][bj][m][0]; *(f32x4*)(d + 4) = acc[ai][bj][m][1]; }
    }
};

namespace att {
constexpr int NW = 8, QBLK = 32, KVBLK = 64;
constexpr float THRL = 11.5f;
#define SBAR() __builtin_amdgcn_sched_barrier(0)
__device__ __forceinline__ int crow(int r, int hi) { return (r & 3) + 8 * (r >> 2) + 4 * hi; }
__device__ __forceinline__ void partialSM(f32x16& p, float& m_reg, float& alpha) {
    float pmax = p[0];
#pragma unroll
    for (int r = 1; r < 16; ++r) pmax = fmaxf(pmax, p[r]);
    { auto rr = __builtin_amdgcn_permlane32_swap(__float_as_uint(pmax), __float_as_uint(pmax), false, false);
      pmax = fmaxf(__uint_as_float(rr[0]), __uint_as_float(rr[1])); }
    float mn;
    if (__builtin_expect(__all(pmax - m_reg <= THRL), 1)) { mn = m_reg; alpha = 1.f; }
    else { mn = fmaxf(m_reg, pmax); alpha = __builtin_amdgcn_exp2f(m_reg - mn); m_reg = mn; }
#pragma unroll
    for (int r = 0; r < 16; ++r) p[r] = p[r] - mn;
#pragma unroll
    for (int r = 0; r < 8; ++r) p[r] = __builtin_amdgcn_exp2f(p[r]);
}
__device__ __forceinline__ void finishSM(f32x16& p, float alpha, float& l_reg, bf16x8& pa0, bf16x8& pa1) {
#pragma unroll
    for (int r = 8; r < 16; ++r) p[r] = __builtin_amdgcn_exp2f(p[r]);
    float ps = 0;
#pragma unroll
    for (int r = 0; r < 16; ++r) ps += p[r];
    { auto rr = __builtin_amdgcn_permlane32_swap(__float_as_uint(ps), __float_as_uint(ps), false, false);
      ps = __uint_as_float(rr[0]) + __uint_as_float(rr[1]); }
    l_reg = l_reg * alpha + ps;
#define PK4(P, BASE, OUT) do { unsigned a0 = cvt_pk_bf16(P[BASE + 0], P[BASE + 1]), a1 = cvt_pk_bf16(P[BASE + 2], P[BASE + 3]);   \
    unsigned b0 = cvt_pk_bf16(P[BASE + 4], P[BASE + 5]), b1 = cvt_pk_bf16(P[BASE + 6], P[BASE + 7]);                              \
    auto r0 = __builtin_amdgcn_permlane32_swap(a0, b0, false, false); auto r1 = __builtin_amdgcn_permlane32_swap(a1, b1, false, false); \
    u32x4 w = {r0[0], r1[0], r0[1], r1[1]}; OUT = *reinterpret_cast<bf16x8*>(&w); } while (0)
    PK4(p, 0, pa0); PK4(p, 8, pa1);
#undef PK4
}
template <int DQK> __device__ __forceinline__ int kswz(int row, int colB) { return row * (DQK * 2 + 16) + colB; }
template <int DQK> __device__ __forceinline__ void qkt(f32x16& p, const LAS char* Ks, const bf16x8* qr, int krow, int hi) {
    p = f32x16{};
#pragma unroll
    for (int d0 = 0; d0 < DQK / 16; ++d0) { const int cb = (d0 * 16 + hi * 8) * 2;
        bf16x8 b0 = *reinterpret_cast<const LAS bf16x8*>(Ks + kswz<DQK>(krow, cb));
        p = __builtin_amdgcn_mfma_f32_32x32x16_bf16(b0, qr[d0], p, 0, 0, 0); }
}
__device__ __forceinline__ int v_st(int k, int c) { const int kk = (k & ~0xC) | ((k & 4) << 1) | ((k & 8) >> 1); return ((kk >> 3) * 4 + (c >> 5)) * 512 + ((kk & 7) * 32 + (c & 31)) * 2; }
__device__ __forceinline__ int v_rd_base(int lane) { return ((lane & 3) << 3) | (((lane >> 2) & 3) << 6) | (((lane >> 4) & 1) << 5) | (((lane >> 5) & 1) << 8); }
constexpr int v_rd_off(int d0, int ks, int half) { return d0 * 512 + ks * 4096 + half * 2048; }
template <int OFF> __device__ __forceinline__ s16x4 tr_read(int vb) {
    s16x4 r; asm volatile("ds_read_b64_tr_b16 %0, %1 offset:%2" : "=&v"(r) : "v"(vb), "i"(OFF) : "memory"); return r;
}
template <int D0, int KH> __device__ __forceinline__ void pv_one(f32x16& od, int vb, bf16x8 pa0, bf16x8 pa1) {
    const s16x4 l0 = tr_read<v_rd_off(D0, 2 * KH, 0)>(vb), h0 = tr_read<v_rd_off(D0, 2 * KH, 1)>(vb), l1 = tr_read<v_rd_off(D0, 2 * KH + 1, 0)>(vb), h1 = tr_read<v_rd_off(D0, 2 * KH + 1, 1)>(vb);
    asm volatile("s_waitcnt lgkmcnt(0)" ::: "memory"); SBAR();
#define PK(L, H) (bf16x8){L[0], L[1], L[2], L[3], H[0], H[1], H[2], H[3]}
    od = __builtin_amdgcn_mfma_f32_32x32x16_bf16(pa0, PK(l0, h0), od, 0, 0, 0);
    od = __builtin_amdgcn_mfma_f32_32x32x16_bf16(pa1, PK(l1, h1), od, 0, 0, 0);
#undef PK
}
template <int KH> __device__ __forceinline__ void pv_d0(f32x16* o, int vb, bf16x8 pa0, bf16x8 pa1) {
    pv_one<0, KH>(o[0], vb, pa0, pa1); pv_one<1, KH>(o[1], vb, pa0, pa1); pv_one<2, KH>(o[2], vb, pa0, pa1); pv_one<3, KH>(o[3], vb, pa0, pa1);
}
template <int DQK, int LDQ, int LDK, int LDV, int LDO, bool QSLAB = false>
__device__ __forceinline__ void attn_unit(const bf16* __restrict__ Qb, const bf16* __restrict__ Kh, const bf16* __restrict__ Vh, bf16* __restrict__ Ob, const int seq, LAS char* lds, const float* qscale = nullptr, const float qmul = 1.f) {
    constexpr int SHM_V = KVBLK * 128 * 2, SHM_K = KVBLK * (DQK * 2 + 16), KCH = DQK / 64;
    const int tid = threadIdx.x, wid = tid >> 6, lane = tid & 63, r32 = lane & 31, hi = lane >> 5;
    LAS char* V_lds = lds; LAS char* K_lds = lds + 2 * SHM_V;
    LAS float* wsf = (LAS float*)(lds + 2 * SHM_V + 2 * SHM_K) + wid * 64; LAS float* li_l = wsf; LAS float* al_l = wsf + 32;
    float m_reg = -1e30f, l_reg = 0; f32x16 o[4] = {}; bf16x8 qr[DQK / 16];
    if constexpr (!QSLAB) { const bf16* Qw = Qb + (long)(wid * QBLK + r32) * LDQ + hi * 8;
#pragma unroll
        for (int d0 = 0; d0 < DQK / 16; ++d0) qr[d0] = *reinterpret_cast<const bf16x8*>(Qw + d0 * 16);
    } else { const float* Qf = (const float*)Qb + (size_t)(wid * QBLK + r32) * LDQ + hi * 8; const float sc = qscale[wid * QBLK + r32] * qmul;
#pragma unroll
        for (int d0 = 0; d0 < DQK / 16; ++d0) { f32x4 a = {0.f, 0.f, 0.f, 0.f}, b = {0.f, 0.f, 0.f, 0.f};
#pragma unroll
            for (int ks = 0; ks < 4; ++ks) { const float* p = Qf + (size_t)ks * MT * LDQ + d0 * 16; a += *(const f32x4*)p; b += *(const f32x4*)(p + 4); }
            a = a * sc; b = b * sc; u32x4 w = {cvt_pk_bf16(a[0], a[1]), cvt_pk_bf16(a[2], a[3]), cvt_pk_bf16(b[0], b[1]), cvt_pk_bf16(b[2], b[3])}; qr[d0] = *reinterpret_cast<bf16x8*>(&w); } }
    const int sr = tid >> 4, sc = (tid & 15) * 8, vst0 = v_st(sr, sc), vst1 = v_st(32 + sr, sc);
    unsigned kgo[KCH]; int klo[KCH];
#pragma unroll
    for (int i = 0; i < KCH; ++i) { const int id = tid + 512 * i, row = id / (DQK / 8), c8 = id % (DQK / 8); kgo[i] = (unsigned)(row * LDK + c8 * 8) * 2u; klo[i] = kswz<DQK>(row, c8 * 16); }
    const unsigned vgo0 = (unsigned)(sr * LDV + sc) * 2u, vgo1 = (unsigned)((32 + sr) * LDV + sc) * 2u;
    const int vb0 = (int)(uintptr_t)V_lds + v_rd_base(lane);
    bf16x8 vs0, vs1, ks[KCH];
#define SLOAD(k0) do { const char* _vt = (const char*)(Vh + (size_t)(k0) * LDV); const char* _kt = (const char*)(Kh + (size_t)(k0) * LDK); \
    vs0 = *reinterpret_cast<const bf16x8*>(_vt + vgo0); vs1 = *reinterpret_cast<const bf16x8*>(_vt + vgo1); \
    _Pragma("unroll") for (int _i = 0; _i < KCH; ++_i) ks[_i] = *reinterpret_cast<const bf16x8*>(_kt + kgo[_i]); } while (0)
#define SWRITE(b) do { *(LAS bf16x8*)(V_lds + (b) * SHM_V + vst0) = vs0; *(LAS bf16x8*)(V_lds + (b) * SHM_V + vst1) = vs1; \
    _Pragma("unroll") for (int _i = 0; _i < KCH; ++_i) *(LAS bf16x8*)(K_lds + (b) * SHM_K + klo[_i]) = ks[_i]; } while (0)
#define SWAIT() asm volatile("s_waitcnt vmcnt(0)" ::: "memory")
#define RESC(a) do { if (__any((a) < 1.f)) { if (hi == 0) al_l[r32] = (a); asm volatile("s_waitcnt lgkmcnt(0)" ::: "memory"); \
    _Pragma("unroll") for (int d = 0; d < 4; ++d) _Pragma("unroll") for (int r = 0; r < 16; ++r) o[d][r] *= al_l[crow(r, hi)]; } } while (0)
    f32x16 pA, pB; float alA, alB; bf16x8 pa0, pa1; const int NT = seq / KVBLK;
    SLOAD(0); SWAIT(); SWRITE(0); __syncthreads();
    if (1 < NT) SLOAD(KVBLK);
    qkt<DQK>(pA, K_lds, qr, r32, hi); partialSM(pA, m_reg, alA);
    if (1 < NT) { SWAIT(); SWRITE(1); } __syncthreads();
    if (2 < NT) SLOAD(2 * KVBLK);
    SBAR(); qkt<DQK>(pB, K_lds, qr, 32 + r32, hi);
    finishSM(pA, alA, l_reg, pa0, pa1); SBAR();
    pv_d0<0>(o, vb0, pa0, pa1); partialSM(pB, m_reg, alB); RESC(alB);
    for (int j = 1; j < NT; ++j) {
        const int cb = j & 1, pb = cb ^ 1;
        SBAR(); qkt<DQK>(pA, K_lds + cb * SHM_K, qr, r32, hi);
        finishSM(pB, alB, l_reg, pa0, pa1); SBAR();
        pv_d0<1>(o, vb0 + pb * SHM_V, pa0, pa1); partialSM(pA, m_reg, alA);
        __syncthreads(); if (j + 1 < NT) { SWAIT(); SWRITE(pb); }
        RESC(alA); __syncthreads();
        if (j + 2 < NT) SLOAD((j + 2) * KVBLK);
        SBAR(); qkt<DQK>(pB, K_lds + cb * SHM_K, qr, 32 + r32, hi);
        finishSM(pA, alA, l_reg, pa0, pa1); SBAR();
        pv_d0<0>(o, vb0 + cb * SHM_V, pa0, pa1); partialSM(pB, m_reg, alB); RESC(alB);
    }
    finishSM(pB, alB, l_reg, pa0, pa1); SBAR();
    pv_d0<1>(o, vb0 + ((NT - 1) & 1) * SHM_V, pa0, pa1);
    if (hi == 0) li_l[r32] = l_reg; asm volatile("s_waitcnt lgkmcnt(0)" ::: "memory");
    float rli[16];
#pragma unroll
    for (int r = 0; r < 16; ++r) rli[r] = __builtin_amdgcn_rcpf(li_l[crow(r, hi)]);
    bf16* Ow = Ob + (size_t)(wid * QBLK) * LDO;
    int r32e = r32, hie = hi; asm volatile("" : "+v"(r32e), "+v"(hie));
    const unsigned ob = (unsigned)(4 * hie * LDO + r32e);
#pragma unroll
    for (int r = 0; r < 16; ++r) {
#pragma unroll
        for (int d0 = 0; d0 < 4; ++d0) Ow[ob + (unsigned)(((r & 3) + 8 * (r >> 2)) * LDO + d0 * 32)] = f2bf(o[d0][r] * rli[r]); }
    __syncthreads();
#undef SLOAD
#undef SWRITE
#undef SWAIT
#undef RESC
}
}

struct Frame {
    LAS unsigned char* lds; volatile LAS unsigned* MISC; unsigned* ctl;
    int tid, lane, wave, vcu, G;
    unsigned char* ws; float* out;
    const float* in[41];
};
enum { I_X = 0, I_MEM, I_POS, I_GMIX, I_WIN, I_GQ, I_WUQ, I_GKV, I_WUKV, I_SHIFT, I_W0F, I_W2F, I_W0B, I_W2B, I_A0F, I_A2F, I_A0B, I_A2B, I_G2, I_KK, I_KA, I_RK,
       I_LNXG, I_LNXB, I_WUPM, I_WUPR, I_WOUT, I_GCROSS, I_GMEM, I_WQC, I_WKVC, I_WOC, I_GFFN, I_WRG, I_BRG, I_WRE, I_BRE, I_WEG, I_WEU, I_WED, I_GFINAL };

template <int MODE> __device__ __forceinline__ int rowmap(int n) {
    if (MODE == 1) {
        if (n < 768) return n;
        if (n < 832) { const int p = n - 768; return 768 + (p < 32 ? 2 * p : 2 * (p - 32) + 1); }
        if (n < 6976) return 1024 + (n - 832);
        if (n < 7616) return 7168 + (n - 6976);
        return 7936 + (n - 7616);
    }
    if (MODE == 2) {
        const int h = n / QKD, d = n % QKD; if (d < NOPE) return n; const int p = d - NOPE; return h * QKD + NOPE + (p < 32 ? 2 * p : 2 * (p - 32) + 1);
    }
    if (MODE == 3) return (n >> 7) * 256 + (n & 127);
    if (MODE == 4) return (n >> 7) * 256 + 128 + (n & 127);
    return n;
}
constexpr int CVT_SCR = 16640;
template <int MODE> __device__ __forceinline__ void cvt_item(const float* W, int K, int N, const float* gain, bf16* WT, int ldt, LAS float* scr, int item, int lane, int kofs = 0) {
    const int nblk = N / 64, kb = item / nblk, nb = item % nblk, k0 = 64 * kb, n0 = 64 * nb;
    const int kq = lane >> 4, nc = (lane & 15) * 4;
    f32x4 v[16];
#pragma unroll
    for (int i = 0; i < 16; ++i) { const int k = k0 + 4 * i + kq - kofs; v[i] = (f32x4){0.f, 0.f, 0.f, 0.f};
        if (k >= 0 && k < K) { v[i] = *(const f32x4*)(W + (size_t)k * N + n0 + nc); if (gain) v[i] = v[i] * gain[k]; } }
#pragma unroll
    for (int i = 0; i < 16; ++i) { const int kk = 4 * i + kq;
#pragma unroll
        for (int c = 0; c < 4; ++c) scr[(nc + c) * 65 + kk] = v[i][c]; }
    LDS_WAIT(); asm volatile("" ::: "memory");
    const int kc = (lane & 7) * 8;
#pragma unroll
    for (int jj = 0; jj < 8; ++jj) { const int n = (lane >> 3) + 8 * jj; const LAS float* s = scr + n * 65 + kc;
        u32x4 o; o.x = cvt_pk_bf16(s[0], s[1]); o.y = cvt_pk_bf16(s[2], s[3]); o.z = cvt_pk_bf16(s[4], s[5]); o.w = cvt_pk_bf16(s[6], s[7]);
        *(u32x4*)(WT + (size_t)rowmap<MODE>(n0 + n) * ldt + k0 + kc) = o; }
    LDS_WAIT(); asm volatile("" ::: "memory");
}
#define CVT_JOB(MODE, src, K, N, gain, dst, ldt) { const int _n = (((K) + 63) / 64) * ((N) / 64); if (r < _n) { cvt_item<MODE>(src, K, N, gain, dst, ldt, scr, r, F.lane); continue; } r -= _n; }
#define CVT_JOB_PAD(src, K, N, dst, KPAD, KOFS) { const int _n = ((KPAD) / 64) * ((N) / 64); if (r < _n) { cvt_item<0>(src, K, N, nullptr, dst, KPAD, scr, r, F.lane, KOFS); continue; } r -= _n; }

__device__ __forceinline__ void p0_prologue(Frame& F) {
    LAS float* scr = (LAS float*)(F.lds + F.wave * CVT_SCR);
    const int gw = F.vcu * 8 + F.wave, NGW = F.G * 8;
    unsigned char* ws = F.ws;
    constexpr int TOTAL = 32 * (IN_W / 64) + 8 * 48 + 4 * 64 + 4 * (4 * 32) + 4 * 32 + 3 * (32 * 32) + 32 * 8 + 32 * 16 + 8 * 32;
    for (int it = gw; it < TOTAL; it += NGW) {
        int r = it;
        CVT_JOB(1, F.in[I_WIN], DM, IN_W, F.in[I_GMIX], (bf16*)(ws + WS_WIN), DM)
        CVT_JOB(2, F.in[I_WUQ], QLORA, MH * QKD, F.in[I_GQ], (bf16*)(ws + WS_WUQ), QLORA)
        CVT_JOB(0, F.in[I_WUKV], KVLORA, MH * 256, F.in[I_GKV], (bf16*)(ws + WS_WUKV), KVLORA)
        CVT_JOB_PAD(F.in[I_W2F], DLORA, RW, (bf16*)(ws + WS_W2F), 256, 0)
        CVT_JOB_PAD(F.in[I_W2B], DLORA, RW, (bf16*)(ws + WS_W2F + 1 * MiB), 256, 128)
        CVT_JOB_PAD(F.in[I_A2F], DLORA, RW, (bf16*)(ws + WS_W2F + 2 * MiB), 256, 0)
        CVT_JOB_PAD(F.in[I_A2B], DLORA, RW, (bf16*)(ws + WS_W2F + 3 * MiB), 256, 128)
        CVT_JOB(0, F.in[I_G2], GLORA, RW, nullptr, (bf16*)(ws + WS_G2), GLORA)
        CVT_JOB(0, F.in[I_WUPM], DM, DM, nullptr, (bf16*)(ws + WS_WUPM), DM)
        CVT_JOB(0, F.in[I_WUPR], DM, DM, nullptr, (bf16*)(ws + WS_WUPR), DM)
        CVT_JOB(0, F.in[I_WOUT], DM, DM, nullptr, (bf16*)(ws + WS_WOUT), DM)
        CVT_JOB(0, F.in[I_WQC], DM, CW, F.in[I_GCROSS], (bf16*)(ws + WS_WQC), DM)
        CVT_JOB(0, F.in[I_WKVC], DM, 2 * CW, nullptr, (bf16*)(ws + WS_WKVC), DM)
        CVT_JOB(0, F.in[I_WOC], CW, DM, nullptr, (bf16*)(ws + WS_WOC), CW)
    }
    const float* x = F.in[I_X]; bf16* xb = (bf16*)(ws + WS_XB); float* rstd1 = (float*)(ws + WS_RSTD);
    for (int m = gw; m < MT + NB * MEMLEN; m += NGW) {
        const bool ismem = m >= MT; const int mm = ismem ? m - MT : m;
        const f32x4* xr = (const f32x4*)((ismem ? F.in[I_MEM] : x) + (size_t)mm * DM) + F.lane;
        f32x4 v[8]; float s = 0.f;
#pragma unroll
        for (int j = 0; j < 8; ++j) { v[j] = xr[64 * j]; s += (v[j].x * v[j].x + v[j].y * v[j].y) + (v[j].z * v[j].z + v[j].w * v[j].w); }
        const float rs = 1.0f / sqrtf(wave_sum(s) * (1.f / DM) + RMS_EPS);
        if (!ismem) { if (F.lane == 0) rstd1[mm] = rs;
            u32x2* o8 = (u32x2*)(xb + (size_t)mm * DM) + F.lane;
#pragma unroll
            for (int j = 0; j < 8; ++j) { u32x2 w; w.x = cvt_pk_bf16(v[j].x, v[j].y); w.y = cvt_pk_bf16(v[j].z, v[j].w); o8[64 * j] = w; }
        } else { const f32x4* gr = (const f32x4*)F.in[I_GMEM] + F.lane;
            u32x2* o8 = (u32x2*)((bf16*)(ws + WS_MEMN) + (size_t)mm * DM) + F.lane;
#pragma unroll
            for (int j = 0; j < 8; ++j) { const f32x4 g = gr[64 * j]; u32x2 w; w.x = cvt_pk_bf16(v[j].x * rs * g.x, v[j].y * rs * g.y); w.y = cvt_pk_bf16(v[j].z * rs * g.z, v[j].w * rs * g.w); o8[64 * j] = w; }
        }
    }
    const int gt = F.vcu * 512 + F.tid, NGT = F.G * 512;
    { const int* pos = (const int*)F.in[I_POS]; f32x2* cs = (f32x2*)(ws + WS_ROPE);
      for (int i = gt; i < MT * 32; i += NGT) { const int t = i >> 5, f = i & 31;
          const float inv = exp2f(-(float)f * (13.287712379549449f / 32.0f));
          const float ang = (float)pos[t] * inv;
          const double a = (double)ang; const double k = rint(a * 0.15915494309189535); const float red = (float)(a - k * 6.283185307179586);
          cs[i] = (f32x2){cosf(red), sinf(red)}; } }
    { float* WR = (float*)(ws + WS_WR); const float* gf = F.in[I_GFFN];
      for (int i = gt; i < DM * 36; i += NGT) { const int k = i / 36, c = i % 36; float w;
          if (c < 4) w = F.in[I_WRG][k * 4 + c]; else { const int gi = (c - 4) >> 3, e = (c - 4) & 7; w = F.in[I_WRE][((size_t)gi * DM + k) * 8 + e]; }
          WR[i] = w * gf[k]; } }
}

__device__ __forceinline__ void p_final(Frame& F, bool with_moe) {
    const int gw = F.vcu * 8 + F.wave, NGW = F.G * 8;
    const f32x4* gr = (const f32x4*)F.in[I_GFINAL] + F.lane;
    const int* route = (const int*)(F.ws + WS_ROUTE); const bf16* ybuf = (const bf16*)(F.ws + WS_YBUF);
    const int* cnts = (const int*)(F.ctl + CW_CNT);
    for (int m = gw; m < MT; m += NGW) {
        f32x4* xr = (f32x4*)(F.out + (size_t)m * DM) + F.lane;
        f32x4 v[8];
#pragma unroll
        for (int j = 0; j < 8; ++j) v[j] = xr[64 * j];
        if (with_moe) {
#pragma unroll
            for (int kx = 0; kx < 2; ++kx) { const int e = route[m * 8 + 2 * kx], pos = route[m * 8 + 2 * kx + 1];
                int base = 0; for (int q = 0; q < e; ++q) base += (cnts[64 * q] + 255) & ~255;
                const u32x2* yr = (const u32x2*)(ybuf + (size_t)(base + pos) * DM) + F.lane;
#pragma unroll
                for (int j = 0; j < 8; ++j) { const u32x2 w = yr[64 * j]; v[j].x += bflo(w.x); v[j].y += bfhi(w.x); v[j].z += bflo(w.y); v[j].w += bfhi(w.y); } }
        }
        float s = 0.f;
#pragma unroll
        for (int j = 0; j < 8; ++j) s += (v[j].x * v[j].x + v[j].y * v[j].y) + (v[j].z * v[j].z + v[j].w * v[j].w);
        const float rs = 1.0f / sqrtf(wave_sum(s) * (1.f / DM) + RMS_EPS);
#pragma unroll
        for (int j = 0; j < 8; ++j) { const f32x4 g = gr[64 * j]; xr[64 * j] = (f32x4){v[j].x * rs * g.x, v[j].y * rs * g.y, v[j].z * rs * g.z, v[j].w * rs * g.w}; }
    }
}
__device__ __forceinline__ void p_copy_x(Frame& F) {
    const int gt = F.vcu * 512 + F.tid, NGT = F.G * 512; const f32x4* s = (const f32x4*)F.in[I_X]; f32x4* d = (f32x4*)F.out;
    for (int i = gt; i < MT * DM / 4; i += NGT) d[i] = s[i];
}

__device__ __forceinline__ void p2_rowpass(Frame& F) {
    const int gw = F.vcu * 8 + F.wave, NGW = F.G * 8, l = F.lane;
    unsigned char* ws = F.ws;
    const bf16* zm = (const bf16*)(ws + WS_ZMLA); const bf16* zl = (const bf16*)(ws + WS_ZLORA); bf16* la = (bf16*)(ws + WS_LORAA);
    float* rstd_q = (float*)(ws + WS_RSTD) + MT; float* rstd_kv = (float*)(ws + WS_RSTD) + 2 * MT;
    const f32x2* cs = (const f32x2*)(ws + WS_ROPE); bf16* Kb = (bf16*)(ws + WS_K);
    const float* sh = F.in[I_SHIFT] + 6144;
    f32x2 s0[5], s1[5], s2[5];
#pragma unroll
    for (int i = 0; i < 5; ++i) { const int j = 2 * l + 128 * i; s0[i] = *(const f32x2*)(sh + j); s1[i] = *(const f32x2*)(sh + RWKV_IN + j); s2[i] = *(const f32x2*)(sh + 2 * RWKV_IN + j); }
    for (int t = gw; t < MT; t += NGW) {
        const bf16* zr = zm + (size_t)t * ZM_LD;
        { const u32x4 w = *((const u32x4*)zr + l); float s = 0.f;
          s += bflo(w.x) * bflo(w.x) + bfhi(w.x) * bfhi(w.x) + bflo(w.y) * bflo(w.y) + bfhi(w.y) * bfhi(w.y) + bflo(w.z) * bflo(w.z) + bfhi(w.z) * bfhi(w.z) + bflo(w.w) * bflo(w.w) + bfhi(w.w) * bfhi(w.w);
          s = wave_sum(s); if (l == 0) rstd_q[t] = 1.0f / sqrtf(s * (1.f / QLORA) + RMS_EPS); }
        { const u32x2 w = *((const u32x2*)(zr + QLORA) + l); float s = bflo(w.x) * bflo(w.x) + bfhi(w.x) * bfhi(w.x) + bflo(w.y) * bflo(w.y) + bfhi(w.y) * bfhi(w.y);
          s = wave_sum(s); if (l == 0) rstd_kv[t] = 1.0f / sqrtf(s * (1.f / KVLORA) + RMS_EPS); }
        { const int i = l & 31, hs = l >> 5; const unsigned w = *((const unsigned*)(zr + 768) + i); const float x1 = bflo(w), x2 = bfhi(w); const f32x2 c = cs[(size_t)t * 32 + i];
          const unsigned o = cvt_pk_bf16(x1 * c.x - x2 * c.y, x2 * c.x + x1 * c.y);
#pragma unroll
          for (int hh = 0; hh < 8; ++hh) *((unsigned*)(Kb + (size_t)t * (MH * QKD) + (hs * 8 + hh) * QKD + NOPE) + i) = o; }
        const int s = t % SEQ; const float fp = s > 0 ? 1.f : 0.f, fn = s < SEQ - 1 ? 1.f : 0.f;
        const bf16* z0 = zl + (size_t)t * ZL_LD; const bf16* zp = s > 0 ? z0 - ZL_LD : z0; const bf16* zn = s < SEQ - 1 ? z0 + ZL_LD : z0;
        bf16* lr = la + (size_t)t * LA_LD;
#pragma unroll
        for (int i = 0; i < 5; ++i) { const int j = 2 * l + 128 * i;
            const unsigned wp = *(const unsigned*)(zp + j), w0 = *(const unsigned*)(z0 + j), wn = *(const unsigned*)(zn + j);
            float va = s0[i].x * fp * bflo(wp) + s1[i].x * bflo(w0) + s2[i].x * fn * bflo(wn);
            float vb = s0[i].y * fp * bfhi(wp) + s1[i].y * bfhi(w0) + s2[i].y * fn * bfhi(wn);
            int dst;
            if (j < 192) { va = tanhf(va); vb = tanhf(vb); dst = (j / 96) * 128 + (j % 96); } else if (j < 384) { dst = (j / 96) * 128 + (j % 96); } else { va = sigmoidf_(va); vb = sigmoidf_(vb); dst = 512 + (j - 384); }
            *(unsigned*)(lr + dst) = cvt_pk_bf16(va, vb); }
        { const int p = 2 * l; *(unsigned*)(lr + (p >> 5) * 128 + 96 + (p & 31)) = 0u; }
    }
}

namespace scan {
constexpr int TC = 16, DATA_B = TC * 6 * 64 * 4, BUF_B = DATA_B + 64 + TC * 32 * 4;
template <int CTRL> __device__ __forceinline__ float dpp_add(float v) {
    return v + __builtin_bit_cast(float, __builtin_amdgcn_update_dpp(0, __builtin_bit_cast(int, v), CTRL, 0xF, 0xF, false));
}
__device__ __forceinline__ float red16(float v) { v = dpp_add<0xB1>(v); v = dpp_add<0x4E>(v); v = dpp_add<0x141>(v); v = dpp_add<0x140>(v); return v; }
struct Raw { unsigned short r[3], k[3], v[3], wl, ic; };
template <int VAR> __device__ __forceinline__ void scan_unit(Frame& F, const int b, const int h, const int dir, const int half) {
    unsigned char* ws = F.ws; const int l = F.lane, w = F.wave, tid = F.tid;
    const bf16* zr = (const bf16*)(ws + WS_ZRKV) + (size_t)b * SEQ * ZR_LD + h * 64 + l;
    const bf16* wlp = (const bf16*)(ws + (dir ? WS_WLB : WS_WLF)) + (size_t)b * SEQ * RW + h * 64 + l;
    const bf16* icp = (const bf16*)(ws + (dir ? WS_ICB : WS_ICF)) + (size_t)b * SEQ * RW + h * 64 + l;
    bf16* yout = (bf16*)(ws + (dir ? WS_YB : WS_YF)) + (size_t)b * SEQ * RW + h * 64 + half * 32;
    const int ch = h * 64 + l; const float* sh = F.in[I_SHIFT];
    const float sr0 = sh[ch], sr1 = sh[RWKV_IN + ch], sr2 = sh[2 * RWKV_IN + ch];
    const float sk0 = sh[2048 + ch], sk1 = sh[RWKV_IN + 2048 + ch], sk2 = sh[2 * RWKV_IN + 2048 + ch];
    const float sv0 = sh[4096 + ch], sv1 = sh[RWKV_IN + 4096 + ch], sv2 = sh[2 * RWKV_IN + 4096 + ch];
    const float kk_c = F.in[I_KK][ch], ka_c = F.in[I_KA][ch], rk_c = F.in[I_RK][ch];
    LAS unsigned char* L = F.lds;
    Raw raw[2];
#define SC_TOK(ci, i) (dir ? (SEQ - 1 - ((ci) * TC + (i))) : ((ci) * TC + (i)))
#define SC_LOAD(ci) do { _Pragma("unroll") for (int q = 0; q < 2; ++q) { const int s = SC_TOK(ci, 2 * w + q); const int sp = s > 0 ? s - 1 : s, sn = s < SEQ - 1 ? s + 1 : s; \
        const bf16* z0 = zr + (size_t)s * ZR_LD; const bf16* zp = zr + (size_t)sp * ZR_LD; const bf16* zn = zr + (size_t)sn * ZR_LD; \
        raw[q].r[0] = zp[0]; raw[q].r[1] = z0[0]; raw[q].r[2] = zn[0]; raw[q].k[0] = zp[2048]; raw[q].k[1] = z0[2048]; raw[q].k[2] = zn[2048]; \
        raw[q].v[0] = zp[4096]; raw[q].v[1] = z0[4096]; raw[q].v[2] = zn[4096]; raw[q].wl = wlp[(size_t)s * RW]; raw[q].ic = icp[(size_t)s * RW]; } } while (0)
#define SC_PREP(ci, bufi) do { _Pragma("unroll") for (int q = 0; q < 2; ++q) { const int i = 2 * w + q; const int s = SC_TOK(ci, i); const float fp = s > 0 ? 1.f : 0.f, fn = s < SEQ - 1 ? 1.f : 0.f; \
        const float r_s = sr0 * fp * bf2f(raw[q].r[0]) + sr1 * bf2f(raw[q].r[1]) + sr2 * fn * bf2f(raw[q].r[2]); \
        const float k_s = sk0 * fp * bf2f(raw[q].k[0]) + sk1 * bf2f(raw[q].k[1]) + sk2 * fn * bf2f(raw[q].k[2]); \
        const float v_s = sv0 * fp * bf2f(raw[q].v[0]) + sv1 * bf2f(raw[q].v[1]) + sv2 * fn * bf2f(raw[q].v[2]); \
        const float kkr = k_s * kk_c; const float ss = wave_sum(kkr * kkr); const float kk = kkr * (1.0f / sqrtf(ss + 1e-12f)); \
        const float icv = bf2f(raw[q].ic); const float kd = k_s * (1.0f + (icv - 1.0f) * ka_c); const float bb = kk * icv; const float wd = __builtin_amdgcn_exp2f(bf2f(raw[q].wl)); \
        const float bon = wave_sum(r_s * kd * rk_c); \
        LAS float* d = (LAS float*)(L + (bufi) * BUF_B) + i * 384 + l; d[0] = wd; d[64] = kk; d[128] = bb; d[192] = kd; d[256] = r_s; d[320] = v_s; \
        if (l == 0) ((LAS float*)(L + (bufi) * BUF_B + DATA_B))[i] = bon; } } while (0)
    const int g = l >> 4, j = l & 15, row = half * 32 + w * 4 + g;
    f32x2 Sa = {0.f, 0.f}, Sb = {0.f, 0.f};
    struct Ops { f32x4 w, a, b, k, r; float v, bon; };
#define SC_LD(O, i) do { O.w = p4[(i) * 96 + j]; O.a = p4[(i) * 96 + 16 + j]; O.b = p4[(i) * 96 + 32 + j]; O.k = p4[(i) * 96 + 48 + j]; O.r = p4[(i) * 96 + 64 + j]; \
        O.v = pf[(i) * 384 + 320 + row]; O.bon = pb[i]; } while (0)
#define SC_STEP(O, YP) do { f32x2 t = Sa * O.a.xy; t = Sb * O.a.zw + t; float sa = red16(t.x + t.y); \
        const f32x2 nsa = {-sa, -sa}; const f32x2 vv2 = {O.v, O.v}; \
        const f32x2 u0 = nsa * O.b.xy + vv2 * O.k.xy, u1 = nsa * O.b.zw + vv2 * O.k.zw; \
        Sa = Sa * O.w.xy + u0; Sb = Sb * O.w.zw + u1; \
        f32x2 ty = Sa * O.r.xy; ty = Sb * O.r.zw + ty; YP = ty.x + ty.y; } while (0)
    SC_LOAD(0); SC_PREP(0, 0); __syncthreads();
    constexpr int NCH = SEQ / TC;
    for (int ci = 0; ci < NCH; ++ci) {
        const int bi = ci & 1;
        if (VAR != 2 && ci + 1 < NCH) SC_LOAD(ci + 1);
        const LAS f32x4* p4 = (const LAS f32x4*)(L + bi * BUF_B); const LAS float* pf = (const LAS float*)(L + bi * BUF_B);
        const LAS float* pb = (const LAS float*)(L + bi * BUF_B + DATA_B);
        float ykeep = 0.f;
        Ops oA, oB; SC_LD(oA, 0);
        if (VAR != 1) {
#pragma unroll
        for (int i = 0; i < TC; i += 4) {
            float y0, y1, y2, y3; float v0, v1, v2, v3, b0, b1, b2, b3;
            SC_LD(oB, i + 1); v0 = oA.v; b0 = oA.bon; SC_STEP(oA, y0);
            SC_LD(oA, i + 2); v1 = oB.v; b1 = oB.bon; SC_STEP(oB, y1);
            SC_LD(oB, i + 3); v2 = oA.v; b2 = oA.bon; SC_STEP(oA, y2);
            if (i + 4 < TC) SC_LD(oA, i + 4);
            v3 = oB.v; b3 = oB.bon; SC_STEP(oB, y3);
            y0 = red16(y0); y1 = red16(y1); y2 = red16(y2); y3 = red16(y3);
            y0 += b0 * v0; y1 += b1 * v1; y2 += b2 * v2; y3 += b3 * v3;
            ykeep = (j == i) ? y0 : ykeep; ykeep = (j == i + 1) ? y1 : ykeep; ykeep = (j == i + 2) ? y2 : ykeep; ykeep = (j == i + 3) ? y3 : ykeep;
        }
        }
        ((LAS float*)(L + bi * BUF_B + DATA_B + 64))[j * 32 + w * 4 + g] = ykeep;
        if (VAR != 2 && ci + 1 < NCH) SC_PREP(ci + 1, bi ^ 1);
        __syncthreads();
        { const int st = tid >> 5, rw_ = tid & 31; const int s = SC_TOK(ci, st);
          const unsigned short yv = f2bf(((const LAS float*)(L + bi * BUF_B + DATA_B + 64))[st * 32 + rw_]);
          if (VAR == 0) yout[(size_t)s * RW + rw_] = yv; else asm volatile("" :: "v"(yv)); }
    }
    __syncthreads();
#undef SC_TOK
#undef SC_LOAD
#undef SC_PREP
#undef SC_LD
#undef SC_STEP
}
}

namespace scan2 {
constexpr int TC = 16, NS = 5, NPREP = 6, NREC = 2;
constexpr int ROWB = 144;
constexpr int P_ACAT = 0, P_BHAT = 4608, P_KHAT = 6656, P_VT = 8704, P_NCAT = 10752, P_MRF = 11776, P_PC = 12800, P_GINIT = 13056, PKG_B = 17152;
constexpr int S_L1 = 0, S_L2 = 4608, S_MF = 9216, S_NF = 10240, SCR_B = 11264;
constexpr int OFF_PKG = 0, OFF_SCR = NS * PKG_B, OFF_FLAG = OFF_SCR + NPREP * SCR_B, TOTAL_B = OFF_FLAG + 64;
static_assert(TOTAL_B <= 152 * 1024, "scan2 LDS");
__device__ __forceinline__ int crow(int r, int hi) { return (r & 3) + 8 * (r >> 2) + 4 * hi; }
__device__ __forceinline__ void lds_st16(LAS unsigned char* p, float v) { *(LAS unsigned short*)p = f2bf(v); }
__device__ __forceinline__ bf16x8 pack_acc8(const f32x16& x, int base) {
    u32x4 w = {cvt_pk_bf16(x[base + 0], x[base + 1]), cvt_pk_bf16(x[base + 2], x[base + 3]), cvt_pk_bf16(x[base + 4], x[base + 5]), cvt_pk_bf16(x[base + 6], x[base + 7])};
    return *reinterpret_cast<bf16x8*>(&w);
}
__device__ __forceinline__ void spin_ge(volatile LAS int* p, int want) { while (*p < want) __builtin_amdgcn_s_sleep(1); }

template <int dir> __device__ __forceinline__ void scan_unit(Frame& F, const int b, const int h) {
    unsigned char* ws = F.ws; const int l = F.lane, w = F.wave;
    LAS unsigned char* L = F.lds;
    volatile LAS int* ready = (volatile LAS int*)(L + OFF_FLAG);
    volatile LAS int* consumed = ready + NS;
    if (F.tid < 16) ready[F.tid] = 0;
    __syncthreads();
    constexpr int NCH = SEQ / TC;
    if (w < NREC) {
        const int half = w; const int v = l & 31, hi = l >> 5, vg = 32 * half + v;
        f32x16 X0 = {}, X1 = {};
        bf16* yout = (bf16*)(ws + (dir ? WS_YB : WS_YF)) + (size_t)b * SEQ * RW + h * 64 + half * 32 + v;
        for (int ci = 0; ci < NCH; ++ci) {
            const int slot = ci % NS; const LAS unsigned char* P = L + OFF_PKG + slot * PKG_B;
            spin_ge(ready + slot, ci + 1);
            const bf16x8 a00 = *(const LAS bf16x8*)(P + P_ACAT + v * ROWB + (0 + hi) * 16), a01 = *(const LAS bf16x8*)(P + P_ACAT + v * ROWB + (2 + hi) * 16);
            const bf16x8 a10 = *(const LAS bf16x8*)(P + P_ACAT + v * ROWB + (4 + hi) * 16), a11 = *(const LAS bf16x8*)(P + P_ACAT + v * ROWB + (6 + hi) * 16);
            const bf16x8 ncat = *(const LAS bf16x8*)(P + P_NCAT + v * 32 + hi * 16), vt = *(const LAS bf16x8*)(P + P_VT + vg * 32 + hi * 16);
            const bf16x8 mrf = *(const LAS bf16x8*)(P + P_MRF + l * 16);
            const bf16x8 bh0 = *(const LAS bf16x8*)(P + P_BHAT + v * 32 + hi * 16), bh1 = *(const LAS bf16x8*)(P + P_BHAT + (32 + v) * 32 + hi * 16);
            const bf16x8 kh0 = *(const LAS bf16x8*)(P + P_KHAT + v * 32 + hi * 16), kh1 = *(const LAS bf16x8*)(P + P_KHAT + (32 + v) * 32 + hi * 16);
            f32x16 G;
            { const f32x4 g0 = *(const LAS f32x4*)(P + P_GINIT + vg * 64 + hi * 16), g1 = *(const LAS f32x4*)(P + P_GINIT + vg * 64 + 32 + hi * 16);
#pragma unroll
              for (int r = 0; r < 8; ++r) G[r] = 0.f;
#pragma unroll
              for (int r = 0; r < 4; ++r) { G[8 + r] = g0[r]; G[12 + r] = g1[r]; } }
            f32x4 pc[8];
#pragma unroll
            for (int q = 0; q < 8; ++q) pc[q] = *(const LAS f32x4*)(P + P_PC + (32 * (q >> 2) + 8 * (q & 3) + 4 * hi) * 4);
            const bf16x8 s00 = pack_acc8(X0, 0), s01 = pack_acc8(X0, 8), s10 = pack_acc8(X1, 0), s11 = pack_acc8(X1, 8);
            G = __builtin_amdgcn_mfma_f32_32x32x16_bf16(a00, s00, G, 0, 0, 0);
            G = __builtin_amdgcn_mfma_f32_32x32x16_bf16(a01, s01, G, 0, 0, 0);
            G = __builtin_amdgcn_mfma_f32_32x32x16_bf16(a10, s10, G, 0, 0, 0);
            G = __builtin_amdgcn_mfma_f32_32x32x16_bf16(a11, s11, G, 0, 0, 0);
            G = __builtin_amdgcn_mfma_f32_32x32x16_bf16(ncat, vt, G, 0, 0, 0);
            const bf16x8 uf = pack_acc8(G, 0);
#pragma unroll
            for (int r = 0; r < 16; ++r) { X0[r] *= pc[r >> 2][r & 3]; X1[r] *= pc[4 + (r >> 2)][r & 3]; }
            X0 = __builtin_amdgcn_mfma_f32_32x32x16_bf16(bh0, uf, X0, 0, 0, 0);
            X1 = __builtin_amdgcn_mfma_f32_32x32x16_bf16(bh1, uf, X1, 0, 0, 0);
            X0 = __builtin_amdgcn_mfma_f32_32x32x16_bf16(kh0, vt, X0, 0, 0, 0);
            X1 = __builtin_amdgcn_mfma_f32_32x32x16_bf16(kh1, vt, X1, 0, 0, 0);
            G = __builtin_amdgcn_mfma_f32_32x32x16_bf16(mrf, uf, G, 0, 0, 0);
            LDS_WAIT();
            if (l == 0) consumed[half] = ci + 1;
#pragma unroll
            for (int q = 0; q < 8; ++q) { const int t = crow(q, hi); const int s = dir ? (SEQ - 1 - (ci * TC + t)) : (ci * TC + t);
                yout[(size_t)s * RW] = f2bf(G[8 + q]); }
        }
    } else {
        const int pw = w - NREC; LAS unsigned char* SC = L + OFF_SCR + pw * SCR_B;
        const bf16* zr = (const bf16*)(ws + WS_ZRKV) + (size_t)b * SEQ * ZR_LD + h * 64 + l;
        const bf16* wlp = (const bf16*)(ws + (dir ? WS_WLB : WS_WLF)) + (size_t)b * SEQ * RW + h * 64 + l;
        const bf16* icp = (const bf16*)(ws + (dir ? WS_ICB : WS_ICF)) + (size_t)b * SEQ * RW + h * 64 + l;
        const int ch = h * 64 + l; const float* sh = F.in[I_SHIFT];
        const float sr0 = sh[ch], sr1 = sh[RWKV_IN + ch], sr2 = sh[2 * RWKV_IN + ch];
        const float sk0 = sh[2048 + ch], sk1 = sh[RWKV_IN + 2048 + ch], sk2 = sh[2 * RWKV_IN + 2048 + ch];
        const float sv0 = sh[4096 + ch], sv1 = sh[RWKV_IN + 4096 + ch], sv2 = sh[2 * RWKV_IN + 4096 + ch];
        const float kk_c = F.in[I_KK][ch], ka_c = F.in[I_KA][ch], rk_c = F.in[I_RK][ch];
        const int posk = (((l >> 5) * 2 + ((l >> 4) & 1)) * 2 + ((l >> 2) & 1)) * 8 + ((l >> 3) & 1) * 4 + (l & 3);
        for (int ci = pw; ci < NCH; ci += NPREP) {
            const int slot = ci % NS; LAS unsigned char* P = L + OFF_PKG + slot * PKG_B;
            const int s_lo = dir ? (SEQ - TC - ci * TC) : ci * TC;
            float rr[18], rk[18], rv[18], wl[16], ic[16];
#pragma unroll
            for (int tau = 0; tau < 18; ++tau) { const int s = s_lo - 1 + tau; const bool ok = (s >= 0) && (s < SEQ); const int sc = ok ? s : s_lo; const bf16* z = zr + (size_t)sc * ZR_LD;
                const float f = ok ? 1.f : 0.f; rr[tau] = f * bf2f(z[0]); rk[tau] = f * bf2f(z[2048]); rv[tau] = f * bf2f(z[4096]); }
#pragma unroll
            for (int i = 0; i < 16; ++i) { const int s = dir ? (s_lo + 15 - i) : (s_lo + i); wl[i] = bf2f(wlp[(size_t)s * RW]); ic[i] = bf2f(icp[(size_t)s * RW]); }
            float cum[16];
            cum[0] = wl[0];
#pragma unroll
            for (int i = 1; i < 16; ++i) cum[i] = cum[i - 1] + wl[i];
            spin_ge(consumed, ci - NS + 1); spin_ge(consumed + 1, ci - NS + 1);
            float at[16];
#pragma unroll
            for (int i = 0; i < 16; ++i) { const int tau = dir ? (16 - i) : (i + 1);
                const float r_s = sr0 * rr[tau - 1] + sr1 * rr[tau] + sr2 * rr[tau + 1];
                const float k_s = sk0 * rk[tau - 1] + sk1 * rk[tau] + sk2 * rk[tau + 1];
                const float v_s = sv0 * rv[tau - 1] + sv1 * rv[tau] + sv2 * rv[tau + 1];
                const float kkr = k_s * kk_c; const float ss = wave_sum(kkr * kkr); const float kk = kkr * __builtin_amdgcn_rsqf(ss + 1e-12f);
                const float kd = k_s * (1.0f + (ic[i] - 1.0f) * ka_c); const float bb = kk * ic[i];
                const float bon = wave_sum(r_s * kd * rk_c);
                const float p = __builtin_amdgcn_exp2f(cum[i]), pm = i ? __builtin_amdgcn_exp2f(cum[i - 1]) : 1.0f, pinv = __builtin_amdgcn_exp2f(-cum[i]), pr = __builtin_amdgcn_exp2f(cum[15] - cum[i]);
                at[i] = -kk * pm;
                lds_st16(SC + S_L2 + i * ROWB + l * 2, at[i]);
                const float rt = r_s * p;
                lds_st16(SC + S_L2 + (16 + i) * ROWB + l * 2, rt); lds_st16(P + P_ACAT + (16 + i) * ROWB + posk * 2, rt);
                lds_st16(SC + S_L1 + i * ROWB + l * 2, bb * pinv); lds_st16(SC + S_L1 + (16 + i) * ROWB + l * 2, kd * pinv);
                lds_st16(P + P_BHAT + l * 32 + ((((i >> 2) & 1) * 8) + (i & 3) + 4 * (i >> 3)) * 2, bb * pr);
                lds_st16(P + P_KHAT + l * 32 + i * 2, kd * pr);
                lds_st16(P + P_VT + l * 32 + i * 2, v_s); *(LAS float*)(P + P_GINIT + l * 64 + i * 4) = bon * v_s;
            }
            *(LAS float*)(P + P_PC + l * 4) = __builtin_amdgcn_exp2f(cum[15]);
            LDS_WAIT();
            f32x16 Z = {};
            { const int r = l & 31, hh = l >> 5;
#pragma unroll
              for (int ks = 0; ks < 4; ++ks) { const bf16x8 fa = *(const LAS bf16x8*)(SC + S_L1 + r * ROWB + (ks * 16 + hh * 8) * 2), fb = *(const LAS bf16x8*)(SC + S_L2 + r * ROWB + (ks * 16 + hh * 8) * 2);
                  Z = __builtin_amdgcn_mfma_f32_32x32x16_bf16(fa, fb, Z, 0, 0, 0); } }
            { const int c = l & 31, hh = l >> 5;
              if (c < 16) {
#pragma unroll
                  for (int r = 0; r < 8; ++r) { const int s = crow(r, hh); *(LAS float*)(SC + S_MF + (c * 16 + s) * 4) = (s < c) ? Z[r] : 0.f; }
#pragma unroll
                  for (int r = 8; r < 16; ++r) { const int s = crow(r, hh) - 16; *(LAS float*)(SC + S_NF + (s * 16 + c) * 4) = (s < c) ? Z[r] : 0.f; }
                  *(LAS u32x4*)(P + P_MRF + l * 16) = (u32x4){0u, 0u, 0u, 0u};
              } else { const int t = c - 16; f32x16 Zm = Z;
#pragma unroll
                  for (int r = 0; r < 8; ++r) { const int s = crow(r, hh); Zm[r] = (s <= t) ? Z[r] : 0.f; }
                  *(LAS bf16x8*)(P + P_MRF + l * 16) = pack_acc8(Zm, 0);
#pragma unroll
                  for (int r = 8; r < 16; ++r) { const int s = crow(r, hh) - 16; lds_st16(P + P_NCAT + c * 32 + s * 2, (s <= t) ? Z[r] : 0.f); }
              } }
            LDS_WAIT();
            { float x[16]; x[0] = at[0];
#pragma unroll
              for (int t = 1; t < 16; ++t) { float acc = at[t];
#pragma unroll
                  for (int s4 = 0; s4 < (t + 3) / 4; ++s4) { const f32x4 m = *(const LAS f32x4*)(SC + S_MF + (t * 16 + s4 * 4) * 4);
#pragma unroll
                      for (int q = 0; q < 4; ++q) if (s4 * 4 + q < t) acc += x[s4 * 4 + q] * m[q]; }
                  x[t] = acc; }
#pragma unroll
              for (int t = 0; t < 16; ++t) lds_st16(P + P_ACAT + t * ROWB + posk * 2, x[t]); }
            if (l < 16) { float n[16], x[16];
#pragma unroll
              for (int q = 0; q < 4; ++q) { const f32x4 nv = *(const LAS f32x4*)(SC + S_NF + (l * 16 + q * 4) * 4); n[q * 4 + 0] = nv[0]; n[q * 4 + 1] = nv[1]; n[q * 4 + 2] = nv[2]; n[q * 4 + 3] = nv[3]; }
              x[0] = n[0];
#pragma unroll
              for (int t = 1; t < 16; ++t) { float acc = n[t];
#pragma unroll
                  for (int s4 = 0; s4 < (t + 3) / 4; ++s4) { const f32x4 m = *(const LAS f32x4*)(SC + S_MF + (t * 16 + s4 * 4) * 4);
#pragma unroll
                      for (int q = 0; q < 4; ++q) if (s4 * 4 + q < t) acc += x[s4 * 4 + q] * m[q]; }
                  x[t] = acc; }
#pragma unroll
              for (int t = 0; t < 16; ++t) lds_st16(P + P_NCAT + t * 32 + l * 2, x[t]); }
            LDS_WAIT();
            if (l == 0) ready[slot] = ci + 1;
        }
    }
    __syncthreads();
}
}

__device__ __forceinline__ void p5_post(Frame& F) {
    const int gw = F.vcu * 8 + F.wave, NGW = F.G * 8, l = F.lane; unsigned char* ws = F.ws;
    const bf16* yf = (const bf16*)(ws + WS_YF); const bf16* yb = (const bf16*)(ws + WS_YB); const bf16* gg = (const bf16*)(ws + WS_G); bf16* o = (bf16*)(ws + WS_ORWKV);
    const float* lg = F.in[I_LNXG]; const float* lb = F.in[I_LNXB];
    for (int t = gw; t < MT; t += NGW) {
        const size_t base = (size_t)t * RW;
#pragma unroll 4
        for (int h = 0; h < RH; ++h) { const int c = h * 64 + l;
            const float y = bf2f(yf[base + c]) + bf2f(yb[base + c]);
            const float mu = wave_sum(y) * (1.f / 64.f); const float d = y - mu; const float var = wave_sum(d * d) * (1.f / 64.f);
            const float yn = d * (1.0f / sqrtf(var + LNX_EPS));
            o[base + c] = f2bf((yn * lg[c] + lb[c]) * bf2f(gg[base + c])); }
    }
}

__device__ __forceinline__ void p8_rowpass(Frame& F) {
    const int gw = F.vcu * 8 + F.wave, NGW = F.G * 8; float* rstd2 = (float*)(F.ws + WS_RSTD) + 3 * MT; bf16* hb = (bf16*)(F.ws + WS_H1B);
    for (int m = gw; m < MT; m += NGW) {
        const f32x4* xr = (const f32x4*)(F.out + (size_t)m * DM) + F.lane; f32x4 v[8]; float s = 0.f;
#pragma unroll
        for (int j = 0; j < 8; ++j) { v[j] = xr[64 * j]; s += (v[j].x * v[j].x + v[j].y * v[j].y) + (v[j].z * v[j].z + v[j].w * v[j].w); }
        s = wave_sum(s); if (F.lane == 0) rstd2[m] = 1.0f / sqrtf(s * (1.f / DM) + RMS_EPS);
        u32x2* o8 = (u32x2*)(hb + (size_t)m * DM) + F.lane;
#pragma unroll
        for (int j = 0; j < 8; ++j) { u32x2 w; w.x = cvt_pk_bf16(v[j].x, v[j].y); w.y = cvt_pk_bf16(v[j].z, v[j].w); o8[64 * j] = w; }
    }
}
__device__ __forceinline__ void p12_router(Frame& F) {
    const int gw = F.vcu * 8 + F.wave, NGW = F.G * 8, l = F.lane; unsigned char* ws = F.ws;
    float* rstd3 = (float*)(ws + WS_RSTD) + 4 * MT; bf16* n3 = (bf16*)(ws + WS_N3); const float* WR = (const float*)(ws + WS_WR);
    int* lists = (int*)(ws + WS_LIST); int* route = (int*)(ws + WS_ROUTE); float* slotw = (float*)(ws + WS_SLOTW);
    int* cnt = (int*)(F.ctl + CW_CNT);
    const float* brg = F.in[I_BRG]; const float* bre = F.in[I_BRE];
    for (int t0 = gw * 2; t0 < MT; t0 += NGW * 2) {
        float ss[2] = {0.f, 0.f};
#pragma unroll
        for (int q = 0; q < 2; ++q) { const f32x4* xr = (const f32x4*)(F.out + (size_t)(t0 + q) * DM) + l; u32x2* o8 = (u32x2*)(n3 + (size_t)(t0 + q) * DM) + l;
#pragma unroll
            for (int j = 0; j < 8; ++j) { const f32x4 x = xr[64 * j]; ss[q] += (x.x * x.x + x.y * x.y) + (x.z * x.z + x.w * x.w);
                u32x2 w; w.x = cvt_pk_bf16(x.x, x.y); w.y = cvt_pk_bf16(x.z, x.w); o8[64 * j] = w; } }
        float acc[2][36];
#pragma unroll
        for (int q = 0; q < 2; ++q)
#pragma unroll
            for (int o = 0; o < 36; ++o) acc[q][o] = 0.f;
        const f32x4* xr0 = (const f32x4*)(F.out + (size_t)t0 * DM) + l; const f32x4* xr1 = xr0 + DM / 4;
#pragma unroll 1
        for (int j = 0; j < 8; ++j) { const f32x4 xa = xr0[64 * j], xb = xr1[64 * j];
#pragma unroll 1
            for (int c4 = 0; c4 < 4; ++c4) { const int c = 4 * l + 256 * j + c4; const f32x4* wr = (const f32x4*)(WR + (size_t)c * 36);
                const float x0 = c4 == 0 ? xa.x : c4 == 1 ? xa.y : c4 == 2 ? xa.z : xa.w, x1 = c4 == 0 ? xb.x : c4 == 1 ? xb.y : c4 == 2 ? xb.z : xb.w;
#pragma unroll
                for (int o4 = 0; o4 < 9; ++o4) { const f32x4 w = wr[o4];
#pragma unroll
                    for (int k = 0; k < 4; ++k) { acc[0][o4 * 4 + k] += x0 * w[k]; acc[1][o4 * 4 + k] += x1 * w[k]; } } }
        }
#pragma unroll
        for (int q = 0; q < 2; ++q) { ss[q] = wave_sum(ss[q]);
#pragma unroll
            for (int o = 0; o < 36; ++o) acc[q][o] = wave_sum(acc[q][o]); }
#pragma unroll
        for (int q = 0; q < 2; ++q) { const int t = t0 + q; const float rs = 1.0f / sqrtf(ss[q] * (1.f / DM) + RMS_EPS);
            float lg[4]; float gmax = -3.0e38f; int gsel = 0;
#pragma unroll
            for (int g = 0; g < 4; ++g) { lg[g] = acc[q][g] * rs + brg[g]; if (lg[g] > gmax) { gmax = lg[g]; gsel = g; } }
            float gz = 0.f;
#pragma unroll
            for (int g = 0; g < 4; ++g) gz += __expf(lg[g] - gmax);
            const float pg = 1.0f / gz;
            float le[8];
#pragma unroll
            for (int e = 0; e < 8; ++e) { float a = acc[q][4 + e];
#pragma unroll
                for (int g = 1; g < 4; ++g) a = (gsel == g) ? acc[q][4 + g * 8 + e] : a;
                le[e] = a * rs + bre[gsel * 8 + e]; }
            float m1 = -3.0e38f, m2 = -3.0e38f; int e1 = 0, e2 = 0;
#pragma unroll
            for (int e = 0; e < 8; ++e) { if (le[e] > m1) { m2 = m1; e2 = e1; m1 = le[e]; e1 = e; } else if (le[e] > m2) { m2 = le[e]; e2 = e; } }
            const float x2 = __expf(m2 - m1); const float w1 = pg / (1.0f + x2), w2 = pg * x2 / (1.0f + x2);
            if (l == 0) { rstd3[t] = rs;
                const int E1 = gsel * 8 + e1, E2 = gsel * 8 + e2;
                const int p1 = atomicAdd(cnt + 64 * E1, 1), p2 = atomicAdd(cnt + 64 * E2, 1);
                lists[E1 * MT + p1] = t; lists[E2 * MT + p2] = t; slotw[E1 * MT + p1] = w1; slotw[E2 * MT + p2] = w2;
                route[t * 8 + 0] = E1; route[t * 8 + 1] = p1; route[t * 8 + 2] = E2; route[t * 8 + 3] = p2; }
        }
    }
}
struct MoeOrder {
    static constexpr bool GATHER = true;
    const volatile LAS int* tp; const int* cnt; const int* lists; const char* A; const char* B; int G, c, lognt; size_t bstride_e, bstride_t;
    bool gather;
    __device__ __forceinline__ bool next(int i, Unit& u) const {
        const int L = i * G + c; const int RT = tp[32]; if (L >= (RT << lognt)) return false;
        const int rt = L >> lognt, nt = L & ((1 << lognt) - 1); int e = 0;
        for (int q = 1; q < 32; ++q) e = (rt >= tp[q]) ? q : e;
        u.pm = rt; u.pn = nt; u.aux0 = e; u.aux1 = (rt - tp[e]) * 256;
        u.Ab = A; u.Bb = B + (size_t)e * bstride_e + (size_t)nt * bstride_t; return true;
    }
    __device__ __forceinline__ unsigned arow(const Unit& u, int r) const {
        if (!gather) return (unsigned)(u.pm * 256 + r);
        const int idx = u.aux1 + r; const int n = cnt[64 * u.aux0]; return idx < n ? (unsigned)lists[u.aux0 * MT + idx] : 0u;
    }
};
struct EpiMoe1 {
    static constexpr bool PERM = true;
    bf16* hid; const int* cnt; const int* lists; const float* slotw; const float* rstd;
    __device__ __forceinline__ void operator()(const PG8_ACC, const Unit& u, int wr, int wc, int fr, int fq) const {
        const int n = cnt[64 * u.aux0];
#pragma unroll
        for (int ai = 0; ai < 2; ++ai)
#pragma unroll
            for (int m = 0; m < 4; ++m) { const int r = ai * 128 + wr * 64 + m * 16 + fr; const int idx = u.aux1 + r; const bool ok = idx < n;
                const int tok = ok ? lists[u.aux0 * MT + idx] : 0; const float rs = rstd[tok]; const float wt = ok ? slotw[u.aux0 * MT + idx] : 0.f;
                f32x4 o0, o1;
#pragma unroll
                for (int j = 0; j < 4; ++j) { const float g0 = acc[ai][0][m][0][j] * rs, u0 = acc[ai][1][m][0][j] * rs, g1 = acc[ai][0][m][1][j] * rs, u1 = acc[ai][1][m][1][j] * rs;
                    o0[j] = g0 * sigmoidf_(g0) * u0 * wt; o1[j] = g1 * sigmoidf_(g1) * u1 * wt; }
                *(u32x4*)(hid + (size_t)(u.pm * 256 + r) * DE + u.pn * 128 + wc * 32 + 8 * fq) = pg8::pack8(o0, o1); }
    }
};
struct EpiMoe2 {
    static constexpr bool PERM = true;
    bf16* y;
    __device__ __forceinline__ void operator()(const PG8_ACC, const Unit& u, int wr, int wc, int fr, int fq) const {
        EPI_FOR(ai, m, bj) { const int row = u.pm * 256 + ai * 128 + wr * 64 + m * 16 + fr; const int col = u.pn * 256 + bj * 128 + wc * 32 + 8 * fq;
            *(u32x4*)(y + (size_t)row * DM + col) = pg8::pack8(acc[ai][bj][m][0], acc[ai][bj][m][1]); }
    }
};
__device__ __forceinline__ void moe_table(Frame& F) {
    if (F.tid == 0) { const int* cnt = (const int*)(F.ctl + CW_CNT); int acc = 0;
        for (int e = 0; e < 32; ++e) { F.MISC[16 + e] = (unsigned)acc; acc += (__hip_atomic_load(cnt + 64 * e, __ATOMIC_RELAXED, __HIP_MEMORY_SCOPE_AGENT) + 255) >> 8; }
        F.MISC[16 + 32] = (unsigned)acc; }
    __syncthreads();
}
__device__ __forceinline__ void p5_expert_cvt(Frame& F) {
    LAS float* scr = (LAS float*)(F.lds + F.wave * CVT_SCR); const int gw = F.vcu * 8 + F.wave, NGW = F.G * 8; unsigned char* ws = F.ws;
    for (int it = gw; it < NE * 768; it += NGW) { const int e = it / 768, r = it % 768;
        if (r < 256) cvt_item<3>(F.in[I_WEG] + (size_t)e * DM * DE, DM, DE, F.in[I_GFFN], (bf16*)(ws + WS_WGU) + (size_t)e * 1024 * DM, DM, scr, r, F.lane);
        else if (r < 512) cvt_item<4>(F.in[I_WEU] + (size_t)e * DM * DE, DM, DE, F.in[I_GFFN], (bf16*)(ws + WS_WGU) + (size_t)e * 1024 * DM, DM, scr, r - 256, F.lane);
        else cvt_item<0>(F.in[I_WED] + (size_t)e * DE * DM, DE, DM, nullptr, (bf16*)(ws + WS_WD) + (size_t)e * DM * DE, DE, scr, r - 512, F.lane); }
}

struct Args { const float* in[41]; float* out; unsigned char* ws; int ph_lo, ph_hi; };
constexpr int NPHASE = 16;
__global__ void __launch_bounds__(512, 2) fwd_kernel(Args args) {
    extern __shared__ __attribute__((aligned(16))) unsigned char lds_raw[];
    Frame F;
    F.lds = (LAS unsigned char*)lds_raw; F.MISC = (volatile LAS unsigned*)(F.lds + MISC_OFF);
    F.tid = threadIdx.x; F.lane = F.tid & 63; F.wave = __builtin_amdgcn_readfirstlane(F.tid >> 6);
    F.G = gridDim.x; { const int bx = blockIdx.x; F.vcu = (F.G % 8 == 0) ? (bx % 8) * (F.G / 8) + bx / 8 : bx; }
    F.ws = args.ws; F.out = args.out; F.ctl = (unsigned*)(args.ws + WS_CTL);
#pragma unroll
    for (int i = 0; i < 41; ++i) F.in[i] = args.in[i];
    for (int u = F.tid; u < (LDS_BYTES - LDSCTL_OFF) / 4; u += 512) ((LAS unsigned*)(F.lds + LDSCTL_OFF))[u] = 0u;
    __syncthreads();
    XcdBarrier bar; bar.bar = F.ctl + CW_BAR; bar.x = 0; bar.st = nullptr;
    const int lo = args.ph_lo, hi = args.ph_hi;
    if (hi - lo > 1) bar = xcd_barrier_post(F.ctl + CW_BAR, F.MISC + 8);
#ifndef ATT_DQK_TEST
#define ATT_DQK_TEST QKD
#endif
#define PROBE_N (MT * 768)
#ifndef LSEL
#define LSEL 31
#endif
#ifndef PH_MASK
#define PH_MASK 0xFFFFu
#endif
#ifndef SCAN_MFMA
#define SCAN_MFMA 1
#endif
#ifndef SCAN_DUMMY
#define SCAN_DUMMY 0
#endif
#ifndef REPEAT_MASK
#define REPEAT_MASK 0x0u
#endif
#define REP(k) _Pragma("unroll") for (int _rep = 0; _rep <= (int)(((REPEAT_MASK) >> (k)) & 1u); ++_rep)
#define IN(k) ((((PH_MASK) >> (k)) & 1u) && lo <= (k) && (k) < hi)
#define SEAM(k) do { if (lo <= (k) && (k) + 1 < hi) xcd_barrier(bar); } while (0)
    unsigned char* ws = args.ws;

    bf16* const zmla = (bf16*)(ws + WS_ZMLA); bf16* const loraA = (bf16*)(ws + WS_LORAA);
    float* const rstd1 = (float*)(ws + WS_RSTD); float* const rstd_q = rstd1 + MT; float* const rstd_kv = rstd1 + 2 * MT;
    const int bid = (int)blockIdx.x;
    if (IN(0)) { REP(0) p0_prologue(F); }
    SEAM(0);
    if (IN(1)) {
        if (EN_RWKV || EN_MLA) REP(1) { pg8::StaticOrder S; S.init((const bf16*)(ws + WS_XB), DM, (const bf16*)(ws + WS_WIN), DM, MT, G1_N, F.G, bid);
          EpiG1 E{rstd1, zmla, (bf16*)(ws + WS_ZRKV), (bf16*)(ws + WS_ZLORA), (bf16*)(ws + WS_ZGATE)};
          pg8::gemm_phase(F.lds, DM, DM, DM, S, E); }
        else p_copy_x(F);
        if (EN_CROSS) { pg8::StaticOrder S; S.init((const bf16*)(ws + WS_MEMN), DM, (const bf16*)(ws + WS_WKVC), DM, NB * MEMLEN, 2 * CW, F.G, bid);
          EpiPlain E{(bf16*)(ws + WS_KVC), 2 * CW, nullptr, 1.f};
          pg8::gemm_phase(F.lds, DM, DM, DM, S, E); }
    }
    SEAM(1);
    if (IN(2)) { if (EN_RWKV || EN_MLA) REP(2) p2_rowpass(F); }
    SEAM(2);
    if (IN(3)) REP(3) {
        if (EN_MLA) {
            { pg8::StaticOrder S; S.init(zmla, ZM_LD, (const bf16*)(ws + WS_WUQ), QLORA, MT, MH * QKD, F.G, bid);
              EpiQ E{(bf16*)(ws + WS_Q), rstd_q, (const float*)(ws + WS_ROPE)};
              pg8::gemm_phase(F.lds, QLORA, ZM_LD, QLORA, S, E); }
            { pg8::StaticOrder S; S.init(zmla + QLORA, ZM_LD, (const bf16*)(ws + WS_WUKV), KVLORA, MT, MH * 256, F.G, bid);
              EpiKV E{(bf16*)(ws + WS_K), (bf16*)(ws + WS_V), rstd_kv};
              pg8::gemm_phase(F.lds, KVLORA, ZM_LD, KVLORA, S, E); }
        }
        if (EN_RWKV) {
            if (LSEL & 1) { pg8::StaticOrder S; S.init(loraA, LA_LD, (const bf16*)(ws + WS_W2F), 256, MT, RW, F.G, bid);
              EpiLora<0> E{(bf16*)(ws + WS_WLF), F.in[I_W0F]}; pg8::gemm_phase(F.lds, 256, LA_LD, 256, S, E); }
            if (LSEL & 2) { pg8::StaticOrder S; S.init(loraA, LA_LD, (const bf16*)(ws + WS_W2F + 1 * MiB), 256, MT, RW, F.G, bid);
              EpiLora<0> E{(bf16*)(ws + WS_WLB), F.in[I_W0B]}; pg8::gemm_phase(F.lds, 256, LA_LD, 256, S, E); }
            if (LSEL & 4) { pg8::StaticOrder S; S.init(loraA + 256, LA_LD, (const bf16*)(ws + WS_W2F + 2 * MiB), 256, MT, RW, F.G, bid);
              EpiLora<1> E{(bf16*)(ws + WS_ICF), F.in[I_A0F]}; pg8::gemm_phase(F.lds, 256, LA_LD, 256, S, E); }
            if (LSEL & 8) { pg8::StaticOrder S; S.init(loraA + 256, LA_LD, (const bf16*)(ws + WS_W2F + 3 * MiB), 256, MT, RW, F.G, bid);
              EpiLora<1> E{(bf16*)(ws + WS_ICB), F.in[I_A0B]}; pg8::gemm_phase(F.lds, 256, LA_LD, 256, S, E); }
            if (LSEL & 16) { pg8::StaticOrder S; S.init(loraA + 512, LA_LD, (const bf16*)(ws + WS_G2), GLORA, MT, RW, F.G, bid);
              EpiLora<2> E{(bf16*)(ws + WS_G), nullptr}; pg8::gemm_phase(F.lds, GLORA, LA_LD, GLORA, S, E); }
        }
    }
    SEAM(3);
    if (IN(4)) {
        constexpr int NSCAN = NB * RH * 2, NATT = NB * MH * (SEQ / 256);
        int s_begin = F.vcu, s_end = NSCAN, s_step = F.G, a_begin = F.vcu, a_step = F.G, a_cnt = (F.vcu < NATT) ? (NATT - 1 - F.vcu) / F.G + 1 : 0;
        if (EN_RWKV && EN_MLA && F.G == 256) { s_step = 1; a_step = 1;
            if (F.vcu < 128) { s_end = F.vcu + 1; a_begin = 384 + F.vcu; a_cnt = 1; } else { s_end = 0; a_begin = (F.vcu - 128) * 3; a_cnt = 3; } }
        if (EN_RWKV) for (int u = s_begin; u < s_end; u += s_step) { const int dir = u & 1, bh = u >> 1;
            if (dir) scan2::scan_unit<1>(F, bh >> 5, bh & 31); else scan2::scan_unit<0>(F, bh >> 5, bh & 31); }
        if (EN_MLA) for (int i = 0; i < a_cnt; ++i) { const int L = a_begin + i * a_step; const int qb = L & 15, bh = L >> 4, b = bh >> 4, h = bh & 15;
            att::attn_unit<ATT_DQK_TEST, MH * QKD, MH * QKD, MH * VDIM, DM>((const bf16*)(ws + WS_Q) + ((size_t)(b * SEQ + qb * 256) * (MH * QKD) + h * QKD),
                                (const bf16*)(ws + WS_K) + ((size_t)b * SEQ * (MH * QKD) + h * QKD),
                                (const bf16*)(ws + WS_V) + ((size_t)b * SEQ * (MH * VDIM) + h * VDIM),
                                (bf16*)(ws + WS_OMLA) + ((size_t)(b * SEQ + qb * 256) * DM + h * VDIM), SEQ, (LAS char*)F.lds); }
    }
    SEAM(4);
    if (IN(5)) { if (EN_RWKV) REP(5) p5_post(F); if (EN_MOE) REP(17) p5_expert_cvt(F); }
    SEAM(5);
    if (IN(6)) REP(6) {
        if (EN_MLA) { pg8::StaticOrder S; S.init((const bf16*)(ws + WS_OMLA), DM, (const bf16*)(ws + WS_WUPM), DM, MT, DM, F.G, bid);
            EpiUp<0> E{(bf16*)(ws + WS_MERGED), (const bf16*)(ws + WS_ZGATE), 0}; pg8::gemm_phase(F.lds, DM, DM, DM, S, E); }
        if (EN_RWKV) { pg8::StaticOrder S; S.init((const bf16*)(ws + WS_ORWKV), DM, (const bf16*)(ws + WS_WUPR), DM, MT, DM, F.G, bid);
            EpiUp<EN_MLA> E{(bf16*)(ws + WS_MERGED), (const bf16*)(ws + WS_ZGATE), DM}; pg8::gemm_phase(F.lds, DM, DM, DM, S, E); }
    }
    SEAM(6);
    if (IN(7)) REP(7) {
        if (EN_RWKV || EN_MLA) { pg8::StaticOrder S; S.init((const bf16*)(ws + WS_MERGED), DM, (const bf16*)(ws + WS_WOUT), DM, MT, DM, F.G, bid);
            EpiResid E{F.in[I_X], F.out}; pg8::gemm_phase(F.lds, DM, DM, DM, S, E); }
    }
    SEAM(7);
    if (IN(8)) { if (EN_CROSS || EN_MOE) p8_rowpass(F); }
    SEAM(8);
    if (IN(9)) REP(9) {
        if (EN_CROSS) { SplitKOrder S{(const char*)(ws + WS_H1B), (const char*)(ws + WS_WQC), F.G, F.vcu};
            EpiSlab E{(float*)(ws + WS_QSLAB)}; pg8::gemm_phase(F.lds, 512, DM, DM, S, E); }
    }
    SEAM(9);
    if (IN(10)) REP(10) {
        if (EN_CROSS) {
            for (int i = 0; ; ++i) { const int L = i * F.G + F.vcu; if (L >= NB * CH * (SEQ / 256)) break;
                const int qb = L & 15, bh = L >> 4, b = bh >> 2, h = bh & 3;
                att::attn_unit<CHD, CW, 2 * CW, 2 * CW, CW, true>((const bf16*)((const float*)(ws + WS_QSLAB) + ((size_t)(b * SEQ + qb * 256) * CW + h * CHD)),
                                    (const bf16*)(ws + WS_KVC) + ((size_t)b * MEMLEN * (2 * CW) + h * CHD),
                                    (const bf16*)(ws + WS_KVC) + ((size_t)b * MEMLEN * (2 * CW) + CW + h * CHD),
                                    (bf16*)(ws + WS_OC) + ((size_t)(b * SEQ + qb * 256) * CW + h * CHD), MEMLEN, (LAS char*)F.lds, rstd1 + 3 * MT + (b * SEQ + qb * 256), CSCALE); }
        }
    }
    SEAM(10);
    if (IN(11)) {
        if (EN_CROSS) { pg8::StaticOrder S; S.init((const bf16*)(ws + WS_OC), CW, (const bf16*)(ws + WS_WOC), CW, MT, DM, F.G, bid);
            EpiResid E{F.out, F.out}; pg8::gemm_phase(F.lds, CW, CW, CW, S, E); }
    }
    SEAM(11);
    if (IN(12)) { if (EN_MOE) p12_router(F); }
    SEAM(12);
    if (IN(13)) REP(13) {
        if (EN_MOE) { moe_table(F);
            MoeOrder S{(const volatile LAS int*)(F.MISC + 16), (const int*)(F.ctl + CW_CNT), (const int*)(ws + WS_LIST), (const char*)(ws + WS_N3), (const char*)(ws + WS_WGU), F.G, F.vcu, 2,
                       (size_t)1024 * DM * 2, (size_t)256 * DM * 2, true};
            EpiMoe1 E{(bf16*)(ws + WS_HID), (const int*)(F.ctl + CW_CNT), (const int*)(ws + WS_LIST), (const float*)(ws + WS_SLOTW), rstd1 + 4 * MT};
            pg8::gemm_phase(F.lds, DM, DM, DM, S, E); }
    }
    SEAM(13);
    if (IN(14)) REP(14) {
        if (EN_MOE) { moe_table(F);
            MoeOrder S{(const volatile LAS int*)(F.MISC + 16), (const int*)(F.ctl + CW_CNT), (const int*)(ws + WS_LIST), (const char*)(ws + WS_HID), (const char*)(ws + WS_WD), F.G, F.vcu, 3,
                       (size_t)DM * DE * 2, (size_t)256 * DE * 2, false};
            EpiMoe2 E{(bf16*)(ws + WS_YBUF)};
            pg8::gemm_phase(F.lds, DE, DE, DE, S, E); }
    }
    SEAM(14);
#ifdef PROBE_OFF
    if (IN(15)) { const int gt = F.vcu * 512 + F.tid, NGT = F.G * 512; const bf16* sb = (const bf16*)(ws + (size_t)PROBE_OFF * MiB);
        for (int i = gt; i < MT * DM; i += NGT) F.out[i] = (i < PROBE_N) ? bf2f(sb[i]) : 0.f; }
#else
    if (IN(15)) { p_final(F, EN_MOE != 0); }
#endif
#undef IN
#undef SEAM
}

extern "C" void kernel_launch(void* const* d_in, const int* in_sizes, int n_in, void* d_out, int out_size, void* d_ws, size_t ws_size, hipStream_t stream) {
    static int grid = 0;
    if (grid == 0) {
        if (n_in != 41 || out_size != MT * DM || ws_size < WS_END) { fprintf(stderr, "kernel_launch: unexpected shapes n_in %d out %d ws %zu (need %zu)\n", n_in, out_size, ws_size, (size_t)WS_END); grid = -1; return; }
        int dev = 0, cus = 0, per_cu = 0;
        if (hipGetDevice(&dev) != hipSuccess || hipDeviceGetAttribute(&cus, hipDeviceAttributeMultiprocessorCount, dev) != hipSuccess) { grid = -1; return; }
        if (hipFuncSetAttribute((const void*)fwd_kernel, hipFuncAttributeMaxDynamicSharedMemorySize, LDS_BYTES) != hipSuccess) { fprintf(stderr, "kernel_launch: hipFuncSetAttribute failed\n"); grid = -1; return; }
        if (hipOccupancyMaxActiveBlocksPerMultiprocessor(&per_cu, (const void*)fwd_kernel, 512, LDS_BYTES) != hipSuccess || per_cu < 1) { fprintf(stderr, "kernel_launch: occupancy query says %d\n", per_cu); }
        (void)hipGetLastError();
        grid = cus;
    }
    if (grid < 0) return;
    (void)hipMemsetAsync((char*)d_ws + WS_CTL, 0, CTL_BYTES, stream);
    Args a{};
    for (int i = 0; i < 41; ++i) a.in[i] = (const float*)d_in[i];
    a.out = (float*)d_out; a.ws = (unsigned char*)d_ws;
#if N_LAUNCH_SPLIT
    for (int p = 0; p < NPHASE; ++p) { a.ph_lo = p; a.ph_hi = p + 1; hipLaunchKernelGGL(fwd_kernel, dim3(grid), dim3(512), LDS_BYTES, stream, a); }
#else
    a.ph_lo = 0; a.ph_hi = NPHASE;
    hipLaunchKernelGGL(fwd_kernel, dim3(grid), dim3(512), LDS_BYTES, stream, a);
#endif
}
```

```cpp
#include <hip/hip_runtime.h>
#include <cstdio>
#include <cstdint>

#ifndef EN_RWKV
#define EN_RWKV 1
#endif
#ifndef EN_MLA
#define EN_MLA 1
#endif
#ifndef EN_CROSS
#define EN_CROSS 1
#endif
#ifndef EN_MOE
#define EN_MOE 1
#endif
#ifndef N_LAUNCH_SPLIT
#define N_LAUNCH_SPLIT 0
#endif

#define GAS __attribute__((address_space(1)))
#define LAS __attribute__((address_space(3)))
typedef unsigned short bf16;
typedef short bf16x8 __attribute__((ext_vector_type(8)));
typedef short s16x4 __attribute__((ext_vector_type(4)));
typedef float f32x4 __attribute__((ext_vector_type(4)));
typedef float f32x2 __attribute__((ext_vector_type(2)));
typedef float f32x16 __attribute__((ext_vector_type(16)));
typedef unsigned u32x4 __attribute__((ext_vector_type(4)));
typedef unsigned u32x2 __attribute__((ext_vector_type(2)));

constexpr int DM = 2048, NB = 2, SEQ = 4096, MT = NB * SEQ;
constexpr int MEMLEN = 256;
constexpr int QLORA = 512, KVLORA = 256, ROPE = 64, NOPE = 128, VDIM = 128, QKD = 192, MH = 16;
constexpr int RW = 2048, RH = 32, RHD = 64, DLORA = 96, GLORA = 256;
constexpr int MLA_IN = 832, RWKV_IN = 6784, GATE_IN = 4096, IN_W = MLA_IN + RWKV_IN + GATE_IN;
constexpr int CH = 4, CHD = 128, CW = 512;
constexpr int NG = 4, EPG = 8, NE = 32, DE = 512;
constexpr float RMS_EPS = 1e-6f, LNX_EPS = 64e-5f;
constexpr int G1_N = 12032;
constexpr int ZM_LD = 1024, ZR_LD = 6144, ZL_LD = 768, ZG_LD = 4096, LA_LD = 768;
constexpr int MOE_SLOTS = 2 * MT + NE * 256;

constexpr size_t MiB = 1u << 20;
constexpr size_t WS_CTL = 0, CTL_BYTES = 1 * MiB;
constexpr size_t WS_WUQ = 1 * MiB;
constexpr size_t WS_WUKV = 4 * MiB;
constexpr size_t WS_W2F = 6 * MiB;
constexpr size_t WS_G2 = 10 * MiB;
constexpr size_t WS_WUPM = 11 * MiB, WS_WUPR = 19 * MiB, WS_WOUT = 27 * MiB;
constexpr size_t WS_WQC = 35 * MiB;
constexpr size_t WS_WKVC = 37 * MiB;
constexpr size_t WS_WOC = 41 * MiB;
constexpr size_t WS_WIN = 43 * MiB;
constexpr size_t WS_MISC = 90 * MiB;
constexpr size_t WS_ROPE = WS_MISC;
constexpr size_t WS_MEMN = WS_MISC + 2 * MiB;
constexpr size_t WS_KVC = WS_MISC + 4 * MiB;
constexpr size_t WS_RSTD = WS_MISC + 5 * MiB;
constexpr size_t WS_WR = WS_RSTD + 256 * 1024;
constexpr size_t WS_LIST = WS_MISC + 6 * MiB;
constexpr size_t WS_ROUTE = WS_MISC + 7 * MiB;
constexpr size_t WS_SLOTW = WS_MISC + 8 * MiB;
constexpr size_t WS_XB = 100 * MiB;
constexpr size_t WS_ZMLA = 132 * MiB;
constexpr size_t WS_ZLORA = 148 * MiB;
constexpr size_t WS_LORAA = 160 * MiB;
constexpr size_t WS_ZRKV = 172 * MiB;
constexpr size_t WS_ZGATE = 268 * MiB;
constexpr size_t WS_Q = 332 * MiB;
constexpr size_t WS_K = 380 * MiB;
constexpr size_t WS_V = 428 * MiB;
constexpr size_t WS_WLF = 460 * MiB, WS_WLB = 492 * MiB, WS_ICF = 524 * MiB, WS_ICB = 556 * MiB;
constexpr size_t WS_G = 588 * MiB;
constexpr size_t WS_END = 620 * MiB;
constexpr size_t WS_YF = WS_WIN, WS_YB = WS_ZMLA, WS_ORWKV = WS_Q, WS_MERGED = WS_K, WS_QC = WS_V, WS_OC = WS_V + 8 * MiB;
constexpr size_t WS_WGU = WS_WLF, WS_WD = WS_ZRKV, WS_HID = WS_ZGATE, WS_YBUF = WS_Q;
constexpr size_t WS_OMLA = WS_XB, WS_H1B = WS_XB, WS_N3 = WS_XB;

constexpr int CW_BAR = 4096;
constexpr int CW_CNT = 16384;

constexpr int RING_BYTES = 155648;
constexpr int LDSCTL_OFF = RING_BYTES, MISC_OFF = LDSCTL_OFF + 320;
constexpr int LDS_BYTES = 157696;

#define LDS_WAIT() asm volatile("s_waitcnt lgkmcnt(0)" ::: "memory")
#define VM_WAIT() asm volatile("s_waitcnt vmcnt(0)" ::: "memory")
typedef __bf16 bf16x2_t __attribute__((ext_vector_type(2)));
__device__ __forceinline__ unsigned cvt_pk_bf16(float lo, float hi) { f32x2 v = {lo, hi}; bf16x2_t b = __builtin_convertvector(v, bf16x2_t); return __builtin_bit_cast(unsigned, b); }
__device__ __forceinline__ float bf2f(unsigned short b) { return __builtin_bit_cast(float, ((unsigned)b) << 16); }
__device__ __forceinline__ float bflo(unsigned w) { return __builtin_bit_cast(float, w << 16); }
__device__ __forceinline__ float bfhi(unsigned w) { return __builtin_bit_cast(float, w & 0xffff0000u); }
__device__ __forceinline__ unsigned short f2bf(float f) { return (unsigned short)(cvt_pk_bf16(f, 0.f) & 0xffffu); }
__device__ __forceinline__ float sigmoidf_(float x) { return __builtin_amdgcn_rcpf(1.0f + __builtin_amdgcn_exp2f(-1.4426950408889634f * x)); }
template <int CTRL> __device__ __forceinline__ float dpp_add_(float v) {
    return v + __builtin_bit_cast(float, __builtin_amdgcn_update_dpp(0, __builtin_bit_cast(int, v), CTRL, 0xF, 0xF, false));
}
__device__ __forceinline__ float wave_sum(float v) {
    v = dpp_add_<0xB1>(v); v = dpp_add_<0x4E>(v); v = dpp_add_<0x141>(v); v = dpp_add_<0x140>(v);
    const int iv = __builtin_bit_cast(int, v);
    const float s0 = __builtin_bit_cast(float, __builtin_amdgcn_readlane(iv, 0)), s1 = __builtin_bit_cast(float, __builtin_amdgcn_readlane(iv, 16));
    const float s2 = __builtin_bit_cast(float, __builtin_amdgcn_readlane(iv, 32)), s3 = __builtin_bit_cast(float, __builtin_amdgcn_readlane(iv, 48));
    return (s0 + s1) + (s2 + s3);
}

#define XB_TMO      128
#define XB_XCNT(j)  (256  + 64 * (j))
#define XB_XSUB(j)  (1280 + 64 * (j))
#define XB_XGEN(j)  (2304 + 64 * (j))
#define XB_TOP      3328
#define XB_TOPGEN   3392
#define XCD_BAR_WORDS 3456
#define XB_SPIN_CAP (1u << 18)
__device__ __forceinline__ unsigned xb_ld(unsigned* p)              { return __hip_atomic_load(p, __ATOMIC_RELAXED, __HIP_MEMORY_SCOPE_AGENT); }
__device__ __forceinline__ unsigned xb_add(unsigned* p, unsigned v) { return __hip_atomic_fetch_add(p, v, __ATOMIC_RELAXED, __HIP_MEMORY_SCOPE_AGENT); }
__device__ __forceinline__ unsigned xb_xcc_id() { return (unsigned)__builtin_amdgcn_s_getreg((3 << 11) | 20) & 0xFu; }
#define XB_SPIN(cond, bar) do { unsigned _sp = 0; while (cond) { __builtin_amdgcn_s_sleep(1); \
    if ((++_sp & 255u) == 0u) { if (xb_ld(&(bar)[XB_TMO])) break; if (_sp > XB_SPIN_CAP) { atomicAdd(&(bar)[XB_TMO], 1u); break; } } } } while (0)
struct XcdBarrier { unsigned* bar; unsigned x; volatile LAS unsigned* st; };
__device__ __forceinline__ XcdBarrier xcd_barrier_post(unsigned* bar, volatile LAS unsigned* st) {
    XcdBarrier b; b.bar = bar; b.x = xb_xcc_id(); b.st = st;
    if (threadIdx.x == 0) (void)xb_add(&bar[XB_XCNT(b.x)], 1u);
    return b;
}
__device__ __forceinline__ void xcd_barrier_complete(unsigned* bar, unsigned x, unsigned& nloc, unsigned& nx) {
    const unsigned G = gridDim.x * gridDim.y * gridDim.z;
    unsigned sum, cnt, mine, sp = 0u;
    for (;;) {
        sum = 0u; cnt = 0u; mine = 0u;
#pragma unroll
        for (unsigned j = 0; j < 16; ++j) { const unsigned c = xb_ld(&bar[XB_XCNT(j)]); sum += c; cnt += (c > 0u) ? 1u : 0u; mine = (j == x) ? c : mine; }
        if (sum == G) break;
        __builtin_amdgcn_s_sleep(1);
        if ((++sp & 255u) == 0u) { if (xb_ld(&bar[XB_TMO])) break; if (sp > XB_SPIN_CAP) { atomicAdd(&bar[XB_TMO], 1u); break; } }
    }
    nloc = mine > 0u ? mine : 1u; nx = cnt > 0u ? cnt : 1u;
}
__device__ __forceinline__ void xcd_barrier(const XcdBarrier& b) {
    asm volatile("s_waitcnt vmcnt(0)" ::: "memory");
    __syncthreads();
    if (threadIdx.x == 0) {
        unsigned* bar = b.bar;
        __builtin_amdgcn_s_waitcnt(0);
        unsigned nloc = b.st[0], nx = b.st[1];
        if (nloc == 0u) { xcd_barrier_complete(bar, b.x, nloc, nx); b.st[0] = nloc; b.st[1] = nx; }
        const unsigned old = xb_add(&bar[XB_XSUB(b.x)], 1u);
        const unsigned gen = old / nloc;
        if (old + 1u == (gen + 1u) * nloc) {
            __builtin_amdgcn_fence(__ATOMIC_RELEASE, "agent");
            asm volatile("s_waitcnt vmcnt(0)" ::: "memory");
            const unsigned og = xb_add(&bar[XB_TOP], 1u);
            const unsigned tg = og / nx;
            if (og + 1u == (tg + 1u) * nx) xb_add(&bar[XB_TOPGEN], 1u);
            else XB_SPIN(xb_ld(&bar[XB_TOPGEN]) == tg, bar);
            __builtin_amdgcn_fence(__ATOMIC_ACQUIRE, "agent");
            xb_add(&bar[XB_XGEN(b.x)], 1u);
            asm volatile("s_waitcnt vmcnt(0)" ::: "memory");
        } else {
            XB_SPIN(xb_ld(&bar[XB_XGEN(b.x)]) == gen, bar);
            __builtin_amdgcn_fence(__ATOMIC_ACQUIRE, "agent");
            asm volatile("s_waitcnt vmcnt(0)" ::: "memory");
        }
    }
    __syncthreads();
}

namespace pg8 {
constexpr int BM = 256, BK = 64, HALF = 128, HTB = HALF * BK * 2, STAGE_BYTES = 8 * HTB, NXCD = 8, WGM = 8;
__host__ __device__ __forceinline__ int lds_byte(int r, int c) { const int st = (r >> 4) * 2 + (c >> 5), rr = r & 15, cc = c & 31, ob = rr * 64 + cc * 2; return st * 1024 + (ob ^ (((ob >> 9) & 1) << 5)); }
__host__ __device__ __forceinline__ void stage_rc(int b, int& R, int& C) { const int st = b / 1024, sb = b % 1024, swz = sb ^ (((sb >> 9) & 1) << 5); R = (st >> 1) * 16 + swz / 64; C = (st & 1) * 32 + (swz % 64) / 2; }
__host__ __device__ __forceinline__ int perm32(int rho) { const int n = rho >> 4, i = rho & 15; return 8 * (i >> 2) + 4 * n + (i & 3); }

struct Unit { int pm, pn; const char* Ab; const char* Bb; int aux0, aux1; };

struct StaticOrder {
    static constexpr bool GATHER = false;
    int nM, nN, nwg, G, c; const char* A; const char* Bt; int lda, ldb;
    __device__ void init(const bf16* A_, int lda_, const bf16* Bt_, int ldb_, int M, int N, int G_, int c_) { A = (const char*)A_; Bt = (const char*)Bt_; lda = lda_; ldb = ldb_; nM = M / BM; nN = N / BM; nwg = nM * nN; G = G_; c = c_; }
    __device__ __forceinline__ bool next(int i, Unit& u) const {
        const long L = (long)i * G + c; if (L >= nwg) return false;
        int wgid = (int)L; { const int q = nwg / NXCD, r = nwg % NXCD, xcd = wgid % NXCD, off = wgid / NXCD; wgid = (xcd < r ? xcd * (q + 1) : r * (q + 1) + (xcd - r) * q) + off; }
        const int nig = WGM * nN, gid = wgid / nig, fm = gid * WGM, gsz = (nM - fm) < WGM ? (nM - fm) : WGM;
        u.pm = fm + ((wgid % nig) % gsz); u.pn = (wgid % nig) / gsz; u.Ab = A + (size_t)u.pm * BM * lda * 2; u.Bb = Bt + (size_t)u.pn * BM * ldb * 2; u.aux0 = 0; u.aux1 = 0; return true;
    }
    __device__ __forceinline__ unsigned arow(const Unit& u, int r) const { return (unsigned)r; }
};

#define PG8_ACC f32x4 (&acc)[2][2][4][2]
template <class Epi, class Sched>
__device__ __forceinline__ void gemm_phase(LAS unsigned char* lds, const int K, const int lda, const int ldb, const Sched& S, const Epi& E) {
    const int tid = threadIdx.x, wid = __builtin_amdgcn_readfirstlane(tid >> 6), lane = tid & 63, wr = wid >> 2, wc = wid & 3, fr = lane & 15, fq = lane >> 4;
    const int nt = K / BK;
    int sR[2], sC[2]; unsigned voffB[2];
#pragma unroll
    for (int i = 0; i < 2; ++i) { stage_rc(tid * 16 + i * 8192, sR[i], sC[i]); const int Rb = Epi::PERM ? ((sR[i] & ~31) + perm32(sR[i] & 31)) : sR[i];
        voffB[i] = (unsigned)(Rb * ldb + sC[i]) * 2u; }
    const size_t kstep = (size_t)(BK * 2);
    const size_t hstepB = (size_t)HALF * ldb * 2;
    const unsigned ldsw = (unsigned)wid * 1024u;
    const int aoff = lds_byte(wr * 64 + fr, fq * 8), boff = lds_byte(wc * 32 + fr, fq * 8);
#define PG8_SA(b, h) (((b) * 2 + (h)) * HTB)
#define PG8_SB(b, h) ((4 + (b) * 2 + (h)) * HTB)
#define PG8_STAGE(bufoff, gbase, voff) do { _Pragma("unroll") for (int _i = 0; _i < 2; ++_i) \
        __builtin_amdgcn_global_load_lds((const unsigned*)((const char*)(gbase) + (voff)[_i]), (LAS unsigned*)(lds + (bufoff) + ldsw + _i * 8192), 16, 0, 0); } while (0)
#define PG8_LDA(dst, b, h) do { _Pragma("unroll") for (int m = 0; m < 4; ++m) _Pragma("unroll") for (int k = 0; k < 2; ++k) dst[m][k] = *(const LAS bf16x8*)(lds + PG8_SA(b, h) + aoff + m * 2048 + k * 1024); } while (0)
#define PG8_LDB(dst, b, h) do { _Pragma("unroll") for (int n = 0; n < 2; ++n) _Pragma("unroll") for (int k = 0; k < 2; ++k) dst[n][k] = *(const LAS bf16x8*)(lds + PG8_SB(b, h) + boff + n * 2048 + k * 1024); } while (0)
#define PG8_MMA(ai, bj, At, Bt) do { __builtin_amdgcn_s_setprio(1); _Pragma("unroll") for (int m = 0; m < 4; ++m) _Pragma("unroll") for (int n = 0; n < 2; ++n) _Pragma("unroll") for (int k = 0; k < 2; ++k) \
        acc[ai][bj][m][n] = __builtin_amdgcn_mfma_f32_16x16x32_bf16(Bt[n][k], At[m][k], acc[ai][bj][m][n], 0, 0, 0); __builtin_amdgcn_s_setprio(0); } while (0)
#define PG8_WAIT_V(n) asm volatile("s_waitcnt vmcnt(" #n ")" ::: "memory")
#define PG8_WAIT_L(n) asm volatile("s_waitcnt lgkmcnt(" #n ")" ::: "memory")
#define PG8_BAR __builtin_amdgcn_s_barrier()
#define PG8_SCHED __builtin_amdgcn_sched_barrier(0)
#define PG8_SETVA(dst, u) do { _Pragma("unroll") for (int _h = 0; _h < 2; ++_h) _Pragma("unroll") for (int _i = 0; _i < 2; ++_i) \
        dst[_h][_i] = (S.arow(u, _h * HALF + sR[_i]) * (unsigned)lda + (unsigned)sC[_i]) * 2u; } while (0)
    Unit cur, nxt; int ui = 0;
    if (!S.next(0, cur)) return;
    f32x4 acc[2][2][4][2];
#pragma unroll
    for (int a = 0; a < 2; ++a)
#pragma unroll
        for (int b = 0; b < 2; ++b)
#pragma unroll
            for (int m = 0; m < 4; ++m)
#pragma unroll
                for (int n = 0; n < 2; ++n) acc[a][b][m][n] = (f32x4){0.f, 0.f, 0.f, 0.f};
    bf16x8 At[4][2], B0[2][2], B1[2][2];
    constexpr bool GA = Sched::GATHER;
    unsigned vA[2][2], nvA[2][2];
    PG8_SETVA(vA, cur);
    const char* cA = cur.Ab; const char* cB = cur.Bb;
    PG8_STAGE(PG8_SB(0, 0), cB, voffB); PG8_STAGE(PG8_SA(0, 0), cA, vA[0]); PG8_STAGE(PG8_SB(0, 1), cB + hstepB, voffB); PG8_STAGE(PG8_SA(0, 1), cA, vA[1]);
    if (wr == 1) PG8_BAR;
    PG8_WAIT_V(4); PG8_BAR;
    PG8_STAGE(PG8_SB(1, 0), cB + kstep, voffB); PG8_STAGE(PG8_SA(1, 0), cA + kstep, vA[0]); PG8_STAGE(PG8_SB(1, 1), cB + hstepB + kstep, voffB);
    PG8_WAIT_V(6); PG8_BAR;
    for (;;) {
        const bool has_next = S.next(ui + 1, nxt);
        const char* nA = cA; const char* nB = cB;
        if (has_next) { nA = nxt.Ab; nB = nxt.Bb; if (GA) PG8_SETVA(nvA, nxt); }
        else if (GA) {
#pragma unroll
            for (int h = 0; h < 2; ++h)
#pragma unroll
                for (int i = 0; i < 2; ++i) nvA[h][i] = vA[h][i]; }
#pragma unroll 1
        for (int t = 0; t < nt; t += 2) {
            const bool last = (t == nt - 2);
            const char* a1 = cA + (size_t)(t + 1) * kstep;
            const char* a2 = last ? nA : cA + (size_t)(t + 2) * kstep; const char* b2 = last ? nB : cB + (size_t)(t + 2) * kstep;
            const char* a3 = a2 + kstep; const char* b3 = b2 + kstep;
            unsigned s2[2][2];
#pragma unroll
            for (int h = 0; h < 2; ++h)
#pragma unroll
                for (int i = 0; i < 2; ++i) s2[h][i] = (GA && last) ? nvA[h][i] : vA[h][i];
            PG8_LDB(B0, 0, 0); PG8_SCHED; PG8_LDA(At, 0, 0); PG8_STAGE(PG8_SA(1, 1), a1, vA[1]);
            PG8_WAIT_L(8); PG8_BAR; PG8_WAIT_L(0); PG8_MMA(0, 0, At, B0); PG8_BAR; PG8_SCHED;
            PG8_LDB(B1, 0, 1); PG8_STAGE(PG8_SB(0, 0), b2, voffB);
            PG8_BAR; PG8_WAIT_L(0); PG8_MMA(0, 1, At, B1); PG8_BAR;
            PG8_LDA(At, 0, 1); PG8_STAGE(PG8_SA(0, 0), a2, s2[0]);
            PG8_BAR; PG8_WAIT_L(0); PG8_MMA(1, 0, At, B0); PG8_BAR; PG8_SCHED;
            PG8_STAGE(PG8_SB(0, 1), b2 + hstepB, voffB);
            PG8_WAIT_V(6); PG8_BAR; PG8_MMA(1, 1, At, B1); PG8_BAR;
            PG8_LDB(B0, 1, 0); PG8_SCHED; PG8_LDA(At, 1, 0); PG8_STAGE(PG8_SA(0, 1), a2, s2[1]);
            PG8_WAIT_L(8); PG8_BAR; PG8_WAIT_L(0); PG8_MMA(0, 0, At, B0); PG8_BAR; PG8_SCHED;
            PG8_LDB(B1, 1, 1); PG8_STAGE(PG8_SB(1, 0), b3, voffB);
            PG8_BAR; PG8_WAIT_L(0); PG8_MMA(0, 1, At, B1); PG8_BAR;
            PG8_LDA(At, 1, 1); PG8_STAGE(PG8_SA(1, 0), a3, s2[0]);
            PG8_BAR; PG8_WAIT_L(0); PG8_MMA(1, 0, At, B0); PG8_BAR; PG8_SCHED;
            PG8_STAGE(PG8_SB(1, 1), b3 + hstepB, voffB);
            PG8_WAIT_V(6); PG8_BAR; PG8_MMA(1, 1, At, B1); PG8_BAR;
        }
        { int fr_e = fr, fq_e = fq; asm volatile("" : "+v"(fr_e), "+v"(fq_e));
          E(acc, cur, wr, wc, fr_e, fq_e); }
        if (!has_next) break;
#pragma unroll
        for (int a = 0; a < 2; ++a)
#pragma unroll
            for (int b = 0; b < 2; ++b)
#pragma unroll
                for (int m = 0; m < 4; ++m)
#pragma unroll
                    for (int n = 0; n < 2; ++n) acc[a][b][m][n] = (f32x4){0.f, 0.f, 0.f, 0.f};
        cur = nxt; cA = nA; cB = nB; ++ui;
        if (GA) {
#pragma unroll
        for (int h = 0; h < 2; ++h)
#pragma unroll
            for (int i = 0; i < 2; ++i) vA[h][i] = nvA[h][i]; }
    }
    PG8_WAIT_V(0);
    if (wr == 0) PG8_BAR;
    PG8_BAR;
#undef PG8_SA
#undef PG8_SB
#undef PG8_STAGE
#undef PG8_LDA
#undef PG8_LDB
#undef PG8_MMA
#undef PG8_WAIT_V
#undef PG8_WAIT_L
#undef PG8_BAR
#undef PG8_SCHED
#undef PG8_SETVA
}
#define EPI_FOR(ai, m, bj) _Pragma("unroll") for (int ai = 0; ai < 2; ++ai) _Pragma("unroll") for (int m = 0; m < 4; ++m) _Pragma("unroll") for (int bj = 0; bj < 2; ++bj)
__device__ __forceinline__ u32x4 pack8(f32x4 v0, f32x4 v1) { u32x4 w; w.x = cvt_pk_bf16(v0[0], v0[1]); w.y = cvt_pk_bf16(v0[2], v0[3]); w.z = cvt_pk_bf16(v1[0], v1[1]); w.w = cvt_pk_bf16(v1[2], v1[3]); return w; }
}
using pg8::Unit;

struct EpiG1 {
    static constexpr bool PERM = true;
    const float* rstd; bf16 *zmla, *zrkv, *zlora, *zgate;
    __device__ __forceinline__ void operator()(const PG8_ACC, const Unit& u, int wr, int wc, int fr, int fq) const {
        bf16* base; int ld, c0;
        if (u.pn < 4) { base = zmla; ld = ZM_LD; c0 = u.pn * 256; } else if (u.pn < 28) { base = zrkv; ld = ZR_LD; c0 = (u.pn - 4) * 256; }
        else if (u.pn < 31) { base = zlora; ld = ZL_LD; c0 = (u.pn - 28) * 256; } else { base = zgate; ld = ZG_LD; c0 = (u.pn - 31) * 256; }
        const int col0 = c0 + wc * 32 + 8 * fq;
        EPI_FOR(ai, m, bj) { const int row = u.pm * 256 + ai * 128 + wr * 64 + m * 16 + fr; const float rs = rstd[row];
            *(u32x4*)(base + (size_t)row * ld + col0 + bj * 128) = pg8::pack8(acc[ai][bj][m][0] * rs, acc[ai][bj][m][1] * rs); }
    }
};
struct EpiPlain {
    static constexpr bool PERM = true;
    bf16* O; int ld; const float* rstd; float scale;
    __device__ __forceinline__ void operator()(const PG8_ACC, const Unit& u, int wr, int wc, int fr, int fq) const {
        const int col0 = u.pn * 256 + wc * 32 + 8 * fq;
        EPI_FOR(ai, m, bj) { const int row = u.pm * 256 + ai * 128 + wr * 64 + m * 16 + fr; const float rs = (rstd ? rstd[row] : 1.f) * scale;
            *(u32x4*)(O + (size_t)row * ld + col0 + bj * 128) = pg8::pack8(acc[ai][bj][m][0] * rs, acc[ai][bj][m][1] * rs); }
    }
};
constexpr float QSCALE = 0.07216878364870322f * 1.4426950408889634f;
constexpr float CSCALE = 0.08838834764831845f * 1.4426950408889634f;
struct EpiQ {
    static constexpr bool PERM = true;
    bf16* Q; const float* rstd; const float* cs;
    __device__ __forceinline__ void operator()(const PG8_ACC, const Unit& u, int wr, int wc, int fr, int fq) const {
        EPI_FOR(ai, m, bj) { const int row = u.pm * 256 + ai * 128 + wr * 64 + m * 16 + fr; const int col = u.pn * 256 + bj * 128 + wc * 32 + 8 * fq;
            const float rs = rstd[row] * QSCALE; f32x4 v0 = acc[ai][bj][m][0] * rs, v1 = acc[ai][bj][m][1] * rs;
            const int cih = col % QKD;
            if (cih >= NOPE) { const int i0 = (cih - NOPE) >> 1; const f32x4* t = (const f32x4*)(cs + ((size_t)row * 32 + i0) * 2);
                const f32x4 a = t[0], b = t[1];
                f32x4 r0, r1;
                r0[0] = v0[0] * a[0] - v0[1] * a[1]; r0[1] = v0[1] * a[0] + v0[0] * a[1]; r0[2] = v0[2] * a[2] - v0[3] * a[3]; r0[3] = v0[3] * a[2] + v0[2] * a[3];
                r1[0] = v1[0] * b[0] - v1[1] * b[1]; r1[1] = v1[1] * b[0] + v1[0] * b[1]; r1[2] = v1[2] * b[2] - v1[3] * b[3]; r1[3] = v1[3] * b[2] + v1[2] * b[3];
                v0 = r0; v1 = r1; }
            *(u32x4*)(Q + (size_t)row * (MH * QKD) + col) = pg8::pack8(v0, v1); }
    }
};
struct EpiKV {
    static constexpr bool PERM = true;
    bf16* Kb; bf16* Vb; const float* rstd;
    __device__ __forceinline__ void operator()(const PG8_ACC, const Unit& u, int wr, int wc, int fr, int fq) const {
        const int c = wc * 32 + 8 * fq;
        EPI_FOR(ai, m, bj) { const int row = u.pm * 256 + ai * 128 + wr * 64 + m * 16 + fr; const float rs = rstd[row];
            bf16* dst = bj == 0 ? Kb + (size_t)row * (MH * QKD) + u.pn * QKD + c : Vb + (size_t)row * (MH * VDIM) + u.pn * VDIM + c;
            *(u32x4*)dst = pg8::pack8(acc[ai][bj][m][0] * rs, acc[ai][bj][m][1] * rs); }
    }
};
template <int MODE> struct EpiLora {
    static constexpr bool PERM = true;
    bf16* O; const float* bias;
    __device__ __forceinline__ void operator()(const PG8_ACC, const Unit& u, int wr, int wc, int fr, int fq) const {
        EPI_FOR(ai, m, bj) { const int row = u.pm * 256 + ai * 128 + wr * 64 + m * 16 + fr; const int col = u.pn * 256 + bj * 128 + wc * 32 + 8 * fq;
            f32x4 v0 = acc[ai][bj][m][0], v1 = acc[ai][bj][m][1];
            if (MODE != 2) { const f32x4 b0 = *(const f32x4*)(bias + col), b1 = *(const f32x4*)(bias + col + 4);
#pragma unroll
                for (int j = 0; j < 4; ++j) { float s0 = sigmoidf_(v0[j] + b0[j]), s1 = sigmoidf_(v1[j] + b1[j]);
                    if (MODE == 0) { s0 *= -0.8750394f; s1 *= -0.8750394f; }
                    v0[j] = s0; v1[j] = s1; } }
            *(u32x4*)(O + (size_t)row * RW + col) = pg8::pack8(v0, v1); }
    }
};
template <int SECOND> struct EpiUp {
    static constexpr bool PERM = true;
    bf16* O; const bf16* zg; int goff;
    __device__ __forceinline__ void operator()(const PG8_ACC, const Unit& u, int wr, int wc, int fr, int fq) const {
        EPI_FOR(ai, m, bj) { const int row = u.pm * 256 + ai * 128 + wr * 64 + m * 16 + fr; const int col = u.pn * 256 + bj * 128 + wc * 32 + 8 * fq;
            const u32x4 g = *(const u32x4*)(zg + (size_t)row * ZG_LD + goff + col);
            f32x4 v0 = acc[ai][bj][m][0], v1 = acc[ai][bj][m][1];
            v0[0] *= sigmoidf_(bflo(g.x)); v0[1] *= sigmoidf_(bfhi(g.x)); v0[2] *= sigmoidf_(bflo(g.y)); v0[3] *= sigmoidf_(bfhi(g.y));
            v1[0] *= sigmoidf_(bflo(g.z)); v1[1] *= sigmoidf_(bfhi(g.z)); v1[2] *= sigmoidf_(bflo(g.w)); v1[3] *= sigmoidf_(bfhi(g.w));
            bf16* dst = O + (size_t)row * DM + col;
            if (SECOND) { const u32x4 p = *(const u32x4*)dst;
                v0[0] += bflo(p.x); v0[1] += bfhi(p.x); v0[2] += bflo(p.y); v0[3] += bfhi(p.y); v1[0] += bflo(p.z); v1[1] += bfhi(p.z); v1[2] += bflo(p.w); v1[3] += bfhi(p.w); }
            *(u32x4*)dst = pg8::pack8(v0, v1); }
    }
};
struct EpiResid {
    static constexpr bool PERM = true;
    const float* base; float* out;
    __device__ __forceinline__ void operator()(const PG8_ACC, const Unit& u, int wr, int wc, int fr, int fq) const {
        EPI_FOR(ai, m, bj) { const int row = u.pm * 256 + ai * 128 + wr * 64 + m * 16 + fr; const int col = u.pn * 256 + bj * 128 + wc * 32 + 8 * fq;
            const size_t o = (size_t)row * DM + col; const f32x4 b0 = *(const f32x4*)(base + o), b1 = *(const f32x4*)(base + o + 4);
            *(f32x4*)(out + o) = b0 + acc[ai][bj][m][0]; *(f32x4*)(out + o + 4) = b1 + acc[ai][bj][m][1]; }
    }
};

namespace att {
constexpr int NW = 8, QBLK = 32, KVBLK = 64;
constexpr float THRL = 11.5f;
#define SBAR() __builtin_amdgcn_sched_barrier(0)
__device__ __forceinline__ int crow(int r, int hi) { return (r & 3) + 8 * (r >> 2) + 4 * hi; }
__device__ __forceinline__ void partialSM(f32x16& p, float& m_reg, float& alpha) {
    float pmax = p[0];
#pragma unroll
    for (int r = 1; r < 16; ++r) pmax = fmaxf(pmax, p[r]);
    { auto rr = __builtin_amdgcn_permlane32_swap(__float_as_uint(pmax), __float_as_uint(pmax), false, false);
      pmax = fmaxf(__uint_as_float(rr[0]), __uint_as_float(rr[1])); }
    float mn;
    if (__builtin_expect(__all(pmax - m_reg <= THRL), 1)) { mn = m_reg; alpha = 1.f; }
    else { mn = fmaxf(m_reg, pmax); alpha = __builtin_amdgcn_exp2f(m_reg - mn); m_reg = mn; }
#pragma unroll
    for (int r = 0; r < 16; ++r) p[r] = p[r] - mn;
#pragma unroll
    for (int r = 0; r < 8; ++r) p[r] = __builtin_amdgcn_exp2f(p[r]);
}
__device__ __forceinline__ void finishSM(f32x16& p, float alpha, float& l_reg, bf16x8& pa0, bf16x8& pa1) {
#pragma unroll
    for (int r = 8; r < 16; ++r) p[r] = __builtin_amdgcn_exp2f(p[r]);
    float ps = 0;
#pragma unroll
    for (int r = 0; r < 16; ++r) ps += p[r];
    { auto rr = __builtin_amdgcn_permlane32_swap(__float_as_uint(ps), __float_as_uint(ps), false, false);
      ps = __uint_as_float(rr[0]) + __uint_as_float(rr[1]); }
    l_reg = l_reg * alpha + ps;
#define PK4(P, BASE, OUT) do { unsigned a0 = cvt_pk_bf16(P[BASE + 0], P[BASE + 1]), a1 = cvt_pk_bf16(P[BASE + 2], P[BASE + 3]);   \
    unsigned b0 = cvt_pk_bf16(P[BASE + 4], P[BASE + 5]), b1 = cvt_pk_bf16(P[BASE + 6], P[BASE + 7]);                              \
    auto r0 = __builtin_amdgcn_permlane32_swap(a0, b0, false, false); auto r1 = __builtin_amdgcn_permlane32_swap(a1, b1, false, false); \
    u32x4 w = {r0[0], r1[0], r0[1], r1[1]}; OUT = *reinterpret_cast<bf16x8*>(&w); } while (0)
    PK4(p, 0, pa0); PK4(p, 8, pa1);
#undef PK4
}
template <int DQK> __device__ __forceinline__ int kswz(int row, int colB) { return row * (DQK * 2 + 16) + colB; }
template <int DQK> __device__ __forceinline__ void qkt(f32x16& p, const LAS char* Ks, const bf16x8* qr, int krow, int hi) {
    p = f32x16{};
#pragma unroll
    for (int d0 = 0; d0 < DQK / 16; ++d0) { const int cb = (d0 * 16 + hi * 8) * 2;
        bf16x8 b0 = *reinterpret_cast<const LAS bf16x8*>(Ks + kswz<DQK>(krow, cb));
        p = __builtin_amdgcn_mfma_f32_32x32x16_bf16(b0, qr[d0], p, 0, 0, 0); }
}
__device__ __forceinline__ int v_st(int k, int c) { const int kk = (k & ~0xC) | ((k & 4) << 1) | ((k & 8) >> 1); return ((kk >> 3) * 4 + (c >> 5)) * 512 + ((kk & 7) * 32 + (c & 31)) * 2; }
__device__ __forceinline__ int v_rd_base(int lane) { return ((lane & 3) << 3) | (((lane >> 2) & 3) << 6) | (((lane >> 4) & 1) << 5) | (((lane >> 5) & 1) << 8); }
constexpr int v_rd_off(int d0, int ks, int half) { return d0 * 512 + ks * 4096 + half * 2048; }
template <int OFF> __device__ __forceinline__ s16x4 tr_read(int vb) {
    s16x4 r; asm volatile("ds_read_b64_tr_b16 %0, %1 offset:%2" : "=&v"(r) : "v"(vb), "i"(OFF) : "memory"); return r;
}
template <int D0, int KH> __device__ __forceinline__ void pv_one(f32x16& od, int vb, bf16x8 pa0, bf16x8 pa1) {
    const s16x4 l0 = tr_read<v_rd_off(D0, 2 * KH, 0)>(vb), h0 = tr_read<v_rd_off(D0, 2 * KH, 1)>(vb), l1 = tr_read<v_rd_off(D0, 2 * KH + 1, 0)>(vb), h1 = tr_read<v_rd_off(D0, 2 * KH + 1, 1)>(vb);
    asm volatile("s_waitcnt lgkmcnt(0)" ::: "memory"); SBAR();
#define PK(L, H) (bf16x8){L[0], L[1], L[2], L[3], H[0], H[1], H[2], H[3]}
    od = __builtin_amdgcn_mfma_f32_32x32x16_bf16(pa0, PK(l0, h0), od, 0, 0, 0);
    od = __builtin_amdgcn_mfma_f32_32x32x16_bf16(pa1, PK(l1, h1), od, 0, 0, 0);
#undef PK
}
template <int KH> __device__ __forceinline__ void pv_d0(f32x16* o, int vb, bf16x8 pa0, bf16x8 pa1) {
    pv_one<0, KH>(o[0], vb, pa0, pa1); pv_one<1, KH>(o[1], vb, pa0, pa1); pv_one<2, KH>(o[2], vb, pa0, pa1); pv_one<3, KH>(o[3], vb, pa0, pa1);
}
template <int DQK, int LDQ, int LDK, int LDV, int LDO>
__device__ __forceinline__ void attn_unit(const bf16* __restrict__ Qb, const bf16* __restrict__ Kh, const bf16* __restrict__ Vh, bf16* __restrict__ Ob, const int seq, LAS char* lds) {
    constexpr int SHM_V = KVBLK * 128 * 2, SHM_K = KVBLK * (DQK * 2 + 16), KCH = DQK / 64;
    const int tid = threadIdx.x, wid = tid >> 6, lane = tid & 63, r32 = lane & 31, hi = lane >> 5;
    LAS char* V_lds = lds; LAS char* K_lds = lds + 2 * SHM_V;
    LAS float* wsf = (LAS float*)(lds + 2 * SHM_V + 2 * SHM_K) + wid * 64; LAS float* li_l = wsf; LAS float* al_l = wsf + 32;
    float m_reg = -1e30f, l_reg = 0; f32x16 o[4] = {}; bf16x8 qr[DQK / 16];
    const bf16* Qw = Qb + (long)(wid * QBLK + r32) * LDQ + hi * 8;
#pragma unroll
    for (int d0 = 0; d0 < DQK / 16; ++d0) qr[d0] = *reinterpret_cast<const bf16x8*>(Qw + d0 * 16);
    const int sr = tid >> 4, sc = (tid & 15) * 8, vst0 = v_st(sr, sc), vst1 = v_st(32 + sr, sc);
    unsigned kgo[KCH]; int klo[KCH];
#pragma unroll
    for (int i = 0; i < KCH; ++i) { const int id = tid + 512 * i, row = id / (DQK / 8), c8 = id % (DQK / 8); kgo[i] = (unsigned)(row * LDK + c8 * 8) * 2u; klo[i] = kswz<DQK>(row, c8 * 16); }
    const unsigned vgo0 = (unsigned)(sr * LDV + sc) * 2u, vgo1 = (unsigned)((32 + sr) * LDV + sc) * 2u;
    const int vb0 = (int)(uintptr_t)V_lds + v_rd_base(lane);
    bf16x8 vs0, vs1, ks[KCH];
#define SLOAD(k0) do { const char* _vt = (const char*)(Vh + (size_t)(k0) * LDV); const char* _kt = (const char*)(Kh + (size_t)(k0) * LDK); \
    vs0 = *reinterpret_cast<const bf16x8*>(_vt + vgo0); vs1 = *reinterpret_cast<const bf16x8*>(_vt + vgo1); \
    _Pragma("unroll") for (int _i = 0; _i < KCH; ++_i) ks[_i] = *reinterpret_cast<const bf16x8*>(_kt + kgo[_i]); } while (0)
#define SWRITE(b) do { *(LAS bf16x8*)(V_lds + (b) * SHM_V + vst0) = vs0; *(LAS bf16x8*)(V_lds + (b) * SHM_V + vst1) = vs1; \
    _Pragma("unroll") for (int _i = 0; _i < KCH; ++_i) *(LAS bf16x8*)(K_lds + (b) * SHM_K + klo[_i]) = ks[_i]; } while (0)
#define SWAIT() asm volatile("s_waitcnt vmcnt(0)" ::: "memory")
#define RESC(a) do { if (__any((a) < 1.f)) { if (hi == 0) al_l[r32] = (a); asm volatile("s_waitcnt lgkmcnt(0)" ::: "memory"); \
    _Pragma("unroll") for (int d = 0; d < 4; ++d) _Pragma("unroll") for (int r = 0; r < 16; ++r) o[d][r] *= al_l[crow(r, hi)]; } } while (0)
    f32x16 pA, pB; float alA, alB; bf16x8 pa0, pa1; const int NT = seq / KVBLK;
    SLOAD(0); SWAIT(); SWRITE(0); __syncthreads();
    if (1 < NT) SLOAD(KVBLK);
    qkt<DQK>(pA, K_lds, qr, r32, hi); partialSM(pA, m_reg, alA);
    if (1 < NT) { SWAIT(); SWRITE(1); } __syncthreads();
    if (2 < NT) SLOAD(2 * KVBLK);
    SBAR(); qkt<DQK>(pB, K_lds, qr, 32 + r32, hi);
    finishSM(pA, alA, l_reg, pa0, pa1); SBAR();
    pv_d0<0>(o, vb0, pa0, pa1); partialSM(pB, m_reg, alB); RESC(alB);
    for (int j = 1; j < NT; ++j) {
        const int cb = j & 1, pb = cb ^ 1;
        SBAR(); qkt<DQK>(pA, K_lds + cb * SHM_K, qr, r32, hi);
        finishSM(pB, alB, l_reg, pa0, pa1); SBAR();
        pv_d0<1>(o, vb0 + pb * SHM_V, pa0, pa1); partialSM(pA, m_reg, alA);
        __syncthreads(); if (j + 1 < NT) { SWAIT(); SWRITE(pb); }
        RESC(alA); __syncthreads();
        if (j + 2 < NT) SLOAD((j + 2) * KVBLK);
        SBAR(); qkt<DQK>(pB, K_lds + cb * SHM_K, qr, 32 + r32, hi);
        finishSM(pA, alA, l_reg, pa0, pa1); SBAR();
        pv_d0<0>(o, vb0 + cb * SHM_V, pa0, pa1); partialSM(pB, m_reg, alB); RESC(alB);
    }
    finishSM(pB, alB, l_reg, pa0, pa1); SBAR();
    pv_d0<1>(o, vb0 + ((NT - 1) & 1) * SHM_V, pa0, pa1);
    if (hi == 0) li_l[r32] = l_reg; asm volatile("s_waitcnt lgkmcnt(0)" ::: "memory");
    float rli[16];
#pragma unroll
    for (int r = 0; r < 16; ++r) rli[r] = __builtin_amdgcn_rcpf(li_l[crow(r, hi)]);
    bf16* Ow = Ob + (size_t)(wid * QBLK) * LDO;
    int r32e = r32, hie = hi; asm volatile("" : "+v"(r32e), "+v"(hie));
    const unsigned ob = (unsigned)(4 * hie * LDO + r32e);
#pragma unroll
    for (int r = 0; r < 16; ++r) {
#pragma unroll
        for (int d0 = 0; d0 < 4; ++d0) Ow[ob + (unsigned)(((r & 3) + 8 * (r >> 2)) * LDO + d0 * 32)] = f2bf(o[d0][r] * rli[r]); }
    __syncthreads();
#undef SLOAD
#undef SWRITE
#undef SWAIT
#undef RESC
}
}

struct Frame {
    LAS unsigned char* lds; volatile LAS unsigned* MISC; unsigned* ctl;
    int tid, lane, wave, vcu, G;
    unsigned char* ws; float* out;
    const float* in[41];
};
enum { I_X = 0, I_MEM, I_POS, I_GMIX, I_WIN, I_GQ, I_WUQ, I_GKV, I_WUKV, I_SHIFT, I_W0F, I_W2F, I_W0B, I_W2B, I_A0F, I_A2F, I_A0B, I_A2B, I_G2, I_KK, I_KA, I_RK,
       I_LNXG, I_LNXB, I_WUPM, I_WUPR, I_WOUT, I_GCROSS, I_GMEM, I_WQC, I_WKVC, I_WOC, I_GFFN, I_WRG, I_BRG, I_WRE, I_BRE, I_WEG, I_WEU, I_WED, I_GFINAL };

template <int MODE> __device__ __forceinline__ int rowmap(int n) {
    if (MODE == 1) {
        if (n < 768) return n;
        if (n < 832) { const int p = n - 768; return 768 + (p < 32 ? 2 * p : 2 * (p - 32) + 1); }
        if (n < 6976) return 1024 + (n - 832);
        if (n < 7616) return 7168 + (n - 6976);
        return 7936 + (n - 7616);
    }
    if (MODE == 2) {
        const int h = n / QKD, d = n % QKD; if (d < NOPE) return n; const int p = d - NOPE; return h * QKD + NOPE + (p < 32 ? 2 * p : 2 * (p - 32) + 1);
    }
    if (MODE == 3) return (n >> 7) * 256 + (n & 127);
    if (MODE == 4) return (n >> 7) * 256 + 128 + (n & 127);
    return n;
}
constexpr int CVT_SCR = 16640;
template <int MODE> __device__ __forceinline__ void cvt_item(const float* W, int K, int N, const float* gain, bf16* WT, int ldt, LAS float* scr, int item, int lane, int kofs = 0) {
    const int nblk = N / 64, kb = item / nblk, nb = item % nblk, k0 = 64 * kb, n0 = 64 * nb;
    const int kq = lane >> 4, nc = (lane & 15) * 4;
    f32x4 v[16];
#pragma unroll
    for (int i = 0; i < 16; ++i) { const int k = k0 + 4 * i + kq - kofs; v[i] = (f32x4){0.f, 0.f, 0.f, 0.f};
        if (k >= 0 && k < K) { v[i] = *(const f32x4*)(W + (size_t)k * N + n0 + nc); if (gain) v[i] = v[i] * gain[k]; } }
#pragma unroll
    for (int i = 0; i < 16; ++i) { const int kk = 4 * i + kq;
#pragma unroll
        for (int c = 0; c < 4; ++c) scr[(nc + c) * 65 + kk] = v[i][c]; }
    LDS_WAIT(); asm volatile("" ::: "memory");
    const int kc = (lane & 7) * 8;
#pragma unroll
    for (int jj = 0; jj < 8; ++jj) { const int n = (lane >> 3) + 8 * jj; const LAS float* s = scr + n * 65 + kc;
        u32x4 o; o.x = cvt_pk_bf16(s[0], s[1]); o.y = cvt_pk_bf16(s[2], s[3]); o.z = cvt_pk_bf16(s[4], s[5]); o.w = cvt_pk_bf16(s[6], s[7]);
        *(u32x4*)(WT + (size_t)rowmap<MODE>(n0 + n) * ldt + k0 + kc) = o; }
    LDS_WAIT(); asm volatile("" ::: "memory");
}
#define CVT_JOB(MODE, src, K, N, gain, dst, ldt) { const int _n = (((K) + 63) / 64) * ((N) / 64); if (r < _n) { cvt_item<MODE>(src, K, N, gain, dst, ldt, scr, r, F.lane); continue; } r -= _n; }
#define CVT_JOB_PAD(src, K, N, dst, KPAD, KOFS) { const int _n = ((KPAD) / 64) * ((N) / 64); if (r < _n) { cvt_item<0>(src, K, N, nullptr, dst, KPAD, scr, r, F.lane, KOFS); continue; } r -= _n; }
struct CvtD { const float* W; const float* gain; bf16* WT; int K, N, ldt, mode, kofs, item; };
__device__ __forceinline__ int rowmap_rt(int mode, int n) { return mode == 1 ? rowmap<1>(n) : mode == 2 ? rowmap<2>(n) : mode == 3 ? rowmap<3>(n) : mode == 4 ? rowmap<4>(n) : n; }
__device__ __forceinline__ void cvt_load(const CvtD& d, int lane, f32x4 (&v)[16], float (&g)[16]) {
    const int nblk = d.N / 64, kb = d.item / nblk, nb = d.item % nblk, k0 = 64 * kb, n0 = 64 * nb; const int kq = lane >> 4, nc = (lane & 15) * 4;
#pragma unroll
    for (int i = 0; i < 16; ++i) { const int k = k0 + 4 * i + kq - d.kofs; v[i] = (f32x4){0.f, 0.f, 0.f, 0.f}; g[i] = 1.f;
        if (k >= 0 && k < d.K) { v[i] = *(const f32x4*)(d.W + (size_t)k * d.N + n0 + nc); if (d.gain) g[i] = d.gain[k]; } }
}
__device__ __forceinline__ void cvt_process(const CvtD& d, int lane, f32x4 (&v)[16], float (&g)[16], LAS float* scr) {
    const int nblk = d.N / 64, kb = d.item / nblk, nb = d.item % nblk, k0 = 64 * kb, n0 = 64 * nb; const int kq = lane >> 4, nc = (lane & 15) * 4;
#pragma unroll
    for (int i = 0; i < 16; ++i) { const int kk = 4 * i + kq;
#pragma unroll
        for (int c = 0; c < 4; ++c) scr[(nc + c) * 65 + kk] = v[i][c] * g[i]; }
    LDS_WAIT(); asm volatile("" ::: "memory");
    const int kc = (lane & 7) * 8;
#pragma unroll
    for (int jj = 0; jj < 8; ++jj) { const int n = (lane >> 3) + 8 * jj; const LAS float* s = scr + n * 65 + kc;
        u32x4 o; o.x = cvt_pk_bf16(s[0], s[1]); o.y = cvt_pk_bf16(s[2], s[3]); o.z = cvt_pk_bf16(s[4], s[5]); o.w = cvt_pk_bf16(s[6], s[7]);
        *(u32x4*)(d.WT + (size_t)rowmap_rt(d.mode, n0 + n) * d.ldt + k0 + kc) = o; }
    LDS_WAIT(); asm volatile("" ::: "memory");
}
#define CVT_PIPE(TOTAL_, DESC_) do { CvtD dA, dB; f32x4 vA[16], vB[16]; float gA[16], gB[16]; int it = gw; \
        if (it < (TOTAL_)) { DESC_(it, dA); cvt_load(dA, F.lane, vA, gA); } \
        for (; it < (TOTAL_); it += 2 * NGW) { const int itn = it + NGW, itn2 = it + 2 * NGW; \
            if (itn < (TOTAL_)) { DESC_(itn, dB); cvt_load(dB, F.lane, vB, gB); } \
            cvt_process(dA, F.lane, vA, gA, scr); \
            if (itn2 < (TOTAL_)) { DESC_(itn2, dA); cvt_load(dA, F.lane, vA, gA); } \
            if (itn < (TOTAL_)) cvt_process(dB, F.lane, vB, gB, scr); } } while (0)

__device__ __forceinline__ void p0_prologue(Frame& F) {
    LAS float* scr = (LAS float*)(F.lds + F.wave * CVT_SCR);
    const int gw = F.vcu * 8 + F.wave, NGW = F.G * 8;
    unsigned char* ws = F.ws;
    constexpr int TOTAL = 32 * (IN_W / 64) + 8 * 48 + 4 * 64 + 4 * (4 * 32) + 4 * 32 + 3 * (32 * 32) + 32 * 8 + 32 * 16 + 8 * 32;
#define P0_SETD(d, mode_, src_, K_, N_, gain_, dst_, ldt_, KPAD_, KOFS_) { const int _n = ((KPAD_) / 64) * ((N_) / 64); if (r < _n) { d.W = src_; d.gain = gain_; d.WT = dst_; d.K = K_; d.N = N_; d.ldt = ldt_; d.mode = mode_; d.kofs = KOFS_; d.item = r; break; } r -= _n; }
#define P0_DESC(it_, d) do { int r = (it_); \
        P0_SETD(d, 1, F.in[I_WIN], DM, IN_W, F.in[I_GMIX], (bf16*)(ws + WS_WIN), DM, DM, 0) \
        P0_SETD(d, 2, F.in[I_WUQ], QLORA, MH * QKD, F.in[I_GQ], (bf16*)(ws + WS_WUQ), QLORA, QLORA, 0) \
        P0_SETD(d, 0, F.in[I_WUKV], KVLORA, MH * 256, F.in[I_GKV], (bf16*)(ws + WS_WUKV), KVLORA, KVLORA, 0) \
        P0_SETD(d, 0, F.in[I_W2F], DLORA, RW, nullptr, (bf16*)(ws + WS_W2F), 256, 256, 0) \
        P0_SETD(d, 0, F.in[I_W2B], DLORA, RW, nullptr, (bf16*)(ws + WS_W2F + 1 * MiB), 256, 256, 128) \
        P0_SETD(d, 0, F.in[I_A2F], DLORA, RW, nullptr, (bf16*)(ws + WS_W2F + 2 * MiB), 256, 256, 0) \
        P0_SETD(d, 0, F.in[I_A2B], DLORA, RW, nullptr, (bf16*)(ws + WS_W2F + 3 * MiB), 256, 256, 128) \
        P0_SETD(d, 0, F.in[I_G2], GLORA, RW, nullptr, (bf16*)(ws + WS_G2), GLORA, GLORA, 0) \
        P0_SETD(d, 0, F.in[I_WUPM], DM, DM, nullptr, (bf16*)(ws + WS_WUPM), DM, DM, 0) \
        P0_SETD(d, 0, F.in[I_WUPR], DM, DM, nullptr, (bf16*)(ws + WS_WUPR), DM, DM, 0) \
        P0_SETD(d, 0, F.in[I_WOUT], DM, DM, nullptr, (bf16*)(ws + WS_WOUT), DM, DM, 0) \
        P0_SETD(d, 0, F.in[I_WQC], DM, CW, F.in[I_GCROSS], (bf16*)(ws + WS_WQC), DM, DM, 0) \
        P0_SETD(d, 0, F.in[I_WKVC], DM, 2 * CW, nullptr, (bf16*)(ws + WS_WKVC), DM, DM, 0) \
        P0_SETD(d, 0, F.in[I_WOC], CW, DM, nullptr, (bf16*)(ws + WS_WOC), CW, CW, 0) \
    } while (0)
    CVT_PIPE(TOTAL, P0_DESC);
#undef P0_SETD
#undef P0_DESC
    const float* x = F.in[I_X]; bf16* xb = (bf16*)(ws + WS_XB); float* rstd1 = (float*)(ws + WS_RSTD);
    for (int m = gw; m < MT + NB * MEMLEN; m += NGW) {
        const bool ismem = m >= MT; const int mm = ismem ? m - MT : m;
        const f32x4* xr = (const f32x4*)((ismem ? F.in[I_MEM] : x) + (size_t)mm * DM) + F.lane;
        f32x4 v[8]; float s = 0.f;
#pragma unroll
        for (int j = 0; j < 8; ++j) { v[j] = xr[64 * j]; s += (v[j].x * v[j].x + v[j].y * v[j].y) + (v[j].z * v[j].z + v[j].w * v[j].w); }
        const float rs = 1.0f / sqrtf(wave_sum(s) * (1.f / DM) + RMS_EPS);
        if (!ismem) { if (F.lane == 0) rstd1[mm] = rs;
            u32x2* o8 = (u32x2*)(xb + (size_t)mm * DM) + F.lane;
#pragma unroll
            for (int j = 0; j < 8; ++j) { u32x2 w; w.x = cvt_pk_bf16(v[j].x, v[j].y); w.y = cvt_pk_bf16(v[j].z, v[j].w); o8[64 * j] = w; }
        } else { const f32x4* gr = (const f32x4*)F.in[I_GMEM] + F.lane;
            u32x2* o8 = (u32x2*)((bf16*)(ws + WS_MEMN) + (size_t)mm * DM) + F.lane;
#pragma unroll
            for (int j = 0; j < 8; ++j) { const f32x4 g = gr[64 * j]; u32x2 w; w.x = cvt_pk_bf16(v[j].x * rs * g.x, v[j].y * rs * g.y); w.y = cvt_pk_bf16(v[j].z * rs * g.z, v[j].w * rs * g.w); o8[64 * j] = w; }
        }
    }
    const int gt = F.vcu * 512 + F.tid, NGT = F.G * 512;
    { const int* pos = (const int*)F.in[I_POS]; f32x2* cs = (f32x2*)(ws + WS_ROPE);
      for (int i = gt; i < MT * 32; i += NGT) { const int t = i >> 5, f = i & 31;
          const float inv = exp2f(-(float)f * (13.287712379549449f / 32.0f));
          const float ang = (float)pos[t] * inv;
          const double a = (double)ang; const double k = rint(a * 0.15915494309189535); const float red = (float)(a - k * 6.283185307179586);
          cs[i] = (f32x2){cosf(red), sinf(red)}; } }
    { float* WR = (float*)(ws + WS_WR); const float* gf = F.in[I_GFFN];
      for (int i = gt; i < DM * 36; i += NGT) { const int k = i / 36, c = i % 36; float w;
          if (c < 4) w = F.in[I_WRG][k * 4 + c]; else { const int gi = (c - 4) >> 3, e = (c - 4) & 7; w = F.in[I_WRE][((size_t)gi * DM + k) * 8 + e]; }
          WR[i] = w * gf[k]; } }
}

__device__ __forceinline__ void p_final(Frame& F, bool with_moe) {
    const int gw = F.vcu * 8 + F.wave, NGW = F.G * 8;
    const f32x4* gr = (const f32x4*)F.in[I_GFINAL] + F.lane;
    const int* route = (const int*)(F.ws + WS_ROUTE); const bf16* ybuf = (const bf16*)(F.ws + WS_YBUF);
    const int* cnts = (const int*)(F.ctl + CW_CNT);
    for (int m = gw; m < MT; m += NGW) {
        f32x4* xr = (f32x4*)(F.out + (size_t)m * DM) + F.lane;
        f32x4 v[8];
#pragma unroll
        for (int j = 0; j < 8; ++j) v[j] = xr[64 * j];
        if (with_moe) {
#pragma unroll
            for (int kx = 0; kx < 2; ++kx) { const int e = route[m * 8 + 2 * kx], pos = route[m * 8 + 2 * kx + 1];
                int base = 0; for (int q = 0; q < e; ++q) base += (cnts[64 * q] + 255) & ~255;
                const u32x2* yr = (const u32x2*)(ybuf + (size_t)(base + pos) * DM) + F.lane;
#pragma unroll
                for (int j = 0; j < 8; ++j) { const u32x2 w = yr[64 * j]; v[j].x += bflo(w.x); v[j].y += bfhi(w.x); v[j].z += bflo(w.y); v[j].w += bfhi(w.y); } }
        }
        float s = 0.f;
#pragma unroll
        for (int j = 0; j < 8; ++j) s += (v[j].x * v[j].x + v[j].y * v[j].y) + (v[j].z * v[j].z + v[j].w * v[j].w);
        const float rs = 1.0f / sqrtf(wave_sum(s) * (1.f / DM) + RMS_EPS);
#pragma unroll
        for (int j = 0; j < 8; ++j) { const f32x4 g = gr[64 * j]; xr[64 * j] = (f32x4){v[j].x * rs * g.x, v[j].y * rs * g.y, v[j].z * rs * g.z, v[j].w * rs * g.w}; }
    }
}
__device__ __forceinline__ void p_copy_x(Frame& F) {
    const int gt = F.vcu * 512 + F.tid, NGT = F.G * 512; const f32x4* s = (const f32x4*)F.in[I_X]; f32x4* d = (f32x4*)F.out;
    for (int i = gt; i < MT * DM / 4; i += NGT) d[i] = s[i];
}

__device__ __forceinline__ void p2_rowpass(Frame& F) {
    const int gw = F.vcu * 8 + F.wave, NGW = F.G * 8, l = F.lane;
    unsigned char* ws = F.ws;
    const bf16* zm = (const bf16*)(ws + WS_ZMLA); const bf16* zl = (const bf16*)(ws + WS_ZLORA); bf16* la = (bf16*)(ws + WS_LORAA);
    float* rstd_q = (float*)(ws + WS_RSTD) + MT; float* rstd_kv = (float*)(ws + WS_RSTD) + 2 * MT;
    const f32x2* cs = (const f32x2*)(ws + WS_ROPE); bf16* Kb = (bf16*)(ws + WS_K);
    const float* sh = F.in[I_SHIFT] + 6144;
    f32x2 s0[5], s1[5], s2[5];
#pragma unroll
    for (int i = 0; i < 5; ++i) { const int j = 2 * l + 128 * i; s0[i] = *(const f32x2*)(sh + j); s1[i] = *(const f32x2*)(sh + RWKV_IN + j); s2[i] = *(const f32x2*)(sh + 2 * RWKV_IN + j); }
    for (int t = gw; t < MT; t += NGW) {
        const bf16* zr = zm + (size_t)t * ZM_LD;
        { const u32x4 w = *((const u32x4*)zr + l); float s = 0.f;
          s += bflo(w.x) * bflo(w.x) + bfhi(w.x) * bfhi(w.x) + bflo(w.y) * bflo(w.y) + bfhi(w.y) * bfhi(w.y) + bflo(w.z) * bflo(w.z) + bfhi(w.z) * bfhi(w.z) + bflo(w.w) * bflo(w.w) + bfhi(w.w) * bfhi(w.w);
          s = wave_sum(s); if (l == 0) rstd_q[t] = 1.0f / sqrtf(s * (1.f / QLORA) + RMS_EPS); }
        { const u32x2 w = *((const u32x2*)(zr + QLORA) + l); float s = bflo(w.x) * bflo(w.x) + bfhi(w.x) * bfhi(w.x) + bflo(w.y) * bflo(w.y) + bfhi(w.y) * bfhi(w.y);
          s = wave_sum(s); if (l == 0) rstd_kv[t] = 1.0f / sqrtf(s * (1.f / KVLORA) + RMS_EPS); }
        { const int i = l & 31, hs = l >> 5; const unsigned w = *((const unsigned*)(zr + 768) + i); const float x1 = bflo(w), x2 = bfhi(w); const f32x2 c = cs[(size_t)t * 32 + i];
          const unsigned o = cvt_pk_bf16(x1 * c.x - x2 * c.y, x2 * c.x + x1 * c.y);
#pragma unroll
          for (int hh = 0; hh < 8; ++hh) *((unsigned*)(Kb + (size_t)t * (MH * QKD) + (hs * 8 + hh) * QKD + NOPE) + i) = o; }
        const int s = t % SEQ; const float fp = s > 0 ? 1.f : 0.f, fn = s < SEQ - 1 ? 1.f : 0.f;
        const bf16* z0 = zl + (size_t)t * ZL_LD; const bf16* zp = s > 0 ? z0 - ZL_LD : z0; const bf16* zn = s < SEQ - 1 ? z0 + ZL_LD : z0;
        bf16* lr = la + (size_t)t * LA_LD;
#pragma unroll
        for (int i = 0; i < 5; ++i) { const int j = 2 * l + 128 * i;
            const unsigned wp = *(const unsigned*)(zp + j), w0 = *(const unsigned*)(z0 + j), wn = *(const unsigned*)(zn + j);
            float va = s0[i].x * fp * bflo(wp) + s1[i].x * bflo(w0) + s2[i].x * fn * bflo(wn);
            float vb = s0[i].y * fp * bfhi(wp) + s1[i].y * bfhi(w0) + s2[i].y * fn * bfhi(wn);
            int dst;
            if (j < 192) { va = tanhf(va); vb = tanhf(vb); dst = (j / 96) * 128 + (j % 96); } else if (j < 384) { dst = (j / 96) * 128 + (j % 96); } else { va = sigmoidf_(va); vb = sigmoidf_(vb); dst = 512 + (j - 384); }
            *(unsigned*)(lr + dst) = cvt_pk_bf16(va, vb); }
        { const int p = 2 * l; *(unsigned*)(lr + (p >> 5) * 128 + 96 + (p & 31)) = 0u; }
    }
}

namespace scan {
constexpr int TC = 16, DATA_B = TC * 6 * 64 * 4, BUF_B = DATA_B + 64 + TC * 32 * 4;
template <int CTRL> __device__ __forceinline__ float dpp_add(float v) {
    return v + __builtin_bit_cast(float, __builtin_amdgcn_update_dpp(0, __builtin_bit_cast(int, v), CTRL, 0xF, 0xF, false));
}
__device__ __forceinline__ float red16(float v) { v = dpp_add<0xB1>(v); v = dpp_add<0x4E>(v); v = dpp_add<0x141>(v); v = dpp_add<0x140>(v); return v; }
struct Raw { unsigned short r[3], k[3], v[3], wl, ic; };
template <int VAR> __device__ __forceinline__ void scan_unit(Frame& F, const int b, const int h, const int dir, const int half) {
    unsigned char* ws = F.ws; const int l = F.lane, w = F.wave, tid = F.tid;
    const bf16* zr = (const bf16*)(ws + WS_ZRKV) + (size_t)b * SEQ * ZR_LD + h * 64 + l;
    const bf16* wlp = (const bf16*)(ws + (dir ? WS_WLB : WS_WLF)) + (size_t)b * SEQ * RW + h * 64 + l;
    const bf16* icp = (const bf16*)(ws + (dir ? WS_ICB : WS_ICF)) + (size_t)b * SEQ * RW + h * 64 + l;
    bf16* yout = (bf16*)(ws + (dir ? WS_YB : WS_YF)) + (size_t)b * SEQ * RW + h * 64 + half * 32;
    const int ch = h * 64 + l; const float* sh = F.in[I_SHIFT];
    const float sr0 = sh[ch], sr1 = sh[RWKV_IN + ch], sr2 = sh[2 * RWKV_IN + ch];
    const float sk0 = sh[2048 + ch], sk1 = sh[RWKV_IN + 2048 + ch], sk2 = sh[2 * RWKV_IN + 2048 + ch];
    const float sv0 = sh[4096 + ch], sv1 = sh[RWKV_IN + 4096 + ch], sv2 = sh[2 * RWKV_IN + 4096 + ch];
    const float kk_c = F.in[I_KK][ch], ka_c = F.in[I_KA][ch], rk_c = F.in[I_RK][ch];
    LAS unsigned char* L = F.lds;
    Raw raw[2];
#define SC_TOK(ci, i) (dir ? (SEQ - 1 - ((ci) * TC + (i))) : ((ci) * TC + (i)))
#define SC_LOAD(ci) do { _Pragma("unroll") for (int q = 0; q < 2; ++q) { const int s = SC_TOK(ci, 2 * w + q); const int sp = s > 0 ? s - 1 : s, sn = s < SEQ - 1 ? s + 1 : s; \
        const bf16* z0 = zr + (size_t)s * ZR_LD; const bf16* zp = zr + (size_t)sp * ZR_LD; const bf16* zn = zr + (size_t)sn * ZR_LD; \
        raw[q].r[0] = zp[0]; raw[q].r[1] = z0[0]; raw[q].r[2] = zn[0]; raw[q].k[0] = zp[2048]; raw[q].k[1] = z0[2048]; raw[q].k[2] = zn[2048]; \
        raw[q].v[0] = zp[4096]; raw[q].v[1] = z0[4096]; raw[q].v[2] = zn[4096]; raw[q].wl = wlp[(size_t)s * RW]; raw[q].ic = icp[(size_t)s * RW]; } } while (0)
#define SC_PREP(ci, bufi) do { _Pragma("unroll") for (int q = 0; q < 2; ++q) { const int i = 2 * w + q; const int s = SC_TOK(ci, i); const float fp = s > 0 ? 1.f : 0.f, fn = s < SEQ - 1 ? 1.f : 0.f; \
        const float r_s = sr0 * fp * bf2f(raw[q].r[0]) + sr1 * bf2f(raw[q].r[1]) + sr2 * fn * bf2f(raw[q].r[2]); \
        const float k_s = sk0 * fp * bf2f(raw[q].k[0]) + sk1 * bf2f(raw[q].k[1]) + sk2 * fn * bf2f(raw[q].k[2]); \
        const float v_s = sv0 * fp * bf2f(raw[q].v[0]) + sv1 * bf2f(raw[q].v[1]) + sv2 * fn * bf2f(raw[q].v[2]); \
        const float kkr = k_s * kk_c; const float ss = wave_sum(kkr * kkr); const float kk = kkr * (1.0f / sqrtf(ss + 1e-12f)); \
        const float icv = bf2f(raw[q].ic); const float kd = k_s * (1.0f + (icv - 1.0f) * ka_c); const float bb = kk * icv; const float wd = __builtin_amdgcn_exp2f(bf2f(raw[q].wl)); \
        const float bon = wave_sum(r_s * kd * rk_c); \
        LAS float* d = (LAS float*)(L + (bufi) * BUF_B) + i * 384 + l; d[0] = wd; d[64] = kk; d[128] = bb; d[192] = kd; d[256] = r_s; d[320] = v_s; \
        if (l == 0) ((LAS float*)(L + (bufi) * BUF_B + DATA_B))[i] = bon; } } while (0)
    const int g = l >> 4, j = l & 15, row = half * 32 + w * 4 + g;
    f32x2 Sa = {0.f, 0.f}, Sb = {0.f, 0.f};
    struct Ops { f32x4 w, a, b, k, r; float v, bon; };
#define SC_LD(O, i) do { O.w = p4[(i) * 96 + j]; O.a = p4[(i) * 96 + 16 + j]; O.b = p4[(i) * 96 + 32 + j]; O.k = p4[(i) * 96 + 48 + j]; O.r = p4[(i) * 96 + 64 + j]; \
        O.v = pf[(i) * 384 + 320 + row]; O.bon = pb[i]; } while (0)
#define SC_STEP(O, YP) do { f32x2 t = Sa * O.a.xy; t = Sb * O.a.zw + t; float sa = red16(t.x + t.y); \
        const f32x2 nsa = {-sa, -sa}; const f32x2 vv2 = {O.v, O.v}; \
        const f32x2 u0 = nsa * O.b.xy + vv2 * O.k.xy, u1 = nsa * O.b.zw + vv2 * O.k.zw; \
        Sa = Sa * O.w.xy + u0; Sb = Sb * O.w.zw + u1; \
        f32x2 ty = Sa * O.r.xy; ty = Sb * O.r.zw + ty; YP = ty.x + ty.y; } while (0)
    SC_LOAD(0); SC_PREP(0, 0); __syncthreads();
    constexpr int NCH = SEQ / TC;
    for (int ci = 0; ci < NCH; ++ci) {
        const int bi = ci & 1;
        if (VAR != 2 && ci + 1 < NCH) SC_LOAD(ci + 1);
        const LAS f32x4* p4 = (const LAS f32x4*)(L + bi * BUF_B); const LAS float* pf = (const LAS float*)(L + bi * BUF_B);
        const LAS float* pb = (const LAS float*)(L + bi * BUF_B + DATA_B);
        float ykeep = 0.f;
        Ops oA, oB; SC_LD(oA, 0);
        if (VAR != 1) {
#pragma unroll
        for (int i = 0; i < TC; i += 4) {
            float y0, y1, y2, y3; float v0, v1, v2, v3, b0, b1, b2, b3;
            SC_LD(oB, i + 1); v0 = oA.v; b0 = oA.bon; SC_STEP(oA, y0);
            SC_LD(oA, i + 2); v1 = oB.v; b1 = oB.bon; SC_STEP(oB, y1);
            SC_LD(oB, i + 3); v2 = oA.v; b2 = oA.bon; SC_STEP(oA, y2);
            if (i + 4 < TC) SC_LD(oA, i + 4);
            v3 = oB.v; b3 = oB.bon; SC_STEP(oB, y3);
            y0 = red16(y0); y1 = red16(y1); y2 = red16(y2); y3 = red16(y3);
            y0 += b0 * v0; y1 += b1 * v1; y2 += b2 * v2; y3 += b3 * v3;
            ykeep = (j == i) ? y0 : ykeep; ykeep = (j == i + 1) ? y1 : ykeep; ykeep = (j == i + 2) ? y2 : ykeep; ykeep = (j == i + 3) ? y3 : ykeep;
        }
        }
        ((LAS float*)(L + bi * BUF_B + DATA_B + 64))[j * 32 + w * 4 + g] = ykeep;
        if (VAR != 2 && ci + 1 < NCH) SC_PREP(ci + 1, bi ^ 1);
        __syncthreads();
        { const int st = tid >> 5, rw_ = tid & 31; const int s = SC_TOK(ci, st);
          const unsigned short yv = f2bf(((const LAS float*)(L + bi * BUF_B + DATA_B + 64))[st * 32 + rw_]);
          if (VAR == 0) yout[(size_t)s * RW + rw_] = yv; else asm volatile("" :: "v"(yv)); }
    }
    __syncthreads();
#undef SC_TOK
#undef SC_LOAD
#undef SC_PREP
#undef SC_LD
#undef SC_STEP
}
}

namespace scan2 {
constexpr int TC = 16, NS = 5, NPREP = 6, NREC = 2;
constexpr int ROWB = 144;
constexpr int P_ACAT = 0, P_BHAT = 4608, P_KHAT = 6656, P_VT = 8704, P_NCAT = 10752, P_MRF = 11776, P_PC = 12800, P_GINIT = 13056, PKG_B = 17152;
constexpr int S_L1 = 0, S_L2 = 4608, S_MF = 9216, S_NF = 10240, SCR_B = 11264;
constexpr int OFF_PKG = 0, OFF_SCR = NS * PKG_B, OFF_FLAG = OFF_SCR + NPREP * SCR_B, TOTAL_B = OFF_FLAG + 64;
static_assert(TOTAL_B <= 152 * 1024, "scan2 LDS");
__device__ __forceinline__ int crow(int r, int hi) { return (r & 3) + 8 * (r >> 2) + 4 * hi; }
__device__ __forceinline__ void lds_st16(LAS unsigned char* p, float v) { *(LAS unsigned short*)p = f2bf(v); }
__device__ __forceinline__ bf16x8 pack_acc8(const f32x16& x, int base) {
    u32x4 w = {cvt_pk_bf16(x[base + 0], x[base + 1]), cvt_pk_bf16(x[base + 2], x[base + 3]), cvt_pk_bf16(x[base + 4], x[base + 5]), cvt_pk_bf16(x[base + 6], x[base + 7])};
    return *reinterpret_cast<bf16x8*>(&w);
}
__device__ __forceinline__ float wave_sum_b(float v) {
    v = scan::red16(v);
    v += __builtin_bit_cast(float, __builtin_amdgcn_update_dpp(0, __builtin_bit_cast(int, v), 0x142, 0xA, 0xF, false));
    v += __builtin_bit_cast(float, __builtin_amdgcn_update_dpp(0, __builtin_bit_cast(int, v), 0x143, 0xC, 0xF, false));
    return __builtin_bit_cast(float, __builtin_amdgcn_readlane(__builtin_bit_cast(int, v), 63));
}
__device__ __forceinline__ void spin_ge(volatile LAS int* p, int want) { while (*p < want) __builtin_amdgcn_s_sleep(1); }

template <int dir> __device__ __forceinline__ void scan_unit(Frame& F, const int b, const int h) {
    unsigned char* ws = F.ws; const int l = F.lane, w = F.wave;
    LAS unsigned char* L = F.lds;
    volatile LAS int* ready = (volatile LAS int*)(L + OFF_FLAG);
    volatile LAS int* consumed = ready + NS;
    if (F.tid < 16) ready[F.tid] = 0;
    __syncthreads();
    constexpr int NCH = SEQ / TC;
    if (w < NREC) {
        const int half = w; const int v = l & 31, hi = l >> 5, vg = 32 * half + v;
        f32x16 X0 = {}, X1 = {};
        bf16* yout = (bf16*)(ws + (dir ? WS_YB : WS_YF)) + (size_t)b * SEQ * RW + h * 64 + half * 32 + v;
        for (int ci = 0; ci < NCH; ++ci) {
            const int slot = ci % NS; const LAS unsigned char* P = L + OFF_PKG + slot * PKG_B;
            spin_ge(ready + slot, ci + 1);
            const bf16x8 a00 = *(const LAS bf16x8*)(P + P_ACAT + v * ROWB + (0 + hi) * 16), a01 = *(const LAS bf16x8*)(P + P_ACAT + v * ROWB + (2 + hi) * 16);
            const bf16x8 a10 = *(const LAS bf16x8*)(P + P_ACAT + v * ROWB + (4 + hi) * 16), a11 = *(const LAS bf16x8*)(P + P_ACAT + v * ROWB + (6 + hi) * 16);
            const bf16x8 ncat = *(const LAS bf16x8*)(P + P_NCAT + v * 32 + hi * 16), vt = *(const LAS bf16x8*)(P + P_VT + vg * 32 + hi * 16);
            const bf16x8 mrf = *(const LAS bf16x8*)(P + P_MRF + l * 16);
            const bf16x8 bh0 = *(const LAS bf16x8*)(P + P_BHAT + v * 32 + hi * 16), bh1 = *(const LAS bf16x8*)(P + P_BHAT + (32 + v) * 32 + hi * 16);
            const bf16x8 kh0 = *(const LAS bf16x8*)(P + P_KHAT + v * 32 + hi * 16), kh1 = *(const LAS bf16x8*)(P + P_KHAT + (32 + v) * 32 + hi * 16);
            f32x16 G;
            { const f32x4 g0 = *(const LAS f32x4*)(P + P_GINIT + vg * 64 + hi * 16), g1 = *(const LAS f32x4*)(P + P_GINIT + vg * 64 + 32 + hi * 16);
#pragma unroll
              for (int r = 0; r < 8; ++r) G[r] = 0.f;
#pragma unroll
              for (int r = 0; r < 4; ++r) { G[8 + r] = g0[r]; G[12 + r] = g1[r]; } }
            f32x4 pc[8];
#pragma unroll
            for (int q = 0; q < 8; ++q) pc[q] = *(const LAS f32x4*)(P + P_PC + (32 * (q >> 2) + 8 * (q & 3) + 4 * hi) * 4);
            const bf16x8 s00 = pack_acc8(X0, 0), s01 = pack_acc8(X0, 8), s10 = pack_acc8(X1, 0), s11 = pack_acc8(X1, 8);
            G = __builtin_amdgcn_mfma_f32_32x32x16_bf16(a00, s00, G, 0, 0, 0);
            G = __builtin_amdgcn_mfma_f32_32x32x16_bf16(a01, s01, G, 0, 0, 0);
            G = __builtin_amdgcn_mfma_f32_32x32x16_bf16(a10, s10, G, 0, 0, 0);
            G = __builtin_amdgcn_mfma_f32_32x32x16_bf16(a11, s11, G, 0, 0, 0);
            G = __builtin_amdgcn_mfma_f32_32x32x16_bf16(ncat, vt, G, 0, 0, 0);
            const bf16x8 uf = pack_acc8(G, 0);
#pragma unroll
            for (int r = 0; r < 16; ++r) { X0[r] *= pc[r >> 2][r & 3]; X1[r] *= pc[4 + (r >> 2)][r & 3]; }
            X0 = __builtin_amdgcn_mfma_f32_32x32x16_bf16(bh0, uf, X0, 0, 0, 0);
            X1 = __builtin_amdgcn_mfma_f32_32x32x16_bf16(bh1, uf, X1, 0, 0, 0);
            X0 = __builtin_amdgcn_mfma_f32_32x32x16_bf16(kh0, vt, X0, 0, 0, 0);
            X1 = __builtin_amdgcn_mfma_f32_32x32x16_bf16(kh1, vt, X1, 0, 0, 0);
            G = __builtin_amdgcn_mfma_f32_32x32x16_bf16(mrf, uf, G, 0, 0, 0);
            LDS_WAIT();
            if (l == 0) consumed[half] = ci + 1;
#pragma unroll
            for (int q = 0; q < 8; ++q) { const int t = crow(q, hi); const int s = dir ? (SEQ - 1 - (ci * TC + t)) : (ci * TC + t);
                yout[(size_t)s * RW] = f2bf(G[8 + q]); }
        }
    } else {
        const int pw = w - NREC; LAS unsigned char* SC = L + OFF_SCR + pw * SCR_B;
        const bf16* zr = (const bf16*)(ws + WS_ZRKV) + (size_t)b * SEQ * ZR_LD + h * 64 + l;
        const bf16* wlp = (const bf16*)(ws + (dir ? WS_WLB : WS_WLF)) + (size_t)b * SEQ * RW + h * 64 + l;
        const bf16* icp = (const bf16*)(ws + (dir ? WS_ICB : WS_ICF)) + (size_t)b * SEQ * RW + h * 64 + l;
        const int ch = h * 64 + l; const float* sh = F.in[I_SHIFT];
        const float sr0 = sh[ch], sr1 = sh[RWKV_IN + ch], sr2 = sh[2 * RWKV_IN + ch];
        const float sk0 = sh[2048 + ch], sk1 = sh[RWKV_IN + 2048 + ch], sk2 = sh[2 * RWKV_IN + 2048 + ch];
        const float sv0 = sh[4096 + ch], sv1 = sh[RWKV_IN + 4096 + ch], sv2 = sh[2 * RWKV_IN + 4096 + ch];
        const float kk_c = F.in[I_KK][ch], ka_c = F.in[I_KA][ch], rk_c = F.in[I_RK][ch];
        const int posk = (((l >> 5) * 2 + ((l >> 4) & 1)) * 2 + ((l >> 2) & 1)) * 8 + ((l >> 3) & 1) * 4 + (l & 3);
        for (int ci = pw; ci < NCH; ci += NPREP) {
            const int slot = ci % NS; LAS unsigned char* P = L + OFF_PKG + slot * PKG_B;
            const int s_lo = dir ? (SEQ - TC - ci * TC) : ci * TC;
            float rr[18], rk[18], rv[18], wl[16], ic[16];
#pragma unroll
            for (int tau = 0; tau < 18; ++tau) { const int s = s_lo - 1 + tau; const bool ok = (s >= 0) && (s < SEQ); const int sc = ok ? s : s_lo; const bf16* z = zr + (size_t)sc * ZR_LD;
                const float f = ok ? 1.f : 0.f; rr[tau] = f * bf2f(z[0]); rk[tau] = f * bf2f(z[2048]); rv[tau] = f * bf2f(z[4096]); }
#pragma unroll
            for (int i = 0; i < 16; ++i) { const int s = dir ? (s_lo + 15 - i) : (s_lo + i); wl[i] = bf2f(wlp[(size_t)s * RW]); ic[i] = bf2f(icp[(size_t)s * RW]); }
            float cum[16];
            cum[0] = wl[0];
#pragma unroll
            for (int i = 1; i < 16; ++i) cum[i] = cum[i - 1] + wl[i];
            spin_ge(consumed, ci - NS + 1); spin_ge(consumed + 1, ci - NS + 1);
            float at[16]; float pprev = 1.0f; const float pC = __builtin_amdgcn_exp2f(cum[15]);
#pragma unroll
            for (int i = 0; i < 16; ++i) { const int tau = dir ? (16 - i) : (i + 1);
                const float r_s = sr0 * rr[tau - 1] + sr1 * rr[tau] + sr2 * rr[tau + 1];
                const float k_s = sk0 * rk[tau - 1] + sk1 * rk[tau] + sk2 * rk[tau + 1];
                const float v_s = sv0 * rv[tau - 1] + sv1 * rv[tau] + sv2 * rv[tau + 1];
                const float kkr = k_s * kk_c; const float ss = wave_sum_b(kkr * kkr); const float kk = kkr * __builtin_amdgcn_rsqf(ss + 1e-12f);
                const float kd = k_s * (1.0f + (ic[i] - 1.0f) * ka_c); const float bb = kk * ic[i];
                const float bon = wave_sum_b(r_s * kd * rk_c);
                const float p = __builtin_amdgcn_exp2f(cum[i]), pm = pprev, pinv = __builtin_amdgcn_exp2f(-cum[i]), pr = pC * pinv; pprev = p;
                at[i] = -kk * pm;
                lds_st16(SC + S_L2 + i * ROWB + l * 2, at[i]);
                const float rt = r_s * p;
                lds_st16(SC + S_L2 + (16 + i) * ROWB + l * 2, rt); lds_st16(P + P_ACAT + (16 + i) * ROWB + posk * 2, rt);
                lds_st16(SC + S_L1 + i * ROWB + l * 2, bb * pinv); lds_st16(SC + S_L1 + (16 + i) * ROWB + l * 2, kd * pinv);
                lds_st16(P + P_BHAT + l * 32 + ((((i >> 2) & 1) * 8) + (i & 3) + 4 * (i >> 3)) * 2, bb * pr);
                lds_st16(P + P_KHAT + l * 32 + i * 2, kd * pr);
                lds_st16(P + P_VT + l * 32 + i * 2, v_s); *(LAS float*)(P + P_GINIT + l * 64 + i * 4) = bon * v_s;
            }
            *(LAS float*)(P + P_PC + l * 4) = pC;
            LDS_WAIT();
            f32x16 Z = {};
            { const int r = l & 31, hh = l >> 5;
#pragma unroll
              for (int ks = 0; ks < 4; ++ks) { const bf16x8 fa = *(const LAS bf16x8*)(SC + S_L1 + r * ROWB + (ks * 16 + hh * 8) * 2), fb = *(const LAS bf16x8*)(SC + S_L2 + r * ROWB + (ks * 16 + hh * 8) * 2);
                  Z = __builtin_amdgcn_mfma_f32_32x32x16_bf16(fa, fb, Z, 0, 0, 0); } }
            { const int c = l & 31, hh = l >> 5;
              if (c < 16) {
#pragma unroll
                  for (int r = 0; r < 8; ++r) { const int s = crow(r, hh); *(LAS float*)(SC + S_MF + (c * 16 + s) * 4) = (s < c) ? Z[r] : 0.f; }
#pragma unroll
                  for (int r = 8; r < 16; ++r) { const int s = crow(r, hh) - 16; *(LAS float*)(SC + S_NF + (s * 16 + c) * 4) = (s < c) ? Z[r] : 0.f; }
                  *(LAS u32x4*)(P + P_MRF + l * 16) = (u32x4){0u, 0u, 0u, 0u};
              } else { const int t = c - 16; f32x16 Zm = Z;
#pragma unroll
                  for (int r = 0; r < 8; ++r) { const int s = crow(r, hh); Zm[r] = (s <= t) ? Z[r] : 0.f; }
                  *(LAS bf16x8*)(P + P_MRF + l * 16) = pack_acc8(Zm, 0);
#pragma unroll
                  for (int r = 8; r < 16; ++r) { const int s = crow(r, hh) - 16; lds_st16(P + P_NCAT + c * 32 + s * 2, (s <= t) ? Z[r] : 0.f); }
              } }
            LDS_WAIT();
            { float x[16]; x[0] = at[0];
#pragma unroll
              for (int t = 1; t < 16; ++t) { float acc = at[t];
#pragma unroll
                  for (int s4 = 0; s4 < (t + 3) / 4; ++s4) { const f32x4 m = *(const LAS f32x4*)(SC + S_MF + (t * 16 + s4 * 4) * 4);
#pragma unroll
                      for (int q = 0; q < 4; ++q) if (s4 * 4 + q < t) acc += x[s4 * 4 + q] * m[q]; }
                  x[t] = acc; }
#pragma unroll
              for (int t = 0; t < 16; ++t) lds_st16(P + P_ACAT + t * ROWB + posk * 2, x[t]); }
            if (l < 16) { float n[16], x[16];
#pragma unroll
              for (int q = 0; q < 4; ++q) { const f32x4 nv = *(const LAS f32x4*)(SC + S_NF + (l * 16 + q * 4) * 4); n[q * 4 + 0] = nv[0]; n[q * 4 + 1] = nv[1]; n[q * 4 + 2] = nv[2]; n[q * 4 + 3] = nv[3]; }
              x[0] = n[0];
#pragma unroll
              for (int t = 1; t < 16; ++t) { float acc = n[t];
#pragma unroll
                  for (int s4 = 0; s4 < (t + 3) / 4; ++s4) { const f32x4 m = *(const LAS f32x4*)(SC + S_MF + (t * 16 + s4 * 4) * 4);
#pragma unroll
                      for (int q = 0; q < 4; ++q) if (s4 * 4 + q < t) acc += x[s4 * 4 + q] * m[q]; }
                  x[t] = acc; }
#pragma unroll
              for (int t = 0; t < 16; ++t) lds_st16(P + P_NCAT + t * 32 + l * 2, x[t]); }
            LDS_WAIT();
            if (l == 0) ready[slot] = ci + 1;
        }
    }
    __syncthreads();
}
}

__device__ __forceinline__ void p5_post(Frame& F) {
    const int gw = F.vcu * 8 + F.wave, NGW = F.G * 8, l = F.lane; unsigned char* ws = F.ws;
    const bf16* yf = (const bf16*)(ws + WS_YF); const bf16* yb = (const bf16*)(ws + WS_YB); const bf16* gg = (const bf16*)(ws + WS_G); bf16* o = (bf16*)(ws + WS_ORWKV);
    const float* lg = F.in[I_LNXG]; const float* lb = F.in[I_LNXB];
    for (int t = gw; t < MT; t += NGW) {
        const size_t base = (size_t)t * RW;
#pragma unroll 4
        for (int h = 0; h < RH; ++h) { const int c = h * 64 + l;
            const float y = bf2f(yf[base + c]) + bf2f(yb[base + c]);
            const float mu = wave_sum(y) * (1.f / 64.f); const float d = y - mu; const float var = wave_sum(d * d) * (1.f / 64.f);
            const float yn = d * (1.0f / sqrtf(var + LNX_EPS));
            o[base + c] = f2bf((yn * lg[c] + lb[c]) * bf2f(gg[base + c])); }
    }
}

__device__ __forceinline__ void p8_rowpass(Frame& F) {
    const int gw = F.vcu * 8 + F.wave, NGW = F.G * 8; float* rstd2 = (float*)(F.ws + WS_RSTD) + 3 * MT; bf16* hb = (bf16*)(F.ws + WS_H1B);
    for (int m = gw; m < MT; m += NGW) {
        const f32x4* xr = (const f32x4*)(F.out + (size_t)m * DM) + F.lane; f32x4 v[8]; float s = 0.f;
#pragma unroll
        for (int j = 0; j < 8; ++j) { v[j] = xr[64 * j]; s += (v[j].x * v[j].x + v[j].y * v[j].y) + (v[j].z * v[j].z + v[j].w * v[j].w); }
        s = wave_sum(s); if (F.lane == 0) rstd2[m] = 1.0f / sqrtf(s * (1.f / DM) + RMS_EPS);
        u32x2* o8 = (u32x2*)(hb + (size_t)m * DM) + F.lane;
#pragma unroll
        for (int j = 0; j < 8; ++j) { u32x2 w; w.x = cvt_pk_bf16(v[j].x, v[j].y); w.y = cvt_pk_bf16(v[j].z, v[j].w); o8[64 * j] = w; }
    }
}
__device__ __forceinline__ void p12_router(Frame& F) {
    const int gw = F.vcu * 8 + F.wave, NGW = F.G * 8, l = F.lane; unsigned char* ws = F.ws;
    float* rstd3 = (float*)(ws + WS_RSTD) + 4 * MT; bf16* n3 = (bf16*)(ws + WS_N3); const float* WR = (const float*)(ws + WS_WR);
    int* lists = (int*)(ws + WS_LIST); int* route = (int*)(ws + WS_ROUTE); float* slotw = (float*)(ws + WS_SLOTW);
    int* cnt = (int*)(F.ctl + CW_CNT);
    const float* brg = F.in[I_BRG]; const float* bre = F.in[I_BRE];
    LAS float* wl = (LAS float*)(F.lds + 16384);
    LAS float* lgt = (LAS float*)(F.lds + F.wave * 1024);
    for (int tb = F.vcu * 32; tb < MT; tb += F.G * 32) {
        const int t0 = tb + F.wave * 4;
        float ss[4] = {0.f, 0.f, 0.f, 0.f};
#pragma unroll
        for (int q = 0; q < 4; ++q) { const f32x4* xr = (const f32x4*)(F.out + (size_t)(t0 + q) * DM) + l; u32x2* o8 = (u32x2*)(n3 + (size_t)(t0 + q) * DM) + l;
#pragma unroll
            for (int j = 0; j < 8; ++j) { const f32x4 x = xr[64 * j]; ss[q] += (x.x * x.x + x.y * x.y) + (x.z * x.z + x.w * x.w);
                u32x2 w; w.x = cvt_pk_bf16(x.x, x.y); w.y = cvt_pk_bf16(x.z, x.w); o8[64 * j] = w; } }
#pragma unroll
        for (int q = 0; q < 4; ++q) ss[q] = wave_sum(ss[q]);
#pragma unroll 1
        for (int pass = 0; pass < 2; ++pass) {
            const float* x0p = F.out + (size_t)(t0 + 2 * pass) * DM + l; const float* x1p = x0p + DM;
            float acc[2][36];
#pragma unroll
            for (int q = 0; q < 2; ++q)
#pragma unroll
                for (int o = 0; o < 36; ++o) acc[q][o] = 0.f;
#pragma unroll 1
            for (int blk = 0; blk < 8; ++blk) {
                __syncthreads();
                { const f32x4* src4 = (const f32x4*)(WR + (size_t)blk * 256 * 36); LAS f32x4* dst4 = (LAS f32x4*)wl;
#pragma unroll
                  for (int i = 0; i < 5; ++i) { const int idx = F.tid + 512 * i; if (idx < 2304) dst4[idx] = src4[idx]; } }
                __syncthreads();
#pragma unroll
                for (int c4 = 0; c4 < 4; ++c4) { const int cl = l + 64 * c4; const float x0 = x0p[blk * 256 + 64 * c4], x1 = x1p[blk * 256 + 64 * c4];
                    const LAS f32x4* wr = (const LAS f32x4*)(wl + cl * 36);
#pragma unroll
                    for (int o4 = 0; o4 < 9; ++o4) { const f32x4 w = wr[o4];
#pragma unroll
                        for (int k = 0; k < 4; ++k) { acc[0][o4 * 4 + k] += x0 * w[k]; acc[1][o4 * 4 + k] += x1 * w[k]; } } }
            }
#pragma unroll
            for (int q = 0; q < 2; ++q)
#pragma unroll
                for (int o = 0; o < 36; ++o) { const float v = wave_sum(acc[q][o]); if (l == 0) lgt[(2 * pass + q) * 36 + o] = v; }
        }
        LDS_WAIT();
#pragma unroll
        for (int q = 0; q < 4; ++q) { const int t = t0 + q; const float rs = 1.0f / sqrtf(ss[q] * (1.f / DM) + RMS_EPS);
            float lg[4]; float gmax = -3.0e38f; int gsel = 0;
#pragma unroll
            for (int g = 0; g < 4; ++g) { lg[g] = lgt[q * 36 + g] * rs + brg[g]; if (lg[g] > gmax) { gmax = lg[g]; gsel = g; } }
            float gz = 0.f;
#pragma unroll
            for (int g = 0; g < 4; ++g) gz += __expf(lg[g] - gmax);
            const float pg = 1.0f / gz;
            float le[8];
#pragma unroll
            for (int e = 0; e < 8; ++e) { float a = lgt[q * 36 + 4 + e];
#pragma unroll
                for (int g = 1; g < 4; ++g) a = (gsel == g) ? lgt[q * 36 + 4 + g * 8 + e] : a;
                le[e] = a * rs + bre[gsel * 8 + e]; }
            float m1 = -3.0e38f, m2 = -3.0e38f; int e1 = 0, e2 = 0;
#pragma unroll
            for (int e = 0; e < 8; ++e) { if (le[e] > m1) { m2 = m1; e2 = e1; m1 = le[e]; e1 = e; } else if (le[e] > m2) { m2 = le[e]; e2 = e; } }
            const float xe = __expf(m2 - m1); const float w1 = pg / (1.0f + xe), w2 = pg * xe / (1.0f + xe);
            if (l == 0) { rstd3[t] = rs;
                const int E1 = gsel * 8 + e1, E2 = gsel * 8 + e2;
                const int p1 = atomicAdd(cnt + 64 * E1, 1), p2 = atomicAdd(cnt + 64 * E2, 1);
                lists[E1 * MT + p1] = t; lists[E2 * MT + p2] = t; slotw[E1 * MT + p1] = w1; slotw[E2 * MT + p2] = w2;
                route[t * 8 + 0] = E1; route[t * 8 + 1] = p1; route[t * 8 + 2] = E2; route[t * 8 + 3] = p2; }
        }
    }
}
struct MoeOrder {
    static constexpr bool GATHER = true;
    const volatile LAS int* tp; const int* cnt; const int* lists; const char* A; const char* B; int G, c, lognt; size_t bstride_e, bstride_t;
    bool gather;
    __device__ __forceinline__ bool next(int i, Unit& u) const {
        const int L = i * G + c; const int RT = tp[32]; if (L >= (RT << lognt)) return false;
        const int rt = L >> lognt, nt = L & ((1 << lognt) - 1); int e = 0;
        for (int q = 1; q < 32; ++q) e = (rt >= tp[q]) ? q : e;
        u.pm = rt; u.pn = nt; u.aux0 = e; u.aux1 = (rt - tp[e]) * 256;
        u.Ab = A; u.Bb = B + (size_t)e * bstride_e + (size_t)nt * bstride_t; return true;
    }
    __device__ __forceinline__ unsigned arow(const Unit& u, int r) const {
        if (!gather) return (unsigned)(u.pm * 256 + r);
        const int idx = u.aux1 + r; const int n = cnt[64 * u.aux0]; return idx < n ? (unsigned)lists[u.aux0 * MT + idx] : 0u;
    }
};
struct EpiMoe1 {
    static constexpr bool PERM = true;
    bf16* hid; const int* cnt; const int* lists; const float* slotw; const float* rstd;
    __device__ __forceinline__ void operator()(const PG8_ACC, const Unit& u, int wr, int wc, int fr, int fq) const {
        const int n = cnt[64 * u.aux0];
#pragma unroll
        for (int ai = 0; ai < 2; ++ai)
#pragma unroll
            for (int m = 0; m < 4; ++m) { const int r = ai * 128 + wr * 64 + m * 16 + fr; const int idx = u.aux1 + r; const bool ok = idx < n;
                const int tok = ok ? lists[u.aux0 * MT + idx] : 0; const float rs = rstd[tok]; const float wt = ok ? slotw[u.aux0 * MT + idx] : 0.f;
                f32x4 o0, o1;
#pragma unroll
                for (int j = 0; j < 4; ++j) { const float g0 = acc[ai][0][m][0][j] * rs, u0 = acc[ai][1][m][0][j] * rs, g1 = acc[ai][0][m][1][j] * rs, u1 = acc[ai][1][m][1][j] * rs;
                    o0[j] = g0 * sigmoidf_(g0) * u0 * wt; o1[j] = g1 * sigmoidf_(g1) * u1 * wt; }
                *(u32x4*)(hid + (size_t)(u.pm * 256 + r) * DE + u.pn * 128 + wc * 32 + 8 * fq) = pg8::pack8(o0, o1); }
    }
};
struct EpiMoe2 {
    static constexpr bool PERM = true;
    bf16* y;
    __device__ __forceinline__ void operator()(const PG8_ACC, const Unit& u, int wr, int wc, int fr, int fq) const {
        EPI_FOR(ai, m, bj) { const int row = u.pm * 256 + ai * 128 + wr * 64 + m * 16 + fr; const int col = u.pn * 256 + bj * 128 + wc * 32 + 8 * fq;
            *(u32x4*)(y + (size_t)row * DM + col) = pg8::pack8(acc[ai][bj][m][0], acc[ai][bj][m][1]); }
    }
};
__device__ __forceinline__ void moe_table(Frame& F) {
    if (F.tid == 0) { const int* cnt = (const int*)(F.ctl + CW_CNT); int acc = 0;
        for (int e = 0; e < 32; ++e) { F.MISC[16 + e] = (unsigned)acc; acc += (__hip_atomic_load(cnt + 64 * e, __ATOMIC_RELAXED, __HIP_MEMORY_SCOPE_AGENT) + 255) >> 8; }
        F.MISC[16 + 32] = (unsigned)acc; }
    __syncthreads();
}
__device__ __forceinline__ void p5_expert_cvt(Frame& F) {
    LAS float* scr = (LAS float*)(F.lds + F.wave * CVT_SCR); const int gw = F.vcu * 8 + F.wave, NGW = F.G * 8; unsigned char* ws = F.ws;
#define EX_DESC(it_, d) do { const int e = (it_) / 768, r = (it_) % 768; \
        if (r < 256) { d.W = F.in[I_WEG] + (size_t)e * DM * DE; d.gain = F.in[I_GFFN]; d.WT = (bf16*)(ws + WS_WGU) + (size_t)e * 1024 * DM; d.K = DM; d.N = DE; d.ldt = DM; d.mode = 3; d.kofs = 0; d.item = r; } \
        else if (r < 512) { d.W = F.in[I_WEU] + (size_t)e * DM * DE; d.gain = F.in[I_GFFN]; d.WT = (bf16*)(ws + WS_WGU) + (size_t)e * 1024 * DM; d.K = DM; d.N = DE; d.ldt = DM; d.mode = 4; d.kofs = 0; d.item = r - 256; } \
        else { d.W = F.in[I_WED] + (size_t)e * DE * DM; d.gain = nullptr; d.WT = (bf16*)(ws + WS_WD) + (size_t)e * DM * DE; d.K = DE; d.N = DM; d.ldt = DE; d.mode = 0; d.kofs = 0; d.item = r - 512; } } while (0)
    CVT_PIPE(NE * 768, EX_DESC);
#undef EX_DESC
}

struct Args { const float* in[41]; float* out; unsigned char* ws; int ph_lo, ph_hi; };
constexpr int NPHASE = 16;
__global__ void __launch_bounds__(512, 2) fwd_kernel(Args args) {
    extern __shared__ __attribute__((aligned(16))) unsigned char lds_raw[];
    Frame F;
    F.lds = (LAS unsigned char*)lds_raw; F.MISC = (volatile LAS unsigned*)(F.lds + MISC_OFF);
    F.tid = threadIdx.x; F.lane = F.tid & 63; F.wave = __builtin_amdgcn_readfirstlane(F.tid >> 6);
    F.G = gridDim.x; { const int bx = blockIdx.x; F.vcu = (F.G % 8 == 0) ? (bx % 8) * (F.G / 8) + bx / 8 : bx; }
    F.ws = args.ws; F.out = args.out; F.ctl = (unsigned*)(args.ws + WS_CTL);
#pragma unroll
    for (int i = 0; i < 41; ++i) F.in[i] = args.in[i];
    for (int u = F.tid; u < (LDS_BYTES - LDSCTL_OFF) / 4; u += 512) ((LAS unsigned*)(F.lds + LDSCTL_OFF))[u] = 0u;
    __syncthreads();
    XcdBarrier bar; bar.bar = F.ctl + CW_BAR; bar.x = 0; bar.st = nullptr;
    const int lo = args.ph_lo, hi = args.ph_hi;
    if (hi - lo > 1) bar = xcd_barrier_post(F.ctl + CW_BAR, F.MISC + 8);
#ifndef ATT_DQK_TEST
#define ATT_DQK_TEST QKD
#endif
#define PROBE_N (MT * 768)
#ifndef LSEL
#define LSEL 31
#endif
#ifndef PH_MASK
#define PH_MASK 0xFFFFu
#endif
#ifndef SCAN_MFMA
#define SCAN_MFMA 1
#endif
#ifndef SCAN_DUMMY
#define SCAN_DUMMY 0
#endif
#ifndef REPEAT_MASK
#define REPEAT_MASK 0x0u
#endif
#define REP(k) _Pragma("unroll") for (int _rep = 0; _rep <= (int)(((REPEAT_MASK) >> (k)) & 1u); ++_rep)
#define IN(k) ((((PH_MASK) >> (k)) & 1u) && lo <= (k) && (k) < hi)
#define SEAM(k) do { if (lo <= (k) && (k) + 1 < hi) xcd_barrier(bar); } while (0)
    unsigned char* ws = args.ws;

    bf16* const zmla = (bf16*)(ws + WS_ZMLA); bf16* const loraA = (bf16*)(ws + WS_LORAA);
    float* const rstd1 = (float*)(ws + WS_RSTD); float* const rstd_q = rstd1 + MT; float* const rstd_kv = rstd1 + 2 * MT;
    const int bid = (int)blockIdx.x;
    if (IN(0)) { REP(0) p0_prologue(F); }
    SEAM(0);
    if (IN(1)) {
        if (EN_RWKV || EN_MLA) REP(1) { pg8::StaticOrder S; S.init((const bf16*)(ws + WS_XB), DM, (const bf16*)(ws + WS_WIN), DM, MT, G1_N, F.G, bid);
          EpiG1 E{rstd1, zmla, (bf16*)(ws + WS_ZRKV), (bf16*)(ws + WS_ZLORA), (bf16*)(ws + WS_ZGATE)};
          pg8::gemm_phase(F.lds, DM, DM, DM, S, E); }
        else p_copy_x(F);
        if (EN_CROSS) { pg8::StaticOrder S; S.init((const bf16*)(ws + WS_MEMN), DM, (const bf16*)(ws + WS_WKVC), DM, NB * MEMLEN, 2 * CW, F.G, bid);
          EpiPlain E{(bf16*)(ws + WS_KVC), 2 * CW, nullptr, 1.f};
          pg8::gemm_phase(F.lds, DM, DM, DM, S, E); }
    }
    SEAM(1);
    if (IN(2)) { if (EN_RWKV || EN_MLA) REP(2) p2_rowpass(F); }
    SEAM(2);
    if (IN(3)) REP(3) {
        if (EN_MLA) {
            { pg8::StaticOrder S; S.init(zmla, ZM_LD, (const bf16*)(ws + WS_WUQ), QLORA, MT, MH * QKD, F.G, bid);
              EpiQ E{(bf16*)(ws + WS_Q), rstd_q, (const float*)(ws + WS_ROPE)};
              pg8::gemm_phase(F.lds, QLORA, ZM_LD, QLORA, S, E); }
            { pg8::StaticOrder S; S.init(zmla + QLORA, ZM_LD, (const bf16*)(ws + WS_WUKV), KVLORA, MT, MH * 256, F.G, bid);
              EpiKV E{(bf16*)(ws + WS_K), (bf16*)(ws + WS_V), rstd_kv};
              pg8::gemm_phase(F.lds, KVLORA, ZM_LD, KVLORA, S, E); }
        }
        if (EN_RWKV) {
            if (LSEL & 1) { pg8::StaticOrder S; S.init(loraA, LA_LD, (const bf16*)(ws + WS_W2F), 256, MT, RW, F.G, bid);
              EpiLora<0> E{(bf16*)(ws + WS_WLF), F.in[I_W0F]}; pg8::gemm_phase(F.lds, 256, LA_LD, 256, S, E); }
            if (LSEL & 2) { pg8::StaticOrder S; S.init(loraA, LA_LD, (const bf16*)(ws + WS_W2F + 1 * MiB), 256, MT, RW, F.G, bid);
              EpiLora<0> E{(bf16*)(ws + WS_WLB), F.in[I_W0B]}; pg8::gemm_phase(F.lds, 256, LA_LD, 256, S, E); }
            if (LSEL & 4) { pg8::StaticOrder S; S.init(loraA + 256, LA_LD, (const bf16*)(ws + WS_W2F + 2 * MiB), 256, MT, RW, F.G, bid);
              EpiLora<1> E{(bf16*)(ws + WS_ICF), F.in[I_A0F]}; pg8::gemm_phase(F.lds, 256, LA_LD, 256, S, E); }
            if (LSEL & 8) { pg8::StaticOrder S; S.init(loraA + 256, LA_LD, (const bf16*)(ws + WS_W2F + 3 * MiB), 256, MT, RW, F.G, bid);
              EpiLora<1> E{(bf16*)(ws + WS_ICB), F.in[I_A0B]}; pg8::gemm_phase(F.lds, 256, LA_LD, 256, S, E); }
            if (LSEL & 16) { pg8::StaticOrder S; S.init(loraA + 512, LA_LD, (const bf16*)(ws + WS_G2), GLORA, MT, RW, F.G, bid);
              EpiLora<2> E{(bf16*)(ws + WS_G), nullptr}; pg8::gemm_phase(F.lds, GLORA, LA_LD, GLORA, S, E); }
        }
    }
    SEAM(3);
    if (IN(4)) {
        constexpr int NSCAN = NB * RH * 2, NATT = NB * MH * (SEQ / 256);
        int s_begin = F.vcu, s_end = NSCAN, s_step = F.G, a_begin = F.vcu, a_step = F.G, a_cnt = (F.vcu < NATT) ? (NATT - 1 - F.vcu) / F.G + 1 : 0;
        if (EN_RWKV && EN_MLA && F.G == 256) { s_step = 1; a_step = 1;
            if (F.vcu < 128) { s_end = F.vcu + 1; a_begin = 384 + F.vcu; a_cnt = 1; } else { s_end = 0; a_begin = (F.vcu - 128) * 3; a_cnt = 3; } }
        if (EN_RWKV) for (int u = s_begin; u < s_end; u += s_step) { const int dir = u & 1, bh = u >> 1;
            if (dir) scan2::scan_unit<1>(F, bh >> 5, bh & 31); else scan2::scan_unit<0>(F, bh >> 5, bh & 31); }
        if (EN_MLA) for (int i = 0; i < a_cnt; ++i) { const int L = a_begin + i * a_step; const int qb = L & 15, bh = L >> 4, b = bh >> 4, h = bh & 15;
            att::attn_unit<ATT_DQK_TEST, MH * QKD, MH * QKD, MH * VDIM, DM>((const bf16*)(ws + WS_Q) + ((size_t)(b * SEQ + qb * 256) * (MH * QKD) + h * QKD),
                                (const bf16*)(ws + WS_K) + ((size_t)b * SEQ * (MH * QKD) + h * QKD),
                                (const bf16*)(ws + WS_V) + ((size_t)b * SEQ * (MH * VDIM) + h * VDIM),
                                (bf16*)(ws + WS_OMLA) + ((size_t)(b * SEQ + qb * 256) * DM + h * VDIM), SEQ, (LAS char*)F.lds); }
    }
    SEAM(4);
    if (IN(5)) { if (EN_RWKV) REP(5) p5_post(F); if (EN_MOE) REP(17) p5_expert_cvt(F); }
    SEAM(5);
    if (IN(6)) REP(6) {
        if (EN_MLA) { pg8::StaticOrder S; S.init((const bf16*)(ws + WS_OMLA), DM, (const bf16*)(ws + WS_WUPM), DM, MT, DM, F.G, bid);
            EpiUp<0> E{(bf16*)(ws + WS_MERGED), (const bf16*)(ws + WS_ZGATE), 0}; pg8::gemm_phase(F.lds, DM, DM, DM, S, E); }
        if (EN_RWKV) { pg8::StaticOrder S; S.init((const bf16*)(ws + WS_ORWKV), DM, (const bf16*)(ws + WS_WUPR), DM, MT, DM, F.G, bid);
            EpiUp<EN_MLA> E{(bf16*)(ws + WS_MERGED), (const bf16*)(ws + WS_ZGATE), DM}; pg8::gemm_phase(F.lds, DM, DM, DM, S, E); }
    }
    SEAM(6);
    if (IN(7)) REP(7) {
        if (EN_RWKV || EN_MLA) { pg8::StaticOrder S; S.init((const bf16*)(ws + WS_MERGED), DM, (const bf16*)(ws + WS_WOUT), DM, MT, DM, F.G, bid);
            EpiResid E{F.in[I_X], F.out}; pg8::gemm_phase(F.lds, DM, DM, DM, S, E); }
    }
    SEAM(7);
    if (IN(8)) { if (EN_CROSS || EN_MOE) p8_rowpass(F); }
    SEAM(8);
    if (IN(9)) REP(9) {
        if (EN_CROSS) { pg8::StaticOrder S; S.init((const bf16*)(ws + WS_H1B), DM, (const bf16*)(ws + WS_WQC), DM, MT, CW, F.G, bid);
            EpiPlain E{(bf16*)(ws + WS_QC), CW, rstd1 + 3 * MT, CSCALE}; pg8::gemm_phase(F.lds, DM, DM, DM, S, E); }
    }
    SEAM(9);
    if (IN(10)) REP(10) {
        if (EN_CROSS) {
            for (int i = 0; ; ++i) { const int L = i * F.G + F.vcu; if (L >= NB * CH * (SEQ / 256)) break;
                const int qb = L & 15, bh = L >> 4, b = bh >> 2, h = bh & 3;
                att::attn_unit<CHD, CW, 2 * CW, 2 * CW, CW>((const bf16*)(ws + WS_QC) + ((size_t)(b * SEQ + qb * 256) * CW + h * CHD),
                                    (const bf16*)(ws + WS_KVC) + ((size_t)b * MEMLEN * (2 * CW) + h * CHD),
                                    (const bf16*)(ws + WS_KVC) + ((size_t)b * MEMLEN * (2 * CW) + CW + h * CHD),
                                    (bf16*)(ws + WS_OC) + ((size_t)(b * SEQ + qb * 256) * CW + h * CHD), MEMLEN, (LAS char*)F.lds); }
        }
    }
    SEAM(10);
    if (IN(11)) {
        if (EN_CROSS) { pg8::StaticOrder S; S.init((const bf16*)(ws + WS_OC), CW, (const bf16*)(ws + WS_WOC), CW, MT, DM, F.G, bid);
            EpiResid E{F.out, F.out}; pg8::gemm_phase(F.lds, CW, CW, CW, S, E); }
    }
    SEAM(11);
    if (IN(12)) { if (EN_MOE) p12_router(F); }
    SEAM(12);
    if (IN(13)) REP(13) {
        if (EN_MOE) { moe_table(F);
            MoeOrder S{(const volatile LAS int*)(F.MISC + 16), (const int*)(F.ctl + CW_CNT), (const int*)(ws + WS_LIST), (const char*)(ws + WS_N3), (const char*)(ws + WS_WGU), F.G, F.vcu, 2,
                       (size_t)1024 * DM * 2, (size_t)256 * DM * 2, true};
            EpiMoe1 E{(bf16*)(ws + WS_HID), (const int*)(F.ctl + CW_CNT), (const int*)(ws + WS_LIST), (const float*)(ws + WS_SLOTW), rstd1 + 4 * MT};
            pg8::gemm_phase(F.lds, DM, DM, DM, S, E); }
    }
    SEAM(13);
    if (IN(14)) REP(14) {
        if (EN_MOE) { moe_table(F);
            MoeOrder S{(const volatile LAS int*)(F.MISC + 16), (const int*)(F.ctl + CW_CNT), (const int*)(ws + WS_LIST), (const char*)(ws + WS_HID), (const char*)(ws + WS_WD), F.G, F.vcu, 3,
                       (size_t)DM * DE * 2, (size_t)256 * DE * 2, false};
            EpiMoe2 E{(bf16*)(ws + WS_YBUF)};
            pg8::gemm_phase(F.lds, DE, DE, DE, S, E); }
    }
    SEAM(14);
#ifdef PROBE_OFF
    if (IN(15)) { const int gt = F.vcu * 512 + F.tid, NGT = F.G * 512; const bf16* sb = (const bf16*)(ws + (size_t)PROBE_OFF * MiB);
        for (int i = gt; i < MT * DM; i += NGT) F.out[i] = (i < PROBE_N) ? bf2f(sb[i]) : 0.f; }
#else
    if (IN(15)) { p_final(F, EN_MOE != 0); }
#endif
#undef IN
#undef SEAM
}

extern "C" void kernel_launch(void* const* d_in, const int* in_sizes, int n_in, void* d_out, int out_size, void* d_ws, size_t ws_size, hipStream_t stream) {
    static int grid = 0;
    if (grid == 0) {
        if (n_in != 41 || out_size != MT * DM || ws_size < WS_END) { fprintf(stderr, "kernel_launch: unexpected shapes n_in %d out %d ws %zu (need %zu)\n", n_in, out_size, ws_size, (size_t)WS_END); grid = -1; return; }
        int dev = 0, cus = 0, per_cu = 0;
        if (hipGetDevice(&dev) != hipSuccess || hipDeviceGetAttribute(&cus, hipDeviceAttributeMultiprocessorCount, dev) != hipSuccess) { grid = -1; return; }
        if (hipFuncSetAttribute((const void*)fwd_kernel, hipFuncAttributeMaxDynamicSharedMemorySize, LDS_BYTES) != hipSuccess) { fprintf(stderr, "kernel_launch: hipFuncSetAttribute failed\n"); grid = -1; return; }
        if (hipOccupancyMaxActiveBlocksPerMultiprocessor(&per_cu, (const void*)fwd_kernel, 512, LDS_BYTES) != hipSuccess || per_cu < 1) { fprintf(stderr, "kernel_launch: occupancy query says %d\n", per_cu); }
        (void)hipGetLastError();
        grid = cus;
    }
    if (grid < 0) return;
    (void)hipMemsetAsync((char*)d_ws + WS_CTL, 0, CTL_BYTES, stream);
    Args a{};
    for (int i = 0; i < 41; ++i) a.in[i] = (const float*)d_in[i];
    a.out = (float*)d_out; a.ws = (unsigned char*)d_ws;
#if N_LAUNCH_SPLIT
    for (int p = 0; p < NPHASE; ++p) { a.ph_lo = p; a.ph_hi = p + 1; hipLaunchKernelGGL(fwd_kernel, dim3(grid), dim3(512), LDS_BYTES, stream, a); }
#else
    a.ph_lo = 0; a.ph_hi = NPHASE;
    hipLaunchKernelGGL(fwd_kernel, dim3(grid), dim3(512), LDS_BYTES, stream, a);
#endif
}
```

```cpp
#include <hip/hip_runtime.h>
#include <cstdio>
#include <cstdint>

#ifndef EN_RWKV
#define EN_RWKV 1
#endif
#ifndef EN_MLA
#define EN_MLA 1
#endif
#ifndef EN_CROSS
#define EN_CROSS 1
#endif
#ifndef EN_MOE
#define EN_MOE 1
#endif
#ifndef N_LAUNCH_SPLIT
#define N_LAUNCH_SPLIT 0
#endif

#define GAS __attribute__((address_space(1)))
#define LAS __attribute__((address_space(3)))
typedef unsigned short bf16;
typedef short bf16x8 __attribute__((ext_vector_type(8)));
typedef short s16x4 __attribute__((ext_vector_type(4)));
typedef float f32x4 __attribute__((ext_vector_type(4)));
typedef float f32x2 __attribute__((ext_vector_type(2)));
typedef float f32x16 __attribute__((ext_vector_type(16)));
typedef unsigned u32x4 __attribute__((ext_vector_type(4)));
typedef unsigned u32x2 __attribute__((ext_vector_type(2)));

constexpr int DM = 2048, NB = 2, SEQ = 4096, MT = NB * SEQ;
constexpr int MEMLEN = 256;
constexpr int QLORA = 512, KVLORA = 256, ROPE = 64, NOPE = 128, VDIM = 128, QKD = 192, MH = 16;
constexpr int RW = 2048, RH = 32, RHD = 64, DLORA = 96, GLORA = 256;
constexpr int MLA_IN = 832, RWKV_IN = 6784, GATE_IN = 4096, IN_W = MLA_IN + RWKV_IN + GATE_IN;
constexpr int CH = 4, CHD = 128, CW = 512;
constexpr int NG = 4, EPG = 8, NE = 32, DE = 512;
constexpr float RMS_EPS = 1e-6f, LNX_EPS = 64e-5f;
constexpr int G1_N = 12032;
constexpr int ZM_LD = 1024, ZR_LD = 6144, ZL_LD = 768, ZG_LD = 4096, LA_LD = 768;
constexpr int MOE_SLOTS = 2 * MT + NE * 256;

constexpr size_t MiB = 1u << 20;
constexpr size_t WS_CTL = 0, CTL_BYTES = 1 * MiB;
constexpr size_t WS_WUQ = 1 * MiB;
constexpr size_t WS_WUKV = 4 * MiB;
constexpr size_t WS_W2F = 6 * MiB;
constexpr size_t WS_G2 = 10 * MiB;
constexpr size_t WS_WUPM = 11 * MiB, WS_WUPR = 19 * MiB, WS_WOUT = 27 * MiB;
constexpr size_t WS_WQC = 35 * MiB;
constexpr size_t WS_WKVC = 37 * MiB;
constexpr size_t WS_WOC = 41 * MiB;
constexpr size_t WS_WIN = 43 * MiB;
constexpr size_t WS_MISC = 90 * MiB;
constexpr size_t WS_ROPE = WS_MISC;
constexpr size_t WS_MEMN = WS_MISC + 2 * MiB;
constexpr size_t WS_KVC = WS_MISC + 4 * MiB;
constexpr size_t WS_RSTD = WS_MISC + 5 * MiB;
constexpr size_t WS_WR = WS_RSTD + 256 * 1024;
constexpr size_t WS_LIST = WS_MISC + 6 * MiB;
constexpr size_t WS_ROUTE = WS_MISC + 7 * MiB;
constexpr size_t WS_SLOTW = WS_MISC + 8 * MiB;
constexpr size_t WS_XB = 100 * MiB;
constexpr size_t WS_ZMLA = 132 * MiB;
constexpr size_t WS_ZLORA = 148 * MiB;
constexpr size_t WS_LORAA = 160 * MiB;
constexpr size_t WS_ZRKV = 172 * MiB;
constexpr size_t WS_ZGATE = 268 * MiB;
constexpr size_t WS_Q = 332 * MiB;
constexpr size_t WS_K = 380 * MiB;
constexpr size_t WS_V = 428 * MiB;
constexpr size_t WS_WLF = 460 * MiB, WS_WLB = 492 * MiB, WS_ICF = 524 * MiB, WS_ICB = 556 * MiB;
constexpr size_t WS_G = 588 * MiB;
constexpr size_t WS_END = 620 * MiB;
constexpr size_t WS_YF = WS_WIN, WS_YB = WS_ZMLA, WS_ORWKV = WS_Q, WS_MERGED = WS_K, WS_QC = WS_V, WS_OC = WS_V + 8 * MiB;
constexpr size_t WS_WGU = WS_WLF, WS_WD = WS_ZRKV, WS_HID = WS_ZGATE, WS_YBUF = WS_Q;
constexpr size_t WS_OMLA = WS_XB, WS_H1B = WS_XB, WS_N3 = WS_XB;

constexpr int CW_BAR = 4096;
constexpr int CW_CNT = 16384;

constexpr int RING_BYTES = 155648;
constexpr int LDSCTL_OFF = RING_BYTES, MISC_OFF = LDSCTL_OFF + 320;
constexpr int LDS_BYTES = 157696;

#define LDS_WAIT() asm volatile("s_waitcnt lgkmcnt(0)" ::: "memory")
#define VM_WAIT() asm volatile("s_waitcnt vmcnt(0)" ::: "memory")
typedef __bf16 bf16x2_t __attribute__((ext_vector_type(2)));
__device__ __forceinline__ unsigned cvt_pk_bf16(float lo, float hi) { f32x2 v = {lo, hi}; bf16x2_t b = __builtin_convertvector(v, bf16x2_t); return __builtin_bit_cast(unsigned, b); }
__device__ __forceinline__ float bf2f(unsigned short b) { return __builtin_bit_cast(float, ((unsigned)b) << 16); }
__device__ __forceinline__ float bflo(unsigned w) { return __builtin_bit_cast(float, w << 16); }
__device__ __forceinline__ float bfhi(unsigned w) { return __builtin_bit_cast(float, w & 0xffff0000u); }
__device__ __forceinline__ unsigned short f2bf(float f) { return (unsigned short)(cvt_pk_bf16(f, 0.f) & 0xffffu); }
__device__ __forceinline__ float sigmoidf_(float x) { return __builtin_amdgcn_rcpf(1.0f + __builtin_amdgcn_exp2f(-1.4426950408889634f * x)); }
template <int CTRL> __device__ __forceinline__ float dpp_add_(float v) {
    return v + __builtin_bit_cast(float, __builtin_amdgcn_update_dpp(0, __builtin_bit_cast(int, v), CTRL, 0xF, 0xF, false));
}
__device__ __forceinline__ float wave_sum(float v) {
    v = dpp_add_<0xB1>(v); v = dpp_add_<0x4E>(v); v = dpp_add_<0x141>(v); v = dpp_add_<0x140>(v);
    const int iv = __builtin_bit_cast(int, v);
    const float s0 = __builtin_bit_cast(float, __builtin_amdgcn_readlane(iv, 0)), s1 = __builtin_bit_cast(float, __builtin_amdgcn_readlane(iv, 16));
    const float s2 = __builtin_bit_cast(float, __builtin_amdgcn_readlane(iv, 32)), s3 = __builtin_bit_cast(float, __builtin_amdgcn_readlane(iv, 48));
    return (s0 + s1) + (s2 + s3);
}

#define XB_TMO      128
#define XB_XCNT(j)  (256  + 64 * (j))
#define XB_XSUB(j)  (1280 + 64 * (j))
#define XB_XGEN(j)  (2304 + 64 * (j))
#define XB_TOP      3328
#define XB_TOPGEN   3392
#define XCD_BAR_WORDS 3456
#define XB_SPIN_CAP (1u << 18)
__device__ __forceinline__ unsigned xb_ld(unsigned* p)              { return __hip_atomic_load(p, __ATOMIC_RELAXED, __HIP_MEMORY_SCOPE_AGENT); }
__device__ __forceinline__ unsigned xb_add(unsigned* p, unsigned v) { return __hip_atomic_fetch_add(p, v, __ATOMIC_RELAXED, __HIP_MEMORY_SCOPE_AGENT); }
__device__ __forceinline__ unsigned xb_xcc_id() { return (unsigned)__builtin_amdgcn_s_getreg((3 << 11) | 20) & 0xFu; }
#define XB_SPIN(cond, bar) do { unsigned _sp = 0; while (cond) { __builtin_amdgcn_s_sleep(1); \
    if ((++_sp & 255u) == 0u) { if (xb_ld(&(bar)[XB_TMO])) break; if (_sp > XB_SPIN_CAP) { atomicAdd(&(bar)[XB_TMO], 1u); break; } } } } while (0)
struct XcdBarrier { unsigned* bar; unsigned x; volatile LAS unsigned* st; };
__device__ __forceinline__ XcdBarrier xcd_barrier_post(unsigned* bar, volatile LAS unsigned* st) {
    XcdBarrier b; b.bar = bar; b.x = xb_xcc_id(); b.st = st;
    if (threadIdx.x == 0) (void)xb_add(&bar[XB_XCNT(b.x)], 1u);
    return b;
}
__device__ __forceinline__ void xcd_barrier_complete(unsigned* bar, unsigned x, unsigned& nloc, unsigned& nx) {
    const unsigned G = gridDim.x * gridDim.y * gridDim.z;
    unsigned sum, cnt, mine, sp = 0u;
    for (;;) {
        sum = 0u; cnt = 0u; mine = 0u;
#pragma unroll
        for (unsigned j = 0; j < 16; ++j) { const unsigned c = xb_ld(&bar[XB_XCNT(j)]); sum += c; cnt += (c > 0u) ? 1u : 0u; mine = (j == x) ? c : mine; }
        if (sum == G) break;
        __builtin_amdgcn_s_sleep(1);
        if ((++sp & 255u) == 0u) { if (xb_ld(&bar[XB_TMO])) break; if (sp > XB_SPIN_CAP) { atomicAdd(&bar[XB_TMO], 1u); break; } }
    }
    nloc = mine > 0u ? mine : 1u; nx = cnt > 0u ? cnt : 1u;
}
__device__ __forceinline__ void xcd_barrier(const XcdBarrier& b) {
    asm volatile("s_waitcnt vmcnt(0)" ::: "memory");
    __syncthreads();
    if (threadIdx.x == 0) {
        unsigned* bar = b.bar;
        __builtin_amdgcn_s_waitcnt(0);
        unsigned nloc = b.st[0], nx = b.st[1];
        if (nloc == 0u) { xcd_barrier_complete(bar, b.x, nloc, nx); b.st[0] = nloc; b.st[1] = nx; }
        const unsigned old = xb_add(&bar[XB_XSUB(b.x)], 1u);
        const unsigned gen = old / nloc;
        if (old + 1u == (gen + 1u) * nloc) {
            __builtin_amdgcn_fence(__ATOMIC_RELEASE, "agent");
            asm volatile("s_waitcnt vmcnt(0)" ::: "memory");
            const unsigned og = xb_add(&bar[XB_TOP], 1u);
            const unsigned tg = og / nx;
            if (og + 1u == (tg + 1u) * nx) xb_add(&bar[XB_TOPGEN], 1u);
            else XB_SPIN(xb_ld(&bar[XB_TOPGEN]) == tg, bar);
            __builtin_amdgcn_fence(__ATOMIC_ACQUIRE, "agent");
            xb_add(&bar[XB_XGEN(b.x)], 1u);
            asm volatile("s_waitcnt vmcnt(0)" ::: "memory");
        } else {
            XB_SPIN(xb_ld(&bar[XB_XGEN(b.x)]) == gen, bar);
            __builtin_amdgcn_fence(__ATOMIC_ACQUIRE, "agent");
            asm volatile("s_waitcnt vmcnt(0)" ::: "memory");
        }
    }
    __syncthreads();
}

namespace pg8 {
constexpr int BM = 256, BK = 64, HALF = 128, HTB = HALF * BK * 2, STAGE_BYTES = 8 * HTB, NXCD = 8, WGM = 8;
__host__ __device__ __forceinline__ int lds_byte(int r, int c) { const int st = (r >> 4) * 2 + (c >> 5), rr = r & 15, cc = c & 31, ob = rr * 64 + cc * 2; return st * 1024 + (ob ^ (((ob >> 9) & 1) << 5)); }
__host__ __device__ __forceinline__ void stage_rc(int b, int& R, int& C) { const int st = b / 1024, sb = b % 1024, swz = sb ^ (((sb >> 9) & 1) << 5); R = (st >> 1) * 16 + swz / 64; C = (st & 1) * 32 + (swz % 64) / 2; }
__host__ __device__ __forceinline__ int perm32(int rho) { const int n = rho >> 4, i = rho & 15; return 8 * (i >> 2) + 4 * n + (i & 3); }

struct Unit { int pm, pn; const char* Ab; const char* Bb; int aux0, aux1; };

struct StaticOrder {
    static constexpr bool GATHER = false;
    int nM, nN, nwg, G, c; const char* A; const char* Bt; int lda, ldb;
    __device__ void init(const bf16* A_, int lda_, const bf16* Bt_, int ldb_, int M, int N, int G_, int c_) { A = (const char*)A_; Bt = (const char*)Bt_; lda = lda_; ldb = ldb_; nM = M / BM; nN = N / BM; nwg = nM * nN; G = G_; c = c_; }
    __device__ __forceinline__ bool next(int i, Unit& u) const {
        const long L = (long)i * G + c; if (L >= nwg) return false;
        int wgid = (int)L; { const int q = nwg / NXCD, r = nwg % NXCD, xcd = wgid % NXCD, off = wgid / NXCD; wgid = (xcd < r ? xcd * (q + 1) : r * (q + 1) + (xcd - r) * q) + off; }
        const int nig = WGM * nN, gid = wgid / nig, fm = gid * WGM, gsz = (nM - fm) < WGM ? (nM - fm) : WGM;
        u.pm = fm + ((wgid % nig) % gsz); u.pn = (wgid % nig) / gsz; u.Ab = A + (size_t)u.pm * BM * lda * 2; u.Bb = Bt + (size_t)u.pn * BM * ldb * 2; u.aux0 = 0; u.aux1 = 0; return true;
    }
    __device__ __forceinline__ unsigned arow(const Unit& u, int r) const { return (unsigned)r; }
};

#define PG8_ACC f32x4 (&acc)[2][2][4][2]
template <class Epi, class Sched>
__device__ __forceinline__ void gemm_phase(LAS unsigned char* lds, const int K, const int lda, const int ldb, const Sched& S, const Epi& E) {
    const int tid = threadIdx.x, wid = __builtin_amdgcn_readfirstlane(tid >> 6), lane = tid & 63, wr = wid >> 2, wc = wid & 3, fr = lane & 15, fq = lane >> 4;
    const int nt = K / BK;
    int sR[2], sC[2]; unsigned voffB[2];
#pragma unroll
    for (int i = 0; i < 2; ++i) { stage_rc(tid * 16 + i * 8192, sR[i], sC[i]); const int Rb = Epi::PERM ? ((sR[i] & ~31) + perm32(sR[i] & 31)) : sR[i];
        voffB[i] = (unsigned)(Rb * ldb + sC[i]) * 2u; }
    const size_t kstep = (size_t)(BK * 2);
    const size_t hstepB = (size_t)HALF * ldb * 2;
    const unsigned ldsw = (unsigned)wid * 1024u;
    const int aoff = lds_byte(wr * 64 + fr, fq * 8), boff = lds_byte(wc * 32 + fr, fq * 8);
#define PG8_SA(b, h) (((b) * 2 + (h)) * HTB)
#define PG8_SB(b, h) ((4 + (b) * 2 + (h)) * HTB)
#define PG8_STAGE(bufoff, gbase, voff) do { _Pragma("unroll") for (int _i = 0; _i < 2; ++_i) \
        __builtin_amdgcn_global_load_lds((const unsigned*)((const char*)(gbase) + (voff)[_i]), (LAS unsigned*)(lds + (bufoff) + ldsw + _i * 8192), 16, 0, 0); } while (0)
#define PG8_LDA(dst, b, h) do { _Pragma("unroll") for (int m = 0; m < 4; ++m) _Pragma("unroll") for (int k = 0; k < 2; ++k) dst[m][k] = *(const LAS bf16x8*)(lds + PG8_SA(b, h) + aoff + m * 2048 + k * 1024); } while (0)
#define PG8_LDB(dst, b, h) do { _Pragma("unroll") for (int n = 0; n < 2; ++n) _Pragma("unroll") for (int k = 0; k < 2; ++k) dst[n][k] = *(const LAS bf16x8*)(lds + PG8_SB(b, h) + boff + n * 2048 + k * 1024); } while (0)
#define PG8_MMA(ai, bj, At, Bt) do { __builtin_amdgcn_s_setprio(1); _Pragma("unroll") for (int m = 0; m < 4; ++m) _Pragma("unroll") for (int n = 0; n < 2; ++n) _Pragma("unroll") for (int k = 0; k < 2; ++k) \
        acc[ai][bj][m][n] = __builtin_amdgcn_mfma_f32_16x16x32_bf16(Bt[n][k], At[m][k], acc[ai][bj][m][n], 0, 0, 0); __builtin_amdgcn_s_setprio(0); } while (0)
#define PG8_WAIT_V(n) asm volatile("s_waitcnt vmcnt(" #n ")" ::: "memory")
#define PG8_WAIT_L(n) asm volatile("s_waitcnt lgkmcnt(" #n ")" ::: "memory")
#define PG8_BAR __builtin_amdgcn_s_barrier()
#define PG8_SCHED __builtin_amdgcn_sched_barrier(0)
#define PG8_SETVA(dst, u) do { _Pragma("unroll") for (int _h = 0; _h < 2; ++_h) _Pragma("unroll") for (int _i = 0; _i < 2; ++_i) \
        dst[_h][_i] = (S.arow(u, _h * HALF + sR[_i]) * (unsigned)lda + (unsigned)sC[_i]) * 2u; } while (0)
    Unit cur, nxt; int ui = 0;
    if (!S.next(0, cur)) return;
    f32x4 acc[2][2][4][2];
#pragma unroll
    for (int a = 0; a < 2; ++a)
#pragma unroll
        for (int b = 0; b < 2; ++b)
#pragma unroll
            for (int m = 0; m < 4; ++m)
#pragma unroll
                for (int n = 0; n < 2; ++n) acc[a][b][m][n] = (f32x4){0.f, 0.f, 0.f, 0.f};
    bf16x8 At[4][2], B0[2][2], B1[2][2];
    constexpr bool GA = Sched::GATHER;
    unsigned vA[2][2], nvA[2][2];
    PG8_SETVA(vA, cur);
    const char* cA = cur.Ab; const char* cB = cur.Bb;
    PG8_STAGE(PG8_SB(0, 0), cB, voffB); PG8_STAGE(PG8_SA(0, 0), cA, vA[0]); PG8_STAGE(PG8_SB(0, 1), cB + hstepB, voffB); PG8_STAGE(PG8_SA(0, 1), cA, vA[1]);
    if (wr == 1) PG8_BAR;
    PG8_WAIT_V(4); PG8_BAR;
    PG8_STAGE(PG8_SB(1, 0), cB + kstep, voffB); PG8_STAGE(PG8_SA(1, 0), cA + kstep, vA[0]); PG8_STAGE(PG8_SB(1, 1), cB + hstepB + kstep, voffB);
    PG8_WAIT_V(6); PG8_BAR;
    for (;;) {
        const bool has_next = S.next(ui + 1, nxt);
        const char* nA = cA; const char* nB = cB;
        if (has_next) { nA = nxt.Ab; nB = nxt.Bb; if (GA) PG8_SETVA(nvA, nxt); }
        else if (GA) {
#pragma unroll
            for (int h = 0; h < 2; ++h)
#pragma unroll
                for (int i = 0; i < 2; ++i) nvA[h][i] = vA[h][i]; }
#pragma unroll 1
        for (int t = 0; t < nt; t += 2) {
            const bool last = (t == nt - 2);
            const char* a1 = cA + (size_t)(t + 1) * kstep;
            const char* a2 = last ? nA : cA + (size_t)(t + 2) * kstep; const char* b2 = last ? nB : cB + (size_t)(t + 2) * kstep;
            const char* a3 = a2 + kstep; const char* b3 = b2 + kstep;
            unsigned s2[2][2];
#pragma unroll
            for (int h = 0; h < 2; ++h)
#pragma unroll
                for (int i = 0; i < 2; ++i) s2[h][i] = (GA && last) ? nvA[h][i] : vA[h][i];
            PG8_LDB(B0, 0, 0); PG8_SCHED; PG8_LDA(At, 0, 0); PG8_STAGE(PG8_SA(1, 1), a1, vA[1]);
            PG8_WAIT_L(8); PG8_BAR; PG8_WAIT_L(0); PG8_MMA(0, 0, At, B0); PG8_BAR; PG8_SCHED;
            PG8_LDB(B1, 0, 1); PG8_STAGE(PG8_SB(0, 0), b2, voffB);
            PG8_BAR; PG8_WAIT_L(0); PG8_MMA(0, 1, At, B1); PG8_BAR;
            PG8_LDA(At, 0, 1); PG8_STAGE(PG8_SA(0, 0), a2, s2[0]);
            PG8_BAR; PG8_WAIT_L(0); PG8_MMA(1, 0, At, B0); PG8_BAR; PG8_SCHED;
            PG8_STAGE(PG8_SB(0, 1), b2 + hstepB, voffB);
            PG8_WAIT_V(6); PG8_BAR; PG8_MMA(1, 1, At, B1); PG8_BAR;
            PG8_LDB(B0, 1, 0); PG8_SCHED; PG8_LDA(At, 1, 0); PG8_STAGE(PG8_SA(0, 1), a2, s2[1]);
            PG8_WAIT_L(8); PG8_BAR; PG8_WAIT_L(0); PG8_MMA(0, 0, At, B0); PG8_BAR; PG8_SCHED;
            PG8_LDB(B1, 1, 1); PG8_STAGE(PG8_SB(1, 0), b3, voffB);
            PG8_BAR; PG8_WAIT_L(0); PG8_MMA(0, 1, At, B1); PG8_BAR;
            PG8_LDA(At, 1, 1); PG8_STAGE(PG8_SA(1, 0), a3, s2[0]);
            PG8_BAR; PG8_WAIT_L(0); PG8_MMA(1, 0, At, B0); PG8_BAR; PG8_SCHED;
            PG8_STAGE(PG8_SB(1, 1), b3 + hstepB, voffB);
            PG8_WAIT_V(6); PG8_BAR; PG8_MMA(1, 1, At, B1); PG8_BAR;
        }
        { int fr_e = fr, fq_e = fq; asm volatile("" : "+v"(fr_e), "+v"(fq_e));
          E(acc, cur, wr, wc, fr_e, fq_e); }
        if (!has_next) break;
#pragma unroll
        for (int a = 0; a < 2; ++a)
#pragma unroll
            for (int b = 0; b < 2; ++b)
#pragma unroll
                for (int m = 0; m < 4; ++m)
#pragma unroll
                    for (int n = 0; n < 2; ++n) acc[a][b][m][n] = (f32x4){0.f, 0.f, 0.f, 0.f};
        cur = nxt; cA = nA; cB = nB; ++ui;
        if (GA) {
#pragma unroll
        for (int h = 0; h < 2; ++h)
#pragma unroll
            for (int i = 0; i < 2; ++i) vA[h][i] = nvA[h][i]; }
    }
    PG8_WAIT_V(0);
    if (wr == 0) PG8_BAR;
    PG8_BAR;
#undef PG8_SA
#undef PG8_SB
#undef PG8_STAGE
#undef PG8_LDA
#undef PG8_LDB
#undef PG8_MMA
#undef PG8_WAIT_V
#undef PG8_WAIT_L
#undef PG8_BAR
#undef PG8_SCHED
#undef PG8_SETVA
}
#define EPI_FOR(ai, m, bj) _Pragma("unroll") for (int ai = 0; ai < 2; ++ai) _Pragma("unroll") for (int m = 0; m < 4; ++m) _Pragma("unroll") for (int bj = 0; bj < 2; ++bj)
__device__ __forceinline__ u32x4 pack8(f32x4 v0, f32x4 v1) { u32x4 w; w.x = cvt_pk_bf16(v0[0], v0[1]); w.y = cvt_pk_bf16(v0[2], v0[3]); w.z = cvt_pk_bf16(v1[0], v1[1]); w.w = cvt_pk_bf16(v1[2], v1[3]); return w; }
}
using pg8::Unit;

struct EpiG1 {
    static constexpr bool PERM = true;
    const float* rstd; bf16 *zmla, *zrkv, *zlora, *zgate;
    __device__ __forceinline__ void operator()(const PG8_ACC, const Unit& u, int wr, int wc, int fr, int fq) const {
        bf16* base; int ld, c0;
        if (u.pn < 4) { base = zmla; ld = ZM_LD; c0 = u.pn * 256; } else if (u.pn < 28) { base = zrkv; ld = ZR_LD; c0 = (u.pn - 4) * 256; }
        else if (u.pn < 31) { base = zlora; ld = ZL_LD; c0 = (u.pn - 28) * 256; } else { base = zgate; ld = ZG_LD; c0 = (u.pn - 31) * 256; }
        const int col0 = c0 + wc * 32 + 8 * fq;
        EPI_FOR(ai, m, bj) { const int row = u.pm * 256 + ai * 128 + wr * 64 + m * 16 + fr; const float rs = rstd[row];
            *(u32x4*)(base + (size_t)row * ld + col0 + bj * 128) = pg8::pack8(acc[ai][bj][m][0] * rs, acc[ai][bj][m][1] * rs); }
    }
};
struct EpiPlain {
    static constexpr bool PERM = true;
    bf16* O; int ld; const float* rstd; float scale;
    __device__ __forceinline__ void operator()(const PG8_ACC, const Unit& u, int wr, int wc, int fr, int fq) const {
        const int col0 = u.pn * 256 + wc * 32 + 8 * fq;
        EPI_FOR(ai, m, bj) { const int row = u.pm * 256 + ai * 128 + wr * 64 + m * 16 + fr; const float rs = (rstd ? rstd[row] : 1.f) * scale;
            *(u32x4*)(O + (size_t)row * ld + col0 + bj * 128) = pg8::pack8(acc[ai][bj][m][0] * rs, acc[ai][bj][m][1] * rs); }
    }
};
constexpr float QSCALE = 0.07216878364870322f * 1.4426950408889634f;
constexpr float CSCALE = 0.08838834764831845f * 1.4426950408889634f;
struct EpiQ {
    static constexpr bool PERM = true;
    bf16* Q; const float* rstd; const float* cs;
    __device__ __forceinline__ void operator()(const PG8_ACC, const Unit& u, int wr, int wc, int fr, int fq) const {
        EPI_FOR(ai, m, bj) { const int row = u.pm * 256 + ai * 128 + wr * 64 + m * 16 + fr; const int col = u.pn * 256 + bj * 128 + wc * 32 + 8 * fq;
            const float rs = rstd[row] * QSCALE; f32x4 v0 = acc[ai][bj][m][0] * rs, v1 = acc[ai][bj][m][1] * rs;
            const int cih = col % QKD;
            if (cih >= NOPE) { const int i0 = (cih - NOPE) >> 1; const f32x4* t = (const f32x4*)(cs + ((size_t)row * 32 + i0) * 2);
                const f32x4 a = t[0], b = t[1];
                f32x4 r0, r1;
                r0[0] = v0[0] * a[0] - v0[1] * a[1]; r0[1] = v0[1] * a[0] + v0[0] * a[1]; r0[2] = v0[2] * a[2] - v0[3] * a[3]; r0[3] = v0[3] * a[2] + v0[2] * a[3];
                r1[0] = v1[0] * b[0] - v1[1] * b[1]; r1[1] = v1[1] * b[0] + v1[0] * b[1]; r1[2] = v1[2] * b[2] - v1[3] * b[3]; r1[3] = v1[3] * b[2] + v1[2] * b[3];
                v0 = r0; v1 = r1; }
            *(u32x4*)(Q + (size_t)row * (MH * QKD) + col) = pg8::pack8(v0, v1); }
    }
};
struct EpiKV {
    static constexpr bool PERM = true;
    bf16* Kb; bf16* Vb; const float* rstd;
    __device__ __forceinline__ void operator()(const PG8_ACC, const Unit& u, int wr, int wc, int fr, int fq) const {
        const int c = wc * 32 + 8 * fq;
        EPI_FOR(ai, m, bj) { const int row = u.pm * 256 + ai * 128 + wr * 64 + m * 16 + fr; const float rs = rstd[row];
            bf16* dst = bj == 0 ? Kb + (size_t)row * (MH * QKD) + u.pn * QKD + c : Vb + (size_t)row * (MH * VDIM) + u.pn * VDIM + c;
            *(u32x4*)dst = pg8::pack8(acc[ai][bj][m][0] * rs, acc[ai][bj][m][1] * rs); }
    }
};
template <int MODE> struct EpiLora {
    static constexpr bool PERM = true;
    bf16* O; const float* bias;
    __device__ __forceinline__ void operator()(const PG8_ACC, const Unit& u, int wr, int wc, int fr, int fq) const {
        EPI_FOR(ai, m, bj) { const int row = u.pm * 256 + ai * 128 + wr * 64 + m * 16 + fr; const int col = u.pn * 256 + bj * 128 + wc * 32 + 8 * fq;
            f32x4 v0 = acc[ai][bj][m][0], v1 = acc[ai][bj][m][1];
            if (MODE != 2) { const f32x4 b0 = *(const f32x4*)(bias + col), b1 = *(const f32x4*)(bias + col + 4);
#pragma unroll
                for (int j = 0; j < 4; ++j) { float s0 = sigmoidf_(v0[j] + b0[j]), s1 = sigmoidf_(v1[j] + b1[j]);
                    if (MODE == 0) { s0 *= -0.8750394f; s1 *= -0.8750394f; }
                    v0[j] = s0; v1[j] = s1; } }
            *(u32x4*)(O + (size_t)row * RW + col) = pg8::pack8(v0, v1); }
    }
};
template <int MODE> struct EpiLora2 {
    static constexpr bool PERM = true;
    bf16* O0; bf16* O1; const float* bias0; const float* bias1;
    __device__ __forceinline__ void operator()(const PG8_ACC, const Unit& u, int wr, int wc, int fr, int fq) const {
        const bool second = u.pn >= 8; bf16* O = second ? O1 : O0; const float* bias = second ? bias1 : bias0; const int pn = second ? u.pn - 8 : u.pn;
        EPI_FOR(ai, m, bj) { const int row = u.pm * 256 + ai * 128 + wr * 64 + m * 16 + fr; const int col = pn * 256 + bj * 128 + wc * 32 + 8 * fq;
            f32x4 v0 = acc[ai][bj][m][0], v1 = acc[ai][bj][m][1];
            const f32x4 b0 = *(const f32x4*)(bias + col), b1 = *(const f32x4*)(bias + col + 4);
#pragma unroll
            for (int j = 0; j < 4; ++j) { float s0 = sigmoidf_(v0[j] + b0[j]), s1 = sigmoidf_(v1[j] + b1[j]);
                if (MODE == 0) { s0 *= -0.8750394f; s1 *= -0.8750394f; }
                v0[j] = s0; v1[j] = s1; }
            *(u32x4*)(O + (size_t)row * RW + col) = pg8::pack8(v0, v1); }
    }
};
template <int SECOND> struct EpiUp {
    static constexpr bool PERM = true;
    bf16* O; const bf16* zg; int goff;
    __device__ __forceinline__ void operator()(const PG8_ACC, const Unit& u, int wr, int wc, int fr, int fq) const {
        EPI_FOR(ai, m, bj) { const int row = u.pm * 256 + ai * 128 + wr * 64 + m * 16 + fr; const int col = u.pn * 256 + bj * 128 + wc * 32 + 8 * fq;
            const u32x4 g = *(const u32x4*)(zg + (size_t)row * ZG_LD + goff + col);
            f32x4 v0 = acc[ai][bj][m][0], v1 = acc[ai][bj][m][1];
            v0[0] *= sigmoidf_(bflo(g.x)); v0[1] *= sigmoidf_(bfhi(g.x)); v0[2] *= sigmoidf_(bflo(g.y)); v0[3] *= sigmoidf_(bfhi(g.y));
            v1[0] *= sigmoidf_(bflo(g.z)); v1[1] *= sigmoidf_(bfhi(g.z)); v1[2] *= sigmoidf_(bflo(g.w)); v1[3] *= sigmoidf_(bfhi(g.w));
            bf16* dst = O + (size_t)row * DM + col;
            if (SECOND) { const u32x4 p = *(const u32x4*)dst;
                v0[0] += bflo(p.x); v0[1] += bfhi(p.x); v0[2] += bflo(p.y); v0[3] += bfhi(p.y); v1[0] += bflo(p.z); v1[1] += bfhi(p.z); v1[2] += bflo(p.w); v1[3] += bfhi(p.w); }
            *(u32x4*)dst = pg8::pack8(v0, v1); }
    }
};
struct EpiResid {
    static constexpr bool PERM = true;
    const float* base; float* out;
    __device__ __forceinline__ void operator()(const PG8_ACC, const Unit& u, int wr, int wc, int fr, int fq) const {
        EPI_FOR(ai, m, bj) { const int row = u.pm * 256 + ai * 128 + wr * 64 + m * 16 + fr; const int col = u.pn * 256 + bj * 128 + wc * 32 + 8 * fq;
            const size_t o = (size_t)row * DM + col; const f32x4 b0 = *(const f32x4*)(base + o), b1 = *(const f32x4*)(base + o + 4);
            *(f32x4*)(out + o) = b0 + acc[ai][bj][m][0]; *(f32x4*)(out + o + 4) = b1 + acc[ai][bj][m][1]; }
    }
};

namespace att {
constexpr int NW = 8, QBLK = 32, KVBLK = 64;
constexpr float THRL = 11.5f;
#define SBAR() __builtin_amdgcn_sched_barrier(0)
__device__ __forceinline__ int crow(int r, int hi) { return (r & 3) + 8 * (r >> 2) + 4 * hi; }
__device__ __forceinline__ void partialSM(f32x16& p, float& m_reg, float& alpha) {
    float pmax = p[0];
#pragma unroll
    for (int r = 1; r < 16; ++r) pmax = fmaxf(pmax, p[r]);
    { auto rr = __builtin_amdgcn_permlane32_swap(__float_as_uint(pmax), __float_as_uint(pmax), false, false);
      pmax = fmaxf(__uint_as_float(rr[0]), __uint_as_float(rr[1])); }
    float mn;
    if (__builtin_expect(__all(pmax - m_reg <= THRL), 1)) { mn = m_reg; alpha = 1.f; }
    else { mn = fmaxf(m_reg, pmax); alpha = __builtin_amdgcn_exp2f(m_reg - mn); m_reg = mn; }
#pragma unroll
    for (int r = 0; r < 16; ++r) p[r] = p[r] - mn;
#pragma unroll
    for (int r = 0; r < 8; ++r) p[r] = __builtin_amdgcn_exp2f(p[r]);
}
__device__ __forceinline__ void finishSM(f32x16& p, float alpha, float& l_reg, bf16x8& pa0, bf16x8& pa1) {
#pragma unroll
    for (int r = 8; r < 16; ++r) p[r] = __builtin_amdgcn_exp2f(p[r]);
    float ps = 0;
#pragma unroll
    for (int r = 0; r < 16; ++r) ps += p[r];
    { auto rr = __builtin_amdgcn_permlane32_swap(__float_as_uint(ps), __float_as_uint(ps), false, false);
      ps = __uint_as_float(rr[0]) + __uint_as_float(rr[1]); }
    l_reg = l_reg * alpha + ps;
#define PK4(P, BASE, OUT) do { unsigned a0 = cvt_pk_bf16(P[BASE + 0], P[BASE + 1]), a1 = cvt_pk_bf16(P[BASE + 2], P[BASE + 3]);   \
    unsigned b0 = cvt_pk_bf16(P[BASE + 4], P[BASE + 5]), b1 = cvt_pk_bf16(P[BASE + 6], P[BASE + 7]);                              \
    auto r0 = __builtin_amdgcn_permlane32_swap(a0, b0, false, false); auto r1 = __builtin_amdgcn_permlane32_swap(a1, b1, false, false); \
    u32x4 w = {r0[0], r1[0], r0[1], r1[1]}; OUT = *reinterpret_cast<bf16x8*>(&w); } while (0)
    PK4(p, 0, pa0); PK4(p, 8, pa1);
#undef PK4
}
template <int DQK> __device__ __forceinline__ int kswz(int row, int colB) { return row * (DQK * 2 + 16) + colB; }
template <int DQK> __device__ __forceinline__ void qkt(f32x16& p, const LAS char* Ks, const bf16x8* qr, int krow, int hi) {
    p = f32x16{};
#pragma unroll
    for (int d0 = 0; d0 < DQK / 16; ++d0) { const int cb = (d0 * 16 + hi * 8) * 2;
        bf16x8 b0 = *reinterpret_cast<const LAS bf16x8*>(Ks + kswz<DQK>(krow, cb));
        p = __builtin_amdgcn_mfma_f32_32x32x16_bf16(b0, qr[d0], p, 0, 0, 0); }
}
__device__ __forceinline__ int v_st(int k, int c) { const int kk = (k & ~0xC) | ((k & 4) << 1) | ((k & 8) >> 1); return ((kk >> 3) * 4 + (c >> 5)) * 512 + ((kk & 7) * 32 + (c & 31)) * 2; }
__device__ __forceinline__ int v_rd_base(int lane) { return ((lane & 3) << 3) | (((lane >> 2) & 3) << 6) | (((lane >> 4) & 1) << 5) | (((lane >> 5) & 1) << 8); }
constexpr int v_rd_off(int d0, int ks, int half) { return d0 * 512 + ks * 4096 + half * 2048; }
template <int OFF> __device__ __forceinline__ s16x4 tr_read(int vb) {
    s16x4 r; asm volatile("ds_read_b64_tr_b16 %0, %1 offset:%2" : "=&v"(r) : "v"(vb), "i"(OFF) : "memory"); return r;
}
template <int D0, int KH> __device__ __forceinline__ void pv_one(f32x16& od, int vb, bf16x8 pa0, bf16x8 pa1) {
    const s16x4 l0 = tr_read<v_rd_off(D0, 2 * KH, 0)>(vb), h0 = tr_read<v_rd_off(D0, 2 * KH, 1)>(vb), l1 = tr_read<v_rd_off(D0, 2 * KH + 1, 0)>(vb), h1 = tr_read<v_rd_off(D0, 2 * KH + 1, 1)>(vb);
    asm volatile("s_waitcnt lgkmcnt(0)" ::: "memory"); SBAR();
#define PK(L, H) (bf16x8){L[0], L[1], L[2], L[3], H[0], H[1], H[2], H[3]}
    od = __builtin_amdgcn_mfma_f32_32x32x16_bf16(pa0, PK(l0, h0), od, 0, 0, 0);
    od = __builtin_amdgcn_mfma_f32_32x32x16_bf16(pa1, PK(l1, h1), od, 0, 0, 0);
#undef PK
}
template <int KH> __device__ __forceinline__ void pv_d0(f32x16* o, int vb, bf16x8 pa0, bf16x8 pa1) {
    pv_one<0, KH>(o[0], vb, pa0, pa1); pv_one<1, KH>(o[1], vb, pa0, pa1); pv_one<2, KH>(o[2], vb, pa0, pa1); pv_one<3, KH>(o[3], vb, pa0, pa1);
}
template <int DQK, int LDQ, int LDK, int LDV, int LDO>
__device__ __forceinline__ void attn_unit(const bf16* __restrict__ Qb, const bf16* __restrict__ Kh, const bf16* __restrict__ Vh, bf16* __restrict__ Ob, const int seq, LAS char* lds) {
    constexpr int SHM_V = KVBLK * 128 * 2, SHM_K = KVBLK * (DQK * 2 + 16), KCH = DQK / 64;
    const int tid = threadIdx.x, wid = tid >> 6, lane = tid & 63, r32 = lane & 31, hi = lane >> 5;
    LAS char* V_lds = lds; LAS char* K_lds = lds + 2 * SHM_V;
    LAS float* wsf = (LAS float*)(lds + 2 * SHM_V + 2 * SHM_K) + wid * 64; LAS float* li_l = wsf; LAS float* al_l = wsf + 32;
    float m_reg = -1e30f, l_reg = 0; f32x16 o[4] = {}; bf16x8 qr[DQK / 16];
    const bf16* Qw = Qb + (long)(wid * QBLK + r32) * LDQ + hi * 8;
#pragma unroll
    for (int d0 = 0; d0 < DQK / 16; ++d0) qr[d0] = *reinterpret_cast<const bf16x8*>(Qw + d0 * 16);
    const int sr = tid >> 4, sc = (tid & 15) * 8, vst0 = v_st(sr, sc), vst1 = v_st(32 + sr, sc);
    unsigned kgo[KCH]; int klo[KCH];
#pragma unroll
    for (int i = 0; i < KCH; ++i) { const int id = tid + 512 * i, row = id / (DQK / 8), c8 = id % (DQK / 8); kgo[i] = (unsigned)(row * LDK + c8 * 8) * 2u; klo[i] = kswz<DQK>(row, c8 * 16); }
    const unsigned vgo0 = (unsigned)(sr * LDV + sc) * 2u, vgo1 = (unsigned)((32 + sr) * LDV + sc) * 2u;
    const int vb0 = (int)(uintptr_t)V_lds + v_rd_base(lane);
    bf16x8 vs0, vs1, ks[KCH];
#define SLOAD(k0) do { const char* _vt = (const char*)(Vh + (size_t)(k0) * LDV); const char* _kt = (const char*)(Kh + (size_t)(k0) * LDK); \
    vs0 = *reinterpret_cast<const bf16x8*>(_vt + vgo0); vs1 = *reinterpret_cast<const bf16x8*>(_vt + vgo1); \
    _Pragma("unroll") for (int _i = 0; _i < KCH; ++_i) ks[_i] = *reinterpret_cast<const bf16x8*>(_kt + kgo[_i]); } while (0)
#define SWRITE(b) do { *(LAS bf16x8*)(V_lds + (b) * SHM_V + vst0) = vs0; *(LAS bf16x8*)(V_lds + (b) * SHM_V + vst1) = vs1; \
    _Pragma("unroll") for (int _i = 0; _i < KCH; ++_i) *(LAS bf16x8*)(K_lds + (b) * SHM_K + klo[_i]) = ks[_i]; } while (0)
#define SWAIT() asm volatile("s_waitcnt vmcnt(0)" ::: "memory")
#define RESC(a) do { if (__any((a) < 1.f)) { if (hi == 0) al_l[r32] = (a); asm volatile("s_waitcnt lgkmcnt(0)" ::: "memory"); \
    _Pragma("unroll") for (int d = 0; d < 4; ++d) _Pragma("unroll") for (int r = 0; r < 16; ++r) o[d][r] *= al_l[crow(r, hi)]; } } while (0)
    f32x16 pA, pB; float alA, alB; bf16x8 pa0, pa1; const int NT = seq / KVBLK;
    SLOAD(0); SWAIT(); SWRITE(0); __syncthreads();
    if (1 < NT) SLOAD(KVBLK);
    qkt<DQK>(pA, K_lds, qr, r32, hi); partialSM(pA, m_reg, alA);
    if (1 < NT) { SWAIT(); SWRITE(1); } __syncthreads();
    if (2 < NT) SLOAD(2 * KVBLK);
    SBAR(); qkt<DQK>(pB, K_lds, qr, 32 + r32, hi);
    finishSM(pA, alA, l_reg, pa0, pa1); SBAR();
    pv_d0<0>(o, vb0, pa0, pa1); partialSM(pB, m_reg, alB); RESC(alB);
    for (int j = 1; j < NT; ++j) {
        const int cb = j & 1, pb = cb ^ 1;
        SBAR(); qkt<DQK>(pA, K_lds + cb * SHM_K, qr, r32, hi);
        finishSM(pB, alB, l_reg, pa0, pa1); SBAR();
        pv_d0<1>(o, vb0 + pb * SHM_V, pa0, pa1); partialSM(pA, m_reg, alA);
        __syncthreads(); if (j + 1 < NT) { SWAIT(); SWRITE(pb); }
        RESC(alA); __syncthreads();
        if (j + 2 < NT) SLOAD((j + 2) * KVBLK);
        SBAR(); qkt<DQK>(pB, K_lds + cb * SHM_K, qr, 32 + r32, hi);
        finishSM(pA, alA, l_reg, pa0, pa1); SBAR();
        pv_d0<0>(o, vb0 + cb * SHM_V, pa0, pa1); partialSM(pB, m_reg, alB); RESC(alB);
    }
    finishSM(pB, alB, l_reg, pa0, pa1); SBAR();
    pv_d0<1>(o, vb0 + ((NT - 1) & 1) * SHM_V, pa0, pa1);
    if (hi == 0) li_l[r32] = l_reg; asm volatile("s_waitcnt lgkmcnt(0)" ::: "memory");
    float rli[16];
#pragma unroll
    for (int r = 0; r < 16; ++r) rli[r] = __builtin_amdgcn_rcpf(li_l[crow(r, hi)]);
    bf16* Ow = Ob + (size_t)(wid * QBLK) * LDO;
    int r32e = r32, hie = hi; asm volatile("" : "+v"(r32e), "+v"(hie));
    const unsigned ob = (unsigned)(4 * hie * LDO + r32e);
#pragma unroll
    for (int r = 0; r < 16; ++r) {
#pragma unroll
        for (int d0 = 0; d0 < 4; ++d0) Ow[ob + (unsigned)(((r & 3) + 8 * (r >> 2)) * LDO + d0 * 32)] = f2bf(o[d0][r] * rli[r]); }
    __syncthreads();
#undef SLOAD
#undef SWRITE
#undef SWAIT
#undef RESC
}
}

struct Frame {
    LAS unsigned char* lds; volatile LAS unsigned* MISC; unsigned* ctl;
    int tid, lane, wave, vcu, G;
    unsigned char* ws; float* out;
    const float* in[41];
};
enum { I_X = 0, I_MEM, I_POS, I_GMIX, I_WIN, I_GQ, I_WUQ, I_GKV, I_WUKV, I_SHIFT, I_W0F, I_W2F, I_W0B, I_W2B, I_A0F, I_A2F, I_A0B, I_A2B, I_G2, I_KK, I_KA, I_RK,
       I_LNXG, I_LNXB, I_WUPM, I_WUPR, I_WOUT, I_GCROSS, I_GMEM, I_WQC, I_WKVC, I_WOC, I_GFFN, I_WRG, I_BRG, I_WRE, I_BRE, I_WEG, I_WEU, I_WED, I_GFINAL };

template <int MODE> __device__ __forceinline__ int rowmap(int n) {
    if (MODE == 1) {
        if (n < 768) return n;
        if (n < 832) { const int p = n - 768; return 768 + (p < 32 ? 2 * p : 2 * (p - 32) + 1); }
        if (n < 6976) return 1024 + (n - 832);
        if (n < 7616) return 7168 + (n - 6976);
        return 7936 + (n - 7616);
    }
    if (MODE == 2) {
        const int h = n / QKD, d = n % QKD; if (d < NOPE) return n; const int p = d - NOPE; return h * QKD + NOPE + (p < 32 ? 2 * p : 2 * (p - 32) + 1);
    }
    if (MODE == 3) return (n >> 7) * 256 + (n & 127);
    if (MODE == 4) return (n >> 7) * 256 + 128 + (n & 127);
    return n;
}
constexpr int CVT_SCR = 16640;
template <int MODE> __device__ __forceinline__ void cvt_item(const float* W, int K, int N, const float* gain, bf16* WT, int ldt, LAS float* scr, int item, int lane, int kofs = 0) {
    const int nblk = N / 64, kb = item / nblk, nb = item % nblk, k0 = 64 * kb, n0 = 64 * nb;
    const int kq = lane >> 4, nc = (lane & 15) * 4;
    f32x4 v[16];
#pragma unroll
    for (int i = 0; i < 16; ++i) { const int k = k0 + 4 * i + kq - kofs; v[i] = (f32x4){0.f, 0.f, 0.f, 0.f};
        if (k >= 0 && k < K) { v[i] = *(const f32x4*)(W + (size_t)k * N + n0 + nc); if (gain) v[i] = v[i] * gain[k]; } }
#pragma unroll
    for (int i = 0; i < 16; ++i) { const int kk = 4 * i + kq;
#pragma unroll
        for (int c = 0; c < 4; ++c) scr[(nc + c) * 65 + kk] = v[i][c]; }
    LDS_WAIT(); asm volatile("" ::: "memory");
    const int kc = (lane & 7) * 8;
#pragma unroll
    for (int jj = 0; jj < 8; ++jj) { const int n = (lane >> 3) + 8 * jj; const LAS float* s = scr + n * 65 + kc;
        u32x4 o; o.x = cvt_pk_bf16(s[0], s[1]); o.y = cvt_pk_bf16(s[2], s[3]); o.z = cvt_pk_bf16(s[4], s[5]); o.w = cvt_pk_bf16(s[6], s[7]);
        *(u32x4*)(WT + (size_t)rowmap<MODE>(n0 + n) * ldt + k0 + kc) = o; }
    LDS_WAIT(); asm volatile("" ::: "memory");
}
#define CVT_JOB(MODE, src, K, N, gain, dst, ldt) { const int _n = (((K) + 63) / 64) * ((N) / 64); if (r < _n) { cvt_item<MODE>(src, K, N, gain, dst, ldt, scr, r, F.lane); continue; } r -= _n; }
#define CVT_JOB_PAD(src, K, N, dst, KPAD, KOFS) { const int _n = ((KPAD) / 64) * ((N) / 64); if (r < _n) { cvt_item<0>(src, K, N, nullptr, dst, KPAD, scr, r, F.lane, KOFS); continue; } r -= _n; }
struct CvtD { const float* W; const float* gain; bf16* WT; int K, N, ldt, mode, kofs, item; };
__device__ __forceinline__ int rowmap_rt(int mode, int n) { return mode == 1 ? rowmap<1>(n) : mode == 2 ? rowmap<2>(n) : mode == 3 ? rowmap<3>(n) : mode == 4 ? rowmap<4>(n) : n; }
__device__ __forceinline__ void cvt_load(const CvtD& d, int lane, f32x4 (&v)[16], float (&g)[16]) {
    const int nblk = d.N / 64, kb = d.item / nblk, nb = d.item % nblk, k0 = 64 * kb, n0 = 64 * nb; const int kq = lane >> 4, nc = (lane & 15) * 4;
#pragma unroll
    for (int i = 0; i < 16; ++i) { const int k = k0 + 4 * i + kq - d.kofs; v[i] = (f32x4){0.f, 0.f, 0.f, 0.f}; g[i] = 1.f;
        if (k >= 0 && k < d.K) { v[i] = *(const f32x4*)(d.W + (size_t)k * d.N + n0 + nc); if (d.gain) g[i] = d.gain[k]; } }
}
__device__ __forceinline__ void cvt_process(const CvtD& d, int lane, f32x4 (&v)[16], float (&g)[16], LAS float* scr) {
    const int nblk = d.N / 64, kb = d.item / nblk, nb = d.item % nblk, k0 = 64 * kb, n0 = 64 * nb; const int kq = lane >> 4, nc = (lane & 15) * 4;
#pragma unroll
    for (int i = 0; i < 16; ++i) { const int kk = 4 * i + kq;
#pragma unroll
        for (int c = 0; c < 4; ++c) scr[(nc + c) * 65 + kk] = v[i][c] * g[i]; }
    LDS_WAIT(); asm volatile("" ::: "memory");
    const int kc = (lane & 7) * 8;
#pragma unroll
    for (int jj = 0; jj < 8; ++jj) { const int n = (lane >> 3) + 8 * jj; const LAS float* s = scr + n * 65 + kc;
        u32x4 o; o.x = cvt_pk_bf16(s[0], s[1]); o.y = cvt_pk_bf16(s[2], s[3]); o.z = cvt_pk_bf16(s[4], s[5]); o.w = cvt_pk_bf16(s[6], s[7]);
        *(u32x4*)(d.WT + (size_t)rowmap_rt(d.mode, n0 + n) * d.ldt + k0 + kc) = o; }
    LDS_WAIT(); asm volatile("" ::: "memory");
}
#define CVT_PIPE(TOTAL_, DESC_) do { CvtD dA, dB; f32x4 vA[16], vB[16]; float gA[16], gB[16]; int it = gw; \
        if (it < (TOTAL_)) { DESC_(it, dA); cvt_load(dA, F.lane, vA, gA); } \
        for (; it < (TOTAL_); it += 2 * NGW) { const int itn = it + NGW, itn2 = it + 2 * NGW; \
            if (itn < (TOTAL_)) { DESC_(itn, dB); cvt_load(dB, F.lane, vB, gB); } \
            cvt_process(dA, F.lane, vA, gA, scr); \
            if (itn2 < (TOTAL_)) { DESC_(itn2, dA); cvt_load(dA, F.lane, vA, gA); } \
            if (itn < (TOTAL_)) cvt_process(dB, F.lane, vB, gB, scr); } } while (0)

__device__ __forceinline__ void p0_prologue(Frame& F) {
    LAS float* scr = (LAS float*)(F.lds + F.wave * CVT_SCR);
    const int gw = F.vcu * 8 + F.wave, NGW = F.G * 8;
    unsigned char* ws = F.ws;
    constexpr int TOTAL = 32 * (IN_W / 64) + 8 * 48 + 4 * 64 + 4 * (4 * 32) + 4 * 32 + 3 * (32 * 32) + 32 * 8 + 32 * 16 + 8 * 32;
#define P0_SETD(d, mode_, src_, K_, N_, gain_, dst_, ldt_, KPAD_, KOFS_) { const int _n = ((KPAD_) / 64) * ((N_) / 64); if (r < _n) { d.W = src_; d.gain = gain_; d.WT = dst_; d.K = K_; d.N = N_; d.ldt = ldt_; d.mode = mode_; d.kofs = KOFS_; d.item = r; break; } r -= _n; }
#define P0_DESC(it_, d) do { int r = (it_); \
        P0_SETD(d, 1, F.in[I_WIN], DM, IN_W, F.in[I_GMIX], (bf16*)(ws + WS_WIN), DM, DM, 0) \
        P0_SETD(d, 2, F.in[I_WUQ], QLORA, MH * QKD, F.in[I_GQ], (bf16*)(ws + WS_WUQ), QLORA, QLORA, 0) \
        P0_SETD(d, 0, F.in[I_WUKV], KVLORA, MH * 256, F.in[I_GKV], (bf16*)(ws + WS_WUKV), KVLORA, KVLORA, 0) \
        P0_SETD(d, 0, F.in[I_W2F], DLORA, RW, nullptr, (bf16*)(ws + WS_W2F), 256, 256, 0) \
        P0_SETD(d, 0, F.in[I_W2B], DLORA, RW, nullptr, (bf16*)(ws + WS_W2F + 1 * MiB), 256, 256, 128) \
        P0_SETD(d, 0, F.in[I_A2F], DLORA, RW, nullptr, (bf16*)(ws + WS_W2F + 2 * MiB), 256, 256, 0) \
        P0_SETD(d, 0, F.in[I_A2B], DLORA, RW, nullptr, (bf16*)(ws + WS_W2F + 3 * MiB), 256, 256, 128) \
        P0_SETD(d, 0, F.in[I_G2], GLORA, RW, nullptr, (bf16*)(ws + WS_G2), GLORA, GLORA, 0) \
        P0_SETD(d, 0, F.in[I_WUPM], DM, DM, nullptr, (bf16*)(ws + WS_WUPM), DM, DM, 0) \
        P0_SETD(d, 0, F.in[I_WUPR], DM, DM, nullptr, (bf16*)(ws + WS_WUPR), DM, DM, 0) \
        P0_SETD(d, 0, F.in[I_WOUT], DM, DM, nullptr, (bf16*)(ws + WS_WOUT), DM, DM, 0) \
        P0_SETD(d, 0, F.in[I_WQC], DM, CW, F.in[I_GCROSS], (bf16*)(ws + WS_WQC), DM, DM, 0) \
        P0_SETD(d, 0, F.in[I_WKVC], DM, 2 * CW, nullptr, (bf16*)(ws + WS_WKVC), DM, DM, 0) \
        P0_SETD(d, 0, F.in[I_WOC], CW, DM, nullptr, (bf16*)(ws + WS_WOC), CW, CW, 0) \
    } while (0)
    CVT_PIPE(TOTAL, P0_DESC);
#undef P0_SETD
#undef P0_DESC
    const float* x = F.in[I_X]; bf16* xb = (bf16*)(ws + WS_XB); float* rstd1 = (float*)(ws + WS_RSTD);
    for (int m = gw; m < MT + NB * MEMLEN; m += NGW) {
        const bool ismem = m >= MT; const int mm = ismem ? m - MT : m;
        const f32x4* xr = (const f32x4*)((ismem ? F.in[I_MEM] : x) + (size_t)mm * DM) + F.lane;
        f32x4 v[8]; float s = 0.f;
#pragma unroll
        for (int j = 0; j < 8; ++j) { v[j] = xr[64 * j]; s += (v[j].x * v[j].x + v[j].y * v[j].y) + (v[j].z * v[j].z + v[j].w * v[j].w); }
        const float rs = 1.0f / sqrtf(wave_sum(s) * (1.f / DM) + RMS_EPS);
        if (!ismem) { if (F.lane == 0) rstd1[mm] = rs;
            u32x2* o8 = (u32x2*)(xb + (size_t)mm * DM) + F.lane;
#pragma unroll
            for (int j = 0; j < 8; ++j) { u32x2 w; w.x = cvt_pk_bf16(v[j].x, v[j].y); w.y = cvt_pk_bf16(v[j].z, v[j].w); o8[64 * j] = w; }
        } else { const f32x4* gr = (const f32x4*)F.in[I_GMEM] + F.lane;
            u32x2* o8 = (u32x2*)((bf16*)(ws + WS_MEMN) + (size_t)mm * DM) + F.lane;
#pragma unroll
            for (int j = 0; j < 8; ++j) { const f32x4 g = gr[64 * j]; u32x2 w; w.x = cvt_pk_bf16(v[j].x * rs * g.x, v[j].y * rs * g.y); w.y = cvt_pk_bf16(v[j].z * rs * g.z, v[j].w * rs * g.w); o8[64 * j] = w; }
        }
    }
    const int gt = F.vcu * 512 + F.tid, NGT = F.G * 512;
    { const int* pos = (const int*)F.in[I_POS]; f32x2* cs = (f32x2*)(ws + WS_ROPE);
      for (int i = gt; i < MT * 32; i += NGT) { const int t = i >> 5, f = i & 31;
          const float inv = exp2f(-(float)f * (13.287712379549449f / 32.0f));
          const float ang = (float)pos[t] * inv;
          const double a = (double)ang; const double k = rint(a * 0.15915494309189535); const float red = (float)(a - k * 6.283185307179586);
          cs[i] = (f32x2){cosf(red), sinf(red)}; } }
    { float* WR = (float*)(ws + WS_WR); const float* gf = F.in[I_GFFN];
      for (int i = gt; i < DM * 36; i += NGT) { const int k = i / 36, c = i % 36; float w;
          if (c < 4) w = F.in[I_WRG][k * 4 + c]; else { const int gi = (c - 4) >> 3, e = (c - 4) & 7; w = F.in[I_WRE][((size_t)gi * DM + k) * 8 + e]; }
          WR[i] = w * gf[k]; } }
}

__device__ __forceinline__ void p_final(Frame& F, bool with_moe) {
    const int gw = F.vcu * 8 + F.wave, NGW = F.G * 8;
    const f32x4* gr = (const f32x4*)F.in[I_GFINAL] + F.lane;
    const int* route = (const int*)(F.ws + WS_ROUTE); const bf16* ybuf = (const bf16*)(F.ws + WS_YBUF);
    const int* cnts = (const int*)(F.ctl + CW_CNT);
    for (int m = gw; m < MT; m += NGW) {
        f32x4* xr = (f32x4*)(F.out + (size_t)m * DM) + F.lane;
        f32x4 v[8];
#pragma unroll
        for (int j = 0; j < 8; ++j) v[j] = xr[64 * j];
        if (with_moe) {
#pragma unroll
            for (int kx = 0; kx < 2; ++kx) { const int e = route[m * 8 + 2 * kx], pos = route[m * 8 + 2 * kx + 1];
                int base = 0; for (int q = 0; q < e; ++q) base += (cnts[64 * q] + 255) & ~255;
                const u32x2* yr = (const u32x2*)(ybuf + (size_t)(base + pos) * DM) + F.lane;
#pragma unroll
                for (int j = 0; j < 8; ++j) { const u32x2 w = yr[64 * j]; v[j].x += bflo(w.x); v[j].y += bfhi(w.x); v[j].z += bflo(w.y); v[j].w += bfhi(w.y); } }
        }
        float s = 0.f;
#pragma unroll
        for (int j = 0; j < 8; ++j) s += (v[j].x * v[j].x + v[j].y * v[j].y) + (v[j].z * v[j].z + v[j].w * v[j].w);
        const float rs = 1.0f / sqrtf(wave_sum(s) * (1.f / DM) + RMS_EPS);
#pragma unroll
        for (int j = 0; j < 8; ++j) { const f32x4 g = gr[64 * j]; xr[64 * j] = (f32x4){v[j].x * rs * g.x, v[j].y * rs * g.y, v[j].z * rs * g.z, v[j].w * rs * g.w}; }
    }
}
__device__ __forceinline__ void p_copy_x(Frame& F) {
    const int gt = F.vcu * 512 + F.tid, NGT = F.G * 512; const f32x4* s = (const f32x4*)F.in[I_X]; f32x4* d = (f32x4*)F.out;
    for (int i = gt; i < MT * DM / 4; i += NGT) d[i] = s[i];
}

__device__ __forceinline__ void p2_rowpass(Frame& F) {
    const int gw = F.vcu * 8 + F.wave, NGW = F.G * 8, l = F.lane;
    unsigned char* ws = F.ws;
    const bf16* zm = (const bf16*)(ws + WS_ZMLA); const bf16* zl = (const bf16*)(ws + WS_ZLORA); bf16* la = (bf16*)(ws + WS_LORAA);
    float* rstd_q = (float*)(ws + WS_RSTD) + MT; float* rstd_kv = (float*)(ws + WS_RSTD) + 2 * MT;
    const f32x2* cs = (const f32x2*)(ws + WS_ROPE); bf16* Kb = (bf16*)(ws + WS_K);
    const float* sh = F.in[I_SHIFT] + 6144;
    f32x2 s0[5], s1[5], s2[5];
#pragma unroll
    for (int i = 0; i < 5; ++i) { const int j = 2 * l + 128 * i; s0[i] = *(const f32x2*)(sh + j); s1[i] = *(const f32x2*)(sh + RWKV_IN + j); s2[i] = *(const f32x2*)(sh + 2 * RWKV_IN + j); }
    for (int t = gw; t < MT; t += NGW) {
        const bf16* zr = zm + (size_t)t * ZM_LD;
        { const u32x4 w = *((const u32x4*)zr + l); float s = 0.f;
          s += bflo(w.x) * bflo(w.x) + bfhi(w.x) * bfhi(w.x) + bflo(w.y) * bflo(w.y) + bfhi(w.y) * bfhi(w.y) + bflo(w.z) * bflo(w.z) + bfhi(w.z) * bfhi(w.z) + bflo(w.w) * bflo(w.w) + bfhi(w.w) * bfhi(w.w);
          s = wave_sum(s); if (l == 0) rstd_q[t] = 1.0f / sqrtf(s * (1.f / QLORA) + RMS_EPS); }
        { const u32x2 w = *((const u32x2*)(zr + QLORA) + l); float s = bflo(w.x) * bflo(w.x) + bfhi(w.x) * bfhi(w.x) + bflo(w.y) * bflo(w.y) + bfhi(w.y) * bfhi(w.y);
          s = wave_sum(s); if (l == 0) rstd_kv[t] = 1.0f / sqrtf(s * (1.f / KVLORA) + RMS_EPS); }
        { const int i = l & 31, hs = l >> 5; const unsigned w = *((const unsigned*)(zr + 768) + i); const float x1 = bflo(w), x2 = bfhi(w); const f32x2 c = cs[(size_t)t * 32 + i];
          const unsigned o = cvt_pk_bf16(x1 * c.x - x2 * c.y, x2 * c.x + x1 * c.y);
#pragma unroll
          for (int hh = 0; hh < 8; ++hh) *((unsigned*)(Kb + (size_t)t * (MH * QKD) + (hs * 8 + hh) * QKD + NOPE) + i) = o; }
        const int s = t % SEQ; const float fp = s > 0 ? 1.f : 0.f, fn = s < SEQ - 1 ? 1.f : 0.f;
        const bf16* z0 = zl + (size_t)t * ZL_LD; const bf16* zp = s > 0 ? z0 - ZL_LD : z0; const bf16* zn = s < SEQ - 1 ? z0 + ZL_LD : z0;
        bf16* lr = la + (size_t)t * LA_LD;
#pragma unroll
        for (int i = 0; i < 5; ++i) { const int j = 2 * l + 128 * i;
            const unsigned wp = *(const unsigned*)(zp + j), w0 = *(const unsigned*)(z0 + j), wn = *(const unsigned*)(zn + j);
            float va = s0[i].x * fp * bflo(wp) + s1[i].x * bflo(w0) + s2[i].x * fn * bflo(wn);
            float vb = s0[i].y * fp * bfhi(wp) + s1[i].y * bfhi(w0) + s2[i].y * fn * bfhi(wn);
            int dst;
            if (j < 192) { va = tanhf(va); vb = tanhf(vb); dst = (j / 96) * 128 + (j % 96); } else if (j < 384) { dst = (j / 96) * 128 + (j % 96); } else { va = sigmoidf_(va); vb = sigmoidf_(vb); dst = 512 + (j - 384); }
            *(unsigned*)(lr + dst) = cvt_pk_bf16(va, vb); }
        { const int p = 2 * l; *(unsigned*)(lr + (p >> 5) * 128 + 96 + (p & 31)) = 0u; }
    }
}

namespace scan {
constexpr int TC = 16, DATA_B = TC * 6 * 64 * 4, BUF_B = DATA_B + 64 + TC * 32 * 4;
template <int CTRL> __device__ __forceinline__ float dpp_add(float v) {
    return v + __builtin_bit_cast(float, __builtin_amdgcn_update_dpp(0, __builtin_bit_cast(int, v), CTRL, 0xF, 0xF, false));
}
__device__ __forceinline__ float red16(float v) { v = dpp_add<0xB1>(v); v = dpp_add<0x4E>(v); v = dpp_add<0x141>(v); v = dpp_add<0x140>(v); return v; }
struct Raw { unsigned short r[3], k[3], v[3], wl, ic; };
template <int VAR> __device__ __forceinline__ void scan_unit(Frame& F, const int b, const int h, const int dir, const int half) {
    unsigned char* ws = F.ws; const int l = F.lane, w = F.wave, tid = F.tid;
    const bf16* zr = (const bf16*)(ws + WS_ZRKV) + (size_t)b * SEQ * ZR_LD + h * 64 + l;
    const bf16* wlp = (const bf16*)(ws + (dir ? WS_WLB : WS_WLF)) + (size_t)b * SEQ * RW + h * 64 + l;
    const bf16* icp = (const bf16*)(ws + (dir ? WS_ICB : WS_ICF)) + (size_t)b * SEQ * RW + h * 64 + l;
    bf16* yout = (bf16*)(ws + (dir ? WS_YB : WS_YF)) + (size_t)b * SEQ * RW + h * 64 + half * 32;
    const int ch = h * 64 + l; const float* sh = F.in[I_SHIFT];
    const float sr0 = sh[ch], sr1 = sh[RWKV_IN + ch], sr2 = sh[2 * RWKV_IN + ch];
    const float sk0 = sh[2048 + ch], sk1 = sh[RWKV_IN + 2048 + ch], sk2 = sh[2 * RWKV_IN + 2048 + ch];
    const float sv0 = sh[4096 + ch], sv1 = sh[RWKV_IN + 4096 + ch], sv2 = sh[2 * RWKV_IN + 4096 + ch];
    const float kk_c = F.in[I_KK][ch], ka_c = F.in[I_KA][ch], rk_c = F.in[I_RK][ch];
    LAS unsigned char* L = F.lds;
    Raw raw[2];
#define SC_TOK(ci, i) (dir ? (SEQ - 1 - ((ci) * TC + (i))) : ((ci) * TC + (i)))
#define SC_LOAD(ci) do { _Pragma("unroll") for (int q = 0; q < 2; ++q) { const int s = SC_TOK(ci, 2 * w + q); const int sp = s > 0 ? s - 1 : s, sn = s < SEQ - 1 ? s + 1 : s; \
        const bf16* z0 = zr + (size_t)s * ZR_LD; const bf16* zp = zr + (size_t)sp * ZR_LD; const bf16* zn = zr + (size_t)sn * ZR_LD; \
        raw[q].r[0] = zp[0]; raw[q].r[1] = z0[0]; raw[q].r[2] = zn[0]; raw[q].k[0] = zp[2048]; raw[q].k[1] = z0[2048]; raw[q].k[2] = zn[2048]; \
        raw[q].v[0] = zp[4096]; raw[q].v[1] = z0[4096]; raw[q].v[2] = zn[4096]; raw[q].wl = wlp[(size_t)s * RW]; raw[q].ic = icp[(size_t)s * RW]; } } while (0)
#define SC_PREP(ci, bufi) do { _Pragma("unroll") for (int q = 0; q < 2; ++q) { const int i = 2 * w + q; const int s = SC_TOK(ci, i); const float fp = s > 0 ? 1.f : 0.f, fn = s < SEQ - 1 ? 1.f : 0.f; \
        const float r_s = sr0 * fp * bf2f(raw[q].r[0]) + sr1 * bf2f(raw[q].r[1]) + sr2 * fn * bf2f(raw[q].r[2]); \
        const float k_s = sk0 * fp * bf2f(raw[q].k[0]) + sk1 * bf2f(raw[q].k[1]) + sk2 * fn * bf2f(raw[q].k[2]); \
        const float v_s = sv0 * fp * bf2f(raw[q].v[0]) + sv1 * bf2f(raw[q].v[1]) + sv2 * fn * bf2f(raw[q].v[2]); \
        const float kkr = k_s * kk_c; const float ss = wave_sum(kkr * kkr); const float kk = kkr * (1.0f / sqrtf(ss + 1e-12f)); \
        const float icv = bf2f(raw[q].ic); const float kd = k_s * (1.0f + (icv - 1.0f) * ka_c); const float bb = kk * icv; const float wd = __builtin_amdgcn_exp2f(bf2f(raw[q].wl)); \
        const float bon = wave_sum(r_s * kd * rk_c); \
        LAS float* d = (LAS float*)(L + (bufi) * BUF_B) + i * 384 + l; d[0] = wd; d[64] = kk; d[128] = bb; d[192] = kd; d[256] = r_s; d[320] = v_s; \
        if (l == 0) ((LAS float*)(L + (bufi) * BUF_B + DATA_B))[i] = bon; } } while (0)
    const int g = l >> 4, j = l & 15, row = half * 32 + w * 4 + g;
    f32x2 Sa = {0.f, 0.f}, Sb = {0.f, 0.f};
    struct Ops { f32x4 w, a, b, k, r; float v, bon; };
#define SC_LD(O, i) do { O.w = p4[(i) * 96 + j]; O.a = p4[(i) * 96 + 16 + j]; O.b = p4[(i) * 96 + 32 + j]; O.k = p4[(i) * 96 + 48 + j]; O.r = p4[(i) * 96 + 64 + j]; \
        O.v = pf[(i) * 384 + 320 + row]; O.bon = pb[i]; } while (0)
#define SC_STEP(O, YP) do { f32x2 t = Sa * O.a.xy; t = Sb * O.a.zw + t; float sa = red16(t.x + t.y); \
        const f32x2 nsa = {-sa, -sa}; const f32x2 vv2 = {O.v, O.v}; \
        const f32x2 u0 = nsa * O.b.xy + vv2 * O.k.xy, u1 = nsa * O.b.zw + vv2 * O.k.zw; \
        Sa = Sa * O.w.xy + u0; Sb = Sb * O.w.zw + u1; \
        f32x2 ty = Sa * O.r.xy; ty = Sb * O.r.zw + ty; YP = ty.x + ty.y; } while (0)
    SC_LOAD(0); SC_PREP(0, 0); __syncthreads();
    constexpr int NCH = SEQ / TC;
    for (int ci = 0; ci < NCH; ++ci) {
        const int bi = ci & 1;
        if (VAR != 2 && ci + 1 < NCH) SC_LOAD(ci + 1);
        const LAS f32x4* p4 = (const LAS f32x4*)(L + bi * BUF_B); const LAS float* pf = (const LAS float*)(L + bi * BUF_B);
        const LAS float* pb = (const LAS float*)(L + bi * BUF_B + DATA_B);
        float ykeep = 0.f;
        Ops oA, oB; SC_LD(oA, 0);
        if (VAR != 1) {
#pragma unroll
        for (int i = 0; i < TC; i += 4) {
            float y0, y1, y2, y3; float v0, v1, v2, v3, b0, b1, b2, b3;
            SC_LD(oB, i + 1); v0 = oA.v; b0 = oA.bon; SC_STEP(oA, y0);
            SC_LD(oA, i + 2); v1 = oB.v; b1 = oB.bon; SC_STEP(oB, y1);
            SC_LD(oB, i + 3); v2 = oA.v; b2 = oA.bon; SC_STEP(oA, y2);
            if (i + 4 < TC) SC_LD(oA, i + 4);
            v3 = oB.v; b3 = oB.bon; SC_STEP(oB, y3);
            y0 = red16(y0); y1 = red16(y1); y2 = red16(y2); y3 = red16(y3);
            y0 += b0 * v0; y1 += b1 * v1; y2 += b2 * v2; y3 += b3 * v3;
            ykeep = (j == i) ? y0 : ykeep; ykeep = (j == i + 1) ? y1 : ykeep; ykeep = (j == i + 2) ? y2 : ykeep; ykeep = (j == i + 3) ? y3 : ykeep;
        }
        }
        ((LAS float*)(L + bi * BUF_B + DATA_B + 64))[j * 32 + w * 4 + g] = ykeep;
        if (VAR != 2 && ci + 1 < NCH) SC_PREP(ci + 1, bi ^ 1);
        __syncthreads();
        { const int st = tid >> 5, rw_ = tid & 31; const int s = SC_TOK(ci, st);
          const unsigned short yv = f2bf(((const LAS float*)(L + bi * BUF_B + DATA_B + 64))[st * 32 + rw_]);
          if (VAR == 0) yout[(size_t)s * RW + rw_] = yv; else asm volatile("" :: "v"(yv)); }
    }
    __syncthreads();
#undef SC_TOK
#undef SC_LOAD
#undef SC_PREP
#undef SC_LD
#undef SC_STEP
}
}

namespace scan2 {
constexpr int TC = 16, NS = 5, NPREP = 6, NREC = 2;
constexpr int ROWB = 144;
constexpr int P_ACAT = 0, P_BHAT = 4608, P_KHAT = 6656, P_VT = 8704, P_NCAT = 10752, P_MRF = 11776, P_PC = 12800, P_GINIT = 13056, PKG_B = 17152;
constexpr int S_L1 = 0, S_L2 = 4608, S_MF = 9216, S_NF = 10240, SCR_B = 11264;
constexpr int OFF_PKG = 0, OFF_SCR = NS * PKG_B, OFF_FLAG = OFF_SCR + NPREP * SCR_B, TOTAL_B = OFF_FLAG + 64;
static_assert(TOTAL_B <= 152 * 1024, "scan2 LDS");
__device__ __forceinline__ int crow(int r, int hi) { return (r & 3) + 8 * (r >> 2) + 4 * hi; }
__device__ __forceinline__ void lds_st16(LAS unsigned char* p, float v) { *(LAS unsigned short*)p = f2bf(v); }
__device__ __forceinline__ bf16x8 pack_acc8(const f32x16& x, int base) {
    u32x4 w = {cvt_pk_bf16(x[base + 0], x[base + 1]), cvt_pk_bf16(x[base + 2], x[base + 3]), cvt_pk_bf16(x[base + 4], x[base + 5]), cvt_pk_bf16(x[base + 6], x[base + 7])};
    return *reinterpret_cast<bf16x8*>(&w);
}
__device__ __forceinline__ float wave_sum_b(float v) {
    v = scan::red16(v);
    v += __builtin_bit_cast(float, __builtin_amdgcn_update_dpp(0, __builtin_bit_cast(int, v), 0x142, 0xA, 0xF, false));
    v += __builtin_bit_cast(float, __builtin_amdgcn_update_dpp(0, __builtin_bit_cast(int, v), 0x143, 0xC, 0xF, false));
    return __builtin_bit_cast(float, __builtin_amdgcn_readlane(__builtin_bit_cast(int, v), 63));
}
__device__ __forceinline__ void spin_ge(volatile LAS int* p, int want) { while (*p < want) __builtin_amdgcn_s_sleep(1); }

template <int dir> __device__ __forceinline__ void scan_unit(Frame& F, const int b, const int h) {
    unsigned char* ws = F.ws; const int l = F.lane, w = F.wave;
    LAS unsigned char* L = F.lds;
    volatile LAS int* ready = (volatile LAS int*)(L + OFF_FLAG);
    volatile LAS int* consumed = ready + NS;
    if (F.tid < 16) ready[F.tid] = 0;
    __syncthreads();
    constexpr int NCH = SEQ / TC;
    if (w < NREC) {
        const int half = w; const int v = l & 31, hi = l >> 5, vg = 32 * half + v;
        f32x16 X0 = {}, X1 = {};
        bf16* yout = (bf16*)(ws + (dir ? WS_YB : WS_YF)) + (size_t)b * SEQ * RW + h * 64 + half * 32 + v;
        for (int ci = 0; ci < NCH; ++ci) {
            const int slot = ci % NS; const LAS unsigned char* P = L + OFF_PKG + slot * PKG_B;
            spin_ge(ready + slot, ci + 1);
            const bf16x8 a00 = *(const LAS bf16x8*)(P + P_ACAT + v * ROWB + (0 + hi) * 16), a01 = *(const LAS bf16x8*)(P + P_ACAT + v * ROWB + (2 + hi) * 16);
            const bf16x8 a10 = *(const LAS bf16x8*)(P + P_ACAT + v * ROWB + (4 + hi) * 16), a11 = *(const LAS bf16x8*)(P + P_ACAT + v * ROWB + (6 + hi) * 16);
            const bf16x8 ncat = *(const LAS bf16x8*)(P + P_NCAT + v * 32 + hi * 16), vt = *(const LAS bf16x8*)(P + P_VT + vg * 32 + hi * 16);
            const bf16x8 mrf = *(const LAS bf16x8*)(P + P_MRF + l * 16);
            const bf16x8 bh0 = *(const LAS bf16x8*)(P + P_BHAT + v * 32 + hi * 16), bh1 = *(const LAS bf16x8*)(P + P_BHAT + (32 + v) * 32 + hi * 16);
            const bf16x8 kh0 = *(const LAS bf16x8*)(P + P_KHAT + v * 32 + hi * 16), kh1 = *(const LAS bf16x8*)(P + P_KHAT + (32 + v) * 32 + hi * 16);
            f32x16 G;
            { const f32x4 g0 = *(const LAS f32x4*)(P + P_GINIT + vg * 64 + hi * 16), g1 = *(const LAS f32x4*)(P + P_GINIT + vg * 64 + 32 + hi * 16);
#pragma unroll
              for (int r = 0; r < 8; ++r) G[r] = 0.f;
#pragma unroll
              for (int r = 0; r < 4; ++r) { G[8 + r] = g0[r]; G[12 + r] = g1[r]; } }
            f32x4 pc[8];
#pragma unroll
            for (int q = 0; q < 8; ++q) pc[q] = *(const LAS f32x4*)(P + P_PC + (32 * (q >> 2) + 8 * (q & 3) + 4 * hi) * 4);
            const bf16x8 s00 = pack_acc8(X0, 0), s01 = pack_acc8(X0, 8), s10 = pack_acc8(X1, 0), s11 = pack_acc8(X1, 8);
            G = __builtin_amdgcn_mfma_f32_32x32x16_bf16(a00, s00, G, 0, 0, 0);
            G = __builtin_amdgcn_mfma_f32_32x32x16_bf16(a01, s01, G, 0, 0, 0);
            G = __builtin_amdgcn_mfma_f32_32x32x16_bf16(a10, s10, G, 0, 0, 0);
            G = __builtin_amdgcn_mfma_f32_32x32x16_bf16(a11, s11, G, 0, 0, 0);
            G = __builtin_amdgcn_mfma_f32_32x32x16_bf16(ncat, vt, G, 0, 0, 0);
            const bf16x8 uf = pack_acc8(G, 0);
#pragma unroll
            for (int r = 0; r < 16; ++r) { X0[r] *= pc[r >> 2][r & 3]; X1[r] *= pc[4 + (r >> 2)][r & 3]; }
            X0 = __builtin_amdgcn_mfma_f32_32x32x16_bf16(bh0, uf, X0, 0, 0, 0);
            X1 = __builtin_amdgcn_mfma_f32_32x32x16_bf16(bh1, uf, X1, 0, 0, 0);
            X0 = __builtin_amdgcn_mfma_f32_32x32x16_bf16(kh0, vt, X0, 0, 0, 0);
            X1 = __builtin_amdgcn_mfma_f32_32x32x16_bf16(kh1, vt, X1, 0, 0, 0);
            G = __builtin_amdgcn_mfma_f32_32x32x16_bf16(mrf, uf, G, 0, 0, 0);
            LDS_WAIT();
            if (l == 0) consumed[half] = ci + 1;
#pragma unroll
            for (int q = 0; q < 8; ++q) { const int t = crow(q, hi); const int s = dir ? (SEQ - 1 - (ci * TC + t)) : (ci * TC + t);
                yout[(size_t)s * RW] = f2bf(G[8 + q]); }
        }
    } else {
        const int pw = w - NREC; LAS unsigned char* SC = L + OFF_SCR + pw * SCR_B;
        const bf16* zr = (const bf16*)(ws + WS_ZRKV) + (size_t)b * SEQ * ZR_LD + h * 64 + l;
        const bf16* wlp = (const bf16*)(ws + (dir ? WS_WLB : WS_WLF)) + (size_t)b * SEQ * RW + h * 64 + l;
        const bf16* icp = (const bf16*)(ws + (dir ? WS_ICB : WS_ICF)) + (size_t)b * SEQ * RW + h * 64 + l;
        const int ch = h * 64 + l; const float* sh = F.in[I_SHIFT];
        const float sr0 = sh[ch], sr1 = sh[RWKV_IN + ch], sr2 = sh[2 * RWKV_IN + ch];
        const float sk0 = sh[2048 + ch], sk1 = sh[RWKV_IN + 2048 + ch], sk2 = sh[2 * RWKV_IN + 2048 + ch];
        const float sv0 = sh[4096 + ch], sv1 = sh[RWKV_IN + 4096 + ch], sv2 = sh[2 * RWKV_IN + 4096 + ch];
        const float kk_c = F.in[I_KK][ch], ka_c = F.in[I_KA][ch], rk_c = F.in[I_RK][ch];
        const int posk = (((l >> 5) * 2 + ((l >> 4) & 1)) * 2 + ((l >> 2) & 1)) * 8 + ((l >> 3) & 1) * 4 + (l & 3);
        for (int ci = pw; ci < NCH; ci += NPREP) {
            const int slot = ci % NS; LAS unsigned char* P = L + OFF_PKG + slot * PKG_B;
            const int s_lo = dir ? (SEQ - TC - ci * TC) : ci * TC;
            float rr[18], rk[18], rv[18], wl[16], ic[16];
#pragma unroll
            for (int tau = 0; tau < 18; ++tau) { const int s = s_lo - 1 + tau; const bool ok = (s >= 0) && (s < SEQ); const int sc = ok ? s : s_lo; const bf16* z = zr + (size_t)sc * ZR_LD;
                const float f = ok ? 1.f : 0.f; rr[tau] = f * bf2f(z[0]); rk[tau] = f * bf2f(z[2048]); rv[tau] = f * bf2f(z[4096]); }
#pragma unroll
            for (int i = 0; i < 16; ++i) { const int s = dir ? (s_lo + 15 - i) : (s_lo + i); wl[i] = bf2f(wlp[(size_t)s * RW]); ic[i] = bf2f(icp[(size_t)s * RW]); }
            float cum[16];
            cum[0] = wl[0];
#pragma unroll
            for (int i = 1; i < 16; ++i) cum[i] = cum[i - 1] + wl[i];
            spin_ge(consumed, ci - NS + 1); spin_ge(consumed + 1, ci - NS + 1);
            float at[16]; float pprev = 1.0f; const float pC = __builtin_amdgcn_exp2f(cum[15]);
#pragma unroll
            for (int i = 0; i < 16; ++i) { const int tau = dir ? (16 - i) : (i + 1);
                const float r_s = sr0 * rr[tau - 1] + sr1 * rr[tau] + sr2 * rr[tau + 1];
                const float k_s = sk0 * rk[tau - 1] + sk1 * rk[tau] + sk2 * rk[tau + 1];
                const float v_s = sv0 * rv[tau - 1] + sv1 * rv[tau] + sv2 * rv[tau + 1];
                const float kkr = k_s * kk_c; const float ss = wave_sum_b(kkr * kkr); const float kk = kkr * __builtin_amdgcn_rsqf(ss + 1e-12f);
                const float kd = k_s * (1.0f + (ic[i] - 1.0f) * ka_c); const float bb = kk * ic[i];
                const float bon = wave_sum_b(r_s * kd * rk_c);
                const float p = __builtin_amdgcn_exp2f(cum[i]), pm = pprev, pinv = __builtin_amdgcn_exp2f(-cum[i]), pr = pC * pinv; pprev = p;
                at[i] = -kk * pm;
                lds_st16(SC + S_L2 + i * ROWB + l * 2, at[i]);
                const float rt = r_s * p;
                lds_st16(SC + S_L2 + (16 + i) * ROWB + l * 2, rt); lds_st16(P + P_ACAT + (16 + i) * ROWB + posk * 2, rt);
                lds_st16(SC + S_L1 + i * ROWB + l * 2, bb * pinv); lds_st16(SC + S_L1 + (16 + i) * ROWB + l * 2, kd * pinv);
                lds_st16(P + P_BHAT + l * 32 + ((((i >> 2) & 1) * 8) + (i & 3) + 4 * (i >> 3)) * 2, bb * pr);
                lds_st16(P + P_KHAT + l * 32 + i * 2, kd * pr);
                lds_st16(P + P_VT + l * 32 + i * 2, v_s); *(LAS float*)(P + P_GINIT + l * 64 + i * 4) = bon * v_s;
            }
            *(LAS float*)(P + P_PC + l * 4) = pC;
            LDS_WAIT();
            f32x16 Z = {};
            { const int r = l & 31, hh = l >> 5;
#pragma unroll
              for (int ks = 0; ks < 4; ++ks) { const bf16x8 fa = *(const LAS bf16x8*)(SC + S_L1 + r * ROWB + (ks * 16 + hh * 8) * 2), fb = *(const LAS bf16x8*)(SC + S_L2 + r * ROWB + (ks * 16 + hh * 8) * 2);
                  Z = __builtin_amdgcn_mfma_f32_32x32x16_bf16(fa, fb, Z, 0, 0, 0); } }
            { const int c = l & 31, hh = l >> 5;
              if (c < 16) {
#pragma unroll
                  for (int r = 0; r < 8; ++r) { const int s = crow(r, hh); *(LAS float*)(SC + S_MF + (c * 16 + s) * 4) = (s < c) ? Z[r] : 0.f; }
#pragma unroll
                  for (int r = 8; r < 16; ++r) { const int s = crow(r, hh) - 16; *(LAS float*)(SC + S_NF + (s * 16 + c) * 4) = (s < c) ? Z[r] : 0.f; }
                  *(LAS u32x4*)(P + P_MRF + l * 16) = (u32x4){0u, 0u, 0u, 0u};
              } else { const int t = c - 16; f32x16 Zm = Z;
#pragma unroll
                  for (int r = 0; r < 8; ++r) { const int s = crow(r, hh); Zm[r] = (s <= t) ? Z[r] : 0.f; }
                  *(LAS bf16x8*)(P + P_MRF + l * 16) = pack_acc8(Zm, 0);
#pragma unroll
                  for (int r = 8; r < 16; ++r) { const int s = crow(r, hh) - 16; lds_st16(P + P_NCAT + c * 32 + s * 2, (s <= t) ? Z[r] : 0.f); }
              } }
            LDS_WAIT();
            { float x[16]; x[0] = at[0];
#pragma unroll
              for (int t = 1; t < 16; ++t) { float acc = at[t];
#pragma unroll
                  for (int s4 = 0; s4 < (t + 3) / 4; ++s4) { const f32x4 m = *(const LAS f32x4*)(SC + S_MF + (t * 16 + s4 * 4) * 4);
#pragma unroll
                      for (int q = 0; q < 4; ++q) if (s4 * 4 + q < t) acc += x[s4 * 4 + q] * m[q]; }
                  x[t] = acc; }
#pragma unroll
              for (int t = 0; t < 16; ++t) lds_st16(P + P_ACAT + t * ROWB + posk * 2, x[t]); }
            if (l < 16) { float n[16], x[16];
#pragma unroll
              for (int q = 0; q < 4; ++q) { const f32x4 nv = *(const LAS f32x4*)(SC + S_NF + (l * 16 + q * 4) * 4); n[q * 4 + 0] = nv[0]; n[q * 4 + 1] = nv[1]; n[q * 4 + 2] = nv[2]; n[q * 4 + 3] = nv[3]; }
              x[0] = n[0];
#pragma unroll
              for (int t = 1; t < 16; ++t) { float acc = n[t];
#pragma unroll
                  for (int s4 = 0; s4 < (t + 3) / 4; ++s4) { const f32x4 m = *(const LAS f32x4*)(SC + S_MF + (t * 16 + s4 * 4) * 4);
#pragma unroll
                      for (int q = 0; q < 4; ++q) if (s4 * 4 + q < t) acc += x[s4 * 4 + q] * m[q]; }
                  x[t] = acc; }
#pragma unroll
              for (int t = 0; t < 16; ++t) lds_st16(P + P_NCAT + t * 32 + l * 2, x[t]); }
            LDS_WAIT();
            if (l == 0) ready[slot] = ci + 1;
        }
    }
    __syncthreads();
}
}

__device__ __forceinline__ void p5_post(Frame& F) {
    const int gw = F.vcu * 8 + F.wave, NGW = F.G * 8, l = F.lane; unsigned char* ws = F.ws;
    const bf16* yf = (const bf16*)(ws + WS_YF); const bf16* yb = (const bf16*)(ws + WS_YB); const bf16* gg = (const bf16*)(ws + WS_G); bf16* o = (bf16*)(ws + WS_ORWKV);
    const float* lg = F.in[I_LNXG]; const float* lb = F.in[I_LNXB];
    for (int t = gw; t < MT; t += NGW) {
        const size_t base = (size_t)t * RW;
#pragma unroll 4
        for (int h = 0; h < RH; ++h) { const int c = h * 64 + l;
            const float y = bf2f(yf[base + c]) + bf2f(yb[base + c]);
            const float mu = wave_sum(y) * (1.f / 64.f); const float d = y - mu; const float var = wave_sum(d * d) * (1.f / 64.f);
            const float yn = d * (1.0f / sqrtf(var + LNX_EPS));
            o[base + c] = f2bf((yn * lg[c] + lb[c]) * bf2f(gg[base + c])); }
    }
}

__device__ __forceinline__ void p8_rowpass(Frame& F) {
    const int gw = F.vcu * 8 + F.wave, NGW = F.G * 8; float* rstd2 = (float*)(F.ws + WS_RSTD) + 3 * MT; bf16* hb = (bf16*)(F.ws + WS_H1B);
    for (int m = gw; m < MT; m += NGW) {
        const f32x4* xr = (const f32x4*)(F.out + (size_t)m * DM) + F.lane; f32x4 v[8]; float s = 0.f;
#pragma unroll
        for (int j = 0; j < 8; ++j) { v[j] = xr[64 * j]; s += (v[j].x * v[j].x + v[j].y * v[j].y) + (v[j].z * v[j].z + v[j].w * v[j].w); }
        s = wave_sum(s); if (F.lane == 0) rstd2[m] = 1.0f / sqrtf(s * (1.f / DM) + RMS_EPS);
        u32x2* o8 = (u32x2*)(hb + (size_t)m * DM) + F.lane;
#pragma unroll
        for (int j = 0; j < 8; ++j) { u32x2 w; w.x = cvt_pk_bf16(v[j].x, v[j].y); w.y = cvt_pk_bf16(v[j].z, v[j].w); o8[64 * j] = w; }
    }
}
__device__ __forceinline__ void p12_router(Frame& F) {
    const int gw = F.vcu * 8 + F.wave, NGW = F.G * 8, l = F.lane; unsigned char* ws = F.ws;
    float* rstd3 = (float*)(ws + WS_RSTD) + 4 * MT; bf16* n3 = (bf16*)(ws + WS_N3); const float* WR = (const float*)(ws + WS_WR);
    int* lists = (int*)(ws + WS_LIST); int* route = (int*)(ws + WS_ROUTE); float* slotw = (float*)(ws + WS_SLOTW);
    int* cnt = (int*)(F.ctl + CW_CNT);
    const float* brg = F.in[I_BRG]; const float* bre = F.in[I_BRE];
    LAS float* wl = (LAS float*)(F.lds + 16384);
    LAS float* lgt = (LAS float*)(F.lds + F.wave * 1024);
    for (int tb = F.vcu * 32; tb < MT; tb += F.G * 32) {
        const int t0 = tb + F.wave * 4;
        float ss[4] = {0.f, 0.f, 0.f, 0.f};
#pragma unroll
        for (int q = 0; q < 4; ++q) { const f32x4* xr = (const f32x4*)(F.out + (size_t)(t0 + q) * DM) + l; u32x2* o8 = (u32x2*)(n3 + (size_t)(t0 + q) * DM) + l;
#pragma unroll
            for (int j = 0; j < 8; ++j) { const f32x4 x = xr[64 * j]; ss[q] += (x.x * x.x + x.y * x.y) + (x.z * x.z + x.w * x.w);
                u32x2 w; w.x = cvt_pk_bf16(x.x, x.y); w.y = cvt_pk_bf16(x.z, x.w); o8[64 * j] = w; } }
#pragma unroll
        for (int q = 0; q < 4; ++q) ss[q] = wave_sum(ss[q]);
#pragma unroll 1
        for (int pass = 0; pass < 2; ++pass) {
            const float* x0p = F.out + (size_t)(t0 + 2 * pass) * DM + l; const float* x1p = x0p + DM;
            float acc[2][36];
#pragma unroll
            for (int q = 0; q < 2; ++q)
#pragma unroll
                for (int o = 0; o < 36; ++o) acc[q][o] = 0.f;
#pragma unroll 1
            for (int blk = 0; blk < 8; ++blk) {
                __syncthreads();
                { const f32x4* src4 = (const f32x4*)(WR + (size_t)blk * 256 * 36); LAS f32x4* dst4 = (LAS f32x4*)wl;
#pragma unroll
                  for (int i = 0; i < 5; ++i) { const int idx = F.tid + 512 * i; if (idx < 2304) dst4[idx] = src4[idx]; } }
                __syncthreads();
#pragma unroll
                for (int c4 = 0; c4 < 4; ++c4) { const int cl = l + 64 * c4; const float x0 = x0p[blk * 256 + 64 * c4], x1 = x1p[blk * 256 + 64 * c4];
                    const LAS f32x4* wr = (const LAS f32x4*)(wl + cl * 36);
#pragma unroll
                    for (int o4 = 0; o4 < 9; ++o4) { const f32x4 w = wr[o4];
#pragma unroll
                        for (int k = 0; k < 4; ++k) { acc[0][o4 * 4 + k] += x0 * w[k]; acc[1][o4 * 4 + k] += x1 * w[k]; } } }
            }
#pragma unroll
            for (int q = 0; q < 2; ++q)
#pragma unroll
                for (int o = 0; o < 36; ++o) { const float v = wave_sum(acc[q][o]); if (l == 0) lgt[(2 * pass + q) * 36 + o] = v; }
        }
        LDS_WAIT();
#pragma unroll
        for (int q = 0; q < 4; ++q) { const int t = t0 + q; const float rs = 1.0f / sqrtf(ss[q] * (1.f / DM) + RMS_EPS);
            float lg[4]; float gmax = -3.0e38f; int gsel = 0;
#pragma unroll
            for (int g = 0; g < 4; ++g) { lg[g] = lgt[q * 36 + g] * rs + brg[g]; if (lg[g] > gmax) { gmax = lg[g]; gsel = g; } }
            float gz = 0.f;
#pragma unroll
            for (int g = 0; g < 4; ++g) gz += __expf(lg[g] - gmax);
            const float pg = 1.0f / gz;
            float le[8];
#pragma unroll
            for (int e = 0; e < 8; ++e) { float a = lgt[q * 36 + 4 + e];
#pragma unroll
                for (int g = 1; g < 4; ++g) a = (gsel == g) ? lgt[q * 36 + 4 + g * 8 + e] : a;
                le[e] = a * rs + bre[gsel * 8 + e]; }
            float m1 = -3.0e38f, m2 = -3.0e38f; int e1 = 0, e2 = 0;
#pragma unroll
            for (int e = 0; e < 8; ++e) { if (le[e] > m1) { m2 = m1; e2 = e1; m1 = le[e]; e1 = e; } else if (le[e] > m2) { m2 = le[e]; e2 = e; } }
            const float xe = __expf(m2 - m1); const float w1 = pg / (1.0f + xe), w2 = pg * xe / (1.0f + xe);
            if (l == 0) { rstd3[t] = rs;
                const int E1 = gsel * 8 + e1, E2 = gsel * 8 + e2;
                const int p1 = atomicAdd(cnt + 64 * E1, 1), p2 = atomicAdd(cnt + 64 * E2, 1);
                lists[E1 * MT + p1] = t; lists[E2 * MT + p2] = t; slotw[E1 * MT + p1] = w1; slotw[E2 * MT + p2] = w2;
                route[t * 8 + 0] = E1; route[t * 8 + 1] = p1; route[t * 8 + 2] = E2; route[t * 8 + 3] = p2; }
        }
    }
}
struct MoeOrder {
    static constexpr bool GATHER = true;
    const volatile LAS int* tp; const int* cnt; const int* lists; const char* A; const char* B; int G, c, lognt; size_t bstride_e, bstride_t;
    bool gather;
    __device__ __forceinline__ bool next(int i, Unit& u) const {
        const int L = i * G + c; const int RT = tp[32]; if (L >= (RT << lognt)) return false;
        const int rt = L >> lognt, nt = L & ((1 << lognt) - 1); int e = 0;
        for (int q = 1; q < 32; ++q) e = (rt >= tp[q]) ? q : e;
        u.pm = rt; u.pn = nt; u.aux0 = e; u.aux1 = (rt - tp[e]) * 256;
        u.Ab = A; u.Bb = B + (size_t)e * bstride_e + (size_t)nt * bstride_t; return true;
    }
    __device__ __forceinline__ unsigned arow(const Unit& u, int r) const {
        if (!gather) return (unsigned)(u.pm * 256 + r);
        const int idx = u.aux1 + r; const int n = cnt[64 * u.aux0]; return idx < n ? (unsigned)lists[u.aux0 * MT + idx] : 0u;
    }
};
struct EpiMoe1 {
    static constexpr bool PERM = true;
    bf16* hid; const int* cnt; const int* lists; const float* slotw; const float* rstd;
    __device__ __forceinline__ void operator()(const PG8_ACC, const Unit& u, int wr, int wc, int fr, int fq) const {
        const int n = cnt[64 * u.aux0];
#pragma unroll
        for (int ai = 0; ai < 2; ++ai)
#pragma unroll
            for (int m = 0; m < 4; ++m) { const int r = ai * 128 + wr * 64 + m * 16 + fr; const int idx = u.aux1 + r; const bool ok = idx < n;
                const int tok = ok ? lists[u.aux0 * MT + idx] : 0; const float rs = rstd[tok]; const float wt = ok ? slotw[u.aux0 * MT + idx] : 0.f;
                f32x4 o0, o1;
#pragma unroll
                for (int j = 0; j < 4; ++j) { const float g0 = acc[ai][0][m][0][j] * rs, u0 = acc[ai][1][m][0][j] * rs, g1 = acc[ai][0][m][1][j] * rs, u1 = acc[ai][1][m][1][j] * rs;
                    o0[j] = g0 * sigmoidf_(g0) * u0 * wt; o1[j] = g1 * sigmoidf_(g1) * u1 * wt; }
                *(u32x4*)(hid + (size_t)(u.pm * 256 + r) * DE + u.pn * 128 + wc * 32 + 8 * fq) = pg8::pack8(o0, o1); }
    }
};
struct EpiMoe2 {
    static constexpr bool PERM = true;
    bf16* y;
    __device__ __forceinline__ void operator()(const PG8_ACC, const Unit& u, int wr, int wc, int fr, int fq) const {
        EPI_FOR(ai, m, bj) { const int row = u.pm * 256 + ai * 128 + wr * 64 + m * 16 + fr; const int col = u.pn * 256 + bj * 128 + wc * 32 + 8 * fq;
            *(u32x4*)(y + (size_t)row * DM + col) = pg8::pack8(acc[ai][bj][m][0], acc[ai][bj][m][1]); }
    }
};
__device__ __forceinline__ void moe_table(Frame& F) {
    if (F.tid == 0) { const int* cnt = (const int*)(F.ctl + CW_CNT); int acc = 0;
        for (int e = 0; e < 32; ++e) { F.MISC[16 + e] = (unsigned)acc; acc += (__hip_atomic_load(cnt + 64 * e, __ATOMIC_RELAXED, __HIP_MEMORY_SCOPE_AGENT) + 255) >> 8; }
        F.MISC[16 + 32] = (unsigned)acc; }
    __syncthreads();
}
__device__ __forceinline__ void p5_expert_cvt(Frame& F) {
    LAS float* scr = (LAS float*)(F.lds + F.wave * CVT_SCR); const int gw = F.vcu * 8 + F.wave, NGW = F.G * 8; unsigned char* ws = F.ws;
#define EX_DESC(it_, d) do { const int e = (it_) / 768, r = (it_) % 768; \
        if (r < 256) { d.W = F.in[I_WEG] + (size_t)e * DM * DE; d.gain = F.in[I_GFFN]; d.WT = (bf16*)(ws + WS_WGU) + (size_t)e * 1024 * DM; d.K = DM; d.N = DE; d.ldt = DM; d.mode = 3; d.kofs = 0; d.item = r; } \
        else if (r < 512) { d.W = F.in[I_WEU] + (size_t)e * DM * DE; d.gain = F.in[I_GFFN]; d.WT = (bf16*)(ws + WS_WGU) + (size_t)e * 1024 * DM; d.K = DM; d.N = DE; d.ldt = DM; d.mode = 4; d.kofs = 0; d.item = r - 256; } \
        else { d.W = F.in[I_WED] + (size_t)e * DE * DM; d.gain = nullptr; d.WT = (bf16*)(ws + WS_WD) + (size_t)e * DM * DE; d.K = DE; d.N = DM; d.ldt = DE; d.mode = 0; d.kofs = 0; d.item = r - 512; } } while (0)
    CVT_PIPE(NE * 768, EX_DESC);
#undef EX_DESC
}

struct Args { const float* in[41]; float* out; unsigned char* ws; int ph_lo, ph_hi; };
constexpr int NPHASE = 16;
__global__ void __launch_bounds__(512, 2) fwd_kernel(Args args) {
    extern __shared__ __attribute__((aligned(16))) unsigned char lds_raw[];
    Frame F;
    F.lds = (LAS unsigned char*)lds_raw; F.MISC = (volatile LAS unsigned*)(F.lds + MISC_OFF);
    F.tid = threadIdx.x; F.lane = F.tid & 63; F.wave = __builtin_amdgcn_readfirstlane(F.tid >> 6);
    F.G = gridDim.x; { const int bx = blockIdx.x; F.vcu = (F.G % 8 == 0) ? (bx % 8) * (F.G / 8) + bx / 8 : bx; }
    F.ws = args.ws; F.out = args.out; F.ctl = (unsigned*)(args.ws + WS_CTL);
#pragma unroll
    for (int i = 0; i < 41; ++i) F.in[i] = args.in[i];
    for (int u = F.tid; u < (LDS_BYTES - LDSCTL_OFF) / 4; u += 512) ((LAS unsigned*)(F.lds + LDSCTL_OFF))[u] = 0u;
    __syncthreads();
    XcdBarrier bar; bar.bar = F.ctl + CW_BAR; bar.x = 0; bar.st = nullptr;
    const int lo = args.ph_lo, hi = args.ph_hi;
    if (hi - lo > 1) bar = xcd_barrier_post(F.ctl + CW_BAR, F.MISC + 8);
#ifndef ATT_DQK_TEST
#define ATT_DQK_TEST QKD
#endif
#define PROBE_N (MT * 768)
#ifndef LSEL
#define LSEL 31
#endif
#ifndef PH_MASK
#define PH_MASK 0xFFFFu
#endif
#ifndef SCAN_MFMA
#define SCAN_MFMA 1
#endif
#ifndef SCAN_DUMMY
#define SCAN_DUMMY 0
#endif
#ifndef REPEAT_MASK
#define REPEAT_MASK 0x0u
#endif
#define REP(k) _Pragma("unroll") for (int _rep = 0; _rep <= (int)(((REPEAT_MASK) >> (k)) & 1u); ++_rep)
#define IN(k) ((((PH_MASK) >> (k)) & 1u) && lo <= (k) && (k) < hi)
#ifndef PROBE_TIME
#define PROBE_TIME -1
#endif
#define SEAM(k) do { if (lo <= (k) && (k) + 1 < hi) xcd_barrier(bar); if (PROBE_TIME >= 0 && blockIdx.x == 0 && F.tid == 0) { const unsigned long long _t = wall_clock64(); F.MISC[64 + 2 * ((k) + 1)] = (unsigned)_t; F.MISC[65 + 2 * ((k) + 1)] = (unsigned)(_t >> 32); } } while (0)
    unsigned char* ws = args.ws;

    bf16* const zmla = (bf16*)(ws + WS_ZMLA); bf16* const loraA = (bf16*)(ws + WS_LORAA);
    float* const rstd1 = (float*)(ws + WS_RSTD); float* const rstd_q = rstd1 + MT; float* const rstd_kv = rstd1 + 2 * MT;
    const int bid = (int)blockIdx.x;
    if (PROBE_TIME >= 0 && blockIdx.x == 0 && F.tid == 0) { const unsigned long long _t = wall_clock64(); F.MISC[64] = (unsigned)_t; F.MISC[65] = (unsigned)(_t >> 32); }
    if (IN(0)) { REP(0) p0_prologue(F); }
    SEAM(0);
    if (IN(1)) {
        if (EN_RWKV || EN_MLA) REP(1) { pg8::StaticOrder S; S.init((const bf16*)(ws + WS_XB), DM, (const bf16*)(ws + WS_WIN), DM, MT, G1_N, F.G, bid);
          EpiG1 E{rstd1, zmla, (bf16*)(ws + WS_ZRKV), (bf16*)(ws + WS_ZLORA), (bf16*)(ws + WS_ZGATE)};
          pg8::gemm_phase(F.lds, DM, DM, DM, S, E); }
        else p_copy_x(F);
    }
    SEAM(1);
    if (IN(2)) { if (EN_RWKV || EN_MLA) REP(2) p2_rowpass(F); }
    SEAM(2);
    if (IN(3)) REP(3) {
        if (EN_MLA) {
            { pg8::StaticOrder S; S.init(zmla, ZM_LD, (const bf16*)(ws + WS_WUQ), QLORA, MT, MH * QKD, F.G, bid);
              EpiQ E{(bf16*)(ws + WS_Q), rstd_q, (const float*)(ws + WS_ROPE)};
              pg8::gemm_phase(F.lds, QLORA, ZM_LD, QLORA, S, E); }
            { pg8::StaticOrder S; S.init(zmla + QLORA, ZM_LD, (const bf16*)(ws + WS_WUKV), KVLORA, MT, MH * 256, F.G, bid);
              EpiKV E{(bf16*)(ws + WS_K), (bf16*)(ws + WS_V), rstd_kv};
              pg8::gemm_phase(F.lds, KVLORA, ZM_LD, KVLORA, S, E); }
        }
        if (EN_RWKV) {
            { pg8::StaticOrder S; S.init(loraA, LA_LD, (const bf16*)(ws + WS_W2F), 256, MT, 2 * RW, F.G, bid);
              EpiLora2<0> E{(bf16*)(ws + WS_WLF), (bf16*)(ws + WS_WLB), F.in[I_W0F], F.in[I_W0B]}; pg8::gemm_phase(F.lds, 256, LA_LD, 256, S, E); }
            { pg8::StaticOrder S; S.init(loraA + 256, LA_LD, (const bf16*)(ws + WS_W2F + 2 * MiB), 256, MT, 2 * RW, F.G, bid);
              EpiLora2<1> E{(bf16*)(ws + WS_ICF), (bf16*)(ws + WS_ICB), F.in[I_A0F], F.in[I_A0B]}; pg8::gemm_phase(F.lds, 256, LA_LD, 256, S, E); }
            if (LSEL & 16) { pg8::StaticOrder S; S.init(loraA + 512, LA_LD, (const bf16*)(ws + WS_G2), GLORA, MT, RW, F.G, bid);
              EpiLora<2> E{(bf16*)(ws + WS_G), nullptr}; pg8::gemm_phase(F.lds, GLORA, LA_LD, GLORA, S, E); }
        }
    }
    SEAM(3);
    if (IN(4)) {
        constexpr int NSCAN = NB * RH * 2, NATT = NB * MH * (SEQ / 256);
        int s_begin = F.vcu, s_end = NSCAN, s_step = F.G, a_begin = F.vcu, a_step = F.G, a_cnt = (F.vcu < NATT) ? (NATT - 1 - F.vcu) / F.G + 1 : 0;
        if (EN_RWKV && EN_MLA && F.G == 256) { s_step = 1; a_step = 1;
            if (F.vcu < 128) { s_end = F.vcu + 1; a_begin = 384 + F.vcu; a_cnt = 1; } else { s_end = 0; a_begin = (F.vcu - 128) * 3; a_cnt = 3; } }
        if (EN_RWKV) for (int u = s_begin; u < s_end; u += s_step) { const int dir = u & 1, bh = u >> 1;
            if (dir) scan2::scan_unit<1>(F, bh >> 5, bh & 31); else scan2::scan_unit<0>(F, bh >> 5, bh & 31); }
        if (EN_MLA) for (int i = 0; i < a_cnt; ++i) { const int L = a_begin + i * a_step; const int qb = L & 15, bh = L >> 4, b = bh >> 4, h = bh & 15;
            att::attn_unit<ATT_DQK_TEST, MH * QKD, MH * QKD, MH * VDIM, DM>((const bf16*)(ws + WS_Q) + ((size_t)(b * SEQ + qb * 256) * (MH * QKD) + h * QKD),
                                (const bf16*)(ws + WS_K) + ((size_t)b * SEQ * (MH * QKD) + h * QKD),
                                (const bf16*)(ws + WS_V) + ((size_t)b * SEQ * (MH * VDIM) + h * VDIM),
                                (bf16*)(ws + WS_OMLA) + ((size_t)(b * SEQ + qb * 256) * DM + h * VDIM), SEQ, (LAS char*)F.lds); }
    }
    SEAM(4);
    if (IN(5)) { if (EN_RWKV) REP(5) p5_post(F); if (EN_MOE) REP(17) p5_expert_cvt(F); }
    SEAM(5);
    if (IN(6)) REP(6) {
        if (EN_MLA) { pg8::StaticOrder S; S.init((const bf16*)(ws + WS_OMLA), DM, (const bf16*)(ws + WS_WUPM), DM, MT, DM, F.G, bid);
            EpiUp<0> E{(bf16*)(ws + WS_MERGED), (const bf16*)(ws + WS_ZGATE), 0}; pg8::gemm_phase(F.lds, DM, DM, DM, S, E); }
        if (EN_RWKV) { pg8::StaticOrder S; S.init((const bf16*)(ws + WS_ORWKV), DM, (const bf16*)(ws + WS_WUPR), DM, MT, DM, F.G, bid);
            EpiUp<EN_MLA> E{(bf16*)(ws + WS_MERGED), (const bf16*)(ws + WS_ZGATE), DM}; pg8::gemm_phase(F.lds, DM, DM, DM, S, E); }
    }
    SEAM(6);
    if (IN(7)) REP(7) {
        if (EN_RWKV || EN_MLA) { pg8::StaticOrder S; S.init((const bf16*)(ws + WS_MERGED), DM, (const bf16*)(ws + WS_WOUT), DM, MT, DM, F.G, bid);
            EpiResid E{F.in[I_X], F.out}; pg8::gemm_phase(F.lds, DM, DM, DM, S, E); }
    }
    SEAM(7);
    if (IN(8)) { if (EN_CROSS || EN_MOE) p8_rowpass(F); }
    SEAM(8);
    if (IN(9)) REP(9) {
        if (EN_CROSS) { pg8::StaticOrder S; S.init((const bf16*)(ws + WS_H1B), DM, (const bf16*)(ws + WS_WQC), DM, MT, CW, F.G, bid);
            EpiPlain E{(bf16*)(ws + WS_QC), CW, rstd1 + 3 * MT, CSCALE}; pg8::gemm_phase(F.lds, DM, DM, DM, S, E); }
        if (EN_CROSS && bid >= 64) { pg8::StaticOrder S; S.init((const bf16*)(ws + WS_MEMN), DM, (const bf16*)(ws + WS_WKVC), DM, NB * MEMLEN, 2 * CW, F.G, bid - 64);
            EpiPlain E{(bf16*)(ws + WS_KVC), 2 * CW, nullptr, 1.f}; pg8::gemm_phase(F.lds, DM, DM, DM, S, E); }
    }
    SEAM(9);
    if (IN(10)) REP(10) {
        if (EN_CROSS) {
            for (int i = 0; ; ++i) { const int L = i * F.G + F.vcu; if (L >= NB * CH * (SEQ / 256)) break;
                const int qb = L & 15, bh = L >> 4, b = bh >> 2, h = bh & 3;
                att::attn_unit<CHD, CW, 2 * CW, 2 * CW, CW>((const bf16*)(ws + WS_QC) + ((size_t)(b * SEQ + qb * 256) * CW + h * CHD),
                                    (const bf16*)(ws + WS_KVC) + ((size_t)b * MEMLEN * (2 * CW) + h * CHD),
                                    (const bf16*)(ws + WS_KVC) + ((size_t)b * MEMLEN * (2 * CW) + CW + h * CHD),
                                    (bf16*)(ws + WS_OC) + ((size_t)(b * SEQ + qb * 256) * CW + h * CHD), MEMLEN, (LAS char*)F.lds); }
        }
    }
    SEAM(10);
    if (IN(11)) {
        if (EN_CROSS) { pg8::StaticOrder S; S.init((const bf16*)(ws + WS_OC), CW, (const bf16*)(ws + WS_WOC), CW, MT, DM, F.G, bid);
            EpiResid E{F.out, F.out}; pg8::gemm_phase(F.lds, CW, CW, CW, S, E); }
    }
    SEAM(11);
    if (IN(12)) { if (EN_MOE) p12_router(F); }
    SEAM(12);
    if (IN(13)) REP(13) {
        if (EN_MOE) { moe_table(F);
            MoeOrder S{(const volatile LAS int*)(F.MISC + 16), (const int*)(F.ctl + CW_CNT), (const int*)(ws + WS_LIST), (const char*)(ws + WS_N3), (const char*)(ws + WS_WGU), F.G, F.vcu, 2,
                       (size_t)1024 * DM * 2, (size_t)256 * DM * 2, true};
            EpiMoe1 E{(bf16*)(ws + WS_HID), (const int*)(F.ctl + CW_CNT), (const int*)(ws + WS_LIST), (const float*)(ws + WS_SLOTW), rstd1 + 4 * MT};
            pg8::gemm_phase(F.lds, DM, DM, DM, S, E); }
    }
    SEAM(13);
    if (IN(14)) REP(14) {
        if (EN_MOE) { moe_table(F);
            MoeOrder S{(const volatile LAS int*)(F.MISC + 16), (const int*)(F.ctl + CW_CNT), (const int*)(ws + WS_LIST), (const char*)(ws + WS_HID), (const char*)(ws + WS_WD), F.G, F.vcu, 3,
                       (size_t)DM * DE * 2, (size_t)256 * DE * 2, false};
            EpiMoe2 E{(bf16*)(ws + WS_YBUF)};
            pg8::gemm_phase(F.lds, DE, DE, DE, S, E); }
    }
    SEAM(14);
#ifdef PROBE_OFF
    if (IN(15)) { const int gt = F.vcu * 512 + F.tid, NGT = F.G * 512; const bf16* sb = (const bf16*)(ws + (size_t)PROBE_OFF * MiB);
        for (int i = gt; i < MT * DM; i += NGT) F.out[i] = (i < PROBE_N) ? bf2f(sb[i]) : 0.f; }
#else
    if (IN(15)) { p_final(F, EN_MOE != 0); }
#endif
    if (PROBE_TIME >= 0) { __syncthreads(); if (blockIdx.x == 0 && F.tid == 0) {
        const unsigned long long a = ((unsigned long long)F.MISC[65 + 2 * PROBE_TIME] << 32) | F.MISC[64 + 2 * PROBE_TIME], b = ((unsigned long long)F.MISC[65 + 2 * (PROBE_TIME + 1)] << 32) | F.MISC[64 + 2 * (PROBE_TIME + 1)];
        F.out[(size_t)(F.vcu * 8) * DM] += (float)(b - a) * 0.001f; } }
#undef IN
#undef SEAM
}

extern "C" void kernel_launch(void* const* d_in, const int* in_sizes, int n_in, void* d_out, int out_size, void* d_ws, size_t ws_size, hipStream_t stream) {
    static int grid = 0;
    if (grid == 0) {
        if (n_in != 41 || out_size != MT * DM || ws_size < WS_END) { fprintf(stderr, "kernel_launch: unexpected shapes n_in %d out %d ws %zu (need %zu)\n", n_in, out_size, ws_size, (size_t)WS_END); grid = -1; return; }
        int dev = 0, cus = 0, per_cu = 0;
        if (hipGetDevice(&dev) != hipSuccess || hipDeviceGetAttribute(&cus, hipDeviceAttributeMultiprocessorCount, dev) != hipSuccess) { grid = -1; return; }
        if (hipFuncSetAttribute((const void*)fwd_kernel, hipFuncAttributeMaxDynamicSharedMemorySize, LDS_BYTES) != hipSuccess) { fprintf(stderr, "kernel_launch: hipFuncSetAttribute failed\n"); grid = -1; return; }
        if (hipOccupancyMaxActiveBlocksPerMultiprocessor(&per_cu, (const void*)fwd_kernel, 512, LDS_BYTES) != hipSuccess || per_cu < 1) { fprintf(stderr, "kernel_launch: occupancy query says %d\n", per_cu); }
        (void)hipGetLastError();
        grid = cus;
    }
    if (grid < 0) return;
    (void)hipMemsetAsync((char*)d_ws + WS_CTL, 0, CTL_BYTES, stream);
    Args a{};
    for (int i = 0; i < 41; ++i) a.in[i] = (const float*)d_in[i];
    a.out = (float*)d_out; a.ws = (unsigned char*)d_ws;
#if N_LAUNCH_SPLIT
    for (int p = 0; p < NPHASE; ++p) { a.ph_lo = p; a.ph_hi = p + 1; hipLaunchKernelGGL(fwd_kernel, dim3(grid), dim3(512), LDS_BYTES, stream, a); }
#else
    a.ph_lo = 0; a.ph_hi = NPHASE;
    hipLaunchKernelGGL(fwd_kernel, dim3(grid), dim3(512), LDS_BYTES, stream, a);
#endif
}
```

```cpp
#include <hip/hip_runtime.h>
#include <cstdio>
#include <cstdint>

#ifndef SCAN_SEC
#define SCAN_SEC -1
#endif
#ifndef EN_RWKV
#define EN_RWKV 1
#endif
#ifndef EN_MLA
#define EN_MLA 1
#endif
#ifndef EN_CROSS
#define EN_CROSS 1
#endif
#ifndef EN_MOE
#define EN_MOE 1
#endif
#ifndef N_LAUNCH_SPLIT
#define N_LAUNCH_SPLIT 0
#endif

#define GAS __attribute__((address_space(1)))
#define LAS __attribute__((address_space(3)))
typedef unsigned short bf16;
typedef short bf16x8 __attribute__((ext_vector_type(8)));
typedef short s16x4 __attribute__((ext_vector_type(4)));
typedef float f32x4 __attribute__((ext_vector_type(4)));
typedef float f32x2 __attribute__((ext_vector_type(2)));
typedef float f32x16 __attribute__((ext_vector_type(16)));
typedef unsigned u32x4 __attribute__((ext_vector_type(4)));
typedef unsigned u32x2 __attribute__((ext_vector_type(2)));

constexpr int DM = 2048, NB = 2, SEQ = 4096, MT = NB * SEQ;
constexpr int MEMLEN = 256;
constexpr int QLORA = 512, KVLORA = 256, ROPE = 64, NOPE = 128, VDIM = 128, QKD = 192, MH = 16;
constexpr int RW = 2048, RH = 32, RHD = 64, DLORA = 96, GLORA = 256;
constexpr int MLA_IN = 832, RWKV_IN = 6784, GATE_IN = 4096, IN_W = MLA_IN + RWKV_IN + GATE_IN;
constexpr int CH = 4, CHD = 128, CW = 512;
constexpr int NG = 4, EPG = 8, NE = 32, DE = 512;
constexpr float RMS_EPS = 1e-6f, LNX_EPS = 64e-5f;
constexpr int G1_N = 12032;
constexpr int ZM_LD = 1024, ZR_LD = 6144, ZL_LD = 768, ZG_LD = 4096, LA_LD = 768;
constexpr int MOE_SLOTS = 2 * MT + NE * 256;

constexpr size_t MiB = 1u << 20;
constexpr size_t WS_CTL = 0, CTL_BYTES = 1 * MiB;
constexpr size_t WS_WUQ = 1 * MiB;
constexpr size_t WS_WUKV = 4 * MiB;
constexpr size_t WS_W2F = 6 * MiB;
constexpr size_t WS_G2 = 10 * MiB;
constexpr size_t WS_WUPM = 11 * MiB, WS_WUPR = 19 * MiB, WS_WOUT = 27 * MiB;
constexpr size_t WS_WQC = 35 * MiB;
constexpr size_t WS_WKVC = 37 * MiB;
constexpr size_t WS_WOC = 41 * MiB;
constexpr size_t WS_WIN = 43 * MiB;
constexpr size_t WS_MISC = 90 * MiB;
constexpr size_t WS_ROPE = WS_MISC;
constexpr size_t WS_MEMN = WS_MISC + 2 * MiB;
constexpr size_t WS_KVC = WS_MISC + 4 * MiB;
constexpr size_t WS_RSTD = WS_MISC + 5 * MiB;
constexpr size_t WS_WR = WS_RSTD + 256 * 1024;
constexpr size_t WS_LIST = WS_MISC + 6 * MiB;
constexpr size_t WS_ROUTE = WS_MISC + 7 * MiB;
constexpr size_t WS_SLOTW = WS_MISC + 8 * MiB;
constexpr size_t WS_XB = 100 * MiB;
constexpr size_t WS_ZMLA = 132 * MiB;
constexpr size_t WS_ZLORA = 148 * MiB;
constexpr size_t WS_LORAA = 160 * MiB;
constexpr size_t WS_ZRKV = 172 * MiB;
constexpr size_t WS_ZGATE = 268 * MiB;
constexpr size_t WS_Q = 332 * MiB;
constexpr size_t WS_K = 380 * MiB;
constexpr size_t WS_V = 428 * MiB;
constexpr size_t WS_WLF = 460 * MiB, WS_WLB = 492 * MiB, WS_ICF = 524 * MiB, WS_ICB = 556 * MiB;
constexpr size_t WS_G = 588 * MiB;
constexpr size_t WS_END = 620 * MiB;
constexpr size_t WS_YF = WS_WIN, WS_YB = WS_ZMLA, WS_ORWKV = WS_Q, WS_MERGED = WS_K, WS_QC = WS_V, WS_OC = WS_V + 8 * MiB;
constexpr size_t WS_WGU = WS_WLF, WS_WD = WS_ZRKV, WS_HID = WS_ZGATE, WS_YBUF = WS_Q;
constexpr size_t WS_OMLA = WS_XB, WS_H1B = WS_XB, WS_N3 = WS_XB;

constexpr int CW_BAR = 4096;
constexpr int CW_CNT = 16384;

constexpr int RING_BYTES = 159744;
constexpr int LDSCTL_OFF = RING_BYTES, MISC_OFF = LDSCTL_OFF + 320;
constexpr int LDS_BYTES = 161792;

#define LDS_WAIT() asm volatile("s_waitcnt lgkmcnt(0)" ::: "memory")
#define VM_WAIT() asm volatile("s_waitcnt vmcnt(0)" ::: "memory")
typedef __bf16 bf16x2_t __attribute__((ext_vector_type(2)));
__device__ __forceinline__ unsigned cvt_pk_bf16(float lo, float hi) { f32x2 v = {lo, hi}; bf16x2_t b = __builtin_convertvector(v, bf16x2_t); return __builtin_bit_cast(unsigned, b); }
__device__ __forceinline__ float bf2f(unsigned short b) { return __builtin_bit_cast(float, ((unsigned)b) << 16); }
__device__ __forceinline__ float bflo(unsigned w) { return __builtin_bit_cast(float, w << 16); }
__device__ __forceinline__ float bfhi(unsigned w) { return __builtin_bit_cast(float, w & 0xffff0000u); }
__device__ __forceinline__ unsigned short f2bf(float f) { return (unsigned short)(cvt_pk_bf16(f, 0.f) & 0xffffu); }
__device__ __forceinline__ float sigmoidf_(float x) { return __builtin_amdgcn_rcpf(1.0f + __builtin_amdgcn_exp2f(-1.4426950408889634f * x)); }
template <int CTRL> __device__ __forceinline__ float dpp_add_(float v) {
    return v + __builtin_bit_cast(float, __builtin_amdgcn_update_dpp(0, __builtin_bit_cast(int, v), CTRL, 0xF, 0xF, false));
}
__device__ __forceinline__ float wave_sum(float v) {
    v = dpp_add_<0xB1>(v); v = dpp_add_<0x4E>(v); v = dpp_add_<0x141>(v); v = dpp_add_<0x140>(v);
    const int iv = __builtin_bit_cast(int, v);
    const float s0 = __builtin_bit_cast(float, __builtin_amdgcn_readlane(iv, 0)), s1 = __builtin_bit_cast(float, __builtin_amdgcn_readlane(iv, 16));
    const float s2 = __builtin_bit_cast(float, __builtin_amdgcn_readlane(iv, 32)), s3 = __builtin_bit_cast(float, __builtin_amdgcn_readlane(iv, 48));
    return (s0 + s1) + (s2 + s3);
}

#define XB_TMO      128
#define XB_XCNT(j)  (256  + 64 * (j))
#define XB_XSUB(j)  (1280 + 64 * (j))
#define XB_XGEN(j)  (2304 + 64 * (j))
#define XB_TOP      3328
#define XB_TOPGEN   3392
#define XCD_BAR_WORDS 3456
#define XB_SPIN_CAP (1u << 18)
__device__ __forceinline__ unsigned xb_ld(unsigned* p)              { return __hip_atomic_load(p, __ATOMIC_RELAXED, __HIP_MEMORY_SCOPE_AGENT); }
__device__ __forceinline__ unsigned xb_add(unsigned* p, unsigned v) { return __hip_atomic_fetch_add(p, v, __ATOMIC_RELAXED, __HIP_MEMORY_SCOPE_AGENT); }
__device__ __forceinline__ unsigned xb_xcc_id() { return (unsigned)__builtin_amdgcn_s_getreg((3 << 11) | 20) & 0xFu; }
#define XB_SPIN(cond, bar) do { unsigned _sp = 0; while (cond) { __builtin_amdgcn_s_sleep(1); \
    if ((++_sp & 255u) == 0u) { if (xb_ld(&(bar)[XB_TMO])) break; if (_sp > XB_SPIN_CAP) { atomicAdd(&(bar)[XB_TMO], 1u); break; } } } } while (0)
struct XcdBarrier { unsigned* bar; unsigned x; volatile LAS unsigned* st; };
__device__ __forceinline__ XcdBarrier xcd_barrier_post(unsigned* bar, volatile LAS unsigned* st) {
    XcdBarrier b; b.bar = bar; b.x = xb_xcc_id(); b.st = st;
    if (threadIdx.x == 0) (void)xb_add(&bar[XB_XCNT(b.x)], 1u);
    return b;
}
__device__ __forceinline__ void xcd_barrier_complete(unsigned* bar, unsigned x, unsigned& nloc, unsigned& nx) {
    const unsigned G = gridDim.x * gridDim.y * gridDim.z;
    unsigned sum, cnt, mine, sp = 0u;
    for (;;) {
        sum = 0u; cnt = 0u; mine = 0u;
#pragma unroll
        for (unsigned j = 0; j < 16; ++j) { const unsigned c = xb_ld(&bar[XB_XCNT(j)]); sum += c; cnt += (c > 0u) ? 1u : 0u; mine = (j == x) ? c : mine; }
        if (sum == G) break;
        __builtin_amdgcn_s_sleep(1);
        if ((++sp & 255u) == 0u) { if (xb_ld(&bar[XB_TMO])) break; if (sp > XB_SPIN_CAP) { atomicAdd(&bar[XB_TMO], 1u); break; } }
    }
    nloc = mine > 0u ? mine : 1u; nx = cnt > 0u ? cnt : 1u;
}
__device__ __forceinline__ void xcd_barrier(const XcdBarrier& b) {
    asm volatile("s_waitcnt vmcnt(0)" ::: "memory");
    __syncthreads();
    if (threadIdx.x == 0) {
        unsigned* bar = b.bar;
        __builtin_amdgcn_s_waitcnt(0);
        unsigned nloc = b.st[0], nx = b.st[1];
        if (nloc == 0u) { xcd_barrier_complete(bar, b.x, nloc, nx); b.st[0] = nloc; b.st[1] = nx; }
        const unsigned old = xb_add(&bar[XB_XSUB(b.x)], 1u);
        const unsigned gen = old / nloc;
        if (old + 1u == (gen + 1u) * nloc) {
            __builtin_amdgcn_fence(__ATOMIC_RELEASE, "agent");
            asm volatile("s_waitcnt vmcnt(0)" ::: "memory");
            const unsigned og = xb_add(&bar[XB_TOP], 1u);
            const unsigned tg = og / nx;
            if (og + 1u == (tg + 1u) * nx) xb_add(&bar[XB_TOPGEN], 1u);
            else XB_SPIN(xb_ld(&bar[XB_TOPGEN]) == tg, bar);
            __builtin_amdgcn_fence(__ATOMIC_ACQUIRE, "agent");
            xb_add(&bar[XB_XGEN(b.x)], 1u);
            asm volatile("s_waitcnt vmcnt(0)" ::: "memory");
        } else {
            XB_SPIN(xb_ld(&bar[XB_XGEN(b.x)]) == gen, bar);
            __builtin_amdgcn_fence(__ATOMIC_ACQUIRE, "agent");
            asm volatile("s_waitcnt vmcnt(0)" ::: "memory");
        }
    }
    __syncthreads();
}

namespace pg8 {
constexpr int BM = 256, BK = 64, HALF = 128, HTB = HALF * BK * 2, STAGE_BYTES = 8 * HTB, NXCD = 8, WGM = 8;
__host__ __device__ __forceinline__ int lds_byte(int r, int c) { const int st = (r >> 4) * 2 + (c >> 5), rr = r & 15, cc = c & 31, ob = rr * 64 + cc * 2; return st * 1024 + (ob ^ (((ob >> 9) & 1) << 5)); }
__host__ __device__ __forceinline__ void stage_rc(int b, int& R, int& C) { const int st = b / 1024, sb = b % 1024, swz = sb ^ (((sb >> 9) & 1) << 5); R = (st >> 1) * 16 + swz / 64; C = (st & 1) * 32 + (swz % 64) / 2; }
__host__ __device__ __forceinline__ int perm32(int rho) { const int n = rho >> 4, i = rho & 15; return 8 * (i >> 2) + 4 * n + (i & 3); }

struct Unit { int pm, pn; const char* Ab; const char* Bb; int aux0, aux1; };

struct StaticOrder {
    static constexpr bool GATHER = false;
    int nM, nN, nwg, G, c; const char* A; const char* Bt; int lda, ldb;
    __device__ void init(const bf16* A_, int lda_, const bf16* Bt_, int ldb_, int M, int N, int G_, int c_) { A = (const char*)A_; Bt = (const char*)Bt_; lda = lda_; ldb = ldb_; nM = M / BM; nN = N / BM; nwg = nM * nN; G = G_; c = c_; }
    __device__ __forceinline__ bool next(int i, Unit& u) const {
        const long L = (long)i * G + c; if (L >= nwg) return false;
        int wgid = (int)L; { const int q = nwg / NXCD, r = nwg % NXCD, xcd = wgid % NXCD, off = wgid / NXCD; wgid = (xcd < r ? xcd * (q + 1) : r * (q + 1) + (xcd - r) * q) + off; }
        const int nig = WGM * nN, gid = wgid / nig, fm = gid * WGM, gsz = (nM - fm) < WGM ? (nM - fm) : WGM;
        u.pm = fm + ((wgid % nig) % gsz); u.pn = (wgid % nig) / gsz; u.Ab = A + (size_t)u.pm * BM * lda * 2; u.Bb = Bt + (size_t)u.pn * BM * ldb * 2; u.aux0 = 0; u.aux1 = 0; return true;
    }
    __device__ __forceinline__ unsigned arow(const Unit& u, int r) const { return (unsigned)r; }
};

#define PG8_ACC f32x4 (&acc)[2][2][4][2]
template <class Epi, class Sched>
__device__ __forceinline__ void gemm_phase(LAS unsigned char* lds, const int K, const int lda, const int ldb, const Sched& S, const Epi& E) {
    const int tid = threadIdx.x, wid = __builtin_amdgcn_readfirstlane(tid >> 6), lane = tid & 63, wr = wid >> 2, wc = wid & 3, fr = lane & 15, fq = lane >> 4;
    const int nt = K / BK;
    int sR[2], sC[2]; unsigned voffB[2];
#pragma unroll
    for (int i = 0; i < 2; ++i) { stage_rc(tid * 16 + i * 8192, sR[i], sC[i]); const int Rb = Epi::PERM ? ((sR[i] & ~31) + perm32(sR[i] & 31)) : sR[i];
        voffB[i] = (unsigned)(Rb * ldb + sC[i]) * 2u; }
    const size_t kstep = (size_t)(BK * 2);
    const size_t hstepB = (size_t)HALF * ldb * 2;
    const unsigned ldsw = (unsigned)wid * 1024u;
    const int aoff = lds_byte(wr * 64 + fr, fq * 8), boff = lds_byte(wc * 32 + fr, fq * 8);
#define PG8_SA(b, h) (((b) * 2 + (h)) * HTB)
#define PG8_SB(b, h) ((4 + (b) * 2 + (h)) * HTB)
#define PG8_STAGE(bufoff, gbase, voff) do { _Pragma("unroll") for (int _i = 0; _i < 2; ++_i) \
        __builtin_amdgcn_global_load_lds((const unsigned*)((const char*)(gbase) + (voff)[_i]), (LAS unsigned*)(lds + (bufoff) + ldsw + _i * 8192), 16, 0, 0); } while (0)
#define PG8_LDA(dst, b, h) do { _Pragma("unroll") for (int m = 0; m < 4; ++m) _Pragma("unroll") for (int k = 0; k < 2; ++k) dst[m][k] = *(const LAS bf16x8*)(lds + PG8_SA(b, h) + aoff + m * 2048 + k * 1024); } while (0)
#define PG8_LDB(dst, b, h) do { _Pragma("unroll") for (int n = 0; n < 2; ++n) _Pragma("unroll") for (int k = 0; k < 2; ++k) dst[n][k] = *(const LAS bf16x8*)(lds + PG8_SB(b, h) + boff + n * 2048 + k * 1024); } while (0)
#define PG8_MMA(ai, bj, At, Bt) do { __builtin_amdgcn_s_setprio(1); _Pragma("unroll") for (int m = 0; m < 4; ++m) _Pragma("unroll") for (int n = 0; n < 2; ++n) _Pragma("unroll") for (int k = 0; k < 2; ++k) \
        acc[ai][bj][m][n] = __builtin_amdgcn_mfma_f32_16x16x32_bf16(Bt[n][k], At[m][k], acc[ai][bj][m][n], 0, 0, 0); __builtin_amdgcn_s_setprio(0); } while (0)
#define PG8_WAIT_V(n) asm volatile("s_waitcnt vmcnt(" #n ")" ::: "memory")
#define PG8_WAIT_L(n) asm volatile("s_waitcnt lgkmcnt(" #n ")" ::: "memory")
#define PG8_BAR __builtin_amdgcn_s_barrier()
#define PG8_SCHED __builtin_amdgcn_sched_barrier(0)
#define PG8_SETVA(dst, u) do { _Pragma("unroll") for (int _h = 0; _h < 2; ++_h) _Pragma("unroll") for (int _i = 0; _i < 2; ++_i) \
        dst[_h][_i] = (S.arow(u, _h * HALF + sR[_i]) * (unsigned)lda + (unsigned)sC[_i]) * 2u; } while (0)
    Unit cur, nxt; int ui = 0;
    if (!S.next(0, cur)) return;
    f32x4 acc[2][2][4][2];
#pragma unroll
    for (int a = 0; a < 2; ++a)
#pragma unroll
        for (int b = 0; b < 2; ++b)
#pragma unroll
            for (int m = 0; m < 4; ++m)
#pragma unroll
                for (int n = 0; n < 2; ++n) acc[a][b][m][n] = (f32x4){0.f, 0.f, 0.f, 0.f};
    bf16x8 At[4][2], B0[2][2], B1[2][2];
    constexpr bool GA = Sched::GATHER;
    unsigned vA[2][2], nvA[2][2];
    PG8_SETVA(vA, cur);
    const char* cA = cur.Ab; const char* cB = cur.Bb;
    PG8_STAGE(PG8_SB(0, 0), cB, voffB); PG8_STAGE(PG8_SA(0, 0), cA, vA[0]); PG8_STAGE(PG8_SB(0, 1), cB + hstepB, voffB); PG8_STAGE(PG8_SA(0, 1), cA, vA[1]);
    if (wr == 1) PG8_BAR;
    PG8_WAIT_V(4); PG8_BAR;
    PG8_STAGE(PG8_SB(1, 0), cB + kstep, voffB); PG8_STAGE(PG8_SA(1, 0), cA + kstep, vA[0]); PG8_STAGE(PG8_SB(1, 1), cB + hstepB + kstep, voffB);
    PG8_WAIT_V(6); PG8_BAR;
    for (;;) {
        const bool has_next = S.next(ui + 1, nxt);
        const char* nA = cA; const char* nB = cB;
        if (has_next) { nA = nxt.Ab; nB = nxt.Bb; if (GA) PG8_SETVA(nvA, nxt); }
        else if (GA) {
#pragma unroll
            for (int h = 0; h < 2; ++h)
#pragma unroll
                for (int i = 0; i < 2; ++i) nvA[h][i] = vA[h][i]; }
#pragma unroll 1
        for (int t = 0; t < nt; t += 2) {
            const bool last = (t == nt - 2);
            const char* a1 = cA + (size_t)(t + 1) * kstep;
            const char* a2 = last ? nA : cA + (size_t)(t + 2) * kstep; const char* b2 = last ? nB : cB + (size_t)(t + 2) * kstep;
            const char* a3 = a2 + kstep; const char* b3 = b2 + kstep;
            unsigned s2[2][2];
#pragma unroll
            for (int h = 0; h < 2; ++h)
#pragma unroll
                for (int i = 0; i < 2; ++i) s2[h][i] = (GA && last) ? nvA[h][i] : vA[h][i];
            PG8_LDB(B0, 0, 0); PG8_SCHED; PG8_LDA(At, 0, 0); PG8_STAGE(PG8_SA(1, 1), a1, vA[1]);
            PG8_WAIT_L(8); PG8_BAR; PG8_WAIT_L(0); PG8_MMA(0, 0, At, B0); PG8_BAR; PG8_SCHED;
            PG8_LDB(B1, 0, 1); PG8_STAGE(PG8_SB(0, 0), b2, voffB);
            PG8_BAR; PG8_WAIT_L(0); PG8_MMA(0, 1, At, B1); PG8_BAR;
            PG8_LDA(At, 0, 1); PG8_STAGE(PG8_SA(0, 0), a2, s2[0]);
            PG8_BAR; PG8_WAIT_L(0); PG8_MMA(1, 0, At, B0); PG8_BAR; PG8_SCHED;
            PG8_STAGE(PG8_SB(0, 1), b2 + hstepB, voffB);
            PG8_WAIT_V(6); PG8_BAR; PG8_MMA(1, 1, At, B1); PG8_BAR;
            PG8_LDB(B0, 1, 0); PG8_SCHED; PG8_LDA(At, 1, 0); PG8_STAGE(PG8_SA(0, 1), a2, s2[1]);
            PG8_WAIT_L(8); PG8_BAR; PG8_WAIT_L(0); PG8_MMA(0, 0, At, B0); PG8_BAR; PG8_SCHED;
            PG8_LDB(B1, 1, 1); PG8_STAGE(PG8_SB(1, 0), b3, voffB);
            PG8_BAR; PG8_WAIT_L(0); PG8_MMA(0, 1, At, B1); PG8_BAR;
            PG8_LDA(At, 1, 1); PG8_STAGE(PG8_SA(1, 0), a3, s2[0]);
            PG8_BAR; PG8_WAIT_L(0); PG8_MMA(1, 0, At, B0); PG8_BAR; PG8_SCHED;
            PG8_STAGE(PG8_SB(1, 1), b3 + hstepB, voffB);
            PG8_WAIT_V(6); PG8_BAR; PG8_MMA(1, 1, At, B1); PG8_BAR;
        }
        { int fr_e = fr, fq_e = fq; asm volatile("" : "+v"(fr_e), "+v"(fq_e));
          E(acc, cur, wr, wc, fr_e, fq_e); }
        if (!has_next) break;
#pragma unroll
        for (int a = 0; a < 2; ++a)
#pragma unroll
            for (int b = 0; b < 2; ++b)
#pragma unroll
                for (int m = 0; m < 4; ++m)
#pragma unroll
                    for (int n = 0; n < 2; ++n) acc[a][b][m][n] = (f32x4){0.f, 0.f, 0.f, 0.f};
        cur = nxt; cA = nA; cB = nB; ++ui;
        if (GA) {
#pragma unroll
        for (int h = 0; h < 2; ++h)
#pragma unroll
            for (int i = 0; i < 2; ++i) vA[h][i] = nvA[h][i]; }
    }
    PG8_WAIT_V(0);
    if (wr == 0) PG8_BAR;
    PG8_BAR;
#undef PG8_SA
#undef PG8_SB
#undef PG8_STAGE
#undef PG8_LDA
#undef PG8_LDB
#undef PG8_MMA
#undef PG8_WAIT_V
#undef PG8_WAIT_L
#undef PG8_BAR
#undef PG8_SCHED
#undef PG8_SETVA
}
#define EPI_FOR(ai, m, bj) _Pragma("unroll") for (int ai = 0; ai < 2; ++ai) _Pragma("unroll") for (int m = 0; m < 4; ++m) _Pragma("unroll") for (int bj = 0; bj < 2; ++bj)
__device__ __forceinline__ u32x4 pack8(f32x4 v0, f32x4 v1) { u32x4 w; w.x = cvt_pk_bf16(v0[0], v0[1]); w.y = cvt_pk_bf16(v0[2], v0[3]); w.z = cvt_pk_bf16(v1[0], v1[1]); w.w = cvt_pk_bf16(v1[2], v1[3]); return w; }
}
using pg8::Unit;

struct EpiG1 {
    static constexpr bool PERM = true;
    const float* rstd; bf16 *zmla, *zrkv, *zlora, *zgate;
    __device__ __forceinline__ void operator()(const PG8_ACC, const Unit& u, int wr, int wc, int fr, int fq) const {
        bf16* base; int ld, c0;
        if (u.pn < 4) { base = zmla; ld = ZM_LD; c0 = u.pn * 256; } else if (u.pn < 28) { base = zrkv; ld = ZR_LD; c0 = (u.pn - 4) * 256; }
        else if (u.pn < 31) { base = zlora; ld = ZL_LD; c0 = (u.pn - 28) * 256; } else { base = zgate; ld = ZG_LD; c0 = (u.pn - 31) * 256; }
        const int col0 = c0 + wc * 32 + 8 * fq;
        EPI_FOR(ai, m, bj) { const int row = u.pm * 256 + ai * 128 + wr * 64 + m * 16 + fr; const float rs = rstd[row];
            *(u32x4*)(base + (size_t)row * ld + col0 + bj * 128) = pg8::pack8(acc[ai][bj][m][0] * rs, acc[ai][bj][m][1] * rs); }
    }
};
struct EpiPlain {
    static constexpr bool PERM = true;
    bf16* O; int ld; const float* rstd; float scale;
    __device__ __forceinline__ void operator()(const PG8_ACC, const Unit& u, int wr, int wc, int fr, int fq) const {
        const int col0 = u.pn * 256 + wc * 32 + 8 * fq;
        EPI_FOR(ai, m, bj) { const int row = u.pm * 256 + ai * 128 + wr * 64 + m * 16 + fr; const float rs = (rstd ? rstd[row] : 1.f) * scale;
            *(u32x4*)(O + (size_t)row * ld + col0 + bj * 128) = pg8::pack8(acc[ai][bj][m][0] * rs, acc[ai][bj][m][1] * rs); }
    }
};
constexpr float QSCALE = 0.07216878364870322f * 1.4426950408889634f;
constexpr float CSCALE = 0.08838834764831845f * 1.4426950408889634f;
struct EpiQ {
    static constexpr bool PERM = true;
    bf16* Q; const float* rstd; const float* cs;
    __device__ __forceinline__ void operator()(const PG8_ACC, const Unit& u, int wr, int wc, int fr, int fq) const {
        EPI_FOR(ai, m, bj) { const int row = u.pm * 256 + ai * 128 + wr * 64 + m * 16 + fr; const int col = u.pn * 256 + bj * 128 + wc * 32 + 8 * fq;
            const float rs = rstd[row] * QSCALE; f32x4 v0 = acc[ai][bj][m][0] * rs, v1 = acc[ai][bj][m][1] * rs;
            const int cih = col % QKD;
            if (cih >= NOPE) { const int i0 = (cih - NOPE) >> 1; const f32x4* t = (const f32x4*)(cs + ((size_t)row * 32 + i0) * 2);
                const f32x4 a = t[0], b = t[1];
                f32x4 r0, r1;
                r0[0] = v0[0] * a[0] - v0[1] * a[1]; r0[1] = v0[1] * a[0] + v0[0] * a[1]; r0[2] = v0[2] * a[2] - v0[3] * a[3]; r0[3] = v0[3] * a[2] + v0[2] * a[3];
                r1[0] = v1[0] * b[0] - v1[1] * b[1]; r1[1] = v1[1] * b[0] + v1[0] * b[1]; r1[2] = v1[2] * b[2] - v1[3] * b[3]; r1[3] = v1[3] * b[2] + v1[2] * b[3];
                v0 = r0; v1 = r1; }
            *(u32x4*)(Q + (size_t)row * (MH * QKD) + col) = pg8::pack8(v0, v1); }
    }
};
struct EpiKV {
    static constexpr bool PERM = true;
    bf16* Kb; bf16* Vb; const float* rstd;
    __device__ __forceinline__ void operator()(const PG8_ACC, const Unit& u, int wr, int wc, int fr, int fq) const {
        const int c = wc * 32 + 8 * fq;
        EPI_FOR(ai, m, bj) { const int row = u.pm * 256 + ai * 128 + wr * 64 + m * 16 + fr; const float rs = rstd[row];
            bf16* dst = bj == 0 ? Kb + (size_t)row * (MH * QKD) + u.pn * QKD + c : Vb + (size_t)row * (MH * VDIM) + u.pn * VDIM + c;
            *(u32x4*)dst = pg8::pack8(acc[ai][bj][m][0] * rs, acc[ai][bj][m][1] * rs); }
    }
};
template <int MODE> struct EpiLora {
    static constexpr bool PERM = true;
    bf16* O; const float* bias;
    __device__ __forceinline__ void operator()(const PG8_ACC, const Unit& u, int wr, int wc, int fr, int fq) const {
        EPI_FOR(ai, m, bj) { const int row = u.pm * 256 + ai * 128 + wr * 64 + m * 16 + fr; const int col = u.pn * 256 + bj * 128 + wc * 32 + 8 * fq;
            f32x4 v0 = acc[ai][bj][m][0], v1 = acc[ai][bj][m][1];
            if (MODE != 2) { const f32x4 b0 = *(const f32x4*)(bias + col), b1 = *(const f32x4*)(bias + col + 4);
#pragma unroll
                for (int j = 0; j < 4; ++j) { float s0 = sigmoidf_(v0[j] + b0[j]), s1 = sigmoidf_(v1[j] + b1[j]);
                    if (MODE == 0) { s0 *= -0.8750394f; s1 *= -0.8750394f; }
                    v0[j] = s0; v1[j] = s1; } }
            *(u32x4*)(O + (size_t)row * RW + col) = pg8::pack8(v0, v1); }
    }
};
template <int MODE> struct EpiLora2 {
    static constexpr bool PERM = true;
    bf16* O0; bf16* O1; const float* bias0; const float* bias1;
    __device__ __forceinline__ void operator()(const PG8_ACC, const Unit& u, int wr, int wc, int fr, int fq) const {
        const bool second = u.pn >= 8; bf16* O = second ? O1 : O0; const float* bias = second ? bias1 : bias0; const int pn = second ? u.pn - 8 : u.pn;
        EPI_FOR(ai, m, bj) { const int row = u.pm * 256 + ai * 128 + wr * 64 + m * 16 + fr; const int col = pn * 256 + bj * 128 + wc * 32 + 8 * fq;
            f32x4 v0 = acc[ai][bj][m][0], v1 = acc[ai][bj][m][1];
            const f32x4 b0 = *(const f32x4*)(bias + col), b1 = *(const f32x4*)(bias + col + 4);
#pragma unroll
            for (int j = 0; j < 4; ++j) { float s0 = sigmoidf_(v0[j] + b0[j]), s1 = sigmoidf_(v1[j] + b1[j]);
                if (MODE == 0) { s0 *= -0.8750394f; s1 *= -0.8750394f; }
                v0[j] = s0; v1[j] = s1; }
            *(u32x4*)(O + (size_t)row * RW + col) = pg8::pack8(v0, v1); }
    }
};
template <int SECOND> struct EpiUp {
    static constexpr bool PERM = true;
    bf16* O; const bf16* zg; int goff;
    __device__ __forceinline__ void operator()(const PG8_ACC, const Unit& u, int wr, int wc, int fr, int fq) const {
        EPI_FOR(ai, m, bj) { const int row = u.pm * 256 + ai * 128 + wr * 64 + m * 16 + fr; const int col = u.pn * 256 + bj * 128 + wc * 32 + 8 * fq;
            const u32x4 g = *(const u32x4*)(zg + (size_t)row * ZG_LD + goff + col);
            f32x4 v0 = acc[ai][bj][m][0], v1 = acc[ai][bj][m][1];
            v0[0] *= sigmoidf_(bflo(g.x)); v0[1] *= sigmoidf_(bfhi(g.x)); v0[2] *= sigmoidf_(bflo(g.y)); v0[3] *= sigmoidf_(bfhi(g.y));
            v1[0] *= sigmoidf_(bflo(g.z)); v1[1] *= sigmoidf_(bfhi(g.z)); v1[2] *= sigmoidf_(bflo(g.w)); v1[3] *= sigmoidf_(bfhi(g.w));
            bf16* dst = O + (size_t)row * DM + col;
            if (SECOND) { const u32x4 p = *(const u32x4*)dst;
                v0[0] += bflo(p.x); v0[1] += bfhi(p.x); v0[2] += bflo(p.y); v0[3] += bfhi(p.y); v1[0] += bflo(p.z); v1[1] += bfhi(p.z); v1[2] += bflo(p.w); v1[3] += bfhi(p.w); }
            *(u32x4*)dst = pg8::pack8(v0, v1); }
    }
};
struct EpiResid {
    static constexpr bool PERM = true;
    const float* base; float* out;
    __device__ __forceinline__ void operator()(const PG8_ACC, const Unit& u, int wr, int wc, int fr, int fq) const {
        EPI_FOR(ai, m, bj) { const int row = u.pm * 256 + ai * 128 + wr * 64 + m * 16 + fr; const int col = u.pn * 256 + bj * 128 + wc * 32 + 8 * fq;
            const size_t o = (size_t)row * DM + col; const f32x4 b0 = *(const f32x4*)(base + o), b1 = *(const f32x4*)(base + o + 4);
            *(f32x4*)(out + o) = b0 + acc[ai][bj][m][0]; *(f32x4*)(out + o + 4) = b1 + acc[ai][bj][m][1]; }
    }
};

namespace att {
constexpr int NW = 8, QBLK = 32, KVBLK = 64;
constexpr float THRL = 11.5f;
#define SBAR() __builtin_amdgcn_sched_barrier(0)
__device__ __forceinline__ int crow(int r, int hi) { return (r & 3) + 8 * (r >> 2) + 4 * hi; }
__device__ __forceinline__ void partialSM(f32x16& p, float& m_reg, float& alpha) {
    float pmax = p[0];
#pragma unroll
    for (int r = 1; r < 16; ++r) pmax = fmaxf(pmax, p[r]);
    { auto rr = __builtin_amdgcn_permlane32_swap(__float_as_uint(pmax), __float_as_uint(pmax), false, false);
      pmax = fmaxf(__uint_as_float(rr[0]), __uint_as_float(rr[1])); }
    float mn;
    if (__builtin_expect(__all(pmax - m_reg <= THRL), 1)) { mn = m_reg; alpha = 1.f; }
    else { mn = fmaxf(m_reg, pmax); alpha = __builtin_amdgcn_exp2f(m_reg - mn); m_reg = mn; }
#pragma unroll
    for (int r = 0; r < 16; ++r) p[r] = p[r] - mn;
#pragma unroll
    for (int r = 0; r < 8; ++r) p[r] = __builtin_amdgcn_exp2f(p[r]);
}
__device__ __forceinline__ void finishSM(f32x16& p, float alpha, float& l_reg, bf16x8& pa0, bf16x8& pa1) {
#pragma unroll
    for (int r = 8; r < 16; ++r) p[r] = __builtin_amdgcn_exp2f(p[r]);
    float ps = 0;
#pragma unroll
    for (int r = 0; r < 16; ++r) ps += p[r];
    { auto rr = __builtin_amdgcn_permlane32_swap(__float_as_uint(ps), __float_as_uint(ps), false, false);
      ps = __uint_as_float(rr[0]) + __uint_as_float(rr[1]); }
    l_reg = l_reg * alpha + ps;
#define PK4(P, BASE, OUT) do { unsigned a0 = cvt_pk_bf16(P[BASE + 0], P[BASE + 1]), a1 = cvt_pk_bf16(P[BASE + 2], P[BASE + 3]);   \
    unsigned b0 = cvt_pk_bf16(P[BASE + 4], P[BASE + 5]), b1 = cvt_pk_bf16(P[BASE + 6], P[BASE + 7]);                              \
    auto r0 = __builtin_amdgcn_permlane32_swap(a0, b0, false, false); auto r1 = __builtin_amdgcn_permlane32_swap(a1, b1, false, false); \
    u32x4 w = {r0[0], r1[0], r0[1], r1[1]}; OUT = *reinterpret_cast<bf16x8*>(&w); } while (0)
    PK4(p, 0, pa0); PK4(p, 8, pa1);
#undef PK4
}
template <int DQK> __device__ __forceinline__ int kswz(int row, int colB) { return row * (DQK * 2 + 16) + colB; }
template <int DQK> __device__ __forceinline__ void qkt(f32x16& p, const LAS char* Ks, const bf16x8* qr, int krow, int hi) {
    p = f32x16{};
#pragma unroll
    for (int d0 = 0; d0 < DQK / 16; ++d0) { const int cb = (d0 * 16 + hi * 8) * 2;
        bf16x8 b0 = *reinterpret_cast<const LAS bf16x8*>(Ks + kswz<DQK>(krow, cb));
        p = __builtin_amdgcn_mfma_f32_32x32x16_bf16(b0, qr[d0], p, 0, 0, 0); }
}
__device__ __forceinline__ int v_st(int k, int c) { const int kk = (k & ~0xC) | ((k & 4) << 1) | ((k & 8) >> 1); return ((kk >> 3) * 4 + (c >> 5)) * 512 + ((kk & 7) * 32 + (c & 31)) * 2; }
__device__ __forceinline__ int v_rd_base(int lane) { return ((lane & 3) << 3) | (((lane >> 2) & 3) << 6) | (((lane >> 4) & 1) << 5) | (((lane >> 5) & 1) << 8); }
constexpr int v_rd_off(int d0, int ks, int half) { return d0 * 512 + ks * 4096 + half * 2048; }
template <int OFF> __device__ __forceinline__ s16x4 tr_read(int vb) {
    s16x4 r; asm volatile("ds_read_b64_tr_b16 %0, %1 offset:%2" : "=&v"(r) : "v"(vb), "i"(OFF) : "memory"); return r;
}
template <int D0, int KH> __device__ __forceinline__ void pv_one(f32x16& od, int vb, bf16x8 pa0, bf16x8 pa1) {
    const s16x4 l0 = tr_read<v_rd_off(D0, 2 * KH, 0)>(vb), h0 = tr_read<v_rd_off(D0, 2 * KH, 1)>(vb), l1 = tr_read<v_rd_off(D0, 2 * KH + 1, 0)>(vb), h1 = tr_read<v_rd_off(D0, 2 * KH + 1, 1)>(vb);
    asm volatile("s_waitcnt lgkmcnt(0)" ::: "memory"); SBAR();
#define PK(L, H) (bf16x8){L[0], L[1], L[2], L[3], H[0], H[1], H[2], H[3]}
    od = __builtin_amdgcn_mfma_f32_32x32x16_bf16(pa0, PK(l0, h0), od, 0, 0, 0);
    od = __builtin_amdgcn_mfma_f32_32x32x16_bf16(pa1, PK(l1, h1), od, 0, 0, 0);
#undef PK
}
template <int KH> __device__ __forceinline__ void pv_d0(f32x16* o, int vb, bf16x8 pa0, bf16x8 pa1) {
    pv_one<0, KH>(o[0], vb, pa0, pa1); pv_one<1, KH>(o[1], vb, pa0, pa1); pv_one<2, KH>(o[2], vb, pa0, pa1); pv_one<3, KH>(o[3], vb, pa0, pa1);
}
template <int DQK, int LDQ, int LDK, int LDV, int LDO>
__device__ __forceinline__ void attn_unit(const bf16* __restrict__ Qb, const bf16* __restrict__ Kh, const bf16* __restrict__ Vh, bf16* __restrict__ Ob, const int seq, LAS char* lds) {
    constexpr int SHM_V = KVBLK * 128 * 2, SHM_K = KVBLK * (DQK * 2 + 16), KCH = DQK / 64;
    const int tid = threadIdx.x, wid = tid >> 6, lane = tid & 63, r32 = lane & 31, hi = lane >> 5;
    LAS char* V_lds = lds; LAS char* K_lds = lds + 2 * SHM_V;
    LAS float* wsf = (LAS float*)(lds + 2 * SHM_V + 2 * SHM_K) + wid * 64; LAS float* li_l = wsf; LAS float* al_l = wsf + 32;
    float m_reg = -1e30f, l_reg = 0; f32x16 o[4] = {}; bf16x8 qr[DQK / 16];
    const bf16* Qw = Qb + (long)(wid * QBLK + r32) * LDQ + hi * 8;
#pragma unroll
    for (int d0 = 0; d0 < DQK / 16; ++d0) qr[d0] = *reinterpret_cast<const bf16x8*>(Qw + d0 * 16);
    const int sr = tid >> 4, sc = (tid & 15) * 8, vst0 = v_st(sr, sc), vst1 = v_st(32 + sr, sc);
    unsigned kgo[KCH]; int klo[KCH];
#pragma unroll
    for (int i = 0; i < KCH; ++i) { const int id = tid + 512 * i, row = id / (DQK / 8), c8 = id % (DQK / 8); kgo[i] = (unsigned)(row * LDK + c8 * 8) * 2u; klo[i] = kswz<DQK>(row, c8 * 16); }
    const unsigned vgo0 = (unsigned)(sr * LDV + sc) * 2u, vgo1 = (unsigned)((32 + sr) * LDV + sc) * 2u;
    const int vb0 = (int)(uintptr_t)V_lds + v_rd_base(lane);
    bf16x8 vs0, vs1, ks[KCH];
#define SLOAD(k0) do { const char* _vt = (const char*)(Vh + (size_t)(k0) * LDV); const char* _kt = (const char*)(Kh + (size_t)(k0) * LDK); \
    vs0 = *reinterpret_cast<const bf16x8*>(_vt + vgo0); vs1 = *reinterpret_cast<const bf16x8*>(_vt + vgo1); \
    _Pragma("unroll") for (int _i = 0; _i < KCH; ++_i) ks[_i] = *reinterpret_cast<const bf16x8*>(_kt + kgo[_i]); } while (0)
#define SWRITE(b) do { *(LAS bf16x8*)(V_lds + (b) * SHM_V + vst0) = vs0; *(LAS bf16x8*)(V_lds + (b) * SHM_V + vst1) = vs1; \
    _Pragma("unroll") for (int _i = 0; _i < KCH; ++_i) *(LAS bf16x8*)(K_lds + (b) * SHM_K + klo[_i]) = ks[_i]; } while (0)
#define SWAIT() asm volatile("s_waitcnt vmcnt(0)" ::: "memory")
#define RESC(a) do { if (__any((a) < 1.f)) { if (hi == 0) al_l[r32] = (a); asm volatile("s_waitcnt lgkmcnt(0)" ::: "memory"); \
    _Pragma("unroll") for (int d = 0; d < 4; ++d) _Pragma("unroll") for (int r = 0; r < 16; ++r) o[d][r] *= al_l[crow(r, hi)]; } } while (0)
    f32x16 pA, pB; float alA, alB; bf16x8 pa0, pa1; const int NT = seq / KVBLK;
    SLOAD(0); SWAIT(); SWRITE(0); __syncthreads();
    if (1 < NT) SLOAD(KVBLK);
    qkt<DQK>(pA, K_lds, qr, r32, hi); partialSM(pA, m_reg, alA);
    if (1 < NT) { SWAIT(); SWRITE(1); } __syncthreads();
    if (2 < NT) SLOAD(2 * KVBLK);
    SBAR(); qkt<DQK>(pB, K_lds, qr, 32 + r32, hi);
    finishSM(pA, alA, l_reg, pa0, pa1); SBAR();
    pv_d0<0>(o, vb0, pa0, pa1); partialSM(pB, m_reg, alB); RESC(alB);
    for (int j = 1; j < NT; ++j) {
        const int cb = j & 1, pb = cb ^ 1;
        SBAR(); qkt<DQK>(pA, K_lds + cb * SHM_K, qr, r32, hi);
        finishSM(pB, alB, l_reg, pa0, pa1); SBAR();
        pv_d0<1>(o, vb0 + pb * SHM_V, pa0, pa1); partialSM(pA, m_reg, alA);
        __syncthreads(); if (j + 1 < NT) { SWAIT(); SWRITE(pb); }
        RESC(alA); __syncthreads();
        if (j + 2 < NT) SLOAD((j + 2) * KVBLK);
        SBAR(); qkt<DQK>(pB, K_lds + cb * SHM_K, qr, 32 + r32, hi);
        finishSM(pA, alA, l_reg, pa0, pa1); SBAR();
        pv_d0<0>(o, vb0 + cb * SHM_V, pa0, pa1); partialSM(pB, m_reg, alB); RESC(alB);
    }
    finishSM(pB, alB, l_reg, pa0, pa1); SBAR();
    pv_d0<1>(o, vb0 + ((NT - 1) & 1) * SHM_V, pa0, pa1);
    if (hi == 0) li_l[r32] = l_reg; asm volatile("s_waitcnt lgkmcnt(0)" ::: "memory");
    float rli[16];
#pragma unroll
    for (int r = 0; r < 16; ++r) rli[r] = __builtin_amdgcn_rcpf(li_l[crow(r, hi)]);
    bf16* Ow = Ob + (size_t)(wid * QBLK) * LDO;
    int r32e = r32, hie = hi; asm volatile("" : "+v"(r32e), "+v"(hie));
    const unsigned ob = (unsigned)(4 * hie * LDO + r32e);
#pragma unroll
    for (int r = 0; r < 16; ++r) {
#pragma unroll
        for (int d0 = 0; d0 < 4; ++d0) Ow[ob + (unsigned)(((r & 3) + 8 * (r >> 2)) * LDO + d0 * 32)] = f2bf(o[d0][r] * rli[r]); }
    __syncthreads();
#undef SLOAD
#undef SWRITE
#undef SWAIT
#undef RESC
}
}

struct Frame {
    LAS unsigned char* lds; volatile LAS unsigned* MISC; unsigned* ctl;
    int tid, lane, wave, vcu, G;
    unsigned char* ws; float* out;
    const float* in[41];
};
enum { I_X = 0, I_MEM, I_POS, I_GMIX, I_WIN, I_GQ, I_WUQ, I_GKV, I_WUKV, I_SHIFT, I_W0F, I_W2F, I_W0B, I_W2B, I_A0F, I_A2F, I_A0B, I_A2B, I_G2, I_KK, I_KA, I_RK,
       I_LNXG, I_LNXB, I_WUPM, I_WUPR, I_WOUT, I_GCROSS, I_GMEM, I_WQC, I_WKVC, I_WOC, I_GFFN, I_WRG, I_BRG, I_WRE, I_BRE, I_WEG, I_WEU, I_WED, I_GFINAL };

template <int MODE> __device__ __forceinline__ int rowmap(int n) {
    if (MODE == 1) {
        if (n < 768) return n;
        if (n < 832) { const int p = n - 768; return 768 + (p < 32 ? 2 * p : 2 * (p - 32) + 1); }
        if (n < 6976) return 1024 + (n - 832);
        if (n < 7616) return 7168 + (n - 6976);
        return 7936 + (n - 7616);
    }
    if (MODE == 2) {
        const int h = n / QKD, d = n % QKD; if (d < NOPE) return n; const int p = d - NOPE; return h * QKD + NOPE + (p < 32 ? 2 * p : 2 * (p - 32) + 1);
    }
    if (MODE == 3) return (n >> 7) * 256 + (n & 127);
    if (MODE == 4) return (n >> 7) * 256 + 128 + (n & 127);
    return n;
}
constexpr int CVT_SCR = 16640;
template <int MODE> __device__ __forceinline__ void cvt_item(const float* W, int K, int N, const float* gain, bf16* WT, int ldt, LAS float* scr, int item, int lane, int kofs = 0) {
    const int nblk = N / 64, kb = item / nblk, nb = item % nblk, k0 = 64 * kb, n0 = 64 * nb;
    const int kq = lane >> 4, nc = (lane & 15) * 4;
    f32x4 v[16];
#pragma unroll
    for (int i = 0; i < 16; ++i) { const int k = k0 + 4 * i + kq - kofs; v[i] = (f32x4){0.f, 0.f, 0.f, 0.f};
        if (k >= 0 && k < K) { v[i] = *(const f32x4*)(W + (size_t)k * N + n0 + nc); if (gain) v[i] = v[i] * gain[k]; } }
#pragma unroll
    for (int i = 0; i < 16; ++i) { const int kk = 4 * i + kq;
#pragma unroll
        for (int c = 0; c < 4; ++c) scr[(nc + c) * 65 + kk] = v[i][c]; }
    LDS_WAIT(); asm volatile("" ::: "memory");
    const int kc = (lane & 7) * 8;
#pragma unroll
    for (int jj = 0; jj < 8; ++jj) { const int n = (lane >> 3) + 8 * jj; const LAS float* s = scr + n * 65 + kc;
        u32x4 o; o.x = cvt_pk_bf16(s[0], s[1]); o.y = cvt_pk_bf16(s[2], s[3]); o.z = cvt_pk_bf16(s[4], s[5]); o.w = cvt_pk_bf16(s[6], s[7]);
        *(u32x4*)(WT + (size_t)rowmap<MODE>(n0 + n) * ldt + k0 + kc) = o; }
    LDS_WAIT(); asm volatile("" ::: "memory");
}
#define CVT_JOB(MODE, src, K, N, gain, dst, ldt) { const int _n = (((K) + 63) / 64) * ((N) / 64); if (r < _n) { cvt_item<MODE>(src, K, N, gain, dst, ldt, scr, r, F.lane); continue; } r -= _n; }
#define CVT_JOB_PAD(src, K, N, dst, KPAD, KOFS) { const int _n = ((KPAD) / 64) * ((N) / 64); if (r < _n) { cvt_item<0>(src, K, N, nullptr, dst, KPAD, scr, r, F.lane, KOFS); continue; } r -= _n; }
struct CvtD { const float* W; const float* gain; bf16* WT; int K, N, ldt, mode, kofs, item; };
__device__ __forceinline__ int rowmap_rt(int mode, int n) { return mode == 1 ? rowmap<1>(n) : mode == 2 ? rowmap<2>(n) : mode == 3 ? rowmap<3>(n) : mode == 4 ? rowmap<4>(n) : n; }
__device__ __forceinline__ void cvt_load(const CvtD& d, int lane, f32x4 (&v)[16], float (&g)[16]) {
    const int nblk = d.N / 64, kb = d.item / nblk, nb = d.item % nblk, k0 = 64 * kb, n0 = 64 * nb; const int kq = lane >> 4, nc = (lane & 15) * 4;
#pragma unroll
    for (int i = 0; i < 16; ++i) { const int k = k0 + 4 * i + kq - d.kofs; v[i] = (f32x4){0.f, 0.f, 0.f, 0.f}; g[i] = 1.f;
        if (k >= 0 && k < d.K) { v[i] = *(const f32x4*)(d.W + (size_t)k * d.N + n0 + nc); if (d.gain) g[i] = d.gain[k]; } }
}
__device__ __forceinline__ void cvt_process(const CvtD& d, int lane, f32x4 (&v)[16], float (&g)[16], LAS float* scr) {
    const int nblk = d.N / 64, kb = d.item / nblk, nb = d.item % nblk, k0 = 64 * kb, n0 = 64 * nb; const int kq = lane >> 4, nc = (lane & 15) * 4;
#pragma unroll
    for (int i = 0; i < 16; ++i) { const int kk = 4 * i + kq;
#pragma unroll
        for (int c = 0; c < 4; ++c) scr[(nc + c) * 65 + kk] = v[i][c] * g[i]; }
    LDS_WAIT(); asm volatile("" ::: "memory");
    const int kc = (lane & 7) * 8;
#pragma unroll
    for (int jj = 0; jj < 8; ++jj) { const int n = (lane >> 3) + 8 * jj; const LAS float* s = scr + n * 65 + kc;
        u32x4 o; o.x = cvt_pk_bf16(s[0], s[1]); o.y = cvt_pk_bf16(s[2], s[3]); o.z = cvt_pk_bf16(s[4], s[5]); o.w = cvt_pk_bf16(s[6], s[7]);
        *(u32x4*)(d.WT + (size_t)rowmap_rt(d.mode, n0 + n) * d.ldt + k0 + kc) = o; }
    LDS_WAIT(); asm volatile("" ::: "memory");
}
#define CVT_PIPE(TOTAL_, DESC_) do { CvtD dA, dB; f32x4 vA[16], vB[16]; float gA[16], gB[16]; int it = gw; \
        if (it < (TOTAL_)) { DESC_(it, dA); cvt_load(dA, F.lane, vA, gA); } \
        for (; it < (TOTAL_); it += 2 * NGW) { const int itn = it + NGW, itn2 = it + 2 * NGW; \
            if (itn < (TOTAL_)) { DESC_(itn, dB); cvt_load(dB, F.lane, vB, gB); } \
            cvt_process(dA, F.lane, vA, gA, scr); \
            if (itn2 < (TOTAL_)) { DESC_(itn2, dA); cvt_load(dA, F.lane, vA, gA); } \
            if (itn < (TOTAL_)) cvt_process(dB, F.lane, vB, gB, scr); } } while (0)

__device__ __forceinline__ void p0_prologue(Frame& F) {
    LAS float* scr = (LAS float*)(F.lds + F.wave * CVT_SCR);
    const int gw = F.vcu * 8 + F.wave, NGW = F.G * 8;
    unsigned char* ws = F.ws;
    constexpr int TOTAL = 32 * (IN_W / 64) + 8 * 48 + 4 * 64 + 4 * (4 * 32) + 4 * 32 + 3 * (32 * 32) + 32 * 8 + 32 * 16 + 8 * 32;
#define P0_SETD(d, mode_, src_, K_, N_, gain_, dst_, ldt_, KPAD_, KOFS_) { const int _n = ((KPAD_) / 64) * ((N_) / 64); if (r < _n) { d.W = src_; d.gain = gain_; d.WT = dst_; d.K = K_; d.N = N_; d.ldt = ldt_; d.mode = mode_; d.kofs = KOFS_; d.item = r; break; } r -= _n; }
#define P0_DESC(it_, d) do { int r = (it_); \
        P0_SETD(d, 1, F.in[I_WIN], DM, IN_W, F.in[I_GMIX], (bf16*)(ws + WS_WIN), DM, DM, 0) \
        P0_SETD(d, 2, F.in[I_WUQ], QLORA, MH * QKD, F.in[I_GQ], (bf16*)(ws + WS_WUQ), QLORA, QLORA, 0) \
        P0_SETD(d, 0, F.in[I_WUKV], KVLORA, MH * 256, F.in[I_GKV], (bf16*)(ws + WS_WUKV), KVLORA, KVLORA, 0) \
        P0_SETD(d, 0, F.in[I_W2F], DLORA, RW, nullptr, (bf16*)(ws + WS_W2F), 256, 256, 0) \
        P0_SETD(d, 0, F.in[I_W2B], DLORA, RW, nullptr, (bf16*)(ws + WS_W2F + 1 * MiB), 256, 256, 128) \
        P0_SETD(d, 0, F.in[I_A2F], DLORA, RW, nullptr, (bf16*)(ws + WS_W2F + 2 * MiB), 256, 256, 0) \
        P0_SETD(d, 0, F.in[I_A2B], DLORA, RW, nullptr, (bf16*)(ws + WS_W2F + 3 * MiB), 256, 256, 128) \
        P0_SETD(d, 0, F.in[I_G2], GLORA, RW, nullptr, (bf16*)(ws + WS_G2), GLORA, GLORA, 0) \
        P0_SETD(d, 0, F.in[I_WUPM], DM, DM, nullptr, (bf16*)(ws + WS_WUPM), DM, DM, 0) \
        P0_SETD(d, 0, F.in[I_WUPR], DM, DM, nullptr, (bf16*)(ws + WS_WUPR), DM, DM, 0) \
        P0_SETD(d, 0, F.in[I_WOUT], DM, DM, nullptr, (bf16*)(ws + WS_WOUT), DM, DM, 0) \
        P0_SETD(d, 0, F.in[I_WQC], DM, CW, F.in[I_GCROSS], (bf16*)(ws + WS_WQC), DM, DM, 0) \
        P0_SETD(d, 0, F.in[I_WKVC], DM, 2 * CW, nullptr, (bf16*)(ws + WS_WKVC), DM, DM, 0) \
        P0_SETD(d, 0, F.in[I_WOC], CW, DM, nullptr, (bf16*)(ws + WS_WOC), CW, CW, 0) \
    } while (0)
    CVT_PIPE(TOTAL, P0_DESC);
#undef P0_SETD
#undef P0_DESC
    const float* x = F.in[I_X]; bf16* xb = (bf16*)(ws + WS_XB); float* rstd1 = (float*)(ws + WS_RSTD);
    for (int m = gw; m < MT + NB * MEMLEN; m += NGW) {
        const bool ismem = m >= MT; const int mm = ismem ? m - MT : m;
        const f32x4* xr = (const f32x4*)((ismem ? F.in[I_MEM] : x) + (size_t)mm * DM) + F.lane;
        f32x4 v[8]; float s = 0.f;
#pragma unroll
        for (int j = 0; j < 8; ++j) { v[j] = xr[64 * j]; s += (v[j].x * v[j].x + v[j].y * v[j].y) + (v[j].z * v[j].z + v[j].w * v[j].w); }
        const float rs = 1.0f / sqrtf(wave_sum(s) * (1.f / DM) + RMS_EPS);
        if (!ismem) { if (F.lane == 0) rstd1[mm] = rs;
            u32x2* o8 = (u32x2*)(xb + (size_t)mm * DM) + F.lane;
#pragma unroll
            for (int j = 0; j < 8; ++j) { u32x2 w; w.x = cvt_pk_bf16(v[j].x, v[j].y); w.y = cvt_pk_bf16(v[j].z, v[j].w); o8[64 * j] = w; }
        } else { const f32x4* gr = (const f32x4*)F.in[I_GMEM] + F.lane;
            u32x2* o8 = (u32x2*)((bf16*)(ws + WS_MEMN) + (size_t)mm * DM) + F.lane;
#pragma unroll
            for (int j = 0; j < 8; ++j) { const f32x4 g = gr[64 * j]; u32x2 w; w.x = cvt_pk_bf16(v[j].x * rs * g.x, v[j].y * rs * g.y); w.y = cvt_pk_bf16(v[j].z * rs * g.z, v[j].w * rs * g.w); o8[64 * j] = w; }
        }
    }
    const int gt = F.vcu * 512 + F.tid, NGT = F.G * 512;
    { const int* pos = (const int*)F.in[I_POS]; f32x2* cs = (f32x2*)(ws + WS_ROPE);
      for (int i = gt; i < MT * 32; i += NGT) { const int t = i >> 5, f = i & 31;
          const float inv = exp2f(-(float)f * (13.287712379549449f / 32.0f));
          const float ang = (float)pos[t] * inv;
          const double a = (double)ang; const double k = rint(a * 0.15915494309189535); const float red = (float)(a - k * 6.283185307179586);
          cs[i] = (f32x2){cosf(red), sinf(red)}; } }
    { float* WR = (float*)(ws + WS_WR); const float* gf = F.in[I_GFFN];
      for (int i = gt; i < DM * 36; i += NGT) { const int k = i / 36, c = i % 36; float w;
          if (c < 4) w = F.in[I_WRG][k * 4 + c]; else { const int gi = (c - 4) >> 3, e = (c - 4) & 7; w = F.in[I_WRE][((size_t)gi * DM + k) * 8 + e]; }
          WR[i] = w * gf[k]; } }
}

__device__ __forceinline__ void p_final(Frame& F, bool with_moe) {
    const int gw = F.vcu * 8 + F.wave, NGW = F.G * 8;
    const f32x4* gr = (const f32x4*)F.in[I_GFINAL] + F.lane;
    const int* route = (const int*)(F.ws + WS_ROUTE); const bf16* ybuf = (const bf16*)(F.ws + WS_YBUF);
    const int* cnts = (const int*)(F.ctl + CW_CNT);
    for (int m = gw; m < MT; m += NGW) {
        f32x4* xr = (f32x4*)(F.out + (size_t)m * DM) + F.lane;
        f32x4 v[8];
#pragma unroll
        for (int j = 0; j < 8; ++j) v[j] = xr[64 * j];
        if (with_moe) {
#pragma unroll
            for (int kx = 0; kx < 2; ++kx) { const int e = route[m * 8 + 2 * kx], pos = route[m * 8 + 2 * kx + 1];
                int base = 0; for (int q = 0; q < e; ++q) base += (cnts[64 * q] + 255) & ~255;
                const u32x2* yr = (const u32x2*)(ybuf + (size_t)(base + pos) * DM) + F.lane;
#pragma unroll
                for (int j = 0; j < 8; ++j) { const u32x2 w = yr[64 * j]; v[j].x += bflo(w.x); v[j].y += bfhi(w.x); v[j].z += bflo(w.y); v[j].w += bfhi(w.y); } }
        }
        float s = 0.f;
#pragma unroll
        for (int j = 0; j < 8; ++j) s += (v[j].x * v[j].x + v[j].y * v[j].y) + (v[j].z * v[j].z + v[j].w * v[j].w);
        const float rs = 1.0f / sqrtf(wave_sum(s) * (1.f / DM) + RMS_EPS);
#pragma unroll
        for (int j = 0; j < 8; ++j) { const f32x4 g = gr[64 * j]; xr[64 * j] = (f32x4){v[j].x * rs * g.x, v[j].y * rs * g.y, v[j].z * rs * g.z, v[j].w * rs * g.w}; }
    }
}
__device__ __forceinline__ void p_copy_x(Frame& F) {
    const int gt = F.vcu * 512 + F.tid, NGT = F.G * 512; const f32x4* s = (const f32x4*)F.in[I_X]; f32x4* d = (f32x4*)F.out;
    for (int i = gt; i < MT * DM / 4; i += NGT) d[i] = s[i];
}

__device__ __forceinline__ void p2_rowpass(Frame& F) {
    const int gw = F.vcu * 8 + F.wave, NGW = F.G * 8, l = F.lane;
    unsigned char* ws = F.ws;
    const bf16* zm = (const bf16*)(ws + WS_ZMLA); const bf16* zl = (const bf16*)(ws + WS_ZLORA); bf16* la = (bf16*)(ws + WS_LORAA);
    float* rstd_q = (float*)(ws + WS_RSTD) + MT; float* rstd_kv = (float*)(ws + WS_RSTD) + 2 * MT;
    const f32x2* cs = (const f32x2*)(ws + WS_ROPE); bf16* Kb = (bf16*)(ws + WS_K);
    const float* sh = F.in[I_SHIFT] + 6144;
    f32x2 s0[5], s1[5], s2[5];
#pragma unroll
    for (int i = 0; i < 5; ++i) { const int j = 2 * l + 128 * i; s0[i] = *(const f32x2*)(sh + j); s1[i] = *(const f32x2*)(sh + RWKV_IN + j); s2[i] = *(const f32x2*)(sh + 2 * RWKV_IN + j); }
    for (int t = gw; t < MT; t += NGW) {
        const bf16* zr = zm + (size_t)t * ZM_LD;
        { const u32x4 w = *((const u32x4*)zr + l); float s = 0.f;
          s += bflo(w.x) * bflo(w.x) + bfhi(w.x) * bfhi(w.x) + bflo(w.y) * bflo(w.y) + bfhi(w.y) * bfhi(w.y) + bflo(w.z) * bflo(w.z) + bfhi(w.z) * bfhi(w.z) + bflo(w.w) * bflo(w.w) + bfhi(w.w) * bfhi(w.w);
          s = wave_sum(s); if (l == 0) rstd_q[t] = 1.0f / sqrtf(s * (1.f / QLORA) + RMS_EPS); }
        { const u32x2 w = *((const u32x2*)(zr + QLORA) + l); float s = bflo(w.x) * bflo(w.x) + bfhi(w.x) * bfhi(w.x) + bflo(w.y) * bflo(w.y) + bfhi(w.y) * bfhi(w.y);
          s = wave_sum(s); if (l == 0) rstd_kv[t] = 1.0f / sqrtf(s * (1.f / KVLORA) + RMS_EPS); }
        { const int i = l & 31, hs = l >> 5; const unsigned w = *((const unsigned*)(zr + 768) + i); const float x1 = bflo(w), x2 = bfhi(w); const f32x2 c = cs[(size_t)t * 32 + i];
          const unsigned o = cvt_pk_bf16(x1 * c.x - x2 * c.y, x2 * c.x + x1 * c.y);
#pragma unroll
          for (int hh = 0; hh < 8; ++hh) *((unsigned*)(Kb + (size_t)t * (MH * QKD) + (hs * 8 + hh) * QKD + NOPE) + i) = o; }
        const int s = t % SEQ; const float fp = s > 0 ? 1.f : 0.f, fn = s < SEQ - 1 ? 1.f : 0.f;
        const bf16* z0 = zl + (size_t)t * ZL_LD; const bf16* zp = s > 0 ? z0 - ZL_LD : z0; const bf16* zn = s < SEQ - 1 ? z0 + ZL_LD : z0;
        bf16* lr = la + (size_t)t * LA_LD;
#pragma unroll
        for (int i = 0; i < 5; ++i) { const int j = 2 * l + 128 * i;
            const unsigned wp = *(const unsigned*)(zp + j), w0 = *(const unsigned*)(z0 + j), wn = *(const unsigned*)(zn + j);
            float va = s0[i].x * fp * bflo(wp) + s1[i].x * bflo(w0) + s2[i].x * fn * bflo(wn);
            float vb = s0[i].y * fp * bfhi(wp) + s1[i].y * bfhi(w0) + s2[i].y * fn * bfhi(wn);
            int dst;
            if (j < 192) { va = tanhf(va); vb = tanhf(vb); dst = (j / 96) * 128 + (j % 96); } else if (j < 384) { dst = (j / 96) * 128 + (j % 96); } else { va = sigmoidf_(va); vb = sigmoidf_(vb); dst = 512 + (j - 384); }
            *(unsigned*)(lr + dst) = cvt_pk_bf16(va, vb); }
        { const int p = 2 * l; *(unsigned*)(lr + (p >> 5) * 128 + 96 + (p & 31)) = 0u; }
    }
}

namespace scan {
constexpr int TC = 16, DATA_B = TC * 6 * 64 * 4, BUF_B = DATA_B + 64 + TC * 32 * 4;
template <int CTRL> __device__ __forceinline__ float dpp_add(float v) {
    return v + __builtin_bit_cast(float, __builtin_amdgcn_update_dpp(0, __builtin_bit_cast(int, v), CTRL, 0xF, 0xF, false));
}
__device__ __forceinline__ float red16(float v) { v = dpp_add<0xB1>(v); v = dpp_add<0x4E>(v); v = dpp_add<0x141>(v); v = dpp_add<0x140>(v); return v; }
struct Raw { unsigned short r[3], k[3], v[3], wl, ic; };
template <int VAR> __device__ __forceinline__ void scan_unit(Frame& F, const int b, const int h, const int dir, const int half) {
    unsigned char* ws = F.ws; const int l = F.lane, w = F.wave, tid = F.tid;
    const bf16* zr = (const bf16*)(ws + WS_ZRKV) + (size_t)b * SEQ * ZR_LD + h * 64 + l;
    const bf16* wlp = (const bf16*)(ws + (dir ? WS_WLB : WS_WLF)) + (size_t)b * SEQ * RW + h * 64 + l;
    const bf16* icp = (const bf16*)(ws + (dir ? WS_ICB : WS_ICF)) + (size_t)b * SEQ * RW + h * 64 + l;
    bf16* yout = (bf16*)(ws + (dir ? WS_YB : WS_YF)) + (size_t)b * SEQ * RW + h * 64 + half * 32;
    const int ch = h * 64 + l; const float* sh = F.in[I_SHIFT];
    const float sr0 = sh[ch], sr1 = sh[RWKV_IN + ch], sr2 = sh[2 * RWKV_IN + ch];
    const float sk0 = sh[2048 + ch], sk1 = sh[RWKV_IN + 2048 + ch], sk2 = sh[2 * RWKV_IN + 2048 + ch];
    const float sv0 = sh[4096 + ch], sv1 = sh[RWKV_IN + 4096 + ch], sv2 = sh[2 * RWKV_IN + 4096 + ch];
    const float kk_c = F.in[I_KK][ch], ka_c = F.in[I_KA][ch], rk_c = F.in[I_RK][ch];
    LAS unsigned char* L = F.lds;
    Raw raw[2];
#define SC_TOK(ci, i) (dir ? (SEQ - 1 - ((ci) * TC + (i))) : ((ci) * TC + (i)))
#define SC_LOAD(ci) do { _Pragma("unroll") for (int q = 0; q < 2; ++q) { const int s = SC_TOK(ci, 2 * w + q); const int sp = s > 0 ? s - 1 : s, sn = s < SEQ - 1 ? s + 1 : s; \
        const bf16* z0 = zr + (size_t)s * ZR_LD; const bf16* zp = zr + (size_t)sp * ZR_LD; const bf16* zn = zr + (size_t)sn * ZR_LD; \
        raw[q].r[0] = zp[0]; raw[q].r[1] = z0[0]; raw[q].r[2] = zn[0]; raw[q].k[0] = zp[2048]; raw[q].k[1] = z0[2048]; raw[q].k[2] = zn[2048]; \
        raw[q].v[0] = zp[4096]; raw[q].v[1] = z0[4096]; raw[q].v[2] = zn[4096]; raw[q].wl = wlp[(size_t)s * RW]; raw[q].ic = icp[(size_t)s * RW]; } } while (0)
#define SC_PREP(ci, bufi) do { _Pragma("unroll") for (int q = 0; q < 2; ++q) { const int i = 2 * w + q; const int s = SC_TOK(ci, i); const float fp = s > 0 ? 1.f : 0.f, fn = s < SEQ - 1 ? 1.f : 0.f; \
        const float r_s = sr0 * fp * bf2f(raw[q].r[0]) + sr1 * bf2f(raw[q].r[1]) + sr2 * fn * bf2f(raw[q].r[2]); \
        const float k_s = sk0 * fp * bf2f(raw[q].k[0]) + sk1 * bf2f(raw[q].k[1]) + sk2 * fn * bf2f(raw[q].k[2]); \
        const float v_s = sv0 * fp * bf2f(raw[q].v[0]) + sv1 * bf2f(raw[q].v[1]) + sv2 * fn * bf2f(raw[q].v[2]); \
        const float kkr = k_s * kk_c; const float ss = wave_sum(kkr * kkr); const float kk = kkr * (1.0f / sqrtf(ss + 1e-12f)); \
        const float icv = bf2f(raw[q].ic); const float kd = k_s * (1.0f + (icv - 1.0f) * ka_c); const float bb = kk * icv; const float wd = __builtin_amdgcn_exp2f(bf2f(raw[q].wl)); \
        const float bon = wave_sum(r_s * kd * rk_c); \
        LAS float* d = (LAS float*)(L + (bufi) * BUF_B) + i * 384 + l; d[0] = wd; d[64] = kk; d[128] = bb; d[192] = kd; d[256] = r_s; d[320] = v_s; \
        if (l == 0) ((LAS float*)(L + (bufi) * BUF_B + DATA_B))[i] = bon; } } while (0)
    const int g = l >> 4, j = l & 15, row = half * 32 + w * 4 + g;
    f32x2 Sa = {0.f, 0.f}, Sb = {0.f, 0.f};
    struct Ops { f32x4 w, a, b, k, r; float v, bon; };
#define SC_LD(O, i) do { O.w = p4[(i) * 96 + j]; O.a = p4[(i) * 96 + 16 + j]; O.b = p4[(i) * 96 + 32 + j]; O.k = p4[(i) * 96 + 48 + j]; O.r = p4[(i) * 96 + 64 + j]; \
        O.v = pf[(i) * 384 + 320 + row]; O.bon = pb[i]; } while (0)
#define SC_STEP(O, YP) do { f32x2 t = Sa * O.a.xy; t = Sb * O.a.zw + t; float sa = red16(t.x + t.y); \
        const f32x2 nsa = {-sa, -sa}; const f32x2 vv2 = {O.v, O.v}; \
        const f32x2 u0 = nsa * O.b.xy + vv2 * O.k.xy, u1 = nsa * O.b.zw + vv2 * O.k.zw; \
        Sa = Sa * O.w.xy + u0; Sb = Sb * O.w.zw + u1; \
        f32x2 ty = Sa * O.r.xy; ty = Sb * O.r.zw + ty; YP = ty.x + ty.y; } while (0)
    SC_LOAD(0); SC_PREP(0, 0); __syncthreads();
    constexpr int NCH = SEQ / TC;
    for (int ci = 0; ci < NCH; ++ci) {
        const int bi = ci & 1;
        if (VAR != 2 && ci + 1 < NCH) SC_LOAD(ci + 1);
        const LAS f32x4* p4 = (const LAS f32x4*)(L + bi * BUF_B); const LAS float* pf = (const LAS float*)(L + bi * BUF_B);
        const LAS float* pb = (const LAS float*)(L + bi * BUF_B + DATA_B);
        float ykeep = 0.f;
        Ops oA, oB; SC_LD(oA, 0);
        if (VAR != 1) {
#pragma unroll
        for (int i = 0; i < TC; i += 4) {
            float y0, y1, y2, y3; float v0, v1, v2, v3, b0, b1, b2, b3;
            SC_LD(oB, i + 1); v0 = oA.v; b0 = oA.bon; SC_STEP(oA, y0);
            SC_LD(oA, i + 2); v1 = oB.v; b1 = oB.bon; SC_STEP(oB, y1);
            SC_LD(oB, i + 3); v2 = oA.v; b2 = oA.bon; SC_STEP(oA, y2);
            if (i + 4 < TC) SC_LD(oA, i + 4);
            v3 = oB.v; b3 = oB.bon; SC_STEP(oB, y3);
            y0 = red16(y0); y1 = red16(y1); y2 = red16(y2); y3 = red16(y3);
            y0 += b0 * v0; y1 += b1 * v1; y2 += b2 * v2; y3 += b3 * v3;
            ykeep = (j == i) ? y0 : ykeep; ykeep = (j == i + 1) ? y1 : ykeep; ykeep = (j == i + 2) ? y2 : ykeep; ykeep = (j == i + 3) ? y3 : ykeep;
        }
        }
        ((LAS float*)(L + bi * BUF_B + DATA_B + 64))[j * 32 + w * 4 + g] = ykeep;
        if (VAR != 2 && ci + 1 < NCH) SC_PREP(ci + 1, bi ^ 1);
        __syncthreads();
        { const int st = tid >> 5, rw_ = tid & 31; const int s = SC_TOK(ci, st);
          const unsigned short yv = f2bf(((const LAS float*)(L + bi * BUF_B + DATA_B + 64))[st * 32 + rw_]);
          if (VAR == 0) yout[(size_t)s * RW + rw_] = yv; else asm volatile("" :: "v"(yv)); }
    }
    __syncthreads();
#undef SC_TOK
#undef SC_LOAD
#undef SC_PREP
#undef SC_LD
#undef SC_STEP
}
}

namespace scan2 {
constexpr int TC = 16, NS = 6, NPREP = 6, NREC = 2;
constexpr int ROWB = 144;
constexpr int P_ACAT = 0, P_BHAT = 4608, P_KHAT = 6656, P_VT = 8704, P_NCAT = 10752, P_MRF = 11776, P_PC = 12800, P_GINIT = 13056  , PKG_B = 15104;
constexpr int S_L1 = 0, S_L2 = 4608, S_MF = 9216, S_NF = 10240, SCR_B = 11264;
constexpr int OFF_PKG = 0, OFF_SCR = NS * PKG_B, OFF_FLAG = OFF_SCR + NPREP * SCR_B, TOTAL_B = OFF_FLAG + 64;
static_assert(TOTAL_B <= 156 * 1024, "scan2 LDS");
__device__ __forceinline__ int crow(int r, int hi) { return (r & 3) + 8 * (r >> 2) + 4 * hi; }
__device__ __forceinline__ void lds_st16(LAS unsigned char* p, float v) { *(LAS unsigned short*)p = f2bf(v); }
__device__ __forceinline__ bf16x8 pack_acc8(const f32x16& x, int base) {
    u32x4 w = {cvt_pk_bf16(x[base + 0], x[base + 1]), cvt_pk_bf16(x[base + 2], x[base + 3]), cvt_pk_bf16(x[base + 4], x[base + 5]), cvt_pk_bf16(x[base + 6], x[base + 7])};
    return *reinterpret_cast<bf16x8*>(&w);
}
__device__ __forceinline__ float wave_sum_b(float v) {
    v = scan::red16(v);
    v += __builtin_bit_cast(float, __builtin_amdgcn_update_dpp(0, __builtin_bit_cast(int, v), 0x142, 0xA, 0xF, false));
    v += __builtin_bit_cast(float, __builtin_amdgcn_update_dpp(0, __builtin_bit_cast(int, v), 0x143, 0xC, 0xF, false));
    return __builtin_bit_cast(float, __builtin_amdgcn_readlane(__builtin_bit_cast(int, v), 63));
}
__device__ __forceinline__ void spin_ge(volatile LAS int* p, int want) { while (*p < want) __builtin_amdgcn_s_sleep(1); }

template <int dir> __device__ __forceinline__ void scan_unit(Frame& F, const int b, const int h) {
    unsigned char* ws = F.ws; const int l = F.lane, w = F.wave;
    LAS unsigned char* L = F.lds;
    volatile LAS int* ready = (volatile LAS int*)(L + OFF_FLAG);
    volatile LAS int* consumed = ready + NS;
    if (F.tid < 16) ready[F.tid] = 0;
    __syncthreads();
    constexpr int NCH = SEQ / TC;
    if (w < NREC) {
        const int half = w; const int v = l & 31, hi = l >> 5, vg = 32 * half + v;
        __builtin_amdgcn_s_setprio(3);
        f32x16 X0 = {}, X1 = {};
        bf16* yout = (bf16*)(ws + (dir ? WS_YB : WS_YF)) + (size_t)b * SEQ * RW + h * 64 + half * 32 + v;
        for (int ci = 0; ci < NCH; ++ci) {
            const int slot = ci % NS; const LAS unsigned char* P = L + OFF_PKG + slot * PKG_B;
            spin_ge(ready + slot, ci + 1);
            const bf16x8 a00 = *(const LAS bf16x8*)(P + P_ACAT + v * ROWB + (0 + hi) * 16), a01 = *(const LAS bf16x8*)(P + P_ACAT + v * ROWB + (2 + hi) * 16);
            const bf16x8 a10 = *(const LAS bf16x8*)(P + P_ACAT + v * ROWB + (4 + hi) * 16), a11 = *(const LAS bf16x8*)(P + P_ACAT + v * ROWB + (6 + hi) * 16);
            const bf16x8 ncat = *(const LAS bf16x8*)(P + P_NCAT + v * 32 + hi * 16), vt = *(const LAS bf16x8*)(P + P_VT + vg * 32 + hi * 16);
            const bf16x8 mrf = *(const LAS bf16x8*)(P + P_MRF + l * 16);
            const bf16x8 bh0 = *(const LAS bf16x8*)(P + P_BHAT + v * 32 + hi * 16), bh1 = *(const LAS bf16x8*)(P + P_BHAT + (32 + v) * 32 + hi * 16);
            const bf16x8 kh0 = *(const LAS bf16x8*)(P + P_KHAT + v * 32 + hi * 16), kh1 = *(const LAS bf16x8*)(P + P_KHAT + (32 + v) * 32 + hi * 16);
            f32x16 G;
            { const u32x2 q0 = *(const LAS u32x2*)(P + P_GINIT + vg * 32 + hi * 8), q1 = *(const LAS u32x2*)(P + P_GINIT + vg * 32 + 16 + hi * 8);
              const f32x4 g0 = {bflo(q0.x), bfhi(q0.x), bflo(q0.y), bfhi(q0.y)}, g1 = {bflo(q1.x), bfhi(q1.x), bflo(q1.y), bfhi(q1.y)};
#pragma unroll
              for (int r = 0; r < 8; ++r) G[r] = 0.f;
#pragma unroll
              for (int r = 0; r < 4; ++r) { G[8 + r] = g0[r]; G[12 + r] = g1[r]; } }
            f32x4 pc[8];
#pragma unroll
            for (int q = 0; q < 8; ++q) pc[q] = *(const LAS f32x4*)(P + P_PC + (32 * (q >> 2) + 8 * (q & 3) + 4 * hi) * 4);
            const bf16x8 s00 = pack_acc8(X0, 0), s01 = pack_acc8(X0, 8), s10 = pack_acc8(X1, 0), s11 = pack_acc8(X1, 8);
            G = __builtin_amdgcn_mfma_f32_32x32x16_bf16(a00, s00, G, 0, 0, 0);
            G = __builtin_amdgcn_mfma_f32_32x32x16_bf16(a01, s01, G, 0, 0, 0);
            G = __builtin_amdgcn_mfma_f32_32x32x16_bf16(a10, s10, G, 0, 0, 0);
            G = __builtin_amdgcn_mfma_f32_32x32x16_bf16(a11, s11, G, 0, 0, 0);
            G = __builtin_amdgcn_mfma_f32_32x32x16_bf16(ncat, vt, G, 0, 0, 0);
            const bf16x8 uf = pack_acc8(G, 0);
#pragma unroll
            for (int r = 0; r < 16; ++r) { X0[r] *= pc[r >> 2][r & 3]; X1[r] *= pc[4 + (r >> 2)][r & 3]; }
            X0 = __builtin_amdgcn_mfma_f32_32x32x16_bf16(bh0, uf, X0, 0, 0, 0);
            X1 = __builtin_amdgcn_mfma_f32_32x32x16_bf16(bh1, uf, X1, 0, 0, 0);
            X0 = __builtin_amdgcn_mfma_f32_32x32x16_bf16(kh0, vt, X0, 0, 0, 0);
            X1 = __builtin_amdgcn_mfma_f32_32x32x16_bf16(kh1, vt, X1, 0, 0, 0);
            G = __builtin_amdgcn_mfma_f32_32x32x16_bf16(mrf, uf, G, 0, 0, 0);
            LDS_WAIT();
            if (l == 0) consumed[half] = ci + 1;
#pragma unroll
            for (int q = 0; q < 8; ++q) { const int t = crow(q, hi); const int s = dir ? (SEQ - 1 - (ci * TC + t)) : (ci * TC + t);
                yout[(size_t)s * RW] = f2bf(G[8 + q]); }
        }
        __builtin_amdgcn_s_setprio(0);
    } else {
        const int pw = w - NREC; LAS unsigned char* SC = L + OFF_SCR + pw * SCR_B;
        const bf16* zr = (const bf16*)(ws + WS_ZRKV) + (size_t)b * SEQ * ZR_LD + h * 64 + l;
        const bf16* wlp = (const bf16*)(ws + (dir ? WS_WLB : WS_WLF)) + (size_t)b * SEQ * RW + h * 64 + l;
        const bf16* icp = (const bf16*)(ws + (dir ? WS_ICB : WS_ICF)) + (size_t)b * SEQ * RW + h * 64 + l;
        const int ch = h * 64 + l; const float* sh = F.in[I_SHIFT];
        const float sr0 = sh[ch], sr1 = sh[RWKV_IN + ch], sr2 = sh[2 * RWKV_IN + ch];
        const float sk0 = sh[2048 + ch], sk1 = sh[RWKV_IN + 2048 + ch], sk2 = sh[2 * RWKV_IN + 2048 + ch];
        const float sv0 = sh[4096 + ch], sv1 = sh[RWKV_IN + 4096 + ch], sv2 = sh[2 * RWKV_IN + 4096 + ch];
        const float kk_c = F.in[I_KK][ch], ka_c = F.in[I_KA][ch], rk_c = F.in[I_RK][ch];
        const int posk = (((l >> 5) * 2 + ((l >> 4) & 1)) * 2 + ((l >> 2) & 1)) * 8 + ((l >> 3) & 1) * 4 + (l & 3);
        unsigned long long sec_acc = 0ull;
#define S2_T() ((SCAN_SEC >= 0) ? __builtin_amdgcn_s_memtime() : 0ull)
        for (int ci = pw; ci < NCH; ci += NPREP) {
            const int slot = ci % NS; LAS unsigned char* P = L + OFF_PKG + slot * PKG_B;
            const unsigned long long ts0 = S2_T();
            const int s_lo = dir ? (SEQ - TC - ci * TC) : ci * TC;
            float rr[18], rk[18], rv[18], wl[16], ic[16];
            { unsigned short ur[18], uk[18], uv[18], uw[16], ui[16];
#pragma unroll
              for (int tau = 0; tau < 18; ++tau) { const int s = s_lo - 1 + tau; const bool ok = (s >= 0) && (s < SEQ); const int sc = ok ? s : s_lo; const bf16* z = zr + (size_t)sc * ZR_LD; ur[tau] = z[0]; uk[tau] = z[2048]; uv[tau] = z[4096]; }
#pragma unroll
              for (int i = 0; i < 16; ++i) { const int s = dir ? (s_lo + 15 - i) : (s_lo + i); uw[i] = wlp[(size_t)s * RW]; ui[i] = icp[(size_t)s * RW]; }
              __builtin_amdgcn_sched_barrier(0);
#pragma unroll
              for (int tau = 0; tau < 18; ++tau) { const int s = s_lo - 1 + tau; const float f = ((s >= 0) && (s < SEQ)) ? 1.f : 0.f; rr[tau] = f * bf2f(ur[tau]); rk[tau] = f * bf2f(uk[tau]); rv[tau] = f * bf2f(uv[tau]); }
#pragma unroll
              for (int i = 0; i < 16; ++i) { wl[i] = bf2f(uw[i]); ic[i] = bf2f(ui[i]); } }
            float cum[16];
            cum[0] = wl[0];
#pragma unroll
            for (int i = 1; i < 16; ++i) cum[i] = cum[i - 1] + wl[i];
            const unsigned long long tsA = S2_T();
            float rs_[16], ks_[16], vs_[16], q1[16], q2[16];
#pragma unroll
            for (int i = 0; i < 16; ++i) { const int tau = dir ? (16 - i) : (i + 1);
                rs_[i] = sr0 * rr[tau - 1] + sr1 * rr[tau] + sr2 * rr[tau + 1];
                ks_[i] = sk0 * rk[tau - 1] + sk1 * rk[tau] + sk2 * rk[tau + 1];
                vs_[i] = sv0 * rv[tau - 1] + sv1 * rv[tau] + sv2 * rv[tau + 1];
                const float kkr = ks_[i] * kk_c; q1[i] = kkr * kkr; q2[i] = rs_[i] * (ks_[i] * (1.0f + (ic[i] - 1.0f) * ka_c)) * rk_c; }
#define S2_DPPSTEP(CTRL, RM) do { _Pragma("unroll") for (int i = 0; i < 16; ++i) { \
                q1[i] += __builtin_bit_cast(float, __builtin_amdgcn_update_dpp(0, __builtin_bit_cast(int, q1[i]), CTRL, RM, 0xF, false)); \
                q2[i] += __builtin_bit_cast(float, __builtin_amdgcn_update_dpp(0, __builtin_bit_cast(int, q2[i]), CTRL, RM, 0xF, false)); } } while (0)
            S2_DPPSTEP(0xB1, 0xF); S2_DPPSTEP(0x4E, 0xF); S2_DPPSTEP(0x141, 0xF); S2_DPPSTEP(0x140, 0xF); S2_DPPSTEP(0x142, 0xA); S2_DPPSTEP(0x143, 0xC);
#undef S2_DPPSTEP
            const unsigned long long ts1 = S2_T();
            spin_ge(consumed, ci - NS + 1); spin_ge(consumed + 1, ci - NS + 1);
            const unsigned long long ts2 = S2_T();
            float at[16]; float pprev = 1.0f; const float pC = __builtin_amdgcn_exp2f(cum[15]);
#pragma unroll
            for (int i = 0; i < 16; ++i) {
                const float r_s = rs_[i], k_s = ks_[i], v_s = vs_[i];
                const float ss = __uint_as_float(__builtin_amdgcn_readlane(__float_as_uint(q1[i]), 63)), bon = __uint_as_float(__builtin_amdgcn_readlane(__float_as_uint(q2[i]), 63));
                const float kk = k_s * kk_c * __builtin_amdgcn_rsqf(ss + 1e-12f);
                const float kd = k_s * (1.0f + (ic[i] - 1.0f) * ka_c); const float bb = kk * ic[i];
                const float p = __builtin_amdgcn_exp2f(cum[i]), pm = pprev, pinv = __builtin_amdgcn_exp2f(-cum[i]), pr = pC * pinv; pprev = p;
                at[i] = -kk * pm;
                lds_st16(SC + S_L2 + i * ROWB + l * 2, at[i]);
                const float rt = r_s * p;
                lds_st16(SC + S_L2 + (16 + i) * ROWB + l * 2, rt); lds_st16(P + P_ACAT + (16 + i) * ROWB + posk * 2, rt);
                lds_st16(SC + S_L1 + i * ROWB + l * 2, bb * pinv); lds_st16(SC + S_L1 + (16 + i) * ROWB + l * 2, kd * pinv);
                lds_st16(P + P_BHAT + l * 32 + ((((i >> 2) & 1) * 8) + (i & 3) + 4 * (i >> 3)) * 2, bb * pr);
                lds_st16(P + P_KHAT + l * 32 + i * 2, kd * pr);
                lds_st16(P + P_VT + l * 32 + i * 2, v_s); lds_st16(P + P_GINIT + l * 32 + i * 2, bon * v_s);
            }
            *(LAS float*)(P + P_PC + l * 4) = pC;
            LDS_WAIT();
            const unsigned long long ts3 = S2_T();
            f32x16 Z = {};
            { const int r = l & 31, hh = l >> 5;
#pragma unroll
              for (int ks = 0; ks < 4; ++ks) { const bf16x8 fa = *(const LAS bf16x8*)(SC + S_L1 + r * ROWB + (ks * 16 + hh * 8) * 2), fb = *(const LAS bf16x8*)(SC + S_L2 + r * ROWB + (ks * 16 + hh * 8) * 2);
                  Z = __builtin_amdgcn_mfma_f32_32x32x16_bf16(fa, fb, Z, 0, 0, 0); } }
            { const int c = l & 31, hh = l >> 5;
              if (c < 16) {
#pragma unroll
                  for (int r = 0; r < 8; ++r) { const int s = crow(r, hh); *(LAS float*)(SC + S_MF + (c * 16 + s) * 4) = (s < c) ? Z[r] : 0.f; }
#pragma unroll
                  for (int r = 8; r < 16; ++r) { const int s = crow(r, hh) - 16; *(LAS float*)(SC + S_NF + (s * 16 + c) * 4) = (s < c) ? Z[r] : 0.f; }
                  *(LAS u32x4*)(P + P_MRF + l * 16) = (u32x4){0u, 0u, 0u, 0u};
              } else { const int t = c - 16; f32x16 Zm = Z;
#pragma unroll
                  for (int r = 0; r < 8; ++r) { const int s = crow(r, hh); Zm[r] = (s <= t) ? Z[r] : 0.f; }
                  *(LAS bf16x8*)(P + P_MRF + l * 16) = pack_acc8(Zm, 0);
#pragma unroll
                  for (int r = 8; r < 16; ++r) { const int s = crow(r, hh) - 16; lds_st16(P + P_NCAT + c * 32 + s * 2, (s <= t) ? Z[r] : 0.f); }
              } }
            LDS_WAIT();
            const unsigned long long ts4 = S2_T();
            { float x[16], y[16];
#pragma unroll
              for (int q = 0; q < 4; ++q) { const f32x4 nvv = *(const LAS f32x4*)(SC + S_NF + ((l & 15) * 16 + q * 4) * 4); y[q * 4 + 0] = nvv[0]; y[q * 4 + 1] = nvv[1]; y[q * 4 + 2] = nvv[2]; y[q * 4 + 3] = nvv[3]; }
#pragma unroll
              for (int t = 0; t < 16; ++t) x[t] = at[t];
              f32x4 mrow[16][4];
#pragma unroll
              for (int t = 1; t < 16; ++t)
#pragma unroll
                  for (int s4 = 0; s4 < (t + 3) / 4; ++s4) mrow[t][s4] = *(const LAS f32x4*)(SC + S_MF + (t * 16 + s4 * 4) * 4);
#pragma unroll
              for (int t = 1; t < 16; ++t) { float ax0 = x[t], ax1 = 0.f, ay0 = y[t], ay1 = 0.f;
#pragma unroll
                  for (int s = 0; s < t; ++s) { const float m = mrow[t][s >> 2][s & 3]; if (s & 1) { ax1 += x[s] * m; ay1 += y[s] * m; } else { ax0 += x[s] * m; ay0 += y[s] * m; } }
                  x[t] = ax0 + ax1; y[t] = ay0 + ay1; }
#pragma unroll
              for (int t = 0; t < 16; ++t) lds_st16(P + P_ACAT + t * ROWB + posk * 2, x[t]);
              if (l < 16) {
#pragma unroll
                  for (int t = 0; t < 16; ++t) lds_st16(P + P_NCAT + t * 32 + l * 2, y[t]); } }
            LDS_WAIT();
            if (l == 0) ready[slot] = ci + 1;
            if (SCAN_SEC >= 0) { const unsigned long long ts5 = S2_T(); sec_acc += SCAN_SEC == 0 ? ts1 - ts0 : SCAN_SEC == 1 ? ts2 - ts1 : SCAN_SEC == 2 ? ts3 - ts2 : SCAN_SEC == 3 ? ts4 - ts3 : SCAN_SEC == 4 ? ts5 - ts4 : SCAN_SEC == 6 ? tsA - ts0 : SCAN_SEC == 7 ? ts1 - tsA : ts5 - ts0; }
        }
        if (SCAN_SEC >= 0 && blockIdx.x == 0 && pw == 0 && l == 0) { F.MISC[120] = (unsigned)sec_acc; F.MISC[121] = (unsigned)(sec_acc >> 32); }
    }
    __syncthreads();
}
}

__device__ __forceinline__ void p5_post(Frame& F) {
    const int gw = F.vcu * 8 + F.wave, NGW = F.G * 8, l = F.lane; unsigned char* ws = F.ws;
    const bf16* yf = (const bf16*)(ws + WS_YF); const bf16* yb = (const bf16*)(ws + WS_YB); const bf16* gg = (const bf16*)(ws + WS_G); bf16* o = (bf16*)(ws + WS_ORWKV);
    const float* lg = F.in[I_LNXG]; const float* lb = F.in[I_LNXB];
    for (int t = gw; t < MT; t += NGW) {
        const size_t base = (size_t)t * RW;
#pragma unroll 4
        for (int h = 0; h < RH; ++h) { const int c = h * 64 + l;
            const float y = bf2f(yf[base + c]) + bf2f(yb[base + c]);
            const float mu = wave_sum(y) * (1.f / 64.f); const float d = y - mu; const float var = wave_sum(d * d) * (1.f / 64.f);
            const float yn = d * (1.0f / sqrtf(var + LNX_EPS));
            o[base + c] = f2bf((yn * lg[c] + lb[c]) * bf2f(gg[base + c])); }
    }
}

__device__ __forceinline__ void p8_rowpass(Frame& F) {
    const int gw = F.vcu * 8 + F.wave, NGW = F.G * 8; float* rstd2 = (float*)(F.ws + WS_RSTD) + 3 * MT; bf16* hb = (bf16*)(F.ws + WS_H1B);
    for (int m = gw; m < MT; m += NGW) {
        const f32x4* xr = (const f32x4*)(F.out + (size_t)m * DM) + F.lane; f32x4 v[8]; float s = 0.f;
#pragma unroll
        for (int j = 0; j < 8; ++j) { v[j] = xr[64 * j]; s += (v[j].x * v[j].x + v[j].y * v[j].y) + (v[j].z * v[j].z + v[j].w * v[j].w); }
        s = wave_sum(s); if (F.lane == 0) rstd2[m] = 1.0f / sqrtf(s * (1.f / DM) + RMS_EPS);
        u32x2* o8 = (u32x2*)(hb + (size_t)m * DM) + F.lane;
#pragma unroll
        for (int j = 0; j < 8; ++j) { u32x2 w; w.x = cvt_pk_bf16(v[j].x, v[j].y); w.y = cvt_pk_bf16(v[j].z, v[j].w); o8[64 * j] = w; }
    }
}
__device__ __forceinline__ void p12_router(Frame& F) {
    const int gw = F.vcu * 8 + F.wave, NGW = F.G * 8, l = F.lane; unsigned char* ws = F.ws;
    float* rstd3 = (float*)(ws + WS_RSTD) + 4 * MT; bf16* n3 = (bf16*)(ws + WS_N3); const float* WR = (const float*)(ws + WS_WR);
    int* lists = (int*)(ws + WS_LIST); int* route = (int*)(ws + WS_ROUTE); float* slotw = (float*)(ws + WS_SLOTW);
    int* cnt = (int*)(F.ctl + CW_CNT);
    const float* brg = F.in[I_BRG]; const float* bre = F.in[I_BRE];
    LAS float* wl = (LAS float*)(F.lds + 16384);
    LAS float* lgt = (LAS float*)(F.lds + F.wave * 1024);
    for (int tb = F.vcu * 32; tb < MT; tb += F.G * 32) {
        const int t0 = tb + F.wave * 4;
        float ss[4] = {0.f, 0.f, 0.f, 0.f};
#pragma unroll
        for (int q = 0; q < 4; ++q) { const f32x4* xr = (const f32x4*)(F.out + (size_t)(t0 + q) * DM) + l; u32x2* o8 = (u32x2*)(n3 + (size_t)(t0 + q) * DM) + l;
#pragma unroll
            for (int j = 0; j < 8; ++j) { const f32x4 x = xr[64 * j]; ss[q] += (x.x * x.x + x.y * x.y) + (x.z * x.z + x.w * x.w);
                u32x2 w; w.x = cvt_pk_bf16(x.x, x.y); w.y = cvt_pk_bf16(x.z, x.w); o8[64 * j] = w; } }
#pragma unroll
        for (int q = 0; q < 4; ++q) ss[q] = wave_sum(ss[q]);
#pragma unroll 1
        for (int pass = 0; pass < 2; ++pass) {
            const float* x0p = F.out + (size_t)(t0 + 2 * pass) * DM + l; const float* x1p = x0p + DM;
            float acc[2][36];
#pragma unroll
            for (int q = 0; q < 2; ++q)
#pragma unroll
                for (int o = 0; o < 36; ++o) acc[q][o] = 0.f;
#pragma unroll 1
            for (int blk = 0; blk < 8; ++blk) {
                __syncthreads();
                { const f32x4* src4 = (const f32x4*)(WR + (size_t)blk * 256 * 36); LAS f32x4* dst4 = (LAS f32x4*)wl;
#pragma unroll
                  for (int i = 0; i < 5; ++i) { const int idx = F.tid + 512 * i; if (idx < 2304) dst4[idx] = src4[idx]; } }
                __syncthreads();
#pragma unroll
                for (int c4 = 0; c4 < 4; ++c4) { const int cl = l + 64 * c4; const float x0 = x0p[blk * 256 + 64 * c4], x1 = x1p[blk * 256 + 64 * c4];
                    const LAS f32x4* wr = (const LAS f32x4*)(wl + cl * 36);
#pragma unroll
                    for (int o4 = 0; o4 < 9; ++o4) { const f32x4 w = wr[o4];
#pragma unroll
                        for (int k = 0; k < 4; ++k) { acc[0][o4 * 4 + k] += x0 * w[k]; acc[1][o4 * 4 + k] += x1 * w[k]; } } }
            }
#pragma unroll
            for (int q = 0; q < 2; ++q)
#pragma unroll
                for (int o = 0; o < 36; ++o) { const float v = wave_sum(acc[q][o]); if (l == 0) lgt[(2 * pass + q) * 36 + o] = v; }
        }
        LDS_WAIT();
#pragma unroll
        for (int q = 0; q < 4; ++q) { const int t = t0 + q; const float rs = 1.0f / sqrtf(ss[q] * (1.f / DM) + RMS_EPS);
            float lg[4]; float gmax = -3.0e38f; int gsel = 0;
#pragma unroll
            for (int g = 0; g < 4; ++g) { lg[g] = lgt[q * 36 + g] * rs + brg[g]; if (lg[g] > gmax) { gmax = lg[g]; gsel = g; } }
            float gz = 0.f;
#pragma unroll
            for (int g = 0; g < 4; ++g) gz += __expf(lg[g] - gmax);
            const float pg = 1.0f / gz;
            float le[8];
#pragma unroll
            for (int e = 0; e < 8; ++e) { float a = lgt[q * 36 + 4 + e];
#pragma unroll
                for (int g = 1; g < 4; ++g) a = (gsel == g) ? lgt[q * 36 + 4 + g * 8 + e] : a;
                le[e] = a * rs + bre[gsel * 8 + e]; }
            float m1 = -3.0e38f, m2 = -3.0e38f; int e1 = 0, e2 = 0;
#pragma unroll
            for (int e = 0; e < 8; ++e) { if (le[e] > m1) { m2 = m1; e2 = e1; m1 = le[e]; e1 = e; } else if (le[e] > m2) { m2 = le[e]; e2 = e; } }
            const float xe = __expf(m2 - m1); const float w1 = pg / (1.0f + xe), w2 = pg * xe / (1.0f + xe);
            if (l == 0) { rstd3[t] = rs;
                const int E1 = gsel * 8 + e1, E2 = gsel * 8 + e2;
                const int p1 = atomicAdd(cnt + 64 * E1, 1), p2 = atomicAdd(cnt + 64 * E2, 1);
                lists[E1 * MT + p1] = t; lists[E2 * MT + p2] = t; slotw[E1 * MT + p1] = w1; slotw[E2 * MT + p2] = w2;
                route[t * 8 + 0] = E1; route[t * 8 + 1] = p1; route[t * 8 + 2] = E2; route[t * 8 + 3] = p2; }
        }
    }
}
struct MoeOrder {
    static constexpr bool GATHER = true;
    const volatile LAS int* tp; const int* cnt; const int* lists; const char* A; const char* B; int G, c, lognt; size_t bstride_e, bstride_t;
    bool gather;
    __device__ __forceinline__ bool next(int i, Unit& u) const {
        const int L = i * G + c; const int RT = tp[32]; if (L >= (RT << lognt)) return false;
        const int rt = L >> lognt, nt = L & ((1 << lognt) - 1); int e = 0;
        for (int q = 1; q < 32; ++q) e = (rt >= tp[q]) ? q : e;
        u.pm = rt; u.pn = nt; u.aux0 = e; u.aux1 = (rt - tp[e]) * 256;
        u.Ab = A; u.Bb = B + (size_t)e * bstride_e + (size_t)nt * bstride_t; return true;
    }
    __device__ __forceinline__ unsigned arow(const Unit& u, int r) const {
        if (!gather) return (unsigned)(u.pm * 256 + r);
        const int idx = u.aux1 + r; const int n = cnt[64 * u.aux0]; return idx < n ? (unsigned)lists[u.aux0 * MT + idx] : 0u;
    }
};
struct EpiMoe1 {
    static constexpr bool PERM = true;
    bf16* hid; const int* cnt; const int* lists; const float* slotw; const float* rstd;
    __device__ __forceinline__ void operator()(const PG8_ACC, const Unit& u, int wr, int wc, int fr, int fq) const {
        const int n = cnt[64 * u.aux0];
#pragma unroll
        for (int ai = 0; ai < 2; ++ai)
#pragma unroll
            for (int m = 0; m < 4; ++m) { const int r = ai * 128 + wr * 64 + m * 16 + fr; const int idx = u.aux1 + r; const bool ok = idx < n;
                const int tok = ok ? lists[u.aux0 * MT + idx] : 0; const float rs = rstd[tok]; const float wt = ok ? slotw[u.aux0 * MT + idx] : 0.f;
                f32x4 o0, o1;
#pragma unroll
                for (int j = 0; j < 4; ++j) { const float g0 = acc[ai][0][m][0][j] * rs, u0 = acc[ai][1][m][0][j] * rs, g1 = acc[ai][0][m][1][j] * rs, u1 = acc[ai][1][m][1][j] * rs;
                    o0[j] = g0 * sigmoidf_(g0) * u0 * wt; o1[j] = g1 * sigmoidf_(g1) * u1 * wt; }
                *(u32x4*)(hid + (size_t)(u.pm * 256 + r) * DE + u.pn * 128 + wc * 32 + 8 * fq) = pg8::pack8(o0, o1); }
    }
};
struct EpiMoe2 {
    static constexpr bool PERM = true;
    bf16* y;
    __device__ __forceinline__ void operator()(const PG8_ACC, const Unit& u, int wr, int wc, int fr, int fq) const {
        EPI_FOR(ai, m, bj) { const int row = u.pm * 256 + ai * 128 + wr * 64 + m * 16 + fr; const int col = u.pn * 256 + bj * 128 + wc * 32 + 8 * fq;
            *(u32x4*)(y + (size_t)row * DM + col) = pg8::pack8(acc[ai][bj][m][0], acc[ai][bj][m][1]); }
    }
};
__device__ __forceinline__ void moe_table(Frame& F) {
    if (F.tid == 0) { const int* cnt = (const int*)(F.ctl + CW_CNT); int acc = 0;
        for (int e = 0; e < 32; ++e) { F.MISC[16 + e] = (unsigned)acc; acc += (__hip_atomic_load(cnt + 64 * e, __ATOMIC_RELAXED, __HIP_MEMORY_SCOPE_AGENT) + 255) >> 8; }
        F.MISC[16 + 32] = (unsigned)acc; }
    __syncthreads();
}
__device__ __forceinline__ void p5_expert_cvt(Frame& F) {
    LAS float* scr = (LAS float*)(F.lds + F.wave * CVT_SCR); const int gw = F.vcu * 8 + F.wave, NGW = F.G * 8; unsigned char* ws = F.ws;
#define EX_DESC(it_, d) do { const int e = (it_) / 768, r = (it_) % 768; \
        if (r < 256) { d.W = F.in[I_WEG] + (size_t)e * DM * DE; d.gain = F.in[I_GFFN]; d.WT = (bf16*)(ws + WS_WGU) + (size_t)e * 1024 * DM; d.K = DM; d.N = DE; d.ldt = DM; d.mode = 3; d.kofs = 0; d.item = r; } \
        else if (r < 512) { d.W = F.in[I_WEU] + (size_t)e * DM * DE; d.gain = F.in[I_GFFN]; d.WT = (bf16*)(ws + WS_WGU) + (size_t)e * 1024 * DM; d.K = DM; d.N = DE; d.ldt = DM; d.mode = 4; d.kofs = 0; d.item = r - 256; } \
        else { d.W = F.in[I_WED] + (size_t)e * DE * DM; d.gain = nullptr; d.WT = (bf16*)(ws + WS_WD) + (size_t)e * DM * DE; d.K = DE; d.N = DM; d.ldt = DE; d.mode = 0; d.kofs = 0; d.item = r - 512; } } while (0)
    CVT_PIPE(NE * 768, EX_DESC);
#undef EX_DESC
}

struct Args { const float* in[41]; float* out; unsigned char* ws; int ph_lo, ph_hi; };
constexpr int NPHASE = 16;
__global__ void __launch_bounds__(512, 2) fwd_kernel(Args args) {
    extern __shared__ __attribute__((aligned(16))) unsigned char lds_raw[];
    Frame F;
    F.lds = (LAS unsigned char*)lds_raw; F.MISC = (volatile LAS unsigned*)(F.lds + MISC_OFF);
    F.tid = threadIdx.x; F.lane = F.tid & 63; F.wave = __builtin_amdgcn_readfirstlane(F.tid >> 6);
    F.G = gridDim.x; { const int bx = blockIdx.x; F.vcu = (F.G % 8 == 0) ? (bx % 8) * (F.G / 8) + bx / 8 : bx; }
    F.ws = args.ws; F.out = args.out; F.ctl = (unsigned*)(args.ws + WS_CTL);
#pragma unroll
    for (int i = 0; i < 41; ++i) F.in[i] = args.in[i];
    for (int u = F.tid; u < (LDS_BYTES - LDSCTL_OFF) / 4; u += 512) ((LAS unsigned*)(F.lds + LDSCTL_OFF))[u] = 0u;
    __syncthreads();
    XcdBarrier bar; bar.bar = F.ctl + CW_BAR; bar.x = 0; bar.st = nullptr;
    const int lo = args.ph_lo, hi = args.ph_hi;
    if (hi - lo > 1) bar = xcd_barrier_post(F.ctl + CW_BAR, F.MISC + 8);
#ifndef ATT_DQK_TEST
#define ATT_DQK_TEST QKD
#endif
#define PROBE_N (MT * 768)
#ifndef LSEL
#define LSEL 31
#endif
#ifndef PH_MASK
#define PH_MASK 0xFFFFu
#endif
#ifndef SCAN_MFMA
#define SCAN_MFMA 1
#endif
#ifndef SCAN_DUMMY
#define SCAN_DUMMY 0
#endif
#ifndef REPEAT_MASK
#define REPEAT_MASK 0x0u
#endif
#define REP(k) _Pragma("unroll") for (int _rep = 0; _rep <= (int)(((REPEAT_MASK) >> (k)) & 1u); ++_rep)
#define IN(k) ((((PH_MASK) >> (k)) & 1u) && lo <= (k) && (k) < hi)
#ifndef PROBE_TIME
#define PROBE_TIME -1
#endif
#define SEAM(k) do { if (lo <= (k) && (k) + 1 < hi) xcd_barrier(bar); if (PROBE_TIME >= 0 && blockIdx.x == 0 && F.tid == 0) { const unsigned long long _t = wall_clock64(); F.MISC[64 + 2 * ((k) + 1)] = (unsigned)_t; F.MISC[65 + 2 * ((k) + 1)] = (unsigned)(_t >> 32); } } while (0)
    unsigned char* ws = args.ws;

    bf16* const zmla = (bf16*)(ws + WS_ZMLA); bf16* const loraA = (bf16*)(ws + WS_LORAA);
    float* const rstd1 = (float*)(ws + WS_RSTD); float* const rstd_q = rstd1 + MT; float* const rstd_kv = rstd1 + 2 * MT;
    const int bid = (int)blockIdx.x;
    if (PROBE_TIME >= 0 && blockIdx.x == 0 && F.tid == 0) { const unsigned long long _t = wall_clock64(); F.MISC[64] = (unsigned)_t; F.MISC[65] = (unsigned)(_t >> 32); }
    if (IN(0)) { REP(0) p0_prologue(F); }
    SEAM(0);
    if (IN(1)) {
        if (EN_RWKV || EN_MLA) REP(1) { pg8::StaticOrder S; S.init((const bf16*)(ws + WS_XB), DM, (const bf16*)(ws + WS_WIN), DM, MT, G1_N, F.G, bid);
          EpiG1 E{rstd1, zmla, (bf16*)(ws + WS_ZRKV), (bf16*)(ws + WS_ZLORA), (bf16*)(ws + WS_ZGATE)};
          pg8::gemm_phase(F.lds, DM, DM, DM, S, E); }
        else p_copy_x(F);
    }
    SEAM(1);
    if (IN(2)) { if (EN_RWKV || EN_MLA) REP(2) p2_rowpass(F); }
    SEAM(2);
    if (IN(3)) REP(3) {
        if (EN_MLA) {
            { pg8::StaticOrder S; S.init(zmla, ZM_LD, (const bf16*)(ws + WS_WUQ), QLORA, MT, MH * QKD, F.G, bid);
              EpiQ E{(bf16*)(ws + WS_Q), rstd_q, (const float*)(ws + WS_ROPE)};
              pg8::gemm_phase(F.lds, QLORA, ZM_LD, QLORA, S, E); }
            { pg8::StaticOrder S; S.init(zmla + QLORA, ZM_LD, (const bf16*)(ws + WS_WUKV), KVLORA, MT, MH * 256, F.G, bid);
              EpiKV E{(bf16*)(ws + WS_K), (bf16*)(ws + WS_V), rstd_kv};
              pg8::gemm_phase(F.lds, KVLORA, ZM_LD, KVLORA, S, E); }
        }
        if (EN_RWKV) {
            { pg8::StaticOrder S; S.init(loraA, LA_LD, (const bf16*)(ws + WS_W2F), 256, MT, 2 * RW, F.G, bid);
              EpiLora2<0> E{(bf16*)(ws + WS_WLF), (bf16*)(ws + WS_WLB), F.in[I_W0F], F.in[I_W0B]}; pg8::gemm_phase(F.lds, 256, LA_LD, 256, S, E); }
            { pg8::StaticOrder S; S.init(loraA + 256, LA_LD, (const bf16*)(ws + WS_W2F + 2 * MiB), 256, MT, 2 * RW, F.G, bid);
              EpiLora2<1> E{(bf16*)(ws + WS_ICF), (bf16*)(ws + WS_ICB), F.in[I_A0F], F.in[I_A0B]}; pg8::gemm_phase(F.lds, 256, LA_LD, 256, S, E); }
            if (LSEL & 16) { pg8::StaticOrder S; S.init(loraA + 512, LA_LD, (const bf16*)(ws + WS_G2), GLORA, MT, RW, F.G, bid);
              EpiLora<2> E{(bf16*)(ws + WS_G), nullptr}; pg8::gemm_phase(F.lds, GLORA, LA_LD, GLORA, S, E); }
        }
    }
    SEAM(3);
    if (IN(4)) {
        constexpr int NSCAN = NB * RH * 2, NATT = NB * MH * (SEQ / 256);
        int s_begin = F.vcu, s_end = NSCAN, s_step = F.G, a_begin = F.vcu, a_step = F.G, a_cnt = (F.vcu < NATT) ? (NATT - 1 - F.vcu) / F.G + 1 : 0;
        if (EN_RWKV && EN_MLA && F.G == 256) { s_step = 1; a_step = 1;
            if (F.vcu < 128) { s_end = F.vcu + 1; a_begin = 384 + F.vcu; a_cnt = 1; } else { s_end = 0; a_begin = (F.vcu - 128) * 3; a_cnt = 3; } }
        if (EN_RWKV) for (int u = s_begin; u < s_end; u += s_step) { const int dir = u & 1, bh = u >> 1;
            if (dir) scan2::scan_unit<1>(F, bh >> 5, bh & 31); else scan2::scan_unit<0>(F, bh >> 5, bh & 31); }
        if (EN_MLA) for (int i = 0; i < a_cnt; ++i) { const int L = a_begin + i * a_step; const int qb = L & 15, bh = L >> 4, b = bh >> 4, h = bh & 15;
            att::attn_unit<ATT_DQK_TEST, MH * QKD, MH * QKD, MH * VDIM, DM>((const bf16*)(ws + WS_Q) + ((size_t)(b * SEQ + qb * 256) * (MH * QKD) + h * QKD),
                                (const bf16*)(ws + WS_K) + ((size_t)b * SEQ * (MH * QKD) + h * QKD),
                                (const bf16*)(ws + WS_V) + ((size_t)b * SEQ * (MH * VDIM) + h * VDIM),
                                (bf16*)(ws + WS_OMLA) + ((size_t)(b * SEQ + qb * 256) * DM + h * VDIM), SEQ, (LAS char*)F.lds); }
    }
    SEAM(4);
    if (IN(5)) { if (EN_RWKV) REP(5) p5_post(F); if (EN_MOE) REP(17) p5_expert_cvt(F); }
    SEAM(5);
    if (IN(6)) REP(6) {
        if (EN_MLA) { pg8::StaticOrder S; S.init((const bf16*)(ws + WS_OMLA), DM, (const bf16*)(ws + WS_WUPM), DM, MT, DM, F.G, bid);
            EpiUp<0> E{(bf16*)(ws + WS_MERGED), (const bf16*)(ws + WS_ZGATE), 0}; pg8::gemm_phase(F.lds, DM, DM, DM, S, E); }
        if (EN_RWKV) { pg8::StaticOrder S; S.init((const bf16*)(ws + WS_ORWKV), DM, (const bf16*)(ws + WS_WUPR), DM, MT, DM, F.G, bid);
            EpiUp<EN_MLA> E{(bf16*)(ws + WS_MERGED), (const bf16*)(ws + WS_ZGATE), DM}; pg8::gemm_phase(F.lds, DM, DM, DM, S, E); }
    }
    SEAM(6);
    if (IN(7)) REP(7) {
        if (EN_RWKV || EN_MLA) { pg8::StaticOrder S; S.init((const bf16*)(ws + WS_MERGED), DM, (const bf16*)(ws + WS_WOUT), DM, MT, DM, F.G, bid);
            EpiResid E{F.in[I_X], F.out}; pg8::gemm_phase(F.lds, DM, DM, DM, S, E); }
    }
    SEAM(7);
    if (IN(8)) { if (EN_CROSS || EN_MOE) p8_rowpass(F); }
    SEAM(8);
    if (IN(9)) REP(9) {
        if (EN_CROSS) { pg8::StaticOrder S; S.init((const bf16*)(ws + WS_H1B), DM, (const bf16*)(ws + WS_WQC), DM, MT, CW, F.G, bid);
            EpiPlain E{(bf16*)(ws + WS_QC), CW, rstd1 + 3 * MT, CSCALE}; pg8::gemm_phase(F.lds, DM, DM, DM, S, E); }
        if (EN_CROSS && bid >= 64) { pg8::StaticOrder S; S.init((const bf16*)(ws + WS_MEMN), DM, (const bf16*)(ws + WS_WKVC), DM, NB * MEMLEN, 2 * CW, F.G, bid - 64);
            EpiPlain E{(bf16*)(ws + WS_KVC), 2 * CW, nullptr, 1.f}; pg8::gemm_phase(F.lds, DM, DM, DM, S, E); }
    }
    SEAM(9);
    if (IN(10)) REP(10) {
        if (EN_CROSS) {
            for (int i = 0; ; ++i) { const int L = i * F.G + F.vcu; if (L >= NB * CH * (SEQ / 256)) break;
                const int qb = L & 15, bh = L >> 4, b = bh >> 2, h = bh & 3;
                att::attn_unit<CHD, CW, 2 * CW, 2 * CW, CW>((const bf16*)(ws + WS_QC) + ((size_t)(b * SEQ + qb * 256) * CW + h * CHD),
                                    (const bf16*)(ws + WS_KVC) + ((size_t)b * MEMLEN * (2 * CW) + h * CHD),
                                    (const bf16*)(ws + WS_KVC) + ((size_t)b * MEMLEN * (2 * CW) + CW + h * CHD),
                                    (bf16*)(ws + WS_OC) + ((size_t)(b * SEQ + qb * 256) * CW + h * CHD), MEMLEN, (LAS char*)F.lds); }
        }
    }
    SEAM(10);
    if (IN(11)) {
        if (EN_CROSS) { pg8::StaticOrder S; S.init((const bf16*)(ws + WS_OC), CW, (const bf16*)(ws + WS_WOC), CW, MT, DM, F.G, bid);
            EpiResid E{F.out, F.out}; pg8::gemm_phase(F.lds, CW, CW, CW, S, E); }
    }
    SEAM(11);
    if (IN(12)) { if (EN_MOE) p12_router(F); }
    SEAM(12);
    if (IN(13)) REP(13) {
        if (EN_MOE) { moe_table(F);
            MoeOrder S{(const volatile LAS int*)(F.MISC + 16), (const int*)(F.ctl + CW_CNT), (const int*)(ws + WS_LIST), (const char*)(ws + WS_N3), (const char*)(ws + WS_WGU), F.G, F.vcu, 2,
                       (size_t)1024 * DM * 2, (size_t)256 * DM * 2, true};
            EpiMoe1 E{(bf16*)(ws + WS_HID), (const int*)(F.ctl + CW_CNT), (const int*)(ws + WS_LIST), (const float*)(ws + WS_SLOTW), rstd1 + 4 * MT};
            pg8::gemm_phase(F.lds, DM, DM, DM, S, E); }
    }
    SEAM(13);
    if (IN(14)) REP(14) {
        if (EN_MOE) { moe_table(F);
            MoeOrder S{(const volatile LAS int*)(F.MISC + 16), (const int*)(F.ctl + CW_CNT), (const int*)(ws + WS_LIST), (const char*)(ws + WS_HID), (const char*)(ws + WS_WD), F.G, F.vcu, 3,
                       (size_t)DM * DE * 2, (size_t)256 * DE * 2, false};
            EpiMoe2 E{(bf16*)(ws + WS_YBUF)};
            pg8::gemm_phase(F.lds, DE, DE, DE, S, E); }
    }
    SEAM(14);
#ifdef PROBE_OFF
    if (IN(15)) { const int gt = F.vcu * 512 + F.tid, NGT = F.G * 512; const bf16* sb = (const bf16*)(ws + (size_t)PROBE_OFF * MiB);
        for (int i = gt; i < MT * DM; i += NGT) F.out[i] = (i < PROBE_N) ? bf2f(sb[i]) : 0.f; }
#else
    if (IN(15)) { p_final(F, EN_MOE != 0); }
#endif
    if (SCAN_SEC >= 0) { __syncthreads(); if (blockIdx.x == 0 && F.tid == 0) { const unsigned long long c = ((unsigned long long)F.MISC[121] << 32) | F.MISC[120]; F.out[(size_t)(F.vcu * 8) * DM] += (float)c * 1e-4f; } }
    if (PROBE_TIME >= 0) { __syncthreads(); if (blockIdx.x == 0 && F.tid == 0) {
        const unsigned long long a = ((unsigned long long)F.MISC[65 + 2 * PROBE_TIME] << 32) | F.MISC[64 + 2 * PROBE_TIME], b = ((unsigned long long)F.MISC[65 + 2 * (PROBE_TIME + 1)] << 32) | F.MISC[64 + 2 * (PROBE_TIME + 1)];
        F.out[(size_t)(F.vcu * 8) * DM] += (float)(b - a) * 0.001f; } }
#undef IN
#undef SEAM
}

extern "C" void kernel_launch(void* const* d_in, const int* in_sizes, int n_in, void* d_out, int out_size, void* d_ws, size_t ws_size, hipStream_t stream) {
    static int grid = 0;
    if (grid == 0) {
        if (n_in != 41 || out_size != MT * DM || ws_size < WS_END) { fprintf(stderr, "kernel_launch: unexpected shapes n_in %d out %d ws %zu (need %zu)\n", n_in, out_size, ws_size, (size_t)WS_END); grid = -1; return; }
        int dev = 0, cus = 0, per_cu = 0;
        if (hipGetDevice(&dev) != hipSuccess || hipDeviceGetAttribute(&cus, hipDeviceAttributeMultiprocessorCount, dev) != hipSuccess) { grid = -1; return; }
        if (hipFuncSetAttribute((const void*)fwd_kernel, hipFuncAttributeMaxDynamicSharedMemorySize, LDS_BYTES) != hipSuccess) { fprintf(stderr, "kernel_launch: hipFuncSetAttribute failed\n"); grid = -1; return; }
        if (hipOccupancyMaxActiveBlocksPerMultiprocessor(&per_cu, (const void*)fwd_kernel, 512, LDS_BYTES) != hipSuccess || per_cu < 1) { fprintf(stderr, "kernel_launch: occupancy query says %d\n", per_cu); }
        (void)hipGetLastError();
        grid = cus;
    }
    if (grid < 0) return;
    (void)hipMemsetAsync((char*)d_ws + WS_CTL, 0, CTL_BYTES, stream);
    Args a{};
    for (int i = 0; i < 41; ++i) a.in[i] = (const float*)d_in[i];
    a.out = (float*)d_out; a.ws = (unsigned char*)d_ws;
#if N_LAUNCH_SPLIT
    for (int p = 0; p < NPHASE; ++p) { a.ph_lo = p; a.ph_hi = p + 1; hipLaunchKernelGGL(fwd_kernel, dim3(grid), dim3(512), LDS_BYTES, stream, a); }
#else
    a.ph_lo = 0; a.ph_hi = NPHASE;
    hipLaunchKernelGGL(fwd_kernel, dim3(grid), dim3(512), LDS_BYTES, stream, a);
#endif
}
```

```cpp
#include <hip/hip_runtime.h>
#include <cstdio>
#include <cstdint>

#ifndef SCAN_PW
#define SCAN_PW 0
#endif
#ifndef SCAN_SEC
#define SCAN_SEC -1
#endif
#ifndef EN_RWKV
#define EN_RWKV 1
#endif
#ifndef EN_MLA
#define EN_MLA 1
#endif
#ifndef EN_CROSS
#define EN_CROSS 1
#endif
#ifndef EN_MOE
#define EN_MOE 1
#endif
#ifndef N_LAUNCH_SPLIT
#define N_LAUNCH_SPLIT 0
#endif

#define GAS __attribute__((address_space(1)))
#define LAS __attribute__((address_space(3)))
typedef unsigned short bf16;
typedef short bf16x8 __attribute__((ext_vector_type(8)));
typedef short s16x4 __attribute__((ext_vector_type(4)));
typedef float f32x4 __attribute__((ext_vector_type(4)));
typedef float f32x2 __attribute__((ext_vector_type(2)));
typedef float f32x16 __attribute__((ext_vector_type(16)));
typedef unsigned u32x4 __attribute__((ext_vector_type(4)));
typedef unsigned u32x2 __attribute__((ext_vector_type(2)));

constexpr int DM = 2048, NB = 2, SEQ = 4096, MT = NB * SEQ;
constexpr int MEMLEN = 256;
constexpr int QLORA = 512, KVLORA = 256, ROPE = 64, NOPE = 128, VDIM = 128, QKD = 192, MH = 16;
constexpr int RW = 2048, RH = 32, RHD = 64, DLORA = 96, GLORA = 256;
constexpr int MLA_IN = 832, RWKV_IN = 6784, GATE_IN = 4096, IN_W = MLA_IN + RWKV_IN + GATE_IN;
constexpr int CH = 4, CHD = 128, CW = 512;
constexpr int NG = 4, EPG = 8, NE = 32, DE = 512;
constexpr float RMS_EPS = 1e-6f, LNX_EPS = 64e-5f;
constexpr int G1_N = 12032;
constexpr int ZM_LD = 1024, ZR_LD = 6144, ZL_LD = 768, ZG_LD = 4096, LA_LD = 768;
constexpr int MOE_SLOTS = 2 * MT + NE * 256;

constexpr size_t MiB = 1u << 20;
constexpr size_t WS_CTL = 0, CTL_BYTES = 1 * MiB;
constexpr size_t WS_WUQ = 1 * MiB;
constexpr size_t WS_WUKV = 4 * MiB;
constexpr size_t WS_W2F = 6 * MiB;
constexpr size_t WS_G2 = 10 * MiB;
constexpr size_t WS_WUPM = 11 * MiB, WS_WUPR = 19 * MiB, WS_WOUT = 27 * MiB;
constexpr size_t WS_WQC = 35 * MiB;
constexpr size_t WS_WKVC = 37 * MiB;
constexpr size_t WS_WOC = 41 * MiB;
constexpr size_t WS_WIN = 43 * MiB;
constexpr size_t WS_MISC = 90 * MiB;
constexpr size_t WS_ROPE = WS_MISC;
constexpr size_t WS_MEMN = WS_MISC + 2 * MiB;
constexpr size_t WS_KVC = WS_MISC + 4 * MiB;
constexpr size_t WS_RSTD = WS_MISC + 5 * MiB;
constexpr size_t WS_WR = WS_RSTD + 256 * 1024;
constexpr size_t WS_LIST = WS_MISC + 6 * MiB;
constexpr size_t WS_ROUTE = WS_MISC + 7 * MiB;
constexpr size_t WS_SLOTW = WS_MISC + 8 * MiB;
constexpr size_t WS_XB = 100 * MiB;
constexpr size_t WS_ZMLA = 132 * MiB;
constexpr size_t WS_ZLORA = 148 * MiB;
constexpr size_t WS_LORAA = 160 * MiB;
constexpr size_t WS_ZRKV = 172 * MiB;
constexpr size_t WS_ZGATE = 268 * MiB;
constexpr size_t WS_Q = 332 * MiB;
constexpr size_t WS_K = 380 * MiB;
constexpr size_t WS_V = 428 * MiB;
constexpr size_t WS_WLF = 460 * MiB, WS_WLB = 492 * MiB, WS_ICF = 524 * MiB, WS_ICB = 556 * MiB;
constexpr size_t WS_G = 588 * MiB;
constexpr size_t WS_END = 620 * MiB;
constexpr size_t WS_YF = WS_WIN, WS_YB = WS_ZMLA, WS_ORWKV = WS_Q, WS_MERGED = WS_K, WS_QC = WS_V, WS_OC = WS_V + 8 * MiB;
constexpr size_t WS_WGU = WS_WLF, WS_WD = WS_ZRKV, WS_HID = WS_ZGATE, WS_YBUF = WS_Q;
constexpr size_t WS_OMLA = WS_XB, WS_H1B = WS_XB, WS_N3 = WS_XB;

constexpr int CW_BAR = 4096;
constexpr int CW_CNT = 16384;

constexpr int RING_BYTES = 159744;
constexpr int LDSCTL_OFF = RING_BYTES, MISC_OFF = LDSCTL_OFF + 320;
constexpr int LDS_BYTES = 161792;

#define LDS_WAIT() asm volatile("s_waitcnt lgkmcnt(0)" ::: "memory")
#define VM_WAIT() asm volatile("s_waitcnt vmcnt(0)" ::: "memory")
typedef __bf16 bf16x2_t __attribute__((ext_vector_type(2)));
__device__ __forceinline__ unsigned cvt_pk_bf16(float lo, float hi) { f32x2 v = {lo, hi}; bf16x2_t b = __builtin_convertvector(v, bf16x2_t); return __builtin_bit_cast(unsigned, b); }
__device__ __forceinline__ float bf2f(unsigned short b) { return __builtin_bit_cast(float, ((unsigned)b) << 16); }
__device__ __forceinline__ float bflo(unsigned w) { return __builtin_bit_cast(float, w << 16); }
__device__ __forceinline__ float bfhi(unsigned w) { return __builtin_bit_cast(float, w & 0xffff0000u); }
__device__ __forceinline__ unsigned short f2bf(float f) { return (unsigned short)(cvt_pk_bf16(f, 0.f) & 0xffffu); }
__device__ __forceinline__ float sigmoidf_(float x) { return __builtin_amdgcn_rcpf(1.0f + __builtin_amdgcn_exp2f(-1.4426950408889634f * x)); }
template <int CTRL> __device__ __forceinline__ float dpp_add_(float v) {
    return v + __builtin_bit_cast(float, __builtin_amdgcn_update_dpp(0, __builtin_bit_cast(int, v), CTRL, 0xF, 0xF, false));
}
__device__ __forceinline__ float wave_sum(float v) {
    v = dpp_add_<0xB1>(v); v = dpp_add_<0x4E>(v); v = dpp_add_<0x141>(v); v = dpp_add_<0x140>(v);
    const int iv = __builtin_bit_cast(int, v);
    const float s0 = __builtin_bit_cast(float, __builtin_amdgcn_readlane(iv, 0)), s1 = __builtin_bit_cast(float, __builtin_amdgcn_readlane(iv, 16));
    const float s2 = __builtin_bit_cast(float, __builtin_amdgcn_readlane(iv, 32)), s3 = __builtin_bit_cast(float, __builtin_amdgcn_readlane(iv, 48));
    return (s0 + s1) + (s2 + s3);
}

#define XB_TMO      128
#define XB_XCNT(j)  (256  + 64 * (j))
#define XB_XSUB(j)  (1280 + 64 * (j))
#define XB_XGEN(j)  (2304 + 64 * (j))
#define XB_TOP      3328
#define XB_TOPGEN   3392
#define XCD_BAR_WORDS 3456
#define XB_SPIN_CAP (1u << 18)
__device__ __forceinline__ unsigned xb_ld(unsigned* p)              { return __hip_atomic_load(p, __ATOMIC_RELAXED, __HIP_MEMORY_SCOPE_AGENT); }
__device__ __forceinline__ unsigned xb_add(unsigned* p, unsigned v) { return __hip_atomic_fetch_add(p, v, __ATOMIC_RELAXED, __HIP_MEMORY_SCOPE_AGENT); }
__device__ __forceinline__ unsigned xb_xcc_id() { return (unsigned)__builtin_amdgcn_s_getreg((3 << 11) | 20) & 0xFu; }
#define XB_SPIN(cond, bar) do { unsigned _sp = 0; while (cond) { __builtin_amdgcn_s_sleep(1); \
    if ((++_sp & 255u) == 0u) { if (xb_ld(&(bar)[XB_TMO])) break; if (_sp > XB_SPIN_CAP) { atomicAdd(&(bar)[XB_TMO], 1u); break; } } } } while (0)
struct XcdBarrier { unsigned* bar; unsigned x; volatile LAS unsigned* st; };
__device__ __forceinline__ XcdBarrier xcd_barrier_post(unsigned* bar, volatile LAS unsigned* st) {
    XcdBarrier b; b.bar = bar; b.x = xb_xcc_id(); b.st = st;
    if (threadIdx.x == 0) (void)xb_add(&bar[XB_XCNT(b.x)], 1u);
    return b;
}
__device__ __forceinline__ void xcd_barrier_complete(unsigned* bar, unsigned x, unsigned& nloc, unsigned& nx) {
    const unsigned G = gridDim.x * gridDim.y * gridDim.z;
    unsigned sum, cnt, mine, sp = 0u;
    for (;;) {
        sum = 0u; cnt = 0u; mine = 0u;
#pragma unroll
        for (unsigned j = 0; j < 16; ++j) { const unsigned c = xb_ld(&bar[XB_XCNT(j)]); sum += c; cnt += (c > 0u) ? 1u : 0u; mine = (j == x) ? c : mine; }
        if (sum == G) break;
        __builtin_amdgcn_s_sleep(1);
        if ((++sp & 255u) == 0u) { if (xb_ld(&bar[XB_TMO])) break; if (sp > XB_SPIN_CAP) { atomicAdd(&bar[XB_TMO], 1u); break; } }
    }
    nloc = mine > 0u ? mine : 1u; nx = cnt > 0u ? cnt : 1u;
}
__device__ __forceinline__ void xcd_barrier(const XcdBarrier& b) {
    asm volatile("s_waitcnt vmcnt(0)" ::: "memory");
    __syncthreads();
    if (threadIdx.x == 0) {
        unsigned* bar = b.bar;
        __builtin_amdgcn_s_waitcnt(0);
        unsigned nloc = b.st[0], nx = b.st[1];
        if (nloc == 0u) { xcd_barrier_complete(bar, b.x, nloc, nx); b.st[0] = nloc; b.st[1] = nx; }
        const unsigned old = xb_add(&bar[XB_XSUB(b.x)], 1u);
        const unsigned gen = old / nloc;
        if (old + 1u == (gen + 1u) * nloc) {
            __builtin_amdgcn_fence(__ATOMIC_RELEASE, "agent");
            asm volatile("s_waitcnt vmcnt(0)" ::: "memory");
            const unsigned og = xb_add(&bar[XB_TOP], 1u);
            const unsigned tg = og / nx;
            if (og + 1u == (tg + 1u) * nx) xb_add(&bar[XB_TOPGEN], 1u);
            else XB_SPIN(xb_ld(&bar[XB_TOPGEN]) == tg, bar);
            __builtin_amdgcn_fence(__ATOMIC_ACQUIRE, "agent");
            xb_add(&bar[XB_XGEN(b.x)], 1u);
            asm volatile("s_waitcnt vmcnt(0)" ::: "memory");
        } else {
            XB_SPIN(xb_ld(&bar[XB_XGEN(b.x)]) == gen, bar);
            __builtin_amdgcn_fence(__ATOMIC_ACQUIRE, "agent");
            asm volatile("s_waitcnt vmcnt(0)" ::: "memory");
        }
    }
    __syncthreads();
}

namespace pg8 {
constexpr int BM = 256, BK = 64, HALF = 128, HTB = HALF * BK * 2, STAGE_BYTES = 8 * HTB, NXCD = 8, WGM = 8;
__host__ __device__ __forceinline__ int lds_byte(int r, int c) { const int st = (r >> 4) * 2 + (c >> 5), rr = r & 15, cc = c & 31, ob = rr * 64 + cc * 2; return st * 1024 + (ob ^ (((ob >> 9) & 1) << 5)); }
__host__ __device__ __forceinline__ void stage_rc(int b, int& R, int& C) { const int st = b / 1024, sb = b % 1024, swz = sb ^ (((sb >> 9) & 1) << 5); R = (st >> 1) * 16 + swz / 64; C = (st & 1) * 32 + (swz % 64) / 2; }
__host__ __device__ __forceinline__ int perm32(int rho) { const int n = rho >> 4, i = rho & 15; return 8 * (i >> 2) + 4 * n + (i & 3); }

struct Unit { int pm, pn; const char* Ab; const char* Bb; int aux0, aux1; };

struct StaticOrder {
    static constexpr bool GATHER = false;
    int nM, nN, nwg, G, c; const char* A; const char* Bt; int lda, ldb;
    __device__ void init(const bf16* A_, int lda_, const bf16* Bt_, int ldb_, int M, int N, int G_, int c_) { A = (const char*)A_; Bt = (const char*)Bt_; lda = lda_; ldb = ldb_; nM = M / BM; nN = N / BM; nwg = nM * nN; G = G_; c = c_; }
    __device__ __forceinline__ bool next(int i, Unit& u) const {
        const long L = (long)i * G + c; if (L >= nwg) return false;
        int wgid = (int)L; { const int q = nwg / NXCD, r = nwg % NXCD, xcd = wgid % NXCD, off = wgid / NXCD; wgid = (xcd < r ? xcd * (q + 1) : r * (q + 1) + (xcd - r) * q) + off; }
        const int nig = WGM * nN, gid = wgid / nig, fm = gid * WGM, gsz = (nM - fm) < WGM ? (nM - fm) : WGM;
        u.pm = fm + ((wgid % nig) % gsz); u.pn = (wgid % nig) / gsz; u.Ab = A + (size_t)u.pm * BM * lda * 2; u.Bb = Bt + (size_t)u.pn * BM * ldb * 2; u.aux0 = 0; u.aux1 = 0; return true;
    }
    __device__ __forceinline__ unsigned arow(const Unit& u, int r) const { return (unsigned)r; }
};

#define PG8_ACC f32x4 (&acc)[2][2][4][2]
template <class Epi, class Sched>
__device__ __forceinline__ void gemm_phase(LAS unsigned char* lds, const int K, const int lda, const int ldb, const Sched& S, const Epi& E) {
    const int tid = threadIdx.x, wid = __builtin_amdgcn_readfirstlane(tid >> 6), lane = tid & 63, wr = wid >> 2, wc = wid & 3, fr = lane & 15, fq = lane >> 4;
    const int nt = K / BK;
    int sR[2], sC[2]; unsigned voffB[2];
#pragma unroll
    for (int i = 0; i < 2; ++i) { stage_rc(tid * 16 + i * 8192, sR[i], sC[i]); const int Rb = Epi::PERM ? ((sR[i] & ~31) + perm32(sR[i] & 31)) : sR[i];
        voffB[i] = (unsigned)(Rb * ldb + sC[i]) * 2u; }
    const size_t kstep = (size_t)(BK * 2);
    const size_t hstepB = (size_t)HALF * ldb * 2;
    const unsigned ldsw = (unsigned)wid * 1024u;
    const int aoff = lds_byte(wr * 64 + fr, fq * 8), boff = lds_byte(wc * 32 + fr, fq * 8);
#define PG8_SA(b, h) (((b) * 2 + (h)) * HTB)
#define PG8_SB(b, h) ((4 + (b) * 2 + (h)) * HTB)
#define PG8_STAGE(bufoff, gbase, voff) do { _Pragma("unroll") for (int _i = 0; _i < 2; ++_i) \
        __builtin_amdgcn_global_load_lds((const unsigned*)((const char*)(gbase) + (voff)[_i]), (LAS unsigned*)(lds + (bufoff) + ldsw + _i * 8192), 16, 0, 0); } while (0)
#define PG8_LDA(dst, b, h) do { _Pragma("unroll") for (int m = 0; m < 4; ++m) _Pragma("unroll") for (int k = 0; k < 2; ++k) dst[m][k] = *(const LAS bf16x8*)(lds + PG8_SA(b, h) + aoff + m * 2048 + k * 1024); } while (0)
#define PG8_LDB(dst, b, h) do { _Pragma("unroll") for (int n = 0; n < 2; ++n) _Pragma("unroll") for (int k = 0; k < 2; ++k) dst[n][k] = *(const LAS bf16x8*)(lds + PG8_SB(b, h) + boff + n * 2048 + k * 1024); } while (0)
#define PG8_MMA(ai, bj, At, Bt) do { __builtin_amdgcn_s_setprio(1); _Pragma("unroll") for (int m = 0; m < 4; ++m) _Pragma("unroll") for (int n = 0; n < 2; ++n) _Pragma("unroll") for (int k = 0; k < 2; ++k) \
        acc[ai][bj][m][n] = __builtin_amdgcn_mfma_f32_16x16x32_bf16(Bt[n][k], At[m][k], acc[ai][bj][m][n], 0, 0, 0); __builtin_amdgcn_s_setprio(0); } while (0)
#define PG8_WAIT_V(n) asm volatile("s_waitcnt vmcnt(" #n ")" ::: "memory")
#define PG8_WAIT_L(n) asm volatile("s_waitcnt lgkmcnt(" #n ")" ::: "memory")
#define PG8_BAR __builtin_amdgcn_s_barrier()
#define PG8_SCHED __builtin_amdgcn_sched_barrier(0)
#define PG8_SETVA(dst, u) do { _Pragma("unroll") for (int _h = 0; _h < 2; ++_h) _Pragma("unroll") for (int _i = 0; _i < 2; ++_i) \
        dst[_h][_i] = (S.arow(u, _h * HALF + sR[_i]) * (unsigned)lda + (unsigned)sC[_i]) * 2u; } while (0)
    Unit cur, nxt; int ui = 0;
    if (!S.next(0, cur)) return;
    f32x4 acc[2][2][4][2];
#pragma unroll
    for (int a = 0; a < 2; ++a)
#pragma unroll
        for (int b = 0; b < 2; ++b)
#pragma unroll
            for (int m = 0; m < 4; ++m)
#pragma unroll
                for (int n = 0; n < 2; ++n) acc[a][b][m][n] = (f32x4){0.f, 0.f, 0.f, 0.f};
    bf16x8 At[4][2], B0[2][2], B1[2][2];
    constexpr bool GA = Sched::GATHER;
    unsigned vA[2][2], nvA[2][2];
    PG8_SETVA(vA, cur);
    const char* cA = cur.Ab; const char* cB = cur.Bb;
    PG8_STAGE(PG8_SB(0, 0), cB, voffB); PG8_STAGE(PG8_SA(0, 0), cA, vA[0]); PG8_STAGE(PG8_SB(0, 1), cB + hstepB, voffB); PG8_STAGE(PG8_SA(0, 1), cA, vA[1]);
    if (wr == 1) PG8_BAR;
    PG8_WAIT_V(4); PG8_BAR;
    PG8_STAGE(PG8_SB(1, 0), cB + kstep, voffB); PG8_STAGE(PG8_SA(1, 0), cA + kstep, vA[0]); PG8_STAGE(PG8_SB(1, 1), cB + hstepB + kstep, voffB);
    PG8_WAIT_V(6); PG8_BAR;
    for (;;) {
        const bool has_next = S.next(ui + 1, nxt);
        const char* nA = cA; const char* nB = cB;
        if (has_next) { nA = nxt.Ab; nB = nxt.Bb; if (GA) PG8_SETVA(nvA, nxt); }
        else if (GA) {
#pragma unroll
            for (int h = 0; h < 2; ++h)
#pragma unroll
                for (int i = 0; i < 2; ++i) nvA[h][i] = vA[h][i]; }
#pragma unroll 1
        for (int t = 0; t < nt; t += 2) {
            const bool last = (t == nt - 2);
            const char* a1 = cA + (size_t)(t + 1) * kstep;
            const char* a2 = last ? nA : cA + (size_t)(t + 2) * kstep; const char* b2 = last ? nB : cB + (size_t)(t + 2) * kstep;
            const char* a3 = a2 + kstep; const char* b3 = b2 + kstep;
            unsigned s2[2][2];
#pragma unroll
            for (int h = 0; h < 2; ++h)
#pragma unroll
                for (int i = 0; i < 2; ++i) s2[h][i] = (GA && last) ? nvA[h][i] : vA[h][i];
            PG8_LDB(B0, 0, 0); PG8_SCHED; PG8_LDA(At, 0, 0); PG8_STAGE(PG8_SA(1, 1), a1, vA[1]);
            PG8_WAIT_L(8); PG8_BAR; PG8_WAIT_L(0); PG8_MMA(0, 0, At, B0); PG8_BAR; PG8_SCHED;
            PG8_LDB(B1, 0, 1); PG8_STAGE(PG8_SB(0, 0), b2, voffB);
            PG8_BAR; PG8_WAIT_L(0); PG8_MMA(0, 1, At, B1); PG8_BAR;
            PG8_LDA(At, 0, 1); PG8_STAGE(PG8_SA(0, 0), a2, s2[0]);
            PG8_BAR; PG8_WAIT_L(0); PG8_MMA(1, 0, At, B0); PG8_BAR; PG8_SCHED;
            PG8_STAGE(PG8_SB(0, 1), b2 + hstepB, voffB);
            PG8_WAIT_V(6); PG8_BAR; PG8_MMA(1, 1, At, B1); PG8_BAR;
            PG8_LDB(B0, 1, 0); PG8_SCHED; PG8_LDA(At, 1, 0); PG8_STAGE(PG8_SA(0, 1), a2, s2[1]);
            PG8_WAIT_L(8); PG8_BAR; PG8_WAIT_L(0); PG8_MMA(0, 0, At, B0); PG8_BAR; PG8_SCHED;
            PG8_LDB(B1, 1, 1); PG8_STAGE(PG8_SB(1, 0), b3, voffB);
            PG8_BAR; PG8_WAIT_L(0); PG8_MMA(0, 1, At, B1); PG8_BAR;
            PG8_LDA(At, 1, 1); PG8_STAGE(PG8_SA(1, 0), a3, s2[0]);
            PG8_BAR; PG8_WAIT_L(0); PG8_MMA(1, 0, At, B0); PG8_BAR; PG8_SCHED;
            PG8_STAGE(PG8_SB(1, 1), b3 + hstepB, voffB);
            PG8_WAIT_V(6); PG8_BAR; PG8_MMA(1, 1, At, B1); PG8_BAR;
        }
        { int fr_e = fr, fq_e = fq; asm volatile("" : "+v"(fr_e), "+v"(fq_e));
          E(acc, cur, wr, wc, fr_e, fq_e); }
        if (!has_next) break;
#pragma unroll
        for (int a = 0; a < 2; ++a)
#pragma unroll
            for (int b = 0; b < 2; ++b)
#pragma unroll
                for (int m = 0; m < 4; ++m)
#pragma unroll
                    for (int n = 0; n < 2; ++n) acc[a][b][m][n] = (f32x4){0.f, 0.f, 0.f, 0.f};
        cur = nxt; cA = nA; cB = nB; ++ui;
        if (GA) {
#pragma unroll
        for (int h = 0; h < 2; ++h)
#pragma unroll
            for (int i = 0; i < 2; ++i) vA[h][i] = nvA[h][i]; }
    }
    PG8_WAIT_V(0);
    if (wr == 0) PG8_BAR;
    PG8_BAR;
#undef PG8_SA
#undef PG8_SB
#undef PG8_STAGE
#undef PG8_LDA
#undef PG8_LDB
#undef PG8_MMA
#undef PG8_WAIT_V
#undef PG8_WAIT_L
#undef PG8_BAR
#undef PG8_SCHED
#undef PG8_SETVA
}
#define EPI_FOR(ai, m, bj) _Pragma("unroll") for (int ai = 0; ai < 2; ++ai) _Pragma("unroll") for (int m = 0; m < 4; ++m) _Pragma("unroll") for (int bj = 0; bj < 2; ++bj)
__device__ __forceinline__ u32x4 pack8(f32x4 v0, f32x4 v1) { u32x4 w; w.x = cvt_pk_bf16(v0[0], v0[1]); w.y = cvt_pk_bf16(v0[2], v0[3]); w.z = cvt_pk_bf16(v1[0], v1[1]); w.w = cvt_pk_bf16(v1[2], v1[3]); return w; }
}
using pg8::Unit;

struct EpiG1 {
    static constexpr bool PERM = true;
    const float* rstd; bf16 *zmla, *zrkv, *zlora, *zgate;
    __device__ __forceinline__ void operator()(const PG8_ACC, const Unit& u, int wr, int wc, int fr, int fq) const {
        bf16* base; int ld, c0;
        if (u.pn < 4) { base = zmla; ld = ZM_LD; c0 = u.pn * 256; } else if (u.pn < 28) { base = zrkv; ld = ZR_LD; c0 = (u.pn - 4) * 256; }
        else if (u.pn < 31) { base = zlora; ld = ZL_LD; c0 = (u.pn - 28) * 256; } else { base = zgate; ld = ZG_LD; c0 = (u.pn - 31) * 256; }
        const int col0 = c0 + wc * 32 + 8 * fq;
        EPI_FOR(ai, m, bj) { const int row = u.pm * 256 + ai * 128 + wr * 64 + m * 16 + fr; const float rs = rstd[row];
            *(u32x4*)(base + (size_t)row * ld + col0 + bj * 128) = pg8::pack8(acc[ai][bj][m][0] * rs, acc[ai][bj][m][1] * rs); }
    }
};
struct EpiPlain {
    static constexpr bool PERM = true;
    bf16* O; int ld; const float* rstd; float scale;
    __device__ __forceinline__ void operator()(const PG8_ACC, const Unit& u, int wr, int wc, int fr, int fq) const {
        const int col0 = u.pn * 256 + wc * 32 + 8 * fq;
        EPI_FOR(ai, m, bj) { const int row = u.pm * 256 + ai * 128 + wr * 64 + m * 16 + fr; const float rs = (rstd ? rstd[row] : 1.f) * scale;
            *(u32x4*)(O + (size_t)row * ld + col0 + bj * 128) = pg8::pack8(acc[ai][bj][m][0] * rs, acc[ai][bj][m][1] * rs); }
    }
};
constexpr float QSCALE = 0.07216878364870322f * 1.4426950408889634f;
constexpr float CSCALE = 0.08838834764831845f * 1.4426950408889634f;
struct EpiQ {
    static constexpr bool PERM = true;
    bf16* Q; const float* rstd; const float* cs;
    __device__ __forceinline__ void operator()(const PG8_ACC, const Unit& u, int wr, int wc, int fr, int fq) const {
        EPI_FOR(ai, m, bj) { const int row = u.pm * 256 + ai * 128 + wr * 64 + m * 16 + fr; const int col = u.pn * 256 + bj * 128 + wc * 32 + 8 * fq;
            const float rs = rstd[row] * QSCALE; f32x4 v0 = acc[ai][bj][m][0] * rs, v1 = acc[ai][bj][m][1] * rs;
            const int cih = col % QKD;
            if (cih >= NOPE) { const int i0 = (cih - NOPE) >> 1; const f32x4* t = (const f32x4*)(cs + ((size_t)row * 32 + i0) * 2);
                const f32x4 a = t[0], b = t[1];
                f32x4 r0, r1;
                r0[0] = v0[0] * a[0] - v0[1] * a[1]; r0[1] = v0[1] * a[0] + v0[0] * a[1]; r0[2] = v0[2] * a[2] - v0[3] * a[3]; r0[3] = v0[3] * a[2] + v0[2] * a[3];
                r1[0] = v1[0] * b[0] - v1[1] * b[1]; r1[1] = v1[1] * b[0] + v1[0] * b[1]; r1[2] = v1[2] * b[2] - v1[3] * b[3]; r1[3] = v1[3] * b[2] + v1[2] * b[3];
                v0 = r0; v1 = r1; }
            *(u32x4*)(Q + (size_t)row * (MH * QKD) + col) = pg8::pack8(v0, v1); }
    }
};
struct EpiKV {
    static constexpr bool PERM = true;
    bf16* Kb; bf16* Vb; const float* rstd;
    __device__ __forceinline__ void operator()(const PG8_ACC, const Unit& u, int wr, int wc, int fr, int fq) const {
        const int c = wc * 32 + 8 * fq;
        EPI_FOR(ai, m, bj) { const int row = u.pm * 256 + ai * 128 + wr * 64 + m * 16 + fr; const float rs = rstd[row];
            bf16* dst = bj == 0 ? Kb + (size_t)row * (MH * QKD) + u.pn * QKD + c : Vb + (size_t)row * (MH * VDIM) + u.pn * VDIM + c;
            *(u32x4*)dst = pg8::pack8(acc[ai][bj][m][0] * rs, acc[ai][bj][m][1] * rs); }
    }
};
template <int MODE> struct EpiLora {
    static constexpr bool PERM = true;
    bf16* O; const float* bias;
    __device__ __forceinline__ void operator()(const PG8_ACC, const Unit& u, int wr, int wc, int fr, int fq) const {
        EPI_FOR(ai, m, bj) { const int row = u.pm * 256 + ai * 128 + wr * 64 + m * 16 + fr; const int col = u.pn * 256 + bj * 128 + wc * 32 + 8 * fq;
            f32x4 v0 = acc[ai][bj][m][0], v1 = acc[ai][bj][m][1];
            if (MODE != 2) { const f32x4 b0 = *(const f32x4*)(bias + col), b1 = *(const f32x4*)(bias + col + 4);
#pragma unroll
                for (int j = 0; j < 4; ++j) { float s0 = sigmoidf_(v0[j] + b0[j]), s1 = sigmoidf_(v1[j] + b1[j]);
                    if (MODE == 0) { s0 *= -0.8750394f; s1 *= -0.8750394f; }
                    v0[j] = s0; v1[j] = s1; } }
            *(u32x4*)(O + (size_t)row * RW + col) = pg8::pack8(v0, v1); }
    }
};
template <int MODE> struct EpiLora2 {
    static constexpr bool PERM = true;
    bf16* O0; bf16* O1; const float* bias0; const float* bias1;
    __device__ __forceinline__ void operator()(const PG8_ACC, const Unit& u, int wr, int wc, int fr, int fq) const {
        const bool second = u.pn >= 8; bf16* O = second ? O1 : O0; const float* bias = second ? bias1 : bias0; const int pn = second ? u.pn - 8 : u.pn;
        EPI_FOR(ai, m, bj) { const int row = u.pm * 256 + ai * 128 + wr * 64 + m * 16 + fr; const int col = pn * 256 + bj * 128 + wc * 32 + 8 * fq;
            f32x4 v0 = acc[ai][bj][m][0], v1 = acc[ai][bj][m][1];
            const f32x4 b0 = *(const f32x4*)(bias + col), b1 = *(const f32x4*)(bias + col + 4);
#pragma unroll
            for (int j = 0; j < 4; ++j) { float s0 = sigmoidf_(v0[j] + b0[j]), s1 = sigmoidf_(v1[j] + b1[j]);
                if (MODE == 0) { s0 *= -0.8750394f; s1 *= -0.8750394f; }
                v0[j] = s0; v1[j] = s1; }
            *(u32x4*)(O + (size_t)row * RW + col) = pg8::pack8(v0, v1); }
    }
};
template <int SECOND> struct EpiUp {
    static constexpr bool PERM = true;
    bf16* O; const bf16* zg; int goff;
    __device__ __forceinline__ void operator()(const PG8_ACC, const Unit& u, int wr, int wc, int fr, int fq) const {
        EPI_FOR(ai, m, bj) { const int row = u.pm * 256 + ai * 128 + wr * 64 + m * 16 + fr; const int col = u.pn * 256 + bj * 128 + wc * 32 + 8 * fq;
            const u32x4 g = *(const u32x4*)(zg + (size_t)row * ZG_LD + goff + col);
            f32x4 v0 = acc[ai][bj][m][0], v1 = acc[ai][bj][m][1];
            v0[0] *= sigmoidf_(bflo(g.x)); v0[1] *= sigmoidf_(bfhi(g.x)); v0[2] *= sigmoidf_(bflo(g.y)); v0[3] *= sigmoidf_(bfhi(g.y));
            v1[0] *= sigmoidf_(bflo(g.z)); v1[1] *= sigmoidf_(bfhi(g.z)); v1[2] *= sigmoidf_(bflo(g.w)); v1[3] *= sigmoidf_(bfhi(g.w));
            bf16* dst = O + (size_t)row * DM + col;
            if (SECOND) { const u32x4 p = *(const u32x4*)dst;
                v0[0] += bflo(p.x); v0[1] += bfhi(p.x); v0[2] += bflo(p.y); v0[3] += bfhi(p.y); v1[0] += bflo(p.z); v1[1] += bfhi(p.z); v1[2] += bflo(p.w); v1[3] += bfhi(p.w); }
            *(u32x4*)dst = pg8::pack8(v0, v1); }
    }
};
struct EpiResid {
    static constexpr bool PERM = true;
    const float* base; float* out;
    __device__ __forceinline__ void operator()(const PG8_ACC, const Unit& u, int wr, int wc, int fr, int fq) const {
        EPI_FOR(ai, m, bj) { const int row = u.pm * 256 + ai * 128 + wr * 64 + m * 16 + fr; const int col = u.pn * 256 + bj * 128 + wc * 32 + 8 * fq;
            const size_t o = (size_t)row * DM + col; const f32x4 b0 = *(const f32x4*)(base + o), b1 = *(const f32x4*)(base + o + 4);
            *(f32x4*)(out + o) = b0 + acc[ai][bj][m][0]; *(f32x4*)(out + o + 4) = b1 + acc[ai][bj][m][1]; }
    }
};

namespace att {
constexpr int NW = 8, QBLK = 32, KVBLK = 64;
constexpr float THRL = 11.5f;
#define SBAR() __builtin_amdgcn_sched_barrier(0)
__device__ __forceinline__ int crow(int r, int hi) { return (r & 3) + 8 * (r >> 2) + 4 * hi; }
__device__ __forceinline__ void partialSM(f32x16& p, float& m_reg, float& alpha) {
    float pmax = p[0];
#pragma unroll
    for (int r = 1; r < 16; ++r) pmax = fmaxf(pmax, p[r]);
    { auto rr = __builtin_amdgcn_permlane32_swap(__float_as_uint(pmax), __float_as_uint(pmax), false, false);
      pmax = fmaxf(__uint_as_float(rr[0]), __uint_as_float(rr[1])); }
    float mn;
    if (__builtin_expect(__all(pmax - m_reg <= THRL), 1)) { mn = m_reg; alpha = 1.f; }
    else { mn = fmaxf(m_reg, pmax); alpha = __builtin_amdgcn_exp2f(m_reg - mn); m_reg = mn; }
#pragma unroll
    for (int r = 0; r < 16; ++r) p[r] = p[r] - mn;
#pragma unroll
    for (int r = 0; r < 8; ++r) p[r] = __builtin_amdgcn_exp2f(p[r]);
}
__device__ __forceinline__ void finishSM(f32x16& p, float alpha, float& l_reg, bf16x8& pa0, bf16x8& pa1) {
#pragma unroll
    for (int r = 8; r < 16; ++r) p[r] = __builtin_amdgcn_exp2f(p[r]);
    float ps = 0;
#pragma unroll
    for (int r = 0; r < 16; ++r) ps += p[r];
    { auto rr = __builtin_amdgcn_permlane32_swap(__float_as_uint(ps), __float_as_uint(ps), false, false);
      ps = __uint_as_float(rr[0]) + __uint_as_float(rr[1]); }
    l_reg = l_reg * alpha + ps;
#define PK4(P, BASE, OUT) do { unsigned a0 = cvt_pk_bf16(P[BASE + 0], P[BASE + 1]), a1 = cvt_pk_bf16(P[BASE + 2], P[BASE + 3]);   \
    unsigned b0 = cvt_pk_bf16(P[BASE + 4], P[BASE + 5]), b1 = cvt_pk_bf16(P[BASE + 6], P[BASE + 7]);                              \
    auto r0 = __builtin_amdgcn_permlane32_swap(a0, b0, false, false); auto r1 = __builtin_amdgcn_permlane32_swap(a1, b1, false, false); \
    u32x4 w = {r0[0], r1[0], r0[1], r1[1]}; OUT = *reinterpret_cast<bf16x8*>(&w); } while (0)
    PK4(p, 0, pa0); PK4(p, 8, pa1);
#undef PK4
}
template <int DQK> __device__ __forceinline__ int kswz(int row, int colB) { return row * (DQK * 2 + 16) + colB; }
template <int DQK> __device__ __forceinline__ void qkt(f32x16& p, const LAS char* Ks, const bf16x8* qr, int krow, int hi) {
    p = f32x16{};
#pragma unroll
    for (int d0 = 0; d0 < DQK / 16; ++d0) { const int cb = (d0 * 16 + hi * 8) * 2;
        bf16x8 b0 = *reinterpret_cast<const LAS bf16x8*>(Ks + kswz<DQK>(krow, cb));
        p = __builtin_amdgcn_mfma_f32_32x32x16_bf16(b0, qr[d0], p, 0, 0, 0); }
}
__device__ __forceinline__ int v_st(int k, int c) { const int kk = (k & ~0xC) | ((k & 4) << 1) | ((k & 8) >> 1); return ((kk >> 3) * 4 + (c >> 5)) * 512 + ((kk & 7) * 32 + (c & 31)) * 2; }
__device__ __forceinline__ int v_rd_base(int lane) { return ((lane & 3) << 3) | (((lane >> 2) & 3) << 6) | (((lane >> 4) & 1) << 5) | (((lane >> 5) & 1) << 8); }
constexpr int v_rd_off(int d0, int ks, int half) { return d0 * 512 + ks * 4096 + half * 2048; }
template <int OFF> __device__ __forceinline__ s16x4 tr_read(int vb) {
    s16x4 r; asm volatile("ds_read_b64_tr_b16 %0, %1 offset:%2" : "=&v"(r) : "v"(vb), "i"(OFF) : "memory"); return r;
}
template <int D0, int KH> __device__ __forceinline__ void pv_one(f32x16& od, int vb, bf16x8 pa0, bf16x8 pa1) {
    const s16x4 l0 = tr_read<v_rd_off(D0, 2 * KH, 0)>(vb), h0 = tr_read<v_rd_off(D0, 2 * KH, 1)>(vb), l1 = tr_read<v_rd_off(D0, 2 * KH + 1, 0)>(vb), h1 = tr_read<v_rd_off(D0, 2 * KH + 1, 1)>(vb);
    asm volatile("s_waitcnt lgkmcnt(0)" ::: "memory"); SBAR();
#define PK(L, H) (bf16x8){L[0], L[1], L[2], L[3], H[0], H[1], H[2], H[3]}
    od = __builtin_amdgcn_mfma_f32_32x32x16_bf16(pa0, PK(l0, h0), od, 0, 0, 0);
    od = __builtin_amdgcn_mfma_f32_32x32x16_bf16(pa1, PK(l1, h1), od, 0, 0, 0);
#undef PK
}
template <int KH> __device__ __forceinline__ void pv_d0(f32x16* o, int vb, bf16x8 pa0, bf16x8 pa1) {
    pv_one<0, KH>(o[0], vb, pa0, pa1); pv_one<1, KH>(o[1], vb, pa0, pa1); pv_one<2, KH>(o[2], vb, pa0, pa1); pv_one<3, KH>(o[3], vb, pa0, pa1);
}
template <int DQK, int LDQ, int LDK, int LDV, int LDO>
__device__ __forceinline__ void attn_unit(const bf16* __restrict__ Qb, const bf16* __restrict__ Kh, const bf16* __restrict__ Vh, bf16* __restrict__ Ob, const int seq, LAS char* lds) {
    constexpr int SHM_V = KVBLK * 128 * 2, SHM_K = KVBLK * (DQK * 2 + 16), KCH = DQK / 64;
    const int tid = threadIdx.x, wid = tid >> 6, lane = tid & 63, r32 = lane & 31, hi = lane >> 5;
    LAS char* V_lds = lds; LAS char* K_lds = lds + 2 * SHM_V;
    LAS float* wsf = (LAS float*)(lds + 2 * SHM_V + 2 * SHM_K) + wid * 64; LAS float* li_l = wsf; LAS float* al_l = wsf + 32;
    float m_reg = -1e30f, l_reg = 0; f32x16 o[4] = {}; bf16x8 qr[DQK / 16];
    const bf16* Qw = Qb + (long)(wid * QBLK + r32) * LDQ + hi * 8;
#pragma unroll
    for (int d0 = 0; d0 < DQK / 16; ++d0) qr[d0] = *reinterpret_cast<const bf16x8*>(Qw + d0 * 16);
    const int sr = tid >> 4, sc = (tid & 15) * 8, vst0 = v_st(sr, sc), vst1 = v_st(32 + sr, sc);
    unsigned kgo[KCH]; int klo[KCH];
#pragma unroll
    for (int i = 0; i < KCH; ++i) { const int id = tid + 512 * i, row = id / (DQK / 8), c8 = id % (DQK / 8); kgo[i] = (unsigned)(row * LDK + c8 * 8) * 2u; klo[i] = kswz<DQK>(row, c8 * 16); }
    const unsigned vgo0 = (unsigned)(sr * LDV + sc) * 2u, vgo1 = (unsigned)((32 + sr) * LDV + sc) * 2u;
    const int vb0 = (int)(uintptr_t)V_lds + v_rd_base(lane);
    bf16x8 vs0, vs1, ks[KCH];
#define SLOAD(k0) do { const char* _vt = (const char*)(Vh + (size_t)(k0) * LDV); const char* _kt = (const char*)(Kh + (size_t)(k0) * LDK); \
    vs0 = *reinterpret_cast<const bf16x8*>(_vt + vgo0); vs1 = *reinterpret_cast<const bf16x8*>(_vt + vgo1); \
    _Pragma("unroll") for (int _i = 0; _i < KCH; ++_i) ks[_i] = *reinterpret_cast<const bf16x8*>(_kt + kgo[_i]); } while (0)
#define SWRITE(b) do { *(LAS bf16x8*)(V_lds + (b) * SHM_V + vst0) = vs0; *(LAS bf16x8*)(V_lds + (b) * SHM_V + vst1) = vs1; \
    _Pragma("unroll") for (int _i = 0; _i < KCH; ++_i) *(LAS bf16x8*)(K_lds + (b) * SHM_K + klo[_i]) = ks[_i]; } while (0)
#define SWAIT() asm volatile("s_waitcnt vmcnt(0)" ::: "memory")
#define RESC(a) do { if (__any((a) < 1.f)) { if (hi == 0) al_l[r32] = (a); asm volatile("s_waitcnt lgkmcnt(0)" ::: "memory"); \
    _Pragma("unroll") for (int d = 0; d < 4; ++d) _Pragma("unroll") for (int r = 0; r < 16; ++r) o[d][r] *= al_l[crow(r, hi)]; } } while (0)
    f32x16 pA, pB; float alA, alB; bf16x8 pa0, pa1; const int NT = seq / KVBLK;
    SLOAD(0); SWAIT(); SWRITE(0); __syncthreads();
    if (1 < NT) SLOAD(KVBLK);
    qkt<DQK>(pA, K_lds, qr, r32, hi); partialSM(pA, m_reg, alA);
    if (1 < NT) { SWAIT(); SWRITE(1); } __syncthreads();
    if (2 < NT) SLOAD(2 * KVBLK);
    SBAR(); qkt<DQK>(pB, K_lds, qr, 32 + r32, hi);
    finishSM(pA, alA, l_reg, pa0, pa1); SBAR();
    pv_d0<0>(o, vb0, pa0, pa1); partialSM(pB, m_reg, alB); RESC(alB);
    for (int j = 1; j < NT; ++j) {
        const int cb = j & 1, pb = cb ^ 1;
        SBAR(); qkt<DQK>(pA, K_lds + cb * SHM_K, qr, r32, hi);
        finishSM(pB, alB, l_reg, pa0, pa1); SBAR();
        pv_d0<1>(o, vb0 + pb * SHM_V, pa0, pa1); partialSM(pA, m_reg, alA);
        __syncthreads(); if (j + 1 < NT) { SWAIT(); SWRITE(pb); }
        RESC(alA); __syncthreads();
        if (j + 2 < NT) SLOAD((j + 2) * KVBLK);
        SBAR(); qkt<DQK>(pB, K_lds + cb * SHM_K, qr, 32 + r32, hi);
        finishSM(pA, alA, l_reg, pa0, pa1); SBAR();
        pv_d0<0>(o, vb0 + cb * SHM_V, pa0, pa1); partialSM(pB, m_reg, alB); RESC(alB);
    }
    finishSM(pB, alB, l_reg, pa0, pa1); SBAR();
    pv_d0<1>(o, vb0 + ((NT - 1) & 1) * SHM_V, pa0, pa1);
    if (hi == 0) li_l[r32] = l_reg; asm volatile("s_waitcnt lgkmcnt(0)" ::: "memory");
    float rli[16];
#pragma unroll
    for (int r = 0; r < 16; ++r) rli[r] = __builtin_amdgcn_rcpf(li_l[crow(r, hi)]);
    bf16* Ow = Ob + (size_t)(wid * QBLK) * LDO;
    int r32e = r32, hie = hi; asm volatile("" : "+v"(r32e), "+v"(hie));
    const unsigned ob = (unsigned)(4 * hie * LDO + r32e);
#pragma unroll
    for (int r = 0; r < 16; ++r) {
#pragma unroll
        for (int d0 = 0; d0 < 4; ++d0) Ow[ob + (unsigned)(((r & 3) + 8 * (r >> 2)) * LDO + d0 * 32)] = f2bf(o[d0][r] * rli[r]); }
    __syncthreads();
#undef SLOAD
#undef SWRITE
#undef SWAIT
#undef RESC
}
}

struct Frame {
    LAS unsigned char* lds; volatile LAS unsigned* MISC; unsigned* ctl;
    int tid, lane, wave, vcu, G;
    unsigned char* ws; float* out;
    const float* in[41];
};
enum { I_X = 0, I_MEM, I_POS, I_GMIX, I_WIN, I_GQ, I_WUQ, I_GKV, I_WUKV, I_SHIFT, I_W0F, I_W2F, I_W0B, I_W2B, I_A0F, I_A2F, I_A0B, I_A2B, I_G2, I_KK, I_KA, I_RK,
       I_LNXG, I_LNXB, I_WUPM, I_WUPR, I_WOUT, I_GCROSS, I_GMEM, I_WQC, I_WKVC, I_WOC, I_GFFN, I_WRG, I_BRG, I_WRE, I_BRE, I_WEG, I_WEU, I_WED, I_GFINAL };

template <int MODE> __device__ __forceinline__ int rowmap(int n) {
    if (MODE == 1) {
        if (n < 768) return n;
        if (n < 832) { const int p = n - 768; return 768 + (p < 32 ? 2 * p : 2 * (p - 32) + 1); }
        if (n < 6976) return 1024 + (n - 832);
        if (n < 7616) return 7168 + (n - 6976);
        return 7936 + (n - 7616);
    }
    if (MODE == 2) {
        const int h = n / QKD, d = n % QKD; if (d < NOPE) return n; const int p = d - NOPE; return h * QKD + NOPE + (p < 32 ? 2 * p : 2 * (p - 32) + 1);
    }
    if (MODE == 3) return (n >> 7) * 256 + (n & 127);
    if (MODE == 4) return (n >> 7) * 256 + 128 + (n & 127);
    return n;
}
constexpr int CVT_SCR = 16640;
template <int MODE> __device__ __forceinline__ void cvt_item(const float* W, int K, int N, const float* gain, bf16* WT, int ldt, LAS float* scr, int item, int lane, int kofs = 0) {
    const int nblk = N / 64, kb = item / nblk, nb = item % nblk, k0 = 64 * kb, n0 = 64 * nb;
    const int kq = lane >> 4, nc = (lane & 15) * 4;
    f32x4 v[16];
#pragma unroll
    for (int i = 0; i < 16; ++i) { const int k = k0 + 4 * i + kq - kofs; v[i] = (f32x4){0.f, 0.f, 0.f, 0.f};
        if (k >= 0 && k < K) { v[i] = *(const f32x4*)(W + (size_t)k * N + n0 + nc); if (gain) v[i] = v[i] * gain[k]; } }
#pragma unroll
    for (int i = 0; i < 16; ++i) { const int kk = 4 * i + kq;
#pragma unroll
        for (int c = 0; c < 4; ++c) scr[(nc + c) * 65 + kk] = v[i][c]; }
    LDS_WAIT(); asm volatile("" ::: "memory");
    const int kc = (lane & 7) * 8;
#pragma unroll
    for (int jj = 0; jj < 8; ++jj) { const int n = (lane >> 3) + 8 * jj; const LAS float* s = scr + n * 65 + kc;
        u32x4 o; o.x = cvt_pk_bf16(s[0], s[1]); o.y = cvt_pk_bf16(s[2], s[3]); o.z = cvt_pk_bf16(s[4], s[5]); o.w = cvt_pk_bf16(s[6], s[7]);
        *(u32x4*)(WT + (size_t)rowmap<MODE>(n0 + n) * ldt + k0 + kc) = o; }
    LDS_WAIT(); asm volatile("" ::: "memory");
}
#define CVT_JOB(MODE, src, K, N, gain, dst, ldt) { const int _n = (((K) + 63) / 64) * ((N) / 64); if (r < _n) { cvt_item<MODE>(src, K, N, gain, dst, ldt, scr, r, F.lane); continue; } r -= _n; }
#define CVT_JOB_PAD(src, K, N, dst, KPAD, KOFS) { const int _n = ((KPAD) / 64) * ((N) / 64); if (r < _n) { cvt_item<0>(src, K, N, nullptr, dst, KPAD, scr, r, F.lane, KOFS); continue; } r -= _n; }
struct CvtD { const float* W; const float* gain; bf16* WT; int K, N, ldt, mode, kofs, item; };
__device__ __forceinline__ int rowmap_rt(int mode, int n) { return mode == 1 ? rowmap<1>(n) : mode == 2 ? rowmap<2>(n) : mode == 3 ? rowmap<3>(n) : mode == 4 ? rowmap<4>(n) : n; }
__device__ __forceinline__ void cvt_load(const CvtD& d, int lane, f32x4 (&v)[16], float (&g)[16]) {
    const int nblk = d.N / 64, kb = d.item / nblk, nb = d.item % nblk, k0 = 64 * kb, n0 = 64 * nb; const int kq = lane >> 4, nc = (lane & 15) * 4;
#pragma unroll
    for (int i = 0; i < 16; ++i) { const int k = k0 + 4 * i + kq - d.kofs; v[i] = (f32x4){0.f, 0.f, 0.f, 0.f}; g[i] = 1.f;
        if (k >= 0 && k < d.K) { v[i] = *(const f32x4*)(d.W + (size_t)k * d.N + n0 + nc); if (d.gain) g[i] = d.gain[k]; } }
}
__device__ __forceinline__ void cvt_process(const CvtD& d, int lane, f32x4 (&v)[16], float (&g)[16], LAS float* scr) {
    const int nblk = d.N / 64, kb = d.item / nblk, nb = d.item % nblk, k0 = 64 * kb, n0 = 64 * nb; const int kq = lane >> 4, nc = (lane & 15) * 4;
#pragma unroll
    for (int i = 0; i < 16; ++i) { const int kk = 4 * i + kq;
#pragma unroll
        for (int c = 0; c < 4; ++c) scr[(nc + c) * 65 + kk] = v[i][c] * g[i]; }
    LDS_WAIT(); asm volatile("" ::: "memory");
    const int kc = (lane & 7) * 8;
#pragma unroll
    for (int jj = 0; jj < 8; ++jj) { const int n = (lane >> 3) + 8 * jj; const LAS float* s = scr + n * 65 + kc;
        u32x4 o; o.x = cvt_pk_bf16(s[0], s[1]); o.y = cvt_pk_bf16(s[2], s[3]); o.z = cvt_pk_bf16(s[4], s[5]); o.w = cvt_pk_bf16(s[6], s[7]);
        *(u32x4*)(d.WT + (size_t)rowmap_rt(d.mode, n0 + n) * d.ldt + k0 + kc) = o; }
    LDS_WAIT(); asm volatile("" ::: "memory");
}
#define CVT_PIPE(TOTAL_, DESC_) do { CvtD dA, dB; f32x4 vA[16], vB[16]; float gA[16], gB[16]; int it = gw; \
        if (it < (TOTAL_)) { DESC_(it, dA); cvt_load(dA, F.lane, vA, gA); } \
        for (; it < (TOTAL_); it += 2 * NGW) { const int itn = it + NGW, itn2 = it + 2 * NGW; \
            if (itn < (TOTAL_)) { DESC_(itn, dB); cvt_load(dB, F.lane, vB, gB); } \
            cvt_process(dA, F.lane, vA, gA, scr); \
            if (itn2 < (TOTAL_)) { DESC_(itn2, dA); cvt_load(dA, F.lane, vA, gA); } \
            if (itn < (TOTAL_)) cvt_process(dB, F.lane, vB, gB, scr); } } while (0)

__device__ __forceinline__ void p0_prologue(Frame& F) {
    LAS float* scr = (LAS float*)(F.lds + F.wave * CVT_SCR);
    const int gw = F.vcu * 8 + F.wave, NGW = F.G * 8;
    unsigned char* ws = F.ws;
    constexpr int TOTAL = 32 * (IN_W / 64) + 8 * 48 + 4 * 64 + 4 * (4 * 32) + 4 * 32 + 3 * (32 * 32) + 32 * 8 + 32 * 16 + 8 * 32;
#define P0_SETD(d, mode_, src_, K_, N_, gain_, dst_, ldt_, KPAD_, KOFS_) { const int _n = ((KPAD_) / 64) * ((N_) / 64); if (r < _n) { d.W = src_; d.gain = gain_; d.WT = dst_; d.K = K_; d.N = N_; d.ldt = ldt_; d.mode = mode_; d.kofs = KOFS_; d.item = r; break; } r -= _n; }
#define P0_DESC(it_, d) do { int r = (it_); \
        P0_SETD(d, 1, F.in[I_WIN], DM, IN_W, F.in[I_GMIX], (bf16*)(ws + WS_WIN), DM, DM, 0) \
        P0_SETD(d, 2, F.in[I_WUQ], QLORA, MH * QKD, F.in[I_GQ], (bf16*)(ws + WS_WUQ), QLORA, QLORA, 0) \
        P0_SETD(d, 0, F.in[I_WUKV], KVLORA, MH * 256, F.in[I_GKV], (bf16*)(ws + WS_WUKV), KVLORA, KVLORA, 0) \
        P0_SETD(d, 0, F.in[I_W2F], DLORA, RW, nullptr, (bf16*)(ws + WS_W2F), 256, 256, 0) \
        P0_SETD(d, 0, F.in[I_W2B], DLORA, RW, nullptr, (bf16*)(ws + WS_W2F + 1 * MiB), 256, 256, 128) \
        P0_SETD(d, 0, F.in[I_A2F], DLORA, RW, nullptr, (bf16*)(ws + WS_W2F + 2 * MiB), 256, 256, 0) \
        P0_SETD(d, 0, F.in[I_A2B], DLORA, RW, nullptr, (bf16*)(ws + WS_W2F + 3 * MiB), 256, 256, 128) \
        P0_SETD(d, 0, F.in[I_G2], GLORA, RW, nullptr, (bf16*)(ws + WS_G2), GLORA, GLORA, 0) \
        P0_SETD(d, 0, F.in[I_WUPM], DM, DM, nullptr, (bf16*)(ws + WS_WUPM), DM, DM, 0) \
        P0_SETD(d, 0, F.in[I_WUPR], DM, DM, nullptr, (bf16*)(ws + WS_WUPR), DM, DM, 0) \
        P0_SETD(d, 0, F.in[I_WOUT], DM, DM, nullptr, (bf16*)(ws + WS_WOUT), DM, DM, 0) \
        P0_SETD(d, 0, F.in[I_WQC], DM, CW, F.in[I_GCROSS], (bf16*)(ws + WS_WQC), DM, DM, 0) \
        P0_SETD(d, 0, F.in[I_WKVC], DM, 2 * CW, nullptr, (bf16*)(ws + WS_WKVC), DM, DM, 0) \
        P0_SETD(d, 0, F.in[I_WOC], CW, DM, nullptr, (bf16*)(ws + WS_WOC), CW, CW, 0) \
    } while (0)
    CVT_PIPE(TOTAL, P0_DESC);
#undef P0_SETD
#undef P0_DESC
    const float* x = F.in[I_X]; bf16* xb = (bf16*)(ws + WS_XB); float* rstd1 = (float*)(ws + WS_RSTD);
    for (int m = gw; m < MT + NB * MEMLEN; m += NGW) {
        const bool ismem = m >= MT; const int mm = ismem ? m - MT : m;
        const f32x4* xr = (const f32x4*)((ismem ? F.in[I_MEM] : x) + (size_t)mm * DM) + F.lane;
        f32x4 v[8]; float s = 0.f;
#pragma unroll
        for (int j = 0; j < 8; ++j) { v[j] = xr[64 * j]; s += (v[j].x * v[j].x + v[j].y * v[j].y) + (v[j].z * v[j].z + v[j].w * v[j].w); }
        const float rs = 1.0f / sqrtf(wave_sum(s) * (1.f / DM) + RMS_EPS);
        if (!ismem) { if (F.lane == 0) rstd1[mm] = rs;
            u32x2* o8 = (u32x2*)(xb + (size_t)mm * DM) + F.lane;
#pragma unroll
            for (int j = 0; j < 8; ++j) { u32x2 w; w.x = cvt_pk_bf16(v[j].x, v[j].y); w.y = cvt_pk_bf16(v[j].z, v[j].w); o8[64 * j] = w; }
        } else { const f32x4* gr = (const f32x4*)F.in[I_GMEM] + F.lane;
            u32x2* o8 = (u32x2*)((bf16*)(ws + WS_MEMN) + (size_t)mm * DM) + F.lane;
#pragma unroll
            for (int j = 0; j < 8; ++j) { const f32x4 g = gr[64 * j]; u32x2 w; w.x = cvt_pk_bf16(v[j].x * rs * g.x, v[j].y * rs * g.y); w.y = cvt_pk_bf16(v[j].z * rs * g.z, v[j].w * rs * g.w); o8[64 * j] = w; }
        }
    }
    const int gt = F.vcu * 512 + F.tid, NGT = F.G * 512;
    { const int* pos = (const int*)F.in[I_POS]; f32x2* cs = (f32x2*)(ws + WS_ROPE);
      for (int i = gt; i < MT * 32; i += NGT) { const int t = i >> 5, f = i & 31;
          const float inv = exp2f(-(float)f * (13.287712379549449f / 32.0f));
          const float ang = (float)pos[t] * inv;
          const double a = (double)ang; const double k = rint(a * 0.15915494309189535); const float red = (float)(a - k * 6.283185307179586);
          cs[i] = (f32x2){cosf(red), sinf(red)}; } }
    { float* WR = (float*)(ws + WS_WR); const float* gf = F.in[I_GFFN];
      for (int i = gt; i < DM * 36; i += NGT) { const int k = i / 36, c = i % 36; float w;
          if (c < 4) w = F.in[I_WRG][k * 4 + c]; else { const int gi = (c - 4) >> 3, e = (c - 4) & 7; w = F.in[I_WRE][((size_t)gi * DM + k) * 8 + e]; }
          WR[i] = w * gf[k]; } }
}

__device__ __forceinline__ void p_final(Frame& F, bool with_moe) {
    const int gw = F.vcu * 8 + F.wave, NGW = F.G * 8;
    const f32x4* gr = (const f32x4*)F.in[I_GFINAL] + F.lane;
    const int* route = (const int*)(F.ws + WS_ROUTE); const bf16* ybuf = (const bf16*)(F.ws + WS_YBUF);
    const int* cnts = (const int*)(F.ctl + CW_CNT);
    for (int m = gw; m < MT; m += NGW) {
        f32x4* xr = (f32x4*)(F.out + (size_t)m * DM) + F.lane;
        f32x4 v[8];
#pragma unroll
        for (int j = 0; j < 8; ++j) v[j] = xr[64 * j];
        if (with_moe) {
#pragma unroll
            for (int kx = 0; kx < 2; ++kx) { const int e = route[m * 8 + 2 * kx], pos = route[m * 8 + 2 * kx + 1];
                int base = 0; for (int q = 0; q < e; ++q) base += (cnts[64 * q] + 255) & ~255;
                const u32x2* yr = (const u32x2*)(ybuf + (size_t)(base + pos) * DM) + F.lane;
#pragma unroll
                for (int j = 0; j < 8; ++j) { const u32x2 w = yr[64 * j]; v[j].x += bflo(w.x); v[j].y += bfhi(w.x); v[j].z += bflo(w.y); v[j].w += bfhi(w.y); } }
        }
        float s = 0.f;
#pragma unroll
        for (int j = 0; j < 8; ++j) s += (v[j].x * v[j].x + v[j].y * v[j].y) + (v[j].z * v[j].z + v[j].w * v[j].w);
        const float rs = 1.0f / sqrtf(wave_sum(s) * (1.f / DM) + RMS_EPS);
#pragma unroll
        for (int j = 0; j < 8; ++j) { const f32x4 g = gr[64 * j]; xr[64 * j] = (f32x4){v[j].x * rs * g.x, v[j].y * rs * g.y, v[j].z * rs * g.z, v[j].w * rs * g.w}; }
    }
}
__device__ __forceinline__ void p_copy_x(Frame& F) {
    const int gt = F.vcu * 512 + F.tid, NGT = F.G * 512; const f32x4* s = (const f32x4*)F.in[I_X]; f32x4* d = (f32x4*)F.out;
    for (int i = gt; i < MT * DM / 4; i += NGT) d[i] = s[i];
}

__device__ __forceinline__ void p2_rowpass(Frame& F) {
    const int gw = F.vcu * 8 + F.wave, NGW = F.G * 8, l = F.lane;
    unsigned char* ws = F.ws;
    const bf16* zm = (const bf16*)(ws + WS_ZMLA); const bf16* zl = (const bf16*)(ws + WS_ZLORA); bf16* la = (bf16*)(ws + WS_LORAA);
    float* rstd_q = (float*)(ws + WS_RSTD) + MT; float* rstd_kv = (float*)(ws + WS_RSTD) + 2 * MT;
    const f32x2* cs = (const f32x2*)(ws + WS_ROPE); bf16* Kb = (bf16*)(ws + WS_K);
    const float* sh = F.in[I_SHIFT] + 6144;
    f32x2 s0[5], s1[5], s2[5];
#pragma unroll
    for (int i = 0; i < 5; ++i) { const int j = 2 * l + 128 * i; s0[i] = *(const f32x2*)(sh + j); s1[i] = *(const f32x2*)(sh + RWKV_IN + j); s2[i] = *(const f32x2*)(sh + 2 * RWKV_IN + j); }
    for (int t = gw; t < MT; t += NGW) {
        const bf16* zr = zm + (size_t)t * ZM_LD;
        { const u32x4 w = *((const u32x4*)zr + l); float s = 0.f;
          s += bflo(w.x) * bflo(w.x) + bfhi(w.x) * bfhi(w.x) + bflo(w.y) * bflo(w.y) + bfhi(w.y) * bfhi(w.y) + bflo(w.z) * bflo(w.z) + bfhi(w.z) * bfhi(w.z) + bflo(w.w) * bflo(w.w) + bfhi(w.w) * bfhi(w.w);
          s = wave_sum(s); if (l == 0) rstd_q[t] = 1.0f / sqrtf(s * (1.f / QLORA) + RMS_EPS); }
        { const u32x2 w = *((const u32x2*)(zr + QLORA) + l); float s = bflo(w.x) * bflo(w.x) + bfhi(w.x) * bfhi(w.x) + bflo(w.y) * bflo(w.y) + bfhi(w.y) * bfhi(w.y);
          s = wave_sum(s); if (l == 0) rstd_kv[t] = 1.0f / sqrtf(s * (1.f / KVLORA) + RMS_EPS); }
        { const int i = l & 31, hs = l >> 5; const unsigned w = *((const unsigned*)(zr + 768) + i); const float x1 = bflo(w), x2 = bfhi(w); const f32x2 c = cs[(size_t)t * 32 + i];
          const unsigned o = cvt_pk_bf16(x1 * c.x - x2 * c.y, x2 * c.x + x1 * c.y);
#pragma unroll
          for (int hh = 0; hh < 8; ++hh) *((unsigned*)(Kb + (size_t)t * (MH * QKD) + (hs * 8 + hh) * QKD + NOPE) + i) = o; }
        const int s = t % SEQ; const float fp = s > 0 ? 1.f : 0.f, fn = s < SEQ - 1 ? 1.f : 0.f;
        const bf16* z0 = zl + (size_t)t * ZL_LD; const bf16* zp = s > 0 ? z0 - ZL_LD : z0; const bf16* zn = s < SEQ - 1 ? z0 + ZL_LD : z0;
        bf16* lr = la + (size_t)t * LA_LD;
#pragma unroll
        for (int i = 0; i < 5; ++i) { const int j = 2 * l + 128 * i;
            const unsigned wp = *(const unsigned*)(zp + j), w0 = *(const unsigned*)(z0 + j), wn = *(const unsigned*)(zn + j);
            float va = s0[i].x * fp * bflo(wp) + s1[i].x * bflo(w0) + s2[i].x * fn * bflo(wn);
            float vb = s0[i].y * fp * bfhi(wp) + s1[i].y * bfhi(w0) + s2[i].y * fn * bfhi(wn);
            int dst;
            if (j < 192) { va = tanhf(va); vb = tanhf(vb); dst = (j / 96) * 128 + (j % 96); } else if (j < 384) { dst = (j / 96) * 128 + (j % 96); } else { va = sigmoidf_(va); vb = sigmoidf_(vb); dst = 512 + (j - 384); }
            *(unsigned*)(lr + dst) = cvt_pk_bf16(va, vb); }
        { const int p = 2 * l; *(unsigned*)(lr + (p >> 5) * 128 + 96 + (p & 31)) = 0u; }
    }
}

namespace scan {
constexpr int TC = 16, DATA_B = TC * 6 * 64 * 4, BUF_B = DATA_B + 64 + TC * 32 * 4;
template <int CTRL> __device__ __forceinline__ float dpp_add(float v) {
    return v + __builtin_bit_cast(float, __builtin_amdgcn_update_dpp(0, __builtin_bit_cast(int, v), CTRL, 0xF, 0xF, false));
}
__device__ __forceinline__ float red16(float v) { v = dpp_add<0xB1>(v); v = dpp_add<0x4E>(v); v = dpp_add<0x141>(v); v = dpp_add<0x140>(v); return v; }
struct Raw { unsigned short r[3], k[3], v[3], wl, ic; };
template <int VAR> __device__ __forceinline__ void scan_unit(Frame& F, const int b, const int h, const int dir, const int half) {
    unsigned char* ws = F.ws; const int l = F.lane, w = F.wave, tid = F.tid;
    const bf16* zr = (const bf16*)(ws + WS_ZRKV) + (size_t)b * SEQ * ZR_LD + h * 64 + l;
    const bf16* wlp = (const bf16*)(ws + (dir ? WS_WLB : WS_WLF)) + (size_t)b * SEQ * RW + h * 64 + l;
    const bf16* icp = (const bf16*)(ws + (dir ? WS_ICB : WS_ICF)) + (size_t)b * SEQ * RW + h * 64 + l;
    bf16* yout = (bf16*)(ws + (dir ? WS_YB : WS_YF)) + (size_t)b * SEQ * RW + h * 64 + half * 32;
    const int ch = h * 64 + l; const float* sh = F.in[I_SHIFT];
    const float sr0 = sh[ch], sr1 = sh[RWKV_IN + ch], sr2 = sh[2 * RWKV_IN + ch];
    const float sk0 = sh[2048 + ch], sk1 = sh[RWKV_IN + 2048 + ch], sk2 = sh[2 * RWKV_IN + 2048 + ch];
    const float sv0 = sh[4096 + ch], sv1 = sh[RWKV_IN + 4096 + ch], sv2 = sh[2 * RWKV_IN + 4096 + ch];
    const float kk_c = F.in[I_KK][ch], ka_c = F.in[I_KA][ch], rk_c = F.in[I_RK][ch];
    LAS unsigned char* L = F.lds;
    Raw raw[2];
#define SC_TOK(ci, i) (dir ? (SEQ - 1 - ((ci) * TC + (i))) : ((ci) * TC + (i)))
#define SC_LOAD(ci) do { _Pragma("unroll") for (int q = 0; q < 2; ++q) { const int s = SC_TOK(ci, 2 * w + q); const int sp = s > 0 ? s - 1 : s, sn = s < SEQ - 1 ? s + 1 : s; \
        const bf16* z0 = zr + (size_t)s * ZR_LD; const bf16* zp = zr + (size_t)sp * ZR_LD; const bf16* zn = zr + (size_t)sn * ZR_LD; \
        raw[q].r[0] = zp[0]; raw[q].r[1] = z0[0]; raw[q].r[2] = zn[0]; raw[q].k[0] = zp[2048]; raw[q].k[1] = z0[2048]; raw[q].k[2] = zn[2048]; \
        raw[q].v[0] = zp[4096]; raw[q].v[1] = z0[4096]; raw[q].v[2] = zn[4096]; raw[q].wl = wlp[(size_t)s * RW]; raw[q].ic = icp[(size_t)s * RW]; } } while (0)
#define SC_PREP(ci, bufi) do { _Pragma("unroll") for (int q = 0; q < 2; ++q) { const int i = 2 * w + q; const int s = SC_TOK(ci, i); const float fp = s > 0 ? 1.f : 0.f, fn = s < SEQ - 1 ? 1.f : 0.f; \
        const float r_s = sr0 * fp * bf2f(raw[q].r[0]) + sr1 * bf2f(raw[q].r[1]) + sr2 * fn * bf2f(raw[q].r[2]); \
        const float k_s = sk0 * fp * bf2f(raw[q].k[0]) + sk1 * bf2f(raw[q].k[1]) + sk2 * fn * bf2f(raw[q].k[2]); \
        const float v_s = sv0 * fp * bf2f(raw[q].v[0]) + sv1 * bf2f(raw[q].v[1]) + sv2 * fn * bf2f(raw[q].v[2]); \
        const float kkr = k_s * kk_c; const float ss = wave_sum(kkr * kkr); const float kk = kkr * (1.0f / sqrtf(ss + 1e-12f)); \
        const float icv = bf2f(raw[q].ic); const float kd = k_s * (1.0f + (icv - 1.0f) * ka_c); const float bb = kk * icv; const float wd = __builtin_amdgcn_exp2f(bf2f(raw[q].wl)); \
        const float bon = wave_sum(r_s * kd * rk_c); \
        LAS float* d = (LAS float*)(L + (bufi) * BUF_B) + i * 384 + l; d[0] = wd; d[64] = kk; d[128] = bb; d[192] = kd; d[256] = r_s; d[320] = v_s; \
        if (l == 0) ((LAS float*)(L + (bufi) * BUF_B + DATA_B))[i] = bon; } } while (0)
    const int g = l >> 4, j = l & 15, row = half * 32 + w * 4 + g;
    f32x2 Sa = {0.f, 0.f}, Sb = {0.f, 0.f};
    struct Ops { f32x4 w, a, b, k, r; float v, bon; };
#define SC_LD(O, i) do { O.w = p4[(i) * 96 + j]; O.a = p4[(i) * 96 + 16 + j]; O.b = p4[(i) * 96 + 32 + j]; O.k = p4[(i) * 96 + 48 + j]; O.r = p4[(i) * 96 + 64 + j]; \
        O.v = pf[(i) * 384 + 320 + row]; O.bon = pb[i]; } while (0)
#define SC_STEP(O, YP) do { f32x2 t = Sa * O.a.xy; t = Sb * O.a.zw + t; float sa = red16(t.x + t.y); \
        const f32x2 nsa = {-sa, -sa}; const f32x2 vv2 = {O.v, O.v}; \
        const f32x2 u0 = nsa * O.b.xy + vv2 * O.k.xy, u1 = nsa * O.b.zw + vv2 * O.k.zw; \
        Sa = Sa * O.w.xy + u0; Sb = Sb * O.w.zw + u1; \
        f32x2 ty = Sa * O.r.xy; ty = Sb * O.r.zw + ty; YP = ty.x + ty.y; } while (0)
    SC_LOAD(0); SC_PREP(0, 0); __syncthreads();
    constexpr int NCH = SEQ / TC;
    for (int ci = 0; ci < NCH; ++ci) {
        const int bi = ci & 1;
        if (VAR != 2 && ci + 1 < NCH) SC_LOAD(ci + 1);
        const LAS f32x4* p4 = (const LAS f32x4*)(L + bi * BUF_B); const LAS float* pf = (const LAS float*)(L + bi * BUF_B);
        const LAS float* pb = (const LAS float*)(L + bi * BUF_B + DATA_B);
        float ykeep = 0.f;
        Ops oA, oB; SC_LD(oA, 0);
        if (VAR != 1) {
#pragma unroll
        for (int i = 0; i < TC; i += 4) {
            float y0, y1, y2, y3; float v0, v1, v2, v3, b0, b1, b2, b3;
            SC_LD(oB, i + 1); v0 = oA.v; b0 = oA.bon; SC_STEP(oA, y0);
            SC_LD(oA, i + 2); v1 = oB.v; b1 = oB.bon; SC_STEP(oB, y1);
            SC_LD(oB, i + 3); v2 = oA.v; b2 = oA.bon; SC_STEP(oA, y2);
            if (i + 4 < TC) SC_LD(oA, i + 4);
            v3 = oB.v; b3 = oB.bon; SC_STEP(oB, y3);
            y0 = red16(y0); y1 = red16(y1); y2 = red16(y2); y3 = red16(y3);
            y0 += b0 * v0; y1 += b1 * v1; y2 += b2 * v2; y3 += b3 * v3;
            ykeep = (j == i) ? y0 : ykeep; ykeep = (j == i + 1) ? y1 : ykeep; ykeep = (j == i + 2) ? y2 : ykeep; ykeep = (j == i + 3) ? y3 : ykeep;
        }
        }
        ((LAS float*)(L + bi * BUF_B + DATA_B + 64))[j * 32 + w * 4 + g] = ykeep;
        if (VAR != 2 && ci + 1 < NCH) SC_PREP(ci + 1, bi ^ 1);
        __syncthreads();
        { const int st = tid >> 5, rw_ = tid & 31; const int s = SC_TOK(ci, st);
          const unsigned short yv = f2bf(((const LAS float*)(L + bi * BUF_B + DATA_B + 64))[st * 32 + rw_]);
          if (VAR == 0) yout[(size_t)s * RW + rw_] = yv; else asm volatile("" :: "v"(yv)); }
    }
    __syncthreads();
#undef SC_TOK
#undef SC_LOAD
#undef SC_PREP
#undef SC_LD
#undef SC_STEP
}
}

namespace scan2 {
constexpr int TC = 16, NS = 6, NPREP = 6, NREC = 2;
constexpr int ROWB = 144;
constexpr int P_ACAT = 0, P_BHAT = 4608, P_KHAT = 6656, P_VT = 8704, P_NCAT = 10752, P_MRF = 11776, P_PC = 12800, P_GINIT = 13056  , PKG_B = 15104;
constexpr int S_L1 = 0, S_L2 = 4608, S_MF = 9216, S_NF = 10240, SCR_B = 11264;
constexpr int OFF_PKG = 0, OFF_SCR = NS * PKG_B, OFF_FLAG = OFF_SCR + NPREP * SCR_B, TOTAL_B = OFF_FLAG + 64;
static_assert(TOTAL_B <= 156 * 1024, "scan2 LDS");
__device__ __forceinline__ int crow(int r, int hi) { return (r & 3) + 8 * (r >> 2) + 4 * hi; }
__device__ __forceinline__ void lds_st16(LAS unsigned char* p, float v) { *(LAS unsigned short*)p = f2bf(v); }
__device__ __forceinline__ bf16x8 pack_acc8(const f32x16& x, int base) {
    u32x4 w = {cvt_pk_bf16(x[base + 0], x[base + 1]), cvt_pk_bf16(x[base + 2], x[base + 3]), cvt_pk_bf16(x[base + 4], x[base + 5]), cvt_pk_bf16(x[base + 6], x[base + 7])};
    return *reinterpret_cast<bf16x8*>(&w);
}
__device__ __forceinline__ float wave_sum_b(float v) {
    v = scan::red16(v);
    v += __builtin_bit_cast(float, __builtin_amdgcn_update_dpp(0, __builtin_bit_cast(int, v), 0x142, 0xA, 0xF, false));
    v += __builtin_bit_cast(float, __builtin_amdgcn_update_dpp(0, __builtin_bit_cast(int, v), 0x143, 0xC, 0xF, false));
    return __builtin_bit_cast(float, __builtin_amdgcn_readlane(__builtin_bit_cast(int, v), 63));
}
__device__ __forceinline__ void spin_ge(volatile LAS int* p, int want) { while (*p < want) __builtin_amdgcn_s_sleep(1); }

template <int dir> __device__ __forceinline__ void scan_unit(Frame& F, const int b, const int h) {
    unsigned char* ws = F.ws; const int l = F.lane, w = F.wave;
    LAS unsigned char* L = F.lds;
    volatile LAS int* ready = (volatile LAS int*)(L + OFF_FLAG);
    volatile LAS int* consumed = ready + NS;
    if (F.tid < 16) ready[F.tid] = 0;
    __syncthreads();
    constexpr int NCH = SEQ / TC;
    if (w < NREC) {
        const int half = w; const int v = l & 31, hi = l >> 5, vg = 32 * half + v;
        __builtin_amdgcn_s_setprio(3);
        f32x16 X0 = {}, X1 = {}; unsigned long long rec_acc = 0ull;
        bf16* yout = (bf16*)(ws + (dir ? WS_YB : WS_YF)) + (size_t)b * SEQ * RW + h * 64 + half * 32 + v;
        for (int ci = 0; ci < NCH; ++ci) {
            const int slot = ci % NS; const LAS unsigned char* P = L + OFF_PKG + slot * PKG_B;
            const unsigned long long tr0 = (SCAN_SEC == 9) ? __builtin_amdgcn_s_memtime() : 0ull;
            spin_ge(ready + slot, ci + 1);
            if (SCAN_SEC == 9) rec_acc += __builtin_amdgcn_s_memtime() - tr0;
            const bf16x8 a00 = *(const LAS bf16x8*)(P + P_ACAT + v * ROWB + (0 + hi) * 16), a01 = *(const LAS bf16x8*)(P + P_ACAT + v * ROWB + (2 + hi) * 16);
            const bf16x8 a10 = *(const LAS bf16x8*)(P + P_ACAT + v * ROWB + (4 + hi) * 16), a11 = *(const LAS bf16x8*)(P + P_ACAT + v * ROWB + (6 + hi) * 16);
            const bf16x8 ncat = *(const LAS bf16x8*)(P + P_NCAT + v * 32 + hi * 16), vt = *(const LAS bf16x8*)(P + P_VT + vg * 32 + hi * 16);
            const bf16x8 mrf = *(const LAS bf16x8*)(P + P_MRF + l * 16);
            const bf16x8 bh0 = *(const LAS bf16x8*)(P + P_BHAT + v * 32 + hi * 16), bh1 = *(const LAS bf16x8*)(P + P_BHAT + (32 + v) * 32 + hi * 16);
            const bf16x8 kh0 = *(const LAS bf16x8*)(P + P_KHAT + v * 32 + hi * 16), kh1 = *(const LAS bf16x8*)(P + P_KHAT + (32 + v) * 32 + hi * 16);
            f32x16 G;
            { const u32x2 q0 = *(const LAS u32x2*)(P + P_GINIT + vg * 32 + hi * 8), q1 = *(const LAS u32x2*)(P + P_GINIT + vg * 32 + 16 + hi * 8);
              const f32x4 g0 = {bflo(q0.x), bfhi(q0.x), bflo(q0.y), bfhi(q0.y)}, g1 = {bflo(q1.x), bfhi(q1.x), bflo(q1.y), bfhi(q1.y)};
#pragma unroll
              for (int r = 0; r < 8; ++r) G[r] = 0.f;
#pragma unroll
              for (int r = 0; r < 4; ++r) { G[8 + r] = g0[r]; G[12 + r] = g1[r]; } }
            f32x4 pc[8];
#pragma unroll
            for (int q = 0; q < 8; ++q) pc[q] = *(const LAS f32x4*)(P + P_PC + (32 * (q >> 2) + 8 * (q & 3) + 4 * hi) * 4);
            const bf16x8 s00 = pack_acc8(X0, 0), s01 = pack_acc8(X0, 8), s10 = pack_acc8(X1, 0), s11 = pack_acc8(X1, 8);
            G = __builtin_amdgcn_mfma_f32_32x32x16_bf16(a00, s00, G, 0, 0, 0);
            G = __builtin_amdgcn_mfma_f32_32x32x16_bf16(a01, s01, G, 0, 0, 0);
            G = __builtin_amdgcn_mfma_f32_32x32x16_bf16(a10, s10, G, 0, 0, 0);
            G = __builtin_amdgcn_mfma_f32_32x32x16_bf16(a11, s11, G, 0, 0, 0);
            G = __builtin_amdgcn_mfma_f32_32x32x16_bf16(ncat, vt, G, 0, 0, 0);
            const bf16x8 uf = pack_acc8(G, 0);
#pragma unroll
            for (int r = 0; r < 16; ++r) { X0[r] *= pc[r >> 2][r & 3]; X1[r] *= pc[4 + (r >> 2)][r & 3]; }
            X0 = __builtin_amdgcn_mfma_f32_32x32x16_bf16(bh0, uf, X0, 0, 0, 0);
            X1 = __builtin_amdgcn_mfma_f32_32x32x16_bf16(bh1, uf, X1, 0, 0, 0);
            X0 = __builtin_amdgcn_mfma_f32_32x32x16_bf16(kh0, vt, X0, 0, 0, 0);
            X1 = __builtin_amdgcn_mfma_f32_32x32x16_bf16(kh1, vt, X1, 0, 0, 0);
            G = __builtin_amdgcn_mfma_f32_32x32x16_bf16(mrf, uf, G, 0, 0, 0);
            LDS_WAIT();
            if (l == 0) consumed[half] = ci + 1;
#pragma unroll
            for (int q = 0; q < 8; ++q) { const int t = crow(q, hi); const int s = dir ? (SEQ - 1 - (ci * TC + t)) : (ci * TC + t);
                yout[(size_t)s * RW] = f2bf(G[8 + q]); }
        }
        __builtin_amdgcn_s_setprio(0);
        if (SCAN_SEC == 9 && blockIdx.x == 0 && w == 0 && l == 0) { F.MISC[120] = (unsigned)rec_acc; F.MISC[121] = (unsigned)(rec_acc >> 32); }
    } else {
        const int pw = w - NREC; LAS unsigned char* SC = L + OFF_SCR + pw * SCR_B;
        const __amdgpu_buffer_rsrc_t rsZ = __builtin_amdgcn_make_buffer_rsrc((void*)(ws + WS_ZRKV + ((size_t)b * SEQ * ZR_LD + h * 64) * 2), (short)0, (int)(SEQ * ZR_LD * 2), 0x00020000);
        const __amdgpu_buffer_rsrc_t rsW = __builtin_amdgcn_make_buffer_rsrc((void*)(ws + (dir ? WS_WLB : WS_WLF) + ((size_t)b * SEQ * RW + h * 64) * 2), (short)0, (int)(SEQ * RW * 2), 0x00020000);
        const __amdgpu_buffer_rsrc_t rsI = __builtin_amdgcn_make_buffer_rsrc((void*)(ws + (dir ? WS_ICB : WS_ICF) + ((size_t)b * SEQ * RW + h * 64) * 2), (short)0, (int)(SEQ * RW * 2), 0x00020000);
        const unsigned vl2 = (unsigned)l * 2u;
        const int ch = h * 64 + l; const float* sh = F.in[I_SHIFT];
        const float sr0 = sh[ch], sr1 = sh[RWKV_IN + ch], sr2 = sh[2 * RWKV_IN + ch];
        const float sk0 = sh[2048 + ch], sk1 = sh[RWKV_IN + 2048 + ch], sk2 = sh[2 * RWKV_IN + 2048 + ch];
        const float sv0 = sh[4096 + ch], sv1 = sh[RWKV_IN + 4096 + ch], sv2 = sh[2 * RWKV_IN + 4096 + ch];
        const float kk_c = F.in[I_KK][ch], ka_c = F.in[I_KA][ch], rk_c = F.in[I_RK][ch];
        const int posk = (((l >> 5) * 2 + ((l >> 4) & 1)) * 2 + ((l >> 2) & 1)) * 8 + ((l >> 3) & 1) * 4 + (l & 3);
        unsigned long long sec_acc = 0ull;
#define S2_T() ((SCAN_SEC >= 0) ? __builtin_amdgcn_s_memtime() : 0ull)
        for (int ci = pw; ci < NCH; ci += NPREP) {
            const int slot = ci % NS; LAS unsigned char* P = L + OFF_PKG + slot * PKG_B;
            const unsigned long long ts0 = S2_T();
            const int s_lo = dir ? (SEQ - TC - ci * TC) : ci * TC;
            float rr[18], rk[18], rv[18], wl[16], ic[16];
            { unsigned short ur[18], uk[18], uv[18], uw[16], ui[16];
#pragma unroll
              for (int tau = 0; tau < 18; ++tau) { const int s = s_lo - 1 + tau; const int sc = (tau == 0 && s < 0) ? s_lo : (tau == 17 && s >= SEQ) ? s_lo : s;
                  const unsigned so = (unsigned)sc * (unsigned)(ZR_LD * 2);
                  ur[tau] = __builtin_amdgcn_raw_buffer_load_b16(rsZ, vl2, so, 0); uk[tau] = __builtin_amdgcn_raw_buffer_load_b16(rsZ, vl2, so + 4096u, 0); uv[tau] = __builtin_amdgcn_raw_buffer_load_b16(rsZ, vl2, so + 8192u, 0); }
#pragma unroll
              for (int i = 0; i < 16; ++i) { const int s = dir ? (s_lo + 15 - i) : (s_lo + i); const unsigned so = (unsigned)s * (unsigned)(RW * 2);
                  uw[i] = __builtin_amdgcn_raw_buffer_load_b16(rsW, vl2, so, 0); ui[i] = __builtin_amdgcn_raw_buffer_load_b16(rsI, vl2, so, 0); }
              __builtin_amdgcn_sched_barrier(0);
#pragma unroll
              for (int tau = 0; tau < 18; ++tau) { rr[tau] = bf2f(ur[tau]); rk[tau] = bf2f(uk[tau]); rv[tau] = bf2f(uv[tau]); }
              { const float f0 = (s_lo - 1 >= 0) ? 1.f : 0.f, f17 = (s_lo + 16 < SEQ) ? 1.f : 0.f;
                rr[0] *= f0; rk[0] *= f0; rv[0] *= f0; rr[17] *= f17; rk[17] *= f17; rv[17] *= f17; }
#pragma unroll
              for (int i = 0; i < 16; ++i) { wl[i] = bf2f(uw[i]); ic[i] = bf2f(ui[i]); } }
            float cum[16];
            cum[0] = wl[0];
#pragma unroll
            for (int i = 1; i < 16; ++i) cum[i] = cum[i - 1] + wl[i];
            const unsigned long long tsA = S2_T();
            float rs_[16], ks_[16], vs_[16], q1[16], q2[16];
#pragma unroll
            for (int i = 0; i < 16; ++i) { const int tau = dir ? (16 - i) : (i + 1);
                rs_[i] = sr0 * rr[tau - 1] + sr1 * rr[tau] + sr2 * rr[tau + 1];
                ks_[i] = sk0 * rk[tau - 1] + sk1 * rk[tau] + sk2 * rk[tau + 1];
                vs_[i] = sv0 * rv[tau - 1] + sv1 * rv[tau] + sv2 * rv[tau + 1];
                const float kkr = ks_[i] * kk_c; q1[i] = kkr * kkr; q2[i] = rs_[i] * (ks_[i] * (1.0f + (ic[i] - 1.0f) * ka_c)) * rk_c; }
#define S2_DPPSTEP(CTRL, RM) do { _Pragma("unroll") for (int i = 0; i < 16; ++i) { \
                q1[i] += __builtin_bit_cast(float, __builtin_amdgcn_update_dpp(0, __builtin_bit_cast(int, q1[i]), CTRL, RM, 0xF, false)); \
                q2[i] += __builtin_bit_cast(float, __builtin_amdgcn_update_dpp(0, __builtin_bit_cast(int, q2[i]), CTRL, RM, 0xF, false)); } } while (0)
            S2_DPPSTEP(0xB1, 0xF); S2_DPPSTEP(0x4E, 0xF); S2_DPPSTEP(0x141, 0xF); S2_DPPSTEP(0x140, 0xF); S2_DPPSTEP(0x142, 0xA); S2_DPPSTEP(0x143, 0xC);
#undef S2_DPPSTEP
            const unsigned long long ts1 = S2_T();
            spin_ge(consumed, ci - NS + 1); spin_ge(consumed + 1, ci - NS + 1);
            const unsigned long long ts2 = S2_T();
            float at[16], bhv[16], khv[16], giv[16]; float pprev = 1.0f; const float pC = __builtin_amdgcn_exp2f(cum[15]);
#pragma unroll
            for (int i = 0; i < 16; ++i) {
                const float r_s = rs_[i], k_s = ks_[i], v_s = vs_[i];
                const float ss = __uint_as_float(__builtin_amdgcn_readlane(__float_as_uint(q1[i]), 63)), bon = __uint_as_float(__builtin_amdgcn_readlane(__float_as_uint(q2[i]), 63));
                const float kk = k_s * kk_c * __builtin_amdgcn_rsqf(ss + 1e-12f);
                const float kd = k_s * (1.0f + (ic[i] - 1.0f) * ka_c); const float bb = kk * ic[i];
                const float p = __builtin_amdgcn_exp2f(cum[i]), pm = pprev, pinv = __builtin_amdgcn_exp2f(-cum[i]), pr = pC * pinv; pprev = p;
                at[i] = -kk * pm;
                lds_st16(P + P_ACAT + i * ROWB + posk * 2, at[i]);
                const float rt = r_s * p;
                lds_st16(P + P_ACAT + (16 + i) * ROWB + posk * 2, rt);
                lds_st16(SC + S_L1 + i * ROWB + posk * 2, bb * pinv); lds_st16(SC + S_L1 + (16 + i) * ROWB + posk * 2, kd * pinv);
                bhv[((i >> 2) & 1) * 8 + (i & 3) + 4 * (i >> 3)] = bb * pr; khv[i] = kd * pr; giv[i] = bon * v_s;
            }
#pragma unroll
            for (int hf = 0; hf < 2; ++hf) {
                *(LAS u32x4*)(P + P_BHAT + l * 32 + hf * 16) = (u32x4){cvt_pk_bf16(bhv[hf * 8 + 0], bhv[hf * 8 + 1]), cvt_pk_bf16(bhv[hf * 8 + 2], bhv[hf * 8 + 3]), cvt_pk_bf16(bhv[hf * 8 + 4], bhv[hf * 8 + 5]), cvt_pk_bf16(bhv[hf * 8 + 6], bhv[hf * 8 + 7])};
                *(LAS u32x4*)(P + P_KHAT + l * 32 + hf * 16) = (u32x4){cvt_pk_bf16(khv[hf * 8 + 0], khv[hf * 8 + 1]), cvt_pk_bf16(khv[hf * 8 + 2], khv[hf * 8 + 3]), cvt_pk_bf16(khv[hf * 8 + 4], khv[hf * 8 + 5]), cvt_pk_bf16(khv[hf * 8 + 6], khv[hf * 8 + 7])};
                *(LAS u32x4*)(P + P_VT + l * 32 + hf * 16) = (u32x4){cvt_pk_bf16(vs_[hf * 8 + 0], vs_[hf * 8 + 1]), cvt_pk_bf16(vs_[hf * 8 + 2], vs_[hf * 8 + 3]), cvt_pk_bf16(vs_[hf * 8 + 4], vs_[hf * 8 + 5]), cvt_pk_bf16(vs_[hf * 8 + 6], vs_[hf * 8 + 7])};
                *(LAS u32x4*)(P + P_GINIT + l * 32 + hf * 16) = (u32x4){cvt_pk_bf16(giv[hf * 8 + 0], giv[hf * 8 + 1]), cvt_pk_bf16(giv[hf * 8 + 2], giv[hf * 8 + 3]), cvt_pk_bf16(giv[hf * 8 + 4], giv[hf * 8 + 5]), cvt_pk_bf16(giv[hf * 8 + 6], giv[hf * 8 + 7])}; }
            *(LAS float*)(P + P_PC + l * 4) = pC;
            LDS_WAIT();
            const unsigned long long ts3 = S2_T();
            f32x16 Z = {};
            { const int r = l & 31, hh = l >> 5;
#pragma unroll
              for (int ks = 0; ks < 4; ++ks) { const bf16x8 fa = *(const LAS bf16x8*)(SC + S_L1 + r * ROWB + (ks * 16 + hh * 8) * 2), fb = *(const LAS bf16x8*)(P + P_ACAT + r * ROWB + (ks * 16 + hh * 8) * 2);
                  Z = __builtin_amdgcn_mfma_f32_32x32x16_bf16(fa, fb, Z, 0, 0, 0); } }
            { const int c = l & 31, hh = l >> 5;
              if (c < 16) {
#pragma unroll
                  for (int r = 0; r < 8; ++r) { const int s = crow(r, hh); *(LAS float*)(SC + S_MF + (c * 16 + s) * 4) = (s < c) ? Z[r] : 0.f; }
#pragma unroll
                  for (int r = 8; r < 16; ++r) { const int s = crow(r, hh) - 16; *(LAS float*)(SC + S_NF + (s * 16 + c) * 4) = (s < c) ? Z[r] : 0.f; }
                  *(LAS u32x4*)(P + P_MRF + l * 16) = (u32x4){0u, 0u, 0u, 0u};
              } else { const int t = c - 16; f32x16 Zm = Z;
#pragma unroll
                  for (int r = 0; r < 8; ++r) { const int s = crow(r, hh); Zm[r] = (s <= t) ? Z[r] : 0.f; }
                  *(LAS bf16x8*)(P + P_MRF + l * 16) = pack_acc8(Zm, 0);
#pragma unroll
                  for (int r = 8; r < 16; ++r) { const int s = crow(r, hh) - 16; lds_st16(P + P_NCAT + c * 32 + s * 2, (s <= t) ? Z[r] : 0.f); }
              } }
            LDS_WAIT();
            const unsigned long long ts4 = S2_T();
            { f32x2 xy[16];
#pragma unroll
              for (int q = 0; q < 4; ++q) { const f32x4 nvv = *(const LAS f32x4*)(SC + S_NF + ((l & 15) * 16 + q * 4) * 4);
                  xy[q * 4 + 0] = (f32x2){at[q * 4 + 0], nvv[0]}; xy[q * 4 + 1] = (f32x2){at[q * 4 + 1], nvv[1]}; xy[q * 4 + 2] = (f32x2){at[q * 4 + 2], nvv[2]}; xy[q * 4 + 3] = (f32x2){at[q * 4 + 3], nvv[3]}; }
              f32x4 mrow[16][4];
#pragma unroll
              for (int t = 1; t < 16; ++t)
#pragma unroll
                  for (int s4 = 0; s4 < (t + 3) / 4; ++s4) mrow[t][s4] = *(const LAS f32x4*)(SC + S_MF + (t * 16 + s4 * 4) * 4);
#pragma unroll
              for (int t = 1; t < 16; ++t) { f32x2 a0 = xy[t], a1 = {0.f, 0.f};
#pragma unroll
                  for (int s = 0; s < t; ++s) { const float m = mrow[t][s >> 2][s & 3]; const f32x2 mm = {m, m}; if (s & 1) a1 += xy[s] * mm; else a0 += xy[s] * mm; }
                  xy[t] = a0 + a1; }
#pragma unroll
              for (int t = 0; t < 16; ++t) lds_st16(P + P_ACAT + t * ROWB + posk * 2, xy[t].x);
              if (l < 16) {
#pragma unroll
                  for (int t = 0; t < 16; ++t) lds_st16(P + P_NCAT + t * 32 + l * 2, xy[t].y); } }
            LDS_WAIT();
            if (l == 0) ready[slot] = ci + 1;
            if (SCAN_SEC >= 0) { const unsigned long long ts5 = S2_T(); sec_acc += SCAN_SEC == 0 ? ts1 - ts0 : SCAN_SEC == 1 ? ts2 - ts1 : SCAN_SEC == 2 ? ts3 - ts2 : SCAN_SEC == 3 ? ts4 - ts3 : SCAN_SEC == 4 ? ts5 - ts4 : SCAN_SEC == 6 ? tsA - ts0 : SCAN_SEC == 7 ? ts1 - tsA : ts5 - ts0; }
        }
        if (SCAN_SEC >= 0 && blockIdx.x == 0 && pw == SCAN_PW && SCAN_SEC != 9 && l == 0) { F.MISC[120] = (unsigned)sec_acc; F.MISC[121] = (unsigned)(sec_acc >> 32); }
    }
    __syncthreads();
}
}

__device__ __forceinline__ void p5_post(Frame& F) {
    const int gw = F.vcu * 8 + F.wave, NGW = F.G * 8, l = F.lane; unsigned char* ws = F.ws;
    const bf16* yf = (const bf16*)(ws + WS_YF); const bf16* yb = (const bf16*)(ws + WS_YB); const bf16* gg = (const bf16*)(ws + WS_G); bf16* o = (bf16*)(ws + WS_ORWKV);
    const float* lg = F.in[I_LNXG]; const float* lb = F.in[I_LNXB];
    for (int t = gw; t < MT; t += NGW) {
        const size_t base = (size_t)t * RW;
#pragma unroll 4
        for (int h = 0; h < RH; ++h) { const int c = h * 64 + l;
            const float y = bf2f(yf[base + c]) + bf2f(yb[base + c]);
            const float mu = wave_sum(y) * (1.f / 64.f); const float d = y - mu; const float var = wave_sum(d * d) * (1.f / 64.f);
            const float yn = d * (1.0f / sqrtf(var + LNX_EPS));
            o[base + c] = f2bf((yn * lg[c] + lb[c]) * bf2f(gg[base + c])); }
    }
}

__device__ __forceinline__ void p8_rowpass(Frame& F) {
    const int gw = F.vcu * 8 + F.wave, NGW = F.G * 8; float* rstd2 = (float*)(F.ws + WS_RSTD) + 3 * MT; bf16* hb = (bf16*)(F.ws + WS_H1B);
    for (int m = gw; m < MT; m += NGW) {
        const f32x4* xr = (const f32x4*)(F.out + (size_t)m * DM) + F.lane; f32x4 v[8]; float s = 0.f;
#pragma unroll
        for (int j = 0; j < 8; ++j) { v[j] = xr[64 * j]; s += (v[j].x * v[j].x + v[j].y * v[j].y) + (v[j].z * v[j].z + v[j].w * v[j].w); }
        s = wave_sum(s); if (F.lane == 0) rstd2[m] = 1.0f / sqrtf(s * (1.f / DM) + RMS_EPS);
        u32x2* o8 = (u32x2*)(hb + (size_t)m * DM) + F.lane;
#pragma unroll
        for (int j = 0; j < 8; ++j) { u32x2 w; w.x = cvt_pk_bf16(v[j].x, v[j].y); w.y = cvt_pk_bf16(v[j].z, v[j].w); o8[64 * j] = w; }
    }
}
__device__ __forceinline__ void p12_router(Frame& F) {
    const int gw = F.vcu * 8 + F.wave, NGW = F.G * 8, l = F.lane; unsigned char* ws = F.ws;
    float* rstd3 = (float*)(ws + WS_RSTD) + 4 * MT; bf16* n3 = (bf16*)(ws + WS_N3); const float* WR = (const float*)(ws + WS_WR);
    int* lists = (int*)(ws + WS_LIST); int* route = (int*)(ws + WS_ROUTE); float* slotw = (float*)(ws + WS_SLOTW);
    int* cnt = (int*)(F.ctl + CW_CNT);
    const float* brg = F.in[I_BRG]; const float* bre = F.in[I_BRE];
    LAS float* wl = (LAS float*)(F.lds + 16384);
    LAS float* lgt = (LAS float*)(F.lds + F.wave * 1024);
    for (int tb = F.vcu * 32; tb < MT; tb += F.G * 32) {
        const int t0 = tb + F.wave * 4;
        float ss[4] = {0.f, 0.f, 0.f, 0.f};
#pragma unroll
        for (int q = 0; q < 4; ++q) { const f32x4* xr = (const f32x4*)(F.out + (size_t)(t0 + q) * DM) + l; u32x2* o8 = (u32x2*)(n3 + (size_t)(t0 + q) * DM) + l;
#pragma unroll
            for (int j = 0; j < 8; ++j) { const f32x4 x = xr[64 * j]; ss[q] += (x.x * x.x + x.y * x.y) + (x.z * x.z + x.w * x.w);
                u32x2 w; w.x = cvt_pk_bf16(x.x, x.y); w.y = cvt_pk_bf16(x.z, x.w); o8[64 * j] = w; } }
#pragma unroll
        for (int q = 0; q < 4; ++q) ss[q] = wave_sum(ss[q]);
#pragma unroll 1
        for (int pass = 0; pass < 2; ++pass) {
            const float* x0p = F.out + (size_t)(t0 + 2 * pass) * DM + l; const float* x1p = x0p + DM;
            float acc[2][36];
#pragma unroll
            for (int q = 0; q < 2; ++q)
#pragma unroll
                for (int o = 0; o < 36; ++o) acc[q][o] = 0.f;
#pragma unroll 1
            for (int blk = 0; blk < 8; ++blk) {
                __syncthreads();
                { const f32x4* src4 = (const f32x4*)(WR + (size_t)blk * 256 * 36); LAS f32x4* dst4 = (LAS f32x4*)wl;
#pragma unroll
                  for (int i = 0; i < 5; ++i) { const int idx = F.tid + 512 * i; if (idx < 2304) dst4[idx] = src4[idx]; } }
                __syncthreads();
#pragma unroll
                for (int c4 = 0; c4 < 4; ++c4) { const int cl = l + 64 * c4; const float x0 = x0p[blk * 256 + 64 * c4], x1 = x1p[blk * 256 + 64 * c4];
                    const LAS f32x4* wr = (const LAS f32x4*)(wl + cl * 36);
#pragma unroll
                    for (int o4 = 0; o4 < 9; ++o4) { const f32x4 w = wr[o4];
#pragma unroll
                        for (int k = 0; k < 4; ++k) { acc[0][o4 * 4 + k] += x0 * w[k]; acc[1][o4 * 4 + k] += x1 * w[k]; } } }
            }
#pragma unroll
            for (int q = 0; q < 2; ++q)
#pragma unroll
                for (int o = 0; o < 36; ++o) { const float v = wave_sum(acc[q][o]); if (l == 0) lgt[(2 * pass + q) * 36 + o] = v; }
        }
        LDS_WAIT();
#pragma unroll
        for (int q = 0; q < 4; ++q) { const int t = t0 + q; const float rs = 1.0f / sqrtf(ss[q] * (1.f / DM) + RMS_EPS);
            float lg[4]; float gmax = -3.0e38f; int gsel = 0;
#pragma unroll
            for (int g = 0; g < 4; ++g) { lg[g] = lgt[q * 36 + g] * rs + brg[g]; if (lg[g] > gmax) { gmax = lg[g]; gsel = g; } }
            float gz = 0.f;
#pragma unroll
            for (int g = 0; g < 4; ++g) gz += __expf(lg[g] - gmax);
            const float pg = 1.0f / gz;
            float le[8];
#pragma unroll
            for (int e = 0; e < 8; ++e) { float a = lgt[q * 36 + 4 + e];
#pragma unroll
                for (int g = 1; g < 4; ++g) a = (gsel == g) ? lgt[q * 36 + 4 + g * 8 + e] : a;
                le[e] = a * rs + bre[gsel * 8 + e]; }
            float m1 = -3.0e38f, m2 = -3.0e38f; int e1 = 0, e2 = 0;
#pragma unroll
            for (int e = 0; e < 8; ++e) { if (le[e] > m1) { m2 = m1; e2 = e1; m1 = le[e]; e1 = e; } else if (le[e] > m2) { m2 = le[e]; e2 = e; } }
            const float xe = __expf(m2 - m1); const float w1 = pg / (1.0f + xe), w2 = pg * xe / (1.0f + xe);
            if (l == 0) { rstd3[t] = rs;
                const int E1 = gsel * 8 + e1, E2 = gsel * 8 + e2;
                const int p1 = atomicAdd(cnt + 64 * E1, 1), p2 = atomicAdd(cnt + 64 * E2, 1);
                lists[E1 * MT + p1] = t; lists[E2 * MT + p2] = t; slotw[E1 * MT + p1] = w1; slotw[E2 * MT + p2] = w2;
                route[t * 8 + 0] = E1; route[t * 8 + 1] = p1; route[t * 8 + 2] = E2; route[t * 8 + 3] = p2; }
        }
    }
}
struct MoeOrder {
    static constexpr bool GATHER = true;
    const volatile LAS int* tp; const int* cnt; const int* lists; const char* A; const char* B; int G, c, lognt; size_t bstride_e, bstride_t;
    bool gather;
    __device__ __forceinline__ bool next(int i, Unit& u) const {
        const int L = i * G + c; const int RT = tp[32]; if (L >= (RT << lognt)) return false;
        const int rt = L >> lognt, nt = L & ((1 << lognt) - 1); int e = 0;
        for (int q = 1; q < 32; ++q) e = (rt >= tp[q]) ? q : e;
        u.pm = rt; u.pn = nt; u.aux0 = e; u.aux1 = (rt - tp[e]) * 256;
        u.Ab = A; u.Bb = B + (size_t)e * bstride_e + (size_t)nt * bstride_t; return true;
    }
    __device__ __forceinline__ unsigned arow(const Unit& u, int r) const {
        if (!gather) return (unsigned)(u.pm * 256 + r);
        const int idx = u.aux1 + r; const int n = cnt[64 * u.aux0]; return idx < n ? (unsigned)lists[u.aux0 * MT + idx] : 0u;
    }
};
struct EpiMoe1 {
    static constexpr bool PERM = true;
    bf16* hid; const int* cnt; const int* lists; const float* slotw; const float* rstd;
    __device__ __forceinline__ void operator()(const PG8_ACC, const Unit& u, int wr, int wc, int fr, int fq) const {
        const int n = cnt[64 * u.aux0];
#pragma unroll
        for (int ai = 0; ai < 2; ++ai)
#pragma unroll
            for (int m = 0; m < 4; ++m) { const int r = ai * 128 + wr * 64 + m * 16 + fr; const int idx = u.aux1 + r; const bool ok = idx < n;
                const int tok = ok ? lists[u.aux0 * MT + idx] : 0; const float rs = rstd[tok]; const float wt = ok ? slotw[u.aux0 * MT + idx] : 0.f;
                f32x4 o0, o1;
#pragma unroll
                for (int j = 0; j < 4; ++j) { const float g0 = acc[ai][0][m][0][j] * rs, u0 = acc[ai][1][m][0][j] * rs, g1 = acc[ai][0][m][1][j] * rs, u1 = acc[ai][1][m][1][j] * rs;
                    o0[j] = g0 * sigmoidf_(g0) * u0 * wt; o1[j] = g1 * sigmoidf_(g1) * u1 * wt; }
                *(u32x4*)(hid + (size_t)(u.pm * 256 + r) * DE + u.pn * 128 + wc * 32 + 8 * fq) = pg8::pack8(o0, o1); }
    }
};
struct EpiMoe2 {
    static constexpr bool PERM = true;
    bf16* y;
    __device__ __forceinline__ void operator()(const PG8_ACC, const Unit& u, int wr, int wc, int fr, int fq) const {
        EPI_FOR(ai, m, bj) { const int row = u.pm * 256 + ai * 128 + wr * 64 + m * 16 + fr; const int col = u.pn * 256 + bj * 128 + wc * 32 + 8 * fq;
            *(u32x4*)(y + (size_t)row * DM + col) = pg8::pack8(acc[ai][bj][m][0], acc[ai][bj][m][1]); }
    }
};
__device__ __forceinline__ void moe_table(Frame& F) {
    if (F.tid == 0) { const int* cnt = (const int*)(F.ctl + CW_CNT); int acc = 0;
        for (int e = 0; e < 32; ++e) { F.MISC[16 + e] = (unsigned)acc; acc += (__hip_atomic_load(cnt + 64 * e, __ATOMIC_RELAXED, __HIP_MEMORY_SCOPE_AGENT) + 255) >> 8; }
        F.MISC[16 + 32] = (unsigned)acc; }
    __syncthreads();
}
__device__ __forceinline__ void p5_expert_cvt(Frame& F) {
    LAS float* scr = (LAS float*)(F.lds + F.wave * CVT_SCR); const int gw = F.vcu * 8 + F.wave, NGW = F.G * 8; unsigned char* ws = F.ws;
#define EX_DESC(it_, d) do { const int e = (it_) / 768, r = (it_) % 768; \
        if (r < 256) { d.W = F.in[I_WEG] + (size_t)e * DM * DE; d.gain = F.in[I_GFFN]; d.WT = (bf16*)(ws + WS_WGU) + (size_t)e * 1024 * DM; d.K = DM; d.N = DE; d.ldt = DM; d.mode = 3; d.kofs = 0; d.item = r; } \
        else if (r < 512) { d.W = F.in[I_WEU] + (size_t)e * DM * DE; d.gain = F.in[I_GFFN]; d.WT = (bf16*)(ws + WS_WGU) + (size_t)e * 1024 * DM; d.K = DM; d.N = DE; d.ldt = DM; d.mode = 4; d.kofs = 0; d.item = r - 256; } \
        else { d.W = F.in[I_WED] + (size_t)e * DE * DM; d.gain = nullptr; d.WT = (bf16*)(ws + WS_WD) + (size_t)e * DM * DE; d.K = DE; d.N = DM; d.ldt = DE; d.mode = 0; d.kofs = 0; d.item = r - 512; } } while (0)
    CVT_PIPE(NE * 768, EX_DESC);
#undef EX_DESC
}

struct Args { const float* in[41]; float* out; unsigned char* ws; int ph_lo, ph_hi; };
constexpr int NPHASE = 16;
__global__ void __launch_bounds__(512, 2) fwd_kernel(Args args) {
    extern __shared__ __attribute__((aligned(16))) unsigned char lds_raw[];
    Frame F;
    F.lds = (LAS unsigned char*)lds_raw; F.MISC = (volatile LAS unsigned*)(F.lds + MISC_OFF);
    F.tid = threadIdx.x; F.lane = F.tid & 63; F.wave = __builtin_amdgcn_readfirstlane(F.tid >> 6);
    F.G = gridDim.x; { const int bx = blockIdx.x; F.vcu = (F.G % 8 == 0) ? (bx % 8) * (F.G / 8) + bx / 8 : bx; }
    F.ws = args.ws; F.out = args.out; F.ctl = (unsigned*)(args.ws + WS_CTL);
#pragma unroll
    for (int i = 0; i < 41; ++i) F.in[i] = args.in[i];
    for (int u = F.tid; u < (LDS_BYTES - LDSCTL_OFF) / 4; u += 512) ((LAS unsigned*)(F.lds + LDSCTL_OFF))[u] = 0u;
    __syncthreads();
    XcdBarrier bar; bar.bar = F.ctl + CW_BAR; bar.x = 0; bar.st = nullptr;
    const int lo = args.ph_lo, hi = args.ph_hi;
    if (hi - lo > 1) bar = xcd_barrier_post(F.ctl + CW_BAR, F.MISC + 8);
#ifndef ATT_DQK_TEST
#define ATT_DQK_TEST QKD
#endif
#define PROBE_N (MT * 768)
#ifndef LSEL
#define LSEL 31
#endif
#ifndef PH_MASK
#define PH_MASK 0xFFFFu
#endif
#ifndef SCAN_MFMA
#define SCAN_MFMA 1
#endif
#ifndef SCAN_DUMMY
#define SCAN_DUMMY 0
#endif
#ifndef REPEAT_MASK
#define REPEAT_MASK 0x0u
#endif
#define REP(k) _Pragma("unroll") for (int _rep = 0; _rep <= (int)(((REPEAT_MASK) >> (k)) & 1u); ++_rep)
#define IN(k) ((((PH_MASK) >> (k)) & 1u) && lo <= (k) && (k) < hi)
#ifndef PROBE_TIME
#define PROBE_TIME -1
#endif
#define SEAM(k) do { if (lo <= (k) && (k) + 1 < hi) xcd_barrier(bar); if (PROBE_TIME >= 0 && blockIdx.x == 0 && F.tid == 0) { const unsigned long long _t = wall_clock64(); F.MISC[64 + 2 * ((k) + 1)] = (unsigned)_t; F.MISC[65 + 2 * ((k) + 1)] = (unsigned)(_t >> 32); } } while (0)
    unsigned char* ws = args.ws;

    bf16* const zmla = (bf16*)(ws + WS_ZMLA); bf16* const loraA = (bf16*)(ws + WS_LORAA);
    float* const rstd1 = (float*)(ws + WS_RSTD); float* const rstd_q = rstd1 + MT; float* const rstd_kv = rstd1 + 2 * MT;
    const int bid = (int)blockIdx.x;
    if (PROBE_TIME >= 0 && blockIdx.x == 0 && F.tid == 0) { const unsigned long long _t = wall_clock64(); F.MISC[64] = (unsigned)_t; F.MISC[65] = (unsigned)(_t >> 32); }
    if (IN(0)) { REP(0) p0_prologue(F); }
    SEAM(0);
    if (IN(1)) {
        if (EN_RWKV || EN_MLA) REP(1) { pg8::StaticOrder S; S.init((const bf16*)(ws + WS_XB), DM, (const bf16*)(ws + WS_WIN), DM, MT, G1_N, F.G, bid);
          EpiG1 E{rstd1, zmla, (bf16*)(ws + WS_ZRKV), (bf16*)(ws + WS_ZLORA), (bf16*)(ws + WS_ZGATE)};
          pg8::gemm_phase(F.lds, DM, DM, DM, S, E); }
        else p_copy_x(F);
    }
    SEAM(1);
    if (IN(2)) { if (EN_RWKV || EN_MLA) REP(2) p2_rowpass(F); }
    SEAM(2);
    if (IN(3)) REP(3) {
        if (EN_MLA) {
            { pg8::StaticOrder S; S.init(zmla, ZM_LD, (const bf16*)(ws + WS_WUQ), QLORA, MT, MH * QKD, F.G, bid);
              EpiQ E{(bf16*)(ws + WS_Q), rstd_q, (const float*)(ws + WS_ROPE)};
              pg8::gemm_phase(F.lds, QLORA, ZM_LD, QLORA, S, E); }
            { pg8::StaticOrder S; S.init(zmla + QLORA, ZM_LD, (const bf16*)(ws + WS_WUKV), KVLORA, MT, MH * 256, F.G, bid);
              EpiKV E{(bf16*)(ws + WS_K), (bf16*)(ws + WS_V), rstd_kv};
              pg8::gemm_phase(F.lds, KVLORA, ZM_LD, KVLORA, S, E); }
        }
        if (EN_RWKV) {
            { pg8::StaticOrder S; S.init(loraA, LA_LD, (const bf16*)(ws + WS_W2F), 256, MT, 2 * RW, F.G, bid);
              EpiLora2<0> E{(bf16*)(ws + WS_WLF), (bf16*)(ws + WS_WLB), F.in[I_W0F], F.in[I_W0B]}; pg8::gemm_phase(F.lds, 256, LA_LD, 256, S, E); }
            { pg8::StaticOrder S; S.init(loraA + 256, LA_LD, (const bf16*)(ws + WS_W2F + 2 * MiB), 256, MT, 2 * RW, F.G, bid);
              EpiLora2<1> E{(bf16*)(ws + WS_ICF), (bf16*)(ws + WS_ICB), F.in[I_A0F], F.in[I_A0B]}; pg8::gemm_phase(F.lds, 256, LA_LD, 256, S, E); }
            if (LSEL & 16) { pg8::StaticOrder S; S.init(loraA + 512, LA_LD, (const bf16*)(ws + WS_G2), GLORA, MT, RW, F.G, bid);
              EpiLora<2> E{(bf16*)(ws + WS_G), nullptr}; pg8::gemm_phase(F.lds, GLORA, LA_LD, GLORA, S, E); }
        }
    }
    SEAM(3);
    if (IN(4)) {
        constexpr int NSCAN = NB * RH * 2, NATT = NB * MH * (SEQ / 256);
        int s_begin = F.vcu, s_end = NSCAN, s_step = F.G, a_begin = F.vcu, a_step = F.G, a_cnt = (F.vcu < NATT) ? (NATT - 1 - F.vcu) / F.G + 1 : 0;
        if (EN_RWKV && EN_MLA && F.G == 256) { s_step = 1; a_step = 1;
            if (F.vcu < 128) { s_end = F.vcu + 1; a_begin = 384 + F.vcu; a_cnt = 1; } else { s_end = 0; a_begin = (F.vcu - 128) * 3; a_cnt = 3; } }
        if (EN_RWKV) for (int u = s_begin; u < s_end; u += s_step) { const int dir = u & 1, bh = u >> 1;
            if (dir) scan2::scan_unit<1>(F, bh >> 5, bh & 31); else scan2::scan_unit<0>(F, bh >> 5, bh & 31); }
        if (EN_MLA) for (int i = 0; i < a_cnt; ++i) { const int L = a_begin + i * a_step; const int qb = L & 15, bh = L >> 4, b = bh >> 4, h = bh & 15;
            att::attn_unit<ATT_DQK_TEST, MH * QKD, MH * QKD, MH * VDIM, DM>((const bf16*)(ws + WS_Q) + ((size_t)(b * SEQ + qb * 256) * (MH * QKD) + h * QKD),
                                (const bf16*)(ws + WS_K) + ((size_t)b * SEQ * (MH * QKD) + h * QKD),
                                (const bf16*)(ws + WS_V) + ((size_t)b * SEQ * (MH * VDIM) + h * VDIM),
                                (bf16*)(ws + WS_OMLA) + ((size_t)(b * SEQ + qb * 256) * DM + h * VDIM), SEQ, (LAS char*)F.lds); }
    }
    SEAM(4);
    if (IN(5)) { if (EN_RWKV) REP(5) p5_post(F); if (EN_MOE) REP(17) p5_expert_cvt(F); }
    SEAM(5);
    if (IN(6)) REP(6) {
        if (EN_MLA) { pg8::StaticOrder S; S.init((const bf16*)(ws + WS_OMLA), DM, (const bf16*)(ws + WS_WUPM), DM, MT, DM, F.G, bid);
            EpiUp<0> E{(bf16*)(ws + WS_MERGED), (const bf16*)(ws + WS_ZGATE), 0}; pg8::gemm_phase(F.lds, DM, DM, DM, S, E); }
        if (EN_RWKV) { pg8::StaticOrder S; S.init((const bf16*)(ws + WS_ORWKV), DM, (const bf16*)(ws + WS_WUPR), DM, MT, DM, F.G, bid);
            EpiUp<EN_MLA> E{(bf16*)(ws + WS_MERGED), (const bf16*)(ws + WS_ZGATE), DM}; pg8::gemm_phase(F.lds, DM, DM, DM, S, E); }
    }
    SEAM(6);
    if (IN(7)) REP(7) {
        if (EN_RWKV || EN_MLA) { pg8::StaticOrder S; S.init((const bf16*)(ws + WS_MERGED), DM, (const bf16*)(ws + WS_WOUT), DM, MT, DM, F.G, bid);
            EpiResid E{F.in[I_X], F.out}; pg8::gemm_phase(F.lds, DM, DM, DM, S, E); }
    }
    SEAM(7);
    if (IN(8)) { if (EN_CROSS || EN_MOE) p8_rowpass(F); }
    SEAM(8);
    if (IN(9)) REP(9) {
        if (EN_CROSS) { pg8::StaticOrder S; S.init((const bf16*)(ws + WS_H1B), DM, (const bf16*)(ws + WS_WQC), DM, MT, CW, F.G, bid);
            EpiPlain E{(bf16*)(ws + WS_QC), CW, rstd1 + 3 * MT, CSCALE}; pg8::gemm_phase(F.lds, DM, DM, DM, S, E); }
        if (EN_CROSS && bid >= 64) { pg8::StaticOrder S; S.init((const bf16*)(ws + WS_MEMN), DM, (const bf16*)(ws + WS_WKVC), DM, NB * MEMLEN, 2 * CW, F.G, bid - 64);
            EpiPlain E{(bf16*)(ws + WS_KVC), 2 * CW, nullptr, 1.f}; pg8::gemm_phase(F.lds, DM, DM, DM, S, E); }
    }
    SEAM(9);
    if (IN(10)) REP(10) {
        if (EN_CROSS) {
            for (int i = 0; ; ++i) { const int L = i * F.G + F.vcu; if (L >= NB * CH * (SEQ / 256)) break;
                const int qb = L & 15, bh = L >> 4, b = bh >> 2, h = bh & 3;
                att::attn_unit<CHD, CW, 2 * CW, 2 * CW, CW>((const bf16*)(ws + WS_QC) + ((size_t)(b * SEQ + qb * 256) * CW + h * CHD),
                                    (const bf16*)(ws + WS_KVC) + ((size_t)b * MEMLEN * (2 * CW) + h * CHD),
                                    (const bf16*)(ws + WS_KVC) + ((size_t)b * MEMLEN * (2 * CW) + CW + h * CHD),
                                    (bf16*)(ws + WS_OC) + ((size_t)(b * SEQ + qb * 256) * CW + h * CHD), MEMLEN, (LAS char*)F.lds); }
        }
    }
    SEAM(10);
    if (IN(11)) {
        if (EN_CROSS) { pg8::StaticOrder S; S.init((const bf16*)(ws + WS_OC), CW, (const bf16*)(ws + WS_WOC), CW, MT, DM, F.G, bid);
            EpiResid E{F.out, F.out}; pg8::gemm_phase(F.lds, CW, CW, CW, S, E); }
    }
    SEAM(11);
    if (IN(12)) { if (EN_MOE) p12_router(F); }
    SEAM(12);
    if (IN(13)) REP(13) {
        if (EN_MOE) { moe_table(F);
            MoeOrder S{(const volatile LAS int*)(F.MISC + 16), (const int*)(F.ctl + CW_CNT), (const int*)(ws + WS_LIST), (const char*)(ws + WS_N3), (const char*)(ws + WS_WGU), F.G, F.vcu, 2,
                       (size_t)1024 * DM * 2, (size_t)256 * DM * 2, true};
            EpiMoe1 E{(bf16*)(ws + WS_HID), (const int*)(F.ctl + CW_CNT), (const int*)(ws + WS_LIST), (const float*)(ws + WS_SLOTW), rstd1 + 4 * MT};
            pg8::gemm_phase(F.lds, DM, DM, DM, S, E); }
    }
    SEAM(13);
    if (IN(14)) REP(14) {
        if (EN_MOE) { moe_table(F);
            MoeOrder S{(const volatile LAS int*)(F.MISC + 16), (const int*)(F.ctl + CW_CNT), (const int*)(ws + WS_LIST), (const char*)(ws + WS_HID), (const char*)(ws + WS_WD), F.G, F.vcu, 3,
                       (size_t)DM * DE * 2, (size_t)256 * DE * 2, false};
            EpiMoe2 E{(bf16*)(ws + WS_YBUF)};
            pg8::gemm_phase(F.lds, DE, DE, DE, S, E); }
    }
    SEAM(14);
#ifdef PROBE_OFF
    if (IN(15)) { const int gt = F.vcu * 512 + F.tid, NGT = F.G * 512; const bf16* sb = (const bf16*)(ws + (size_t)PROBE_OFF * MiB);
        for (int i = gt; i < MT * DM; i += NGT) F.out[i] = (i < PROBE_N) ? bf2f(sb[i]) : 0.f; }
#else
    if (IN(15)) { p_final(F, EN_MOE != 0); }
#endif
    if (SCAN_SEC >= 0) { __syncthreads(); if (blockIdx.x == 0 && F.tid == 0) { const unsigned long long c = ((unsigned long long)F.MISC[121] << 32) | F.MISC[120]; F.out[(size_t)(F.vcu * 8) * DM] += (float)c * 1e-4f; } }
    if (PROBE_TIME >= 0) { __syncthreads(); if (blockIdx.x == 0 && F.tid == 0) {
        const unsigned long long a = ((unsigned long long)F.MISC[65 + 2 * PROBE_TIME] << 32) | F.MISC[64 + 2 * PROBE_TIME], b = ((unsigned long long)F.MISC[65 + 2 * (PROBE_TIME + 1)] << 32) | F.MISC[64 + 2 * (PROBE_TIME + 1)];
        F.out[(size_t)(F.vcu * 8) * DM] += (float)(b - a) * 0.001f; } }
#undef IN
#undef SEAM
}

extern "C" void kernel_launch(void* const* d_in, const int* in_sizes, int n_in, void* d_out, int out_size, void* d_ws, size_t ws_size, hipStream_t stream) {
    static int grid = 0;
    if (grid == 0) {
        if (n_in != 41 || out_size != MT * DM || ws_size < WS_END) { fprintf(stderr, "kernel_launch: unexpected shapes n_in %d out %d ws %zu (need %zu)\n", n_in, out_size, ws_size, (size_t)WS_END); grid = -1; return; }
        int dev = 0, cus = 0, per_cu = 0;
        if (hipGetDevice(&dev) != hipSuccess || hipDeviceGetAttribute(&cus, hipDeviceAttributeMultiprocessorCount, dev) != hipSuccess) { grid = -1; return; }
        if (hipFuncSetAttribute((const void*)fwd_kernel, hipFuncAttributeMaxDynamicSharedMemorySize, LDS_BYTES) != hipSuccess) { fprintf(stderr, "kernel_launch: hipFuncSetAttribute failed\n"); grid = -1; return; }
        if (hipOccupancyMaxActiveBlocksPerMultiprocessor(&per_cu, (const void*)fwd_kernel, 512, LDS_BYTES) != hipSuccess || per_cu < 1) { fprintf(stderr, "kernel_launch: occupancy query says %d\n", per_cu); }
        (void)hipGetLastError();
        grid = cus;
    }
    if (grid < 0) return;
    (void)hipMemsetAsync((char*)d_ws + WS_CTL, 0, CTL_BYTES, stream);
    Args a{};
    for (int i = 0; i < 41; ++i) a.in[i] = (const float*)d_in[i];
    a.out = (float*)d_out; a.ws = (unsigned char*)d_ws;
#if N_LAUNCH_SPLIT
    for (int p = 0; p < NPHASE; ++p) { a.ph_lo = p; a.ph_hi = p + 1; hipLaunchKernelGGL(fwd_kernel, dim3(grid), dim3(512), LDS_BYTES, stream, a); }
#else
    a.ph_lo = 0; a.ph_hi = NPHASE;
    hipLaunchKernelGGL(fwd_kernel, dim3(grid), dim3(512), LDS_BYTES, stream, a);
#endif
}
```

```cpp
#include <hip/hip_runtime.h>
#include <cstdio>
#include <cstdint>

#ifndef SCAN_PW
#define SCAN_PW 0
#endif
#ifndef SCAN_SEC
#define SCAN_SEC -1
#endif
#ifndef EN_RWKV
#define EN_RWKV 1
#endif
#ifndef EN_MLA
#define EN_MLA 1
#endif
#ifndef EN_CROSS
#define EN_CROSS 1
#endif
#ifndef EN_MOE
#define EN_MOE 1
#endif
#ifndef N_LAUNCH_SPLIT
#define N_LAUNCH_SPLIT 0
#endif

#define GAS __attribute__((address_space(1)))
#define LAS __attribute__((address_space(3)))
typedef unsigned short bf16;
typedef short bf16x8 __attribute__((ext_vector_type(8)));
typedef short s16x4 __attribute__((ext_vector_type(4)));
typedef float f32x4 __attribute__((ext_vector_type(4)));
typedef float f32x2 __attribute__((ext_vector_type(2)));
typedef float f32x16 __attribute__((ext_vector_type(16)));
typedef unsigned u32x4 __attribute__((ext_vector_type(4)));
typedef unsigned u32x2 __attribute__((ext_vector_type(2)));

constexpr int DM = 2048, NB = 2, SEQ = 4096, MT = NB * SEQ;
constexpr int MEMLEN = 256;
constexpr int QLORA = 512, KVLORA = 256, ROPE = 64, NOPE = 128, VDIM = 128, QKD = 192, MH = 16;
constexpr int RW = 2048, RH = 32, RHD = 64, DLORA = 96, GLORA = 256;
constexpr int MLA_IN = 832, RWKV_IN = 6784, GATE_IN = 4096, IN_W = MLA_IN + RWKV_IN + GATE_IN;
constexpr int CH = 4, CHD = 128, CW = 512;
constexpr int NG = 4, EPG = 8, NE = 32, DE = 512;
constexpr float RMS_EPS = 1e-6f, LNX_EPS = 64e-5f;
constexpr int G1_N = 12032;
constexpr int ZM_LD = 1024, ZR_LD = 6144, ZL_LD = 768, ZG_LD = 4096, LA_LD = 768;
constexpr int MOE_SLOTS = 2 * MT + NE * 256;

constexpr size_t MiB = 1u << 20;
constexpr size_t WS_CTL = 0, CTL_BYTES = 1 * MiB;
constexpr size_t WS_WUQ = 1 * MiB;
constexpr size_t WS_WUKV = 4 * MiB;
constexpr size_t WS_W2F = 6 * MiB;
constexpr size_t WS_G2 = 10 * MiB;
constexpr size_t WS_WUPM = 11 * MiB, WS_WUPR = 19 * MiB, WS_WOUT = 27 * MiB;
constexpr size_t WS_WQC = 35 * MiB;
constexpr size_t WS_WKVC = 37 * MiB;
constexpr size_t WS_WOC = 41 * MiB;
constexpr size_t WS_WIN = 43 * MiB;
constexpr size_t WS_MISC = 90 * MiB;
constexpr size_t WS_ROPE = WS_MISC;
constexpr size_t WS_MEMN = WS_MISC + 2 * MiB;
constexpr size_t WS_KVC = WS_MISC + 4 * MiB;
constexpr size_t WS_RSTD = WS_MISC + 5 * MiB;
constexpr size_t WS_WR = WS_RSTD + 256 * 1024;
constexpr size_t WS_LIST = WS_MISC + 6 * MiB;
constexpr size_t WS_ROUTE = WS_MISC + 7 * MiB;
constexpr size_t WS_SLOTW = WS_MISC + 8 * MiB;
constexpr size_t WS_XB = 100 * MiB;
constexpr size_t WS_ZMLA = 132 * MiB;
constexpr size_t WS_ZLORA = 148 * MiB;
constexpr size_t WS_LORAA = 160 * MiB;
constexpr size_t WS_ZRKV = 172 * MiB;
constexpr size_t WS_ZGATE = 268 * MiB;
constexpr size_t WS_Q = 332 * MiB;
constexpr size_t WS_K = 380 * MiB;
constexpr size_t WS_V = 428 * MiB;
constexpr size_t WS_WLF = 460 * MiB, WS_WLB = 492 * MiB, WS_ICF = 524 * MiB, WS_ICB = 556 * MiB;
constexpr size_t WS_G = 588 * MiB;
constexpr size_t WS_END = 620 * MiB;
constexpr size_t WS_YF = WS_WIN, WS_YB = WS_ZMLA, WS_ORWKV = WS_Q, WS_MERGED = WS_K, WS_QC = WS_V, WS_OC = WS_V + 8 * MiB;
constexpr size_t WS_WGU = WS_WLF, WS_WD = WS_ZRKV, WS_HID = WS_ZGATE, WS_YBUF = WS_Q;
constexpr size_t WS_OMLA = WS_XB, WS_H1B = WS_XB, WS_N3 = WS_XB;

constexpr int CW_BAR = 4096;
constexpr int CW_CNT = 16384;

constexpr int RING_BYTES = 159744;
constexpr int LDSCTL_OFF = RING_BYTES, MISC_OFF = LDSCTL_OFF + 320;
constexpr int LDS_BYTES = 161792;

#define LDS_WAIT() asm volatile("s_waitcnt lgkmcnt(0)" ::: "memory")
#define VM_WAIT() asm volatile("s_waitcnt vmcnt(0)" ::: "memory")
typedef __bf16 bf16x2_t __attribute__((ext_vector_type(2)));
__device__ __forceinline__ unsigned cvt_pk_bf16(float lo, float hi) { f32x2 v = {lo, hi}; bf16x2_t b = __builtin_convertvector(v, bf16x2_t); return __builtin_bit_cast(unsigned, b); }
__device__ __forceinline__ float bf2f(unsigned short b) { return __builtin_bit_cast(float, ((unsigned)b) << 16); }
__device__ __forceinline__ float bflo(unsigned w) { return __builtin_bit_cast(float, w << 16); }
__device__ __forceinline__ float bfhi(unsigned w) { return __builtin_bit_cast(float, w & 0xffff0000u); }
__device__ __forceinline__ unsigned short f2bf(float f) { return (unsigned short)(cvt_pk_bf16(f, 0.f) & 0xffffu); }
__device__ __forceinline__ float sigmoidf_(float x) { return __builtin_amdgcn_rcpf(1.0f + __builtin_amdgcn_exp2f(-1.4426950408889634f * x)); }
template <int CTRL> __device__ __forceinline__ float dpp_add_(float v) {
    return v + __builtin_bit_cast(float, __builtin_amdgcn_update_dpp(0, __builtin_bit_cast(int, v), CTRL, 0xF, 0xF, false));
}
__device__ __forceinline__ float wave_sum(float v) {
    v = dpp_add_<0xB1>(v); v = dpp_add_<0x4E>(v); v = dpp_add_<0x141>(v); v = dpp_add_<0x140>(v);
    const int iv = __builtin_bit_cast(int, v);
    const float s0 = __builtin_bit_cast(float, __builtin_amdgcn_readlane(iv, 0)), s1 = __builtin_bit_cast(float, __builtin_amdgcn_readlane(iv, 16));
    const float s2 = __builtin_bit_cast(float, __builtin_amdgcn_readlane(iv, 32)), s3 = __builtin_bit_cast(float, __builtin_amdgcn_readlane(iv, 48));
    return (s0 + s1) + (s2 + s3);
}

#define XB_TMO      128
#define XB_XCNT(j)  (256  + 64 * (j))
#define XB_XSUB(j)  (1280 + 64 * (j))
#define XB_XGEN(j)  (2304 + 64 * (j))
#define XB_TOP      3328
#define XB_TOPGEN   3392
#define XCD_BAR_WORDS 3456
#define XB_SPIN_CAP (1u << 18)
__device__ __forceinline__ unsigned xb_ld(unsigned* p)              { return __hip_atomic_load(p, __ATOMIC_RELAXED, __HIP_MEMORY_SCOPE_AGENT); }
__device__ __forceinline__ unsigned xb_add(unsigned* p, unsigned v) { return __hip_atomic_fetch_add(p, v, __ATOMIC_RELAXED, __HIP_MEMORY_SCOPE_AGENT); }
__device__ __forceinline__ unsigned xb_xcc_id() { return (unsigned)__builtin_amdgcn_s_getreg((3 << 11) | 20) & 0xFu; }
#define XB_SPIN(cond, bar) do { unsigned _sp = 0; while (cond) { __builtin_amdgcn_s_sleep(1); \
    if ((++_sp & 255u) == 0u) { if (xb_ld(&(bar)[XB_TMO])) break; if (_sp > XB_SPIN_CAP) { atomicAdd(&(bar)[XB_TMO], 1u); break; } } } } while (0)
struct XcdBarrier { unsigned* bar; unsigned x; volatile LAS unsigned* st; };
__device__ __forceinline__ XcdBarrier xcd_barrier_post(unsigned* bar, volatile LAS unsigned* st) {
    XcdBarrier b; b.bar = bar; b.x = xb_xcc_id(); b.st = st;
    if (threadIdx.x == 0) (void)xb_add(&bar[XB_XCNT(b.x)], 1u);
    return b;
}
__device__ __forceinline__ void xcd_barrier_complete(unsigned* bar, unsigned x, unsigned& nloc, unsigned& nx) {
    const unsigned G = gridDim.x * gridDim.y * gridDim.z;
    unsigned sum, cnt, mine, sp = 0u;
    for (;;) {
        sum = 0u; cnt = 0u; mine = 0u;
#pragma unroll
        for (unsigned j = 0; j < 16; ++j) { const unsigned c = xb_ld(&bar[XB_XCNT(j)]); sum += c; cnt += (c > 0u) ? 1u : 0u; mine = (j == x) ? c : mine; }
        if (sum == G) break;
        __builtin_amdgcn_s_sleep(1);
        if ((++sp & 255u) == 0u) { if (xb_ld(&bar[XB_TMO])) break; if (sp > XB_SPIN_CAP) { atomicAdd(&bar[XB_TMO], 1u); break; } }
    }
    nloc = mine > 0u ? mine : 1u; nx = cnt > 0u ? cnt : 1u;
}
__device__ __forceinline__ void xcd_barrier(const XcdBarrier& b) {
    asm volatile("s_waitcnt vmcnt(0)" ::: "memory");
    __syncthreads();
    if (threadIdx.x == 0) {
        unsigned* bar = b.bar;
        __builtin_amdgcn_s_waitcnt(0);
        unsigned nloc = b.st[0], nx = b.st[1];
        if (nloc == 0u) { xcd_barrier_complete(bar, b.x, nloc, nx); b.st[0] = nloc; b.st[1] = nx; }
        const unsigned old = xb_add(&bar[XB_XSUB(b.x)], 1u);
        const unsigned gen = old / nloc;
        if (old + 1u == (gen + 1u) * nloc) {
            __builtin_amdgcn_fence(__ATOMIC_RELEASE, "agent");
            asm volatile("s_waitcnt vmcnt(0)" ::: "memory");
            const unsigned og = xb_add(&bar[XB_TOP], 1u);
            const unsigned tg = og / nx;
            if (og + 1u == (tg + 1u) * nx) xb_add(&bar[XB_TOPGEN], 1u);
            else XB_SPIN(xb_ld(&bar[XB_TOPGEN]) == tg, bar);
            __builtin_amdgcn_fence(__ATOMIC_ACQUIRE, "agent");
            xb_add(&bar[XB_XGEN(b.x)], 1u);
            asm volatile("s_waitcnt vmcnt(0)" ::: "memory");
        } else {
            XB_SPIN(xb_ld(&bar[XB_XGEN(b.x)]) == gen, bar);
            __builtin_amdgcn_fence(__ATOMIC_ACQUIRE, "agent");
            asm volatile("s_waitcnt vmcnt(0)" ::: "memory");
        }
    }
    __syncthreads();
}

namespace pg8 {
constexpr int BM = 256, BK = 64, HALF = 128, HTB = HALF * BK * 2, STAGE_BYTES = 8 * HTB, NXCD = 8, WGM = 8;
__host__ __device__ __forceinline__ int lds_byte(int r, int c) { const int st = (r >> 4) * 2 + (c >> 5), rr = r & 15, cc = c & 31, ob = rr * 64 + cc * 2; return st * 1024 + (ob ^ (((ob >> 9) & 1) << 5)); }
__host__ __device__ __forceinline__ void stage_rc(int b, int& R, int& C) { const int st = b / 1024, sb = b % 1024, swz = sb ^ (((sb >> 9) & 1) << 5); R = (st >> 1) * 16 + swz / 64; C = (st & 1) * 32 + (swz % 64) / 2; }
__host__ __device__ __forceinline__ int perm32(int rho) { const int n = rho >> 4, i = rho & 15; return 8 * (i >> 2) + 4 * n + (i & 3); }

struct Unit { int pm, pn; const char* Ab; const char* Bb; int aux0, aux1; };

struct StaticOrder {
    static constexpr bool GATHER = false;
    int nM, nN, nwg, G, c; const char* A; const char* Bt; int lda, ldb;
    __device__ void init(const bf16* A_, int lda_, const bf16* Bt_, int ldb_, int M, int N, int G_, int c_) { A = (const char*)A_; Bt = (const char*)Bt_; lda = lda_; ldb = ldb_; nM = M / BM; nN = N / BM; nwg = nM * nN; G = G_; c = c_; }
    __device__ __forceinline__ bool next(int i, Unit& u) const {
        const long L = (long)i * G + c; if (L >= nwg) return false;
        int wgid = (int)L; { const int q = nwg / NXCD, r = nwg % NXCD, xcd = wgid % NXCD, off = wgid / NXCD; wgid = (xcd < r ? xcd * (q + 1) : r * (q + 1) + (xcd - r) * q) + off; }
        const int nig = WGM * nN, gid = wgid / nig, fm = gid * WGM, gsz = (nM - fm) < WGM ? (nM - fm) : WGM;
        u.pm = fm + ((wgid % nig) % gsz); u.pn = (wgid % nig) / gsz; u.Ab = A + (size_t)u.pm * BM * lda * 2; u.Bb = Bt + (size_t)u.pn * BM * ldb * 2; u.aux0 = 0; u.aux1 = 0; return true;
    }
    __device__ __forceinline__ unsigned arow(const Unit& u, int r) const { return (unsigned)r; }
};

#define PG8_ACC f32x4 (&acc)[2][2][4][2]
template <class Epi, class Sched>
__device__ __forceinline__ void gemm_phase(LAS unsigned char* lds, const int K, const int lda, const int ldb, const Sched& S, const Epi& E) {
    const int tid = threadIdx.x, wid = __builtin_amdgcn_readfirstlane(tid >> 6), lane = tid & 63, wr = wid >> 2, wc = wid & 3, fr = lane & 15, fq = lane >> 4;
    const int nt = K / BK;
    int sR[2], sC[2]; unsigned voffB[2];
#pragma unroll
    for (int i = 0; i < 2; ++i) { stage_rc(tid * 16 + i * 8192, sR[i], sC[i]); const int Rb = Epi::PERM ? ((sR[i] & ~31) + perm32(sR[i] & 31)) : sR[i];
        voffB[i] = (unsigned)(Rb * ldb + sC[i]) * 2u; }
    const size_t kstep = (size_t)(BK * 2);
    const size_t hstepB = (size_t)HALF * ldb * 2;
    const unsigned ldsw = (unsigned)wid * 1024u;
    const int aoff = lds_byte(wr * 64 + fr, fq * 8), boff = lds_byte(wc * 32 + fr, fq * 8);
#define PG8_SA(b, h) (((b) * 2 + (h)) * HTB)
#define PG8_SB(b, h) ((4 + (b) * 2 + (h)) * HTB)
#define PG8_STAGE(bufoff, gbase, voff) do { _Pragma("unroll") for (int _i = 0; _i < 2; ++_i) \
        __builtin_amdgcn_global_load_lds((const unsigned*)((const char*)(gbase) + (voff)[_i]), (LAS unsigned*)(lds + (bufoff) + ldsw + _i * 8192), 16, 0, 0); } while (0)
#define PG8_LDA(dst, b, h) do { _Pragma("unroll") for (int m = 0; m < 4; ++m) _Pragma("unroll") for (int k = 0; k < 2; ++k) dst[m][k] = *(const LAS bf16x8*)(lds + PG8_SA(b, h) + aoff + m * 2048 + k * 1024); } while (0)
#define PG8_LDB(dst, b, h) do { _Pragma("unroll") for (int n = 0; n < 2; ++n) _Pragma("unroll") for (int k = 0; k < 2; ++k) dst[n][k] = *(const LAS bf16x8*)(lds + PG8_SB(b, h) + boff + n * 2048 + k * 1024); } while (0)
#define PG8_MMA(ai, bj, At, Bt) do { __builtin_amdgcn_s_setprio(1); _Pragma("unroll") for (int m = 0; m < 4; ++m) _Pragma("unroll") for (int n = 0; n < 2; ++n) _Pragma("unroll") for (int k = 0; k < 2; ++k) \
        acc[ai][bj][m][n] = __builtin_amdgcn_mfma_f32_16x16x32_bf16(Bt[n][k], At[m][k], acc[ai][bj][m][n], 0, 0, 0); __builtin_amdgcn_s_setprio(0); } while (0)
#define PG8_WAIT_V(n) asm volatile("s_waitcnt vmcnt(" #n ")" ::: "memory")
#define PG8_WAIT_L(n) asm volatile("s_waitcnt lgkmcnt(" #n ")" ::: "memory")
#define PG8_BAR __builtin_amdgcn_s_barrier()
#define PG8_SCHED __builtin_amdgcn_sched_barrier(0)
#define PG8_SETVA(dst, u) do { _Pragma("unroll") for (int _h = 0; _h < 2; ++_h) _Pragma("unroll") for (int _i = 0; _i < 2; ++_i) \
        dst[_h][_i] = (S.arow(u, _h * HALF + sR[_i]) * (unsigned)lda + (unsigned)sC[_i]) * 2u; } while (0)
    Unit cur, nxt; int ui = 0;
    if (!S.next(0, cur)) return;
    f32x4 acc[2][2][4][2];
#pragma unroll
    for (int a = 0; a < 2; ++a)
#pragma unroll
        for (int b = 0; b < 2; ++b)
#pragma unroll
            for (int m = 0; m < 4; ++m)
#pragma unroll
                for (int n = 0; n < 2; ++n) acc[a][b][m][n] = (f32x4){0.f, 0.f, 0.f, 0.f};
    bf16x8 At[4][2], B0[2][2], B1[2][2];
    constexpr bool GA = Sched::GATHER;
    unsigned vA[2][2], nvA[2][2];
    PG8_SETVA(vA, cur);
    const char* cA = cur.Ab; const char* cB = cur.Bb;
    PG8_STAGE(PG8_SB(0, 0), cB, voffB); PG8_STAGE(PG8_SA(0, 0), cA, vA[0]); PG8_STAGE(PG8_SB(0, 1), cB + hstepB, voffB); PG8_STAGE(PG8_SA(0, 1), cA, vA[1]);
    if (wr == 1) PG8_BAR;
    PG8_WAIT_V(4); PG8_BAR;
    PG8_STAGE(PG8_SB(1, 0), cB + kstep, voffB); PG8_STAGE(PG8_SA(1, 0), cA + kstep, vA[0]); PG8_STAGE(PG8_SB(1, 1), cB + hstepB + kstep, voffB);
    PG8_WAIT_V(6); PG8_BAR;
    for (;;) {
        const bool has_next = S.next(ui + 1, nxt);
        const char* nA = cA; const char* nB = cB;
        if (has_next) { nA = nxt.Ab; nB = nxt.Bb; if (GA) PG8_SETVA(nvA, nxt); }
        else if (GA) {
#pragma unroll
            for (int h = 0; h < 2; ++h)
#pragma unroll
                for (int i = 0; i < 2; ++i) nvA[h][i] = vA[h][i]; }
#pragma unroll 1
        for (int t = 0; t < nt; t += 2) {
            const bool last = (t == nt - 2);
            const char* a1 = cA + (size_t)(t + 1) * kstep;
            const char* a2 = last ? nA : cA + (size_t)(t + 2) * kstep; const char* b2 = last ? nB : cB + (size_t)(t + 2) * kstep;
            const char* a3 = a2 + kstep; const char* b3 = b2 + kstep;
            unsigned s2[2][2];
#pragma unroll
            for (int h = 0; h < 2; ++h)
#pragma unroll
                for (int i = 0; i < 2; ++i) s2[h][i] = (GA && last) ? nvA[h][i] : vA[h][i];
            PG8_LDB(B0, 0, 0); PG8_SCHED; PG8_LDA(At, 0, 0); PG8_STAGE(PG8_SA(1, 1), a1, vA[1]);
            PG8_WAIT_L(8); PG8_BAR; PG8_WAIT_L(0); PG8_MMA(0, 0, At, B0); PG8_BAR; PG8_SCHED;
            PG8_LDB(B1, 0, 1); PG8_STAGE(PG8_SB(0, 0), b2, voffB);
            PG8_BAR; PG8_WAIT_L(0); PG8_MMA(0, 1, At, B1); PG8_BAR;
            PG8_LDA(At, 0, 1); PG8_STAGE(PG8_SA(0, 0), a2, s2[0]);
            PG8_BAR; PG8_WAIT_L(0); PG8_MMA(1, 0, At, B0); PG8_BAR; PG8_SCHED;
            PG8_STAGE(PG8_SB(0, 1), b2 + hstepB, voffB);
            PG8_WAIT_V(6); PG8_BAR; PG8_MMA(1, 1, At, B1); PG8_BAR;
            PG8_LDB(B0, 1, 0); PG8_SCHED; PG8_LDA(At, 1, 0); PG8_STAGE(PG8_SA(0, 1), a2, s2[1]);
            PG8_WAIT_L(8); PG8_BAR; PG8_WAIT_L(0); PG8_MMA(0, 0, At, B0); PG8_BAR; PG8_SCHED;
            PG8_LDB(B1, 1, 1); PG8_STAGE(PG8_SB(1, 0), b3, voffB);
            PG8_BAR; PG8_WAIT_L(0); PG8_MMA(0, 1, At, B1); PG8_BAR;
            PG8_LDA(At, 1, 1); PG8_STAGE(PG8_SA(1, 0), a3, s2[0]);
            PG8_BAR; PG8_WAIT_L(0); PG8_MMA(1, 0, At, B0); PG8_BAR; PG8_SCHED;
            PG8_STAGE(PG8_SB(1, 1), b3 + hstepB, voffB);
            PG8_WAIT_V(6); PG8_BAR; PG8_MMA(1, 1, At, B1); PG8_BAR;
        }
        { int fr_e = fr, fq_e = fq; asm volatile("" : "+v"(fr_e), "+v"(fq_e));
          E(acc, cur, wr, wc, fr_e, fq_e); }
        if (!has_next) break;
#pragma unroll
        for (int a = 0; a < 2; ++a)
#pragma unroll
            for (int b = 0; b < 2; ++b)
#pragma unroll
                for (int m = 0; m < 4; ++m)
#pragma unroll
                    for (int n = 0; n < 2; ++n) acc[a][b][m][n] = (f32x4){0.f, 0.f, 0.f, 0.f};
        cur = nxt; cA = nA; cB = nB; ++ui;
        if (GA) {
#pragma unroll
        for (int h = 0; h < 2; ++h)
#pragma unroll
            for (int i = 0; i < 2; ++i) vA[h][i] = nvA[h][i]; }
    }
    PG8_WAIT_V(0);
    if (wr == 0) PG8_BAR;
    PG8_BAR;
#undef PG8_SA
#undef PG8_SB
#undef PG8_STAGE
#undef PG8_LDA
#undef PG8_LDB
#undef PG8_MMA
#undef PG8_WAIT_V
#undef PG8_WAIT_L
#undef PG8_BAR
#undef PG8_SCHED
#undef PG8_SETVA
}
#define EPI_FOR(ai, m, bj) _Pragma("unroll") for (int ai = 0; ai < 2; ++ai) _Pragma("unroll") for (int m = 0; m < 4; ++m) _Pragma("unroll") for (int bj = 0; bj < 2; ++bj)
__device__ __forceinline__ u32x4 pack8(f32x4 v0, f32x4 v1) { u32x4 w; w.x = cvt_pk_bf16(v0[0], v0[1]); w.y = cvt_pk_bf16(v0[2], v0[3]); w.z = cvt_pk_bf16(v1[0], v1[1]); w.w = cvt_pk_bf16(v1[2], v1[3]); return w; }
}
using pg8::Unit;

struct EpiG1 {
    static constexpr bool PERM = true;
    const float* rstd; bf16 *zmla, *zrkv, *zlora, *zgate;
    __device__ __forceinline__ void operator()(const PG8_ACC, const Unit& u, int wr, int wc, int fr, int fq) const {
        bf16* base; int ld, c0;
        if (u.pn < 4) { base = zmla; ld = ZM_LD; c0 = u.pn * 256; } else if (u.pn < 28) { base = zrkv; ld = ZR_LD; c0 = (u.pn - 4) * 256; }
        else if (u.pn < 31) { base = zlora; ld = ZL_LD; c0 = (u.pn - 28) * 256; } else { base = zgate; ld = ZG_LD; c0 = (u.pn - 31) * 256; }
        const int col0 = c0 + wc * 32 + 8 * fq;
        EPI_FOR(ai, m, bj) { const int row = u.pm * 256 + ai * 128 + wr * 64 + m * 16 + fr; const float rs = rstd[row];
            *(u32x4*)(base + (size_t)row * ld + col0 + bj * 128) = pg8::pack8(acc[ai][bj][m][0] * rs, acc[ai][bj][m][1] * rs); }
    }
};
struct EpiPlain {
    static constexpr bool PERM = true;
    bf16* O; int ld; const float* rstd; float scale;
    __device__ __forceinline__ void operator()(const PG8_ACC, const Unit& u, int wr, int wc, int fr, int fq) const {
        const int col0 = u.pn * 256 + wc * 32 + 8 * fq;
        EPI_FOR(ai, m, bj) { const int row = u.pm * 256 + ai * 128 + wr * 64 + m * 16 + fr; const float rs = (rstd ? rstd[row] : 1.f) * scale;
            *(u32x4*)(O + (size_t)row * ld + col0 + bj * 128) = pg8::pack8(acc[ai][bj][m][0] * rs, acc[ai][bj][m][1] * rs); }
    }
};
constexpr float QSCALE = 0.07216878364870322f * 1.4426950408889634f;
constexpr float CSCALE = 0.08838834764831845f * 1.4426950408889634f;
__device__ __forceinline__ u32x2 pack8_fp8(f32x4 v0, f32x4 v1) {
    int a = __builtin_amdgcn_cvt_pk_fp8_f32(v0[0], v0[1], 0, false); a = __builtin_amdgcn_cvt_pk_fp8_f32(v0[2], v0[3], a, true);
    int b = __builtin_amdgcn_cvt_pk_fp8_f32(v1[0], v1[1], 0, false); b = __builtin_amdgcn_cvt_pk_fp8_f32(v1[2], v1[3], b, true);
    return (u32x2){(unsigned)a, (unsigned)b};
}
struct EpiQ {
    static constexpr bool PERM = true;
    unsigned char* Q; const float* rstd; const float* cs;
    __device__ __forceinline__ void operator()(const PG8_ACC, const Unit& u, int wr, int wc, int fr, int fq) const {
        EPI_FOR(ai, m, bj) { const int row = u.pm * 256 + ai * 128 + wr * 64 + m * 16 + fr; const int col = u.pn * 256 + bj * 128 + wc * 32 + 8 * fq;
            const float rs = rstd[row]; f32x4 v0 = acc[ai][bj][m][0] * rs, v1 = acc[ai][bj][m][1] * rs;
            const int cih = col % QKD;
            if (cih >= NOPE) { const int i0 = (cih - NOPE) >> 1; const f32x4* t = (const f32x4*)(cs + ((size_t)row * 32 + i0) * 2);
                const f32x4 a = t[0], b = t[1];
                f32x4 r0, r1;
                r0[0] = v0[0] * a[0] - v0[1] * a[1]; r0[1] = v0[1] * a[0] + v0[0] * a[1]; r0[2] = v0[2] * a[2] - v0[3] * a[3]; r0[3] = v0[3] * a[2] + v0[2] * a[3];
                r1[0] = v1[0] * b[0] - v1[1] * b[1]; r1[1] = v1[1] * b[0] + v1[0] * b[1]; r1[2] = v1[2] * b[2] - v1[3] * b[3]; r1[3] = v1[3] * b[2] + v1[2] * b[3];
                v0 = r0; v1 = r1; }
            *(u32x2*)(Q + (size_t)row * (MH * QKD) + col) = pack8_fp8(v0, v1); }
    }
};
struct EpiKV {
    static constexpr bool PERM = true;
    unsigned char* Kb; bf16* Vb; const float* rstd;
    __device__ __forceinline__ void operator()(const PG8_ACC, const Unit& u, int wr, int wc, int fr, int fq) const {
        const int c = wc * 32 + 8 * fq;
        EPI_FOR(ai, m, bj) { const int row = u.pm * 256 + ai * 128 + wr * 64 + m * 16 + fr; const float rs = rstd[row];
            if (bj == 0) *(u32x2*)(Kb + (size_t)row * (MH * QKD) + u.pn * QKD + c) = pack8_fp8(acc[ai][bj][m][0] * rs, acc[ai][bj][m][1] * rs);
            else *(u32x4*)(Vb + (size_t)row * (MH * VDIM) + u.pn * VDIM + c) = pg8::pack8(acc[ai][bj][m][0] * rs, acc[ai][bj][m][1] * rs); }
    }
};
template <int MODE> struct EpiLora {
    static constexpr bool PERM = true;
    bf16* O; const float* bias;
    __device__ __forceinline__ void operator()(const PG8_ACC, const Unit& u, int wr, int wc, int fr, int fq) const {
        EPI_FOR(ai, m, bj) { const int row = u.pm * 256 + ai * 128 + wr * 64 + m * 16 + fr; const int col = u.pn * 256 + bj * 128 + wc * 32 + 8 * fq;
            f32x4 v0 = acc[ai][bj][m][0], v1 = acc[ai][bj][m][1];
            if (MODE != 2) { const f32x4 b0 = *(const f32x4*)(bias + col), b1 = *(const f32x4*)(bias + col + 4);
#pragma unroll
                for (int j = 0; j < 4; ++j) { float s0 = sigmoidf_(v0[j] + b0[j]), s1 = sigmoidf_(v1[j] + b1[j]);
                    if (MODE == 0) { s0 *= -0.8750394f; s1 *= -0.8750394f; }
                    v0[j] = s0; v1[j] = s1; } }
            *(u32x4*)(O + (size_t)row * RW + col) = pg8::pack8(v0, v1); }
    }
};
template <int MODE> struct EpiLora2 {
    static constexpr bool PERM = true;
    bf16* O0; bf16* O1; const float* bias0; const float* bias1;
    __device__ __forceinline__ void operator()(const PG8_ACC, const Unit& u, int wr, int wc, int fr, int fq) const {
        const bool second = u.pn >= 8; bf16* O = second ? O1 : O0; const float* bias = second ? bias1 : bias0; const int pn = second ? u.pn - 8 : u.pn;
        EPI_FOR(ai, m, bj) { const int row = u.pm * 256 + ai * 128 + wr * 64 + m * 16 + fr; const int col = pn * 256 + bj * 128 + wc * 32 + 8 * fq;
            f32x4 v0 = acc[ai][bj][m][0], v1 = acc[ai][bj][m][1];
            const f32x4 b0 = *(const f32x4*)(bias + col), b1 = *(const f32x4*)(bias + col + 4);
#pragma unroll
            for (int j = 0; j < 4; ++j) { float s0 = sigmoidf_(v0[j] + b0[j]), s1 = sigmoidf_(v1[j] + b1[j]);
                if (MODE == 0) { s0 *= -0.8750394f; s1 *= -0.8750394f; }
                v0[j] = s0; v1[j] = s1; }
            *(u32x4*)(O + (size_t)row * RW + col) = pg8::pack8(v0, v1); }
    }
};
template <int SECOND> struct EpiUp {
    static constexpr bool PERM = true;
    bf16* O; const bf16* zg; int goff;
    __device__ __forceinline__ void operator()(const PG8_ACC, const Unit& u, int wr, int wc, int fr, int fq) const {
        EPI_FOR(ai, m, bj) { const int row = u.pm * 256 + ai * 128 + wr * 64 + m * 16 + fr; const int col = u.pn * 256 + bj * 128 + wc * 32 + 8 * fq;
            const u32x4 g = *(const u32x4*)(zg + (size_t)row * ZG_LD + goff + col);
            f32x4 v0 = acc[ai][bj][m][0], v1 = acc[ai][bj][m][1];
            v0[0] *= sigmoidf_(bflo(g.x)); v0[1] *= sigmoidf_(bfhi(g.x)); v0[2] *= sigmoidf_(bflo(g.y)); v0[3] *= sigmoidf_(bfhi(g.y));
            v1[0] *= sigmoidf_(bflo(g.z)); v1[1] *= sigmoidf_(bfhi(g.z)); v1[2] *= sigmoidf_(bflo(g.w)); v1[3] *= sigmoidf_(bfhi(g.w));
            bf16* dst = O + (size_t)row * DM + col;
            if (SECOND) { const u32x4 p = *(const u32x4*)dst;
                v0[0] += bflo(p.x); v0[1] += bfhi(p.x); v0[2] += bflo(p.y); v0[3] += bfhi(p.y); v1[0] += bflo(p.z); v1[1] += bfhi(p.z); v1[2] += bflo(p.w); v1[3] += bfhi(p.w); }
            *(u32x4*)dst = pg8::pack8(v0, v1); }
    }
};
struct EpiResid {
    static constexpr bool PERM = true;
    const float* base; float* out;
    __device__ __forceinline__ void operator()(const PG8_ACC, const Unit& u, int wr, int wc, int fr, int fq) const {
        EPI_FOR(ai, m, bj) { const int row = u.pm * 256 + ai * 128 + wr * 64 + m * 16 + fr; const int col = u.pn * 256 + bj * 128 + wc * 32 + 8 * fq;
            const size_t o = (size_t)row * DM + col; const f32x4 b0 = *(const f32x4*)(base + o), b1 = *(const f32x4*)(base + o + 4);
            *(f32x4*)(out + o) = b0 + acc[ai][bj][m][0]; *(f32x4*)(out + o + 4) = b1 + acc[ai][bj][m][1]; }
    }
};

namespace att {
constexpr int NW = 8, QBLK = 32, KVBLK = 64;
constexpr float THRL = 11.5f;
#define SBAR() __builtin_amdgcn_sched_barrier(0)
__device__ __forceinline__ int crow(int r, int hi) { return (r & 3) + 8 * (r >> 2) + 4 * hi; }
template <bool SCALED = false> __device__ __forceinline__ void partialSM(f32x16& p, float& m_reg, float& alpha, const float sc = 1.f) {
    float pmax = p[0];
#pragma unroll
    for (int r = 1; r < 16; ++r) pmax = fmaxf(pmax, p[r]);
    { auto rr = __builtin_amdgcn_permlane32_swap(__float_as_uint(pmax), __float_as_uint(pmax), false, false);
      pmax = fmaxf(__uint_as_float(rr[0]), __uint_as_float(rr[1])); }
    if (SCALED) pmax *= sc;
    float mn;
    if (__builtin_expect(__all(pmax - m_reg <= THRL), 1)) { mn = m_reg; alpha = 1.f; }
    else { mn = fmaxf(m_reg, pmax); alpha = __builtin_amdgcn_exp2f(m_reg - mn); m_reg = mn; }
#pragma unroll
    for (int r = 0; r < 16; ++r) p[r] = SCALED ? __builtin_fmaf(p[r], sc, -mn) : p[r] - mn;
#pragma unroll
    for (int r = 0; r < 8; ++r) p[r] = __builtin_amdgcn_exp2f(p[r]);
}
__device__ __forceinline__ void finishSM(f32x16& p, float alpha, float& l_reg, bf16x8& pa0, bf16x8& pa1) {
#pragma unroll
    for (int r = 8; r < 16; ++r) p[r] = __builtin_amdgcn_exp2f(p[r]);
    float ps = 0;
#pragma unroll
    for (int r = 0; r < 16; ++r) ps += p[r];
    { auto rr = __builtin_amdgcn_permlane32_swap(__float_as_uint(ps), __float_as_uint(ps), false, false);
      ps = __uint_as_float(rr[0]) + __uint_as_float(rr[1]); }
    l_reg = l_reg * alpha + ps;
#define PK4(P, BASE, OUT) do { unsigned a0 = cvt_pk_bf16(P[BASE + 0], P[BASE + 1]), a1 = cvt_pk_bf16(P[BASE + 2], P[BASE + 3]);   \
    unsigned b0 = cvt_pk_bf16(P[BASE + 4], P[BASE + 5]), b1 = cvt_pk_bf16(P[BASE + 6], P[BASE + 7]);                              \
    auto r0 = __builtin_amdgcn_permlane32_swap(a0, b0, false, false); auto r1 = __builtin_amdgcn_permlane32_swap(a1, b1, false, false); \
    u32x4 w = {r0[0], r1[0], r0[1], r1[1]}; OUT = *reinterpret_cast<bf16x8*>(&w); } while (0)
    PK4(p, 0, pa0); PK4(p, 8, pa1);
#undef PK4
}
template <int DQK> __device__ __forceinline__ int kswz(int row, int colB) { return row * (DQK * 2 + 16) + colB; }
template <int DQK> __device__ __forceinline__ void qkt(f32x16& p, const LAS char* Ks, const bf16x8* qr, int krow, int hi) {
    p = f32x16{};
#pragma unroll
    for (int d0 = 0; d0 < DQK / 16; ++d0) { const int cb = (d0 * 16 + hi * 8) * 2;
        bf16x8 b0 = *reinterpret_cast<const LAS bf16x8*>(Ks + kswz<DQK>(krow, cb));
        p = __builtin_amdgcn_mfma_f32_32x32x16_bf16(b0, qr[d0], p, 0, 0, 0); }
}
__device__ __forceinline__ int v_st(int k, int c) { const int kk = (k & ~0xC) | ((k & 4) << 1) | ((k & 8) >> 1); return ((kk >> 3) * 4 + (c >> 5)) * 512 + ((kk & 7) * 32 + (c & 31)) * 2; }
__device__ __forceinline__ int v_rd_base(int lane) { return ((lane & 3) << 3) | (((lane >> 2) & 3) << 6) | (((lane >> 4) & 1) << 5) | (((lane >> 5) & 1) << 8); }
constexpr int v_rd_off(int d0, int ks, int half) { return d0 * 512 + ks * 4096 + half * 2048; }
template <int OFF> __device__ __forceinline__ s16x4 tr_read(int vb) {
    s16x4 r; asm volatile("ds_read_b64_tr_b16 %0, %1 offset:%2" : "=&v"(r) : "v"(vb), "i"(OFF) : "memory"); return r;
}
template <int D0, int KH> __device__ __forceinline__ void pv_one(f32x16& od, int vb, bf16x8 pa0, bf16x8 pa1) {
    const s16x4 l0 = tr_read<v_rd_off(D0, 2 * KH, 0)>(vb), h0 = tr_read<v_rd_off(D0, 2 * KH, 1)>(vb), l1 = tr_read<v_rd_off(D0, 2 * KH + 1, 0)>(vb), h1 = tr_read<v_rd_off(D0, 2 * KH + 1, 1)>(vb);
    asm volatile("s_waitcnt lgkmcnt(0)" ::: "memory"); SBAR();
#define PK(L, H) (bf16x8){L[0], L[1], L[2], L[3], H[0], H[1], H[2], H[3]}
    od = __builtin_amdgcn_mfma_f32_32x32x16_bf16(pa0, PK(l0, h0), od, 0, 0, 0);
    od = __builtin_amdgcn_mfma_f32_32x32x16_bf16(pa1, PK(l1, h1), od, 0, 0, 0);
#undef PK
}
template <int KH> __device__ __forceinline__ void pv_d0(f32x16* o, int vb, bf16x8 pa0, bf16x8 pa1) {
    pv_one<0, KH>(o[0], vb, pa0, pa1); pv_one<1, KH>(o[1], vb, pa0, pa1); pv_one<2, KH>(o[2], vb, pa0, pa1); pv_one<3, KH>(o[3], vb, pa0, pa1);
}
template <int DQK, int LDQ, int LDK, int LDV, int LDO>
__device__ __forceinline__ void attn_unit(const bf16* __restrict__ Qb, const bf16* __restrict__ Kh, const bf16* __restrict__ Vh, bf16* __restrict__ Ob, const int seq, LAS char* lds) {
    constexpr int SHM_V = KVBLK * 128 * 2, SHM_K = KVBLK * (DQK * 2 + 16), KCH = DQK / 64;
    const int tid = threadIdx.x, wid = tid >> 6, lane = tid & 63, r32 = lane & 31, hi = lane >> 5;
    LAS char* V_lds = lds; LAS char* K_lds = lds + 2 * SHM_V;
    LAS float* wsf = (LAS float*)(lds + 2 * SHM_V + 2 * SHM_K) + wid * 64; LAS float* li_l = wsf; LAS float* al_l = wsf + 32;
    float m_reg = -1e30f, l_reg = 0; f32x16 o[4] = {}; bf16x8 qr[DQK / 16];
    const bf16* Qw = Qb + (long)(wid * QBLK + r32) * LDQ + hi * 8;
#pragma unroll
    for (int d0 = 0; d0 < DQK / 16; ++d0) qr[d0] = *reinterpret_cast<const bf16x8*>(Qw + d0 * 16);
    const int sr = tid >> 4, sc = (tid & 15) * 8, vst0 = v_st(sr, sc), vst1 = v_st(32 + sr, sc);
    unsigned kgo[KCH]; int klo[KCH];
#pragma unroll
    for (int i = 0; i < KCH; ++i) { const int id = tid + 512 * i, row = id / (DQK / 8), c8 = id % (DQK / 8); kgo[i] = (unsigned)(row * LDK + c8 * 8) * 2u; klo[i] = kswz<DQK>(row, c8 * 16); }
    const unsigned vgo0 = (unsigned)(sr * LDV + sc) * 2u, vgo1 = (unsigned)((32 + sr) * LDV + sc) * 2u;
    const int vb0 = (int)(uintptr_t)V_lds + v_rd_base(lane);
    bf16x8 vs0, vs1, ks[KCH];
#define SLOAD(k0) do { const char* _vt = (const char*)(Vh + (size_t)(k0) * LDV); const char* _kt = (const char*)(Kh + (size_t)(k0) * LDK); \
    vs0 = *reinterpret_cast<const bf16x8*>(_vt + vgo0); vs1 = *reinterpret_cast<const bf16x8*>(_vt + vgo1); \
    _Pragma("unroll") for (int _i = 0; _i < KCH; ++_i) ks[_i] = *reinterpret_cast<const bf16x8*>(_kt + kgo[_i]); } while (0)
#define SWRITE(b) do { *(LAS bf16x8*)(V_lds + (b) * SHM_V + vst0) = vs0; *(LAS bf16x8*)(V_lds + (b) * SHM_V + vst1) = vs1; \
    _Pragma("unroll") for (int _i = 0; _i < KCH; ++_i) *(LAS bf16x8*)(K_lds + (b) * SHM_K + klo[_i]) = ks[_i]; } while (0)
#define SWAIT() asm volatile("s_waitcnt vmcnt(0)" ::: "memory")
#define RESC(a) do { if (__any((a) < 1.f)) { if (hi == 0) al_l[r32] = (a); asm volatile("s_waitcnt lgkmcnt(0)" ::: "memory"); \
    _Pragma("unroll") for (int d = 0; d < 4; ++d) _Pragma("unroll") for (int r = 0; r < 16; ++r) o[d][r] *= al_l[crow(r, hi)]; } } while (0)
    f32x16 pA, pB; float alA, alB; bf16x8 pa0, pa1; const int NT = seq / KVBLK;
    SLOAD(0); SWAIT(); SWRITE(0); __syncthreads();
    if (1 < NT) SLOAD(KVBLK);
    qkt<DQK>(pA, K_lds, qr, r32, hi); partialSM(pA, m_reg, alA);
    if (1 < NT) { SWAIT(); SWRITE(1); } __syncthreads();
    if (2 < NT) SLOAD(2 * KVBLK);
    SBAR(); qkt<DQK>(pB, K_lds, qr, 32 + r32, hi);
    finishSM(pA, alA, l_reg, pa0, pa1); SBAR();
    pv_d0<0>(o, vb0, pa0, pa1); partialSM(pB, m_reg, alB); RESC(alB);
    for (int j = 1; j < NT; ++j) {
        const int cb = j & 1, pb = cb ^ 1;
        SBAR(); qkt<DQK>(pA, K_lds + cb * SHM_K, qr, r32, hi);
        finishSM(pB, alB, l_reg, pa0, pa1); SBAR();
        pv_d0<1>(o, vb0 + pb * SHM_V, pa0, pa1); partialSM(pA, m_reg, alA);
        __syncthreads(); if (j + 1 < NT) { SWAIT(); SWRITE(pb); }
        RESC(alA); __syncthreads();
        if (j + 2 < NT) SLOAD((j + 2) * KVBLK);
        SBAR(); qkt<DQK>(pB, K_lds + cb * SHM_K, qr, 32 + r32, hi);
        finishSM(pA, alA, l_reg, pa0, pa1); SBAR();
        pv_d0<0>(o, vb0 + cb * SHM_V, pa0, pa1); partialSM(pB, m_reg, alB); RESC(alB);
    }
    finishSM(pB, alB, l_reg, pa0, pa1); SBAR();
    pv_d0<1>(o, vb0 + ((NT - 1) & 1) * SHM_V, pa0, pa1);
    if (hi == 0) li_l[r32] = l_reg; asm volatile("s_waitcnt lgkmcnt(0)" ::: "memory");
    float rli[16];
#pragma unroll
    for (int r = 0; r < 16; ++r) rli[r] = __builtin_amdgcn_rcpf(li_l[crow(r, hi)]);
    bf16* Ow = Ob + (size_t)(wid * QBLK) * LDO;
    int r32e = r32, hie = hi; asm volatile("" : "+v"(r32e), "+v"(hie));
    const unsigned ob = (unsigned)(4 * hie * LDO + r32e);
#pragma unroll
    for (int r = 0; r < 16; ++r) {
#pragma unroll
        for (int d0 = 0; d0 < 4; ++d0) Ow[ob + (unsigned)(((r & 3) + 8 * (r >> 2)) * LDO + d0 * 32)] = f2bf(o[d0][r] * rli[r]); }
    __syncthreads();
#undef SLOAD
#undef SWRITE
#undef SWAIT
#undef RESC
}
typedef int i32x8 __attribute__((ext_vector_type(8)));
__device__ __forceinline__ void qkt_f8(f32x16& p, const LAS char* Ks, const i32x8* qr, int krow, int hi) {
    p = f32x16{};
#pragma unroll
    for (int d0 = 0; d0 < 3; ++d0) { const LAS char* a = Ks + krow * 208 + d0 * 64 + hi * 32;
        const u32x4 lo = *reinterpret_cast<const LAS u32x4*>(a), hh = *reinterpret_cast<const LAS u32x4*>(a + 16);
        const i32x8 av = {(int)lo.x, (int)lo.y, (int)lo.z, (int)lo.w, (int)hh.x, (int)hh.y, (int)hh.z, (int)hh.w};
        p = __builtin_amdgcn_mfma_scale_f32_32x32x64_f8f6f4(av, qr[d0], p, 0, 0, 0, 0, 0, 0); }
}
template <int LDQ, int LDK, int LDV, int LDO>
__device__ __forceinline__ void attn_unit_f8(const unsigned char* __restrict__ Qb, const unsigned char* __restrict__ Kh, const bf16* __restrict__ Vh, bf16* __restrict__ Ob, const int seq, const float SC, LAS char* lds) {
    constexpr int SHM_V = KVBLK * 128 * 2, SHM_K = KVBLK * 208;
    const int tid = threadIdx.x, wid = tid >> 6, lane = tid & 63, r32 = lane & 31, hi = lane >> 5;
    LAS char* V_lds = lds; LAS char* K_lds = lds + 2 * SHM_V;
    LAS float* wsf = (LAS float*)(lds + 2 * SHM_V + 2 * SHM_K) + wid * 64; LAS float* li_l = wsf; LAS float* al_l = wsf + 32;
    float m_reg = -1e30f, l_reg = 0; f32x16 o[4] = {}; i32x8 qr[3];
    { const unsigned char* Qw = Qb + (long)(wid * QBLK + r32) * LDQ + hi * 32;
#pragma unroll
      for (int d0 = 0; d0 < 3; ++d0) { const u32x4 lo = *reinterpret_cast<const u32x4*>(Qw + d0 * 64), hh = *reinterpret_cast<const u32x4*>(Qw + d0 * 64 + 16);
          qr[d0] = (i32x8){(int)lo.x, (int)lo.y, (int)lo.z, (int)lo.w, (int)hh.x, (int)hh.y, (int)hh.z, (int)hh.w}; } }
    const int sr = tid >> 4, sc = (tid & 15) * 8, vst0 = v_st(sr, sc), vst1 = v_st(32 + sr, sc);
    const bool k2 = wid < 4;
    const int id0 = tid, id1 = 512 + tid;
    const unsigned kgo0 = (unsigned)((id0 / 12) * LDK + (id0 % 12) * 16), kgo1 = (unsigned)((id1 / 12) * LDK + (id1 % 12) * 16);
    const int klo0 = (id0 / 12) * 208 + (id0 % 12) * 16, klo1 = (id1 / 12) * 208 + (id1 % 12) * 16;
    const unsigned vgo0 = (unsigned)(sr * LDV + sc) * 2u, vgo1 = (unsigned)((32 + sr) * LDV + sc) * 2u;
    const int vb0 = (int)(uintptr_t)V_lds + v_rd_base(lane);
    bf16x8 vs0, vs1; u32x4 ks0, ks1 = {0u, 0u, 0u, 0u};
#define SLOAD(k0) do { const char* _vt = (const char*)(Vh + (size_t)(k0) * LDV); const unsigned char* _kt = Kh + (size_t)(k0) * LDK; \
    vs0 = *reinterpret_cast<const bf16x8*>(_vt + vgo0); vs1 = *reinterpret_cast<const bf16x8*>(_vt + vgo1); \
    ks0 = *reinterpret_cast<const u32x4*>(_kt + kgo0); if (k2) ks1 = *reinterpret_cast<const u32x4*>(_kt + kgo1); } while (0)
#define SWRITE(b) do { *(LAS bf16x8*)(V_lds + (b) * SHM_V + vst0) = vs0; *(LAS bf16x8*)(V_lds + (b) * SHM_V + vst1) = vs1; \
    *(LAS u32x4*)(K_lds + (b) * SHM_K + klo0) = ks0; if (k2) *(LAS u32x4*)(K_lds + (b) * SHM_K + klo1) = ks1; } while (0)
#define SWAIT() asm volatile("s_waitcnt vmcnt(0)" ::: "memory")
#define RESC(a) do { if (__any((a) < 1.f)) { if (hi == 0) al_l[r32] = (a); asm volatile("s_waitcnt lgkmcnt(0)" ::: "memory"); \
    _Pragma("unroll") for (int d = 0; d < 4; ++d) _Pragma("unroll") for (int r = 0; r < 16; ++r) o[d][r] *= al_l[crow(r, hi)]; } } while (0)
    f32x16 pA, pB; float alA, alB; bf16x8 pa0, pa1; const int NT = seq / KVBLK;
    SLOAD(0); SWAIT(); SWRITE(0); __syncthreads();
    if (1 < NT) SLOAD(KVBLK);
    qkt_f8(pA, K_lds, qr, r32, hi); partialSM<true>(pA, m_reg, alA, SC);
    if (1 < NT) { SWAIT(); SWRITE(1); } __syncthreads();
    if (2 < NT) SLOAD(2 * KVBLK);
    SBAR(); qkt_f8(pB, K_lds, qr, 32 + r32, hi);
    finishSM(pA, alA, l_reg, pa0, pa1); SBAR();
    pv_d0<0>(o, vb0, pa0, pa1); partialSM<true>(pB, m_reg, alB, SC); RESC(alB);
    for (int j = 1; j < NT; ++j) {
        const int cb = j & 1, pb = cb ^ 1;
        SBAR(); qkt_f8(pA, K_lds + cb * SHM_K, qr, r32, hi);
        finishSM(pB, alB, l_reg, pa0, pa1); SBAR();
        pv_d0<1>(o, vb0 + pb * SHM_V, pa0, pa1); partialSM<true>(pA, m_reg, alA, SC);
        __syncthreads(); if (j + 1 < NT) { SWAIT(); SWRITE(pb); }
        RESC(alA); __syncthreads();
        if (j + 2 < NT) SLOAD((j + 2) * KVBLK);
        SBAR(); qkt_f8(pB, K_lds + cb * SHM_K, qr, 32 + r32, hi);
        finishSM(pA, alA, l_reg, pa0, pa1); SBAR();
        pv_d0<0>(o, vb0 + cb * SHM_V, pa0, pa1); partialSM<true>(pB, m_reg, alB, SC); RESC(alB);
    }
    finishSM(pB, alB, l_reg, pa0, pa1); SBAR();
    pv_d0<1>(o, vb0 + ((NT - 1) & 1) * SHM_V, pa0, pa1);
    if (hi == 0) li_l[r32] = l_reg; asm volatile("s_waitcnt lgkmcnt(0)" ::: "memory");
    float rli[16];
#pragma unroll
    for (int r = 0; r < 16; ++r) rli[r] = __builtin_amdgcn_rcpf(li_l[crow(r, hi)]);
    bf16* Ow = Ob + (size_t)(wid * QBLK) * LDO;
    int r32e = r32, hie = hi; asm volatile("" : "+v"(r32e), "+v"(hie));
    const unsigned ob = (unsigned)(4 * hie * LDO + r32e);
#pragma unroll
    for (int r = 0; r < 16; ++r) {
#pragma unroll
        for (int d0 = 0; d0 < 4; ++d0) Ow[ob + (unsigned)(((r & 3) + 8 * (r >> 2)) * LDO + d0 * 32)] = f2bf(o[d0][r] * rli[r]); }
    __syncthreads();
#undef SLOAD
#undef SWRITE
#undef SWAIT
#undef RESC
}
__device__ __forceinline__ float f8_map_probe(const int lane) {
    const int r = lane & 31, h = lane >> 5;
    const float am = 1.f + (float)((r >> 2) & 1), bm = 1.f + (float)((r >> 3) & 1);
    i32x8 a, b;
#pragma unroll
    for (int w = 0; w < 8; ++w) { const int k0 = 32 * h + 4 * w; int pa = 0, pb = 0;
        pa = __builtin_amdgcn_cvt_pk_fp8_f32((float)((k0 + 0) & 7) * am, (float)((k0 + 1) & 7) * am, pa, false); pa = __builtin_amdgcn_cvt_pk_fp8_f32((float)((k0 + 2) & 7) * am, (float)((k0 + 3) & 7) * am, pa, true);
        pb = __builtin_amdgcn_cvt_pk_fp8_f32((float)((3 * (k0 + 0) + 1) % 7) * bm, (float)((3 * (k0 + 1) + 1) % 7) * bm, pb, false); pb = __builtin_amdgcn_cvt_pk_fp8_f32((float)((3 * (k0 + 2) + 1) % 7) * bm, (float)((3 * (k0 + 3) + 1) % 7) * bm, pb, true);
        a[w] = pa; b[w] = pb; }
    f32x16 d = {};
    d = __builtin_amdgcn_mfma_scale_f32_32x32x64_f8f6f4(a, b, d, 0, 0, 0, 0, 0, 0);
    float e0 = 0.f;
    for (int k = 0; k < 64; ++k) e0 += (float)(k & 7) * (float)((3 * k + 1) % 7);
    float err = 0.f;
#pragma unroll
    for (int rr = 0; rr < 16; ++rr) { const int row = crow(rr, h), col = r; const float ex = e0 * (1.f + (float)((row >> 2) & 1)) * (1.f + (float)((col >> 3) & 1)); err = fmaxf(err, fabsf(d[rr] - ex)); }
#pragma unroll
    for (int o = 32; o >= 1; o >>= 1) err = fmaxf(err, __shfl_xor(err, o));
    return err;
}
}

struct Frame {
    LAS unsigned char* lds; volatile LAS unsigned* MISC; unsigned* ctl;
    int tid, lane, wave, vcu, G;
    unsigned char* ws; float* out;
    const float* in[41];
};
enum { I_X = 0, I_MEM, I_POS, I_GMIX, I_WIN, I_GQ, I_WUQ, I_GKV, I_WUKV, I_SHIFT, I_W0F, I_W2F, I_W0B, I_W2B, I_A0F, I_A2F, I_A0B, I_A2B, I_G2, I_KK, I_KA, I_RK,
       I_LNXG, I_LNXB, I_WUPM, I_WUPR, I_WOUT, I_GCROSS, I_GMEM, I_WQC, I_WKVC, I_WOC, I_GFFN, I_WRG, I_BRG, I_WRE, I_BRE, I_WEG, I_WEU, I_WED, I_GFINAL };

template <int MODE> __device__ __forceinline__ int rowmap(int n) {
    if (MODE == 1) {
        if (n < 768) return n;
        if (n < 832) { const int p = n - 768; return 768 + (p < 32 ? 2 * p : 2 * (p - 32) + 1); }
        if (n < 6976) return 1024 + (n - 832);
        if (n < 7616) return 7168 + (n - 6976);
        return 7936 + (n - 7616);
    }
    if (MODE == 2) {
        const int h = n / QKD, d = n % QKD; if (d < NOPE) return n; const int p = d - NOPE; return h * QKD + NOPE + (p < 32 ? 2 * p : 2 * (p - 32) + 1);
    }
    if (MODE == 3) return (n >> 7) * 256 + (n & 127);
    if (MODE == 4) return (n >> 7) * 256 + 128 + (n & 127);
    return n;
}
constexpr int CVT_SCR = 16640;
template <int MODE> __device__ __forceinline__ void cvt_item(const float* W, int K, int N, const float* gain, bf16* WT, int ldt, LAS float* scr, int item, int lane, int kofs = 0) {
    const int nblk = N / 64, kb = item / nblk, nb = item % nblk, k0 = 64 * kb, n0 = 64 * nb;
    const int kq = lane >> 4, nc = (lane & 15) * 4;
    f32x4 v[16];
#pragma unroll
    for (int i = 0; i < 16; ++i) { const int k = k0 + 4 * i + kq - kofs; v[i] = (f32x4){0.f, 0.f, 0.f, 0.f};
        if (k >= 0 && k < K) { v[i] = *(const f32x4*)(W + (size_t)k * N + n0 + nc); if (gain) v[i] = v[i] * gain[k]; } }
#pragma unroll
    for (int i = 0; i < 16; ++i) { const int kk = 4 * i + kq;
#pragma unroll
        for (int c = 0; c < 4; ++c) scr[(nc + c) * 65 + kk] = v[i][c]; }
    LDS_WAIT(); asm volatile("" ::: "memory");
    const int kc = (lane & 7) * 8;
#pragma unroll
    for (int jj = 0; jj < 8; ++jj) { const int n = (lane >> 3) + 8 * jj; const LAS float* s = scr + n * 65 + kc;
        u32x4 o; o.x = cvt_pk_bf16(s[0], s[1]); o.y = cvt_pk_bf16(s[2], s[3]); o.z = cvt_pk_bf16(s[4], s[5]); o.w = cvt_pk_bf16(s[6], s[7]);
        *(u32x4*)(WT + (size_t)rowmap<MODE>(n0 + n) * ldt + k0 + kc) = o; }
    LDS_WAIT(); asm volatile("" ::: "memory");
}
#define CVT_JOB(MODE, src, K, N, gain, dst, ldt) { const int _n = (((K) + 63) / 64) * ((N) / 64); if (r < _n) { cvt_item<MODE>(src, K, N, gain, dst, ldt, scr, r, F.lane); continue; } r -= _n; }
#define CVT_JOB_PAD(src, K, N, dst, KPAD, KOFS) { const int _n = ((KPAD) / 64) * ((N) / 64); if (r < _n) { cvt_item<0>(src, K, N, nullptr, dst, KPAD, scr, r, F.lane, KOFS); continue; } r -= _n; }
struct CvtD { const float* W; const float* gain; bf16* WT; int K, N, ldt, mode, kofs, item; };
__device__ __forceinline__ int rowmap_rt(int mode, int n) { return mode == 1 ? rowmap<1>(n) : mode == 2 ? rowmap<2>(n) : mode == 3 ? rowmap<3>(n) : mode == 4 ? rowmap<4>(n) : n; }
__device__ __forceinline__ void cvt_load(const CvtD& d, int lane, f32x4 (&v)[16], float (&g)[16]) {
    const int nblk = d.N / 64, kb = d.item / nblk, nb = d.item % nblk, k0 = 64 * kb, n0 = 64 * nb; const int kq = lane >> 4, nc = (lane & 15) * 4;
#pragma unroll
    for (int i = 0; i < 16; ++i) { const int k = k0 + 4 * i + kq - d.kofs; v[i] = (f32x4){0.f, 0.f, 0.f, 0.f}; g[i] = 1.f;
        if (k >= 0 && k < d.K) { v[i] = *(const f32x4*)(d.W + (size_t)k * d.N + n0 + nc); if (d.gain) g[i] = d.gain[k]; } }
}
__device__ __forceinline__ void cvt_process(const CvtD& d, int lane, f32x4 (&v)[16], float (&g)[16], LAS float* scr) {
    const int nblk = d.N / 64, kb = d.item / nblk, nb = d.item % nblk, k0 = 64 * kb, n0 = 64 * nb; const int kq = lane >> 4, nc = (lane & 15) * 4;
#pragma unroll
    for (int i = 0; i < 16; ++i) { const int kk = 4 * i + kq;
#pragma unroll
        for (int c = 0; c < 4; ++c) scr[(nc + c) * 65 + kk] = v[i][c] * g[i]; }
    LDS_WAIT(); asm volatile("" ::: "memory");
    const int kc = (lane & 7) * 8;
#pragma unroll
    for (int jj = 0; jj < 8; ++jj) { const int n = (lane >> 3) + 8 * jj; const LAS float* s = scr + n * 65 + kc;
        u32x4 o; o.x = cvt_pk_bf16(s[0], s[1]); o.y = cvt_pk_bf16(s[2], s[3]); o.z = cvt_pk_bf16(s[4], s[5]); o.w = cvt_pk_bf16(s[6], s[7]);
        *(u32x4*)(d.WT + (size_t)rowmap_rt(d.mode, n0 + n) * d.ldt + k0 + kc) = o; }
    LDS_WAIT(); asm volatile("" ::: "memory");
}
#define CVT_PIPE(TOTAL_, DESC_) do { CvtD dA, dB; f32x4 vA[16], vB[16]; float gA[16], gB[16]; int it = gw; \
        if (it < (TOTAL_)) { DESC_(it, dA); cvt_load(dA, F.lane, vA, gA); } \
        for (; it < (TOTAL_); it += 2 * NGW) { const int itn = it + NGW, itn2 = it + 2 * NGW; \
            if (itn < (TOTAL_)) { DESC_(itn, dB); cvt_load(dB, F.lane, vB, gB); } \
            cvt_process(dA, F.lane, vA, gA, scr); \
            if (itn2 < (TOTAL_)) { DESC_(itn2, dA); cvt_load(dA, F.lane, vA, gA); } \
            if (itn < (TOTAL_)) cvt_process(dB, F.lane, vB, gB, scr); } } while (0)

__device__ __forceinline__ void p0_prologue(Frame& F) {
    LAS float* scr = (LAS float*)(F.lds + F.wave * CVT_SCR);
    const int gw = F.vcu * 8 + F.wave, NGW = F.G * 8;
    unsigned char* ws = F.ws;
    constexpr int TOTAL = 32 * (IN_W / 64) + 8 * 48 + 4 * 64 + 4 * (4 * 32) + 4 * 32 + 3 * (32 * 32) + 32 * 8 + 32 * 16 + 8 * 32;
#define P0_SETD(d, mode_, src_, K_, N_, gain_, dst_, ldt_, KPAD_, KOFS_) { const int _n = ((KPAD_) / 64) * ((N_) / 64); if (r < _n) { d.W = src_; d.gain = gain_; d.WT = dst_; d.K = K_; d.N = N_; d.ldt = ldt_; d.mode = mode_; d.kofs = KOFS_; d.item = r; break; } r -= _n; }
#define P0_DESC(it_, d) do { int r = (it_); \
        P0_SETD(d, 1, F.in[I_WIN], DM, IN_W, F.in[I_GMIX], (bf16*)(ws + WS_WIN), DM, DM, 0) \
        P0_SETD(d, 2, F.in[I_WUQ], QLORA, MH * QKD, F.in[I_GQ], (bf16*)(ws + WS_WUQ), QLORA, QLORA, 0) \
        P0_SETD(d, 0, F.in[I_WUKV], KVLORA, MH * 256, F.in[I_GKV], (bf16*)(ws + WS_WUKV), KVLORA, KVLORA, 0) \
        P0_SETD(d, 0, F.in[I_W2F], DLORA, RW, nullptr, (bf16*)(ws + WS_W2F), 256, 256, 0) \
        P0_SETD(d, 0, F.in[I_W2B], DLORA, RW, nullptr, (bf16*)(ws + WS_W2F + 1 * MiB), 256, 256, 128) \
        P0_SETD(d, 0, F.in[I_A2F], DLORA, RW, nullptr, (bf16*)(ws + WS_W2F + 2 * MiB), 256, 256, 0) \
        P0_SETD(d, 0, F.in[I_A2B], DLORA, RW, nullptr, (bf16*)(ws + WS_W2F + 3 * MiB), 256, 256, 128) \
        P0_SETD(d, 0, F.in[I_G2], GLORA, RW, nullptr, (bf16*)(ws + WS_G2), GLORA, GLORA, 0) \
        P0_SETD(d, 0, F.in[I_WUPM], DM, DM, nullptr, (bf16*)(ws + WS_WUPM), DM, DM, 0) \
        P0_SETD(d, 0, F.in[I_WUPR], DM, DM, nullptr, (bf16*)(ws + WS_WUPR), DM, DM, 0) \
        P0_SETD(d, 0, F.in[I_WOUT], DM, DM, nullptr, (bf16*)(ws + WS_WOUT), DM, DM, 0) \
        P0_SETD(d, 0, F.in[I_WQC], DM, CW, F.in[I_GCROSS], (bf16*)(ws + WS_WQC), DM, DM, 0) \
        P0_SETD(d, 0, F.in[I_WKVC], DM, 2 * CW, nullptr, (bf16*)(ws + WS_WKVC), DM, DM, 0) \
        P0_SETD(d, 0, F.in[I_WOC], CW, DM, nullptr, (bf16*)(ws + WS_WOC), CW, CW, 0) \
    } while (0)
    CVT_PIPE(TOTAL, P0_DESC);
#undef P0_SETD
#undef P0_DESC
    const float* x = F.in[I_X]; bf16* xb = (bf16*)(ws + WS_XB); float* rstd1 = (float*)(ws + WS_RSTD);
    for (int m = gw; m < MT + NB * MEMLEN; m += NGW) {
        const bool ismem = m >= MT; const int mm = ismem ? m - MT : m;
        const f32x4* xr = (const f32x4*)((ismem ? F.in[I_MEM] : x) + (size_t)mm * DM) + F.lane;
        f32x4 v[8]; float s = 0.f;
#pragma unroll
        for (int j = 0; j < 8; ++j) { v[j] = xr[64 * j]; s += (v[j].x * v[j].x + v[j].y * v[j].y) + (v[j].z * v[j].z + v[j].w * v[j].w); }
        const float rs = 1.0f / sqrtf(wave_sum(s) * (1.f / DM) + RMS_EPS);
        if (!ismem) { if (F.lane == 0) rstd1[mm] = rs;
            u32x2* o8 = (u32x2*)(xb + (size_t)mm * DM) + F.lane;
#pragma unroll
            for (int j = 0; j < 8; ++j) { u32x2 w; w.x = cvt_pk_bf16(v[j].x, v[j].y); w.y = cvt_pk_bf16(v[j].z, v[j].w); o8[64 * j] = w; }
        } else { const f32x4* gr = (const f32x4*)F.in[I_GMEM] + F.lane;
            u32x2* o8 = (u32x2*)((bf16*)(ws + WS_MEMN) + (size_t)mm * DM) + F.lane;
#pragma unroll
            for (int j = 0; j < 8; ++j) { const f32x4 g = gr[64 * j]; u32x2 w; w.x = cvt_pk_bf16(v[j].x * rs * g.x, v[j].y * rs * g.y); w.y = cvt_pk_bf16(v[j].z * rs * g.z, v[j].w * rs * g.w); o8[64 * j] = w; }
        }
    }
    const int gt = F.vcu * 512 + F.tid, NGT = F.G * 512;
    { const int* pos = (const int*)F.in[I_POS]; f32x2* cs = (f32x2*)(ws + WS_ROPE);
      for (int i = gt; i < MT * 32; i += NGT) { const int t = i >> 5, f = i & 31;
          const float inv = exp2f(-(float)f * (13.287712379549449f / 32.0f));
          const float ang = (float)pos[t] * inv;
          const double a = (double)ang; const double k = rint(a * 0.15915494309189535); const float red = (float)(a - k * 6.283185307179586);
          cs[i] = (f32x2){cosf(red), sinf(red)}; } }
    { float* WR = (float*)(ws + WS_WR); const float* gf = F.in[I_GFFN];
      for (int i = gt; i < DM * 36; i += NGT) { const int k = i / 36, c = i % 36; float w;
          if (c < 4) w = F.in[I_WRG][k * 4 + c]; else { const int gi = (c - 4) >> 3, e = (c - 4) & 7; w = F.in[I_WRE][((size_t)gi * DM + k) * 8 + e]; }
          WR[i] = w * gf[k]; } }
}

__device__ __forceinline__ void p_final(Frame& F, bool with_moe) {
    const int gw = F.vcu * 8 + F.wave, NGW = F.G * 8;
    const f32x4* gr = (const f32x4*)F.in[I_GFINAL] + F.lane;
    const int* route = (const int*)(F.ws + WS_ROUTE); const bf16* ybuf = (const bf16*)(F.ws + WS_YBUF);
    const int* cnts = (const int*)(F.ctl + CW_CNT);
    for (int m = gw; m < MT; m += NGW) {
        f32x4* xr = (f32x4*)(F.out + (size_t)m * DM) + F.lane;
        f32x4 v[8];
#pragma unroll
        for (int j = 0; j < 8; ++j) v[j] = xr[64 * j];
        if (with_moe) {
#pragma unroll
            for (int kx = 0; kx < 2; ++kx) { const int e = route[m * 8 + 2 * kx], pos = route[m * 8 + 2 * kx + 1];
                int base = 0; for (int q = 0; q < e; ++q) base += (cnts[64 * q] + 255) & ~255;
                const u32x2* yr = (const u32x2*)(ybuf + (size_t)(base + pos) * DM) + F.lane;
#pragma unroll
                for (int j = 0; j < 8; ++j) { const u32x2 w = yr[64 * j]; v[j].x += bflo(w.x); v[j].y += bfhi(w.x); v[j].z += bflo(w.y); v[j].w += bfhi(w.y); } }
        }
        float s = 0.f;
#pragma unroll
        for (int j = 0; j < 8; ++j) s += (v[j].x * v[j].x + v[j].y * v[j].y) + (v[j].z * v[j].z + v[j].w * v[j].w);
        const float rs = 1.0f / sqrtf(wave_sum(s) * (1.f / DM) + RMS_EPS);
#pragma unroll
        for (int j = 0; j < 8; ++j) { const f32x4 g = gr[64 * j]; xr[64 * j] = (f32x4){v[j].x * rs * g.x, v[j].y * rs * g.y, v[j].z * rs * g.z, v[j].w * rs * g.w}; }
    }
}
__device__ __forceinline__ void p_copy_x(Frame& F) {
    const int gt = F.vcu * 512 + F.tid, NGT = F.G * 512; const f32x4* s = (const f32x4*)F.in[I_X]; f32x4* d = (f32x4*)F.out;
    for (int i = gt; i < MT * DM / 4; i += NGT) d[i] = s[i];
}

__device__ __forceinline__ void p2_rowpass(Frame& F) {
    const int gw = F.vcu * 8 + F.wave, NGW = F.G * 8, l = F.lane;
    unsigned char* ws = F.ws;
    const bf16* zm = (const bf16*)(ws + WS_ZMLA); const bf16* zl = (const bf16*)(ws + WS_ZLORA); bf16* la = (bf16*)(ws + WS_LORAA);
    float* rstd_q = (float*)(ws + WS_RSTD) + MT; float* rstd_kv = (float*)(ws + WS_RSTD) + 2 * MT;
    const f32x2* cs = (const f32x2*)(ws + WS_ROPE); unsigned char* Kb = ws + WS_K;
    const float* sh = F.in[I_SHIFT] + 6144;
    f32x2 s0[5], s1[5], s2[5];
#pragma unroll
    for (int i = 0; i < 5; ++i) { const int j = 2 * l + 128 * i; s0[i] = *(const f32x2*)(sh + j); s1[i] = *(const f32x2*)(sh + RWKV_IN + j); s2[i] = *(const f32x2*)(sh + 2 * RWKV_IN + j); }
    for (int t = gw; t < MT; t += NGW) {
        const bf16* zr = zm + (size_t)t * ZM_LD;
        { const u32x4 w = *((const u32x4*)zr + l); float s = 0.f;
          s += bflo(w.x) * bflo(w.x) + bfhi(w.x) * bfhi(w.x) + bflo(w.y) * bflo(w.y) + bfhi(w.y) * bfhi(w.y) + bflo(w.z) * bflo(w.z) + bfhi(w.z) * bfhi(w.z) + bflo(w.w) * bflo(w.w) + bfhi(w.w) * bfhi(w.w);
          s = wave_sum(s); if (l == 0) rstd_q[t] = 1.0f / sqrtf(s * (1.f / QLORA) + RMS_EPS); }
        { const u32x2 w = *((const u32x2*)(zr + QLORA) + l); float s = bflo(w.x) * bflo(w.x) + bfhi(w.x) * bfhi(w.x) + bflo(w.y) * bflo(w.y) + bfhi(w.y) * bfhi(w.y);
          s = wave_sum(s); if (l == 0) rstd_kv[t] = 1.0f / sqrtf(s * (1.f / KVLORA) + RMS_EPS); }
        { const int i = l & 31, hs = l >> 5; const unsigned w = *((const unsigned*)(zr + 768) + i); const float x1 = bflo(w), x2 = bfhi(w); const f32x2 c = cs[(size_t)t * 32 + i];
          const unsigned short o = (unsigned short)__builtin_amdgcn_cvt_pk_fp8_f32(x1 * c.x - x2 * c.y, x2 * c.x + x1 * c.y, 0, false);
#pragma unroll
          for (int hh = 0; hh < 8; ++hh) *((unsigned short*)(Kb + (size_t)t * (MH * QKD) + (hs * 8 + hh) * QKD + NOPE) + i) = o; }
        const int s = t % SEQ; const float fp = s > 0 ? 1.f : 0.f, fn = s < SEQ - 1 ? 1.f : 0.f;
        const bf16* z0 = zl + (size_t)t * ZL_LD; const bf16* zp = s > 0 ? z0 - ZL_LD : z0; const bf16* zn = s < SEQ - 1 ? z0 + ZL_LD : z0;
        bf16* lr = la + (size_t)t * LA_LD;
#pragma unroll
        for (int i = 0; i < 5; ++i) { const int j = 2 * l + 128 * i;
            const unsigned wp = *(const unsigned*)(zp + j), w0 = *(const unsigned*)(z0 + j), wn = *(const unsigned*)(zn + j);
            float va = s0[i].x * fp * bflo(wp) + s1[i].x * bflo(w0) + s2[i].x * fn * bflo(wn);
            float vb = s0[i].y * fp * bfhi(wp) + s1[i].y * bfhi(w0) + s2[i].y * fn * bfhi(wn);
            int dst;
            if (j < 192) { va = tanhf(va); vb = tanhf(vb); dst = (j / 96) * 128 + (j % 96); } else if (j < 384) { dst = (j / 96) * 128 + (j % 96); } else { va = sigmoidf_(va); vb = sigmoidf_(vb); dst = 512 + (j - 384); }
            *(unsigned*)(lr + dst) = cvt_pk_bf16(va, vb); }
        { const int p = 2 * l; *(unsigned*)(lr + (p >> 5) * 128 + 96 + (p & 31)) = 0u; }
    }
}

namespace scan {
constexpr int TC = 16, DATA_B = TC * 6 * 64 * 4, BUF_B = DATA_B + 64 + TC * 32 * 4;
template <int CTRL> __device__ __forceinline__ float dpp_add(float v) {
    return v + __builtin_bit_cast(float, __builtin_amdgcn_update_dpp(0, __builtin_bit_cast(int, v), CTRL, 0xF, 0xF, false));
}
__device__ __forceinline__ float red16(float v) { v = dpp_add<0xB1>(v); v = dpp_add<0x4E>(v); v = dpp_add<0x141>(v); v = dpp_add<0x140>(v); return v; }
struct Raw { unsigned short r[3], k[3], v[3], wl, ic; };
template <int VAR> __device__ __forceinline__ void scan_unit(Frame& F, const int b, const int h, const int dir, const int half) {
    unsigned char* ws = F.ws; const int l = F.lane, w = F.wave, tid = F.tid;
    const bf16* zr = (const bf16*)(ws + WS_ZRKV) + (size_t)b * SEQ * ZR_LD + h * 64 + l;
    const bf16* wlp = (const bf16*)(ws + (dir ? WS_WLB : WS_WLF)) + (size_t)b * SEQ * RW + h * 64 + l;
    const bf16* icp = (const bf16*)(ws + (dir ? WS_ICB : WS_ICF)) + (size_t)b * SEQ * RW + h * 64 + l;
    bf16* yout = (bf16*)(ws + (dir ? WS_YB : WS_YF)) + (size_t)b * SEQ * RW + h * 64 + half * 32;
    const int ch = h * 64 + l; const float* sh = F.in[I_SHIFT];
    const float sr0 = sh[ch], sr1 = sh[RWKV_IN + ch], sr2 = sh[2 * RWKV_IN + ch];
    const float sk0 = sh[2048 + ch], sk1 = sh[RWKV_IN + 2048 + ch], sk2 = sh[2 * RWKV_IN + 2048 + ch];
    const float sv0 = sh[4096 + ch], sv1 = sh[RWKV_IN + 4096 + ch], sv2 = sh[2 * RWKV_IN + 4096 + ch];
    const float kk_c = F.in[I_KK][ch], ka_c = F.in[I_KA][ch], rk_c = F.in[I_RK][ch];
    LAS unsigned char* L = F.lds;
    Raw raw[2];
#define SC_TOK(ci, i) (dir ? (SEQ - 1 - ((ci) * TC + (i))) : ((ci) * TC + (i)))
#define SC_LOAD(ci) do { _Pragma("unroll") for (int q = 0; q < 2; ++q) { const int s = SC_TOK(ci, 2 * w + q); const int sp = s > 0 ? s - 1 : s, sn = s < SEQ - 1 ? s + 1 : s; \
        const bf16* z0 = zr + (size_t)s * ZR_LD; const bf16* zp = zr + (size_t)sp * ZR_LD; const bf16* zn = zr + (size_t)sn * ZR_LD; \
        raw[q].r[0] = zp[0]; raw[q].r[1] = z0[0]; raw[q].r[2] = zn[0]; raw[q].k[0] = zp[2048]; raw[q].k[1] = z0[2048]; raw[q].k[2] = zn[2048]; \
        raw[q].v[0] = zp[4096]; raw[q].v[1] = z0[4096]; raw[q].v[2] = zn[4096]; raw[q].wl = wlp[(size_t)s * RW]; raw[q].ic = icp[(size_t)s * RW]; } } while (0)
#define SC_PREP(ci, bufi) do { _Pragma("unroll") for (int q = 0; q < 2; ++q) { const int i = 2 * w + q; const int s = SC_TOK(ci, i); const float fp = s > 0 ? 1.f : 0.f, fn = s < SEQ - 1 ? 1.f : 0.f; \
        const float r_s = sr0 * fp * bf2f(raw[q].r[0]) + sr1 * bf2f(raw[q].r[1]) + sr2 * fn * bf2f(raw[q].r[2]); \
        const float k_s = sk0 * fp * bf2f(raw[q].k[0]) + sk1 * bf2f(raw[q].k[1]) + sk2 * fn * bf2f(raw[q].k[2]); \
        const float v_s = sv0 * fp * bf2f(raw[q].v[0]) + sv1 * bf2f(raw[q].v[1]) + sv2 * fn * bf2f(raw[q].v[2]); \
        const float kkr = k_s * kk_c; const float ss = wave_sum(kkr * kkr); const float kk = kkr * (1.0f / sqrtf(ss + 1e-12f)); \
        const float icv = bf2f(raw[q].ic); const float kd = k_s * (1.0f + (icv - 1.0f) * ka_c); const float bb = kk * icv; const float wd = __builtin_amdgcn_exp2f(bf2f(raw[q].wl)); \
        const float bon = wave_sum(r_s * kd * rk_c); \
        LAS float* d = (LAS float*)(L + (bufi) * BUF_B) + i * 384 + l; d[0] = wd; d[64] = kk; d[128] = bb; d[192] = kd; d[256] = r_s; d[320] = v_s; \
        if (l == 0) ((LAS float*)(L + (bufi) * BUF_B + DATA_B))[i] = bon; } } while (0)
    const int g = l >> 4, j = l & 15, row = half * 32 + w * 4 + g;
    f32x2 Sa = {0.f, 0.f}, Sb = {0.f, 0.f};
    struct Ops { f32x4 w, a, b, k, r; float v, bon; };
#define SC_LD(O, i) do { O.w = p4[(i) * 96 + j]; O.a = p4[(i) * 96 + 16 + j]; O.b = p4[(i) * 96 + 32 + j]; O.k = p4[(i) * 96 + 48 + j]; O.r = p4[(i) * 96 + 64 + j]; \
        O.v = pf[(i) * 384 + 320 + row]; O.bon = pb[i]; } while (0)
#define SC_STEP(O, YP) do { f32x2 t = Sa * O.a.xy; t = Sb * O.a.zw + t; float sa = red16(t.x + t.y); \
        const f32x2 nsa = {-sa, -sa}; const f32x2 vv2 = {O.v, O.v}; \
        const f32x2 u0 = nsa * O.b.xy + vv2 * O.k.xy, u1 = nsa * O.b.zw + vv2 * O.k.zw; \
        Sa = Sa * O.w.xy + u0; Sb = Sb * O.w.zw + u1; \
        f32x2 ty = Sa * O.r.xy; ty = Sb * O.r.zw + ty; YP = ty.x + ty.y; } while (0)
    SC_LOAD(0); SC_PREP(0, 0); __syncthreads();
    constexpr int NCH = SEQ / TC;
    for (int ci = 0; ci < NCH; ++ci) {
        const int bi = ci & 1;
        if (VAR != 2 && ci + 1 < NCH) SC_LOAD(ci + 1);
        const LAS f32x4* p4 = (const LAS f32x4*)(L + bi * BUF_B); const LAS float* pf = (const LAS float*)(L + bi * BUF_B);
        const LAS float* pb = (const LAS float*)(L + bi * BUF_B + DATA_B);
        float ykeep = 0.f;
        Ops oA, oB; SC_LD(oA, 0);
        if (VAR != 1) {
#pragma unroll
        for (int i = 0; i < TC; i += 4) {
            float y0, y1, y2, y3; float v0, v1, v2, v3, b0, b1, b2, b3;
            SC_LD(oB, i + 1); v0 = oA.v; b0 = oA.bon; SC_STEP(oA, y0);
            SC_LD(oA, i + 2); v1 = oB.v; b1 = oB.bon; SC_STEP(oB, y1);
            SC_LD(oB, i + 3); v2 = oA.v; b2 = oA.bon; SC_STEP(oA, y2);
            if (i + 4 < TC) SC_LD(oA, i + 4);
            v3 = oB.v; b3 = oB.bon; SC_STEP(oB, y3);
            y0 = red16(y0); y1 = red16(y1); y2 = red16(y2); y3 = red16(y3);
            y0 += b0 * v0; y1 += b1 * v1; y2 += b2 * v2; y3 += b3 * v3;
            ykeep = (j == i) ? y0 : ykeep; ykeep = (j == i + 1) ? y1 : ykeep; ykeep = (j == i + 2) ? y2 : ykeep; ykeep = (j == i + 3) ? y3 : ykeep;
        }
        }
        ((LAS float*)(L + bi * BUF_B + DATA_B + 64))[j * 32 + w * 4 + g] = ykeep;
        if (VAR != 2 && ci + 1 < NCH) SC_PREP(ci + 1, bi ^ 1);
        __syncthreads();
        { const int st = tid >> 5, rw_ = tid & 31; const int s = SC_TOK(ci, st);
          const unsigned short yv = f2bf(((const LAS float*)(L + bi * BUF_B + DATA_B + 64))[st * 32 + rw_]);
          if (VAR == 0) yout[(size_t)s * RW + rw_] = yv; else asm volatile("" :: "v"(yv)); }
    }
    __syncthreads();
#undef SC_TOK
#undef SC_LOAD
#undef SC_PREP
#undef SC_LD
#undef SC_STEP
}
}

namespace scan2 {
constexpr int TC = 16, NS = 6, NPREP = 6, NREC = 2;
constexpr int ROWB = 144;
constexpr int P_ACAT = 0, P_BHAT = 4608, P_KHAT = 6656, P_VT = 8704, P_NCAT = 10752, P_MRF = 11776, P_PC = 12800, P_GINIT = 13056  , PKG_B = 15104;
constexpr int S_L1 = 0, S_L2 = 4608, S_MF = 9216, S_NF = 10240, SCR_B = 11264;
constexpr int OFF_PKG = 0, OFF_SCR = NS * PKG_B, OFF_FLAG = OFF_SCR + NPREP * SCR_B, TOTAL_B = OFF_FLAG + 64;
static_assert(TOTAL_B <= 156 * 1024, "scan2 LDS");
__device__ __forceinline__ int crow(int r, int hi) { return (r & 3) + 8 * (r >> 2) + 4 * hi; }
__device__ __forceinline__ void lds_st16(LAS unsigned char* p, float v) { *(LAS unsigned short*)p = f2bf(v); }
__device__ __forceinline__ bf16x8 pack_acc8(const f32x16& x, int base) {
    u32x4 w = {cvt_pk_bf16(x[base + 0], x[base + 1]), cvt_pk_bf16(x[base + 2], x[base + 3]), cvt_pk_bf16(x[base + 4], x[base + 5]), cvt_pk_bf16(x[base + 6], x[base + 7])};
    return *reinterpret_cast<bf16x8*>(&w);
}
__device__ __forceinline__ float wave_sum_b(float v) {
    v = scan::red16(v);
    v += __builtin_bit_cast(float, __builtin_amdgcn_update_dpp(0, __builtin_bit_cast(int, v), 0x142, 0xA, 0xF, false));
    v += __builtin_bit_cast(float, __builtin_amdgcn_update_dpp(0, __builtin_bit_cast(int, v), 0x143, 0xC, 0xF, false));
    return __builtin_bit_cast(float, __builtin_amdgcn_readlane(__builtin_bit_cast(int, v), 63));
}
__device__ __forceinline__ void spin_ge(volatile LAS int* p, int want) { while (*p < want) __builtin_amdgcn_s_sleep(1); }

template <int dir> __device__ __forceinline__ void scan_unit(Frame& F, const int b, const int h) {
    unsigned char* ws = F.ws; const int l = F.lane, w = F.wave;
    LAS unsigned char* L = F.lds;
    volatile LAS int* ready = (volatile LAS int*)(L + OFF_FLAG);
    volatile LAS int* consumed = ready + NS;
    if (F.tid < 16) ready[F.tid] = 0;
    __syncthreads();
    constexpr int NCH = SEQ / TC;
    if (w < NREC) {
        const int half = w; const int v = l & 31, hi = l >> 5, vg = 32 * half + v;
        __builtin_amdgcn_s_setprio(3);
        f32x16 X0 = {}, X1 = {}; unsigned long long rec_acc = 0ull;
        bf16* yout = (bf16*)(ws + (dir ? WS_YB : WS_YF)) + (size_t)b * SEQ * RW + h * 64 + half * 32 + v;
        for (int ci = 0; ci < NCH; ++ci) {
            const int slot = ci % NS; const LAS unsigned char* P = L + OFF_PKG + slot * PKG_B;
            const unsigned long long tr0 = (SCAN_SEC == 9) ? __builtin_amdgcn_s_memtime() : 0ull;
            spin_ge(ready + slot, ci + 1);
            if (SCAN_SEC == 9) rec_acc += __builtin_amdgcn_s_memtime() - tr0;
            const bf16x8 a00 = *(const LAS bf16x8*)(P + P_ACAT + v * ROWB + (0 + hi) * 16), a01 = *(const LAS bf16x8*)(P + P_ACAT + v * ROWB + (2 + hi) * 16);
            const bf16x8 a10 = *(const LAS bf16x8*)(P + P_ACAT + v * ROWB + (4 + hi) * 16), a11 = *(const LAS bf16x8*)(P + P_ACAT + v * ROWB + (6 + hi) * 16);
            const bf16x8 ncat = *(const LAS bf16x8*)(P + P_NCAT + v * 32 + hi * 16), vt = *(const LAS bf16x8*)(P + P_VT + vg * 32 + hi * 16);
            const bf16x8 mrf = *(const LAS bf16x8*)(P + P_MRF + l * 16);
            const bf16x8 bh0 = *(const LAS bf16x8*)(P + P_BHAT + v * 32 + hi * 16), bh1 = *(const LAS bf16x8*)(P + P_BHAT + (32 + v) * 32 + hi * 16);
            const bf16x8 kh0 = *(const LAS bf16x8*)(P + P_KHAT + v * 32 + hi * 16), kh1 = *(const LAS bf16x8*)(P + P_KHAT + (32 + v) * 32 + hi * 16);
            f32x16 G;
            { const u32x2 q0 = *(const LAS u32x2*)(P + P_GINIT + vg * 32 + hi * 8), q1 = *(const LAS u32x2*)(P + P_GINIT + vg * 32 + 16 + hi * 8);
              const f32x4 g0 = {bflo(q0.x), bfhi(q0.x), bflo(q0.y), bfhi(q0.y)}, g1 = {bflo(q1.x), bfhi(q1.x), bflo(q1.y), bfhi(q1.y)};
#pragma unroll
              for (int r = 0; r < 8; ++r) G[r] = 0.f;
#pragma unroll
              for (int r = 0; r < 4; ++r) { G[8 + r] = g0[r]; G[12 + r] = g1[r]; } }
            f32x4 pc[8];
#pragma unroll
            for (int q = 0; q < 8; ++q) pc[q] = *(const LAS f32x4*)(P + P_PC + (32 * (q >> 2) + 8 * (q & 3) + 4 * hi) * 4);
            const bf16x8 s00 = pack_acc8(X0, 0), s01 = pack_acc8(X0, 8), s10 = pack_acc8(X1, 0), s11 = pack_acc8(X1, 8);
            G = __builtin_amdgcn_mfma_f32_32x32x16_bf16(a00, s00, G, 0, 0, 0);
            G = __builtin_amdgcn_mfma_f32_32x32x16_bf16(a01, s01, G, 0, 0, 0);
            G = __builtin_amdgcn_mfma_f32_32x32x16_bf16(a10, s10, G, 0, 0, 0);
            G = __builtin_amdgcn_mfma_f32_32x32x16_bf16(a11, s11, G, 0, 0, 0);
            G = __builtin_amdgcn_mfma_f32_32x32x16_bf16(ncat, vt, G, 0, 0, 0);
            const bf16x8 uf = pack_acc8(G, 0);
#pragma unroll
            for (int r = 0; r < 16; ++r) { X0[r] *= pc[r >> 2][r & 3]; X1[r] *= pc[4 + (r >> 2)][r & 3]; }
            X0 = __builtin_amdgcn_mfma_f32_32x32x16_bf16(bh0, uf, X0, 0, 0, 0);
            X1 = __builtin_amdgcn_mfma_f32_32x32x16_bf16(bh1, uf, X1, 0, 0, 0);
            X0 = __builtin_amdgcn_mfma_f32_32x32x16_bf16(kh0, vt, X0, 0, 0, 0);
            X1 = __builtin_amdgcn_mfma_f32_32x32x16_bf16(kh1, vt, X1, 0, 0, 0);
            G = __builtin_amdgcn_mfma_f32_32x32x16_bf16(mrf, uf, G, 0, 0, 0);
            LDS_WAIT();
            if (l == 0) consumed[half] = ci + 1;
#pragma unroll
            for (int q = 0; q < 8; ++q) { const int t = crow(q, hi); const int s = dir ? (SEQ - 1 - (ci * TC + t)) : (ci * TC + t);
                yout[(size_t)s * RW] = f2bf(G[8 + q]); }
        }
        __builtin_amdgcn_s_setprio(0);
        if (SCAN_SEC == 9 && blockIdx.x == 0 && w == 0 && l == 0) { F.MISC[120] = (unsigned)rec_acc; F.MISC[121] = (unsigned)(rec_acc >> 32); }
    } else {
        const int pw = w - NREC; LAS unsigned char* SC = L + OFF_SCR + pw * SCR_B;
        const __amdgpu_buffer_rsrc_t rsZ = __builtin_amdgcn_make_buffer_rsrc((void*)(ws + WS_ZRKV + ((size_t)b * SEQ * ZR_LD + h * 64) * 2), (short)0, (int)(SEQ * ZR_LD * 2), 0x00020000);
        const __amdgpu_buffer_rsrc_t rsW = __builtin_amdgcn_make_buffer_rsrc((void*)(ws + (dir ? WS_WLB : WS_WLF) + ((size_t)b * SEQ * RW + h * 64) * 2), (short)0, (int)(SEQ * RW * 2), 0x00020000);
        const __amdgpu_buffer_rsrc_t rsI = __builtin_amdgcn_make_buffer_rsrc((void*)(ws + (dir ? WS_ICB : WS_ICF) + ((size_t)b * SEQ * RW + h * 64) * 2), (short)0, (int)(SEQ * RW * 2), 0x00020000);
        const unsigned vl2 = (unsigned)l * 2u;
        const int ch = h * 64 + l; const float* sh = F.in[I_SHIFT];
        const float sr0 = sh[ch], sr1 = sh[RWKV_IN + ch], sr2 = sh[2 * RWKV_IN + ch];
        const float sk0 = sh[2048 + ch], sk1 = sh[RWKV_IN + 2048 + ch], sk2 = sh[2 * RWKV_IN + 2048 + ch];
        const float sv0 = sh[4096 + ch], sv1 = sh[RWKV_IN + 4096 + ch], sv2 = sh[2 * RWKV_IN + 4096 + ch];
        const float kk_c = F.in[I_KK][ch], ka_c = F.in[I_KA][ch], rk_c = F.in[I_RK][ch];
        const int posk = (((l >> 5) * 2 + ((l >> 4) & 1)) * 2 + ((l >> 2) & 1)) * 8 + ((l >> 3) & 1) * 4 + (l & 3);
        unsigned long long sec_acc = 0ull;
#define S2_T() ((SCAN_SEC >= 0) ? __builtin_amdgcn_s_memtime() : 0ull)
        for (int ci = pw; ci < NCH; ci += NPREP) {
            const int slot = ci % NS; LAS unsigned char* P = L + OFF_PKG + slot * PKG_B;
            const unsigned long long ts0 = S2_T();
            const int s_lo = dir ? (SEQ - TC - ci * TC) : ci * TC;
            float rr[18], rk[18], rv[18], wl[16], ic[16];
            { unsigned short ur[18], uk[18], uv[18], uw[16], ui[16];
#pragma unroll
              for (int tau = 0; tau < 18; ++tau) { const int s = s_lo - 1 + tau; const int sc = (tau == 0 && s < 0) ? s_lo : (tau == 17 && s >= SEQ) ? s_lo : s;
                  const unsigned so = (unsigned)sc * (unsigned)(ZR_LD * 2);
                  ur[tau] = __builtin_amdgcn_raw_buffer_load_b16(rsZ, vl2, so, 0); uk[tau] = __builtin_amdgcn_raw_buffer_load_b16(rsZ, vl2, so + 4096u, 0); uv[tau] = __builtin_amdgcn_raw_buffer_load_b16(rsZ, vl2, so + 8192u, 0); }
#pragma unroll
              for (int i = 0; i < 16; ++i) { const int s = dir ? (s_lo + 15 - i) : (s_lo + i); const unsigned so = (unsigned)s * (unsigned)(RW * 2);
                  uw[i] = __builtin_amdgcn_raw_buffer_load_b16(rsW, vl2, so, 0); ui[i] = __builtin_amdgcn_raw_buffer_load_b16(rsI, vl2, so, 0); }
              __builtin_amdgcn_sched_barrier(0);
#pragma unroll
              for (int tau = 0; tau < 18; ++tau) { rr[tau] = bf2f(ur[tau]); rk[tau] = bf2f(uk[tau]); rv[tau] = bf2f(uv[tau]); }
              { const float f0 = (s_lo - 1 >= 0) ? 1.f : 0.f, f17 = (s_lo + 16 < SEQ) ? 1.f : 0.f;
                rr[0] *= f0; rk[0] *= f0; rv[0] *= f0; rr[17] *= f17; rk[17] *= f17; rv[17] *= f17; }
#pragma unroll
              for (int i = 0; i < 16; ++i) { wl[i] = bf2f(uw[i]); ic[i] = bf2f(ui[i]); } }
            float cum[16];
            cum[0] = wl[0];
#pragma unroll
            for (int i = 1; i < 16; ++i) cum[i] = cum[i - 1] + wl[i];
            const unsigned long long tsA = S2_T();
            float rs_[16], ks_[16], vs_[16], q1[16], q2[16];
#pragma unroll
            for (int i = 0; i < 16; ++i) { const int tau = dir ? (16 - i) : (i + 1);
                rs_[i] = sr0 * rr[tau - 1] + sr1 * rr[tau] + sr2 * rr[tau + 1];
                ks_[i] = sk0 * rk[tau - 1] + sk1 * rk[tau] + sk2 * rk[tau + 1];
                vs_[i] = sv0 * rv[tau - 1] + sv1 * rv[tau] + sv2 * rv[tau + 1];
                const float kkr = ks_[i] * kk_c; q1[i] = kkr * kkr; q2[i] = rs_[i] * (ks_[i] * (1.0f + (ic[i] - 1.0f) * ka_c)) * rk_c; }
#define S2_DPPSTEP(CTRL, RM) do { _Pragma("unroll") for (int i = 0; i < 16; ++i) { \
                q1[i] += __builtin_bit_cast(float, __builtin_amdgcn_update_dpp(0, __builtin_bit_cast(int, q1[i]), CTRL, RM, 0xF, false)); \
                q2[i] += __builtin_bit_cast(float, __builtin_amdgcn_update_dpp(0, __builtin_bit_cast(int, q2[i]), CTRL, RM, 0xF, false)); } } while (0)
            S2_DPPSTEP(0xB1, 0xF); S2_DPPSTEP(0x4E, 0xF); S2_DPPSTEP(0x141, 0xF); S2_DPPSTEP(0x140, 0xF);
            __builtin_amdgcn_sched_barrier(0);
            asm volatile("s_nop 1");
#define S2_BCAST(CTRL) do { _Pragma("unroll") for (int i = 0; i < 16; ++i) { \
                asm volatile("v_add_f32_dpp %0, %0, %0 " CTRL " bank_mask:0xf" : "+v"(q1[i])); asm volatile("v_add_f32_dpp %0, %0, %0 " CTRL " bank_mask:0xf" : "+v"(q2[i])); } } while (0)
            S2_BCAST("row_bcast:15 row_mask:0xa"); S2_BCAST("row_bcast:31 row_mask:0xc");
#undef S2_BCAST
            asm volatile("s_nop 1");
            __builtin_amdgcn_sched_barrier(0);
#undef S2_DPPSTEP
            const unsigned long long ts1 = S2_T();
            spin_ge(consumed, ci - NS + 1); spin_ge(consumed + 1, ci - NS + 1);
            const unsigned long long ts2 = S2_T();
            float at[16], bhv[16], khv[16], giv[16]; float pprev = 1.0f; const float pC = __builtin_amdgcn_exp2f(cum[15]);
#pragma unroll
            for (int i = 0; i < 16; ++i) {
                const float r_s = rs_[i], k_s = ks_[i], v_s = vs_[i];
                const float ss = __uint_as_float(__builtin_amdgcn_readlane(__float_as_uint(q1[i]), 63)), bon = __uint_as_float(__builtin_amdgcn_readlane(__float_as_uint(q2[i]), 63));
                const float kk = k_s * kk_c * __builtin_amdgcn_rsqf(ss + 1e-12f);
                const float kd = k_s * (1.0f + (ic[i] - 1.0f) * ka_c); const float bb = kk * ic[i];
                const float p = __builtin_amdgcn_exp2f(cum[i]), pm = pprev, pinv = __builtin_amdgcn_exp2f(-cum[i]), pr = pC * pinv; pprev = p;
                at[i] = -kk * pm;
                lds_st16(P + P_ACAT + i * ROWB + posk * 2, at[i]);
                const float rt = r_s * p;
                lds_st16(P + P_ACAT + (16 + i) * ROWB + posk * 2, rt);
                lds_st16(SC + S_L1 + i * ROWB + posk * 2, bb * pinv); lds_st16(SC + S_L1 + (16 + i) * ROWB + posk * 2, kd * pinv);
                bhv[((i >> 2) & 1) * 8 + (i & 3) + 4 * (i >> 3)] = bb * pr; khv[i] = kd * pr; giv[i] = bon * v_s;
            }
#pragma unroll
            for (int hf = 0; hf < 2; ++hf) {
                *(LAS u32x4*)(P + P_BHAT + l * 32 + hf * 16) = (u32x4){cvt_pk_bf16(bhv[hf * 8 + 0], bhv[hf * 8 + 1]), cvt_pk_bf16(bhv[hf * 8 + 2], bhv[hf * 8 + 3]), cvt_pk_bf16(bhv[hf * 8 + 4], bhv[hf * 8 + 5]), cvt_pk_bf16(bhv[hf * 8 + 6], bhv[hf * 8 + 7])};
                *(LAS u32x4*)(P + P_KHAT + l * 32 + hf * 16) = (u32x4){cvt_pk_bf16(khv[hf * 8 + 0], khv[hf * 8 + 1]), cvt_pk_bf16(khv[hf * 8 + 2], khv[hf * 8 + 3]), cvt_pk_bf16(khv[hf * 8 + 4], khv[hf * 8 + 5]), cvt_pk_bf16(khv[hf * 8 + 6], khv[hf * 8 + 7])};
                *(LAS u32x4*)(P + P_VT + l * 32 + hf * 16) = (u32x4){cvt_pk_bf16(vs_[hf * 8 + 0], vs_[hf * 8 + 1]), cvt_pk_bf16(vs_[hf * 8 + 2], vs_[hf * 8 + 3]), cvt_pk_bf16(vs_[hf * 8 + 4], vs_[hf * 8 + 5]), cvt_pk_bf16(vs_[hf * 8 + 6], vs_[hf * 8 + 7])};
                *(LAS u32x4*)(P + P_GINIT + l * 32 + hf * 16) = (u32x4){cvt_pk_bf16(giv[hf * 8 + 0], giv[hf * 8 + 1]), cvt_pk_bf16(giv[hf * 8 + 2], giv[hf * 8 + 3]), cvt_pk_bf16(giv[hf * 8 + 4], giv[hf * 8 + 5]), cvt_pk_bf16(giv[hf * 8 + 6], giv[hf * 8 + 7])}; }
            *(LAS float*)(P + P_PC + l * 4) = pC;
            LDS_WAIT();
            const unsigned long long ts3 = S2_T();
            f32x16 Z = {};
            { const int r = l & 31, hh = l >> 5;
#pragma unroll
              for (int ks = 0; ks < 4; ++ks) { const bf16x8 fa = *(const LAS bf16x8*)(SC + S_L1 + r * ROWB + (ks * 16 + hh * 8) * 2), fb = *(const LAS bf16x8*)(P + P_ACAT + r * ROWB + (ks * 16 + hh * 8) * 2);
                  Z = __builtin_amdgcn_mfma_f32_32x32x16_bf16(fa, fb, Z, 0, 0, 0); } }
            { const int c = l & 31, hh = l >> 5;
              if (c < 16) {
#pragma unroll
                  for (int r = 0; r < 8; ++r) { const int s = crow(r, hh); *(LAS float*)(SC + S_MF + (c * 16 + s) * 4) = (s < c) ? Z[r] : 0.f; }
#pragma unroll
                  for (int r = 8; r < 16; ++r) { const int s = crow(r, hh) - 16; *(LAS float*)(SC + S_NF + (s * 16 + c) * 4) = (s < c) ? Z[r] : 0.f; }
                  *(LAS u32x4*)(P + P_MRF + l * 16) = (u32x4){0u, 0u, 0u, 0u};
              } else { const int t = c - 16; f32x16 Zm = Z;
#pragma unroll
                  for (int r = 0; r < 8; ++r) { const int s = crow(r, hh); Zm[r] = (s <= t) ? Z[r] : 0.f; }
                  *(LAS bf16x8*)(P + P_MRF + l * 16) = pack_acc8(Zm, 0);
#pragma unroll
                  for (int r = 8; r < 16; ++r) { const int s = crow(r, hh) - 16; lds_st16(P + P_NCAT + c * 32 + s * 2, (s <= t) ? Z[r] : 0.f); }
              } }
            LDS_WAIT();
            const unsigned long long ts4 = S2_T();
            { f32x2 xy[16];
#pragma unroll
              for (int q = 0; q < 4; ++q) { const f32x4 nvv = *(const LAS f32x4*)(SC + S_NF + ((l & 15) * 16 + q * 4) * 4);
                  xy[q * 4 + 0] = (f32x2){at[q * 4 + 0], nvv[0]}; xy[q * 4 + 1] = (f32x2){at[q * 4 + 1], nvv[1]}; xy[q * 4 + 2] = (f32x2){at[q * 4 + 2], nvv[2]}; xy[q * 4 + 3] = (f32x2){at[q * 4 + 3], nvv[3]}; }
              f32x4 mrow[16][4];
#pragma unroll
              for (int t = 1; t < 16; ++t)
#pragma unroll
                  for (int s4 = 0; s4 < (t + 3) / 4; ++s4) mrow[t][s4] = *(const LAS f32x4*)(SC + S_MF + (t * 16 + s4 * 4) * 4);
#pragma unroll
              for (int t = 1; t < 16; ++t) { f32x2 a0 = xy[t], a1 = {0.f, 0.f};
#pragma unroll
                  for (int s = 0; s < t; ++s) { const float m = mrow[t][s >> 2][s & 3]; const f32x2 mm = {m, m}; if (s & 1) a1 += xy[s] * mm; else a0 += xy[s] * mm; }
                  xy[t] = a0 + a1; }
#pragma unroll
              for (int t = 0; t < 16; ++t) lds_st16(P + P_ACAT + t * ROWB + posk * 2, xy[t].x);
              if (l < 16) {
#pragma unroll
                  for (int t = 0; t < 16; ++t) lds_st16(P + P_NCAT + t * 32 + l * 2, xy[t].y); } }
            LDS_WAIT();
            if (l == 0) ready[slot] = ci + 1;
            if (SCAN_SEC >= 0) { const unsigned long long ts5 = S2_T(); sec_acc += SCAN_SEC == 0 ? ts1 - ts0 : SCAN_SEC == 1 ? ts2 - ts1 : SCAN_SEC == 2 ? ts3 - ts2 : SCAN_SEC == 3 ? ts4 - ts3 : SCAN_SEC == 4 ? ts5 - ts4 : SCAN_SEC == 6 ? tsA - ts0 : SCAN_SEC == 7 ? ts1 - tsA : ts5 - ts0; }
        }
        if (SCAN_SEC >= 0 && blockIdx.x == 0 && pw == SCAN_PW && SCAN_SEC != 9 && l == 0) { F.MISC[120] = (unsigned)sec_acc; F.MISC[121] = (unsigned)(sec_acc >> 32); }
    }
    __syncthreads();
}
}

__device__ __forceinline__ void p5_post(Frame& F) {
    const int gw = F.vcu * 8 + F.wave, NGW = F.G * 8, l = F.lane; unsigned char* ws = F.ws;
    const bf16* yf = (const bf16*)(ws + WS_YF); const bf16* yb = (const bf16*)(ws + WS_YB); const bf16* gg = (const bf16*)(ws + WS_G); bf16* o = (bf16*)(ws + WS_ORWKV);
    const float* lg = F.in[I_LNXG]; const float* lb = F.in[I_LNXB];
    for (int t = gw; t < MT; t += NGW) {
        const size_t base = (size_t)t * RW;
#pragma unroll 4
        for (int h = 0; h < RH; ++h) { const int c = h * 64 + l;
            const float y = bf2f(yf[base + c]) + bf2f(yb[base + c]);
            const float mu = wave_sum(y) * (1.f / 64.f); const float d = y - mu; const float var = wave_sum(d * d) * (1.f / 64.f);
            const float yn = d * (1.0f / sqrtf(var + LNX_EPS));
            o[base + c] = f2bf((yn * lg[c] + lb[c]) * bf2f(gg[base + c])); }
    }
}

__device__ __forceinline__ void p8_rowpass(Frame& F) {
    const int gw = F.vcu * 8 + F.wave, NGW = F.G * 8; float* rstd2 = (float*)(F.ws + WS_RSTD) + 3 * MT; bf16* hb = (bf16*)(F.ws + WS_H1B);
    for (int m = gw; m < MT; m += NGW) {
        const f32x4* xr = (const f32x4*)(F.out + (size_t)m * DM) + F.lane; f32x4 v[8]; float s = 0.f;
#pragma unroll
        for (int j = 0; j < 8; ++j) { v[j] = xr[64 * j]; s += (v[j].x * v[j].x + v[j].y * v[j].y) + (v[j].z * v[j].z + v[j].w * v[j].w); }
        s = wave_sum(s); if (F.lane == 0) rstd2[m] = 1.0f / sqrtf(s * (1.f / DM) + RMS_EPS);
        u32x2* o8 = (u32x2*)(hb + (size_t)m * DM) + F.lane;
#pragma unroll
        for (int j = 0; j < 8; ++j) { u32x2 w; w.x = cvt_pk_bf16(v[j].x, v[j].y); w.y = cvt_pk_bf16(v[j].z, v[j].w); o8[64 * j] = w; }
    }
}
__device__ __forceinline__ void p12_router(Frame& F) {
    const int gw = F.vcu * 8 + F.wave, NGW = F.G * 8, l = F.lane; unsigned char* ws = F.ws;
    float* rstd3 = (float*)(ws + WS_RSTD) + 4 * MT; bf16* n3 = (bf16*)(ws + WS_N3); const float* WR = (const float*)(ws + WS_WR);
    int* lists = (int*)(ws + WS_LIST); int* route = (int*)(ws + WS_ROUTE); float* slotw = (float*)(ws + WS_SLOTW);
    int* cnt = (int*)(F.ctl + CW_CNT);
    const float* brg = F.in[I_BRG]; const float* bre = F.in[I_BRE];
    LAS float* wl = (LAS float*)(F.lds + 16384);
    LAS float* lgt = (LAS float*)(F.lds + F.wave * 1024);
    for (int tb = F.vcu * 32; tb < MT; tb += F.G * 32) {
        const int t0 = tb + F.wave * 4;
        float ss[4] = {0.f, 0.f, 0.f, 0.f};
#pragma unroll
        for (int q = 0; q < 4; ++q) { const f32x4* xr = (const f32x4*)(F.out + (size_t)(t0 + q) * DM) + l; u32x2* o8 = (u32x2*)(n3 + (size_t)(t0 + q) * DM) + l;
#pragma unroll
            for (int j = 0; j < 8; ++j) { const f32x4 x = xr[64 * j]; ss[q] += (x.x * x.x + x.y * x.y) + (x.z * x.z + x.w * x.w);
                u32x2 w; w.x = cvt_pk_bf16(x.x, x.y); w.y = cvt_pk_bf16(x.z, x.w); o8[64 * j] = w; } }
#pragma unroll
        for (int q = 0; q < 4; ++q) ss[q] = wave_sum(ss[q]);
#pragma unroll 1
        for (int pass = 0; pass < 2; ++pass) {
            const float* x0p = F.out + (size_t)(t0 + 2 * pass) * DM + l; const float* x1p = x0p + DM;
            float acc[2][36];
#pragma unroll
            for (int q = 0; q < 2; ++q)
#pragma unroll
                for (int o = 0; o < 36; ++o) acc[q][o] = 0.f;
#pragma unroll 1
            for (int blk = 0; blk < 8; ++blk) {
                __syncthreads();
                { const f32x4* src4 = (const f32x4*)(WR + (size_t)blk * 256 * 36); LAS f32x4* dst4 = (LAS f32x4*)wl;
#pragma unroll
                  for (int i = 0; i < 5; ++i) { const int idx = F.tid + 512 * i; if (idx < 2304) dst4[idx] = src4[idx]; } }
                __syncthreads();
#pragma unroll
                for (int c4 = 0; c4 < 4; ++c4) { const int cl = l + 64 * c4; const float x0 = x0p[blk * 256 + 64 * c4], x1 = x1p[blk * 256 + 64 * c4];
                    const LAS f32x4* wr = (const LAS f32x4*)(wl + cl * 36);
#pragma unroll
                    for (int o4 = 0; o4 < 9; ++o4) { const f32x4 w = wr[o4];
#pragma unroll
                        for (int k = 0; k < 4; ++k) { acc[0][o4 * 4 + k] += x0 * w[k]; acc[1][o4 * 4 + k] += x1 * w[k]; } } }
            }
#pragma unroll
            for (int q = 0; q < 2; ++q)
#pragma unroll
                for (int o = 0; o < 36; ++o) { const float v = wave_sum(acc[q][o]); if (l == 0) lgt[(2 * pass + q) * 36 + o] = v; }
        }
        LDS_WAIT();
#pragma unroll
        for (int q = 0; q < 4; ++q) { const int t = t0 + q; const float rs = 1.0f / sqrtf(ss[q] * (1.f / DM) + RMS_EPS);
            float lg[4]; float gmax = -3.0e38f; int gsel = 0;
#pragma unroll
            for (int g = 0; g < 4; ++g) { lg[g] = lgt[q * 36 + g] * rs + brg[g]; if (lg[g] > gmax) { gmax = lg[g]; gsel = g; } }
            float gz = 0.f;
#pragma unroll
            for (int g = 0; g < 4; ++g) gz += __expf(lg[g] - gmax);
            const float pg = 1.0f / gz;
            float le[8];
#pragma unroll
            for (int e = 0; e < 8; ++e) { float a = lgt[q * 36 + 4 + e];
#pragma unroll
                for (int g = 1; g < 4; ++g) a = (gsel == g) ? lgt[q * 36 + 4 + g * 8 + e] : a;
                le[e] = a * rs + bre[gsel * 8 + e]; }
            float m1 = -3.0e38f, m2 = -3.0e38f; int e1 = 0, e2 = 0;
#pragma unroll
            for (int e = 0; e < 8; ++e) { if (le[e] > m1) { m2 = m1; e2 = e1; m1 = le[e]; e1 = e; } else if (le[e] > m2) { m2 = le[e]; e2 = e; } }
            const float xe = __expf(m2 - m1); const float w1 = pg / (1.0f + xe), w2 = pg * xe / (1.0f + xe);
            if (l == 0) { rstd3[t] = rs;
                const int E1 = gsel * 8 + e1, E2 = gsel * 8 + e2;
                const int p1 = atomicAdd(cnt + 64 * E1, 1), p2 = atomicAdd(cnt + 64 * E2, 1);
                lists[E1 * MT + p1] = t; lists[E2 * MT + p2] = t; slotw[E1 * MT + p1] = w1; slotw[E2 * MT + p2] = w2;
                route[t * 8 + 0] = E1; route[t * 8 + 1] = p1; route[t * 8 + 2] = E2; route[t * 8 + 3] = p2; }
        }
    }
}
struct MoeOrder {
    static constexpr bool GATHER = true;
    const volatile LAS int* tp; const int* cnt; const int* lists; const char* A; const char* B; int G, c, lognt; size_t bstride_e, bstride_t;
    bool gather;
    __device__ __forceinline__ bool next(int i, Unit& u) const {
        const int L = i * G + c; const int RT = tp[32]; if (L >= (RT << lognt)) return false;
        const int rt = L >> lognt, nt = L & ((1 << lognt) - 1); int e = 0;
        for (int q = 1; q < 32; ++q) e = (rt >= tp[q]) ? q : e;
        u.pm = rt; u.pn = nt; u.aux0 = e; u.aux1 = (rt - tp[e]) * 256;
        u.Ab = A; u.Bb = B + (size_t)e * bstride_e + (size_t)nt * bstride_t; return true;
    }
    __device__ __forceinline__ unsigned arow(const Unit& u, int r) const {
        if (!gather) return (unsigned)(u.pm * 256 + r);
        const int idx = u.aux1 + r; const int n = cnt[64 * u.aux0]; return idx < n ? (unsigned)lists[u.aux0 * MT + idx] : 0u;
    }
};
struct EpiMoe1 {
    static constexpr bool PERM = true;
    bf16* hid; const int* cnt; const int* lists; const float* slotw; const float* rstd;
    __device__ __forceinline__ void operator()(const PG8_ACC, const Unit& u, int wr, int wc, int fr, int fq) const {
        const int n = cnt[64 * u.aux0];
#pragma unroll
        for (int ai = 0; ai < 2; ++ai)
#pragma unroll
            for (int m = 0; m < 4; ++m) { const int r = ai * 128 + wr * 64 + m * 16 + fr; const int idx = u.aux1 + r; const bool ok = idx < n;
                const int tok = ok ? lists[u.aux0 * MT + idx] : 0; const float rs = rstd[tok]; const float wt = ok ? slotw[u.aux0 * MT + idx] : 0.f;
                f32x4 o0, o1;
#pragma unroll
                for (int j = 0; j < 4; ++j) { const float g0 = acc[ai][0][m][0][j] * rs, u0 = acc[ai][1][m][0][j] * rs, g1 = acc[ai][0][m][1][j] * rs, u1 = acc[ai][1][m][1][j] * rs;
                    o0[j] = g0 * sigmoidf_(g0) * u0 * wt; o1[j] = g1 * sigmoidf_(g1) * u1 * wt; }
                *(u32x4*)(hid + (size_t)(u.pm * 256 + r) * DE + u.pn * 128 + wc * 32 + 8 * fq) = pg8::pack8(o0, o1); }
    }
};
struct EpiMoe2 {
    static constexpr bool PERM = true;
    bf16* y;
    __device__ __forceinline__ void operator()(const PG8_ACC, const Unit& u, int wr, int wc, int fr, int fq) const {
        EPI_FOR(ai, m, bj) { const int row = u.pm * 256 + ai * 128 + wr * 64 + m * 16 + fr; const int col = u.pn * 256 + bj * 128 + wc * 32 + 8 * fq;
            *(u32x4*)(y + (size_t)row * DM + col) = pg8::pack8(acc[ai][bj][m][0], acc[ai][bj][m][1]); }
    }
};
__device__ __forceinline__ void moe_table(Frame& F) {
    if (F.tid == 0) { const int* cnt = (const int*)(F.ctl + CW_CNT); int acc = 0;
        for (int e = 0; e < 32; ++e) { F.MISC[16 + e] = (unsigned)acc; acc += (__hip_atomic_load(cnt + 64 * e, __ATOMIC_RELAXED, __HIP_MEMORY_SCOPE_AGENT) + 255) >> 8; }
        F.MISC[16 + 32] = (unsigned)acc; }
    __syncthreads();
}
__device__ __forceinline__ void p5_expert_cvt(Frame& F) {
    LAS float* scr = (LAS float*)(F.lds + F.wave * CVT_SCR); const int gw = F.vcu * 8 + F.wave, NGW = F.G * 8; unsigned char* ws = F.ws;
#define EX_DESC(it_, d) do { const int e = (it_) / 768, r = (it_) % 768; \
        if (r < 256) { d.W = F.in[I_WEG] + (size_t)e * DM * DE; d.gain = F.in[I_GFFN]; d.WT = (bf16*)(ws + WS_WGU) + (size_t)e * 1024 * DM; d.K = DM; d.N = DE; d.ldt = DM; d.mode = 3; d.kofs = 0; d.item = r; } \
        else if (r < 512) { d.W = F.in[I_WEU] + (size_t)e * DM * DE; d.gain = F.in[I_GFFN]; d.WT = (bf16*)(ws + WS_WGU) + (size_t)e * 1024 * DM; d.K = DM; d.N = DE; d.ldt = DM; d.mode = 4; d.kofs = 0; d.item = r - 256; } \
        else { d.W = F.in[I_WED] + (size_t)e * DE * DM; d.gain = nullptr; d.WT = (bf16*)(ws + WS_WD) + (size_t)e * DM * DE; d.K = DE; d.N = DM; d.ldt = DE; d.mode = 0; d.kofs = 0; d.item = r - 512; } } while (0)
    CVT_PIPE(NE * 768, EX_DESC);
#undef EX_DESC
}

struct Args { const float* in[41]; float* out; unsigned char* ws; int ph_lo, ph_hi; };
constexpr int NPHASE = 16;
__global__ void __launch_bounds__(512, 2) fwd_kernel(Args args) {
    extern __shared__ __attribute__((aligned(16))) unsigned char lds_raw[];
    Frame F;
    F.lds = (LAS unsigned char*)lds_raw; F.MISC = (volatile LAS unsigned*)(F.lds + MISC_OFF);
    F.tid = threadIdx.x; F.lane = F.tid & 63; F.wave = __builtin_amdgcn_readfirstlane(F.tid >> 6);
    F.G = gridDim.x; { const int bx = blockIdx.x; F.vcu = (F.G % 8 == 0) ? (bx % 8) * (F.G / 8) + bx / 8 : bx; }
    F.ws = args.ws; F.out = args.out; F.ctl = (unsigned*)(args.ws + WS_CTL);
#pragma unroll
    for (int i = 0; i < 41; ++i) F.in[i] = args.in[i];
    for (int u = F.tid; u < (LDS_BYTES - LDSCTL_OFF) / 4; u += 512) ((LAS unsigned*)(F.lds + LDSCTL_OFF))[u] = 0u;
    __syncthreads();
    XcdBarrier bar; bar.bar = F.ctl + CW_BAR; bar.x = 0; bar.st = nullptr;
    const int lo = args.ph_lo, hi = args.ph_hi;
    if (hi - lo > 1) bar = xcd_barrier_post(F.ctl + CW_BAR, F.MISC + 8);
#ifndef ATT_DQK_TEST
#define ATT_DQK_TEST QKD
#endif
#define PROBE_N (MT * 768)
#ifndef LSEL
#define LSEL 31
#endif
#ifndef PH_MASK
#define PH_MASK 0xFFFFu
#endif
#ifndef SCAN_MFMA
#define SCAN_MFMA 1
#endif
#ifndef SCAN_DUMMY
#define SCAN_DUMMY 0
#endif
#ifndef REPEAT_MASK
#define REPEAT_MASK 0x0u
#endif
#define REP(k) _Pragma("unroll") for (int _rep = 0; _rep <= (int)(((REPEAT_MASK) >> (k)) & 1u); ++_rep)
#define IN(k) ((((PH_MASK) >> (k)) & 1u) && lo <= (k) && (k) < hi)
#ifndef PROBE_TIME
#define PROBE_TIME -1
#endif
#define SEAM(k) do { if (lo <= (k) && (k) + 1 < hi) xcd_barrier(bar); if (PROBE_TIME >= 0 && blockIdx.x == 0 && F.tid == 0) { const unsigned long long _t = wall_clock64(); F.MISC[64 + 2 * ((k) + 1)] = (unsigned)_t; F.MISC[65 + 2 * ((k) + 1)] = (unsigned)(_t >> 32); } } while (0)
    unsigned char* ws = args.ws;

    bf16* const zmla = (bf16*)(ws + WS_ZMLA); bf16* const loraA = (bf16*)(ws + WS_LORAA);
    float* const rstd1 = (float*)(ws + WS_RSTD); float* const rstd_q = rstd1 + MT; float* const rstd_kv = rstd1 + 2 * MT;
    const int bid = (int)blockIdx.x;
    if (PROBE_TIME >= 0 && blockIdx.x == 0 && F.tid == 0) { const unsigned long long _t = wall_clock64(); F.MISC[64] = (unsigned)_t; F.MISC[65] = (unsigned)(_t >> 32); }
    if (IN(0)) { REP(0) p0_prologue(F); }
    SEAM(0);
    if (IN(1)) {
        if (EN_RWKV || EN_MLA) REP(1) { pg8::StaticOrder S; S.init((const bf16*)(ws + WS_XB), DM, (const bf16*)(ws + WS_WIN), DM, MT, G1_N, F.G, bid);
          EpiG1 E{rstd1, zmla, (bf16*)(ws + WS_ZRKV), (bf16*)(ws + WS_ZLORA), (bf16*)(ws + WS_ZGATE)};
          pg8::gemm_phase(F.lds, DM, DM, DM, S, E); }
        else p_copy_x(F);
    }
    SEAM(1);
    if (IN(2)) { if (EN_RWKV || EN_MLA) REP(2) p2_rowpass(F); }
    SEAM(2);
    if (IN(3)) REP(3) {
        if (EN_MLA) {
            { pg8::StaticOrder S; S.init(zmla, ZM_LD, (const bf16*)(ws + WS_WUQ), QLORA, MT, MH * QKD, F.G, bid);
              EpiQ E{ws + WS_Q, rstd_q, (const float*)(ws + WS_ROPE)};
              pg8::gemm_phase(F.lds, QLORA, ZM_LD, QLORA, S, E); }
            { pg8::StaticOrder S; S.init(zmla + QLORA, ZM_LD, (const bf16*)(ws + WS_WUKV), KVLORA, MT, MH * 256, F.G, bid);
              EpiKV E{ws + WS_K, (bf16*)(ws + WS_V), rstd_kv};
              pg8::gemm_phase(F.lds, KVLORA, ZM_LD, KVLORA, S, E); }
        }
        if (EN_RWKV) {
            { pg8::StaticOrder S; S.init(loraA, LA_LD, (const bf16*)(ws + WS_W2F), 256, MT, 2 * RW, F.G, bid);
              EpiLora2<0> E{(bf16*)(ws + WS_WLF), (bf16*)(ws + WS_WLB), F.in[I_W0F], F.in[I_W0B]}; pg8::gemm_phase(F.lds, 256, LA_LD, 256, S, E); }
            { pg8::StaticOrder S; S.init(loraA + 256, LA_LD, (const bf16*)(ws + WS_W2F + 2 * MiB), 256, MT, 2 * RW, F.G, bid);
              EpiLora2<1> E{(bf16*)(ws + WS_ICF), (bf16*)(ws + WS_ICB), F.in[I_A0F], F.in[I_A0B]}; pg8::gemm_phase(F.lds, 256, LA_LD, 256, S, E); }
            if (LSEL & 16) { pg8::StaticOrder S; S.init(loraA + 512, LA_LD, (const bf16*)(ws + WS_G2), GLORA, MT, RW, F.G, bid);
              EpiLora<2> E{(bf16*)(ws + WS_G), nullptr}; pg8::gemm_phase(F.lds, GLORA, LA_LD, GLORA, S, E); }
        }
    }
    SEAM(3);
    if (IN(4)) {
        constexpr int NSCAN = NB * RH * 2, NATT = NB * MH * (SEQ / 256);
        int s_begin = F.vcu, s_end = NSCAN, s_step = F.G, a_begin = F.vcu, a_step = F.G, a_cnt = (F.vcu < NATT) ? (NATT - 1 - F.vcu) / F.G + 1 : 0;
        if (EN_RWKV && EN_MLA && F.G == 256) { s_step = 1; a_step = 1;
            if (F.vcu < 128) { s_end = F.vcu + 1; a_begin = 384 + F.vcu; a_cnt = 1; } else { s_end = 0; a_begin = (F.vcu - 128) * 3; a_cnt = 3; } }
        if (EN_RWKV) for (int u = s_begin; u < s_end; u += s_step) { const int dir = u & 1, bh = u >> 1;
            if (dir) scan2::scan_unit<1>(F, bh >> 5, bh & 31); else scan2::scan_unit<0>(F, bh >> 5, bh & 31); }
        if (EN_MLA) for (int i = 0; i < a_cnt; ++i) { const int L = a_begin + i * a_step; const int qb = L & 15, bh = L >> 4, b = bh >> 4, h = bh & 15;
            att::attn_unit_f8<MH * QKD, MH * QKD, MH * VDIM, DM>(ws + WS_Q + ((size_t)(b * SEQ + qb * 256) * (MH * QKD) + h * QKD),
                                ws + WS_K + ((size_t)b * SEQ * (MH * QKD) + h * QKD),
                                (const bf16*)(ws + WS_V) + ((size_t)b * SEQ * (MH * VDIM) + h * VDIM),
                                (bf16*)(ws + WS_OMLA) + ((size_t)(b * SEQ + qb * 256) * DM + h * VDIM), SEQ, QSCALE, (LAS char*)F.lds); }
    }
    SEAM(4);
    if (IN(5)) { if (EN_RWKV) REP(5) p5_post(F); if (EN_MOE) REP(17) p5_expert_cvt(F); }
    SEAM(5);
    if (IN(6)) REP(6) {
        if (EN_MLA) { pg8::StaticOrder S; S.init((const bf16*)(ws + WS_OMLA), DM, (const bf16*)(ws + WS_WUPM), DM, MT, DM, F.G, bid);
            EpiUp<0> E{(bf16*)(ws + WS_MERGED), (const bf16*)(ws + WS_ZGATE), 0}; pg8::gemm_phase(F.lds, DM, DM, DM, S, E); }
        if (EN_RWKV) { pg8::StaticOrder S; S.init((const bf16*)(ws + WS_ORWKV), DM, (const bf16*)(ws + WS_WUPR), DM, MT, DM, F.G, bid);
            EpiUp<EN_MLA> E{(bf16*)(ws + WS_MERGED), (const bf16*)(ws + WS_ZGATE), DM}; pg8::gemm_phase(F.lds, DM, DM, DM, S, E); }
    }
    SEAM(6);
    if (IN(7)) REP(7) {
        if (EN_RWKV || EN_MLA) { pg8::StaticOrder S; S.init((const bf16*)(ws + WS_MERGED), DM, (const bf16*)(ws + WS_WOUT), DM, MT, DM, F.G, bid);
            EpiResid E{F.in[I_X], F.out}; pg8::gemm_phase(F.lds, DM, DM, DM, S, E); }
    }
    SEAM(7);
    if (IN(8)) { if (EN_CROSS || EN_MOE) p8_rowpass(F); }
    SEAM(8);
    if (IN(9)) REP(9) {
        if (EN_CROSS) { pg8::StaticOrder S; S.init((const bf16*)(ws + WS_H1B), DM, (const bf16*)(ws + WS_WQC), DM, MT, CW, F.G, bid);
            EpiPlain E{(bf16*)(ws + WS_QC), CW, rstd1 + 3 * MT, CSCALE}; pg8::gemm_phase(F.lds, DM, DM, DM, S, E); }
        if (EN_CROSS && bid >= 64) { pg8::StaticOrder S; S.init((const bf16*)(ws + WS_MEMN), DM, (const bf16*)(ws + WS_WKVC), DM, NB * MEMLEN, 2 * CW, F.G, bid - 64);
            EpiPlain E{(bf16*)(ws + WS_KVC), 2 * CW, nullptr, 1.f}; pg8::gemm_phase(F.lds, DM, DM, DM, S, E); }
    }
    SEAM(9);
    if (IN(10)) REP(10) {
        if (EN_CROSS) {
            for (int i = 0; ; ++i) { const int L = i * F.G + F.vcu; if (L >= NB * CH * (SEQ / 256)) break;
                const int qb = L & 15, bh = L >> 4, b = bh >> 2, h = bh & 3;
                att::attn_unit<CHD, CW, 2 * CW, 2 * CW, CW>((const bf16*)(ws + WS_QC) + ((size_t)(b * SEQ + qb * 256) * CW + h * CHD),
                                    (const bf16*)(ws + WS_KVC) + ((size_t)b * MEMLEN * (2 * CW) + h * CHD),
                                    (const bf16*)(ws + WS_KVC) + ((size_t)b * MEMLEN * (2 * CW) + CW + h * CHD),
                                    (bf16*)(ws + WS_OC) + ((size_t)(b * SEQ + qb * 256) * CW + h * CHD), MEMLEN, (LAS char*)F.lds); }
        }
    }
    SEAM(10);
    if (IN(11)) {
        if (EN_CROSS) { pg8::StaticOrder S; S.init((const bf16*)(ws + WS_OC), CW, (const bf16*)(ws + WS_WOC), CW, MT, DM, F.G, bid);
            EpiResid E{F.out, F.out}; pg8::gemm_phase(F.lds, CW, CW, CW, S, E); }
    }
    SEAM(11);
    if (IN(12)) { if (EN_MOE) p12_router(F); }
    SEAM(12);
    if (IN(13)) REP(13) {
        if (EN_MOE) { moe_table(F);
            MoeOrder S{(const volatile LAS int*)(F.MISC + 16), (const int*)(F.ctl + CW_CNT), (const int*)(ws + WS_LIST), (const char*)(ws + WS_N3), (const char*)(ws + WS_WGU), F.G, F.vcu, 2,
                       (size_t)1024 * DM * 2, (size_t)256 * DM * 2, true};
            EpiMoe1 E{(bf16*)(ws + WS_HID), (const int*)(F.ctl + CW_CNT), (const int*)(ws + WS_LIST), (const float*)(ws + WS_SLOTW), rstd1 + 4 * MT};
            pg8::gemm_phase(F.lds, DM, DM, DM, S, E); }
    }
    SEAM(13);
    if (IN(14)) REP(14) {
        if (EN_MOE) { moe_table(F);
            MoeOrder S{(const volatile LAS int*)(F.MISC + 16), (const int*)(F.ctl + CW_CNT), (const int*)(ws + WS_LIST), (const char*)(ws + WS_HID), (const char*)(ws + WS_WD), F.G, F.vcu, 3,
                       (size_t)DM * DE * 2, (size_t)256 * DE * 2, false};
            EpiMoe2 E{(bf16*)(ws + WS_YBUF)};
            pg8::gemm_phase(F.lds, DE, DE, DE, S, E); }
    }
    SEAM(14);
#ifdef PROBE_OFF
    if (IN(15)) { const int gt = F.vcu * 512 + F.tid, NGT = F.G * 512; const bf16* sb = (const bf16*)(ws + (size_t)PROBE_OFF * MiB);
        for (int i = gt; i < MT * DM; i += NGT) F.out[i] = (i < PROBE_N) ? bf2f(sb[i]) : 0.f; }
#else
    if (IN(15)) { p_final(F, EN_MOE != 0); }
#endif
    if (SCAN_SEC == 20) { if (blockIdx.x == 0 && F.wave == 0) { const float e = att::f8_map_probe(F.lane); if (F.lane == 0) F.out[(size_t)(F.vcu * 8) * DM] += 10.f + e; } }
    if (SCAN_SEC >= 0 && SCAN_SEC < 20) { __syncthreads(); if (blockIdx.x == 0 && F.tid == 0) { const unsigned long long c = ((unsigned long long)F.MISC[121] << 32) | F.MISC[120]; F.out[(size_t)(F.vcu * 8) * DM] += (float)c * 1e-4f; } }
    if (PROBE_TIME >= 0) { __syncthreads(); if (blockIdx.x == 0 && F.tid == 0) {
        const unsigned long long a = ((unsigned long long)F.MISC[65 + 2 * PROBE_TIME] << 32) | F.MISC[64 + 2 * PROBE_TIME], b = ((unsigned long long)F.MISC[65 + 2 * (PROBE_TIME + 1)] << 32) | F.MISC[64 + 2 * (PROBE_TIME + 1)];
        F.out[(size_t)(F.vcu * 8) * DM] += (float)(b - a) * 0.001f; } }
#undef IN
#undef SEAM
}

extern "C" void kernel_launch(void* const* d_in, const int* in_sizes, int n_in, void* d_out, int out_size, void* d_ws, size_t ws_size, hipStream_t stream) {
    static int grid = 0;
    if (grid == 0) {
        if (n_in != 41 || out_size != MT * DM || ws_size < WS_END) { fprintf(stderr, "kernel_launch: unexpected shapes n_in %d out %d ws %zu (need %zu)\n", n_in, out_size, ws_size, (size_t)WS_END); grid = -1; return; }
        int dev = 0, cus = 0, per_cu = 0;
        if (hipGetDevice(&dev) != hipSuccess || hipDeviceGetAttribute(&cus, hipDeviceAttributeMultiprocessorCount, dev) != hipSuccess) { grid = -1; return; }
        if (hipFuncSetAttribute((const void*)fwd_kernel, hipFuncAttributeMaxDynamicSharedMemorySize, LDS_BYTES) != hipSuccess) { fprintf(stderr, "kernel_launch: hipFuncSetAttribute failed\n"); grid = -1; return; }
        if (hipOccupancyMaxActiveBlocksPerMultiprocessor(&per_cu, (const void*)fwd_kernel, 512, LDS_BYTES) != hipSuccess || per_cu < 1) { fprintf(stderr, "kernel_launch: occupancy query says %d\n", per_cu); }
        (void)hipGetLastError();
        grid = cus;
    }
    if (grid < 0) return;
    (void)hipMemsetAsync((char*)d_ws + WS_CTL, 0, CTL_BYTES, stream);
    Args a{};
    for (int i = 0; i < 41; ++i) a.in[i] = (const float*)d_in[i];
    a.out = (float*)d_out; a.ws = (unsigned char*)d_ws;
#if N_LAUNCH_SPLIT
    for (int p = 0; p < NPHASE; ++p) { a.ph_lo = p; a.ph_hi = p + 1; hipLaunchKernelGGL(fwd_kernel, dim3(grid), dim3(512), LDS_BYTES, stream, a); }
#else
    a.ph_lo = 0; a.ph_hi = NPHASE;
    hipLaunchKernelGGL(fwd_kernel, dim3(grid), dim3(512), LDS_BYTES, stream, a);
#endif
}
```

```cpp
#include <hip/hip_runtime.h>
#include <cstdio>
#include <cstdint>

#ifndef SCAN_PW
#define SCAN_PW 0
#endif
#ifndef SCAN_SEC
#define SCAN_SEC -1
#endif
#ifndef EN_RWKV
#define EN_RWKV 1
#endif
#ifndef EN_MLA
#define EN_MLA 1
#endif
#ifndef EN_CROSS
#define EN_CROSS 1
#endif
#ifndef EN_MOE
#define EN_MOE 1
#endif
#ifndef N_LAUNCH_SPLIT
#define N_LAUNCH_SPLIT 0
#endif

#define GAS __attribute__((address_space(1)))
#define LAS __attribute__((address_space(3)))
typedef unsigned short bf16;
typedef short bf16x8 __attribute__((ext_vector_type(8)));
typedef short s16x4 __attribute__((ext_vector_type(4)));
typedef float f32x4 __attribute__((ext_vector_type(4)));
typedef float f32x2 __attribute__((ext_vector_type(2)));
typedef float f32x16 __attribute__((ext_vector_type(16)));
typedef unsigned u32x4 __attribute__((ext_vector_type(4)));
typedef unsigned u32x2 __attribute__((ext_vector_type(2)));

constexpr int DM = 2048, NB = 2, SEQ = 4096, MT = NB * SEQ;
constexpr int MEMLEN = 256;
constexpr int QLORA = 512, KVLORA = 256, ROPE = 64, NOPE = 128, VDIM = 128, QKD = 192, MH = 16;
constexpr int RW = 2048, RH = 32, RHD = 64, DLORA = 96, GLORA = 256;
constexpr int MLA_IN = 832, RWKV_IN = 6784, GATE_IN = 4096, IN_W = MLA_IN + RWKV_IN + GATE_IN;
constexpr int CH = 4, CHD = 128, CW = 512;
constexpr int NG = 4, EPG = 8, NE = 32, DE = 512;
constexpr float RMS_EPS = 1e-6f, LNX_EPS = 64e-5f;
constexpr int G1_N = 12032;
constexpr int ZM_LD = 1024, ZR_LD = 6144, ZL_LD = 768, ZG_LD = 4096, LA_LD = 768;
constexpr int MOE_SLOTS = 2 * MT + NE * 256;

constexpr size_t MiB = 1u << 20;
constexpr size_t WS_CTL = 0, CTL_BYTES = 1 * MiB;
constexpr size_t WS_WUQ = 1 * MiB;
constexpr size_t WS_WUKV = 4 * MiB;
constexpr size_t WS_W2F = 6 * MiB;
constexpr size_t WS_G2 = 10 * MiB;
constexpr size_t WS_WUPM = 11 * MiB, WS_WUPR = 19 * MiB, WS_WOUT = 27 * MiB;
constexpr size_t WS_WQC = 35 * MiB;
constexpr size_t WS_WKVC = 37 * MiB;
constexpr size_t WS_WOC = 41 * MiB;
constexpr size_t WS_WIN = 43 * MiB;
constexpr size_t WS_MISC = 90 * MiB;
constexpr size_t WS_ROPE = WS_MISC;
constexpr size_t WS_MEMN = WS_MISC + 2 * MiB;
constexpr size_t WS_KVC = WS_MISC + 4 * MiB;
constexpr size_t WS_RSTD = WS_MISC + 5 * MiB;
constexpr size_t WS_WR = WS_RSTD + 256 * 1024;
constexpr size_t WS_LIST = WS_MISC + 6 * MiB;
constexpr size_t WS_ROUTE = WS_MISC + 7 * MiB;
constexpr size_t WS_SLOTW = WS_MISC + 8 * MiB;
constexpr size_t WS_XB = 100 * MiB;
constexpr size_t WS_ZMLA = 132 * MiB;
constexpr size_t WS_ZLORA = 148 * MiB;
constexpr size_t WS_LORAA = 160 * MiB;
constexpr size_t WS_ZRKV = 172 * MiB;
constexpr size_t WS_ZGATE = 268 * MiB;
constexpr size_t WS_Q = 332 * MiB;
constexpr size_t WS_K = 380 * MiB;
constexpr size_t WS_V = 428 * MiB;
constexpr size_t WS_WLF = 460 * MiB, WS_WLB = 492 * MiB, WS_ICF = 524 * MiB, WS_ICB = 556 * MiB;
constexpr size_t WS_G = 588 * MiB;
constexpr size_t WS_END = 620 * MiB;
constexpr size_t WS_YF = WS_WIN, WS_YB = WS_ZMLA, WS_ORWKV = WS_Q, WS_MERGED = WS_K, WS_QC = WS_V, WS_OC = WS_V + 8 * MiB;
constexpr size_t WS_WGU = WS_WLF, WS_WD = WS_ZRKV, WS_HID = WS_ZGATE, WS_YBUF = WS_Q;
constexpr size_t WS_OMLA = WS_XB, WS_H1B = WS_XB, WS_N3 = WS_XB;

constexpr int CW_BAR = 4096;
constexpr int CW_COLMAX = 32768;
constexpr int CW_CNT = 16384;

constexpr int RING_BYTES = 159744;
constexpr int LDSCTL_OFF = RING_BYTES, MISC_OFF = LDSCTL_OFF + 320;
constexpr int LDS_BYTES = 161792;

#define LDS_WAIT() asm volatile("s_waitcnt lgkmcnt(0)" ::: "memory")
#define VM_WAIT() asm volatile("s_waitcnt vmcnt(0)" ::: "memory")
typedef __bf16 bf16x2_t __attribute__((ext_vector_type(2)));
__device__ __forceinline__ unsigned cvt_pk_bf16(float lo, float hi) { f32x2 v = {lo, hi}; bf16x2_t b = __builtin_convertvector(v, bf16x2_t); return __builtin_bit_cast(unsigned, b); }
__device__ __forceinline__ float bf2f(unsigned short b) { return __builtin_bit_cast(float, ((unsigned)b) << 16); }
__device__ __forceinline__ float bflo(unsigned w) { return __builtin_bit_cast(float, w << 16); }
__device__ __forceinline__ float bfhi(unsigned w) { return __builtin_bit_cast(float, w & 0xffff0000u); }
__device__ __forceinline__ unsigned short f2bf(float f) { return (unsigned short)(cvt_pk_bf16(f, 0.f) & 0xffffu); }
__device__ __forceinline__ float sigmoidf_(float x) { return __builtin_amdgcn_rcpf(1.0f + __builtin_amdgcn_exp2f(-1.4426950408889634f * x)); }
template <int CTRL> __device__ __forceinline__ float dpp_add_(float v) {
    return v + __builtin_bit_cast(float, __builtin_amdgcn_update_dpp(0, __builtin_bit_cast(int, v), CTRL, 0xF, 0xF, false));
}
__device__ __forceinline__ float wave_sum(float v) {
    v = dpp_add_<0xB1>(v); v = dpp_add_<0x4E>(v); v = dpp_add_<0x141>(v); v = dpp_add_<0x140>(v);
    const int iv = __builtin_bit_cast(int, v);
    const float s0 = __builtin_bit_cast(float, __builtin_amdgcn_readlane(iv, 0)), s1 = __builtin_bit_cast(float, __builtin_amdgcn_readlane(iv, 16));
    const float s2 = __builtin_bit_cast(float, __builtin_amdgcn_readlane(iv, 32)), s3 = __builtin_bit_cast(float, __builtin_amdgcn_readlane(iv, 48));
    return (s0 + s1) + (s2 + s3);
}

#define XB_TMO      128
#define XB_XCNT(j)  (256  + 64 * (j))
#define XB_XSUB(j)  (1280 + 64 * (j))
#define XB_XGEN(j)  (2304 + 64 * (j))
#define XB_TOP      3328
#define XB_TOPGEN   3392
#define XCD_BAR_WORDS 3456
#define XB_SPIN_CAP (1u << 18)
__device__ __forceinline__ unsigned xb_ld(unsigned* p)              { return __hip_atomic_load(p, __ATOMIC_RELAXED, __HIP_MEMORY_SCOPE_AGENT); }
__device__ __forceinline__ unsigned xb_add(unsigned* p, unsigned v) { return __hip_atomic_fetch_add(p, v, __ATOMIC_RELAXED, __HIP_MEMORY_SCOPE_AGENT); }
__device__ __forceinline__ unsigned xb_xcc_id() { return (unsigned)__builtin_amdgcn_s_getreg((3 << 11) | 20) & 0xFu; }
#define XB_SPIN(cond, bar) do { unsigned _sp = 0; while (cond) { __builtin_amdgcn_s_sleep(1); \
    if ((++_sp & 255u) == 0u) { if (xb_ld(&(bar)[XB_TMO])) break; if (_sp > XB_SPIN_CAP) { atomicAdd(&(bar)[XB_TMO], 1u); break; } } } } while (0)
struct XcdBarrier { unsigned* bar; unsigned x; volatile LAS unsigned* st; };
__device__ __forceinline__ XcdBarrier xcd_barrier_post(unsigned* bar, volatile LAS unsigned* st) {
    XcdBarrier b; b.bar = bar; b.x = xb_xcc_id(); b.st = st;
    if (threadIdx.x == 0) (void)xb_add(&bar[XB_XCNT(b.x)], 1u);
    return b;
}
__device__ __forceinline__ void xcd_barrier_complete(unsigned* bar, unsigned x, unsigned& nloc, unsigned& nx) {
    const unsigned G = gridDim.x * gridDim.y * gridDim.z;
    unsigned sum, cnt, mine, sp = 0u;
    for (;;) {
        sum = 0u; cnt = 0u; mine = 0u;
#pragma unroll
        for (unsigned j = 0; j < 16; ++j) { const unsigned c = xb_ld(&bar[XB_XCNT(j)]); sum += c; cnt += (c > 0u) ? 1u : 0u; mine = (j == x) ? c : mine; }
        if (sum == G) break;
        __builtin_amdgcn_s_sleep(1);
        if ((++sp & 255u) == 0u) { if (xb_ld(&bar[XB_TMO])) break; if (sp > XB_SPIN_CAP) { atomicAdd(&bar[XB_TMO], 1u); break; } }
    }
    nloc = mine > 0u ? mine : 1u; nx = cnt > 0u ? cnt : 1u;
}
__device__ __forceinline__ void xcd_barrier(const XcdBarrier& b) {
    asm volatile("s_waitcnt vmcnt(0)" ::: "memory");
    __syncthreads();
    if (threadIdx.x == 0) {
        unsigned* bar = b.bar;
        __builtin_amdgcn_s_waitcnt(0);
        unsigned nloc = b.st[0], nx = b.st[1];
        if (nloc == 0u) { xcd_barrier_complete(bar, b.x, nloc, nx); b.st[0] = nloc; b.st[1] = nx; }
        const unsigned old = xb_add(&bar[XB_XSUB(b.x)], 1u);
        const unsigned gen = old / nloc;
        if (old + 1u == (gen + 1u) * nloc) {
            __builtin_amdgcn_fence(__ATOMIC_RELEASE, "agent");
            asm volatile("s_waitcnt vmcnt(0)" ::: "memory");
            const unsigned og = xb_add(&bar[XB_TOP], 1u);
            const unsigned tg = og / nx;
            if (og + 1u == (tg + 1u) * nx) xb_add(&bar[XB_TOPGEN], 1u);
            else XB_SPIN(xb_ld(&bar[XB_TOPGEN]) == tg, bar);
            __builtin_amdgcn_fence(__ATOMIC_ACQUIRE, "agent");
            xb_add(&bar[XB_XGEN(b.x)], 1u);
            asm volatile("s_waitcnt vmcnt(0)" ::: "memory");
        } else {
            XB_SPIN(xb_ld(&bar[XB_XGEN(b.x)]) == gen, bar);
            __builtin_amdgcn_fence(__ATOMIC_ACQUIRE, "agent");
            asm volatile("s_waitcnt vmcnt(0)" ::: "memory");
        }
    }
    __syncthreads();
}

namespace pg8 {
constexpr int BM = 256, BK = 64, HALF = 128, HTB = HALF * BK * 2, STAGE_BYTES = 8 * HTB, NXCD = 8, WGM = 8;
__host__ __device__ __forceinline__ int lds_byte(int r, int c) { const int st = (r >> 4) * 2 + (c >> 5), rr = r & 15, cc = c & 31, ob = rr * 64 + cc * 2; return st * 1024 + (ob ^ (((ob >> 9) & 1) << 5)); }
__host__ __device__ __forceinline__ void stage_rc(int b, int& R, int& C) { const int st = b / 1024, sb = b % 1024, swz = sb ^ (((sb >> 9) & 1) << 5); R = (st >> 1) * 16 + swz / 64; C = (st & 1) * 32 + (swz % 64) / 2; }
__host__ __device__ __forceinline__ int perm32(int rho) { const int n = rho >> 4, i = rho & 15; return 8 * (i >> 2) + 4 * n + (i & 3); }

struct Unit { int pm, pn; const char* Ab; const char* Bb; int aux0, aux1; };

struct StaticOrder {
    static constexpr bool GATHER = false;
    int nM, nN, nwg, G, c; const char* A; const char* Bt; int lda, ldb;
    __device__ void init(const bf16* A_, int lda_, const bf16* Bt_, int ldb_, int M, int N, int G_, int c_) { A = (const char*)A_; Bt = (const char*)Bt_; lda = lda_; ldb = ldb_; nM = M / BM; nN = N / BM; nwg = nM * nN; G = G_; c = c_; }
    __device__ __forceinline__ bool next(int i, Unit& u) const {
        const long L = (long)i * G + c; if (L >= nwg) return false;
        int wgid = (int)L; { const int q = nwg / NXCD, r = nwg % NXCD, xcd = wgid % NXCD, off = wgid / NXCD; wgid = (xcd < r ? xcd * (q + 1) : r * (q + 1) + (xcd - r) * q) + off; }
        const int nig = WGM * nN, gid = wgid / nig, fm = gid * WGM, gsz = (nM - fm) < WGM ? (nM - fm) : WGM;
        u.pm = fm + ((wgid % nig) % gsz); u.pn = (wgid % nig) / gsz; u.Ab = A + (size_t)u.pm * BM * lda * 2; u.Bb = Bt + (size_t)u.pn * BM * ldb * 2; u.aux0 = 0; u.aux1 = 0; return true;
    }
    __device__ __forceinline__ unsigned arow(const Unit& u, int r) const { return (unsigned)r; }
};

#define PG8_ACC f32x4 (&acc)[2][2][4][2]
typedef int i32x4g __attribute__((ext_vector_type(4)));
template <class Epi, class Sched, bool I8 = false>
__device__ __forceinline__ void gemm_phase(LAS unsigned char* lds, const int K, const int lda, const int ldb, const Sched& S, const Epi& E) {
    const int tid = threadIdx.x, wid = __builtin_amdgcn_readfirstlane(tid >> 6), lane = tid & 63, wr = wid >> 2, wc = wid & 3, fr = lane & 15, fq = lane >> 4;
    const int nt = K / BK;
    int sR[2], sC[2]; unsigned voffB[2];
#pragma unroll
    for (int i = 0; i < 2; ++i) { stage_rc(tid * 16 + i * 8192, sR[i], sC[i]); const int Rb = Epi::PERM ? ((sR[i] & ~31) + perm32(sR[i] & 31)) : sR[i];
        voffB[i] = (unsigned)(Rb * ldb + sC[i]) * 2u; }
    const size_t kstep = (size_t)(BK * 2);
    const size_t hstepB = (size_t)HALF * ldb * 2;
    const unsigned ldsw = (unsigned)wid * 1024u;
    const int aoff = lds_byte(wr * 64 + fr, fq * 8), boff = lds_byte(wc * 32 + fr, fq * 8);
#define PG8_SA(b, h) (((b) * 2 + (h)) * HTB)
#define PG8_SB(b, h) ((4 + (b) * 2 + (h)) * HTB)
#define PG8_STAGE(bufoff, gbase, voff) do { _Pragma("unroll") for (int _i = 0; _i < 2; ++_i) \
        __builtin_amdgcn_global_load_lds((const unsigned*)((const char*)(gbase) + (voff)[_i]), (LAS unsigned*)(lds + (bufoff) + ldsw + _i * 8192), 16, 0, 0); } while (0)
#define PG8_LDA(dst, b, h) do { _Pragma("unroll") for (int m = 0; m < 4; ++m) _Pragma("unroll") for (int k = 0; k < 2; ++k) dst[m][k] = *(const LAS bf16x8*)(lds + PG8_SA(b, h) + aoff + m * 2048 + k * 1024); } while (0)
#define PG8_LDB(dst, b, h) do { _Pragma("unroll") for (int n = 0; n < 2; ++n) _Pragma("unroll") for (int k = 0; k < 2; ++k) dst[n][k] = *(const LAS bf16x8*)(lds + PG8_SB(b, h) + boff + n * 2048 + k * 1024); } while (0)
#define PG8_MMA(ai, bj, At, Bt) do { __builtin_amdgcn_s_setprio(1); _Pragma("unroll") for (int m = 0; m < 4; ++m) _Pragma("unroll") for (int n = 0; n < 2; ++n) _Pragma("unroll") for (int k = 0; k < 2; ++k) { \
        if constexpr (I8) acc[ai][bj][m][n] = __builtin_bit_cast(f32x4, __builtin_amdgcn_mfma_i32_16x16x64_i8(__builtin_bit_cast(i32x4g, Bt[n][k]), __builtin_bit_cast(i32x4g, At[m][k]), __builtin_bit_cast(i32x4g, acc[ai][bj][m][n]), 0, 0, 0)); \
        else acc[ai][bj][m][n] = __builtin_amdgcn_mfma_f32_16x16x32_bf16(Bt[n][k], At[m][k], acc[ai][bj][m][n], 0, 0, 0); } __builtin_amdgcn_s_setprio(0); } while (0)
#define PG8_WAIT_V(n) asm volatile("s_waitcnt vmcnt(" #n ")" ::: "memory")
#define PG8_WAIT_L(n) asm volatile("s_waitcnt lgkmcnt(" #n ")" ::: "memory")
#define PG8_BAR __builtin_amdgcn_s_barrier()
#define PG8_SCHED __builtin_amdgcn_sched_barrier(0)
#define PG8_SETVA(dst, u) do { _Pragma("unroll") for (int _h = 0; _h < 2; ++_h) _Pragma("unroll") for (int _i = 0; _i < 2; ++_i) \
        dst[_h][_i] = (S.arow(u, _h * HALF + sR[_i]) * (unsigned)lda + (unsigned)sC[_i]) * 2u; } while (0)
    Unit cur, nxt; int ui = 0;
    if (!S.next(0, cur)) return;
    f32x4 acc[2][2][4][2];
#pragma unroll
    for (int a = 0; a < 2; ++a)
#pragma unroll
        for (int b = 0; b < 2; ++b)
#pragma unroll
            for (int m = 0; m < 4; ++m)
#pragma unroll
                for (int n = 0; n < 2; ++n) acc[a][b][m][n] = (f32x4){0.f, 0.f, 0.f, 0.f};
    bf16x8 At[4][2], B0[2][2], B1[2][2];
    constexpr bool GA = Sched::GATHER;
    unsigned vA[2][2], nvA[2][2];
    PG8_SETVA(vA, cur);
    const char* cA = cur.Ab; const char* cB = cur.Bb;
    PG8_STAGE(PG8_SB(0, 0), cB, voffB); PG8_STAGE(PG8_SA(0, 0), cA, vA[0]); PG8_STAGE(PG8_SB(0, 1), cB + hstepB, voffB); PG8_STAGE(PG8_SA(0, 1), cA, vA[1]);
    if (wr == 1) PG8_BAR;
    PG8_WAIT_V(4); PG8_BAR;
    PG8_STAGE(PG8_SB(1, 0), cB + kstep, voffB); PG8_STAGE(PG8_SA(1, 0), cA + kstep, vA[0]); PG8_STAGE(PG8_SB(1, 1), cB + hstepB + kstep, voffB);
    PG8_WAIT_V(6); PG8_BAR;
    for (;;) {
        const bool has_next = S.next(ui + 1, nxt);
        const char* nA = cA; const char* nB = cB;
        if (has_next) { nA = nxt.Ab; nB = nxt.Bb; if (GA) PG8_SETVA(nvA, nxt); }
        else if (GA) {
#pragma unroll
            for (int h = 0; h < 2; ++h)
#pragma unroll
                for (int i = 0; i < 2; ++i) nvA[h][i] = vA[h][i]; }
#pragma unroll 1
        for (int t = 0; t < nt; t += 2) {
            const bool last = (t == nt - 2);
            const char* a1 = cA + (size_t)(t + 1) * kstep;
            const char* a2 = last ? nA : cA + (size_t)(t + 2) * kstep; const char* b2 = last ? nB : cB + (size_t)(t + 2) * kstep;
            const char* a3 = a2 + kstep; const char* b3 = b2 + kstep;
            unsigned s2[2][2];
#pragma unroll
            for (int h = 0; h < 2; ++h)
#pragma unroll
                for (int i = 0; i < 2; ++i) s2[h][i] = (GA && last) ? nvA[h][i] : vA[h][i];
            PG8_LDB(B0, 0, 0); PG8_SCHED; PG8_LDA(At, 0, 0); PG8_STAGE(PG8_SA(1, 1), a1, vA[1]);
            PG8_WAIT_L(8); PG8_BAR; PG8_WAIT_L(0); PG8_MMA(0, 0, At, B0); PG8_BAR; PG8_SCHED;
            PG8_LDB(B1, 0, 1); PG8_STAGE(PG8_SB(0, 0), b2, voffB);
            PG8_BAR; PG8_WAIT_L(0); PG8_MMA(0, 1, At, B1); PG8_BAR;
            PG8_LDA(At, 0, 1); PG8_STAGE(PG8_SA(0, 0), a2, s2[0]);
            PG8_BAR; PG8_WAIT_L(0); PG8_MMA(1, 0, At, B0); PG8_BAR; PG8_SCHED;
            PG8_STAGE(PG8_SB(0, 1), b2 + hstepB, voffB);
            PG8_WAIT_V(6); PG8_BAR; PG8_MMA(1, 1, At, B1); PG8_BAR;
            PG8_LDB(B0, 1, 0); PG8_SCHED; PG8_LDA(At, 1, 0); PG8_STAGE(PG8_SA(0, 1), a2, s2[1]);
            PG8_WAIT_L(8); PG8_BAR; PG8_WAIT_L(0); PG8_MMA(0, 0, At, B0); PG8_BAR; PG8_SCHED;
            PG8_LDB(B1, 1, 1); PG8_STAGE(PG8_SB(1, 0), b3, voffB);
            PG8_BAR; PG8_WAIT_L(0); PG8_MMA(0, 1, At, B1); PG8_BAR;
            PG8_LDA(At, 1, 1); PG8_STAGE(PG8_SA(1, 0), a3, s2[0]);
            PG8_BAR; PG8_WAIT_L(0); PG8_MMA(1, 0, At, B0); PG8_BAR; PG8_SCHED;
            PG8_STAGE(PG8_SB(1, 1), b3 + hstepB, voffB);
            PG8_WAIT_V(6); PG8_BAR; PG8_MMA(1, 1, At, B1); PG8_BAR;
        }
        { int fr_e = fr, fq_e = fq; asm volatile("" : "+v"(fr_e), "+v"(fq_e));
          E(acc, cur, wr, wc, fr_e, fq_e); }
        if (!has_next) break;
#pragma unroll
        for (int a = 0; a < 2; ++a)
#pragma unroll
            for (int b = 0; b < 2; ++b)
#pragma unroll
                for (int m = 0; m < 4; ++m)
#pragma unroll
                    for (int n = 0; n < 2; ++n) acc[a][b][m][n] = (f32x4){0.f, 0.f, 0.f, 0.f};
        cur = nxt; cA = nA; cB = nB; ++ui;
        if (GA) {
#pragma unroll
        for (int h = 0; h < 2; ++h)
#pragma unroll
            for (int i = 0; i < 2; ++i) vA[h][i] = nvA[h][i]; }
    }
    PG8_WAIT_V(0);
    if (wr == 0) PG8_BAR;
    PG8_BAR;
#undef PG8_SA
#undef PG8_SB
#undef PG8_STAGE
#undef PG8_LDA
#undef PG8_LDB
#undef PG8_MMA
#undef PG8_WAIT_V
#undef PG8_WAIT_L
#undef PG8_BAR
#undef PG8_SCHED
#undef PG8_SETVA
}
#define EPI_FOR(ai, m, bj) _Pragma("unroll") for (int ai = 0; ai < 2; ++ai) _Pragma("unroll") for (int m = 0; m < 4; ++m) _Pragma("unroll") for (int bj = 0; bj < 2; ++bj)
__device__ __forceinline__ u32x4 pack8(f32x4 v0, f32x4 v1) { u32x4 w; w.x = cvt_pk_bf16(v0[0], v0[1]); w.y = cvt_pk_bf16(v0[2], v0[3]); w.z = cvt_pk_bf16(v1[0], v1[1]); w.w = cvt_pk_bf16(v1[2], v1[3]); return w; }
}
using pg8::Unit;

struct EpiG1 {
    static constexpr bool PERM = true;
    const float* rstd; bf16 *zmla, *zrkv, *zlora, *zgate; const float* cmax;
    __device__ __forceinline__ void operator()(const PG8_ACC, const Unit& u, int wr, int wc, int fr, int fq) const {
        bf16* base; int ld, c0;
        if (u.pn < 4) { base = zmla; ld = ZM_LD; c0 = u.pn * 256; } else if (u.pn < 28) { base = zrkv; ld = ZR_LD; c0 = (u.pn - 4) * 256; }
        else if (u.pn < 31) { base = zlora; ld = ZL_LD; c0 = (u.pn - 28) * 256; } else { base = zgate; ld = ZG_LD; c0 = (u.pn - 31) * 256; }
        const int col0 = c0 + wc * 32 + 8 * fq;
        f32x4 cs[2][2];
#pragma unroll
        for (int bj = 0; bj < 2; ++bj) { const float* cp = cmax + u.pn * 256 + bj * 128 + wc * 32 + 8 * fq; cs[bj][0] = *(const f32x4*)cp * (1.0f / 127.0f); cs[bj][1] = *(const f32x4*)(cp + 4) * (1.0f / 127.0f); }
        EPI_FOR(ai, m, bj) { const int row = u.pm * 256 + ai * 128 + wr * 64 + m * 16 + fr; const float rs = rstd[row];
            const f32x4 v0 = __builtin_convertvector(__builtin_bit_cast(pg8::i32x4g, acc[ai][bj][m][0]), f32x4) * rs * cs[bj][0], v1 = __builtin_convertvector(__builtin_bit_cast(pg8::i32x4g, acc[ai][bj][m][1]), f32x4) * rs * cs[bj][1];
            *(u32x4*)(base + (size_t)row * ld + col0 + bj * 128) = pg8::pack8(v0, v1); }
    }
};
struct EpiPlain {
    static constexpr bool PERM = true;
    bf16* O; int ld; const float* rstd; float scale;
    __device__ __forceinline__ void operator()(const PG8_ACC, const Unit& u, int wr, int wc, int fr, int fq) const {
        const int col0 = u.pn * 256 + wc * 32 + 8 * fq;
        EPI_FOR(ai, m, bj) { const int row = u.pm * 256 + ai * 128 + wr * 64 + m * 16 + fr; const float rs = (rstd ? rstd[row] : 1.f) * scale;
            *(u32x4*)(O + (size_t)row * ld + col0 + bj * 128) = pg8::pack8(acc[ai][bj][m][0] * rs, acc[ai][bj][m][1] * rs); }
    }
};
constexpr float QSCALE = 0.07216878364870322f * 1.4426950408889634f;
constexpr float CSCALE = 0.08838834764831845f * 1.4426950408889634f;
__device__ __forceinline__ u32x2 pack8_fp8(f32x4 v0, f32x4 v1) {
    int a = __builtin_amdgcn_cvt_pk_fp8_f32(v0[0], v0[1], 0, false); a = __builtin_amdgcn_cvt_pk_fp8_f32(v0[2], v0[3], a, true);
    int b = __builtin_amdgcn_cvt_pk_fp8_f32(v1[0], v1[1], 0, false); b = __builtin_amdgcn_cvt_pk_fp8_f32(v1[2], v1[3], b, true);
    return (u32x2){(unsigned)a, (unsigned)b};
}
struct EpiQ {
    static constexpr bool PERM = true;
    unsigned char* Q; const float* rstd; const float* cs;
    __device__ __forceinline__ void operator()(const PG8_ACC, const Unit& u, int wr, int wc, int fr, int fq) const {
        EPI_FOR(ai, m, bj) { const int row = u.pm * 256 + ai * 128 + wr * 64 + m * 16 + fr; const int col = u.pn * 256 + bj * 128 + wc * 32 + 8 * fq;
            const float rs = rstd[row]; f32x4 v0 = acc[ai][bj][m][0] * rs, v1 = acc[ai][bj][m][1] * rs;
            const int cih = col % QKD;
            if (cih >= NOPE) { const int i0 = (cih - NOPE) >> 1; const f32x4* t = (const f32x4*)(cs + ((size_t)row * 32 + i0) * 2);
                const f32x4 a = t[0], b = t[1];
                f32x4 r0, r1;
                r0[0] = v0[0] * a[0] - v0[1] * a[1]; r0[1] = v0[1] * a[0] + v0[0] * a[1]; r0[2] = v0[2] * a[2] - v0[3] * a[3]; r0[3] = v0[3] * a[2] + v0[2] * a[3];
                r1[0] = v1[0] * b[0] - v1[1] * b[1]; r1[1] = v1[1] * b[0] + v1[0] * b[1]; r1[2] = v1[2] * b[2] - v1[3] * b[3]; r1[3] = v1[3] * b[2] + v1[2] * b[3];
                v0 = r0; v1 = r1; }
            *(u32x2*)(Q + (size_t)row * (MH * QKD) + col) = pack8_fp8(v0, v1); }
    }
};
struct EpiKV {
    static constexpr bool PERM = true;
    unsigned char* Kb; bf16* Vb; const float* rstd;
    __device__ __forceinline__ void operator()(const PG8_ACC, const Unit& u, int wr, int wc, int fr, int fq) const {
        const int c = wc * 32 + 8 * fq;
        EPI_FOR(ai, m, bj) { const int row = u.pm * 256 + ai * 128 + wr * 64 + m * 16 + fr; const float rs = rstd[row];
            if (bj == 0) *(u32x2*)(Kb + (size_t)row * (MH * QKD) + u.pn * QKD + c) = pack8_fp8(acc[ai][bj][m][0] * rs, acc[ai][bj][m][1] * rs);
            else *(u32x4*)(Vb + (size_t)row * (MH * VDIM) + u.pn * VDIM + c) = pg8::pack8(acc[ai][bj][m][0] * rs, acc[ai][bj][m][1] * rs); }
    }
};
template <int MODE> struct EpiLora {
    static constexpr bool PERM = true;
    bf16* O; const float* bias;
    __device__ __forceinline__ void operator()(const PG8_ACC, const Unit& u, int wr, int wc, int fr, int fq) const {
        EPI_FOR(ai, m, bj) { const int row = u.pm * 256 + ai * 128 + wr * 64 + m * 16 + fr; const int col = u.pn * 256 + bj * 128 + wc * 32 + 8 * fq;
            f32x4 v0 = acc[ai][bj][m][0], v1 = acc[ai][bj][m][1];
            if (MODE != 2) { const f32x4 b0 = *(const f32x4*)(bias + col), b1 = *(const f32x4*)(bias + col + 4);
#pragma unroll
                for (int j = 0; j < 4; ++j) { float s0 = sigmoidf_(v0[j] + b0[j]), s1 = sigmoidf_(v1[j] + b1[j]);
                    if (MODE == 0) { s0 *= -0.8750394f; s1 *= -0.8750394f; }
                    v0[j] = s0; v1[j] = s1; } }
            *(u32x4*)(O + (size_t)row * RW + col) = pg8::pack8(v0, v1); }
    }
};
template <int MODE> struct EpiLora2 {
    static constexpr bool PERM = true;
    bf16* O0; bf16* O1; const float* bias0; const float* bias1;
    __device__ __forceinline__ void operator()(const PG8_ACC, const Unit& u, int wr, int wc, int fr, int fq) const {
        const bool second = u.pn >= 8; bf16* O = second ? O1 : O0; const float* bias = second ? bias1 : bias0; const int pn = second ? u.pn - 8 : u.pn;
        EPI_FOR(ai, m, bj) { const int row = u.pm * 256 + ai * 128 + wr * 64 + m * 16 + fr; const int col = pn * 256 + bj * 128 + wc * 32 + 8 * fq;
            f32x4 v0 = acc[ai][bj][m][0], v1 = acc[ai][bj][m][1];
            const f32x4 b0 = *(const f32x4*)(bias + col), b1 = *(const f32x4*)(bias + col + 4);
#pragma unroll
            for (int j = 0; j < 4; ++j) { float s0 = sigmoidf_(v0[j] + b0[j]), s1 = sigmoidf_(v1[j] + b1[j]);
                if (MODE == 0) { s0 *= -0.8750394f; s1 *= -0.8750394f; }
                v0[j] = s0; v1[j] = s1; }
            *(u32x4*)(O + (size_t)row * RW + col) = pg8::pack8(v0, v1); }
    }
};
template <int SECOND> struct EpiUp {
    static constexpr bool PERM = true;
    bf16* O; const bf16* zg; int goff;
    __device__ __forceinline__ void operator()(const PG8_ACC, const Unit& u, int wr, int wc, int fr, int fq) const {
        EPI_FOR(ai, m, bj) { const int row = u.pm * 256 + ai * 128 + wr * 64 + m * 16 + fr; const int col = u.pn * 256 + bj * 128 + wc * 32 + 8 * fq;
            const u32x4 g = *(const u32x4*)(zg + (size_t)row * ZG_LD + goff + col);
            f32x4 v0 = acc[ai][bj][m][0], v1 = acc[ai][bj][m][1];
            v0[0] *= sigmoidf_(bflo(g.x)); v0[1] *= sigmoidf_(bfhi(g.x)); v0[2] *= sigmoidf_(bflo(g.y)); v0[3] *= sigmoidf_(bfhi(g.y));
            v1[0] *= sigmoidf_(bflo(g.z)); v1[1] *= sigmoidf_(bfhi(g.z)); v1[2] *= sigmoidf_(bflo(g.w)); v1[3] *= sigmoidf_(bfhi(g.w));
            bf16* dst = O + (size_t)row * DM + col;
            if (SECOND) { const u32x4 p = *(const u32x4*)dst;
                v0[0] += bflo(p.x); v0[1] += bfhi(p.x); v0[2] += bflo(p.y); v0[3] += bfhi(p.y); v1[0] += bflo(p.z); v1[1] += bfhi(p.z); v1[2] += bflo(p.w); v1[3] += bfhi(p.w); }
            *(u32x4*)dst = pg8::pack8(v0, v1); }
    }
};
struct EpiResid {
    static constexpr bool PERM = true;
    const float* base; float* out;
    __device__ __forceinline__ void operator()(const PG8_ACC, const Unit& u, int wr, int wc, int fr, int fq) const {
        EPI_FOR(ai, m, bj) { const int row = u.pm * 256 + ai * 128 + wr * 64 + m * 16 + fr; const int col = u.pn * 256 + bj * 128 + wc * 32 + 8 * fq;
            const size_t o = (size_t)row * DM + col; const f32x4 b0 = *(const f32x4*)(base + o), b1 = *(const f32x4*)(base + o + 4);
            *(f32x4*)(out + o) = b0 + acc[ai][bj][m][0]; *(f32x4*)(out + o + 4) = b1 + acc[ai][bj][m][1]; }
    }
};

namespace att {
constexpr int NW = 8, QBLK = 32, KVBLK = 64;
constexpr float THRL = 11.5f;
#define SBAR() __builtin_amdgcn_sched_barrier(0)
__device__ __forceinline__ int crow(int r, int hi) { return (r & 3) + 8 * (r >> 2) + 4 * hi; }
template <bool SCALED = false> __device__ __forceinline__ void partialSM(f32x16& p, float& m_reg, float& alpha, const float sc = 1.f) {
    float pmax = p[0];
#pragma unroll
    for (int r = 1; r < 16; ++r) pmax = fmaxf(pmax, p[r]);
    { auto rr = __builtin_amdgcn_permlane32_swap(__float_as_uint(pmax), __float_as_uint(pmax), false, false);
      pmax = fmaxf(__uint_as_float(rr[0]), __uint_as_float(rr[1])); }
    if (SCALED) pmax *= sc;
    float mn;
    if (__builtin_expect(__all(pmax - m_reg <= THRL), 1)) { mn = m_reg; alpha = 1.f; }
    else { mn = fmaxf(m_reg, pmax); alpha = __builtin_amdgcn_exp2f(m_reg - mn); m_reg = mn; }
#pragma unroll
    for (int r = 0; r < 16; ++r) p[r] = SCALED ? __builtin_fmaf(p[r], sc, -mn) : p[r] - mn;
#pragma unroll
    for (int r = 0; r < 8; ++r) p[r] = __builtin_amdgcn_exp2f(p[r]);
}
__device__ __forceinline__ void finishSM(f32x16& p, float alpha, float& l_reg, bf16x8& pa0, bf16x8& pa1) {
#pragma unroll
    for (int r = 8; r < 16; ++r) p[r] = __builtin_amdgcn_exp2f(p[r]);
    float ps = 0;
#pragma unroll
    for (int r = 0; r < 16; ++r) ps += p[r];
    { auto rr = __builtin_amdgcn_permlane32_swap(__float_as_uint(ps), __float_as_uint(ps), false, false);
      ps = __uint_as_float(rr[0]) + __uint_as_float(rr[1]); }
    l_reg = l_reg * alpha + ps;
#define PK4(P, BASE, OUT) do { unsigned a0 = cvt_pk_bf16(P[BASE + 0], P[BASE + 1]), a1 = cvt_pk_bf16(P[BASE + 2], P[BASE + 3]);   \
    unsigned b0 = cvt_pk_bf16(P[BASE + 4], P[BASE + 5]), b1 = cvt_pk_bf16(P[BASE + 6], P[BASE + 7]);                              \
    auto r0 = __builtin_amdgcn_permlane32_swap(a0, b0, false, false); auto r1 = __builtin_amdgcn_permlane32_swap(a1, b1, false, false); \
    u32x4 w = {r0[0], r1[0], r0[1], r1[1]}; OUT = *reinterpret_cast<bf16x8*>(&w); } while (0)
    PK4(p, 0, pa0); PK4(p, 8, pa1);
#undef PK4
}
template <int DQK> __device__ __forceinline__ int kswz(int row, int colB) { return row * (DQK * 2 + 16) + colB; }
template <int DQK> __device__ __forceinline__ void qkt(f32x16& p, const LAS char* Ks, const bf16x8* qr, int krow, int hi) {
    p = f32x16{};
#pragma unroll
    for (int d0 = 0; d0 < DQK / 16; ++d0) { const int cb = (d0 * 16 + hi * 8) * 2;
        bf16x8 b0 = *reinterpret_cast<const LAS bf16x8*>(Ks + kswz<DQK>(krow, cb));
        p = __builtin_amdgcn_mfma_f32_32x32x16_bf16(b0, qr[d0], p, 0, 0, 0); }
}
__device__ __forceinline__ int v_st(int k, int c) { const int kk = (k & ~0xC) | ((k & 4) << 1) | ((k & 8) >> 1); return ((kk >> 3) * 4 + (c >> 5)) * 512 + ((kk & 7) * 32 + (c & 31)) * 2; }
__device__ __forceinline__ int v_rd_base(int lane) { return ((lane & 3) << 3) | (((lane >> 2) & 3) << 6) | (((lane >> 4) & 1) << 5) | (((lane >> 5) & 1) << 8); }
constexpr int v_rd_off(int d0, int ks, int half) { return d0 * 512 + ks * 4096 + half * 2048; }
template <int OFF> __device__ __forceinline__ s16x4 tr_read(int vb) {
    s16x4 r; asm volatile("ds_read_b64_tr_b16 %0, %1 offset:%2" : "=&v"(r) : "v"(vb), "i"(OFF) : "memory"); return r;
}
template <int D0, int KH> __device__ __forceinline__ void pv_one(f32x16& od, int vb, bf16x8 pa0, bf16x8 pa1) {
    const s16x4 l0 = tr_read<v_rd_off(D0, 2 * KH, 0)>(vb), h0 = tr_read<v_rd_off(D0, 2 * KH, 1)>(vb), l1 = tr_read<v_rd_off(D0, 2 * KH + 1, 0)>(vb), h1 = tr_read<v_rd_off(D0, 2 * KH + 1, 1)>(vb);
    asm volatile("s_waitcnt lgkmcnt(0)" ::: "memory"); SBAR();
#define PK(L, H) (bf16x8){L[0], L[1], L[2], L[3], H[0], H[1], H[2], H[3]}
    od = __builtin_amdgcn_mfma_f32_32x32x16_bf16(pa0, PK(l0, h0), od, 0, 0, 0);
    od = __builtin_amdgcn_mfma_f32_32x32x16_bf16(pa1, PK(l1, h1), od, 0, 0, 0);
#undef PK
}
template <int KH> __device__ __forceinline__ void pv_d0(f32x16* o, int vb, bf16x8 pa0, bf16x8 pa1) {
    pv_one<0, KH>(o[0], vb, pa0, pa1); pv_one<1, KH>(o[1], vb, pa0, pa1); pv_one<2, KH>(o[2], vb, pa0, pa1); pv_one<3, KH>(o[3], vb, pa0, pa1);
}
template <int DQK, int LDQ, int LDK, int LDV, int LDO>
__device__ __forceinline__ void attn_unit(const bf16* __restrict__ Qb, const bf16* __restrict__ Kh, const bf16* __restrict__ Vh, bf16* __restrict__ Ob, const int seq, LAS char* lds) {
    constexpr int SHM_V = KVBLK * 128 * 2, SHM_K = KVBLK * (DQK * 2 + 16), KCH = DQK / 64;
    const int tid = threadIdx.x, wid = tid >> 6, lane = tid & 63, r32 = lane & 31, hi = lane >> 5;
    LAS char* V_lds = lds; LAS char* K_lds = lds + 2 * SHM_V;
    LAS float* wsf = (LAS float*)(lds + 2 * SHM_V + 2 * SHM_K) + wid * 64; LAS float* li_l = wsf; LAS float* al_l = wsf + 32;
    float m_reg = -1e30f, l_reg = 0; f32x16 o[4] = {}; bf16x8 qr[DQK / 16];
    const bf16* Qw = Qb + (long)(wid * QBLK + r32) * LDQ + hi * 8;
#pragma unroll
    for (int d0 = 0; d0 < DQK / 16; ++d0) qr[d0] = *reinterpret_cast<const bf16x8*>(Qw + d0 * 16);
    const int sr = tid >> 4, sc = (tid & 15) * 8, vst0 = v_st(sr, sc), vst1 = v_st(32 + sr, sc);
    unsigned kgo[KCH]; int klo[KCH];
#pragma unroll
    for (int i = 0; i < KCH; ++i) { const int id = tid + 512 * i, row = id / (DQK / 8), c8 = id % (DQK / 8); kgo[i] = (unsigned)(row * LDK + c8 * 8) * 2u; klo[i] = kswz<DQK>(row, c8 * 16); }
    const unsigned vgo0 = (unsigned)(sr * LDV + sc) * 2u, vgo1 = (unsigned)((32 + sr) * LDV + sc) * 2u;
    const int vb0 = (int)(uintptr_t)V_lds + v_rd_base(lane);
    bf16x8 vs0, vs1, ks[KCH];
#define SLOAD(k0) do { const char* _vt = (const char*)(Vh + (size_t)(k0) * LDV); const char* _kt = (const char*)(Kh + (size_t)(k0) * LDK); \
    vs0 = *reinterpret_cast<const bf16x8*>(_vt + vgo0); vs1 = *reinterpret_cast<const bf16x8*>(_vt + vgo1); \
    _Pragma("unroll") for (int _i = 0; _i < KCH; ++_i) ks[_i] = *reinterpret_cast<const bf16x8*>(_kt + kgo[_i]); } while (0)
#define SWRITE(b) do { *(LAS bf16x8*)(V_lds + (b) * SHM_V + vst0) = vs0; *(LAS bf16x8*)(V_lds + (b) * SHM_V + vst1) = vs1; \
    _Pragma("unroll") for (int _i = 0; _i < KCH; ++_i) *(LAS bf16x8*)(K_lds + (b) * SHM_K + klo[_i]) = ks[_i]; } while (0)
#define SWAIT() asm volatile("s_waitcnt vmcnt(0)" ::: "memory")
#define RESC(a) do { if (__any((a) < 1.f)) { if (hi == 0) al_l[r32] = (a); asm volatile("s_waitcnt lgkmcnt(0)" ::: "memory"); \
    _Pragma("unroll") for (int d = 0; d < 4; ++d) _Pragma("unroll") for (int r = 0; r < 16; ++r) o[d][r] *= al_l[crow(r, hi)]; } } while (0)
    f32x16 pA, pB; float alA, alB; bf16x8 pa0, pa1; const int NT = seq / KVBLK;
    SLOAD(0); SWAIT(); SWRITE(0); __syncthreads();
    if (1 < NT) SLOAD(KVBLK);
    qkt<DQK>(pA, K_lds, qr, r32, hi); partialSM(pA, m_reg, alA);
    if (1 < NT) { SWAIT(); SWRITE(1); } __syncthreads();
    if (2 < NT) SLOAD(2 * KVBLK);
    SBAR(); qkt<DQK>(pB, K_lds, qr, 32 + r32, hi);
    finishSM(pA, alA, l_reg, pa0, pa1); SBAR();
    pv_d0<0>(o, vb0, pa0, pa1); partialSM(pB, m_reg, alB); RESC(alB);
    for (int j = 1; j < NT; ++j) {
        const int cb = j & 1, pb = cb ^ 1;
        SBAR(); qkt<DQK>(pA, K_lds + cb * SHM_K, qr, r32, hi);
        finishSM(pB, alB, l_reg, pa0, pa1); SBAR();
        pv_d0<1>(o, vb0 + pb * SHM_V, pa0, pa1); partialSM(pA, m_reg, alA);
        __syncthreads(); if (j + 1 < NT) { SWAIT(); SWRITE(pb); }
        RESC(alA); __syncthreads();
        if (j + 2 < NT) SLOAD((j + 2) * KVBLK);
        SBAR(); qkt<DQK>(pB, K_lds + cb * SHM_K, qr, 32 + r32, hi);
        finishSM(pA, alA, l_reg, pa0, pa1); SBAR();
        pv_d0<0>(o, vb0 + cb * SHM_V, pa0, pa1); partialSM(pB, m_reg, alB); RESC(alB);
    }
    finishSM(pB, alB, l_reg, pa0, pa1); SBAR();
    pv_d0<1>(o, vb0 + ((NT - 1) & 1) * SHM_V, pa0, pa1);
    if (hi == 0) li_l[r32] = l_reg; asm volatile("s_waitcnt lgkmcnt(0)" ::: "memory");
    float rli[16];
#pragma unroll
    for (int r = 0; r < 16; ++r) rli[r] = __builtin_amdgcn_rcpf(li_l[crow(r, hi)]);
    bf16* Ow = Ob + (size_t)(wid * QBLK) * LDO;
    int r32e = r32, hie = hi; asm volatile("" : "+v"(r32e), "+v"(hie));
    const unsigned ob = (unsigned)(4 * hie * LDO + r32e);
#pragma unroll
    for (int r = 0; r < 16; ++r) {
#pragma unroll
        for (int d0 = 0; d0 < 4; ++d0) Ow[ob + (unsigned)(((r & 3) + 8 * (r >> 2)) * LDO + d0 * 32)] = f2bf(o[d0][r] * rli[r]); }
    __syncthreads();
#undef SLOAD
#undef SWRITE
#undef SWAIT
#undef RESC
}
typedef int i32x8 __attribute__((ext_vector_type(8)));
__device__ __forceinline__ void qkt_f8(f32x16& p, const LAS char* Ks, const i32x8* qr, int krow, int hi) {
    p = f32x16{};
#pragma unroll
    for (int d0 = 0; d0 < 3; ++d0) { const LAS char* a = Ks + krow * 208 + d0 * 64 + hi * 32;
        const u32x4 lo = *reinterpret_cast<const LAS u32x4*>(a), hh = *reinterpret_cast<const LAS u32x4*>(a + 16);
        const i32x8 av = {(int)lo.x, (int)lo.y, (int)lo.z, (int)lo.w, (int)hh.x, (int)hh.y, (int)hh.z, (int)hh.w};
        p = __builtin_amdgcn_mfma_scale_f32_32x32x64_f8f6f4(av, qr[d0], p, 0, 0, 0, 0, 0, 0); }
}
template <int LDQ, int LDK, int LDV, int LDO>
__device__ __forceinline__ void attn_unit_f8(const unsigned char* __restrict__ Qb, const unsigned char* __restrict__ Kh, const bf16* __restrict__ Vh, bf16* __restrict__ Ob, const int seq, const float SC, LAS char* lds) {
    constexpr int SHM_V = KVBLK * 128 * 2, SHM_K = KVBLK * 208;
    const int tid = threadIdx.x, wid = tid >> 6, lane = tid & 63, r32 = lane & 31, hi = lane >> 5;
    LAS char* V_lds = lds; LAS char* K_lds = lds + 2 * SHM_V;
    LAS float* wsf = (LAS float*)(lds + 2 * SHM_V + 2 * SHM_K) + wid * 64; LAS float* li_l = wsf; LAS float* al_l = wsf + 32;
    float m_reg = -1e30f, l_reg = 0; f32x16 o[4] = {}; i32x8 qr[3];
    { const unsigned char* Qw = Qb + (long)(wid * QBLK + r32) * LDQ + hi * 32;
#pragma unroll
      for (int d0 = 0; d0 < 3; ++d0) { const u32x4 lo = *reinterpret_cast<const u32x4*>(Qw + d0 * 64), hh = *reinterpret_cast<const u32x4*>(Qw + d0 * 64 + 16);
          qr[d0] = (i32x8){(int)lo.x, (int)lo.y, (int)lo.z, (int)lo.w, (int)hh.x, (int)hh.y, (int)hh.z, (int)hh.w}; } }
    const int sr = tid >> 4, sc = (tid & 15) * 8, vst0 = v_st(sr, sc), vst1 = v_st(32 + sr, sc);
    const bool k2 = wid < 4;
    const int id0 = tid, id1 = 512 + tid;
    const unsigned kgo0 = (unsigned)((id0 / 12) * LDK + (id0 % 12) * 16), kgo1 = (unsigned)((id1 / 12) * LDK + (id1 % 12) * 16);
    const int klo0 = (id0 / 12) * 208 + (id0 % 12) * 16, klo1 = (id1 / 12) * 208 + (id1 % 12) * 16;
    const unsigned vgo0 = (unsigned)(sr * LDV + sc) * 2u, vgo1 = (unsigned)((32 + sr) * LDV + sc) * 2u;
    const int vb0 = (int)(uintptr_t)V_lds + v_rd_base(lane);
    bf16x8 vs0, vs1; u32x4 ks0, ks1 = {0u, 0u, 0u, 0u};
#define SLOAD(k0) do { const char* _vt = (const char*)(Vh + (size_t)(k0) * LDV); const unsigned char* _kt = Kh + (size_t)(k0) * LDK; \
    vs0 = *reinterpret_cast<const bf16x8*>(_vt + vgo0); vs1 = *reinterpret_cast<const bf16x8*>(_vt + vgo1); \
    ks0 = *reinterpret_cast<const u32x4*>(_kt + kgo0); if (k2) ks1 = *reinterpret_cast<const u32x4*>(_kt + kgo1); } while (0)
#define SWRITE(b) do { *(LAS bf16x8*)(V_lds + (b) * SHM_V + vst0) = vs0; *(LAS bf16x8*)(V_lds + (b) * SHM_V + vst1) = vs1; \
    *(LAS u32x4*)(K_lds + (b) * SHM_K + klo0) = ks0; if (k2) *(LAS u32x4*)(K_lds + (b) * SHM_K + klo1) = ks1; } while (0)
#define SWAIT() asm volatile("s_waitcnt vmcnt(0)" ::: "memory")
#define RESC(a) do { if (__any((a) < 1.f)) { if (hi == 0) al_l[r32] = (a); asm volatile("s_waitcnt lgkmcnt(0)" ::: "memory"); \
    _Pragma("unroll") for (int d = 0; d < 4; ++d) _Pragma("unroll") for (int r = 0; r < 16; ++r) o[d][r] *= al_l[crow(r, hi)]; } } while (0)
    f32x16 pA, pB; float alA, alB; bf16x8 pa0, pa1; const int NT = seq / KVBLK;
    SLOAD(0); SWAIT(); SWRITE(0); __syncthreads();
    if (1 < NT) SLOAD(KVBLK);
    qkt_f8(pA, K_lds, qr, r32, hi); partialSM<true>(pA, m_reg, alA, SC);
    if (1 < NT) { SWAIT(); SWRITE(1); } __syncthreads();
    if (2 < NT) SLOAD(2 * KVBLK);
    SBAR(); qkt_f8(pB, K_lds, qr, 32 + r32, hi);
    finishSM(pA, alA, l_reg, pa0, pa1); SBAR();
    pv_d0<0>(o, vb0, pa0, pa1); partialSM<true>(pB, m_reg, alB, SC); RESC(alB);
    for (int j = 1; j < NT; ++j) {
        const int cb = j & 1, pb = cb ^ 1;
        SBAR(); qkt_f8(pA, K_lds + cb * SHM_K, qr, r32, hi);
        finishSM(pB, alB, l_reg, pa0, pa1); SBAR();
        pv_d0<1>(o, vb0 + pb * SHM_V, pa0, pa1); partialSM<true>(pA, m_reg, alA, SC);
        __syncthreads(); if (j + 1 < NT) { SWAIT(); SWRITE(pb); }
        RESC(alA); __syncthreads();
        if (j + 2 < NT) SLOAD((j + 2) * KVBLK);
        SBAR(); qkt_f8(pB, K_lds + cb * SHM_K, qr, 32 + r32, hi);
        finishSM(pA, alA, l_reg, pa0, pa1); SBAR();
        pv_d0<0>(o, vb0 + cb * SHM_V, pa0, pa1); partialSM<true>(pB, m_reg, alB, SC); RESC(alB);
    }
    finishSM(pB, alB, l_reg, pa0, pa1); SBAR();
    pv_d0<1>(o, vb0 + ((NT - 1) & 1) * SHM_V, pa0, pa1);
    if (hi == 0) li_l[r32] = l_reg; asm volatile("s_waitcnt lgkmcnt(0)" ::: "memory");
    float rli[16];
#pragma unroll
    for (int r = 0; r < 16; ++r) rli[r] = __builtin_amdgcn_rcpf(li_l[crow(r, hi)]);
    bf16* Ow = Ob + (size_t)(wid * QBLK) * LDO;
    int r32e = r32, hie = hi; asm volatile("" : "+v"(r32e), "+v"(hie));
    const unsigned ob = (unsigned)(4 * hie * LDO + r32e);
#pragma unroll
    for (int r = 0; r < 16; ++r) {
#pragma unroll
        for (int d0 = 0; d0 < 4; ++d0) Ow[ob + (unsigned)(((r & 3) + 8 * (r >> 2)) * LDO + d0 * 32)] = f2bf(o[d0][r] * rli[r]); }
    __syncthreads();
#undef SLOAD
#undef SWRITE
#undef SWAIT
#undef RESC
}
__device__ __forceinline__ float f8_map_probe(const int lane) {
    const int r = lane & 31, h = lane >> 5;
    const float am = 1.f + (float)((r >> 2) & 1), bm = 1.f + (float)((r >> 3) & 1);
    i32x8 a, b;
#pragma unroll
    for (int w = 0; w < 8; ++w) { const int k0 = 32 * h + 4 * w; int pa = 0, pb = 0;
        pa = __builtin_amdgcn_cvt_pk_fp8_f32((float)((k0 + 0) & 7) * am, (float)((k0 + 1) & 7) * am, pa, false); pa = __builtin_amdgcn_cvt_pk_fp8_f32((float)((k0 + 2) & 7) * am, (float)((k0 + 3) & 7) * am, pa, true);
        pb = __builtin_amdgcn_cvt_pk_fp8_f32((float)((3 * (k0 + 0) + 1) % 7) * bm, (float)((3 * (k0 + 1) + 1) % 7) * bm, pb, false); pb = __builtin_amdgcn_cvt_pk_fp8_f32((float)((3 * (k0 + 2) + 1) % 7) * bm, (float)((3 * (k0 + 3) + 1) % 7) * bm, pb, true);
        a[w] = pa; b[w] = pb; }
    f32x16 d = {};
    d = __builtin_amdgcn_mfma_scale_f32_32x32x64_f8f6f4(a, b, d, 0, 0, 0, 0, 0, 0);
    float e0 = 0.f;
    for (int k = 0; k < 64; ++k) e0 += (float)(k & 7) * (float)((3 * k + 1) % 7);
    float err = 0.f;
#pragma unroll
    for (int rr = 0; rr < 16; ++rr) { const int row = crow(rr, h), col = r; const float ex = e0 * (1.f + (float)((row >> 2) & 1)) * (1.f + (float)((col >> 3) & 1)); err = fmaxf(err, fabsf(d[rr] - ex)); }
#pragma unroll
    for (int o = 32; o >= 1; o >>= 1) err = fmaxf(err, __shfl_xor(err, o));
    return err;
}
}

struct Frame {
    LAS unsigned char* lds; volatile LAS unsigned* MISC; unsigned* ctl;
    int tid, lane, wave, vcu, G;
    unsigned char* ws; float* out;
    const float* in[41];
};
enum { I_X = 0, I_MEM, I_POS, I_GMIX, I_WIN, I_GQ, I_WUQ, I_GKV, I_WUKV, I_SHIFT, I_W0F, I_W2F, I_W0B, I_W2B, I_A0F, I_A2F, I_A0B, I_A2B, I_G2, I_KK, I_KA, I_RK,
       I_LNXG, I_LNXB, I_WUPM, I_WUPR, I_WOUT, I_GCROSS, I_GMEM, I_WQC, I_WKVC, I_WOC, I_GFFN, I_WRG, I_BRG, I_WRE, I_BRE, I_WEG, I_WEU, I_WED, I_GFINAL };

template <int MODE> __device__ __forceinline__ int rowmap(int n) {
    if (MODE == 1) {
        if (n < 768) return n;
        if (n < 832) { const int p = n - 768; return 768 + (p < 32 ? 2 * p : 2 * (p - 32) + 1); }
        if (n < 6976) return 1024 + (n - 832);
        if (n < 7616) return 7168 + (n - 6976);
        return 7936 + (n - 7616);
    }
    if (MODE == 2) {
        const int h = n / QKD, d = n % QKD; if (d < NOPE) return n; const int p = d - NOPE; return h * QKD + NOPE + (p < 32 ? 2 * p : 2 * (p - 32) + 1);
    }
    if (MODE == 3) return (n >> 7) * 256 + (n & 127);
    if (MODE == 4) return (n >> 7) * 256 + 128 + (n & 127);
    return n;
}
constexpr int CVT_SCR = 16640;
template <int MODE> __device__ __forceinline__ void cvt_item(const float* W, int K, int N, const float* gain, bf16* WT, int ldt, LAS float* scr, int item, int lane, int kofs = 0) {
    const int nblk = N / 64, kb = item / nblk, nb = item % nblk, k0 = 64 * kb, n0 = 64 * nb;
    const int kq = lane >> 4, nc = (lane & 15) * 4;
    f32x4 v[16];
#pragma unroll
    for (int i = 0; i < 16; ++i) { const int k = k0 + 4 * i + kq - kofs; v[i] = (f32x4){0.f, 0.f, 0.f, 0.f};
        if (k >= 0 && k < K) { v[i] = *(const f32x4*)(W + (size_t)k * N + n0 + nc); if (gain) v[i] = v[i] * gain[k]; } }
#pragma unroll
    for (int i = 0; i < 16; ++i) { const int kk = 4 * i + kq;
#pragma unroll
        for (int c = 0; c < 4; ++c) scr[(nc + c) * 65 + kk] = v[i][c]; }
    LDS_WAIT(); asm volatile("" ::: "memory");
    const int kc = (lane & 7) * 8;
#pragma unroll
    for (int jj = 0; jj < 8; ++jj) { const int n = (lane >> 3) + 8 * jj; const LAS float* s = scr + n * 65 + kc;
        u32x4 o; o.x = cvt_pk_bf16(s[0], s[1]); o.y = cvt_pk_bf16(s[2], s[3]); o.z = cvt_pk_bf16(s[4], s[5]); o.w = cvt_pk_bf16(s[6], s[7]);
        *(u32x4*)(WT + (size_t)rowmap<MODE>(n0 + n) * ldt + k0 + kc) = o; }
    LDS_WAIT(); asm volatile("" ::: "memory");
}
#define CVT_JOB(MODE, src, K, N, gain, dst, ldt) { const int _n = (((K) + 63) / 64) * ((N) / 64); if (r < _n) { cvt_item<MODE>(src, K, N, gain, dst, ldt, scr, r, F.lane); continue; } r -= _n; }
#define CVT_JOB_PAD(src, K, N, dst, KPAD, KOFS) { const int _n = ((KPAD) / 64) * ((N) / 64); if (r < _n) { cvt_item<0>(src, K, N, nullptr, dst, KPAD, scr, r, F.lane, KOFS); continue; } r -= _n; }
struct CvtD { const float* W; const float* gain; bf16* WT; int K, N, ldt, mode, kofs, item; };
__device__ __forceinline__ unsigned pack4_i8(float a, float b, float c, float d) { const int i0 = (int)a, i1 = (int)b, i2 = (int)c, i3 = (int)d; return (unsigned)(i0 & 255) | ((unsigned)(i1 & 255) << 8) | ((unsigned)(i2 & 255) << 16) | ((unsigned)i3 << 24); }
__device__ __forceinline__ int rowmap_rt(int mode, int n) { return (mode == 1 || mode == 5 || mode == 6) ? rowmap<1>(n) : mode == 2 ? rowmap<2>(n) : mode == 3 ? rowmap<3>(n) : mode == 4 ? rowmap<4>(n) : n; }
__device__ __forceinline__ void cvt_load(const CvtD& d, int lane, f32x4 (&v)[16], float (&g)[16]) {
    const int nblk = d.N / 64, kb = d.item / nblk, nb = d.item % nblk, k0 = 64 * kb, n0 = 64 * nb; const int kq = lane >> 4, nc = (lane & 15) * 4;
#pragma unroll
    for (int i = 0; i < 16; ++i) { const int k = k0 + 4 * i + kq - d.kofs; v[i] = (f32x4){0.f, 0.f, 0.f, 0.f}; g[i] = 1.f;
        if (k >= 0 && k < d.K) { v[i] = *(const f32x4*)(d.W + (size_t)k * d.N + n0 + nc); if (d.gain) g[i] = d.gain[k]; } }
}
__device__ __forceinline__ void cvt_process(const CvtD& d, int lane, f32x4 (&v)[16], float (&g)[16], LAS float* scr, const float* colmax) {
    const int nblk = d.N / 64, kb = d.item / nblk, nb = d.item % nblk, k0 = 64 * kb, n0 = 64 * nb; const int kq = lane >> 4, nc = (lane & 15) * 4;
    if (d.mode == 5) {
        f32x4 mx = {0.f, 0.f, 0.f, 0.f};
#pragma unroll
        for (int i = 0; i < 16; ++i) { const f32x4 t = v[i] * g[i];
#pragma unroll
            for (int c = 0; c < 4; ++c) mx[c] = fmaxf(mx[c], fabsf(t[c])); }
#pragma unroll
        for (int c = 0; c < 4; ++c) { mx[c] = fmaxf(mx[c], __shfl_xor(mx[c], 16)); mx[c] = fmaxf(mx[c], __shfl_xor(mx[c], 32)); }
        if (lane < 16) {
#pragma unroll
            for (int c = 0; c < 4; ++c) __hip_atomic_fetch_max((unsigned*)d.WT + rowmap<1>(n0 + nc + c), __float_as_uint(mx[c]), __ATOMIC_RELAXED, __HIP_MEMORY_SCOPE_AGENT); }
        return; }
#pragma unroll
    for (int i = 0; i < 16; ++i) { const int kk = 4 * i + kq;
#pragma unroll
        for (int c = 0; c < 4; ++c) scr[(nc + c) * 65 + kk] = v[i][c] * g[i]; }
    LDS_WAIT(); asm volatile("" ::: "memory");
    const int kc = (lane & 7) * 8;
#pragma unroll
    for (int jj = 0; jj < 8; ++jj) { const int n = (lane >> 3) + 8 * jj; const LAS float* s = scr + n * 65 + kc; const int rm = rowmap_rt(d.mode, n0 + n);
        if (d.mode == 6) { const float q = 127.0f / fmaxf(__hip_atomic_load(colmax + rm, __ATOMIC_RELAXED, __HIP_MEMORY_SCOPE_AGENT), 1e-30f);
            *(u32x2*)((unsigned char*)d.WT + (size_t)rm * d.ldt + k0 + kc) = (u32x2){pack4_i8(rintf(s[0] * q), rintf(s[1] * q), rintf(s[2] * q), rintf(s[3] * q)), pack4_i8(rintf(s[4] * q), rintf(s[5] * q), rintf(s[6] * q), rintf(s[7] * q))}; }
        else { u32x4 o; o.x = cvt_pk_bf16(s[0], s[1]); o.y = cvt_pk_bf16(s[2], s[3]); o.z = cvt_pk_bf16(s[4], s[5]); o.w = cvt_pk_bf16(s[6], s[7]);
            *(u32x4*)(d.WT + (size_t)rm * d.ldt + k0 + kc) = o; } }
    LDS_WAIT(); asm volatile("" ::: "memory");
}
#define CVT_PIPE(TOTAL_, DESC_) do { CvtD dA, dB; f32x4 vA[16], vB[16]; float gA[16], gB[16]; int it = gw; \
        if (it < (TOTAL_)) { DESC_(it, dA); cvt_load(dA, F.lane, vA, gA); } \
        for (; it < (TOTAL_); it += 2 * NGW) { const int itn = it + NGW, itn2 = it + 2 * NGW; \
            if (itn < (TOTAL_)) { DESC_(itn, dB); cvt_load(dB, F.lane, vB, gB); } \
            cvt_process(dA, F.lane, vA, gA, scr, CVT_COLMAX); \
            if (itn2 < (TOTAL_)) { DESC_(itn2, dA); cvt_load(dA, F.lane, vA, gA); } \
            if (itn < (TOTAL_)) cvt_process(dB, F.lane, vB, gB, scr, CVT_COLMAX); } } while (0)

#define CVT_COLMAX ((const float*)(F.ctl + CW_COLMAX))
__device__ __forceinline__ void p0b_win_i8(Frame& F) {
    LAS float* scr = (LAS float*)(F.lds + F.wave * CVT_SCR);
    const int gw = F.vcu * 8 + F.wave, NGW = F.G * 8;
    unsigned char* ws = F.ws;
#define P0B_DESC(it_, d) do { d.W = F.in[I_WIN]; d.gain = F.in[I_GMIX]; d.WT = (bf16*)(ws + WS_WIN); d.K = DM; d.N = IN_W; d.ldt = DM; d.mode = 6; d.kofs = 0; d.item = (it_); } while (0)
    CVT_PIPE(32 * (IN_W / 64), P0B_DESC);
#undef P0B_DESC
}
__device__ __forceinline__ void p0_prologue(Frame& F) {
    LAS float* scr = (LAS float*)(F.lds + F.wave * CVT_SCR);
    const int gw = F.vcu * 8 + F.wave, NGW = F.G * 8;
    unsigned char* ws = F.ws;
    constexpr int TOTAL = 32 * (IN_W / 64) + 8 * 48 + 4 * 64 + 4 * (4 * 32) + 4 * 32 + 3 * (32 * 32) + 32 * 8 + 32 * 16 + 8 * 32;
#define P0_SETD(d, mode_, src_, K_, N_, gain_, dst_, ldt_, KPAD_, KOFS_) { const int _n = ((KPAD_) / 64) * ((N_) / 64); if (r < _n) { d.W = src_; d.gain = gain_; d.WT = dst_; d.K = K_; d.N = N_; d.ldt = ldt_; d.mode = mode_; d.kofs = KOFS_; d.item = r; break; } r -= _n; }
#define P0_DESC(it_, d) do { int r = (it_); \
        P0_SETD(d, 5, F.in[I_WIN], DM, IN_W, F.in[I_GMIX], (bf16*)(F.ctl + CW_COLMAX), DM, DM, 0) \
        P0_SETD(d, 2, F.in[I_WUQ], QLORA, MH * QKD, F.in[I_GQ], (bf16*)(ws + WS_WUQ), QLORA, QLORA, 0) \
        P0_SETD(d, 0, F.in[I_WUKV], KVLORA, MH * 256, F.in[I_GKV], (bf16*)(ws + WS_WUKV), KVLORA, KVLORA, 0) \
        P0_SETD(d, 0, F.in[I_W2F], DLORA, RW, nullptr, (bf16*)(ws + WS_W2F), 256, 256, 0) \
        P0_SETD(d, 0, F.in[I_W2B], DLORA, RW, nullptr, (bf16*)(ws + WS_W2F + 1 * MiB), 256, 256, 128) \
        P0_SETD(d, 0, F.in[I_A2F], DLORA, RW, nullptr, (bf16*)(ws + WS_W2F + 2 * MiB), 256, 256, 0) \
        P0_SETD(d, 0, F.in[I_A2B], DLORA, RW, nullptr, (bf16*)(ws + WS_W2F + 3 * MiB), 256, 256, 128) \
        P0_SETD(d, 0, F.in[I_G2], GLORA, RW, nullptr, (bf16*)(ws + WS_G2), GLORA, GLORA, 0) \
        P0_SETD(d, 0, F.in[I_WUPM], DM, DM, nullptr, (bf16*)(ws + WS_WUPM), DM, DM, 0) \
        P0_SETD(d, 0, F.in[I_WUPR], DM, DM, nullptr, (bf16*)(ws + WS_WUPR), DM, DM, 0) \
        P0_SETD(d, 0, F.in[I_WOUT], DM, DM, nullptr, (bf16*)(ws + WS_WOUT), DM, DM, 0) \
        P0_SETD(d, 0, F.in[I_WQC], DM, CW, F.in[I_GCROSS], (bf16*)(ws + WS_WQC), DM, DM, 0) \
        P0_SETD(d, 0, F.in[I_WKVC], DM, 2 * CW, nullptr, (bf16*)(ws + WS_WKVC), DM, DM, 0) \
        P0_SETD(d, 0, F.in[I_WOC], CW, DM, nullptr, (bf16*)(ws + WS_WOC), CW, CW, 0) \
    } while (0)
    CVT_PIPE(TOTAL, P0_DESC);
#undef P0_SETD
#undef P0_DESC
    const float* x = F.in[I_X]; bf16* xb = (bf16*)(ws + WS_XB); float* rstd1 = (float*)(ws + WS_RSTD);
    for (int m = gw; m < MT + NB * MEMLEN; m += NGW) {
        const bool ismem = m >= MT; const int mm = ismem ? m - MT : m;
        const f32x4* xr = (const f32x4*)((ismem ? F.in[I_MEM] : x) + (size_t)mm * DM) + F.lane;
        f32x4 v[8]; float s = 0.f;
#pragma unroll
        for (int j = 0; j < 8; ++j) { v[j] = xr[64 * j]; s += (v[j].x * v[j].x + v[j].y * v[j].y) + (v[j].z * v[j].z + v[j].w * v[j].w); }
        const float rs = 1.0f / sqrtf(wave_sum(s) * (1.f / DM) + RMS_EPS);
        if (!ismem) {
            float am = 0.f;
#pragma unroll
            for (int j = 0; j < 8; ++j) am = fmaxf(am, fmaxf(fmaxf(fabsf(v[j].x), fabsf(v[j].y)), fmaxf(fabsf(v[j].z), fabsf(v[j].w))));
#pragma unroll
            for (int o = 32; o >= 1; o >>= 1) am = fmaxf(am, __shfl_xor(am, o));
            am = fmaxf(am, 1e-30f); const float qs = 127.f / am;
            if (F.lane == 0) rstd1[mm] = rs * am * (1.f / 127.f);
            unsigned* o8 = (unsigned*)((unsigned char*)xb + (size_t)mm * DM) + F.lane;
#pragma unroll
            for (int j = 0; j < 8; ++j) o8[64 * j] = pack4_i8(rintf(v[j].x * qs), rintf(v[j].y * qs), rintf(v[j].z * qs), rintf(v[j].w * qs));
        } else { const f32x4* gr = (const f32x4*)F.in[I_GMEM] + F.lane;
            u32x2* o8 = (u32x2*)((bf16*)(ws + WS_MEMN) + (size_t)mm * DM) + F.lane;
#pragma unroll
            for (int j = 0; j < 8; ++j) { const f32x4 g = gr[64 * j]; u32x2 w; w.x = cvt_pk_bf16(v[j].x * rs * g.x, v[j].y * rs * g.y); w.y = cvt_pk_bf16(v[j].z * rs * g.z, v[j].w * rs * g.w); o8[64 * j] = w; }
        }
    }
    const int gt = F.vcu * 512 + F.tid, NGT = F.G * 512;
    { const int* pos = (const int*)F.in[I_POS]; f32x2* cs = (f32x2*)(ws + WS_ROPE);
      for (int i = gt; i < MT * 32; i += NGT) { const int t = i >> 5, f = i & 31;
          const float inv = exp2f(-(float)f * (13.287712379549449f / 32.0f));
          const float ang = (float)pos[t] * inv;
          const double a = (double)ang; const double k = rint(a * 0.15915494309189535); const float red = (float)(a - k * 6.283185307179586);
          cs[i] = (f32x2){cosf(red), sinf(red)}; } }
    { float* WR = (float*)(ws + WS_WR); const float* gf = F.in[I_GFFN];
      for (int i = gt; i < DM * 36; i += NGT) { const int k = i / 36, c = i % 36; float w;
          if (c < 4) w = F.in[I_WRG][k * 4 + c]; else { const int gi = (c - 4) >> 3, e = (c - 4) & 7; w = F.in[I_WRE][((size_t)gi * DM + k) * 8 + e]; }
          WR[i] = w * gf[k]; } }
}

__device__ __forceinline__ void p_final(Frame& F, bool with_moe) {
    const int gw = F.vcu * 8 + F.wave, NGW = F.G * 8;
    const f32x4* gr = (const f32x4*)F.in[I_GFINAL] + F.lane;
    const int* route = (const int*)(F.ws + WS_ROUTE); const bf16* ybuf = (const bf16*)(F.ws + WS_YBUF);
    const int* cnts = (const int*)(F.ctl + CW_CNT);
    for (int m = gw; m < MT; m += NGW) {
        f32x4* xr = (f32x4*)(F.out + (size_t)m * DM) + F.lane;
        f32x4 v[8];
#pragma unroll
        for (int j = 0; j < 8; ++j) v[j] = xr[64 * j];
        if (with_moe) {
#pragma unroll
            for (int kx = 0; kx < 2; ++kx) { const int e = route[m * 8 + 2 * kx], pos = route[m * 8 + 2 * kx + 1];
                int base = 0; for (int q = 0; q < e; ++q) base += (cnts[64 * q] + 255) & ~255;
                const u32x2* yr = (const u32x2*)(ybuf + (size_t)(base + pos) * DM) + F.lane;
#pragma unroll
                for (int j = 0; j < 8; ++j) { const u32x2 w = yr[64 * j]; v[j].x += bflo(w.x); v[j].y += bfhi(w.x); v[j].z += bflo(w.y); v[j].w += bfhi(w.y); } }
        }
        float s = 0.f;
#pragma unroll
        for (int j = 0; j < 8; ++j) s += (v[j].x * v[j].x + v[j].y * v[j].y) + (v[j].z * v[j].z + v[j].w * v[j].w);
        const float rs = 1.0f / sqrtf(wave_sum(s) * (1.f / DM) + RMS_EPS);
#pragma unroll
        for (int j = 0; j < 8; ++j) { const f32x4 g = gr[64 * j]; xr[64 * j] = (f32x4){v[j].x * rs * g.x, v[j].y * rs * g.y, v[j].z * rs * g.z, v[j].w * rs * g.w}; }
    }
}
__device__ __forceinline__ void p_copy_x(Frame& F) {
    const int gt = F.vcu * 512 + F.tid, NGT = F.G * 512; const f32x4* s = (const f32x4*)F.in[I_X]; f32x4* d = (f32x4*)F.out;
    for (int i = gt; i < MT * DM / 4; i += NGT) d[i] = s[i];
}

__device__ __forceinline__ void p2_rowpass(Frame& F) {
    const int gw = F.vcu * 8 + F.wave, NGW = F.G * 8, l = F.lane;
    unsigned char* ws = F.ws;
    const bf16* zm = (const bf16*)(ws + WS_ZMLA); const bf16* zl = (const bf16*)(ws + WS_ZLORA); bf16* la = (bf16*)(ws + WS_LORAA);
    float* rstd_q = (float*)(ws + WS_RSTD) + MT; float* rstd_kv = (float*)(ws + WS_RSTD) + 2 * MT;
    const f32x2* cs = (const f32x2*)(ws + WS_ROPE); unsigned char* Kb = ws + WS_K;
    const float* sh = F.in[I_SHIFT] + 6144;
    f32x2 s0[5], s1[5], s2[5];
#pragma unroll
    for (int i = 0; i < 5; ++i) { const int j = 2 * l + 128 * i; s0[i] = *(const f32x2*)(sh + j); s1[i] = *(const f32x2*)(sh + RWKV_IN + j); s2[i] = *(const f32x2*)(sh + 2 * RWKV_IN + j); }
    for (int t = gw; t < MT; t += NGW) {
        const bf16* zr = zm + (size_t)t * ZM_LD;
        { const u32x4 w = *((const u32x4*)zr + l); float s = 0.f;
          s += bflo(w.x) * bflo(w.x) + bfhi(w.x) * bfhi(w.x) + bflo(w.y) * bflo(w.y) + bfhi(w.y) * bfhi(w.y) + bflo(w.z) * bflo(w.z) + bfhi(w.z) * bfhi(w.z) + bflo(w.w) * bflo(w.w) + bfhi(w.w) * bfhi(w.w);
          s = wave_sum(s); if (l == 0) rstd_q[t] = 1.0f / sqrtf(s * (1.f / QLORA) + RMS_EPS); }
        { const u32x2 w = *((const u32x2*)(zr + QLORA) + l); float s = bflo(w.x) * bflo(w.x) + bfhi(w.x) * bfhi(w.x) + bflo(w.y) * bflo(w.y) + bfhi(w.y) * bfhi(w.y);
          s = wave_sum(s); if (l == 0) rstd_kv[t] = 1.0f / sqrtf(s * (1.f / KVLORA) + RMS_EPS); }
        { const int i = l & 31, hs = l >> 5; const unsigned w = *((const unsigned*)(zr + 768) + i); const float x1 = bflo(w), x2 = bfhi(w); const f32x2 c = cs[(size_t)t * 32 + i];
          const unsigned short o = (unsigned short)__builtin_amdgcn_cvt_pk_fp8_f32(x1 * c.x - x2 * c.y, x2 * c.x + x1 * c.y, 0, false);
#pragma unroll
          for (int hh = 0; hh < 8; ++hh) *((unsigned short*)(Kb + (size_t)t * (MH * QKD) + (hs * 8 + hh) * QKD + NOPE) + i) = o; }
        const int s = t % SEQ; const float fp = s > 0 ? 1.f : 0.f, fn = s < SEQ - 1 ? 1.f : 0.f;
        const bf16* z0 = zl + (size_t)t * ZL_LD; const bf16* zp = s > 0 ? z0 - ZL_LD : z0; const bf16* zn = s < SEQ - 1 ? z0 + ZL_LD : z0;
        bf16* lr = la + (size_t)t * LA_LD;
#pragma unroll
        for (int i = 0; i < 5; ++i) { const int j = 2 * l + 128 * i;
            const unsigned wp = *(const unsigned*)(zp + j), w0 = *(const unsigned*)(z0 + j), wn = *(const unsigned*)(zn + j);
            float va = s0[i].x * fp * bflo(wp) + s1[i].x * bflo(w0) + s2[i].x * fn * bflo(wn);
            float vb = s0[i].y * fp * bfhi(wp) + s1[i].y * bfhi(w0) + s2[i].y * fn * bfhi(wn);
            int dst;
            if (j < 192) { va = tanhf(va); vb = tanhf(vb); dst = (j / 96) * 128 + (j % 96); } else if (j < 384) { dst = (j / 96) * 128 + (j % 96); } else { va = sigmoidf_(va); vb = sigmoidf_(vb); dst = 512 + (j - 384); }
            *(unsigned*)(lr + dst) = cvt_pk_bf16(va, vb); }
        { const int p = 2 * l; *(unsigned*)(lr + (p >> 5) * 128 + 96 + (p & 31)) = 0u; }
    }
}

namespace scan {
constexpr int TC = 16, DATA_B = TC * 6 * 64 * 4, BUF_B = DATA_B + 64 + TC * 32 * 4;
template <int CTRL> __device__ __forceinline__ float dpp_add(float v) {
    return v + __builtin_bit_cast(float, __builtin_amdgcn_update_dpp(0, __builtin_bit_cast(int, v), CTRL, 0xF, 0xF, false));
}
__device__ __forceinline__ float red16(float v) { v = dpp_add<0xB1>(v); v = dpp_add<0x4E>(v); v = dpp_add<0x141>(v); v = dpp_add<0x140>(v); return v; }
struct Raw { unsigned short r[3], k[3], v[3], wl, ic; };
template <int VAR> __device__ __forceinline__ void scan_unit(Frame& F, const int b, const int h, const int dir, const int half) {
    unsigned char* ws = F.ws; const int l = F.lane, w = F.wave, tid = F.tid;
    const bf16* zr = (const bf16*)(ws + WS_ZRKV) + (size_t)b * SEQ * ZR_LD + h * 64 + l;
    const bf16* wlp = (const bf16*)(ws + (dir ? WS_WLB : WS_WLF)) + (size_t)b * SEQ * RW + h * 64 + l;
    const bf16* icp = (const bf16*)(ws + (dir ? WS_ICB : WS_ICF)) + (size_t)b * SEQ * RW + h * 64 + l;
    bf16* yout = (bf16*)(ws + (dir ? WS_YB : WS_YF)) + (size_t)b * SEQ * RW + h * 64 + half * 32;
    const int ch = h * 64 + l; const float* sh = F.in[I_SHIFT];
    const float sr0 = sh[ch], sr1 = sh[RWKV_IN + ch], sr2 = sh[2 * RWKV_IN + ch];
    const float sk0 = sh[2048 + ch], sk1 = sh[RWKV_IN + 2048 + ch], sk2 = sh[2 * RWKV_IN + 2048 + ch];
    const float sv0 = sh[4096 + ch], sv1 = sh[RWKV_IN + 4096 + ch], sv2 = sh[2 * RWKV_IN + 4096 + ch];
    const float kk_c = F.in[I_KK][ch], ka_c = F.in[I_KA][ch], rk_c = F.in[I_RK][ch];
    LAS unsigned char* L = F.lds;
    Raw raw[2];
#define SC_TOK(ci, i) (dir ? (SEQ - 1 - ((ci) * TC + (i))) : ((ci) * TC + (i)))
#define SC_LOAD(ci) do { _Pragma("unroll") for (int q = 0; q < 2; ++q) { const int s = SC_TOK(ci, 2 * w + q); const int sp = s > 0 ? s - 1 : s, sn = s < SEQ - 1 ? s + 1 : s; \
        const bf16* z0 = zr + (size_t)s * ZR_LD; const bf16* zp = zr + (size_t)sp * ZR_LD; const bf16* zn = zr + (size_t)sn * ZR_LD; \
        raw[q].r[0] = zp[0]; raw[q].r[1] = z0[0]; raw[q].r[2] = zn[0]; raw[q].k[0] = zp[2048]; raw[q].k[1] = z0[2048]; raw[q].k[2] = zn[2048]; \
        raw[q].v[0] = zp[4096]; raw[q].v[1] = z0[4096]; raw[q].v[2] = zn[4096]; raw[q].wl = wlp[(size_t)s * RW]; raw[q].ic = icp[(size_t)s * RW]; } } while (0)
#define SC_PREP(ci, bufi) do { _Pragma("unroll") for (int q = 0; q < 2; ++q) { const int i = 2 * w + q; const int s = SC_TOK(ci, i); const float fp = s > 0 ? 1.f : 0.f, fn = s < SEQ - 1 ? 1.f : 0.f; \
        const float r_s = sr0 * fp * bf2f(raw[q].r[0]) + sr1 * bf2f(raw[q].r[1]) + sr2 * fn * bf2f(raw[q].r[2]); \
        const float k_s = sk0 * fp * bf2f(raw[q].k[0]) + sk1 * bf2f(raw[q].k[1]) + sk2 * fn * bf2f(raw[q].k[2]); \
        const float v_s = sv0 * fp * bf2f(raw[q].v[0]) + sv1 * bf2f(raw[q].v[1]) + sv2 * fn * bf2f(raw[q].v[2]); \
        const float kkr = k_s * kk_c; const float ss = wave_sum(kkr * kkr); const float kk = kkr * (1.0f / sqrtf(ss + 1e-12f)); \
        const float icv = bf2f(raw[q].ic); const float kd = k_s * (1.0f + (icv - 1.0f) * ka_c); const float bb = kk * icv; const float wd = __builtin_amdgcn_exp2f(bf2f(raw[q].wl)); \
        const float bon = wave_sum(r_s * kd * rk_c); \
        LAS float* d = (LAS float*)(L + (bufi) * BUF_B) + i * 384 + l; d[0] = wd; d[64] = kk; d[128] = bb; d[192] = kd; d[256] = r_s; d[320] = v_s; \
        if (l == 0) ((LAS float*)(L + (bufi) * BUF_B + DATA_B))[i] = bon; } } while (0)
    const int g = l >> 4, j = l & 15, row = half * 32 + w * 4 + g;
    f32x2 Sa = {0.f, 0.f}, Sb = {0.f, 0.f};
    struct Ops { f32x4 w, a, b, k, r; float v, bon; };
#define SC_LD(O, i) do { O.w = p4[(i) * 96 + j]; O.a = p4[(i) * 96 + 16 + j]; O.b = p4[(i) * 96 + 32 + j]; O.k = p4[(i) * 96 + 48 + j]; O.r = p4[(i) * 96 + 64 + j]; \
        O.v = pf[(i) * 384 + 320 + row]; O.bon = pb[i]; } while (0)
#define SC_STEP(O, YP) do { f32x2 t = Sa * O.a.xy; t = Sb * O.a.zw + t; float sa = red16(t.x + t.y); \
        const f32x2 nsa = {-sa, -sa}; const f32x2 vv2 = {O.v, O.v}; \
        const f32x2 u0 = nsa * O.b.xy + vv2 * O.k.xy, u1 = nsa * O.b.zw + vv2 * O.k.zw; \
        Sa = Sa * O.w.xy + u0; Sb = Sb * O.w.zw + u1; \
        f32x2 ty = Sa * O.r.xy; ty = Sb * O.r.zw + ty; YP = ty.x + ty.y; } while (0)
    SC_LOAD(0); SC_PREP(0, 0); __syncthreads();
    constexpr int NCH = SEQ / TC;
    for (int ci = 0; ci < NCH; ++ci) {
        const int bi = ci & 1;
        if (VAR != 2 && ci + 1 < NCH) SC_LOAD(ci + 1);
        const LAS f32x4* p4 = (const LAS f32x4*)(L + bi * BUF_B); const LAS float* pf = (const LAS float*)(L + bi * BUF_B);
        const LAS float* pb = (const LAS float*)(L + bi * BUF_B + DATA_B);
        float ykeep = 0.f;
        Ops oA, oB; SC_LD(oA, 0);
        if (VAR != 1) {
#pragma unroll
        for (int i = 0; i < TC; i += 4) {
            float y0, y1, y2, y3; float v0, v1, v2, v3, b0, b1, b2, b3;
            SC_LD(oB, i + 1); v0 = oA.v; b0 = oA.bon; SC_STEP(oA, y0);
            SC_LD(oA, i + 2); v1 = oB.v; b1 = oB.bon; SC_STEP(oB, y1);
            SC_LD(oB, i + 3); v2 = oA.v; b2 = oA.bon; SC_STEP(oA, y2);
            if (i + 4 < TC) SC_LD(oA, i + 4);
            v3 = oB.v; b3 = oB.bon; SC_STEP(oB, y3);
            y0 = red16(y0); y1 = red16(y1); y2 = red16(y2); y3 = red16(y3);
            y0 += b0 * v0; y1 += b1 * v1; y2 += b2 * v2; y3 += b3 * v3;
            ykeep = (j == i) ? y0 : ykeep; ykeep = (j == i + 1) ? y1 : ykeep; ykeep = (j == i + 2) ? y2 : ykeep; ykeep = (j == i + 3) ? y3 : ykeep;
        }
        }
        ((LAS float*)(L + bi * BUF_B + DATA_B + 64))[j * 32 + w * 4 + g] = ykeep;
        if (VAR != 2 && ci + 1 < NCH) SC_PREP(ci + 1, bi ^ 1);
        __syncthreads();
        { const int st = tid >> 5, rw_ = tid & 31; const int s = SC_TOK(ci, st);
          const unsigned short yv = f2bf(((const LAS float*)(L + bi * BUF_B + DATA_B + 64))[st * 32 + rw_]);
          if (VAR == 0) yout[(size_t)s * RW + rw_] = yv; else asm volatile("" :: "v"(yv)); }
    }
    __syncthreads();
#undef SC_TOK
#undef SC_LOAD
#undef SC_PREP
#undef SC_LD
#undef SC_STEP
}
}

namespace scan2 {
constexpr int TC = 16, NS = 6, NPREP = 6, NREC = 2;
constexpr int ROWB = 144;
constexpr int P_ACAT = 0, P_BHAT = 4608, P_KHAT = 6656, P_VT = 8704, P_NCAT = 10752, P_MRF = 11776, P_PC = 12800, P_GINIT = 13056  , PKG_B = 15104;
constexpr int S_L1 = 0, S_L2 = 4608, S_MF = 9216, S_NF = 10240, SCR_B = 11264;
constexpr int OFF_PKG = 0, OFF_SCR = NS * PKG_B, OFF_FLAG = OFF_SCR + NPREP * SCR_B, TOTAL_B = OFF_FLAG + 64;
static_assert(TOTAL_B <= 156 * 1024, "scan2 LDS");
__device__ __forceinline__ int crow(int r, int hi) { return (r & 3) + 8 * (r >> 2) + 4 * hi; }
__device__ __forceinline__ void lds_st16(LAS unsigned char* p, float v) { *(LAS unsigned short*)p = f2bf(v); }
__device__ __forceinline__ bf16x8 pack_acc8(const f32x16& x, int base) {
    u32x4 w = {cvt_pk_bf16(x[base + 0], x[base + 1]), cvt_pk_bf16(x[base + 2], x[base + 3]), cvt_pk_bf16(x[base + 4], x[base + 5]), cvt_pk_bf16(x[base + 6], x[base + 7])};
    return *reinterpret_cast<bf16x8*>(&w);
}
__device__ __forceinline__ float wave_sum_b(float v) {
    v = scan::red16(v);
    v += __builtin_bit_cast(float, __builtin_amdgcn_update_dpp(0, __builtin_bit_cast(int, v), 0x142, 0xA, 0xF, false));
    v += __builtin_bit_cast(float, __builtin_amdgcn_update_dpp(0, __builtin_bit_cast(int, v), 0x143, 0xC, 0xF, false));
    return __builtin_bit_cast(float, __builtin_amdgcn_readlane(__builtin_bit_cast(int, v), 63));
}
__device__ __forceinline__ void spin_ge(volatile LAS int* p, int want) { while (*p < want) __builtin_amdgcn_s_sleep(1); }

template <int dir> __device__ __forceinline__ void scan_unit(Frame& F, const int b, const int h) {
    unsigned char* ws = F.ws; const int l = F.lane, w = F.wave;
    LAS unsigned char* L = F.lds;
    volatile LAS int* ready = (volatile LAS int*)(L + OFF_FLAG);
    volatile LAS int* consumed = ready + NS;
    if (F.tid < 16) ready[F.tid] = 0;
    __syncthreads();
    constexpr int NCH = SEQ / TC;
    if (w < NREC) {
        const int half = w; const int v = l & 31, hi = l >> 5, vg = 32 * half + v;
        __builtin_amdgcn_s_setprio(3);
        f32x16 X0 = {}, X1 = {}; unsigned long long rec_acc = 0ull;
        bf16* yout = (bf16*)(ws + (dir ? WS_YB : WS_YF)) + (size_t)b * SEQ * RW + h * 64 + half * 32 + v;
        for (int ci = 0; ci < NCH; ++ci) {
            const int slot = ci % NS; const LAS unsigned char* P = L + OFF_PKG + slot * PKG_B;
            const unsigned long long tr0 = (SCAN_SEC == 9) ? __builtin_amdgcn_s_memtime() : 0ull;
            spin_ge(ready + slot, ci + 1);
            if (SCAN_SEC == 9) rec_acc += __builtin_amdgcn_s_memtime() - tr0;
            const bf16x8 a00 = *(const LAS bf16x8*)(P + P_ACAT + v * ROWB + (0 + hi) * 16), a01 = *(const LAS bf16x8*)(P + P_ACAT + v * ROWB + (2 + hi) * 16);
            const bf16x8 a10 = *(const LAS bf16x8*)(P + P_ACAT + v * ROWB + (4 + hi) * 16), a11 = *(const LAS bf16x8*)(P + P_ACAT + v * ROWB + (6 + hi) * 16);
            const bf16x8 ncat = *(const LAS bf16x8*)(P + P_NCAT + v * 32 + hi * 16), vt = *(const LAS bf16x8*)(P + P_VT + vg * 32 + hi * 16);
            const bf16x8 mrf = *(const LAS bf16x8*)(P + P_MRF + l * 16);
            const bf16x8 bh0 = *(const LAS bf16x8*)(P + P_BHAT + v * 32 + hi * 16), bh1 = *(const LAS bf16x8*)(P + P_BHAT + (32 + v) * 32 + hi * 16);
            const bf16x8 kh0 = *(const LAS bf16x8*)(P + P_KHAT + v * 32 + hi * 16), kh1 = *(const LAS bf16x8*)(P + P_KHAT + (32 + v) * 32 + hi * 16);
            f32x16 G;
            { const u32x2 q0 = *(const LAS u32x2*)(P + P_GINIT + vg * 32 + hi * 8), q1 = *(const LAS u32x2*)(P + P_GINIT + vg * 32 + 16 + hi * 8);
              const f32x4 g0 = {bflo(q0.x), bfhi(q0.x), bflo(q0.y), bfhi(q0.y)}, g1 = {bflo(q1.x), bfhi(q1.x), bflo(q1.y), bfhi(q1.y)};
#pragma unroll
              for (int r = 0; r < 8; ++r) G[r] = 0.f;
#pragma unroll
              for (int r = 0; r < 4; ++r) { G[8 + r] = g0[r]; G[12 + r] = g1[r]; } }
            f32x4 pc[8];
#pragma unroll
            for (int q = 0; q < 8; ++q) pc[q] = *(const LAS f32x4*)(P + P_PC + (32 * (q >> 2) + 8 * (q & 3) + 4 * hi) * 4);
            const bf16x8 s00 = pack_acc8(X0, 0), s01 = pack_acc8(X0, 8), s10 = pack_acc8(X1, 0), s11 = pack_acc8(X1, 8);
            G = __builtin_amdgcn_mfma_f32_32x32x16_bf16(a00, s00, G, 0, 0, 0);
            G = __builtin_amdgcn_mfma_f32_32x32x16_bf16(a01, s01, G, 0, 0, 0);
            G = __builtin_amdgcn_mfma_f32_32x32x16_bf16(a10, s10, G, 0, 0, 0);
            G = __builtin_amdgcn_mfma_f32_32x32x16_bf16(a11, s11, G, 0, 0, 0);
            G = __builtin_amdgcn_mfma_f32_32x32x16_bf16(ncat, vt, G, 0, 0, 0);
            const bf16x8 uf = pack_acc8(G, 0);
#pragma unroll
            for (int r = 0; r < 16; ++r) { X0[r] *= pc[r >> 2][r & 3]; X1[r] *= pc[4 + (r >> 2)][r & 3]; }
            X0 = __builtin_amdgcn_mfma_f32_32x32x16_bf16(bh0, uf, X0, 0, 0, 0);
            X1 = __builtin_amdgcn_mfma_f32_32x32x16_bf16(bh1, uf, X1, 0, 0, 0);
            X0 = __builtin_amdgcn_mfma_f32_32x32x16_bf16(kh0, vt, X0, 0, 0, 0);
            X1 = __builtin_amdgcn_mfma_f32_32x32x16_bf16(kh1, vt, X1, 0, 0, 0);
            G = __builtin_amdgcn_mfma_f32_32x32x16_bf16(mrf, uf, G, 0, 0, 0);
            LDS_WAIT();
            if (l == 0) consumed[half] = ci + 1;
#pragma unroll
            for (int q = 0; q < 8; ++q) { const int t = crow(q, hi); const int s = dir ? (SEQ - 1 - (ci * TC + t)) : (ci * TC + t);
                yout[(size_t)s * RW] = f2bf(G[8 + q]); }
        }
        __builtin_amdgcn_s_setprio(0);
        if (SCAN_SEC == 9 && blockIdx.x == 0 && w == 0 && l == 0) { F.MISC[120] = (unsigned)rec_acc; F.MISC[121] = (unsigned)(rec_acc >> 32); }
    } else {
        const int pw = w - NREC; LAS unsigned char* SC = L + OFF_SCR + pw * SCR_B;
        const __amdgpu_buffer_rsrc_t rsZ = __builtin_amdgcn_make_buffer_rsrc((void*)(ws + WS_ZRKV + ((size_t)b * SEQ * ZR_LD + h * 64) * 2), (short)0, (int)(SEQ * ZR_LD * 2), 0x00020000);
        const __amdgpu_buffer_rsrc_t rsW = __builtin_amdgcn_make_buffer_rsrc((void*)(ws + (dir ? WS_WLB : WS_WLF) + ((size_t)b * SEQ * RW + h * 64) * 2), (short)0, (int)(SEQ * RW * 2), 0x00020000);
        const __amdgpu_buffer_rsrc_t rsI = __builtin_amdgcn_make_buffer_rsrc((void*)(ws + (dir ? WS_ICB : WS_ICF) + ((size_t)b * SEQ * RW + h * 64) * 2), (short)0, (int)(SEQ * RW * 2), 0x00020000);
        const unsigned vl2 = (unsigned)l * 2u;
        const int ch = h * 64 + l; const float* sh = F.in[I_SHIFT];
        const float sr0 = sh[ch], sr1 = sh[RWKV_IN + ch], sr2 = sh[2 * RWKV_IN + ch];
        const float sk0 = sh[2048 + ch], sk1 = sh[RWKV_IN + 2048 + ch], sk2 = sh[2 * RWKV_IN + 2048 + ch];
        const float sv0 = sh[4096 + ch], sv1 = sh[RWKV_IN + 4096 + ch], sv2 = sh[2 * RWKV_IN + 4096 + ch];
        const float kk_c = F.in[I_KK][ch], ka_c = F.in[I_KA][ch], rk_c = F.in[I_RK][ch];
        const int posk = (((l >> 5) * 2 + ((l >> 4) & 1)) * 2 + ((l >> 2) & 1)) * 8 + ((l >> 3) & 1) * 4 + (l & 3);
        unsigned long long sec_acc = 0ull;
#define S2_T() ((SCAN_SEC >= 0) ? __builtin_amdgcn_s_memtime() : 0ull)
        for (int ci = pw; ci < NCH; ci += NPREP) {
            const int slot = ci % NS; LAS unsigned char* P = L + OFF_PKG + slot * PKG_B;
            const unsigned long long ts0 = S2_T();
            const int s_lo = dir ? (SEQ - TC - ci * TC) : ci * TC;
            float rr[18], rk[18], rv[18], wl[16], ic[16];
            { unsigned short ur[18], uk[18], uv[18], uw[16], ui[16];
#pragma unroll
              for (int tau = 0; tau < 18; ++tau) { const int s = s_lo - 1 + tau; const int sc = (tau == 0 && s < 0) ? s_lo : (tau == 17 && s >= SEQ) ? s_lo : s;
                  const unsigned so = (unsigned)sc * (unsigned)(ZR_LD * 2);
                  ur[tau] = __builtin_amdgcn_raw_buffer_load_b16(rsZ, vl2, so, 0); uk[tau] = __builtin_amdgcn_raw_buffer_load_b16(rsZ, vl2, so + 4096u, 0); uv[tau] = __builtin_amdgcn_raw_buffer_load_b16(rsZ, vl2, so + 8192u, 0); }
#pragma unroll
              for (int i = 0; i < 16; ++i) { const int s = dir ? (s_lo + 15 - i) : (s_lo + i); const unsigned so = (unsigned)s * (unsigned)(RW * 2);
                  uw[i] = __builtin_amdgcn_raw_buffer_load_b16(rsW, vl2, so, 0); ui[i] = __builtin_amdgcn_raw_buffer_load_b16(rsI, vl2, so, 0); }
              __builtin_amdgcn_sched_barrier(0);
#pragma unroll
              for (int tau = 0; tau < 18; ++tau) { rr[tau] = bf2f(ur[tau]); rk[tau] = bf2f(uk[tau]); rv[tau] = bf2f(uv[tau]); }
              { const float f0 = (s_lo - 1 >= 0) ? 1.f : 0.f, f17 = (s_lo + 16 < SEQ) ? 1.f : 0.f;
                rr[0] *= f0; rk[0] *= f0; rv[0] *= f0; rr[17] *= f17; rk[17] *= f17; rv[17] *= f17; }
#pragma unroll
              for (int i = 0; i < 16; ++i) { wl[i] = bf2f(uw[i]); ic[i] = bf2f(ui[i]); } }
            float cum[16];
            cum[0] = wl[0];
#pragma unroll
            for (int i = 1; i < 16; ++i) cum[i] = cum[i - 1] + wl[i];
            const unsigned long long tsA = S2_T();
            float rs_[16], ks_[16], vs_[16], q1[16], q2[16];
#pragma unroll
            for (int i = 0; i < 16; ++i) { const int tau = dir ? (16 - i) : (i + 1);
                rs_[i] = sr0 * rr[tau - 1] + sr1 * rr[tau] + sr2 * rr[tau + 1];
                ks_[i] = sk0 * rk[tau - 1] + sk1 * rk[tau] + sk2 * rk[tau + 1];
                vs_[i] = sv0 * rv[tau - 1] + sv1 * rv[tau] + sv2 * rv[tau + 1];
                const float kkr = ks_[i] * kk_c; q1[i] = kkr * kkr; q2[i] = rs_[i] * (ks_[i] * (1.0f + (ic[i] - 1.0f) * ka_c)) * rk_c; }
#define S2_DPPSTEP(CTRL, RM) do { _Pragma("unroll") for (int i = 0; i < 16; ++i) { \
                q1[i] += __builtin_bit_cast(float, __builtin_amdgcn_update_dpp(0, __builtin_bit_cast(int, q1[i]), CTRL, RM, 0xF, false)); \
                q2[i] += __builtin_bit_cast(float, __builtin_amdgcn_update_dpp(0, __builtin_bit_cast(int, q2[i]), CTRL, RM, 0xF, false)); } } while (0)
            S2_DPPSTEP(0xB1, 0xF); S2_DPPSTEP(0x4E, 0xF); S2_DPPSTEP(0x141, 0xF); S2_DPPSTEP(0x140, 0xF);
            __builtin_amdgcn_sched_barrier(0);
            asm volatile("s_nop 1");
#define S2_BCAST(CTRL) do { _Pragma("unroll") for (int i = 0; i < 16; ++i) { \
                asm volatile("v_add_f32_dpp %0, %0, %0 " CTRL " bank_mask:0xf" : "+v"(q1[i])); asm volatile("v_add_f32_dpp %0, %0, %0 " CTRL " bank_mask:0xf" : "+v"(q2[i])); } } while (0)
            S2_BCAST("row_bcast:15 row_mask:0xa"); S2_BCAST("row_bcast:31 row_mask:0xc");
#undef S2_BCAST
            asm volatile("s_nop 1");
            __builtin_amdgcn_sched_barrier(0);
#undef S2_DPPSTEP
            const unsigned long long ts1 = S2_T();
            spin_ge(consumed, ci - NS + 1); spin_ge(consumed + 1, ci - NS + 1);
            const unsigned long long ts2 = S2_T();
            float at[16], bhv[16], khv[16], giv[16]; float pprev = 1.0f; const float pC = __builtin_amdgcn_exp2f(cum[15]);
#pragma unroll
            for (int i = 0; i < 16; ++i) {
                const float r_s = rs_[i], k_s = ks_[i], v_s = vs_[i];
                const float ss = __uint_as_float(__builtin_amdgcn_readlane(__float_as_uint(q1[i]), 63)), bon = __uint_as_float(__builtin_amdgcn_readlane(__float_as_uint(q2[i]), 63));
                const float kk = k_s * kk_c * __builtin_amdgcn_rsqf(ss + 1e-12f);
                const float kd = k_s * (1.0f + (ic[i] - 1.0f) * ka_c); const float bb = kk * ic[i];
                const float p = __builtin_amdgcn_exp2f(cum[i]), pm = pprev, pinv = __builtin_amdgcn_exp2f(-cum[i]), pr = pC * pinv; pprev = p;
                at[i] = -kk * pm;
                lds_st16(P + P_ACAT + i * ROWB + posk * 2, at[i]);
                const float rt = r_s * p;
                lds_st16(P + P_ACAT + (16 + i) * ROWB + posk * 2, rt);
                lds_st16(SC + S_L1 + i * ROWB + posk * 2, bb * pinv); lds_st16(SC + S_L1 + (16 + i) * ROWB + posk * 2, kd * pinv);
                bhv[((i >> 2) & 1) * 8 + (i & 3) + 4 * (i >> 3)] = bb * pr; khv[i] = kd * pr; giv[i] = bon * v_s;
            }
#pragma unroll
            for (int hf = 0; hf < 2; ++hf) {
                *(LAS u32x4*)(P + P_BHAT + l * 32 + hf * 16) = (u32x4){cvt_pk_bf16(bhv[hf * 8 + 0], bhv[hf * 8 + 1]), cvt_pk_bf16(bhv[hf * 8 + 2], bhv[hf * 8 + 3]), cvt_pk_bf16(bhv[hf * 8 + 4], bhv[hf * 8 + 5]), cvt_pk_bf16(bhv[hf * 8 + 6], bhv[hf * 8 + 7])};
                *(LAS u32x4*)(P + P_KHAT + l * 32 + hf * 16) = (u32x4){cvt_pk_bf16(khv[hf * 8 + 0], khv[hf * 8 + 1]), cvt_pk_bf16(khv[hf * 8 + 2], khv[hf * 8 + 3]), cvt_pk_bf16(khv[hf * 8 + 4], khv[hf * 8 + 5]), cvt_pk_bf16(khv[hf * 8 + 6], khv[hf * 8 + 7])};
                *(LAS u32x4*)(P + P_VT + l * 32 + hf * 16) = (u32x4){cvt_pk_bf16(vs_[hf * 8 + 0], vs_[hf * 8 + 1]), cvt_pk_bf16(vs_[hf * 8 + 2], vs_[hf * 8 + 3]), cvt_pk_bf16(vs_[hf * 8 + 4], vs_[hf * 8 + 5]), cvt_pk_bf16(vs_[hf * 8 + 6], vs_[hf * 8 + 7])};
                *(LAS u32x4*)(P + P_GINIT + l * 32 + hf * 16) = (u32x4){cvt_pk_bf16(giv[hf * 8 + 0], giv[hf * 8 + 1]), cvt_pk_bf16(giv[hf * 8 + 2], giv[hf * 8 + 3]), cvt_pk_bf16(giv[hf * 8 + 4], giv[hf * 8 + 5]), cvt_pk_bf16(giv[hf * 8 + 6], giv[hf * 8 + 7])}; }
            *(LAS float*)(P + P_PC + l * 4) = pC;
            LDS_WAIT();
            const unsigned long long ts3 = S2_T();
            f32x16 Z = {};
            { const int r = l & 31, hh = l >> 5;
#pragma unroll
              for (int ks = 0; ks < 4; ++ks) { const bf16x8 fa = *(const LAS bf16x8*)(SC + S_L1 + r * ROWB + (ks * 16 + hh * 8) * 2), fb = *(const LAS bf16x8*)(P + P_ACAT + r * ROWB + (ks * 16 + hh * 8) * 2);
                  Z = __builtin_amdgcn_mfma_f32_32x32x16_bf16(fa, fb, Z, 0, 0, 0); } }
            { const int c = l & 31, hh = l >> 5;
              if (c < 16) {
#pragma unroll
                  for (int r = 0; r < 8; ++r) { const int s = crow(r, hh); *(LAS float*)(SC + S_MF + (c * 16 + s) * 4) = (s < c) ? Z[r] : 0.f; }
#pragma unroll
                  for (int r = 8; r < 16; ++r) { const int s = crow(r, hh) - 16; *(LAS float*)(SC + S_NF + (s * 16 + c) * 4) = (s < c) ? Z[r] : 0.f; }
                  *(LAS u32x4*)(P + P_MRF + l * 16) = (u32x4){0u, 0u, 0u, 0u};
              } else { const int t = c - 16; f32x16 Zm = Z;
#pragma unroll
                  for (int r = 0; r < 8; ++r) { const int s = crow(r, hh); Zm[r] = (s <= t) ? Z[r] : 0.f; }
                  *(LAS bf16x8*)(P + P_MRF + l * 16) = pack_acc8(Zm, 0);
#pragma unroll
                  for (int r = 8; r < 16; ++r) { const int s = crow(r, hh) - 16; lds_st16(P + P_NCAT + c * 32 + s * 2, (s <= t) ? Z[r] : 0.f); }
              } }
            LDS_WAIT();
            const unsigned long long ts4 = S2_T();
            { f32x2 xy[16];
#pragma unroll
              for (int q = 0; q < 4; ++q) { const f32x4 nvv = *(const LAS f32x4*)(SC + S_NF + ((l & 15) * 16 + q * 4) * 4);
                  xy[q * 4 + 0] = (f32x2){at[q * 4 + 0], nvv[0]}; xy[q * 4 + 1] = (f32x2){at[q * 4 + 1], nvv[1]}; xy[q * 4 + 2] = (f32x2){at[q * 4 + 2], nvv[2]}; xy[q * 4 + 3] = (f32x2){at[q * 4 + 3], nvv[3]}; }
              f32x4 mrow[16][4];
#pragma unroll
              for (int t = 1; t < 16; ++t)
#pragma unroll
                  for (int s4 = 0; s4 < (t + 3) / 4; ++s4) mrow[t][s4] = *(const LAS f32x4*)(SC + S_MF + (t * 16 + s4 * 4) * 4);
#pragma unroll
              for (int t = 1; t < 16; ++t) { f32x2 a0 = xy[t], a1 = {0.f, 0.f};
#pragma unroll
                  for (int s = 0; s < t; ++s) { const float m = mrow[t][s >> 2][s & 3]; const f32x2 mm = {m, m}; if (s & 1) a1 += xy[s] * mm; else a0 += xy[s] * mm; }
                  xy[t] = a0 + a1; }
#pragma unroll
              for (int t = 0; t < 16; ++t) lds_st16(P + P_ACAT + t * ROWB + posk * 2, xy[t].x);
              if (l < 16) {
#pragma unroll
                  for (int t = 0; t < 16; ++t) lds_st16(P + P_NCAT + t * 32 + l * 2, xy[t].y); } }
            LDS_WAIT();
            if (l == 0) ready[slot] = ci + 1;
            if (SCAN_SEC >= 0) { const unsigned long long ts5 = S2_T(); sec_acc += SCAN_SEC == 0 ? ts1 - ts0 : SCAN_SEC == 1 ? ts2 - ts1 : SCAN_SEC == 2 ? ts3 - ts2 : SCAN_SEC == 3 ? ts4 - ts3 : SCAN_SEC == 4 ? ts5 - ts4 : SCAN_SEC == 6 ? tsA - ts0 : SCAN_SEC == 7 ? ts1 - tsA : ts5 - ts0; }
        }
        if (SCAN_SEC >= 0 && blockIdx.x == 0 && pw == SCAN_PW && SCAN_SEC != 9 && l == 0) { F.MISC[120] = (unsigned)sec_acc; F.MISC[121] = (unsigned)(sec_acc >> 32); }
    }
    __syncthreads();
}
}

__device__ __forceinline__ void p5_post(Frame& F) {
    const int gw = F.vcu * 8 + F.wave, NGW = F.G * 8, l = F.lane; unsigned char* ws = F.ws;
    const bf16* yf = (const bf16*)(ws + WS_YF); const bf16* yb = (const bf16*)(ws + WS_YB); const bf16* gg = (const bf16*)(ws + WS_G); bf16* o = (bf16*)(ws + WS_ORWKV);
    const float* lg = F.in[I_LNXG]; const float* lb = F.in[I_LNXB];
    for (int t = gw; t < MT; t += NGW) {
        const size_t base = (size_t)t * RW;
#pragma unroll 4
        for (int h = 0; h < RH; ++h) { const int c = h * 64 + l;
            const float y = bf2f(yf[base + c]) + bf2f(yb[base + c]);
            const float mu = wave_sum(y) * (1.f / 64.f); const float d = y - mu; const float var = wave_sum(d * d) * (1.f / 64.f);
            const float yn = d * (1.0f / sqrtf(var + LNX_EPS));
            o[base + c] = f2bf((yn * lg[c] + lb[c]) * bf2f(gg[base + c])); }
    }
}

__device__ __forceinline__ void p8_rowpass(Frame& F) {
    const int gw = F.vcu * 8 + F.wave, NGW = F.G * 8; float* rstd2 = (float*)(F.ws + WS_RSTD) + 3 * MT; bf16* hb = (bf16*)(F.ws + WS_H1B);
    for (int m = gw; m < MT; m += NGW) {
        const f32x4* xr = (const f32x4*)(F.out + (size_t)m * DM) + F.lane; f32x4 v[8]; float s = 0.f;
#pragma unroll
        for (int j = 0; j < 8; ++j) { v[j] = xr[64 * j]; s += (v[j].x * v[j].x + v[j].y * v[j].y) + (v[j].z * v[j].z + v[j].w * v[j].w); }
        s = wave_sum(s); if (F.lane == 0) rstd2[m] = 1.0f / sqrtf(s * (1.f / DM) + RMS_EPS);
        u32x2* o8 = (u32x2*)(hb + (size_t)m * DM) + F.lane;
#pragma unroll
        for (int j = 0; j < 8; ++j) { u32x2 w; w.x = cvt_pk_bf16(v[j].x, v[j].y); w.y = cvt_pk_bf16(v[j].z, v[j].w); o8[64 * j] = w; }
    }
}
__device__ __forceinline__ void p12_router(Frame& F) {
    const int gw = F.vcu * 8 + F.wave, NGW = F.G * 8, l = F.lane; unsigned char* ws = F.ws;
    float* rstd3 = (float*)(ws + WS_RSTD) + 4 * MT; bf16* n3 = (bf16*)(ws + WS_N3); const float* WR = (const float*)(ws + WS_WR);
    int* lists = (int*)(ws + WS_LIST); int* route = (int*)(ws + WS_ROUTE); float* slotw = (float*)(ws + WS_SLOTW);
    int* cnt = (int*)(F.ctl + CW_CNT);
    const float* brg = F.in[I_BRG]; const float* bre = F.in[I_BRE];
    LAS float* wl = (LAS float*)(F.lds + 16384);
    LAS float* lgt = (LAS float*)(F.lds + F.wave * 1024);
    for (int tb = F.vcu * 32; tb < MT; tb += F.G * 32) {
        const int t0 = tb + F.wave * 4;
        float ss[4] = {0.f, 0.f, 0.f, 0.f};
#pragma unroll
        for (int q = 0; q < 4; ++q) { const f32x4* xr = (const f32x4*)(F.out + (size_t)(t0 + q) * DM) + l; u32x2* o8 = (u32x2*)(n3 + (size_t)(t0 + q) * DM) + l;
#pragma unroll
            for (int j = 0; j < 8; ++j) { const f32x4 x = xr[64 * j]; ss[q] += (x.x * x.x + x.y * x.y) + (x.z * x.z + x.w * x.w);
                u32x2 w; w.x = cvt_pk_bf16(x.x, x.y); w.y = cvt_pk_bf16(x.z, x.w); o8[64 * j] = w; } }
#pragma unroll
        for (int q = 0; q < 4; ++q) ss[q] = wave_sum(ss[q]);
#pragma unroll 1
        for (int pass = 0; pass < 2; ++pass) {
            const float* x0p = F.out + (size_t)(t0 + 2 * pass) * DM + l; const float* x1p = x0p + DM;
            float acc[2][36];
#pragma unroll
            for (int q = 0; q < 2; ++q)
#pragma unroll
                for (int o = 0; o < 36; ++o) acc[q][o] = 0.f;
#pragma unroll 1
            for (int blk = 0; blk < 8; ++blk) {
                __syncthreads();
                { const f32x4* src4 = (const f32x4*)(WR + (size_t)blk * 256 * 36); LAS f32x4* dst4 = (LAS f32x4*)wl;
#pragma unroll
                  for (int i = 0; i < 5; ++i) { const int idx = F.tid + 512 * i; if (idx < 2304) dst4[idx] = src4[idx]; } }
                __syncthreads();
#pragma unroll
                for (int c4 = 0; c4 < 4; ++c4) { const int cl = l + 64 * c4; const float x0 = x0p[blk * 256 + 64 * c4], x1 = x1p[blk * 256 + 64 * c4];
                    const LAS f32x4* wr = (const LAS f32x4*)(wl + cl * 36);
#pragma unroll
                    for (int o4 = 0; o4 < 9; ++o4) { const f32x4 w = wr[o4];
#pragma unroll
                        for (int k = 0; k < 4; ++k) { acc[0][o4 * 4 + k] += x0 * w[k]; acc[1][o4 * 4 + k] += x1 * w[k]; } } }
            }
#pragma unroll
            for (int q = 0; q < 2; ++q)
#pragma unroll
                for (int o = 0; o < 36; ++o) { const float v = wave_sum(acc[q][o]); if (l == 0) lgt[(2 * pass + q) * 36 + o] = v; }
        }
        LDS_WAIT();
#pragma unroll
        for (int q = 0; q < 4; ++q) { const int t = t0 + q; const float rs = 1.0f / sqrtf(ss[q] * (1.f / DM) + RMS_EPS);
            float lg[4]; float gmax = -3.0e38f; int gsel = 0;
#pragma unroll
            for (int g = 0; g < 4; ++g) { lg[g] = lgt[q * 36 + g] * rs + brg[g]; if (lg[g] > gmax) { gmax = lg[g]; gsel = g; } }
            float gz = 0.f;
#pragma unroll
            for (int g = 0; g < 4; ++g) gz += __expf(lg[g] - gmax);
            const float pg = 1.0f / gz;
            float le[8];
#pragma unroll
            for (int e = 0; e < 8; ++e) { float a = lgt[q * 36 + 4 + e];
#pragma unroll
                for (int g = 1; g < 4; ++g) a = (gsel == g) ? lgt[q * 36 + 4 + g * 8 + e] : a;
                le[e] = a * rs + bre[gsel * 8 + e]; }
            float m1 = -3.0e38f, m2 = -3.0e38f; int e1 = 0, e2 = 0;
#pragma unroll
            for (int e = 0; e < 8; ++e) { if (le[e] > m1) { m2 = m1; e2 = e1; m1 = le[e]; e1 = e; } else if (le[e] > m2) { m2 = le[e]; e2 = e; } }
            const float xe = __expf(m2 - m1); const float w1 = pg / (1.0f + xe), w2 = pg * xe / (1.0f + xe);
            if (l == 0) { rstd3[t] = rs;
                const int E1 = gsel * 8 + e1, E2 = gsel * 8 + e2;
                const int p1 = atomicAdd(cnt + 64 * E1, 1), p2 = atomicAdd(cnt + 64 * E2, 1);
                lists[E1 * MT + p1] = t; lists[E2 * MT + p2] = t; slotw[E1 * MT + p1] = w1; slotw[E2 * MT + p2] = w2;
                route[t * 8 + 0] = E1; route[t * 8 + 1] = p1; route[t * 8 + 2] = E2; route[t * 8 + 3] = p2; }
        }
    }
}
struct MoeOrder {
    static constexpr bool GATHER = true;
    const volatile LAS int* tp; const int* cnt; const int* lists; const char* A; const char* B; int G, c, lognt; size_t bstride_e, bstride_t;
    bool gather;
    __device__ __forceinline__ bool next(int i, Unit& u) const {
        const int L = i * G + c; const int RT = tp[32]; if (L >= (RT << lognt)) return false;
        const int rt = L >> lognt, nt = L & ((1 << lognt) - 1); int e = 0;
        for (int q = 1; q < 32; ++q) e = (rt >= tp[q]) ? q : e;
        u.pm = rt; u.pn = nt; u.aux0 = e; u.aux1 = (rt - tp[e]) * 256;
        u.Ab = A; u.Bb = B + (size_t)e * bstride_e + (size_t)nt * bstride_t; return true;
    }
    __device__ __forceinline__ unsigned arow(const Unit& u, int r) const {
        if (!gather) return (unsigned)(u.pm * 256 + r);
        const int idx = u.aux1 + r; const int n = cnt[64 * u.aux0]; return idx < n ? (unsigned)lists[u.aux0 * MT + idx] : 0u;
    }
};
struct EpiMoe1 {
    static constexpr bool PERM = true;
    bf16* hid; const int* cnt; const int* lists; const float* slotw; const float* rstd;
    __device__ __forceinline__ void operator()(const PG8_ACC, const Unit& u, int wr, int wc, int fr, int fq) const {
        const int n = cnt[64 * u.aux0];
#pragma unroll
        for (int ai = 0; ai < 2; ++ai)
#pragma unroll
            for (int m = 0; m < 4; ++m) { const int r = ai * 128 + wr * 64 + m * 16 + fr; const int idx = u.aux1 + r; const bool ok = idx < n;
                const int tok = ok ? lists[u.aux0 * MT + idx] : 0; const float rs = rstd[tok]; const float wt = ok ? slotw[u.aux0 * MT + idx] : 0.f;
                f32x4 o0, o1;
#pragma unroll
                for (int j = 0; j < 4; ++j) { const float g0 = acc[ai][0][m][0][j] * rs, u0 = acc[ai][1][m][0][j] * rs, g1 = acc[ai][0][m][1][j] * rs, u1 = acc[ai][1][m][1][j] * rs;
                    o0[j] = g0 * sigmoidf_(g0) * u0 * wt; o1[j] = g1 * sigmoidf_(g1) * u1 * wt; }
                *(u32x4*)(hid + (size_t)(u.pm * 256 + r) * DE + u.pn * 128 + wc * 32 + 8 * fq) = pg8::pack8(o0, o1); }
    }
};
struct EpiMoe2 {
    static constexpr bool PERM = true;
    bf16* y;
    __device__ __forceinline__ void operator()(const PG8_ACC, const Unit& u, int wr, int wc, int fr, int fq) const {
        EPI_FOR(ai, m, bj) { const int row = u.pm * 256 + ai * 128 + wr * 64 + m * 16 + fr; const int col = u.pn * 256 + bj * 128 + wc * 32 + 8 * fq;
            *(u32x4*)(y + (size_t)row * DM + col) = pg8::pack8(acc[ai][bj][m][0], acc[ai][bj][m][1]); }
    }
};
__device__ __forceinline__ void moe_table(Frame& F) {
    if (F.tid == 0) { const int* cnt = (const int*)(F.ctl + CW_CNT); int acc = 0;
        for (int e = 0; e < 32; ++e) { F.MISC[16 + e] = (unsigned)acc; acc += (__hip_atomic_load(cnt + 64 * e, __ATOMIC_RELAXED, __HIP_MEMORY_SCOPE_AGENT) + 255) >> 8; }
        F.MISC[16 + 32] = (unsigned)acc; }
    __syncthreads();
}
__device__ __forceinline__ void p5_expert_cvt(Frame& F) {
    LAS float* scr = (LAS float*)(F.lds + F.wave * CVT_SCR); const int gw = F.vcu * 8 + F.wave, NGW = F.G * 8; unsigned char* ws = F.ws;
#define EX_DESC(it_, d) do { const int e = (it_) / 768, r = (it_) % 768; \
        if (r < 256) { d.W = F.in[I_WEG] + (size_t)e * DM * DE; d.gain = F.in[I_GFFN]; d.WT = (bf16*)(ws + WS_WGU) + (size_t)e * 1024 * DM; d.K = DM; d.N = DE; d.ldt = DM; d.mode = 3; d.kofs = 0; d.item = r; } \
        else if (r < 512) { d.W = F.in[I_WEU] + (size_t)e * DM * DE; d.gain = F.in[I_GFFN]; d.WT = (bf16*)(ws + WS_WGU) + (size_t)e * 1024 * DM; d.K = DM; d.N = DE; d.ldt = DM; d.mode = 4; d.kofs = 0; d.item = r - 256; } \
        else { d.W = F.in[I_WED] + (size_t)e * DE * DM; d.gain = nullptr; d.WT = (bf16*)(ws + WS_WD) + (size_t)e * DM * DE; d.K = DE; d.N = DM; d.ldt = DE; d.mode = 0; d.kofs = 0; d.item = r - 512; } } while (0)
    CVT_PIPE(NE * 768, EX_DESC);
#undef EX_DESC
}

struct Args { const float* in[41]; float* out; unsigned char* ws; int ph_lo, ph_hi; };
constexpr int NPHASE = 16;
__global__ void __launch_bounds__(512, 2) fwd_kernel(Args args) {
    extern __shared__ __attribute__((aligned(16))) unsigned char lds_raw[];
    Frame F;
    F.lds = (LAS unsigned char*)lds_raw; F.MISC = (volatile LAS unsigned*)(F.lds + MISC_OFF);
    F.tid = threadIdx.x; F.lane = F.tid & 63; F.wave = __builtin_amdgcn_readfirstlane(F.tid >> 6);
    F.G = gridDim.x; { const int bx = blockIdx.x; F.vcu = (F.G % 8 == 0) ? (bx % 8) * (F.G / 8) + bx / 8 : bx; }
    F.ws = args.ws; F.out = args.out; F.ctl = (unsigned*)(args.ws + WS_CTL);
#pragma unroll
    for (int i = 0; i < 41; ++i) F.in[i] = args.in[i];
    for (int u = F.tid; u < (LDS_BYTES - LDSCTL_OFF) / 4; u += 512) ((LAS unsigned*)(F.lds + LDSCTL_OFF))[u] = 0u;
    __syncthreads();
    XcdBarrier bar; bar.bar = F.ctl + CW_BAR; bar.x = 0; bar.st = nullptr;
    const int lo = args.ph_lo, hi = args.ph_hi;
    if (hi - lo > 1) bar = xcd_barrier_post(F.ctl + CW_BAR, F.MISC + 8);
#ifndef ATT_DQK_TEST
#define ATT_DQK_TEST QKD
#endif
#define PROBE_N (MT * 768)
#ifndef LSEL
#define LSEL 31
#endif
#ifndef PH_MASK
#define PH_MASK 0xFFFFu
#endif
#ifndef SCAN_MFMA
#define SCAN_MFMA 1
#endif
#ifndef SCAN_DUMMY
#define SCAN_DUMMY 0
#endif
#ifndef REPEAT_MASK
#define REPEAT_MASK 0x0u
#endif
#define REP(k) _Pragma("unroll") for (int _rep = 0; _rep <= (int)(((REPEAT_MASK) >> (k)) & 1u); ++_rep)
#define IN(k) ((((PH_MASK) >> (k)) & 1u) && lo <= (k) && (k) < hi)
#ifndef PROBE_TIME
#define PROBE_TIME -1
#endif
#define SEAM(k) do { if (lo <= (k) && (k) + 1 < hi) xcd_barrier(bar); if (PROBE_TIME >= 0 && blockIdx.x == 0 && F.tid == 0) { const unsigned long long _t = wall_clock64(); F.MISC[64 + 2 * ((k) + 1)] = (unsigned)_t; F.MISC[65 + 2 * ((k) + 1)] = (unsigned)(_t >> 32); } } while (0)
    unsigned char* ws = args.ws;

    bf16* const zmla = (bf16*)(ws + WS_ZMLA); bf16* const loraA = (bf16*)(ws + WS_LORAA);
    float* const rstd1 = (float*)(ws + WS_RSTD); float* const rstd_q = rstd1 + MT; float* const rstd_kv = rstd1 + 2 * MT;
    const int bid = (int)blockIdx.x;
    if (PROBE_TIME >= 0 && blockIdx.x == 0 && F.tid == 0) { const unsigned long long _t = wall_clock64(); F.MISC[64] = (unsigned)_t; F.MISC[65] = (unsigned)(_t >> 32); }
    if (IN(0)) { REP(0) { p0_prologue(F); xcd_barrier(bar); p0b_win_i8(F); } }
    SEAM(0);
    if (IN(1)) {
        if (EN_RWKV || EN_MLA) REP(1) { pg8::StaticOrder S; S.init((const bf16*)(ws + WS_XB), DM / 2, (const bf16*)(ws + WS_WIN), DM / 2, MT, G1_N, F.G, bid);
          EpiG1 E{rstd1, zmla, (bf16*)(ws + WS_ZRKV), (bf16*)(ws + WS_ZLORA), (bf16*)(ws + WS_ZGATE), (const float*)(F.ctl + CW_COLMAX)};
          pg8::gemm_phase<EpiG1, pg8::StaticOrder, true>(F.lds, DM / 2, DM / 2, DM / 2, S, E); }
        else p_copy_x(F);
    }
    SEAM(1);
    if (IN(2)) { if (EN_RWKV || EN_MLA) REP(2) p2_rowpass(F); }
    SEAM(2);
    if (IN(3)) REP(3) {
        if (EN_MLA) {
            { pg8::StaticOrder S; S.init(zmla, ZM_LD, (const bf16*)(ws + WS_WUQ), QLORA, MT, MH * QKD, F.G, bid);
              EpiQ E{ws + WS_Q, rstd_q, (const float*)(ws + WS_ROPE)};
              pg8::gemm_phase(F.lds, QLORA, ZM_LD, QLORA, S, E); }
            { pg8::StaticOrder S; S.init(zmla + QLORA, ZM_LD, (const bf16*)(ws + WS_WUKV), KVLORA, MT, MH * 256, F.G, bid);
              EpiKV E{ws + WS_K, (bf16*)(ws + WS_V), rstd_kv};
              pg8::gemm_phase(F.lds, KVLORA, ZM_LD, KVLORA, S, E); }
        }
        if (EN_RWKV) {
            { pg8::StaticOrder S; S.init(loraA, LA_LD, (const bf16*)(ws + WS_W2F), 256, MT, 2 * RW, F.G, bid);
              EpiLora2<0> E{(bf16*)(ws + WS_WLF), (bf16*)(ws + WS_WLB), F.in[I_W0F], F.in[I_W0B]}; pg8::gemm_phase(F.lds, 256, LA_LD, 256, S, E); }
            { pg8::StaticOrder S; S.init(loraA + 256, LA_LD, (const bf16*)(ws + WS_W2F + 2 * MiB), 256, MT, 2 * RW, F.G, bid);
              EpiLora2<1> E{(bf16*)(ws + WS_ICF), (bf16*)(ws + WS_ICB), F.in[I_A0F], F.in[I_A0B]}; pg8::gemm_phase(F.lds, 256, LA_LD, 256, S, E); }
            if (LSEL & 16) { pg8::StaticOrder S; S.init(loraA + 512, LA_LD, (const bf16*)(ws + WS_G2), GLORA, MT, RW, F.G, bid);
              EpiLora<2> E{(bf16*)(ws + WS_G), nullptr}; pg8::gemm_phase(F.lds, GLORA, LA_LD, GLORA, S, E); }
        }
    }
    SEAM(3);
    if (IN(4)) {
        constexpr int NSCAN = NB * RH * 2, NATT = NB * MH * (SEQ / 256);
        int s_begin = F.vcu, s_end = NSCAN, s_step = F.G, a_begin = F.vcu, a_step = F.G, a_cnt = (F.vcu < NATT) ? (NATT - 1 - F.vcu) / F.G + 1 : 0;
        if (EN_RWKV && EN_MLA && F.G == 256) { s_step = 1; a_step = 1;
            if (F.vcu < 128) { s_end = F.vcu + 1; a_begin = 384 + F.vcu; a_cnt = 1; } else { s_end = 0; a_begin = (F.vcu - 128) * 3; a_cnt = 3; } }
        if (EN_RWKV) for (int u = s_begin; u < s_end; u += s_step) { const int dir = u & 1, bh = u >> 1;
            if (dir) scan2::scan_unit<1>(F, bh >> 5, bh & 31); else scan2::scan_unit<0>(F, bh >> 5, bh & 31); }
        if (EN_MLA) for (int i = 0; i < a_cnt; ++i) { const int L = a_begin + i * a_step; const int qb = L & 15, bh = L >> 4, b = bh >> 4, h = bh & 15;
            att::attn_unit_f8<MH * QKD, MH * QKD, MH * VDIM, DM>(ws + WS_Q + ((size_t)(b * SEQ + qb * 256) * (MH * QKD) + h * QKD),
                                ws + WS_K + ((size_t)b * SEQ * (MH * QKD) + h * QKD),
                                (const bf16*)(ws + WS_V) + ((size_t)b * SEQ * (MH * VDIM) + h * VDIM),
                                (bf16*)(ws + WS_OMLA) + ((size_t)(b * SEQ + qb * 256) * DM + h * VDIM), SEQ, QSCALE, (LAS char*)F.lds); }
    }
    SEAM(4);
    if (IN(5)) { if (EN_RWKV) REP(5) p5_post(F); if (EN_MOE) REP(17) p5_expert_cvt(F); }
    SEAM(5);
    if (IN(6)) REP(6) {
        if (EN_MLA) { pg8::StaticOrder S; S.init((const bf16*)(ws + WS_OMLA), DM, (const bf16*)(ws + WS_WUPM), DM, MT, DM, F.G, bid);
            EpiUp<0> E{(bf16*)(ws + WS_MERGED), (const bf16*)(ws + WS_ZGATE), 0}; pg8::gemm_phase(F.lds, DM, DM, DM, S, E); }
        if (EN_RWKV) { pg8::StaticOrder S; S.init((const bf16*)(ws + WS_ORWKV), DM, (const bf16*)(ws + WS_WUPR), DM, MT, DM, F.G, bid);
            EpiUp<EN_MLA> E{(bf16*)(ws + WS_MERGED), (const bf16*)(ws + WS_ZGATE), DM}; pg8::gemm_phase(F.lds, DM, DM, DM, S, E); }
    }
    SEAM(6);
    if (IN(7)) REP(7) {
        if (EN_RWKV || EN_MLA) { pg8::StaticOrder S; S.init((const bf16*)(ws + WS_MERGED), DM, (const bf16*)(ws + WS_WOUT), DM, MT, DM, F.G, bid);
            EpiResid E{F.in[I_X], F.out}; pg8::gemm_phase(F.lds, DM, DM, DM, S, E); }
    }
    SEAM(7);
    if (IN(8)) { if (EN_CROSS || EN_MOE) p8_rowpass(F); }
    SEAM(8);
    if (IN(9)) REP(9) {
        if (EN_CROSS) { pg8::StaticOrder S; S.init((const bf16*)(ws + WS_H1B), DM, (const bf16*)(ws + WS_WQC), DM, MT, CW, F.G, bid);
            EpiPlain E{(bf16*)(ws + WS_QC), CW, rstd1 + 3 * MT, CSCALE}; pg8::gemm_phase(F.lds, DM, DM, DM, S, E); }
        if (EN_CROSS && bid >= 64) { pg8::StaticOrder S; S.init((const bf16*)(ws + WS_MEMN), DM, (const bf16*)(ws + WS_WKVC), DM, NB * MEMLEN, 2 * CW, F.G, bid - 64);
            EpiPlain E{(bf16*)(ws + WS_KVC), 2 * CW, nullptr, 1.f}; pg8::gemm_phase(F.lds, DM, DM, DM, S, E); }
    }
    SEAM(9);
    if (IN(10)) REP(10) {
        if (EN_CROSS) {
            for (int i = 0; ; ++i) { const int L = i * F.G + F.vcu; if (L >= NB * CH * (SEQ / 256)) break;
                const int qb = L & 15, bh = L >> 4, b = bh >> 2, h = bh & 3;
                att::attn_unit<CHD, CW, 2 * CW, 2 * CW, CW>((const bf16*)(ws + WS_QC) + ((size_t)(b * SEQ + qb * 256) * CW + h * CHD),
                                    (const bf16*)(ws + WS_KVC) + ((size_t)b * MEMLEN * (2 * CW) + h * CHD),
                                    (const bf16*)(ws + WS_KVC) + ((size_t)b * MEMLEN * (2 * CW) + CW + h * CHD),
                                    (bf16*)(ws + WS_OC) + ((size_t)(b * SEQ + qb * 256) * CW + h * CHD), MEMLEN, (LAS char*)F.lds); }
        }
    }
    SEAM(10);
    if (IN(11)) {
        if (EN_CROSS) { pg8::StaticOrder S; S.init((const bf16*)(ws + WS_OC), CW, (const bf16*)(ws + WS_WOC), CW, MT, DM, F.G, bid);
            EpiResid E{F.out, F.out}; pg8::gemm_phase(F.lds, CW, CW, CW, S, E); }
    }
    SEAM(11);
    if (IN(12)) { if (EN_MOE) p12_router(F); }
    SEAM(12);
    if (IN(13)) REP(13) {
        if (EN_MOE) { moe_table(F);
            MoeOrder S{(const volatile LAS int*)(F.MISC + 16), (const int*)(F.ctl + CW_CNT), (const int*)(ws + WS_LIST), (const char*)(ws + WS_N3), (const char*)(ws + WS_WGU), F.G, F.vcu, 2,
                       (size_t)1024 * DM * 2, (size_t)256 * DM * 2, true};
            EpiMoe1 E{(bf16*)(ws + WS_HID), (const int*)(F.ctl + CW_CNT), (const int*)(ws + WS_LIST), (const float*)(ws + WS_SLOTW), rstd1 + 4 * MT};
            pg8::gemm_phase(F.lds, DM, DM, DM, S, E); }
    }
    SEAM(13);
    if (IN(14)) REP(14) {
        if (EN_MOE) { moe_table(F);
            MoeOrder S{(const volatile LAS int*)(F.MISC + 16), (const int*)(F.ctl + CW_CNT), (const int*)(ws + WS_LIST), (const char*)(ws + WS_HID), (const char*)(ws + WS_WD), F.G, F.vcu, 3,
                       (size_t)DM * DE * 2, (size_t)256 * DE * 2, false};
            EpiMoe2 E{(bf16*)(ws + WS_YBUF)};
            pg8::gemm_phase(F.lds, DE, DE, DE, S, E); }
    }
    SEAM(14);
#ifdef PROBE_OFF
    if (IN(15)) { const int gt = F.vcu * 512 + F.tid, NGT = F.G * 512; const bf16* sb = (const bf16*)(ws + (size_t)PROBE_OFF * MiB);
        for (int i = gt; i < MT * DM; i += NGT) F.out[i] = (i < PROBE_N) ? bf2f(sb[i]) : 0.f; }
#else
    if (IN(15)) { { int t_ = threadIdx.x; asm volatile("" : "+v"(t_)); F.tid = t_; F.lane = t_ & 63; }
        p_final(F, EN_MOE != 0); }
#endif
    if (SCAN_SEC == 20) { if (blockIdx.x == 0 && F.wave == 0) { const float e = att::f8_map_probe(F.lane); if (F.lane == 0) F.out[(size_t)(F.vcu * 8) * DM] += 10.f + e; } }
    if (SCAN_SEC >= 0 && SCAN_SEC < 20) { __syncthreads(); if (blockIdx.x == 0 && F.tid == 0) { const unsigned long long c = ((unsigned long long)F.MISC[121] << 32) | F.MISC[120]; F.out[(size_t)(F.vcu * 8) * DM] += (float)c * 1e-4f; } }
    if (PROBE_TIME >= 0) { __syncthreads(); if (blockIdx.x == 0 && F.tid == 0) {
        const unsigned long long a = ((unsigned long long)F.MISC[65 + 2 * PROBE_TIME] << 32) | F.MISC[64 + 2 * PROBE_TIME], b = ((unsigned long long)F.MISC[65 + 2 * (PROBE_TIME + 1)] << 32) | F.MISC[64 + 2 * (PROBE_TIME + 1)];
        F.out[(size_t)(F.vcu * 8) * DM] += (float)(b - a) * 0.001f; } }
#undef IN
#undef SEAM
}

extern "C" void kernel_launch(void* const* d_in, const int* in_sizes, int n_in, void* d_out, int out_size, void* d_ws, size_t ws_size, hipStream_t stream) {
    static int grid = 0;
    if (grid == 0) {
        if (n_in != 41 || out_size != MT * DM || ws_size < WS_END) { fprintf(stderr, "kernel_launch: unexpected shapes n_in %d out %d ws %zu (need %zu)\n", n_in, out_size, ws_size, (size_t)WS_END); grid = -1; return; }
        int dev = 0, cus = 0, per_cu = 0;
        if (hipGetDevice(&dev) != hipSuccess || hipDeviceGetAttribute(&cus, hipDeviceAttributeMultiprocessorCount, dev) != hipSuccess) { grid = -1; return; }
        if (hipFuncSetAttribute((const void*)fwd_kernel, hipFuncAttributeMaxDynamicSharedMemorySize, LDS_BYTES) != hipSuccess) { fprintf(stderr, "kernel_launch: hipFuncSetAttribute failed\n"); grid = -1; return; }
        if (hipOccupancyMaxActiveBlocksPerMultiprocessor(&per_cu, (const void*)fwd_kernel, 512, LDS_BYTES) != hipSuccess || per_cu < 1) { fprintf(stderr, "kernel_launch: occupancy query says %d\n", per_cu); }
        (void)hipGetLastError();
        grid = cus;
    }
    if (grid < 0) return;
    (void)hipMemsetAsync((char*)d_ws + WS_CTL, 0, CTL_BYTES, stream);
    Args a{};
    for (int i = 0; i < 41; ++i) a.in[i] = (const float*)d_in[i];
    a.out = (float*)d_out; a.ws = (unsigned char*)d_ws;
#if N_LAUNCH_SPLIT
    for (int p = 0; p < NPHASE; ++p) { a.ph_lo = p; a.ph_hi = p + 1; hipLaunchKernelGGL(fwd_kernel, dim3(grid), dim3(512), LDS_BYTES, stream, a); }
#else
    a.ph_lo = 0; a.ph_hi = NPHASE;
    hipLaunchKernelGGL(fwd_kernel, dim3(grid), dim3(512), LDS_BYTES, stream, a);
#endif
}
```

```cpp
#include <hip/hip_runtime.h>
#include <cstdio>
#include <cstdint>

#ifndef SCAN_PW
#define SCAN_PW 0
#endif
#ifndef SCAN_SEC
#define SCAN_SEC -1
#endif
#ifndef EN_RWKV
#define EN_RWKV 1
#endif
#ifndef EN_MLA
#define EN_MLA 1
#endif
#ifndef EN_CROSS
#define EN_CROSS 1
#endif
#ifndef EN_MOE
#define EN_MOE 1
#endif
#ifndef N_LAUNCH_SPLIT
#define N_LAUNCH_SPLIT 0
#endif

#define GAS __attribute__((address_space(1)))
#define LAS __attribute__((address_space(3)))
typedef unsigned short bf16;
typedef short bf16x8 __attribute__((ext_vector_type(8)));
typedef short s16x4 __attribute__((ext_vector_type(4)));
typedef float f32x4 __attribute__((ext_vector_type(4)));
typedef float f32x2 __attribute__((ext_vector_type(2)));
typedef float f32x16 __attribute__((ext_vector_type(16)));
typedef unsigned u32x4 __attribute__((ext_vector_type(4)));
typedef unsigned u32x2 __attribute__((ext_vector_type(2)));

constexpr int DM = 2048, NB = 2, SEQ = 4096, MT = NB * SEQ;
constexpr int MEMLEN = 256;
constexpr int QLORA = 512, KVLORA = 256, ROPE = 64, NOPE = 128, VDIM = 128, QKD = 192, MH = 16;
constexpr int RW = 2048, RH = 32, RHD = 64, DLORA = 96, GLORA = 256;
constexpr int MLA_IN = 832, RWKV_IN = 6784, GATE_IN = 4096, IN_W = MLA_IN + RWKV_IN + GATE_IN;
constexpr int CH = 4, CHD = 128, CW = 512;
constexpr int NG = 4, EPG = 8, NE = 32, DE = 512;
constexpr float RMS_EPS = 1e-6f, LNX_EPS = 64e-5f;
constexpr int G1_N = 12032;
constexpr int ZM_LD = 1024, ZR_LD = 6144, ZL_LD = 768, ZG_LD = 4096, LA_LD = 768;
constexpr int MOE_SLOTS = 2 * MT + NE * 256;

constexpr size_t MiB = 1u << 20;
constexpr size_t WS_CTL = 0, CTL_BYTES = 1 * MiB;
constexpr size_t WS_WUQ = 1 * MiB;
constexpr size_t WS_WUKV = 4 * MiB;
constexpr size_t WS_W2F = 6 * MiB;
constexpr size_t WS_G2 = 10 * MiB;
constexpr size_t WS_WUPM = 11 * MiB, WS_WUPR = 19 * MiB, WS_WOUT = 27 * MiB;
constexpr size_t WS_WQC = 35 * MiB;
constexpr size_t WS_WKVC = 37 * MiB;
constexpr size_t WS_WOC = 41 * MiB;
constexpr size_t WS_WIN = 43 * MiB;
constexpr size_t WS_MISC = 90 * MiB;
constexpr size_t WS_ROPE = WS_MISC;
constexpr size_t WS_MEMN = WS_MISC + 2 * MiB;
constexpr size_t WS_KVC = WS_MISC + 4 * MiB;
constexpr size_t WS_RSTD = WS_MISC + 5 * MiB;
constexpr size_t WS_WR = WS_RSTD + 256 * 1024;
constexpr size_t WS_LIST = WS_MISC + 6 * MiB;
constexpr size_t WS_ROUTE = WS_MISC + 7 * MiB;
constexpr size_t WS_SLOTW = WS_MISC + 8 * MiB;
constexpr size_t WS_XB = 100 * MiB;
constexpr size_t WS_ZMLA = 132 * MiB;
constexpr size_t WS_ZLORA = 148 * MiB;
constexpr size_t WS_LORAA = 160 * MiB;
constexpr size_t WS_ZRKV = 172 * MiB;
constexpr size_t WS_ZGATE = 268 * MiB;
constexpr size_t WS_Q = 332 * MiB;
constexpr size_t WS_K = 380 * MiB;
constexpr size_t WS_V = 428 * MiB;
constexpr size_t WS_WLF = 460 * MiB, WS_WLB = 492 * MiB, WS_ICF = 524 * MiB, WS_ICB = 556 * MiB;
constexpr size_t WS_G = 588 * MiB;
constexpr size_t WS_END = 620 * MiB;
constexpr size_t WS_YF = WS_WIN, WS_YB = WS_ZMLA, WS_ORWKV = WS_Q, WS_MERGED = WS_K, WS_QC = WS_V, WS_OC = WS_V + 8 * MiB;
constexpr size_t WS_WGU = WS_WLF, WS_WD = WS_ZRKV, WS_HID = WS_ZGATE, WS_YBUF = WS_Q;
constexpr size_t WS_OMLA = WS_XB, WS_H1B = WS_XB, WS_N3 = WS_XB;

constexpr int CW_BAR = 4096;
constexpr int CW_CM_QC = 45056, CW_CM_KVC = 45568, CW_MEMSCALE = 47104;
constexpr int CW_COLMAX = 32768;
constexpr int CW_CNT = 16384;

constexpr int RING_BYTES = 159744;
constexpr int LDSCTL_OFF = RING_BYTES, MISC_OFF = LDSCTL_OFF + 320;
constexpr int LDS_BYTES = 161792;

#define LDS_WAIT() asm volatile("s_waitcnt lgkmcnt(0)" ::: "memory")
#define VM_WAIT() asm volatile("s_waitcnt vmcnt(0)" ::: "memory")
typedef __bf16 bf16x2_t __attribute__((ext_vector_type(2)));
__device__ __forceinline__ unsigned cvt_pk_bf16(float lo, float hi) { f32x2 v = {lo, hi}; bf16x2_t b = __builtin_convertvector(v, bf16x2_t); return __builtin_bit_cast(unsigned, b); }
__device__ __forceinline__ float bf2f(unsigned short b) { return __builtin_bit_cast(float, ((unsigned)b) << 16); }
__device__ __forceinline__ float bflo(unsigned w) { return __builtin_bit_cast(float, w << 16); }
__device__ __forceinline__ float bfhi(unsigned w) { return __builtin_bit_cast(float, w & 0xffff0000u); }
__device__ __forceinline__ unsigned short f2bf(float f) { return (unsigned short)(cvt_pk_bf16(f, 0.f) & 0xffffu); }
__device__ __forceinline__ float sigmoidf_(float x) { return __builtin_amdgcn_rcpf(1.0f + __builtin_amdgcn_exp2f(-1.4426950408889634f * x)); }
template <int CTRL> __device__ __forceinline__ float dpp_add_(float v) {
    return v + __builtin_bit_cast(float, __builtin_amdgcn_update_dpp(0, __builtin_bit_cast(int, v), CTRL, 0xF, 0xF, false));
}
__device__ __forceinline__ float wave_sum(float v) {
    v = dpp_add_<0xB1>(v); v = dpp_add_<0x4E>(v); v = dpp_add_<0x141>(v); v = dpp_add_<0x140>(v);
    const int iv = __builtin_bit_cast(int, v);
    const float s0 = __builtin_bit_cast(float, __builtin_amdgcn_readlane(iv, 0)), s1 = __builtin_bit_cast(float, __builtin_amdgcn_readlane(iv, 16));
    const float s2 = __builtin_bit_cast(float, __builtin_amdgcn_readlane(iv, 32)), s3 = __builtin_bit_cast(float, __builtin_amdgcn_readlane(iv, 48));
    return (s0 + s1) + (s2 + s3);
}

#define XB_TMO      128
#define XB_XCNT(j)  (256  + 64 * (j))
#define XB_XSUB(j)  (1280 + 64 * (j))
#define XB_XGEN(j)  (2304 + 64 * (j))
#define XB_TOP      3328
#define XB_TOPGEN   3392
#define XCD_BAR_WORDS 3456
#define XB_SPIN_CAP (1u << 18)
__device__ __forceinline__ unsigned xb_ld(unsigned* p)              { return __hip_atomic_load(p, __ATOMIC_RELAXED, __HIP_MEMORY_SCOPE_AGENT); }
__device__ __forceinline__ unsigned xb_add(unsigned* p, unsigned v) { return __hip_atomic_fetch_add(p, v, __ATOMIC_RELAXED, __HIP_MEMORY_SCOPE_AGENT); }
__device__ __forceinline__ unsigned xb_xcc_id() { return (unsigned)__builtin_amdgcn_s_getreg((3 << 11) | 20) & 0xFu; }
#define XB_SPIN(cond, bar) do { unsigned _sp = 0; while (cond) { __builtin_amdgcn_s_sleep(1); \
    if ((++_sp & 255u) == 0u) { if (xb_ld(&(bar)[XB_TMO])) break; if (_sp > XB_SPIN_CAP) { atomicAdd(&(bar)[XB_TMO], 1u); break; } } } } while (0)
struct XcdBarrier { unsigned* bar; unsigned x; volatile LAS unsigned* st; };
__device__ __forceinline__ XcdBarrier xcd_barrier_post(unsigned* bar, volatile LAS unsigned* st) {
    XcdBarrier b; b.bar = bar; b.x = xb_xcc_id(); b.st = st;
    if (threadIdx.x == 0) (void)xb_add(&bar[XB_XCNT(b.x)], 1u);
    return b;
}
__device__ __forceinline__ void xcd_barrier_complete(unsigned* bar, unsigned x, unsigned& nloc, unsigned& nx) {
    const unsigned G = gridDim.x * gridDim.y * gridDim.z;
    unsigned sum, cnt, mine, sp = 0u;
    for (;;) {
        sum = 0u; cnt = 0u; mine = 0u;
#pragma unroll
        for (unsigned j = 0; j < 16; ++j) { const unsigned c = xb_ld(&bar[XB_XCNT(j)]); sum += c; cnt += (c > 0u) ? 1u : 0u; mine = (j == x) ? c : mine; }
        if (sum == G) break;
        __builtin_amdgcn_s_sleep(1);
        if ((++sp & 255u) == 0u) { if (xb_ld(&bar[XB_TMO])) break; if (sp > XB_SPIN_CAP) { atomicAdd(&bar[XB_TMO], 1u); break; } }
    }
    nloc = mine > 0u ? mine : 1u; nx = cnt > 0u ? cnt : 1u;
}
__device__ __forceinline__ void xcd_barrier(const XcdBarrier& b) {
    asm volatile("s_waitcnt vmcnt(0)" ::: "memory");
    __syncthreads();
    if (threadIdx.x == 0) {
        unsigned* bar = b.bar;
        __builtin_amdgcn_s_waitcnt(0);
        unsigned nloc = b.st[0], nx = b.st[1];
        if (nloc == 0u) { xcd_barrier_complete(bar, b.x, nloc, nx); b.st[0] = nloc; b.st[1] = nx; }
        const unsigned old = xb_add(&bar[XB_XSUB(b.x)], 1u);
        const unsigned gen = old / nloc;
        if (old + 1u == (gen + 1u) * nloc) {
            __builtin_amdgcn_fence(__ATOMIC_RELEASE, "agent");
            asm volatile("s_waitcnt vmcnt(0)" ::: "memory");
            const unsigned og = xb_add(&bar[XB_TOP], 1u);
            const unsigned tg = og / nx;
            if (og + 1u == (tg + 1u) * nx) xb_add(&bar[XB_TOPGEN], 1u);
            else XB_SPIN(xb_ld(&bar[XB_TOPGEN]) == tg, bar);
            __builtin_amdgcn_fence(__ATOMIC_ACQUIRE, "agent");
            xb_add(&bar[XB_XGEN(b.x)], 1u);
            asm volatile("s_waitcnt vmcnt(0)" ::: "memory");
        } else {
            XB_SPIN(xb_ld(&bar[XB_XGEN(b.x)]) == gen, bar);
            __builtin_amdgcn_fence(__ATOMIC_ACQUIRE, "agent");
            asm volatile("s_waitcnt vmcnt(0)" ::: "memory");
        }
    }
    __syncthreads();
}

namespace pg8 {
constexpr int BM = 256, BK = 64, HALF = 128, HTB = HALF * BK * 2, STAGE_BYTES = 8 * HTB, NXCD = 8, WGM = 8;
__host__ __device__ __forceinline__ int lds_byte(int r, int c) { const int st = (r >> 4) * 2 + (c >> 5), rr = r & 15, cc = c & 31, ob = rr * 64 + cc * 2; return st * 1024 + (ob ^ (((ob >> 9) & 1) << 5)); }
__host__ __device__ __forceinline__ void stage_rc(int b, int& R, int& C) { const int st = b / 1024, sb = b % 1024, swz = sb ^ (((sb >> 9) & 1) << 5); R = (st >> 1) * 16 + swz / 64; C = (st & 1) * 32 + (swz % 64) / 2; }
__host__ __device__ __forceinline__ int perm32(int rho) { const int n = rho >> 4, i = rho & 15; return 8 * (i >> 2) + 4 * n + (i & 3); }

struct Unit { int pm, pn; const char* Ab; const char* Bb; int aux0, aux1; };

struct StaticOrder {
    static constexpr bool GATHER = false;
    int nM, nN, nwg, G, c; const char* A; const char* Bt; int lda, ldb;
    __device__ void init(const bf16* A_, int lda_, const bf16* Bt_, int ldb_, int M, int N, int G_, int c_) { A = (const char*)A_; Bt = (const char*)Bt_; lda = lda_; ldb = ldb_; nM = M / BM; nN = N / BM; nwg = nM * nN; G = G_; c = c_; }
    __device__ __forceinline__ bool next(int i, Unit& u) const {
        const long L = (long)i * G + c; if (L >= nwg) return false;
        int wgid = (int)L; { const int q = nwg / NXCD, r = nwg % NXCD, xcd = wgid % NXCD, off = wgid / NXCD; wgid = (xcd < r ? xcd * (q + 1) : r * (q + 1) + (xcd - r) * q) + off; }
        const int nig = WGM * nN, gid = wgid / nig, fm = gid * WGM, gsz = (nM - fm) < WGM ? (nM - fm) : WGM;
        u.pm = fm + ((wgid % nig) % gsz); u.pn = (wgid % nig) / gsz; u.Ab = A + (size_t)u.pm * BM * lda * 2; u.Bb = Bt + (size_t)u.pn * BM * ldb * 2; u.aux0 = 0; u.aux1 = 0; return true;
    }
    __device__ __forceinline__ unsigned arow(const Unit& u, int r) const { return (unsigned)r; }
};

#define PG8_ACC f32x4 (&acc)[2][2][4][2]
typedef int i32x4g __attribute__((ext_vector_type(4)));
template <class Epi, class Sched, bool I8 = false>
__device__ __forceinline__ void gemm_phase(LAS unsigned char* lds, const int K, const int lda, const int ldb, const Sched& S, const Epi& E) {
    const int tid = threadIdx.x, wid = __builtin_amdgcn_readfirstlane(tid >> 6), lane = tid & 63, wr = wid >> 2, wc = wid & 3, fr = lane & 15, fq = lane >> 4;
    const int nt = K / BK;
    int sR[2], sC[2]; unsigned voffB[2];
#pragma unroll
    for (int i = 0; i < 2; ++i) { stage_rc(tid * 16 + i * 8192, sR[i], sC[i]); const int Rb = Epi::PERM ? ((sR[i] & ~31) + perm32(sR[i] & 31)) : sR[i];
        voffB[i] = (unsigned)(Rb * ldb + sC[i]) * 2u; }
    const size_t kstep = (size_t)(BK * 2);
    const size_t hstepB = (size_t)HALF * ldb * 2;
    const unsigned ldsw = (unsigned)wid * 1024u;
    const int aoff = lds_byte(wr * 64 + fr, fq * 8), boff = lds_byte(wc * 32 + fr, fq * 8);
#define PG8_SA(b, h) (((b) * 2 + (h)) * HTB)
#define PG8_SB(b, h) ((4 + (b) * 2 + (h)) * HTB)
#define PG8_STAGE(bufoff, gbase, voff) do { _Pragma("unroll") for (int _i = 0; _i < 2; ++_i) \
        __builtin_amdgcn_global_load_lds((const unsigned*)((const char*)(gbase) + (voff)[_i]), (LAS unsigned*)(lds + (bufoff) + ldsw + _i * 8192), 16, 0, 0); } while (0)
#define PG8_LDA(dst, b, h) do { _Pragma("unroll") for (int m = 0; m < 4; ++m) _Pragma("unroll") for (int k = 0; k < 2; ++k) dst[m][k] = *(const LAS bf16x8*)(lds + PG8_SA(b, h) + aoff + m * 2048 + k * 1024); } while (0)
#define PG8_LDB(dst, b, h) do { _Pragma("unroll") for (int n = 0; n < 2; ++n) _Pragma("unroll") for (int k = 0; k < 2; ++k) dst[n][k] = *(const LAS bf16x8*)(lds + PG8_SB(b, h) + boff + n * 2048 + k * 1024); } while (0)
#define PG8_MMA(ai, bj, At, Bt) do { __builtin_amdgcn_s_setprio(1); _Pragma("unroll") for (int m = 0; m < 4; ++m) _Pragma("unroll") for (int n = 0; n < 2; ++n) _Pragma("unroll") for (int k = 0; k < 2; ++k) { \
        if constexpr (I8) acc[ai][bj][m][n] = __builtin_bit_cast(f32x4, __builtin_amdgcn_mfma_i32_16x16x64_i8(__builtin_bit_cast(i32x4g, Bt[n][k]), __builtin_bit_cast(i32x4g, At[m][k]), __builtin_bit_cast(i32x4g, acc[ai][bj][m][n]), 0, 0, 0)); \
        else acc[ai][bj][m][n] = __builtin_amdgcn_mfma_f32_16x16x32_bf16(Bt[n][k], At[m][k], acc[ai][bj][m][n], 0, 0, 0); } __builtin_amdgcn_s_setprio(0); } while (0)
#define PG8_WAIT_V(n) asm volatile("s_waitcnt vmcnt(" #n ")" ::: "memory")
#define PG8_WAIT_L(n) asm volatile("s_waitcnt lgkmcnt(" #n ")" ::: "memory")
#define PG8_BAR __builtin_amdgcn_s_barrier()
#define PG8_SCHED __builtin_amdgcn_sched_barrier(0)
#define PG8_SETVA(dst, u) do { _Pragma("unroll") for (int _h = 0; _h < 2; ++_h) _Pragma("unroll") for (int _i = 0; _i < 2; ++_i) \
        dst[_h][_i] = (S.arow(u, _h * HALF + sR[_i]) * (unsigned)lda + (unsigned)sC[_i]) * 2u; } while (0)
    Unit cur, nxt; int ui = 0;
    if (!S.next(0, cur)) return;
    f32x4 acc[2][2][4][2];
#pragma unroll
    for (int a = 0; a < 2; ++a)
#pragma unroll
        for (int b = 0; b < 2; ++b)
#pragma unroll
            for (int m = 0; m < 4; ++m)
#pragma unroll
                for (int n = 0; n < 2; ++n) acc[a][b][m][n] = (f32x4){0.f, 0.f, 0.f, 0.f};
    bf16x8 At[4][2], B0[2][2], B1[2][2];
    constexpr bool GA = Sched::GATHER;
    unsigned vA[2][2], nvA[2][2];
    PG8_SETVA(vA, cur);
    const char* cA = cur.Ab; const char* cB = cur.Bb;
    PG8_STAGE(PG8_SB(0, 0), cB, voffB); PG8_STAGE(PG8_SA(0, 0), cA, vA[0]); PG8_STAGE(PG8_SB(0, 1), cB + hstepB, voffB); PG8_STAGE(PG8_SA(0, 1), cA, vA[1]);
    if (wr == 1) PG8_BAR;
    PG8_WAIT_V(4); PG8_BAR;
    PG8_STAGE(PG8_SB(1, 0), cB + kstep, voffB); PG8_STAGE(PG8_SA(1, 0), cA + kstep, vA[0]); PG8_STAGE(PG8_SB(1, 1), cB + hstepB + kstep, voffB);
    PG8_WAIT_V(6); PG8_BAR;
    for (;;) {
        const bool has_next = S.next(ui + 1, nxt);
        const char* nA = cA; const char* nB = cB;
        if (has_next) { nA = nxt.Ab; nB = nxt.Bb; if (GA) PG8_SETVA(nvA, nxt); }
        else if (GA) {
#pragma unroll
            for (int h = 0; h < 2; ++h)
#pragma unroll
                for (int i = 0; i < 2; ++i) nvA[h][i] = vA[h][i]; }
#pragma unroll 1
        for (int t = 0; t < nt; t += 2) {
            const bool last = (t == nt - 2);
            const char* a1 = cA + (size_t)(t + 1) * kstep;
            const char* a2 = last ? nA : cA + (size_t)(t + 2) * kstep; const char* b2 = last ? nB : cB + (size_t)(t + 2) * kstep;
            const char* a3 = a2 + kstep; const char* b3 = b2 + kstep;
            unsigned s2[2][2];
#pragma unroll
            for (int h = 0; h < 2; ++h)
#pragma unroll
                for (int i = 0; i < 2; ++i) s2[h][i] = (GA && last) ? nvA[h][i] : vA[h][i];
            PG8_LDB(B0, 0, 0); PG8_SCHED; PG8_LDA(At, 0, 0); PG8_STAGE(PG8_SA(1, 1), a1, vA[1]);
            PG8_WAIT_L(8); PG8_BAR; PG8_WAIT_L(0); PG8_MMA(0, 0, At, B0); PG8_BAR; PG8_SCHED;
            PG8_LDB(B1, 0, 1); PG8_STAGE(PG8_SB(0, 0), b2, voffB);
            PG8_BAR; PG8_WAIT_L(0); PG8_MMA(0, 1, At, B1); PG8_BAR;
            PG8_LDA(At, 0, 1); PG8_STAGE(PG8_SA(0, 0), a2, s2[0]);
            PG8_BAR; PG8_WAIT_L(0); PG8_MMA(1, 0, At, B0); PG8_BAR; PG8_SCHED;
            PG8_STAGE(PG8_SB(0, 1), b2 + hstepB, voffB);
            PG8_WAIT_V(6); PG8_BAR; PG8_MMA(1, 1, At, B1); PG8_BAR;
            PG8_LDB(B0, 1, 0); PG8_SCHED; PG8_LDA(At, 1, 0); PG8_STAGE(PG8_SA(0, 1), a2, s2[1]);
            PG8_WAIT_L(8); PG8_BAR; PG8_WAIT_L(0); PG8_MMA(0, 0, At, B0); PG8_BAR; PG8_SCHED;
            PG8_LDB(B1, 1, 1); PG8_STAGE(PG8_SB(1, 0), b3, voffB);
            PG8_BAR; PG8_WAIT_L(0); PG8_MMA(0, 1, At, B1); PG8_BAR;
            PG8_LDA(At, 1, 1); PG8_STAGE(PG8_SA(1, 0), a3, s2[0]);
            PG8_BAR; PG8_WAIT_L(0); PG8_MMA(1, 0, At, B0); PG8_BAR; PG8_SCHED;
            PG8_STAGE(PG8_SB(1, 1), b3 + hstepB, voffB);
            PG8_WAIT_V(6); PG8_BAR; PG8_MMA(1, 1, At, B1); PG8_BAR;
        }
        { int fr_e = fr, fq_e = fq; asm volatile("" : "+v"(fr_e), "+v"(fq_e));
          E(acc, cur, wr, wc, fr_e, fq_e); }
        if (!has_next) break;
#pragma unroll
        for (int a = 0; a < 2; ++a)
#pragma unroll
            for (int b = 0; b < 2; ++b)
#pragma unroll
                for (int m = 0; m < 4; ++m)
#pragma unroll
                    for (int n = 0; n < 2; ++n) acc[a][b][m][n] = (f32x4){0.f, 0.f, 0.f, 0.f};
        cur = nxt; cA = nA; cB = nB; ++ui;
        if (GA) {
#pragma unroll
        for (int h = 0; h < 2; ++h)
#pragma unroll
            for (int i = 0; i < 2; ++i) vA[h][i] = nvA[h][i]; }
    }
    PG8_WAIT_V(0);
    if (wr == 0) PG8_BAR;
    PG8_BAR;
#undef PG8_SA
#undef PG8_SB
#undef PG8_STAGE
#undef PG8_LDA
#undef PG8_LDB
#undef PG8_MMA
#undef PG8_WAIT_V
#undef PG8_WAIT_L
#undef PG8_BAR
#undef PG8_SCHED
#undef PG8_SETVA
}
#define EPI_FOR(ai, m, bj) _Pragma("unroll") for (int ai = 0; ai < 2; ++ai) _Pragma("unroll") for (int m = 0; m < 4; ++m) _Pragma("unroll") for (int bj = 0; bj < 2; ++bj)
__device__ __forceinline__ u32x4 pack8(f32x4 v0, f32x4 v1) { u32x4 w; w.x = cvt_pk_bf16(v0[0], v0[1]); w.y = cvt_pk_bf16(v0[2], v0[3]); w.z = cvt_pk_bf16(v1[0], v1[1]); w.w = cvt_pk_bf16(v1[2], v1[3]); return w; }
}
using pg8::Unit;

struct EpiG1 {
    static constexpr bool PERM = true;
    const float* rstd; bf16 *zmla, *zrkv, *zlora, *zgate; const float* cmax;
    __device__ __forceinline__ void operator()(const PG8_ACC, const Unit& u, int wr, int wc, int fr, int fq) const {
        bf16* base; int ld, c0;
        if (u.pn < 4) { base = zmla; ld = ZM_LD; c0 = u.pn * 256; } else if (u.pn < 28) { base = zrkv; ld = ZR_LD; c0 = (u.pn - 4) * 256; }
        else if (u.pn < 31) { base = zlora; ld = ZL_LD; c0 = (u.pn - 28) * 256; } else { base = zgate; ld = ZG_LD; c0 = (u.pn - 31) * 256; }
        const int col0 = c0 + wc * 32 + 8 * fq;
        f32x4 cs[2][2];
#pragma unroll
        for (int bj = 0; bj < 2; ++bj) { const float* cp = cmax + u.pn * 256 + bj * 128 + wc * 32 + 8 * fq; cs[bj][0] = *(const f32x4*)cp * (1.0f / 127.0f); cs[bj][1] = *(const f32x4*)(cp + 4) * (1.0f / 127.0f); }
        EPI_FOR(ai, m, bj) { const int row = u.pm * 256 + ai * 128 + wr * 64 + m * 16 + fr; const float rs = rstd[row];
            const f32x4 v0 = __builtin_convertvector(__builtin_bit_cast(pg8::i32x4g, acc[ai][bj][m][0]), f32x4) * rs * cs[bj][0], v1 = __builtin_convertvector(__builtin_bit_cast(pg8::i32x4g, acc[ai][bj][m][1]), f32x4) * rs * cs[bj][1];
            *(u32x4*)(base + (size_t)row * ld + col0 + bj * 128) = pg8::pack8(v0, v1); }
    }
};
struct EpiPlain {
    static constexpr bool PERM = true;
    bf16* O; int ld; const float* rstd; float scale;
    __device__ __forceinline__ void operator()(const PG8_ACC, const Unit& u, int wr, int wc, int fr, int fq) const {
        const int col0 = u.pn * 256 + wc * 32 + 8 * fq;
        EPI_FOR(ai, m, bj) { const int row = u.pm * 256 + ai * 128 + wr * 64 + m * 16 + fr; const float rs = (rstd ? rstd[row] : 1.f) * scale;
            *(u32x4*)(O + (size_t)row * ld + col0 + bj * 128) = pg8::pack8(acc[ai][bj][m][0] * rs, acc[ai][bj][m][1] * rs); }
    }
};
struct EpiPlainI8 {
    static constexpr bool PERM = true;
    bf16* O; int ld; const float* rows; const float* cmax; float scale;
    __device__ __forceinline__ void operator()(const PG8_ACC, const Unit& u, int wr, int wc, int fr, int fq) const {
        const int col0 = u.pn * 256 + wc * 32 + 8 * fq; f32x4 cs[2][2];
#pragma unroll
        for (int bj = 0; bj < 2; ++bj) { const float* cp = cmax + col0 + bj * 128; cs[bj][0] = *(const f32x4*)cp * (scale / 127.0f); cs[bj][1] = *(const f32x4*)(cp + 4) * (scale / 127.0f); }
        EPI_FOR(ai, m, bj) { const int row = u.pm * 256 + ai * 128 + wr * 64 + m * 16 + fr; const float rs = rows[row];
            const f32x4 v0 = __builtin_convertvector(__builtin_bit_cast(pg8::i32x4g, acc[ai][bj][m][0]), f32x4) * rs * cs[bj][0], v1 = __builtin_convertvector(__builtin_bit_cast(pg8::i32x4g, acc[ai][bj][m][1]), f32x4) * rs * cs[bj][1];
            *(u32x4*)(O + (size_t)row * ld + col0 + bj * 128) = pg8::pack8(v0, v1); }
    }
};
constexpr float QSCALE = 0.07216878364870322f * 1.4426950408889634f;
constexpr float CSCALE = 0.08838834764831845f * 1.4426950408889634f;
__device__ __forceinline__ u32x2 pack8_fp8(f32x4 v0, f32x4 v1) {
    int a = __builtin_amdgcn_cvt_pk_fp8_f32(v0[0], v0[1], 0, false); a = __builtin_amdgcn_cvt_pk_fp8_f32(v0[2], v0[3], a, true);
    int b = __builtin_amdgcn_cvt_pk_fp8_f32(v1[0], v1[1], 0, false); b = __builtin_amdgcn_cvt_pk_fp8_f32(v1[2], v1[3], b, true);
    return (u32x2){(unsigned)a, (unsigned)b};
}
struct EpiQ {
    static constexpr bool PERM = true;
    unsigned char* Q; const float* rstd; const float* cs;
    __device__ __forceinline__ void operator()(const PG8_ACC, const Unit& u, int wr, int wc, int fr, int fq) const {
        EPI_FOR(ai, m, bj) { const int row = u.pm * 256 + ai * 128 + wr * 64 + m * 16 + fr; const int col = u.pn * 256 + bj * 128 + wc * 32 + 8 * fq;
            const float rs = rstd[row]; f32x4 v0 = acc[ai][bj][m][0] * rs, v1 = acc[ai][bj][m][1] * rs;
            const int cih = col % QKD;
            if (cih >= NOPE) { const int i0 = (cih - NOPE) >> 1; const f32x4* t = (const f32x4*)(cs + ((size_t)row * 32 + i0) * 2);
                const f32x4 a = t[0], b = t[1];
                f32x4 r0, r1;
                r0[0] = v0[0] * a[0] - v0[1] * a[1]; r0[1] = v0[1] * a[0] + v0[0] * a[1]; r0[2] = v0[2] * a[2] - v0[3] * a[3]; r0[3] = v0[3] * a[2] + v0[2] * a[3];
                r1[0] = v1[0] * b[0] - v1[1] * b[1]; r1[1] = v1[1] * b[0] + v1[0] * b[1]; r1[2] = v1[2] * b[2] - v1[3] * b[3]; r1[3] = v1[3] * b[2] + v1[2] * b[3];
                v0 = r0; v1 = r1; }
            *(u32x2*)(Q + (size_t)row * (MH * QKD) + col) = pack8_fp8(v0, v1); }
    }
};
struct EpiKV {
    static constexpr bool PERM = true;
    unsigned char* Kb; bf16* Vb; const float* rstd;
    __device__ __forceinline__ void operator()(const PG8_ACC, const Unit& u, int wr, int wc, int fr, int fq) const {
        const int c = wc * 32 + 8 * fq;
        EPI_FOR(ai, m, bj) { const int row = u.pm * 256 + ai * 128 + wr * 64 + m * 16 + fr; const float rs = rstd[row];
            if (bj == 0) *(u32x2*)(Kb + (size_t)row * (MH * QKD) + u.pn * QKD + c) = pack8_fp8(acc[ai][bj][m][0] * rs, acc[ai][bj][m][1] * rs);
            else *(u32x4*)(Vb + (size_t)row * (MH * VDIM) + u.pn * VDIM + c) = pg8::pack8(acc[ai][bj][m][0] * rs, acc[ai][bj][m][1] * rs); }
    }
};
template <int MODE> struct EpiLora {
    static constexpr bool PERM = true;
    bf16* O; const float* bias;
    __device__ __forceinline__ void operator()(const PG8_ACC, const Unit& u, int wr, int wc, int fr, int fq) const {
        EPI_FOR(ai, m, bj) { const int row = u.pm * 256 + ai * 128 + wr * 64 + m * 16 + fr; const int col = u.pn * 256 + bj * 128 + wc * 32 + 8 * fq;
            f32x4 v0 = acc[ai][bj][m][0], v1 = acc[ai][bj][m][1];
            if (MODE != 2) { const f32x4 b0 = *(const f32x4*)(bias + col), b1 = *(const f32x4*)(bias + col + 4);
#pragma unroll
                for (int j = 0; j < 4; ++j) { float s0 = sigmoidf_(v0[j] + b0[j]), s1 = sigmoidf_(v1[j] + b1[j]);
                    if (MODE == 0) { s0 *= -0.8750394f; s1 *= -0.8750394f; }
                    v0[j] = s0; v1[j] = s1; } }
            *(u32x4*)(O + (size_t)row * RW + col) = pg8::pack8(v0, v1); }
    }
};
template <int MODE> struct EpiLora2 {
    static constexpr bool PERM = true;
    bf16* O0; bf16* O1; const float* bias0; const float* bias1;
    __device__ __forceinline__ void operator()(const PG8_ACC, const Unit& u, int wr, int wc, int fr, int fq) const {
        const bool second = u.pn >= 8; bf16* O = second ? O1 : O0; const float* bias = second ? bias1 : bias0; const int pn = second ? u.pn - 8 : u.pn;
        EPI_FOR(ai, m, bj) { const int row = u.pm * 256 + ai * 128 + wr * 64 + m * 16 + fr; const int col = pn * 256 + bj * 128 + wc * 32 + 8 * fq;
            f32x4 v0 = acc[ai][bj][m][0], v1 = acc[ai][bj][m][1];
            const f32x4 b0 = *(const f32x4*)(bias + col), b1 = *(const f32x4*)(bias + col + 4);
#pragma unroll
            for (int j = 0; j < 4; ++j) { float s0 = sigmoidf_(v0[j] + b0[j]), s1 = sigmoidf_(v1[j] + b1[j]);
                if (MODE == 0) { s0 *= -0.8750394f; s1 *= -0.8750394f; }
                v0[j] = s0; v1[j] = s1; }
            *(u32x4*)(O + (size_t)row * RW + col) = pg8::pack8(v0, v1); }
    }
};
template <int SECOND> struct EpiUp {
    static constexpr bool PERM = true;
    bf16* O; const bf16* zg; int goff;
    __device__ __forceinline__ void operator()(const PG8_ACC, const Unit& u, int wr, int wc, int fr, int fq) const {
        EPI_FOR(ai, m, bj) { const int row = u.pm * 256 + ai * 128 + wr * 64 + m * 16 + fr; const int col = u.pn * 256 + bj * 128 + wc * 32 + 8 * fq;
            const u32x4 g = *(const u32x4*)(zg + (size_t)row * ZG_LD + goff + col);
            f32x4 v0 = acc[ai][bj][m][0], v1 = acc[ai][bj][m][1];
            v0[0] *= sigmoidf_(bflo(g.x)); v0[1] *= sigmoidf_(bfhi(g.x)); v0[2] *= sigmoidf_(bflo(g.y)); v0[3] *= sigmoidf_(bfhi(g.y));
            v1[0] *= sigmoidf_(bflo(g.z)); v1[1] *= sigmoidf_(bfhi(g.z)); v1[2] *= sigmoidf_(bflo(g.w)); v1[3] *= sigmoidf_(bfhi(g.w));
            bf16* dst = O + (size_t)row * DM + col;
            if (SECOND) { const u32x4 p = *(const u32x4*)dst;
                v0[0] += bflo(p.x); v0[1] += bfhi(p.x); v0[2] += bflo(p.y); v0[3] += bfhi(p.y); v1[0] += bflo(p.z); v1[1] += bfhi(p.z); v1[2] += bflo(p.w); v1[3] += bfhi(p.w); }
            *(u32x4*)dst = pg8::pack8(v0, v1); }
    }
};
struct EpiResid {
    static constexpr bool PERM = true;
    const float* base; float* out;
    __device__ __forceinline__ void operator()(const PG8_ACC, const Unit& u, int wr, int wc, int fr, int fq) const {
        EPI_FOR(ai, m, bj) { const int row = u.pm * 256 + ai * 128 + wr * 64 + m * 16 + fr; const int col = u.pn * 256 + bj * 128 + wc * 32 + 8 * fq;
            const size_t o = (size_t)row * DM + col; const f32x4 b0 = *(const f32x4*)(base + o), b1 = *(const f32x4*)(base + o + 4);
            *(f32x4*)(out + o) = b0 + acc[ai][bj][m][0]; *(f32x4*)(out + o + 4) = b1 + acc[ai][bj][m][1]; }
    }
};

namespace att {
constexpr int NW = 8, QBLK = 32, KVBLK = 64;
constexpr float THRL = 11.5f;
#define SBAR() __builtin_amdgcn_sched_barrier(0)
__device__ __forceinline__ int crow(int r, int hi) { return (r & 3) + 8 * (r >> 2) + 4 * hi; }
template <bool SCALED = false> __device__ __forceinline__ void partialSM(f32x16& p, float& m_reg, float& alpha, const float sc = 1.f) {
    float pmax = p[0];
#pragma unroll
    for (int r = 1; r < 16; ++r) pmax = fmaxf(pmax, p[r]);
    { auto rr = __builtin_amdgcn_permlane32_swap(__float_as_uint(pmax), __float_as_uint(pmax), false, false);
      pmax = fmaxf(__uint_as_float(rr[0]), __uint_as_float(rr[1])); }
    if (SCALED) pmax *= sc;
    float mn;
    if (__builtin_expect(__all(pmax - m_reg <= THRL), 1)) { mn = m_reg; alpha = 1.f; }
    else { mn = fmaxf(m_reg, pmax); alpha = __builtin_amdgcn_exp2f(m_reg - mn); m_reg = mn; }
#pragma unroll
    for (int r = 0; r < 16; ++r) p[r] = SCALED ? __builtin_fmaf(p[r], sc, -mn) : p[r] - mn;
#pragma unroll
    for (int r = 0; r < 8; ++r) p[r] = __builtin_amdgcn_exp2f(p[r]);
}
__device__ __forceinline__ void finishSM(f32x16& p, float alpha, float& l_reg, bf16x8& pa0, bf16x8& pa1) {
#pragma unroll
    for (int r = 8; r < 16; ++r) p[r] = __builtin_amdgcn_exp2f(p[r]);
    float ps = 0;
#pragma unroll
    for (int r = 0; r < 16; ++r) ps += p[r];
    { auto rr = __builtin_amdgcn_permlane32_swap(__float_as_uint(ps), __float_as_uint(ps), false, false);
      ps = __uint_as_float(rr[0]) + __uint_as_float(rr[1]); }
    l_reg = l_reg * alpha + ps;
#define PK4(P, BASE, OUT) do { unsigned a0 = cvt_pk_bf16(P[BASE + 0], P[BASE + 1]), a1 = cvt_pk_bf16(P[BASE + 2], P[BASE + 3]);   \
    unsigned b0 = cvt_pk_bf16(P[BASE + 4], P[BASE + 5]), b1 = cvt_pk_bf16(P[BASE + 6], P[BASE + 7]);                              \
    auto r0 = __builtin_amdgcn_permlane32_swap(a0, b0, false, false); auto r1 = __builtin_amdgcn_permlane32_swap(a1, b1, false, false); \
    u32x4 w = {r0[0], r1[0], r0[1], r1[1]}; OUT = *reinterpret_cast<bf16x8*>(&w); } while (0)
    PK4(p, 0, pa0); PK4(p, 8, pa1);
#undef PK4
}
template <int DQK> __device__ __forceinline__ int kswz(int row, int colB) { return row * (DQK * 2 + 16) + colB; }
template <int DQK> __device__ __forceinline__ void qkt(f32x16& p, const LAS char* Ks, const bf16x8* qr, int krow, int hi) {
    p = f32x16{};
#pragma unroll
    for (int d0 = 0; d0 < DQK / 16; ++d0) { const int cb = (d0 * 16 + hi * 8) * 2;
        bf16x8 b0 = *reinterpret_cast<const LAS bf16x8*>(Ks + kswz<DQK>(krow, cb));
        p = __builtin_amdgcn_mfma_f32_32x32x16_bf16(b0, qr[d0], p, 0, 0, 0); }
}
__device__ __forceinline__ int v_st(int k, int c) { const int kk = (k & ~0xC) | ((k & 4) << 1) | ((k & 8) >> 1); return ((kk >> 3) * 4 + (c >> 5)) * 512 + ((kk & 7) * 32 + (c & 31)) * 2; }
__device__ __forceinline__ int v_rd_base(int lane) { return ((lane & 3) << 3) | (((lane >> 2) & 3) << 6) | (((lane >> 4) & 1) << 5) | (((lane >> 5) & 1) << 8); }
constexpr int v_rd_off(int d0, int ks, int half) { return d0 * 512 + ks * 4096 + half * 2048; }
template <int OFF> __device__ __forceinline__ s16x4 tr_read(int vb) {
    s16x4 r; asm volatile("ds_read_b64_tr_b16 %0, %1 offset:%2" : "=&v"(r) : "v"(vb), "i"(OFF) : "memory"); return r;
}
template <int D0, int KH> __device__ __forceinline__ void pv_one(f32x16& od, int vb, bf16x8 pa0, bf16x8 pa1) {
    const s16x4 l0 = tr_read<v_rd_off(D0, 2 * KH, 0)>(vb), h0 = tr_read<v_rd_off(D0, 2 * KH, 1)>(vb), l1 = tr_read<v_rd_off(D0, 2 * KH + 1, 0)>(vb), h1 = tr_read<v_rd_off(D0, 2 * KH + 1, 1)>(vb);
    asm volatile("s_waitcnt lgkmcnt(0)" ::: "memory"); SBAR();
#define PK(L, H) (bf16x8){L[0], L[1], L[2], L[3], H[0], H[1], H[2], H[3]}
    od = __builtin_amdgcn_mfma_f32_32x32x16_bf16(pa0, PK(l0, h0), od, 0, 0, 0);
    od = __builtin_amdgcn_mfma_f32_32x32x16_bf16(pa1, PK(l1, h1), od, 0, 0, 0);
#undef PK
}
template <int KH> __device__ __forceinline__ void pv_d0(f32x16* o, int vb, bf16x8 pa0, bf16x8 pa1) {
    pv_one<0, KH>(o[0], vb, pa0, pa1); pv_one<1, KH>(o[1], vb, pa0, pa1); pv_one<2, KH>(o[2], vb, pa0, pa1); pv_one<3, KH>(o[3], vb, pa0, pa1);
}
template <int DQK, int LDQ, int LDK, int LDV, int LDO>
__device__ __forceinline__ void attn_unit(const bf16* __restrict__ Qb, const bf16* __restrict__ Kh, const bf16* __restrict__ Vh, bf16* __restrict__ Ob, const int seq, LAS char* lds) {
    constexpr int SHM_V = KVBLK * 128 * 2, SHM_K = KVBLK * (DQK * 2 + 16), KCH = DQK / 64;
    const int tid = threadIdx.x, wid = tid >> 6, lane = tid & 63, r32 = lane & 31, hi = lane >> 5;
    LAS char* V_lds = lds; LAS char* K_lds = lds + 2 * SHM_V;
    LAS float* wsf = (LAS float*)(lds + 2 * SHM_V + 2 * SHM_K) + wid * 64; LAS float* li_l = wsf; LAS float* al_l = wsf + 32;
    float m_reg = -1e30f, l_reg = 0; f32x16 o[4] = {}; bf16x8 qr[DQK / 16];
    const bf16* Qw = Qb + (long)(wid * QBLK + r32) * LDQ + hi * 8;
#pragma unroll
    for (int d0 = 0; d0 < DQK / 16; ++d0) qr[d0] = *reinterpret_cast<const bf16x8*>(Qw + d0 * 16);
    const int sr = tid >> 4, sc = (tid & 15) * 8, vst0 = v_st(sr, sc), vst1 = v_st(32 + sr, sc);
    unsigned kgo[KCH]; int klo[KCH];
#pragma unroll
    for (int i = 0; i < KCH; ++i) { const int id = tid + 512 * i, row = id / (DQK / 8), c8 = id % (DQK / 8); kgo[i] = (unsigned)(row * LDK + c8 * 8) * 2u; klo[i] = kswz<DQK>(row, c8 * 16); }
    const unsigned vgo0 = (unsigned)(sr * LDV + sc) * 2u, vgo1 = (unsigned)((32 + sr) * LDV + sc) * 2u;
    const int vb0 = (int)(uintptr_t)V_lds + v_rd_base(lane);
    bf16x8 vs0, vs1, ks[KCH];
#define SLOAD(k0) do { const char* _vt = (const char*)(Vh + (size_t)(k0) * LDV); const char* _kt = (const char*)(Kh + (size_t)(k0) * LDK); \
    vs0 = *reinterpret_cast<const bf16x8*>(_vt + vgo0); vs1 = *reinterpret_cast<const bf16x8*>(_vt + vgo1); \
    _Pragma("unroll") for (int _i = 0; _i < KCH; ++_i) ks[_i] = *reinterpret_cast<const bf16x8*>(_kt + kgo[_i]); } while (0)
#define SWRITE(b) do { *(LAS bf16x8*)(V_lds + (b) * SHM_V + vst0) = vs0; *(LAS bf16x8*)(V_lds + (b) * SHM_V + vst1) = vs1; \
    _Pragma("unroll") for (int _i = 0; _i < KCH; ++_i) *(LAS bf16x8*)(K_lds + (b) * SHM_K + klo[_i]) = ks[_i]; } while (0)
#define SWAIT() asm volatile("s_waitcnt vmcnt(0)" ::: "memory")
#define RESC(a) do { if (__any((a) < 1.f)) { if (hi == 0) al_l[r32] = (a); asm volatile("s_waitcnt lgkmcnt(0)" ::: "memory"); \
    _Pragma("unroll") for (int d = 0; d < 4; ++d) _Pragma("unroll") for (int r = 0; r < 16; ++r) o[d][r] *= al_l[crow(r, hi)]; } } while (0)
    f32x16 pA, pB; float alA, alB; bf16x8 pa0, pa1; const int NT = seq / KVBLK;
    SLOAD(0); SWAIT(); SWRITE(0); __syncthreads();
    if (1 < NT) SLOAD(KVBLK);
    qkt<DQK>(pA, K_lds, qr, r32, hi); partialSM(pA, m_reg, alA);
    if (1 < NT) { SWAIT(); SWRITE(1); } __syncthreads();
    if (2 < NT) SLOAD(2 * KVBLK);
    SBAR(); qkt<DQK>(pB, K_lds, qr, 32 + r32, hi);
    finishSM(pA, alA, l_reg, pa0, pa1); SBAR();
    pv_d0<0>(o, vb0, pa0, pa1); partialSM(pB, m_reg, alB); RESC(alB);
    for (int j = 1; j < NT; ++j) {
        const int cb = j & 1, pb = cb ^ 1;
        SBAR(); qkt<DQK>(pA, K_lds + cb * SHM_K, qr, r32, hi);
        finishSM(pB, alB, l_reg, pa0, pa1); SBAR();
        pv_d0<1>(o, vb0 + pb * SHM_V, pa0, pa1); partialSM(pA, m_reg, alA);
        __syncthreads(); if (j + 1 < NT) { SWAIT(); SWRITE(pb); }
        RESC(alA); __syncthreads();
        if (j + 2 < NT) SLOAD((j + 2) * KVBLK);
        SBAR(); qkt<DQK>(pB, K_lds + cb * SHM_K, qr, 32 + r32, hi);
        finishSM(pA, alA, l_reg, pa0, pa1); SBAR();
        pv_d0<0>(o, vb0 + cb * SHM_V, pa0, pa1); partialSM(pB, m_reg, alB); RESC(alB);
    }
    finishSM(pB, alB, l_reg, pa0, pa1); SBAR();
    pv_d0<1>(o, vb0 + ((NT - 1) & 1) * SHM_V, pa0, pa1);
    if (hi == 0) li_l[r32] = l_reg; asm volatile("s_waitcnt lgkmcnt(0)" ::: "memory");
    float rli[16];
#pragma unroll
    for (int r = 0; r < 16; ++r) rli[r] = __builtin_amdgcn_rcpf(li_l[crow(r, hi)]);
    bf16* Ow = Ob + (size_t)(wid * QBLK) * LDO;
    int r32e = r32, hie = hi; asm volatile("" : "+v"(r32e), "+v"(hie));
    const unsigned ob = (unsigned)(4 * hie * LDO + r32e);
#pragma unroll
    for (int r = 0; r < 16; ++r) {
#pragma unroll
        for (int d0 = 0; d0 < 4; ++d0) Ow[ob + (unsigned)(((r & 3) + 8 * (r >> 2)) * LDO + d0 * 32)] = f2bf(o[d0][r] * rli[r]); }
    __syncthreads();
#undef SLOAD
#undef SWRITE
#undef SWAIT
#undef RESC
}
typedef int i32x8 __attribute__((ext_vector_type(8)));
__device__ __forceinline__ void qkt_f8(f32x16& p, const LAS char* Ks, const i32x8* qr, int krow, int hi) {
    p = f32x16{};
#pragma unroll
    for (int d0 = 0; d0 < 3; ++d0) { const LAS char* a = Ks + krow * 208 + d0 * 64 + hi * 32;
        const u32x4 lo = *reinterpret_cast<const LAS u32x4*>(a), hh = *reinterpret_cast<const LAS u32x4*>(a + 16);
        const i32x8 av = {(int)lo.x, (int)lo.y, (int)lo.z, (int)lo.w, (int)hh.x, (int)hh.y, (int)hh.z, (int)hh.w};
        p = __builtin_amdgcn_mfma_scale_f32_32x32x64_f8f6f4(av, qr[d0], p, 0, 0, 0, 0, 0, 0); }
}
template <int LDQ, int LDK, int LDV, int LDO>
__device__ __forceinline__ void attn_unit_f8(const unsigned char* __restrict__ Qb, const unsigned char* __restrict__ Kh, const bf16* __restrict__ Vh, bf16* __restrict__ Ob, const int seq, const float SC, LAS char* lds) {
    constexpr int SHM_V = KVBLK * 128 * 2, SHM_K = KVBLK * 208;
    const int tid = threadIdx.x, wid = tid >> 6, lane = tid & 63, r32 = lane & 31, hi = lane >> 5;
    LAS char* V_lds = lds; LAS char* K_lds = lds + 2 * SHM_V;
    LAS float* wsf = (LAS float*)(lds + 2 * SHM_V + 2 * SHM_K) + wid * 64; LAS float* li_l = wsf; LAS float* al_l = wsf + 32;
    float m_reg = -1e30f, l_reg = 0; f32x16 o[4] = {}; i32x8 qr[3];
    { const unsigned char* Qw = Qb + (long)(wid * QBLK + r32) * LDQ + hi * 32;
#pragma unroll
      for (int d0 = 0; d0 < 3; ++d0) { const u32x4 lo = *reinterpret_cast<const u32x4*>(Qw + d0 * 64), hh = *reinterpret_cast<const u32x4*>(Qw + d0 * 64 + 16);
          qr[d0] = (i32x8){(int)lo.x, (int)lo.y, (int)lo.z, (int)lo.w, (int)hh.x, (int)hh.y, (int)hh.z, (int)hh.w}; } }
    const int sr = tid >> 4, sc = (tid & 15) * 8, vst0 = v_st(sr, sc), vst1 = v_st(32 + sr, sc);
    const bool k2 = wid < 4;
    const int id0 = tid, id1 = 512 + tid;
    const unsigned kgo0 = (unsigned)((id0 / 12) * LDK + (id0 % 12) * 16), kgo1 = (unsigned)((id1 / 12) * LDK + (id1 % 12) * 16);
    const int klo0 = (id0 / 12) * 208 + (id0 % 12) * 16, klo1 = (id1 / 12) * 208 + (id1 % 12) * 16;
    const unsigned vgo0 = (unsigned)(sr * LDV + sc) * 2u, vgo1 = (unsigned)((32 + sr) * LDV + sc) * 2u;
    const int vb0 = (int)(uintptr_t)V_lds + v_rd_base(lane);
    bf16x8 vs0, vs1; u32x4 ks0, ks1 = {0u, 0u, 0u, 0u};
#define SLOAD(k0) do { const char* _vt = (const char*)(Vh + (size_t)(k0) * LDV); const unsigned char* _kt = Kh + (size_t)(k0) * LDK; \
    vs0 = *reinterpret_cast<const bf16x8*>(_vt + vgo0); vs1 = *reinterpret_cast<const bf16x8*>(_vt + vgo1); \
    ks0 = *reinterpret_cast<const u32x4*>(_kt + kgo0); if (k2) ks1 = *reinterpret_cast<const u32x4*>(_kt + kgo1); } while (0)
#define SWRITE(b) do { *(LAS bf16x8*)(V_lds + (b) * SHM_V + vst0) = vs0; *(LAS bf16x8*)(V_lds + (b) * SHM_V + vst1) = vs1; \
    *(LAS u32x4*)(K_lds + (b) * SHM_K + klo0) = ks0; if (k2) *(LAS u32x4*)(K_lds + (b) * SHM_K + klo1) = ks1; } while (0)
#define SWAIT() asm volatile("s_waitcnt vmcnt(0)" ::: "memory")
#define RESC(a) do { if (__any((a) < 1.f)) { if (hi == 0) al_l[r32] = (a); asm volatile("s_waitcnt lgkmcnt(0)" ::: "memory"); \
    _Pragma("unroll") for (int d = 0; d < 4; ++d) _Pragma("unroll") for (int r = 0; r < 16; ++r) o[d][r] *= al_l[crow(r, hi)]; } } while (0)
    f32x16 pA, pB; float alA, alB; bf16x8 pa0, pa1; const int NT = seq / KVBLK;
    SLOAD(0); SWAIT(); SWRITE(0); __syncthreads();
    if (1 < NT) SLOAD(KVBLK);
    qkt_f8(pA, K_lds, qr, r32, hi); partialSM<true>(pA, m_reg, alA, SC);
    if (1 < NT) { SWAIT(); SWRITE(1); } __syncthreads();
    if (2 < NT) SLOAD(2 * KVBLK);
    SBAR(); qkt_f8(pB, K_lds, qr, 32 + r32, hi);
    finishSM(pA, alA, l_reg, pa0, pa1); SBAR();
    pv_d0<0>(o, vb0, pa0, pa1); partialSM<true>(pB, m_reg, alB, SC); RESC(alB);
    for (int j = 1; j < NT; ++j) {
        const int cb = j & 1, pb = cb ^ 1;
        SBAR(); qkt_f8(pA, K_lds + cb * SHM_K, qr, r32, hi);
        finishSM(pB, alB, l_reg, pa0, pa1); SBAR();
        pv_d0<1>(o, vb0 + pb * SHM_V, pa0, pa1); partialSM<true>(pA, m_reg, alA, SC);
        __syncthreads(); if (j + 1 < NT) { SWAIT(); SWRITE(pb); }
        RESC(alA); __syncthreads();
        if (j + 2 < NT) SLOAD((j + 2) * KVBLK);
        SBAR(); qkt_f8(pB, K_lds + cb * SHM_K, qr, 32 + r32, hi);
        finishSM(pA, alA, l_reg, pa0, pa1); SBAR();
        pv_d0<0>(o, vb0 + cb * SHM_V, pa0, pa1); partialSM<true>(pB, m_reg, alB, SC); RESC(alB);
    }
    finishSM(pB, alB, l_reg, pa0, pa1); SBAR();
    pv_d0<1>(o, vb0 + ((NT - 1) & 1) * SHM_V, pa0, pa1);
    if (hi == 0) li_l[r32] = l_reg; asm volatile("s_waitcnt lgkmcnt(0)" ::: "memory");
    float rli[16];
#pragma unroll
    for (int r = 0; r < 16; ++r) rli[r] = __builtin_amdgcn_rcpf(li_l[crow(r, hi)]);
    bf16* Ow = Ob + (size_t)(wid * QBLK) * LDO;
    int r32e = r32, hie = hi; asm volatile("" : "+v"(r32e), "+v"(hie));
    const unsigned ob = (unsigned)(4 * hie * LDO + r32e);
#pragma unroll
    for (int r = 0; r < 16; ++r) {
#pragma unroll
        for (int d0 = 0; d0 < 4; ++d0) Ow[ob + (unsigned)(((r & 3) + 8 * (r >> 2)) * LDO + d0 * 32)] = f2bf(o[d0][r] * rli[r]); }
    __syncthreads();
#undef SLOAD
#undef SWRITE
#undef SWAIT
#undef RESC
}
__device__ __forceinline__ float f8_map_probe(const int lane) {
    const int r = lane & 31, h = lane >> 5;
    const float am = 1.f + (float)((r >> 2) & 1), bm = 1.f + (float)((r >> 3) & 1);
    i32x8 a, b;
#pragma unroll
    for (int w = 0; w < 8; ++w) { const int k0 = 32 * h + 4 * w; int pa = 0, pb = 0;
        pa = __builtin_amdgcn_cvt_pk_fp8_f32((float)((k0 + 0) & 7) * am, (float)((k0 + 1) & 7) * am, pa, false); pa = __builtin_amdgcn_cvt_pk_fp8_f32((float)((k0 + 2) & 7) * am, (float)((k0 + 3) & 7) * am, pa, true);
        pb = __builtin_amdgcn_cvt_pk_fp8_f32((float)((3 * (k0 + 0) + 1) % 7) * bm, (float)((3 * (k0 + 1) + 1) % 7) * bm, pb, false); pb = __builtin_amdgcn_cvt_pk_fp8_f32((float)((3 * (k0 + 2) + 1) % 7) * bm, (float)((3 * (k0 + 3) + 1) % 7) * bm, pb, true);
        a[w] = pa; b[w] = pb; }
    f32x16 d = {};
    d = __builtin_amdgcn_mfma_scale_f32_32x32x64_f8f6f4(a, b, d, 0, 0, 0, 0, 0, 0);
    float e0 = 0.f;
    for (int k = 0; k < 64; ++k) e0 += (float)(k & 7) * (float)((3 * k + 1) % 7);
    float err = 0.f;
#pragma unroll
    for (int rr = 0; rr < 16; ++rr) { const int row = crow(rr, h), col = r; const float ex = e0 * (1.f + (float)((row >> 2) & 1)) * (1.f + (float)((col >> 3) & 1)); err = fmaxf(err, fabsf(d[rr] - ex)); }
#pragma unroll
    for (int o = 32; o >= 1; o >>= 1) err = fmaxf(err, __shfl_xor(err, o));
    return err;
}
}

struct Frame {
    LAS unsigned char* lds; volatile LAS unsigned* MISC; unsigned* ctl;
    int tid, lane, wave, vcu, G;
    unsigned char* ws; float* out;
    const float* in[41];
};
enum { I_X = 0, I_MEM, I_POS, I_GMIX, I_WIN, I_GQ, I_WUQ, I_GKV, I_WUKV, I_SHIFT, I_W0F, I_W2F, I_W0B, I_W2B, I_A0F, I_A2F, I_A0B, I_A2B, I_G2, I_KK, I_KA, I_RK,
       I_LNXG, I_LNXB, I_WUPM, I_WUPR, I_WOUT, I_GCROSS, I_GMEM, I_WQC, I_WKVC, I_WOC, I_GFFN, I_WRG, I_BRG, I_WRE, I_BRE, I_WEG, I_WEU, I_WED, I_GFINAL };

template <int MODE> __device__ __forceinline__ int rowmap(int n) {
    if (MODE == 1) {
        if (n < 768) return n;
        if (n < 832) { const int p = n - 768; return 768 + (p < 32 ? 2 * p : 2 * (p - 32) + 1); }
        if (n < 6976) return 1024 + (n - 832);
        if (n < 7616) return 7168 + (n - 6976);
        return 7936 + (n - 7616);
    }
    if (MODE == 2) {
        const int h = n / QKD, d = n % QKD; if (d < NOPE) return n; const int p = d - NOPE; return h * QKD + NOPE + (p < 32 ? 2 * p : 2 * (p - 32) + 1);
    }
    if (MODE == 3) return (n >> 7) * 256 + (n & 127);
    if (MODE == 4) return (n >> 7) * 256 + 128 + (n & 127);
    return n;
}
constexpr int CVT_SCR = 16640;
template <int MODE> __device__ __forceinline__ void cvt_item(const float* W, int K, int N, const float* gain, bf16* WT, int ldt, LAS float* scr, int item, int lane, int kofs = 0) {
    const int nblk = N / 64, kb = item / nblk, nb = item % nblk, k0 = 64 * kb, n0 = 64 * nb;
    const int kq = lane >> 4, nc = (lane & 15) * 4;
    f32x4 v[16];
#pragma unroll
    for (int i = 0; i < 16; ++i) { const int k = k0 + 4 * i + kq - kofs; v[i] = (f32x4){0.f, 0.f, 0.f, 0.f};
        if (k >= 0 && k < K) { v[i] = *(const f32x4*)(W + (size_t)k * N + n0 + nc); if (gain) v[i] = v[i] * gain[k]; } }
#pragma unroll
    for (int i = 0; i < 16; ++i) { const int kk = 4 * i + kq;
#pragma unroll
        for (int c = 0; c < 4; ++c) scr[(nc + c) * 65 + kk] = v[i][c]; }
    LDS_WAIT(); asm volatile("" ::: "memory");
    const int kc = (lane & 7) * 8;
#pragma unroll
    for (int jj = 0; jj < 8; ++jj) { const int n = (lane >> 3) + 8 * jj; const LAS float* s = scr + n * 65 + kc;
        u32x4 o; o.x = cvt_pk_bf16(s[0], s[1]); o.y = cvt_pk_bf16(s[2], s[3]); o.z = cvt_pk_bf16(s[4], s[5]); o.w = cvt_pk_bf16(s[6], s[7]);
        *(u32x4*)(WT + (size_t)rowmap<MODE>(n0 + n) * ldt + k0 + kc) = o; }
    LDS_WAIT(); asm volatile("" ::: "memory");
}
#define CVT_JOB(MODE, src, K, N, gain, dst, ldt) { const int _n = (((K) + 63) / 64) * ((N) / 64); if (r < _n) { cvt_item<MODE>(src, K, N, gain, dst, ldt, scr, r, F.lane); continue; } r -= _n; }
#define CVT_JOB_PAD(src, K, N, dst, KPAD, KOFS) { const int _n = ((KPAD) / 64) * ((N) / 64); if (r < _n) { cvt_item<0>(src, K, N, nullptr, dst, KPAD, scr, r, F.lane, KOFS); continue; } r -= _n; }
struct CvtD { const float* W; const float* gain; bf16* WT; int K, N, ldt, mode, kofs, item, q, cm; };
__device__ __forceinline__ unsigned pack4_i8(float a, float b, float c, float d) { const int i0 = (int)a, i1 = (int)b, i2 = (int)c, i3 = (int)d; return (unsigned)(i0 & 255) | ((unsigned)(i1 & 255) << 8) | ((unsigned)(i2 & 255) << 16) | ((unsigned)i3 << 24); }
__device__ __forceinline__ int rowmap_rt(int mode, int n) { return mode == 1 ? rowmap<1>(n) : mode == 2 ? rowmap<2>(n) : mode == 3 ? rowmap<3>(n) : mode == 4 ? rowmap<4>(n) : n; }
__device__ __forceinline__ void cvt_load(const CvtD& d, int lane, f32x4 (&v)[16], float (&g)[16]) {
    const int nblk = d.N / 64, kb = d.item / nblk, nb = d.item % nblk, k0 = 64 * kb, n0 = 64 * nb; const int kq = lane >> 4, nc = (lane & 15) * 4;
#pragma unroll
    for (int i = 0; i < 16; ++i) { const int k = k0 + 4 * i + kq - d.kofs; v[i] = (f32x4){0.f, 0.f, 0.f, 0.f}; g[i] = 1.f;
        if (k >= 0 && k < d.K) { v[i] = *(const f32x4*)(d.W + (size_t)k * d.N + n0 + nc); if (d.gain) g[i] = d.gain[k]; } }
}
__device__ __forceinline__ void cvt_process(const CvtD& d, int lane, f32x4 (&v)[16], float (&g)[16], LAS float* scr, const float* colmax) {
    const int nblk = d.N / 64, kb = d.item / nblk, nb = d.item % nblk, k0 = 64 * kb, n0 = 64 * nb; const int kq = lane >> 4, nc = (lane & 15) * 4;
    if (d.q == 5) {
        f32x4 mx = {0.f, 0.f, 0.f, 0.f};
#pragma unroll
        for (int i = 0; i < 16; ++i) { const f32x4 t = v[i] * g[i];
#pragma unroll
            for (int c = 0; c < 4; ++c) mx[c] = fmaxf(mx[c], fabsf(t[c])); }
#pragma unroll
        for (int c = 0; c < 4; ++c) { mx[c] = fmaxf(mx[c], __shfl_xor(mx[c], 16)); mx[c] = fmaxf(mx[c], __shfl_xor(mx[c], 32)); }
        if (lane < 16) {
#pragma unroll
            for (int c = 0; c < 4; ++c) __hip_atomic_fetch_max((unsigned*)colmax + d.cm + rowmap_rt(d.mode, n0 + nc + c), __float_as_uint(mx[c]), __ATOMIC_RELAXED, __HIP_MEMORY_SCOPE_AGENT); }
        return; }
#pragma unroll
    for (int i = 0; i < 16; ++i) { const int kk = 4 * i + kq;
#pragma unroll
        for (int c = 0; c < 4; ++c) scr[(nc + c) * 65 + kk] = v[i][c] * g[i]; }
    LDS_WAIT(); asm volatile("" ::: "memory");
    const int kc = (lane & 7) * 8;
#pragma unroll
    for (int jj = 0; jj < 8; ++jj) { const int n = (lane >> 3) + 8 * jj; const LAS float* s = scr + n * 65 + kc; const int rm = rowmap_rt(d.mode, n0 + n);
        if (d.q == 6) { const float q = 127.0f / fmaxf(__hip_atomic_load(colmax + d.cm + rm, __ATOMIC_RELAXED, __HIP_MEMORY_SCOPE_AGENT), 1e-30f);
            *(u32x2*)((unsigned char*)d.WT + (size_t)rm * d.ldt + k0 + kc) = (u32x2){pack4_i8(rintf(s[0] * q), rintf(s[1] * q), rintf(s[2] * q), rintf(s[3] * q)), pack4_i8(rintf(s[4] * q), rintf(s[5] * q), rintf(s[6] * q), rintf(s[7] * q))}; }
        else { u32x4 o; o.x = cvt_pk_bf16(s[0], s[1]); o.y = cvt_pk_bf16(s[2], s[3]); o.z = cvt_pk_bf16(s[4], s[5]); o.w = cvt_pk_bf16(s[6], s[7]);
            *(u32x4*)(d.WT + (size_t)rm * d.ldt + k0 + kc) = o; } }
    LDS_WAIT(); asm volatile("" ::: "memory");
}
#define CVT_PIPE(TOTAL_, DESC_) do { CvtD dA, dB; f32x4 vA[16], vB[16]; float gA[16], gB[16]; int it = gw; \
        if (it < (TOTAL_)) { DESC_(it, dA); cvt_load(dA, F.lane, vA, gA); } \
        for (; it < (TOTAL_); it += 2 * NGW) { const int itn = it + NGW, itn2 = it + 2 * NGW; \
            if (itn < (TOTAL_)) { DESC_(itn, dB); cvt_load(dB, F.lane, vB, gB); } \
            cvt_process(dA, F.lane, vA, gA, scr, CVT_COLMAX); \
            if (itn2 < (TOTAL_)) { DESC_(itn2, dA); cvt_load(dA, F.lane, vA, gA); } \
            if (itn < (TOTAL_)) cvt_process(dB, F.lane, vB, gB, scr, CVT_COLMAX); } } while (0)

#define CVT_COLMAX ((const float*)F.ctl)
__device__ __forceinline__ void p0b_win_i8(Frame& F) {
    LAS float* scr = (LAS float*)(F.lds + F.wave * CVT_SCR);
    const int gw = F.vcu * 8 + F.wave, NGW = F.G * 8;
    unsigned char* ws = F.ws;
#define P0B_DESC(it_, d) do { int r = (it_); d.K = DM; d.ldt = DM; d.kofs = 0; d.q = 6; \
        if (r < 32 * (IN_W / 64)) { d.W = F.in[I_WIN]; d.gain = F.in[I_GMIX]; d.WT = (bf16*)(ws + WS_WIN); d.N = IN_W; d.mode = 1; d.cm = CW_COLMAX; d.item = r; } \
        else if ((r -= 32 * (IN_W / 64)) < 32 * 8) { d.W = F.in[I_WQC]; d.gain = F.in[I_GCROSS]; d.WT = (bf16*)(ws + WS_WQC); d.N = CW; d.mode = 0; d.cm = CW_CM_QC; d.item = r; } \
        else { r -= 32 * 8; d.W = F.in[I_WKVC]; d.gain = nullptr; d.WT = (bf16*)(ws + WS_WKVC); d.N = 2 * CW; d.mode = 0; d.cm = CW_CM_KVC; d.item = r; } } while (0)
    CVT_PIPE(32 * (IN_W / 64) + 32 * 8 + 32 * 16, P0B_DESC);
#undef P0B_DESC
}
__device__ __forceinline__ void p0_prologue(Frame& F) {
    LAS float* scr = (LAS float*)(F.lds + F.wave * CVT_SCR);
    const int gw = F.vcu * 8 + F.wave, NGW = F.G * 8;
    unsigned char* ws = F.ws;
    constexpr int TOTAL = 32 * (IN_W / 64) + 8 * 48 + 4 * 64 + 4 * (4 * 32) + 4 * 32 + 3 * (32 * 32) + 32 * 8 + 32 * 16 + 8 * 32;
#define P0_SETD(d, mode_, src_, K_, N_, gain_, dst_, ldt_, KPAD_, KOFS_, Q_, CM_) { const int _n = ((KPAD_) / 64) * ((N_) / 64); if (r < _n) { d.W = src_; d.gain = gain_; d.WT = dst_; d.K = K_; d.N = N_; d.ldt = ldt_; d.mode = mode_; d.kofs = KOFS_; d.item = r; d.q = Q_; d.cm = CM_; break; } r -= _n; }
#define P0_DESC(it_, d) do { int r = (it_); \
        P0_SETD(d, 1, F.in[I_WIN], DM, IN_W, F.in[I_GMIX], (bf16*)(ws + WS_WIN), DM, DM, 0, 5, CW_COLMAX) \
        P0_SETD(d, 2, F.in[I_WUQ], QLORA, MH * QKD, F.in[I_GQ], (bf16*)(ws + WS_WUQ), QLORA, QLORA, 0, 0, 0) \
        P0_SETD(d, 0, F.in[I_WUKV], KVLORA, MH * 256, F.in[I_GKV], (bf16*)(ws + WS_WUKV), KVLORA, KVLORA, 0, 0, 0) \
        P0_SETD(d, 0, F.in[I_W2F], DLORA, RW, nullptr, (bf16*)(ws + WS_W2F), 256, 256, 0, 0, 0) \
        P0_SETD(d, 0, F.in[I_W2B], DLORA, RW, nullptr, (bf16*)(ws + WS_W2F + 1 * MiB), 256, 256, 128, 0, 0) \
        P0_SETD(d, 0, F.in[I_A2F], DLORA, RW, nullptr, (bf16*)(ws + WS_W2F + 2 * MiB), 256, 256, 0, 0, 0) \
        P0_SETD(d, 0, F.in[I_A2B], DLORA, RW, nullptr, (bf16*)(ws + WS_W2F + 3 * MiB), 256, 256, 128, 0, 0) \
        P0_SETD(d, 0, F.in[I_G2], GLORA, RW, nullptr, (bf16*)(ws + WS_G2), GLORA, GLORA, 0, 0, 0) \
        P0_SETD(d, 0, F.in[I_WUPM], DM, DM, nullptr, (bf16*)(ws + WS_WUPM), DM, DM, 0, 0, 0) \
        P0_SETD(d, 0, F.in[I_WUPR], DM, DM, nullptr, (bf16*)(ws + WS_WUPR), DM, DM, 0, 0, 0) \
        P0_SETD(d, 0, F.in[I_WOUT], DM, DM, nullptr, (bf16*)(ws + WS_WOUT), DM, DM, 0, 0, 0) \
        P0_SETD(d, 0, F.in[I_WQC], DM, CW, F.in[I_GCROSS], (bf16*)(ws + WS_WQC), DM, DM, 0, 5, CW_CM_QC) \
        P0_SETD(d, 0, F.in[I_WKVC], DM, 2 * CW, nullptr, (bf16*)(ws + WS_WKVC), DM, DM, 0, 5, CW_CM_KVC) \
        P0_SETD(d, 0, F.in[I_WOC], CW, DM, nullptr, (bf16*)(ws + WS_WOC), CW, CW, 0, 0, 0) \
    } while (0)
    CVT_PIPE(TOTAL, P0_DESC);
#undef P0_SETD
#undef P0_DESC
    const float* x = F.in[I_X]; bf16* xb = (bf16*)(ws + WS_XB); float* rstd1 = (float*)(ws + WS_RSTD);
    for (int m = gw; m < MT + NB * MEMLEN; m += NGW) {
        const bool ismem = m >= MT; const int mm = ismem ? m - MT : m;
        const f32x4* xr = (const f32x4*)((ismem ? F.in[I_MEM] : x) + (size_t)mm * DM) + F.lane;
        f32x4 v[8]; float s = 0.f;
#pragma unroll
        for (int j = 0; j < 8; ++j) { v[j] = xr[64 * j]; s += (v[j].x * v[j].x + v[j].y * v[j].y) + (v[j].z * v[j].z + v[j].w * v[j].w); }
        const float rs = 1.0f / sqrtf(wave_sum(s) * (1.f / DM) + RMS_EPS);
        if (!ismem) {
            float am = 0.f;
#pragma unroll
            for (int j = 0; j < 8; ++j) am = fmaxf(am, fmaxf(fmaxf(fabsf(v[j].x), fabsf(v[j].y)), fmaxf(fabsf(v[j].z), fabsf(v[j].w))));
#pragma unroll
            for (int o = 32; o >= 1; o >>= 1) am = fmaxf(am, __shfl_xor(am, o));
            am = fmaxf(am, 1e-30f); const float qs = 127.f / am;
            if (F.lane == 0) rstd1[mm] = rs * am * (1.f / 127.f);
            unsigned* o8 = (unsigned*)((unsigned char*)xb + (size_t)mm * DM) + F.lane;
#pragma unroll
            for (int j = 0; j < 8; ++j) o8[64 * j] = pack4_i8(rintf(v[j].x * qs), rintf(v[j].y * qs), rintf(v[j].z * qs), rintf(v[j].w * qs));
        } else { const f32x4* gr = (const f32x4*)F.in[I_GMEM] + F.lane; float am = 0.f;
#pragma unroll
            for (int j = 0; j < 8; ++j) { const f32x4 g = gr[64 * j]; v[j] = (f32x4){v[j].x * rs * g.x, v[j].y * rs * g.y, v[j].z * rs * g.z, v[j].w * rs * g.w};
                am = fmaxf(am, fmaxf(fmaxf(fabsf(v[j].x), fabsf(v[j].y)), fmaxf(fabsf(v[j].z), fabsf(v[j].w)))); }
#pragma unroll
            for (int o = 32; o >= 1; o >>= 1) am = fmaxf(am, __shfl_xor(am, o));
            am = fmaxf(am, 1e-30f); const float qs = 127.f / am;
            if (F.lane == 0) ((float*)F.ctl)[CW_MEMSCALE + mm] = am * (1.f / 127.f);
            unsigned* o8 = (unsigned*)(ws + WS_MEMN + (size_t)mm * DM) + F.lane;
#pragma unroll
            for (int j = 0; j < 8; ++j) o8[64 * j] = pack4_i8(rintf(v[j].x * qs), rintf(v[j].y * qs), rintf(v[j].z * qs), rintf(v[j].w * qs));
        }
    }
    const int gt = F.vcu * 512 + F.tid, NGT = F.G * 512;
    { const int* pos = (const int*)F.in[I_POS]; f32x2* cs = (f32x2*)(ws + WS_ROPE);
      for (int i = gt; i < MT * 32; i += NGT) { const int t = i >> 5, f = i & 31;
          const float inv = exp2f(-(float)f * (13.287712379549449f / 32.0f));
          const float ang = (float)pos[t] * inv;
          const double a = (double)ang; const double k = rint(a * 0.15915494309189535); const float red = (float)(a - k * 6.283185307179586);
          cs[i] = (f32x2){cosf(red), sinf(red)}; } }
    { float* WR = (float*)(ws + WS_WR); const float* gf = F.in[I_GFFN];
      for (int i = gt; i < DM * 36; i += NGT) { const int k = i / 36, c = i % 36; float w;
          if (c < 4) w = F.in[I_WRG][k * 4 + c]; else { const int gi = (c - 4) >> 3, e = (c - 4) & 7; w = F.in[I_WRE][((size_t)gi * DM + k) * 8 + e]; }
          WR[i] = w * gf[k]; } }
}

__device__ __forceinline__ void p_final(Frame& F, bool with_moe) {
    const int gw = F.vcu * 8 + F.wave, NGW = F.G * 8;
    const f32x4* gr = (const f32x4*)F.in[I_GFINAL] + F.lane;
    const int* route = (const int*)(F.ws + WS_ROUTE); const bf16* ybuf = (const bf16*)(F.ws + WS_YBUF);
    const int* cnts = (const int*)(F.ctl + CW_CNT);
    for (int m = gw; m < MT; m += NGW) {
        f32x4* xr = (f32x4*)(F.out + (size_t)m * DM) + F.lane;
        f32x4 v[8];
#pragma unroll
        for (int j = 0; j < 8; ++j) v[j] = xr[64 * j];
        if (with_moe) {
#pragma unroll
            for (int kx = 0; kx < 2; ++kx) { const int e = route[m * 8 + 2 * kx], pos = route[m * 8 + 2 * kx + 1];
                int base = 0; for (int q = 0; q < e; ++q) base += (cnts[64 * q] + 255) & ~255;
                const u32x2* yr = (const u32x2*)(ybuf + (size_t)(base + pos) * DM) + F.lane;
#pragma unroll
                for (int j = 0; j < 8; ++j) { const u32x2 w = yr[64 * j]; v[j].x += bflo(w.x); v[j].y += bfhi(w.x); v[j].z += bflo(w.y); v[j].w += bfhi(w.y); } }
        }
        float s = 0.f;
#pragma unroll
        for (int j = 0; j < 8; ++j) s += (v[j].x * v[j].x + v[j].y * v[j].y) + (v[j].z * v[j].z + v[j].w * v[j].w);
        const float rs = 1.0f / sqrtf(wave_sum(s) * (1.f / DM) + RMS_EPS);
#pragma unroll
        for (int j = 0; j < 8; ++j) { const f32x4 g = gr[64 * j]; xr[64 * j] = (f32x4){v[j].x * rs * g.x, v[j].y * rs * g.y, v[j].z * rs * g.z, v[j].w * rs * g.w}; }
    }
}
__device__ __forceinline__ void p_copy_x(Frame& F) {
    const int gt = F.vcu * 512 + F.tid, NGT = F.G * 512; const f32x4* s = (const f32x4*)F.in[I_X]; f32x4* d = (f32x4*)F.out;
    for (int i = gt; i < MT * DM / 4; i += NGT) d[i] = s[i];
}

__device__ __forceinline__ void p2_rowpass(Frame& F) {
    const int gw = F.vcu * 8 + F.wave, NGW = F.G * 8, l = F.lane;
    unsigned char* ws = F.ws;
    const bf16* zm = (const bf16*)(ws + WS_ZMLA); const bf16* zl = (const bf16*)(ws + WS_ZLORA); bf16* la = (bf16*)(ws + WS_LORAA);
    float* rstd_q = (float*)(ws + WS_RSTD) + MT; float* rstd_kv = (float*)(ws + WS_RSTD) + 2 * MT;
    const f32x2* cs = (const f32x2*)(ws + WS_ROPE); unsigned char* Kb = ws + WS_K;
    const float* sh = F.in[I_SHIFT] + 6144;
    f32x2 s0[5], s1[5], s2[5];
#pragma unroll
    for (int i = 0; i < 5; ++i) { const int j = 2 * l + 128 * i; s0[i] = *(const f32x2*)(sh + j); s1[i] = *(const f32x2*)(sh + RWKV_IN + j); s2[i] = *(const f32x2*)(sh + 2 * RWKV_IN + j); }
    for (int t = gw; t < MT; t += NGW) {
        const bf16* zr = zm + (size_t)t * ZM_LD;
        { const u32x4 w = *((const u32x4*)zr + l); float s = 0.f;
          s += bflo(w.x) * bflo(w.x) + bfhi(w.x) * bfhi(w.x) + bflo(w.y) * bflo(w.y) + bfhi(w.y) * bfhi(w.y) + bflo(w.z) * bflo(w.z) + bfhi(w.z) * bfhi(w.z) + bflo(w.w) * bflo(w.w) + bfhi(w.w) * bfhi(w.w);
          s = wave_sum(s); if (l == 0) rstd_q[t] = 1.0f / sqrtf(s * (1.f / QLORA) + RMS_EPS); }
        { const u32x2 w = *((const u32x2*)(zr + QLORA) + l); float s = bflo(w.x) * bflo(w.x) + bfhi(w.x) * bfhi(w.x) + bflo(w.y) * bflo(w.y) + bfhi(w.y) * bfhi(w.y);
          s = wave_sum(s); if (l == 0) rstd_kv[t] = 1.0f / sqrtf(s * (1.f / KVLORA) + RMS_EPS); }
        { const int i = l & 31, hs = l >> 5; const unsigned w = *((const unsigned*)(zr + 768) + i); const float x1 = bflo(w), x2 = bfhi(w); const f32x2 c = cs[(size_t)t * 32 + i];
          const unsigned short o = (unsigned short)__builtin_amdgcn_cvt_pk_fp8_f32(x1 * c.x - x2 * c.y, x2 * c.x + x1 * c.y, 0, false);
#pragma unroll
          for (int hh = 0; hh < 8; ++hh) *((unsigned short*)(Kb + (size_t)t * (MH * QKD) + (hs * 8 + hh) * QKD + NOPE) + i) = o; }
        const int s = t % SEQ; const float fp = s > 0 ? 1.f : 0.f, fn = s < SEQ - 1 ? 1.f : 0.f;
        const bf16* z0 = zl + (size_t)t * ZL_LD; const bf16* zp = s > 0 ? z0 - ZL_LD : z0; const bf16* zn = s < SEQ - 1 ? z0 + ZL_LD : z0;
        bf16* lr = la + (size_t)t * LA_LD;
#pragma unroll
        for (int i = 0; i < 5; ++i) { const int j = 2 * l + 128 * i;
            const unsigned wp = *(const unsigned*)(zp + j), w0 = *(const unsigned*)(z0 + j), wn = *(const unsigned*)(zn + j);
            float va = s0[i].x * fp * bflo(wp) + s1[i].x * bflo(w0) + s2[i].x * fn * bflo(wn);
            float vb = s0[i].y * fp * bfhi(wp) + s1[i].y * bfhi(w0) + s2[i].y * fn * bfhi(wn);
            int dst;
            if (j < 192) { va = tanhf(va); vb = tanhf(vb); dst = (j / 96) * 128 + (j % 96); } else if (j < 384) { dst = (j / 96) * 128 + (j % 96); } else { va = sigmoidf_(va); vb = sigmoidf_(vb); dst = 512 + (j - 384); }
            *(unsigned*)(lr + dst) = cvt_pk_bf16(va, vb); }
        { const int p = 2 * l; *(unsigned*)(lr + (p >> 5) * 128 + 96 + (p & 31)) = 0u; }
    }
}

namespace scan {
constexpr int TC = 16, DATA_B = TC * 6 * 64 * 4, BUF_B = DATA_B + 64 + TC * 32 * 4;
template <int CTRL> __device__ __forceinline__ float dpp_add(float v) {
    return v + __builtin_bit_cast(float, __builtin_amdgcn_update_dpp(0, __builtin_bit_cast(int, v), CTRL, 0xF, 0xF, false));
}
__device__ __forceinline__ float red16(float v) { v = dpp_add<0xB1>(v); v = dpp_add<0x4E>(v); v = dpp_add<0x141>(v); v = dpp_add<0x140>(v); return v; }
struct Raw { unsigned short r[3], k[3], v[3], wl, ic; };
template <int VAR> __device__ __forceinline__ void scan_unit(Frame& F, const int b, const int h, const int dir, const int half) {
    unsigned char* ws = F.ws; const int l = F.lane, w = F.wave, tid = F.tid;
    const bf16* zr = (const bf16*)(ws + WS_ZRKV) + (size_t)b * SEQ * ZR_LD + h * 64 + l;
    const bf16* wlp = (const bf16*)(ws + (dir ? WS_WLB : WS_WLF)) + (size_t)b * SEQ * RW + h * 64 + l;
    const bf16* icp = (const bf16*)(ws + (dir ? WS_ICB : WS_ICF)) + (size_t)b * SEQ * RW + h * 64 + l;
    bf16* yout = (bf16*)(ws + (dir ? WS_YB : WS_YF)) + (size_t)b * SEQ * RW + h * 64 + half * 32;
    const int ch = h * 64 + l; const float* sh = F.in[I_SHIFT];
    const float sr0 = sh[ch], sr1 = sh[RWKV_IN + ch], sr2 = sh[2 * RWKV_IN + ch];
    const float sk0 = sh[2048 + ch], sk1 = sh[RWKV_IN + 2048 + ch], sk2 = sh[2 * RWKV_IN + 2048 + ch];
    const float sv0 = sh[4096 + ch], sv1 = sh[RWKV_IN + 4096 + ch], sv2 = sh[2 * RWKV_IN + 4096 + ch];
    const float kk_c = F.in[I_KK][ch], ka_c = F.in[I_KA][ch], rk_c = F.in[I_RK][ch];
    LAS unsigned char* L = F.lds;
    Raw raw[2];
#define SC_TOK(ci, i) (dir ? (SEQ - 1 - ((ci) * TC + (i))) : ((ci) * TC + (i)))
#define SC_LOAD(ci) do { _Pragma("unroll") for (int q = 0; q < 2; ++q) { const int s = SC_TOK(ci, 2 * w + q); const int sp = s > 0 ? s - 1 : s, sn = s < SEQ - 1 ? s + 1 : s; \
        const bf16* z0 = zr + (size_t)s * ZR_LD; const bf16* zp = zr + (size_t)sp * ZR_LD; const bf16* zn = zr + (size_t)sn * ZR_LD; \
        raw[q].r[0] = zp[0]; raw[q].r[1] = z0[0]; raw[q].r[2] = zn[0]; raw[q].k[0] = zp[2048]; raw[q].k[1] = z0[2048]; raw[q].k[2] = zn[2048]; \
        raw[q].v[0] = zp[4096]; raw[q].v[1] = z0[4096]; raw[q].v[2] = zn[4096]; raw[q].wl = wlp[(size_t)s * RW]; raw[q].ic = icp[(size_t)s * RW]; } } while (0)
#define SC_PREP(ci, bufi) do { _Pragma("unroll") for (int q = 0; q < 2; ++q) { const int i = 2 * w + q; const int s = SC_TOK(ci, i); const float fp = s > 0 ? 1.f : 0.f, fn = s < SEQ - 1 ? 1.f : 0.f; \
        const float r_s = sr0 * fp * bf2f(raw[q].r[0]) + sr1 * bf2f(raw[q].r[1]) + sr2 * fn * bf2f(raw[q].r[2]); \
        const float k_s = sk0 * fp * bf2f(raw[q].k[0]) + sk1 * bf2f(raw[q].k[1]) + sk2 * fn * bf2f(raw[q].k[2]); \
        const float v_s = sv0 * fp * bf2f(raw[q].v[0]) + sv1 * bf2f(raw[q].v[1]) + sv2 * fn * bf2f(raw[q].v[2]); \
        const float kkr = k_s * kk_c; const float ss = wave_sum(kkr * kkr); const float kk = kkr * (1.0f / sqrtf(ss + 1e-12f)); \
        const float icv = bf2f(raw[q].ic); const float kd = k_s * (1.0f + (icv - 1.0f) * ka_c); const float bb = kk * icv; const float wd = __builtin_amdgcn_exp2f(bf2f(raw[q].wl)); \
        const float bon = wave_sum(r_s * kd * rk_c); \
        LAS float* d = (LAS float*)(L + (bufi) * BUF_B) + i * 384 + l; d[0] = wd; d[64] = kk; d[128] = bb; d[192] = kd; d[256] = r_s; d[320] = v_s; \
        if (l == 0) ((LAS float*)(L + (bufi) * BUF_B + DATA_B))[i] = bon; } } while (0)
    const int g = l >> 4, j = l & 15, row = half * 32 + w * 4 + g;
    f32x2 Sa = {0.f, 0.f}, Sb = {0.f, 0.f};
    struct Ops { f32x4 w, a, b, k, r; float v, bon; };
#define SC_LD(O, i) do { O.w = p4[(i) * 96 + j]; O.a = p4[(i) * 96 + 16 + j]; O.b = p4[(i) * 96 + 32 + j]; O.k = p4[(i) * 96 + 48 + j]; O.r = p4[(i) * 96 + 64 + j]; \
        O.v = pf[(i) * 384 + 320 + row]; O.bon = pb[i]; } while (0)
#define SC_STEP(O, YP) do { f32x2 t = Sa * O.a.xy; t = Sb * O.a.zw + t; float sa = red16(t.x + t.y); \
        const f32x2 nsa = {-sa, -sa}; const f32x2 vv2 = {O.v, O.v}; \
        const f32x2 u0 = nsa * O.b.xy + vv2 * O.k.xy, u1 = nsa * O.b.zw + vv2 * O.k.zw; \
        Sa = Sa * O.w.xy + u0; Sb = Sb * O.w.zw + u1; \
        f32x2 ty = Sa * O.r.xy; ty = Sb * O.r.zw + ty; YP = ty.x + ty.y; } while (0)
    SC_LOAD(0); SC_PREP(0, 0); __syncthreads();
    constexpr int NCH = SEQ / TC;
    for (int ci = 0; ci < NCH; ++ci) {
        const int bi = ci & 1;
        if (VAR != 2 && ci + 1 < NCH) SC_LOAD(ci + 1);
        const LAS f32x4* p4 = (const LAS f32x4*)(L + bi * BUF_B); const LAS float* pf = (const LAS float*)(L + bi * BUF_B);
        const LAS float* pb = (const LAS float*)(L + bi * BUF_B + DATA_B);
        float ykeep = 0.f;
        Ops oA, oB; SC_LD(oA, 0);
        if (VAR != 1) {
#pragma unroll
        for (int i = 0; i < TC; i += 4) {
            float y0, y1, y2, y3; float v0, v1, v2, v3, b0, b1, b2, b3;
            SC_LD(oB, i + 1); v0 = oA.v; b0 = oA.bon; SC_STEP(oA, y0);
            SC_LD(oA, i + 2); v1 = oB.v; b1 = oB.bon; SC_STEP(oB, y1);
            SC_LD(oB, i + 3); v2 = oA.v; b2 = oA.bon; SC_STEP(oA, y2);
            if (i + 4 < TC) SC_LD(oA, i + 4);
            v3 = oB.v; b3 = oB.bon; SC_STEP(oB, y3);
            y0 = red16(y0); y1 = red16(y1); y2 = red16(y2); y3 = red16(y3);
            y0 += b0 * v0; y1 += b1 * v1; y2 += b2 * v2; y3 += b3 * v3;
            ykeep = (j == i) ? y0 : ykeep; ykeep = (j == i + 1) ? y1 : ykeep; ykeep = (j == i + 2) ? y2 : ykeep; ykeep = (j == i + 3) ? y3 : ykeep;
        }
        }
        ((LAS float*)(L + bi * BUF_B + DATA_B + 64))[j * 32 + w * 4 + g] = ykeep;
        if (VAR != 2 && ci + 1 < NCH) SC_PREP(ci + 1, bi ^ 1);
        __syncthreads();
        { const int st = tid >> 5, rw_ = tid & 31; const int s = SC_TOK(ci, st);
          const unsigned short yv = f2bf(((const LAS float*)(L + bi * BUF_B + DATA_B + 64))[st * 32 + rw_]);
          if (VAR == 0) yout[(size_t)s * RW + rw_] = yv; else asm volatile("" :: "v"(yv)); }
    }
    __syncthreads();
#undef SC_TOK
#undef SC_LOAD
#undef SC_PREP
#undef SC_LD
#undef SC_STEP
}
}

namespace scan2 {
constexpr int TC = 16, NS = 6, NPREP = 6, NREC = 2;
constexpr int ROWB = 144;
constexpr int P_ACAT = 0, P_BHAT = 4608, P_KHAT = 6656, P_VT = 8704, P_NCAT = 10752, P_MRF = 11776, P_PC = 12800, P_GINIT = 13056  , PKG_B = 15104;
constexpr int S_L1 = 0, S_L2 = 4608, S_MF = 9216, S_NF = 10240, SCR_B = 11264;
constexpr int OFF_PKG = 0, OFF_SCR = NS * PKG_B, OFF_FLAG = OFF_SCR + NPREP * SCR_B, TOTAL_B = OFF_FLAG + 64;
static_assert(TOTAL_B <= 156 * 1024, "scan2 LDS");
__device__ __forceinline__ int crow(int r, int hi) { return (r & 3) + 8 * (r >> 2) + 4 * hi; }
__device__ __forceinline__ void lds_st16(LAS unsigned char* p, float v) { *(LAS unsigned short*)p = f2bf(v); }
__device__ __forceinline__ bf16x8 pack_acc8(const f32x16& x, int base) {
    u32x4 w = {cvt_pk_bf16(x[base + 0], x[base + 1]), cvt_pk_bf16(x[base + 2], x[base + 3]), cvt_pk_bf16(x[base + 4], x[base + 5]), cvt_pk_bf16(x[base + 6], x[base + 7])};
    return *reinterpret_cast<bf16x8*>(&w);
}
__device__ __forceinline__ float wave_sum_b(float v) {
    v = scan::red16(v);
    v += __builtin_bit_cast(float, __builtin_amdgcn_update_dpp(0, __builtin_bit_cast(int, v), 0x142, 0xA, 0xF, false));
    v += __builtin_bit_cast(float, __builtin_amdgcn_update_dpp(0, __builtin_bit_cast(int, v), 0x143, 0xC, 0xF, false));
    return __builtin_bit_cast(float, __builtin_amdgcn_readlane(__builtin_bit_cast(int, v), 63));
}
__device__ __forceinline__ void spin_ge(volatile LAS int* p, int want) { while (*p < want) __builtin_amdgcn_s_sleep(1); }

template <int dir> __device__ __forceinline__ void scan_unit(Frame& F, const int b, const int h) {
    unsigned char* ws = F.ws; const int l = F.lane, w = F.wave;
    LAS unsigned char* L = F.lds;
    volatile LAS int* ready = (volatile LAS int*)(L + OFF_FLAG);
    volatile LAS int* consumed = ready + NS;
    if (F.tid < 16) ready[F.tid] = 0;
    __syncthreads();
    constexpr int NCH = SEQ / TC;
    if (w < NREC) {
        const int half = w; const int v = l & 31, hi = l >> 5, vg = 32 * half + v;
        __builtin_amdgcn_s_setprio(3);
        f32x16 X0 = {}, X1 = {}; unsigned long long rec_acc = 0ull;
        bf16* yout = (bf16*)(ws + (dir ? WS_YB : WS_YF)) + (size_t)b * SEQ * RW + h * 64 + half * 32 + v;
        for (int ci = 0; ci < NCH; ++ci) {
            const int slot = ci % NS; const LAS unsigned char* P = L + OFF_PKG + slot * PKG_B;
            const unsigned long long tr0 = (SCAN_SEC == 9) ? __builtin_amdgcn_s_memtime() : 0ull;
            spin_ge(ready + slot, ci + 1);
            if (SCAN_SEC == 9) rec_acc += __builtin_amdgcn_s_memtime() - tr0;
            const bf16x8 a00 = *(const LAS bf16x8*)(P + P_ACAT + v * ROWB + (0 + hi) * 16), a01 = *(const LAS bf16x8*)(P + P_ACAT + v * ROWB + (2 + hi) * 16);
            const bf16x8 a10 = *(const LAS bf16x8*)(P + P_ACAT + v * ROWB + (4 + hi) * 16), a11 = *(const LAS bf16x8*)(P + P_ACAT + v * ROWB + (6 + hi) * 16);
            const bf16x8 ncat = *(const LAS bf16x8*)(P + P_NCAT + v * 32 + hi * 16), vt = *(const LAS bf16x8*)(P + P_VT + vg * 32 + hi * 16);
            const bf16x8 mrf = *(const LAS bf16x8*)(P + P_MRF + l * 16);
            const bf16x8 bh0 = *(const LAS bf16x8*)(P + P_BHAT + v * 32 + hi * 16), bh1 = *(const LAS bf16x8*)(P + P_BHAT + (32 + v) * 32 + hi * 16);
            const bf16x8 kh0 = *(const LAS bf16x8*)(P + P_KHAT + v * 32 + hi * 16), kh1 = *(const LAS bf16x8*)(P + P_KHAT + (32 + v) * 32 + hi * 16);
            f32x16 G;
            { const u32x2 q0 = *(const LAS u32x2*)(P + P_GINIT + vg * 32 + hi * 8), q1 = *(const LAS u32x2*)(P + P_GINIT + vg * 32 + 16 + hi * 8);
              const f32x4 g0 = {bflo(q0.x), bfhi(q0.x), bflo(q0.y), bfhi(q0.y)}, g1 = {bflo(q1.x), bfhi(q1.x), bflo(q1.y), bfhi(q1.y)};
#pragma unroll
              for (int r = 0; r < 8; ++r) G[r] = 0.f;
#pragma unroll
              for (int r = 0; r < 4; ++r) { G[8 + r] = g0[r]; G[12 + r] = g1[r]; } }
            f32x4 pc[8];
#pragma unroll
            for (int q = 0; q < 8; ++q) pc[q] = *(const LAS f32x4*)(P + P_PC + (32 * (q >> 2) + 8 * (q & 3) + 4 * hi) * 4);
            const bf16x8 s00 = pack_acc8(X0, 0), s01 = pack_acc8(X0, 8), s10 = pack_acc8(X1, 0), s11 = pack_acc8(X1, 8);
            G = __builtin_amdgcn_mfma_f32_32x32x16_bf16(a00, s00, G, 0, 0, 0);
            G = __builtin_amdgcn_mfma_f32_32x32x16_bf16(a01, s01, G, 0, 0, 0);
            G = __builtin_amdgcn_mfma_f32_32x32x16_bf16(a10, s10, G, 0, 0, 0);
            G = __builtin_amdgcn_mfma_f32_32x32x16_bf16(a11, s11, G, 0, 0, 0);
            G = __builtin_amdgcn_mfma_f32_32x32x16_bf16(ncat, vt, G, 0, 0, 0);
            const bf16x8 uf = pack_acc8(G, 0);
#pragma unroll
            for (int r = 0; r < 16; ++r) { X0[r] *= pc[r >> 2][r & 3]; X1[r] *= pc[4 + (r >> 2)][r & 3]; }
            X0 = __builtin_amdgcn_mfma_f32_32x32x16_bf16(bh0, uf, X0, 0, 0, 0);
            X1 = __builtin_amdgcn_mfma_f32_32x32x16_bf16(bh1, uf, X1, 0, 0, 0);
            X0 = __builtin_amdgcn_mfma_f32_32x32x16_bf16(kh0, vt, X0, 0, 0, 0);
            X1 = __builtin_amdgcn_mfma_f32_32x32x16_bf16(kh1, vt, X1, 0, 0, 0);
            G = __builtin_amdgcn_mfma_f32_32x32x16_bf16(mrf, uf, G, 0, 0, 0);
            LDS_WAIT();
            if (l == 0) consumed[half] = ci + 1;
#pragma unroll
            for (int q = 0; q < 8; ++q) { const int t = crow(q, hi); const int s = dir ? (SEQ - 1 - (ci * TC + t)) : (ci * TC + t);
                yout[(size_t)s * RW] = f2bf(G[8 + q]); }
        }
        __builtin_amdgcn_s_setprio(0);
        if (SCAN_SEC == 9 && blockIdx.x == 0 && w == 0 && l == 0) { F.MISC[120] = (unsigned)rec_acc; F.MISC[121] = (unsigned)(rec_acc >> 32); }
    } else {
        const int pw = w - NREC; LAS unsigned char* SC = L + OFF_SCR + pw * SCR_B;
        const __amdgpu_buffer_rsrc_t rsZ = __builtin_amdgcn_make_buffer_rsrc((void*)(ws + WS_ZRKV + ((size_t)b * SEQ * ZR_LD + h * 64) * 2), (short)0, (int)(SEQ * ZR_LD * 2), 0x00020000);
        const __amdgpu_buffer_rsrc_t rsW = __builtin_amdgcn_make_buffer_rsrc((void*)(ws + (dir ? WS_WLB : WS_WLF) + ((size_t)b * SEQ * RW + h * 64) * 2), (short)0, (int)(SEQ * RW * 2), 0x00020000);
        const __amdgpu_buffer_rsrc_t rsI = __builtin_amdgcn_make_buffer_rsrc((void*)(ws + (dir ? WS_ICB : WS_ICF) + ((size_t)b * SEQ * RW + h * 64) * 2), (short)0, (int)(SEQ * RW * 2), 0x00020000);
        const unsigned vl2 = (unsigned)l * 2u;
        const int ch = h * 64 + l; const float* sh = F.in[I_SHIFT];
        const float sr0 = sh[ch], sr1 = sh[RWKV_IN + ch], sr2 = sh[2 * RWKV_IN + ch];
        const float sk0 = sh[2048 + ch], sk1 = sh[RWKV_IN + 2048 + ch], sk2 = sh[2 * RWKV_IN + 2048 + ch];
        const float sv0 = sh[4096 + ch], sv1 = sh[RWKV_IN + 4096 + ch], sv2 = sh[2 * RWKV_IN + 4096 + ch];
        const float kk_c = F.in[I_KK][ch], ka_c = F.in[I_KA][ch], rk_c = F.in[I_RK][ch];
        const int posk = (((l >> 5) * 2 + ((l >> 4) & 1)) * 2 + ((l >> 2) & 1)) * 8 + ((l >> 3) & 1) * 4 + (l & 3);
        unsigned long long sec_acc = 0ull;
#define S2_T() ((SCAN_SEC >= 0) ? __builtin_amdgcn_s_memtime() : 0ull)
        for (int ci = pw; ci < NCH; ci += NPREP) {
            const int slot = ci % NS; LAS unsigned char* P = L + OFF_PKG + slot * PKG_B;
            const unsigned long long ts0 = S2_T();
            const int s_lo = dir ? (SEQ - TC - ci * TC) : ci * TC;
            float rr[18], rk[18], rv[18], wl[16], ic[16];
            { unsigned short ur[18], uk[18], uv[18], uw[16], ui[16];
#pragma unroll
              for (int tau = 0; tau < 18; ++tau) { const int s = s_lo - 1 + tau; const int sc = (tau == 0 && s < 0) ? s_lo : (tau == 17 && s >= SEQ) ? s_lo : s;
                  const unsigned so = (unsigned)sc * (unsigned)(ZR_LD * 2);
                  ur[tau] = __builtin_amdgcn_raw_buffer_load_b16(rsZ, vl2, so, 0); uk[tau] = __builtin_amdgcn_raw_buffer_load_b16(rsZ, vl2, so + 4096u, 0); uv[tau] = __builtin_amdgcn_raw_buffer_load_b16(rsZ, vl2, so + 8192u, 0); }
#pragma unroll
              for (int i = 0; i < 16; ++i) { const int s = dir ? (s_lo + 15 - i) : (s_lo + i); const unsigned so = (unsigned)s * (unsigned)(RW * 2);
                  uw[i] = __builtin_amdgcn_raw_buffer_load_b16(rsW, vl2, so, 0); ui[i] = __builtin_amdgcn_raw_buffer_load_b16(rsI, vl2, so, 0); }
              __builtin_amdgcn_sched_barrier(0);
#pragma unroll
              for (int tau = 0; tau < 18; ++tau) { rr[tau] = bf2f(ur[tau]); rk[tau] = bf2f(uk[tau]); rv[tau] = bf2f(uv[tau]); }
              { const float f0 = (s_lo - 1 >= 0) ? 1.f : 0.f, f17 = (s_lo + 16 < SEQ) ? 1.f : 0.f;
                rr[0] *= f0; rk[0] *= f0; rv[0] *= f0; rr[17] *= f17; rk[17] *= f17; rv[17] *= f17; }
#pragma unroll
              for (int i = 0; i < 16; ++i) { wl[i] = bf2f(uw[i]); ic[i] = bf2f(ui[i]); } }
            float cum[16];
            cum[0] = wl[0];
#pragma unroll
            for (int i = 1; i < 16; ++i) cum[i] = cum[i - 1] + wl[i];
            const unsigned long long tsA = S2_T();
            float rs_[16], ks_[16], vs_[16], q1[16], q2[16];
#pragma unroll
            for (int i = 0; i < 16; ++i) { const int tau = dir ? (16 - i) : (i + 1);
                rs_[i] = sr0 * rr[tau - 1] + sr1 * rr[tau] + sr2 * rr[tau + 1];
                ks_[i] = sk0 * rk[tau - 1] + sk1 * rk[tau] + sk2 * rk[tau + 1];
                vs_[i] = sv0 * rv[tau - 1] + sv1 * rv[tau] + sv2 * rv[tau + 1];
                const float kkr = ks_[i] * kk_c; q1[i] = kkr * kkr; q2[i] = rs_[i] * (ks_[i] * (1.0f + (ic[i] - 1.0f) * ka_c)) * rk_c; }
#define S2_DPPSTEP(CTRL, RM) do { _Pragma("unroll") for (int i = 0; i < 16; ++i) { \
                q1[i] += __builtin_bit_cast(float, __builtin_amdgcn_update_dpp(0, __builtin_bit_cast(int, q1[i]), CTRL, RM, 0xF, false)); \
                q2[i] += __builtin_bit_cast(float, __builtin_amdgcn_update_dpp(0, __builtin_bit_cast(int, q2[i]), CTRL, RM, 0xF, false)); } } while (0)
            S2_DPPSTEP(0xB1, 0xF); S2_DPPSTEP(0x4E, 0xF); S2_DPPSTEP(0x141, 0xF); S2_DPPSTEP(0x140, 0xF);
            __builtin_amdgcn_sched_barrier(0);
            asm volatile("s_nop 1");
#define S2_BCAST(CTRL) do { _Pragma("unroll") for (int i = 0; i < 16; ++i) { \
                asm volatile("v_add_f32_dpp %0, %0, %0 " CTRL " bank_mask:0xf" : "+v"(q1[i])); asm volatile("v_add_f32_dpp %0, %0, %0 " CTRL " bank_mask:0xf" : "+v"(q2[i])); } } while (0)
            S2_BCAST("row_bcast:15 row_mask:0xa"); S2_BCAST("row_bcast:31 row_mask:0xc");
#undef S2_BCAST
            asm volatile("s_nop 1");
            __builtin_amdgcn_sched_barrier(0);
#undef S2_DPPSTEP
            const unsigned long long ts1 = S2_T();
            spin_ge(consumed, ci - NS + 1); spin_ge(consumed + 1, ci - NS + 1);
            const unsigned long long ts2 = S2_T();
            float at[16], bhv[16], khv[16], giv[16]; float pprev = 1.0f; const float pC = __builtin_amdgcn_exp2f(cum[15]);
#pragma unroll
            for (int i = 0; i < 16; ++i) {
                const float r_s = rs_[i], k_s = ks_[i], v_s = vs_[i];
                const float ss = __uint_as_float(__builtin_amdgcn_readlane(__float_as_uint(q1[i]), 63)), bon = __uint_as_float(__builtin_amdgcn_readlane(__float_as_uint(q2[i]), 63));
                const float kk = k_s * kk_c * __builtin_amdgcn_rsqf(ss + 1e-12f);
                const float kd = k_s * (1.0f + (ic[i] - 1.0f) * ka_c); const float bb = kk * ic[i];
                const float p = __builtin_amdgcn_exp2f(cum[i]), pm = pprev, pinv = __builtin_amdgcn_exp2f(-cum[i]), pr = pC * pinv; pprev = p;
                at[i] = -kk * pm;
                lds_st16(P + P_ACAT + i * ROWB + posk * 2, at[i]);
                const float rt = r_s * p;
                lds_st16(P + P_ACAT + (16 + i) * ROWB + posk * 2, rt);
                lds_st16(SC + S_L1 + i * ROWB + posk * 2, bb * pinv); lds_st16(SC + S_L1 + (16 + i) * ROWB + posk * 2, kd * pinv);
                bhv[((i >> 2) & 1) * 8 + (i & 3) + 4 * (i >> 3)] = bb * pr; khv[i] = kd * pr; giv[i] = bon * v_s;
            }
#pragma unroll
            for (int hf = 0; hf < 2; ++hf) {
                *(LAS u32x4*)(P + P_BHAT + l * 32 + hf * 16) = (u32x4){cvt_pk_bf16(bhv[hf * 8 + 0], bhv[hf * 8 + 1]), cvt_pk_bf16(bhv[hf * 8 + 2], bhv[hf * 8 + 3]), cvt_pk_bf16(bhv[hf * 8 + 4], bhv[hf * 8 + 5]), cvt_pk_bf16(bhv[hf * 8 + 6], bhv[hf * 8 + 7])};
                *(LAS u32x4*)(P + P_KHAT + l * 32 + hf * 16) = (u32x4){cvt_pk_bf16(khv[hf * 8 + 0], khv[hf * 8 + 1]), cvt_pk_bf16(khv[hf * 8 + 2], khv[hf * 8 + 3]), cvt_pk_bf16(khv[hf * 8 + 4], khv[hf * 8 + 5]), cvt_pk_bf16(khv[hf * 8 + 6], khv[hf * 8 + 7])};
                *(LAS u32x4*)(P + P_VT + l * 32 + hf * 16) = (u32x4){cvt_pk_bf16(vs_[hf * 8 + 0], vs_[hf * 8 + 1]), cvt_pk_bf16(vs_[hf * 8 + 2], vs_[hf * 8 + 3]), cvt_pk_bf16(vs_[hf * 8 + 4], vs_[hf * 8 + 5]), cvt_pk_bf16(vs_[hf * 8 + 6], vs_[hf * 8 + 7])};
                *(LAS u32x4*)(P + P_GINIT + l * 32 + hf * 16) = (u32x4){cvt_pk_bf16(giv[hf * 8 + 0], giv[hf * 8 + 1]), cvt_pk_bf16(giv[hf * 8 + 2], giv[hf * 8 + 3]), cvt_pk_bf16(giv[hf * 8 + 4], giv[hf * 8 + 5]), cvt_pk_bf16(giv[hf * 8 + 6], giv[hf * 8 + 7])}; }
            *(LAS float*)(P + P_PC + l * 4) = pC;
            LDS_WAIT();
            const unsigned long long ts3 = S2_T();
            f32x16 Z = {};
            { const int r = l & 31, hh = l >> 5;
#pragma unroll
              for (int ks = 0; ks < 4; ++ks) { const bf16x8 fa = *(const LAS bf16x8*)(SC + S_L1 + r * ROWB + (ks * 16 + hh * 8) * 2), fb = *(const LAS bf16x8*)(P + P_ACAT + r * ROWB + (ks * 16 + hh * 8) * 2);
                  Z = __builtin_amdgcn_mfma_f32_32x32x16_bf16(fa, fb, Z, 0, 0, 0); } }
            { const int c = l & 31, hh = l >> 5;
              if (c < 16) {
#pragma unroll
                  for (int r = 0; r < 8; ++r) { const int s = crow(r, hh); *(LAS float*)(SC + S_MF + (c * 16 + s) * 4) = (s < c) ? Z[r] : 0.f; }
#pragma unroll
                  for (int r = 8; r < 16; ++r) { const int s = crow(r, hh) - 16; *(LAS float*)(SC + S_NF + (s * 16 + c) * 4) = (s < c) ? Z[r] : 0.f; }
                  *(LAS u32x4*)(P + P_MRF + l * 16) = (u32x4){0u, 0u, 0u, 0u};
              } else { const int t = c - 16; f32x16 Zm = Z;
#pragma unroll
                  for (int r = 0; r < 8; ++r) { const int s = crow(r, hh); Zm[r] = (s <= t) ? Z[r] : 0.f; }
                  *(LAS bf16x8*)(P + P_MRF + l * 16) = pack_acc8(Zm, 0);
#pragma unroll
                  for (int r = 8; r < 16; ++r) { const int s = crow(r, hh) - 16; lds_st16(P + P_NCAT + c * 32 + s * 2, (s <= t) ? Z[r] : 0.f); }
              } }
            LDS_WAIT();
            const unsigned long long ts4 = S2_T();
            { f32x2 xy[16];
#pragma unroll
              for (int q = 0; q < 4; ++q) { const f32x4 nvv = *(const LAS f32x4*)(SC + S_NF + ((l & 15) * 16 + q * 4) * 4);
                  xy[q * 4 + 0] = (f32x2){at[q * 4 + 0], nvv[0]}; xy[q * 4 + 1] = (f32x2){at[q * 4 + 1], nvv[1]}; xy[q * 4 + 2] = (f32x2){at[q * 4 + 2], nvv[2]}; xy[q * 4 + 3] = (f32x2){at[q * 4 + 3], nvv[3]}; }
              f32x4 mrow[16][4];
#pragma unroll
              for (int t = 1; t < 16; ++t)
#pragma unroll
                  for (int s4 = 0; s4 < (t + 3) / 4; ++s4) mrow[t][s4] = *(const LAS f32x4*)(SC + S_MF + (t * 16 + s4 * 4) * 4);
#pragma unroll
              for (int t = 1; t < 16; ++t) { f32x2 a0 = xy[t], a1 = {0.f, 0.f};
#pragma unroll
                  for (int s = 0; s < t; ++s) { const float m = mrow[t][s >> 2][s & 3]; const f32x2 mm = {m, m}; if (s & 1) a1 += xy[s] * mm; else a0 += xy[s] * mm; }
                  xy[t] = a0 + a1; }
#pragma unroll
              for (int t = 0; t < 16; ++t) lds_st16(P + P_ACAT + t * ROWB + posk * 2, xy[t].x);
              if (l < 16) {
#pragma unroll
                  for (int t = 0; t < 16; ++t) lds_st16(P + P_NCAT + t * 32 + l * 2, xy[t].y); } }
            LDS_WAIT();
            if (l == 0) ready[slot] = ci + 1;
            if (SCAN_SEC >= 0) { const unsigned long long ts5 = S2_T(); sec_acc += SCAN_SEC == 0 ? ts1 - ts0 : SCAN_SEC == 1 ? ts2 - ts1 : SCAN_SEC == 2 ? ts3 - ts2 : SCAN_SEC == 3 ? ts4 - ts3 : SCAN_SEC == 4 ? ts5 - ts4 : SCAN_SEC == 6 ? tsA - ts0 : SCAN_SEC == 7 ? ts1 - tsA : ts5 - ts0; }
        }
        if (SCAN_SEC >= 0 && blockIdx.x == 0 && pw == SCAN_PW && SCAN_SEC != 9 && l == 0) { F.MISC[120] = (unsigned)sec_acc; F.MISC[121] = (unsigned)(sec_acc >> 32); }
    }
    __syncthreads();
}
}

__device__ __forceinline__ void p5_post(Frame& F) {
    const int gw = F.vcu * 8 + F.wave, NGW = F.G * 8, l = F.lane; unsigned char* ws = F.ws;
    const bf16* yf = (const bf16*)(ws + WS_YF); const bf16* yb = (const bf16*)(ws + WS_YB); const bf16* gg = (const bf16*)(ws + WS_G); bf16* o = (bf16*)(ws + WS_ORWKV);
    const float* lg = F.in[I_LNXG]; const float* lb = F.in[I_LNXB];
    for (int t = gw; t < MT; t += NGW) {
        const size_t base = (size_t)t * RW;
#pragma unroll 4
        for (int h = 0; h < RH; ++h) { const int c = h * 64 + l;
            const float y = bf2f(yf[base + c]) + bf2f(yb[base + c]);
            const float mu = wave_sum(y) * (1.f / 64.f); const float d = y - mu; const float var = wave_sum(d * d) * (1.f / 64.f);
            const float yn = d * (1.0f / sqrtf(var + LNX_EPS));
            o[base + c] = f2bf((yn * lg[c] + lb[c]) * bf2f(gg[base + c])); }
    }
}

__device__ __forceinline__ void p8_rowpass(Frame& F) {
    const int gw = F.vcu * 8 + F.wave, NGW = F.G * 8; float* rstd2 = (float*)(F.ws + WS_RSTD) + 3 * MT; bf16* hb = (bf16*)(F.ws + WS_H1B);
    for (int m = gw; m < MT; m += NGW) {
        const f32x4* xr = (const f32x4*)(F.out + (size_t)m * DM) + F.lane; f32x4 v[8]; float s = 0.f;
#pragma unroll
        for (int j = 0; j < 8; ++j) { v[j] = xr[64 * j]; s += (v[j].x * v[j].x + v[j].y * v[j].y) + (v[j].z * v[j].z + v[j].w * v[j].w); }
        s = wave_sum(s); float am = 0.f;
#pragma unroll
        for (int j = 0; j < 8; ++j) am = fmaxf(am, fmaxf(fmaxf(fabsf(v[j].x), fabsf(v[j].y)), fmaxf(fabsf(v[j].z), fabsf(v[j].w))));
#pragma unroll
        for (int o = 32; o >= 1; o >>= 1) am = fmaxf(am, __shfl_xor(am, o));
        am = fmaxf(am, 1e-30f); const float qs = 127.f / am;
        if (F.lane == 0) rstd2[m] = am * (1.f / 127.f) / sqrtf(s * (1.f / DM) + RMS_EPS);
        unsigned* o8 = (unsigned*)((unsigned char*)hb + (size_t)m * DM) + F.lane;
#pragma unroll
        for (int j = 0; j < 8; ++j) o8[64 * j] = pack4_i8(rintf(v[j].x * qs), rintf(v[j].y * qs), rintf(v[j].z * qs), rintf(v[j].w * qs));
    }
}
__device__ __forceinline__ void p12_router(Frame& F) {
    const int gw = F.vcu * 8 + F.wave, NGW = F.G * 8, l = F.lane; unsigned char* ws = F.ws;
    float* rstd3 = (float*)(ws + WS_RSTD) + 4 * MT; bf16* n3 = (bf16*)(ws + WS_N3); const float* WR = (const float*)(ws + WS_WR);
    int* lists = (int*)(ws + WS_LIST); int* route = (int*)(ws + WS_ROUTE); float* slotw = (float*)(ws + WS_SLOTW);
    int* cnt = (int*)(F.ctl + CW_CNT);
    const float* brg = F.in[I_BRG]; const float* bre = F.in[I_BRE];
    LAS float* wl = (LAS float*)(F.lds + 16384);
    LAS float* lgt = (LAS float*)(F.lds + F.wave * 1024);
    for (int tb = F.vcu * 32; tb < MT; tb += F.G * 32) {
        const int t0 = tb + F.wave * 4;
        float ss[4] = {0.f, 0.f, 0.f, 0.f};
#pragma unroll
        for (int q = 0; q < 4; ++q) { const f32x4* xr = (const f32x4*)(F.out + (size_t)(t0 + q) * DM) + l; u32x2* o8 = (u32x2*)(n3 + (size_t)(t0 + q) * DM) + l;
#pragma unroll
            for (int j = 0; j < 8; ++j) { const f32x4 x = xr[64 * j]; ss[q] += (x.x * x.x + x.y * x.y) + (x.z * x.z + x.w * x.w);
                u32x2 w; w.x = cvt_pk_bf16(x.x, x.y); w.y = cvt_pk_bf16(x.z, x.w); o8[64 * j] = w; } }
#pragma unroll
        for (int q = 0; q < 4; ++q) ss[q] = wave_sum(ss[q]);
#pragma unroll 1
        for (int pass = 0; pass < 2; ++pass) {
            const float* x0p = F.out + (size_t)(t0 + 2 * pass) * DM + l; const float* x1p = x0p + DM;
            float acc[2][36];
#pragma unroll
            for (int q = 0; q < 2; ++q)
#pragma unroll
                for (int o = 0; o < 36; ++o) acc[q][o] = 0.f;
#pragma unroll 1
            for (int blk = 0; blk < 8; ++blk) {
                __syncthreads();
                { const f32x4* src4 = (const f32x4*)(WR + (size_t)blk * 256 * 36); LAS f32x4* dst4 = (LAS f32x4*)wl;
#pragma unroll
                  for (int i = 0; i < 5; ++i) { const int idx = F.tid + 512 * i; if (idx < 2304) dst4[idx] = src4[idx]; } }
                __syncthreads();
#pragma unroll
                for (int c4 = 0; c4 < 4; ++c4) { const int cl = l + 64 * c4; const float x0 = x0p[blk * 256 + 64 * c4], x1 = x1p[blk * 256 + 64 * c4];
                    const LAS f32x4* wr = (const LAS f32x4*)(wl + cl * 36);
#pragma unroll
                    for (int o4 = 0; o4 < 9; ++o4) { const f32x4 w = wr[o4];
#pragma unroll
                        for (int k = 0; k < 4; ++k) { acc[0][o4 * 4 + k] += x0 * w[k]; acc[1][o4 * 4 + k] += x1 * w[k]; } } }
            }
#pragma unroll
            for (int q = 0; q < 2; ++q)
#pragma unroll
                for (int o = 0; o < 36; ++o) { const float v = wave_sum(acc[q][o]); if (l == 0) lgt[(2 * pass + q) * 36 + o] = v; }
        }
        LDS_WAIT();
#pragma unroll
        for (int q = 0; q < 4; ++q) { const int t = t0 + q; const float rs = 1.0f / sqrtf(ss[q] * (1.f / DM) + RMS_EPS);
            float lg[4]; float gmax = -3.0e38f; int gsel = 0;
#pragma unroll
            for (int g = 0; g < 4; ++g) { lg[g] = lgt[q * 36 + g] * rs + brg[g]; if (lg[g] > gmax) { gmax = lg[g]; gsel = g; } }
            float gz = 0.f;
#pragma unroll
            for (int g = 0; g < 4; ++g) gz += __expf(lg[g] - gmax);
            const float pg = 1.0f / gz;
            float le[8];
#pragma unroll
            for (int e = 0; e < 8; ++e) { float a = lgt[q * 36 + 4 + e];
#pragma unroll
                for (int g = 1; g < 4; ++g) a = (gsel == g) ? lgt[q * 36 + 4 + g * 8 + e] : a;
                le[e] = a * rs + bre[gsel * 8 + e]; }
            float m1 = -3.0e38f, m2 = -3.0e38f; int e1 = 0, e2 = 0;
#pragma unroll
            for (int e = 0; e < 8; ++e) { if (le[e] > m1) { m2 = m1; e2 = e1; m1 = le[e]; e1 = e; } else if (le[e] > m2) { m2 = le[e]; e2 = e; } }
            const float xe = __expf(m2 - m1); const float w1 = pg / (1.0f + xe), w2 = pg * xe / (1.0f + xe);
            if (l == 0) { rstd3[t] = rs;
                const int E1 = gsel * 8 + e1, E2 = gsel * 8 + e2;
                const int p1 = atomicAdd(cnt + 64 * E1, 1), p2 = atomicAdd(cnt + 64 * E2, 1);
                lists[E1 * MT + p1] = t; lists[E2 * MT + p2] = t; slotw[E1 * MT + p1] = w1; slotw[E2 * MT + p2] = w2;
                route[t * 8 + 0] = E1; route[t * 8 + 1] = p1; route[t * 8 + 2] = E2; route[t * 8 + 3] = p2; }
        }
    }
}
struct MoeOrder {
    static constexpr bool GATHER = true;
    const volatile LAS int* tp; const int* cnt; const int* lists; const char* A; const char* B; int G, c, lognt; size_t bstride_e, bstride_t;
    bool gather;
    __device__ __forceinline__ bool next(int i, Unit& u) const {
        const int L = i * G + c; const int RT = tp[32]; if (L >= (RT << lognt)) return false;
        const int rt = L >> lognt, nt = L & ((1 << lognt) - 1); int e = 0;
        for (int q = 1; q < 32; ++q) e = (rt >= tp[q]) ? q : e;
        u.pm = rt; u.pn = nt; u.aux0 = e; u.aux1 = (rt - tp[e]) * 256;
        u.Ab = A; u.Bb = B + (size_t)e * bstride_e + (size_t)nt * bstride_t; return true;
    }
    __device__ __forceinline__ unsigned arow(const Unit& u, int r) const {
        if (!gather) return (unsigned)(u.pm * 256 + r);
        const int idx = u.aux1 + r; const int n = cnt[64 * u.aux0]; return idx < n ? (unsigned)lists[u.aux0 * MT + idx] : 0u;
    }
};
struct EpiMoe1 {
    static constexpr bool PERM = true;
    bf16* hid; const int* cnt; const int* lists; const float* slotw; const float* rstd;
    __device__ __forceinline__ void operator()(const PG8_ACC, const Unit& u, int wr, int wc, int fr, int fq) const {
        const int n = cnt[64 * u.aux0];
#pragma unroll
        for (int ai = 0; ai < 2; ++ai)
#pragma unroll
            for (int m = 0; m < 4; ++m) { const int r = ai * 128 + wr * 64 + m * 16 + fr; const int idx = u.aux1 + r; const bool ok = idx < n;
                const int tok = ok ? lists[u.aux0 * MT + idx] : 0; const float rs = rstd[tok]; const float wt = ok ? slotw[u.aux0 * MT + idx] : 0.f;
                f32x4 o0, o1;
#pragma unroll
                for (int j = 0; j < 4; ++j) { const float g0 = acc[ai][0][m][0][j] * rs, u0 = acc[ai][1][m][0][j] * rs, g1 = acc[ai][0][m][1][j] * rs, u1 = acc[ai][1][m][1][j] * rs;
                    o0[j] = g0 * sigmoidf_(g0) * u0 * wt; o1[j] = g1 * sigmoidf_(g1) * u1 * wt; }
                *(u32x4*)(hid + (size_t)(u.pm * 256 + r) * DE + u.pn * 128 + wc * 32 + 8 * fq) = pg8::pack8(o0, o1); }
    }
};
struct EpiMoe2 {
    static constexpr bool PERM = true;
    bf16* y;
    __device__ __forceinline__ void operator()(const PG8_ACC, const Unit& u, int wr, int wc, int fr, int fq) const {
        EPI_FOR(ai, m, bj) { const int row = u.pm * 256 + ai * 128 + wr * 64 + m * 16 + fr; const int col = u.pn * 256 + bj * 128 + wc * 32 + 8 * fq;
            *(u32x4*)(y + (size_t)row * DM + col) = pg8::pack8(acc[ai][bj][m][0], acc[ai][bj][m][1]); }
    }
};
__device__ __forceinline__ void moe_table(Frame& F) {
    if (F.tid == 0) { const int* cnt = (const int*)(F.ctl + CW_CNT); int acc = 0;
        for (int e = 0; e < 32; ++e) { F.MISC[16 + e] = (unsigned)acc; acc += (__hip_atomic_load(cnt + 64 * e, __ATOMIC_RELAXED, __HIP_MEMORY_SCOPE_AGENT) + 255) >> 8; }
        F.MISC[16 + 32] = (unsigned)acc; }
    __syncthreads();
}
__device__ __forceinline__ void p5_expert_cvt(Frame& F) {
    LAS float* scr = (LAS float*)(F.lds + F.wave * CVT_SCR); const int gw = F.vcu * 8 + F.wave, NGW = F.G * 8; unsigned char* ws = F.ws;
#define EX_DESC(it_, d) do { const int e = (it_) / 768, r = (it_) % 768; \
        if (r < 256) { d.W = F.in[I_WEG] + (size_t)e * DM * DE; d.gain = F.in[I_GFFN]; d.WT = (bf16*)(ws + WS_WGU) + (size_t)e * 1024 * DM; d.K = DM; d.N = DE; d.ldt = DM; d.mode = 3; d.kofs = 0; d.item = r; d.q = 0; d.cm = 0; } \
        else if (r < 512) { d.W = F.in[I_WEU] + (size_t)e * DM * DE; d.gain = F.in[I_GFFN]; d.WT = (bf16*)(ws + WS_WGU) + (size_t)e * 1024 * DM; d.K = DM; d.N = DE; d.ldt = DM; d.mode = 4; d.kofs = 0; d.item = r - 256; d.q = 0; d.cm = 0; } \
        else { d.W = F.in[I_WED] + (size_t)e * DE * DM; d.gain = nullptr; d.WT = (bf16*)(ws + WS_WD) + (size_t)e * DM * DE; d.K = DE; d.N = DM; d.ldt = DE; d.mode = 0; d.kofs = 0; d.item = r - 512; d.q = 0; d.cm = 0; } } while (0)
    CVT_PIPE(NE * 768, EX_DESC);
#undef EX_DESC
}

struct Args { const float* in[41]; float* out; unsigned char* ws; int ph_lo, ph_hi; };
constexpr int NPHASE = 16;
__global__ void __launch_bounds__(512, 2) fwd_kernel(Args args) {
    extern __shared__ __attribute__((aligned(16))) unsigned char lds_raw[];
    Frame F;
    F.lds = (LAS unsigned char*)lds_raw; F.MISC = (volatile LAS unsigned*)(F.lds + MISC_OFF);
    F.tid = threadIdx.x; F.lane = F.tid & 63; F.wave = __builtin_amdgcn_readfirstlane(F.tid >> 6);
    F.G = gridDim.x; { const int bx = blockIdx.x; F.vcu = (F.G % 8 == 0) ? (bx % 8) * (F.G / 8) + bx / 8 : bx; }
    F.ws = args.ws; F.out = args.out; F.ctl = (unsigned*)(args.ws + WS_CTL);
#pragma unroll
    for (int i = 0; i < 41; ++i) F.in[i] = args.in[i];
    for (int u = F.tid; u < (LDS_BYTES - LDSCTL_OFF) / 4; u += 512) ((LAS unsigned*)(F.lds + LDSCTL_OFF))[u] = 0u;
    __syncthreads();
    XcdBarrier bar; bar.bar = F.ctl + CW_BAR; bar.x = 0; bar.st = nullptr;
    const int lo = args.ph_lo, hi = args.ph_hi;
    if (hi - lo > 1) bar = xcd_barrier_post(F.ctl + CW_BAR, F.MISC + 8);
#ifndef ATT_DQK_TEST
#define ATT_DQK_TEST QKD
#endif
#define PROBE_N (MT * 768)
#ifndef LSEL
#define LSEL 31
#endif
#ifndef PH_MASK
#define PH_MASK 0xFFFFu
#endif
#ifndef SCAN_MFMA
#define SCAN_MFMA 1
#endif
#ifndef SCAN_DUMMY
#define SCAN_DUMMY 0
#endif
#ifndef REPEAT_MASK
#define REPEAT_MASK 0x0u
#endif
#define REP(k) _Pragma("unroll") for (int _rep = 0; _rep <= (int)(((REPEAT_MASK) >> (k)) & 1u); ++_rep)
#define IN(k) ((((PH_MASK) >> (k)) & 1u) && lo <= (k) && (k) < hi)
#ifndef PROBE_TIME
#define PROBE_TIME -1
#endif
#define SEAM(k) do { if (lo <= (k) && (k) + 1 < hi) xcd_barrier(bar); if (PROBE_TIME >= 0 && blockIdx.x == 0 && F.tid == 0) { const unsigned long long _t = wall_clock64(); F.MISC[64 + 2 * ((k) + 1)] = (unsigned)_t; F.MISC[65 + 2 * ((k) + 1)] = (unsigned)(_t >> 32); } } while (0)
    unsigned char* ws = args.ws;

    bf16* const zmla = (bf16*)(ws + WS_ZMLA); bf16* const loraA = (bf16*)(ws + WS_LORAA);
    float* const rstd1 = (float*)(ws + WS_RSTD); float* const rstd_q = rstd1 + MT; float* const rstd_kv = rstd1 + 2 * MT;
    const int bid = (int)blockIdx.x;
    if (PROBE_TIME >= 0 && blockIdx.x == 0 && F.tid == 0) { const unsigned long long _t = wall_clock64(); F.MISC[64] = (unsigned)_t; F.MISC[65] = (unsigned)(_t >> 32); }
    if (IN(0)) { REP(0) { p0_prologue(F); xcd_barrier(bar); p0b_win_i8(F); } }
    SEAM(0);
    if (IN(1)) {
        if (EN_RWKV || EN_MLA) REP(1) { pg8::StaticOrder S; S.init((const bf16*)(ws + WS_XB), DM / 2, (const bf16*)(ws + WS_WIN), DM / 2, MT, G1_N, F.G, bid);
          EpiG1 E{rstd1, zmla, (bf16*)(ws + WS_ZRKV), (bf16*)(ws + WS_ZLORA), (bf16*)(ws + WS_ZGATE), (const float*)(F.ctl + CW_COLMAX)};
          pg8::gemm_phase<EpiG1, pg8::StaticOrder, true>(F.lds, DM / 2, DM / 2, DM / 2, S, E); }
        else p_copy_x(F);
    }
    SEAM(1);
    if (IN(2)) { if (EN_RWKV || EN_MLA) REP(2) p2_rowpass(F); }
    SEAM(2);
    if (IN(3)) REP(3) {
        if (EN_MLA) {
            { pg8::StaticOrder S; S.init(zmla, ZM_LD, (const bf16*)(ws + WS_WUQ), QLORA, MT, MH * QKD, F.G, bid);
              EpiQ E{ws + WS_Q, rstd_q, (const float*)(ws + WS_ROPE)};
              pg8::gemm_phase(F.lds, QLORA, ZM_LD, QLORA, S, E); }
            { pg8::StaticOrder S; S.init(zmla + QLORA, ZM_LD, (const bf16*)(ws + WS_WUKV), KVLORA, MT, MH * 256, F.G, bid);
              EpiKV E{ws + WS_K, (bf16*)(ws + WS_V), rstd_kv};
              pg8::gemm_phase(F.lds, KVLORA, ZM_LD, KVLORA, S, E); }
        }
        if (EN_RWKV) {
            { pg8::StaticOrder S; S.init(loraA, LA_LD, (const bf16*)(ws + WS_W2F), 256, MT, 2 * RW, F.G, bid);
              EpiLora2<0> E{(bf16*)(ws + WS_WLF), (bf16*)(ws + WS_WLB), F.in[I_W0F], F.in[I_W0B]}; pg8::gemm_phase(F.lds, 256, LA_LD, 256, S, E); }
            { pg8::StaticOrder S; S.init(loraA + 256, LA_LD, (const bf16*)(ws + WS_W2F + 2 * MiB), 256, MT, 2 * RW, F.G, bid);
              EpiLora2<1> E{(bf16*)(ws + WS_ICF), (bf16*)(ws + WS_ICB), F.in[I_A0F], F.in[I_A0B]}; pg8::gemm_phase(F.lds, 256, LA_LD, 256, S, E); }
            if (LSEL & 16) { pg8::StaticOrder S; S.init(loraA + 512, LA_LD, (const bf16*)(ws + WS_G2), GLORA, MT, RW, F.G, bid);
              EpiLora<2> E{(bf16*)(ws + WS_G), nullptr}; pg8::gemm_phase(F.lds, GLORA, LA_LD, GLORA, S, E); }
        }
    }
    SEAM(3);
    if (IN(4)) {
        constexpr int NSCAN = NB * RH * 2, NATT = NB * MH * (SEQ / 256);
        int s_begin = F.vcu, s_end = NSCAN, s_step = F.G, a_begin = F.vcu, a_step = F.G, a_cnt = (F.vcu < NATT) ? (NATT - 1 - F.vcu) / F.G + 1 : 0;
        if (EN_RWKV && EN_MLA && F.G == 256) { s_step = 1; a_step = 1;
            if (F.vcu < 128) { s_end = F.vcu + 1; a_begin = 384 + F.vcu; a_cnt = 1; } else { s_end = 0; a_begin = (F.vcu - 128) * 3; a_cnt = 3; } }
        if (EN_RWKV) for (int u = s_begin; u < s_end; u += s_step) { const int dir = u & 1, bh = u >> 1;
            if (dir) scan2::scan_unit<1>(F, bh >> 5, bh & 31); else scan2::scan_unit<0>(F, bh >> 5, bh & 31); }
        if (EN_MLA) for (int i = 0; i < a_cnt; ++i) { const int L = a_begin + i * a_step; const int qb = L & 15, bh = L >> 4, b = bh >> 4, h = bh & 15;
            att::attn_unit_f8<MH * QKD, MH * QKD, MH * VDIM, DM>(ws + WS_Q + ((size_t)(b * SEQ + qb * 256) * (MH * QKD) + h * QKD),
                                ws + WS_K + ((size_t)b * SEQ * (MH * QKD) + h * QKD),
                                (const bf16*)(ws + WS_V) + ((size_t)b * SEQ * (MH * VDIM) + h * VDIM),
                                (bf16*)(ws + WS_OMLA) + ((size_t)(b * SEQ + qb * 256) * DM + h * VDIM), SEQ, QSCALE, (LAS char*)F.lds); }
    }
    SEAM(4);
    if (IN(5)) { if (EN_RWKV) REP(5) p5_post(F); if (EN_MOE) REP(17) p5_expert_cvt(F); }
    SEAM(5);
    if (IN(6)) REP(6) {
        if (EN_MLA) { pg8::StaticOrder S; S.init((const bf16*)(ws + WS_OMLA), DM, (const bf16*)(ws + WS_WUPM), DM, MT, DM, F.G, bid);
            EpiUp<0> E{(bf16*)(ws + WS_MERGED), (const bf16*)(ws + WS_ZGATE), 0}; pg8::gemm_phase(F.lds, DM, DM, DM, S, E); }
        if (EN_RWKV) { pg8::StaticOrder S; S.init((const bf16*)(ws + WS_ORWKV), DM, (const bf16*)(ws + WS_WUPR), DM, MT, DM, F.G, bid);
            EpiUp<EN_MLA> E{(bf16*)(ws + WS_MERGED), (const bf16*)(ws + WS_ZGATE), DM}; pg8::gemm_phase(F.lds, DM, DM, DM, S, E); }
    }
    SEAM(6);
    if (IN(7)) REP(7) {
        if (EN_RWKV || EN_MLA) { pg8::StaticOrder S; S.init((const bf16*)(ws + WS_MERGED), DM, (const bf16*)(ws + WS_WOUT), DM, MT, DM, F.G, bid);
            EpiResid E{F.in[I_X], F.out}; pg8::gemm_phase(F.lds, DM, DM, DM, S, E); }
    }
    SEAM(7);
    if (IN(8)) { if (EN_CROSS || EN_MOE) p8_rowpass(F); }
    SEAM(8);
    if (IN(9)) REP(9) {
        if (EN_CROSS) { pg8::StaticOrder S; S.init((const bf16*)(ws + WS_H1B), DM / 2, (const bf16*)(ws + WS_WQC), DM / 2, MT, CW, F.G, bid);
            EpiPlainI8 E{(bf16*)(ws + WS_QC), CW, rstd1 + 3 * MT, (const float*)F.ctl + CW_CM_QC, CSCALE}; pg8::gemm_phase<EpiPlainI8, pg8::StaticOrder, true>(F.lds, DM / 2, DM / 2, DM / 2, S, E); }
        if (EN_CROSS && bid >= 64) { pg8::StaticOrder S; S.init((const bf16*)(ws + WS_MEMN), DM / 2, (const bf16*)(ws + WS_WKVC), DM / 2, NB * MEMLEN, 2 * CW, F.G, bid - 64);
            EpiPlainI8 E{(bf16*)(ws + WS_KVC), 2 * CW, (const float*)F.ctl + CW_MEMSCALE, (const float*)F.ctl + CW_CM_KVC, 1.f}; pg8::gemm_phase<EpiPlainI8, pg8::StaticOrder, true>(F.lds, DM / 2, DM / 2, DM / 2, S, E); }
    }
    SEAM(9);
    if (IN(10)) REP(10) {
        if (EN_CROSS) {
            for (int i = 0; ; ++i) { const int L = i * F.G + F.vcu; if (L >= NB * CH * (SEQ / 256)) break;
                const int qb = L & 15, bh = L >> 4, b = bh >> 2, h = bh & 3;
                att::attn_unit<CHD, CW, 2 * CW, 2 * CW, CW>((const bf16*)(ws + WS_QC) + ((size_t)(b * SEQ + qb * 256) * CW + h * CHD),
                                    (const bf16*)(ws + WS_KVC) + ((size_t)b * MEMLEN * (2 * CW) + h * CHD),
                                    (const bf16*)(ws + WS_KVC) + ((size_t)b * MEMLEN * (2 * CW) + CW + h * CHD),
                                    (bf16*)(ws + WS_OC) + ((size_t)(b * SEQ + qb * 256) * CW + h * CHD), MEMLEN, (LAS char*)F.lds); }
        }
    }
    SEAM(10);
    if (IN(11)) {
        if (EN_CROSS) { pg8::StaticOrder S; S.init((const bf16*)(ws + WS_OC), CW, (const bf16*)(ws + WS_WOC), CW, MT, DM, F.G, bid);
            EpiResid E{F.out, F.out}; pg8::gemm_phase(F.lds, CW, CW, CW, S, E); }
    }
    SEAM(11);
    if (IN(12)) { if (EN_MOE) p12_router(F); }
    SEAM(12);
    if (IN(13)) REP(13) {
        if (EN_MOE) { moe_table(F);
            MoeOrder S{(const volatile LAS int*)(F.MISC + 16), (const int*)(F.ctl + CW_CNT), (const int*)(ws + WS_LIST), (const char*)(ws + WS_N3), (const char*)(ws + WS_WGU), F.G, F.vcu, 2,
                       (size_t)1024 * DM * 2, (size_t)256 * DM * 2, true};
            EpiMoe1 E{(bf16*)(ws + WS_HID), (const int*)(F.ctl + CW_CNT), (const int*)(ws + WS_LIST), (const float*)(ws + WS_SLOTW), rstd1 + 4 * MT};
            pg8::gemm_phase(F.lds, DM, DM, DM, S, E); }
    }
    SEAM(13);
    if (IN(14)) REP(14) {
        if (EN_MOE) { moe_table(F);
            MoeOrder S{(const volatile LAS int*)(F.MISC + 16), (const int*)(F.ctl + CW_CNT), (const int*)(ws + WS_LIST), (const char*)(ws + WS_HID), (const char*)(ws + WS_WD), F.G, F.vcu, 3,
                       (size_t)DM * DE * 2, (size_t)256 * DE * 2, false};
            EpiMoe2 E{(bf16*)(ws + WS_YBUF)};
            pg8::gemm_phase(F.lds, DE, DE, DE, S, E); }
    }
    SEAM(14);
#ifdef PROBE_OFF
    if (IN(15)) { const int gt = F.vcu * 512 + F.tid, NGT = F.G * 512; const bf16* sb = (const bf16*)(ws + (size_t)PROBE_OFF * MiB);
        for (int i = gt; i < MT * DM; i += NGT) F.out[i] = (i < PROBE_N) ? bf2f(sb[i]) : 0.f; }
#else
    if (IN(15)) { { int t_ = threadIdx.x; asm volatile("" : "+v"(t_)); F.tid = t_; F.lane = t_ & 63; }
        p_final(F, EN_MOE != 0); }
#endif
    if (SCAN_SEC == 20) { if (blockIdx.x == 0 && F.wave == 0) { const float e = att::f8_map_probe(F.lane); if (F.lane == 0) F.out[(size_t)(F.vcu * 8) * DM] += 10.f + e; } }
    if (SCAN_SEC >= 0 && SCAN_SEC < 20) { __syncthreads(); if (blockIdx.x == 0 && F.tid == 0) { const unsigned long long c = ((unsigned long long)F.MISC[121] << 32) | F.MISC[120]; F.out[(size_t)(F.vcu * 8) * DM] += (float)c * 1e-4f; } }
    if (PROBE_TIME >= 0) { __syncthreads(); if (blockIdx.x == 0 && F.tid == 0) {
        const unsigned long long a = ((unsigned long long)F.MISC[65 + 2 * PROBE_TIME] << 32) | F.MISC[64 + 2 * PROBE_TIME], b = ((unsigned long long)F.MISC[65 + 2 * (PROBE_TIME + 1)] << 32) | F.MISC[64 + 2 * (PROBE_TIME + 1)];
        F.out[(size_t)(F.vcu * 8) * DM] += (float)(b - a) * 0.001f; } }
#undef IN
#undef SEAM
}

extern "C" void kernel_launch(void* const* d_in, const int* in_sizes, int n_in, void* d_out, int out_size, void* d_ws, size_t ws_size, hipStream_t stream) {
    static int grid = 0;
    if (grid == 0) {
        if (n_in != 41 || out_size != MT * DM || ws_size < WS_END) { fprintf(stderr, "kernel_launch: unexpected shapes n_in %d out %d ws %zu (need %zu)\n", n_in, out_size, ws_size, (size_t)WS_END); grid = -1; return; }
        int dev = 0, cus = 0, per_cu = 0;
        if (hipGetDevice(&dev) != hipSuccess || hipDeviceGetAttribute(&cus, hipDeviceAttributeMultiprocessorCount, dev) != hipSuccess) { grid = -1; return; }
        if (hipFuncSetAttribute((const void*)fwd_kernel, hipFuncAttributeMaxDynamicSharedMemorySize, LDS_BYTES) != hipSuccess) { fprintf(stderr, "kernel_launch: hipFuncSetAttribute failed\n"); grid = -1; return; }
        if (hipOccupancyMaxActiveBlocksPerMultiprocessor(&per_cu, (const void*)fwd_kernel, 512, LDS_BYTES) != hipSuccess || per_cu < 1) { fprintf(stderr, "kernel_launch: occupancy query says %d\n", per_cu); }
        (void)hipGetLastError();
        grid = cus;
    }
    if (grid < 0) return;
    (void)hipMemsetAsync((char*)d_ws + WS_CTL, 0, CTL_BYTES, stream);
    Args a{};
    for (int i = 0; i < 41; ++i) a.in[i] = (const float*)d_in[i];
    a.out = (float*)d_out; a.ws = (unsigned char*)d_ws;
#if N_LAUNCH_SPLIT
    for (int p = 0; p < NPHASE; ++p) { a.ph_lo = p; a.ph_hi = p + 1; hipLaunchKernelGGL(fwd_kernel, dim3(grid), dim3(512), LDS_BYTES, stream, a); }
#else
    a.ph_lo = 0; a.ph_hi = NPHASE;
    hipLaunchKernelGGL(fwd_kernel, dim3(grid), dim3(512), LDS_BYTES, stream, a);
#endif
}
```

```cpp
#include <hip/hip_runtime.h>
#include <cstdio>
#include <cstdint>

#ifndef SCAN_PW
#define SCAN_PW 0
#endif
#ifndef SCAN_SEC
#define SCAN_SEC -1
#endif
#ifndef EN_RWKV
#define EN_RWKV 1
#endif
#ifndef EN_MLA
#define EN_MLA 1
#endif
#ifndef EN_CROSS
#define EN_CROSS 1
#endif
#ifndef EN_MOE
#define EN_MOE 1
#endif
#ifndef N_LAUNCH_SPLIT
#define N_LAUNCH_SPLIT 0
#endif

#define GAS __attribute__((address_space(1)))
#define LAS __attribute__((address_space(3)))
typedef unsigned short bf16;
typedef short bf16x8 __attribute__((ext_vector_type(8)));
typedef short s16x4 __attribute__((ext_vector_type(4)));
typedef float f32x4 __attribute__((ext_vector_type(4)));
typedef float f32x2 __attribute__((ext_vector_type(2)));
typedef float f32x16 __attribute__((ext_vector_type(16)));
typedef unsigned u32x4 __attribute__((ext_vector_type(4)));
typedef unsigned u32x2 __attribute__((ext_vector_type(2)));

constexpr int DM = 2048, NB = 2, SEQ = 4096, MT = NB * SEQ;
constexpr int MEMLEN = 256;
constexpr int QLORA = 512, KVLORA = 256, ROPE = 64, NOPE = 128, VDIM = 128, QKD = 192, MH = 16;
constexpr int RW = 2048, RH = 32, RHD = 64, DLORA = 96, GLORA = 256;
constexpr int MLA_IN = 832, RWKV_IN = 6784, GATE_IN = 4096, IN_W = MLA_IN + RWKV_IN + GATE_IN;
constexpr int CH = 4, CHD = 128, CW = 512;
constexpr int NG = 4, EPG = 8, NE = 32, DE = 512;
constexpr float RMS_EPS = 1e-6f, LNX_EPS = 64e-5f;
constexpr int G1_N = 12032;
constexpr int ZM_LD = 1024, ZR_LD = 6144, ZL_LD = 768, ZG_LD = 4096, LA_LD = 768;
constexpr int MOE_SLOTS = 2 * MT + NE * 256;

constexpr size_t MiB = 1u << 20;
constexpr size_t WS_CTL = 0, CTL_BYTES = 1 * MiB;
constexpr size_t WS_WUQ = 1 * MiB;
constexpr size_t WS_WUKV = 4 * MiB;
constexpr size_t WS_W2F = 6 * MiB;
constexpr size_t WS_G2 = 10 * MiB;
constexpr size_t WS_WUPM = 11 * MiB, WS_WUPR = 19 * MiB, WS_WOUT = 27 * MiB;
constexpr size_t WS_WQC = 35 * MiB;
constexpr size_t WS_WKVC = 37 * MiB;
constexpr size_t WS_WOC = 41 * MiB;
constexpr size_t WS_WIN = 43 * MiB;
constexpr size_t WS_MISC = 90 * MiB;
constexpr size_t WS_ROPE = WS_MISC;
constexpr size_t WS_MEMN = WS_MISC + 2 * MiB;
constexpr size_t WS_KVC = WS_MISC + 4 * MiB;
constexpr size_t WS_RSTD = WS_MISC + 5 * MiB;
constexpr size_t WS_WR = WS_RSTD + 256 * 1024;
constexpr size_t WS_LIST = WS_MISC + 6 * MiB;
constexpr size_t WS_ROUTE = WS_MISC + 7 * MiB;
constexpr size_t WS_SLOTW = WS_MISC + 8 * MiB;
constexpr size_t WS_XB = 100 * MiB;
constexpr size_t WS_ZMLA = 132 * MiB;
constexpr size_t WS_ZLORA = 148 * MiB;
constexpr size_t WS_LORAA = 160 * MiB;
constexpr size_t WS_ZRKV = 172 * MiB;
constexpr size_t WS_ZGATE = 268 * MiB;
constexpr size_t WS_Q = 332 * MiB;
constexpr size_t WS_K = 380 * MiB;
constexpr size_t WS_V = 428 * MiB;
constexpr size_t WS_WLF = 460 * MiB, WS_WLB = 492 * MiB, WS_ICF = 524 * MiB, WS_ICB = 556 * MiB;
constexpr size_t WS_G = 588 * MiB;
constexpr size_t WS_END = 620 * MiB;
constexpr size_t WS_YF = WS_WIN, WS_YB = WS_ZMLA, WS_ORWKV = WS_Q, WS_MERGED = WS_K, WS_QC = WS_V, WS_OC = WS_V + 8 * MiB;
constexpr size_t WS_WGU = WS_WLF, WS_WD = WS_ZRKV, WS_HID = WS_ZGATE, WS_YBUF = WS_Q;
constexpr size_t WS_OMLA = WS_XB, WS_H1B = WS_XB, WS_N3 = WS_XB;

constexpr int CW_BAR = 4096;
constexpr int CW_CM_QC = 45056, CW_CM_KVC = 45568, CW_MEMSCALE = 47104;
constexpr int CW_ROWS_RWKV = 49152, CW_CM_UPR = 57344;
constexpr int CW_COLMAX = 32768;
constexpr size_t WS_TMP_WIN = WS_ZRKV, WS_TMP_WQC = WS_ZGATE, WS_TMP_WKVC = WS_ZGATE + 2 * MiB, WS_TMP_WUPR = WS_ZGATE + 6 * MiB;
constexpr int CW_CNT = 16384;

constexpr int RING_BYTES = 159744;
constexpr int LDSCTL_OFF = RING_BYTES, MISC_OFF = LDSCTL_OFF + 320;
constexpr int LDS_BYTES = 161792;

#define LDS_WAIT() asm volatile("s_waitcnt lgkmcnt(0)" ::: "memory")
#define VM_WAIT() asm volatile("s_waitcnt vmcnt(0)" ::: "memory")
typedef __bf16 bf16x2_t __attribute__((ext_vector_type(2)));
__device__ __forceinline__ unsigned cvt_pk_bf16(float lo, float hi) { f32x2 v = {lo, hi}; bf16x2_t b = __builtin_convertvector(v, bf16x2_t); return __builtin_bit_cast(unsigned, b); }
__device__ __forceinline__ float bf2f(unsigned short b) { return __builtin_bit_cast(float, ((unsigned)b) << 16); }
__device__ __forceinline__ float bflo(unsigned w) { return __builtin_bit_cast(float, w << 16); }
__device__ __forceinline__ float bfhi(unsigned w) { return __builtin_bit_cast(float, w & 0xffff0000u); }
__device__ __forceinline__ unsigned short f2bf(float f) { return (unsigned short)(cvt_pk_bf16(f, 0.f) & 0xffffu); }
__device__ __forceinline__ float sigmoidf_(float x) { return __builtin_amdgcn_rcpf(1.0f + __builtin_amdgcn_exp2f(-1.4426950408889634f * x)); }
template <int CTRL> __device__ __forceinline__ float dpp_add_(float v) {
    return v + __builtin_bit_cast(float, __builtin_amdgcn_update_dpp(0, __builtin_bit_cast(int, v), CTRL, 0xF, 0xF, false));
}
__device__ __forceinline__ float wave_sum(float v) {
    v = dpp_add_<0xB1>(v); v = dpp_add_<0x4E>(v); v = dpp_add_<0x141>(v); v = dpp_add_<0x140>(v);
    const int iv = __builtin_bit_cast(int, v);
    const float s0 = __builtin_bit_cast(float, __builtin_amdgcn_readlane(iv, 0)), s1 = __builtin_bit_cast(float, __builtin_amdgcn_readlane(iv, 16));
    const float s2 = __builtin_bit_cast(float, __builtin_amdgcn_readlane(iv, 32)), s3 = __builtin_bit_cast(float, __builtin_amdgcn_readlane(iv, 48));
    return (s0 + s1) + (s2 + s3);
}

#define XB_TMO      128
#define XB_XCNT(j)  (256  + 64 * (j))
#define XB_XSUB(j)  (1280 + 64 * (j))
#define XB_XGEN(j)  (2304 + 64 * (j))
#define XB_TOP      3328
#define XB_TOPGEN   3392
#define XCD_BAR_WORDS 3456
#define XB_SPIN_CAP (1u << 18)
__device__ __forceinline__ unsigned xb_ld(unsigned* p)              { return __hip_atomic_load(p, __ATOMIC_RELAXED, __HIP_MEMORY_SCOPE_AGENT); }
__device__ __forceinline__ unsigned xb_add(unsigned* p, unsigned v) { return __hip_atomic_fetch_add(p, v, __ATOMIC_RELAXED, __HIP_MEMORY_SCOPE_AGENT); }
__device__ __forceinline__ unsigned xb_xcc_id() { return (unsigned)__builtin_amdgcn_s_getreg((3 << 11) | 20) & 0xFu; }
#define XB_SPIN(cond, bar) do { unsigned _sp = 0; while (cond) { __builtin_amdgcn_s_sleep(1); \
    if ((++_sp & 255u) == 0u) { if (xb_ld(&(bar)[XB_TMO])) break; if (_sp > XB_SPIN_CAP) { atomicAdd(&(bar)[XB_TMO], 1u); break; } } } } while (0)
struct XcdBarrier { unsigned* bar; unsigned x; volatile LAS unsigned* st; };
__device__ __forceinline__ XcdBarrier xcd_barrier_post(unsigned* bar, volatile LAS unsigned* st) {
    XcdBarrier b; b.bar = bar; b.x = xb_xcc_id(); b.st = st;
    if (threadIdx.x == 0) (void)xb_add(&bar[XB_XCNT(b.x)], 1u);
    return b;
}
__device__ __forceinline__ void xcd_barrier_complete(unsigned* bar, unsigned x, unsigned& nloc, unsigned& nx) {
    const unsigned G = gridDim.x * gridDim.y * gridDim.z;
    unsigned sum, cnt, mine, sp = 0u;
    for (;;) {
        sum = 0u; cnt = 0u; mine = 0u;
#pragma unroll
        for (unsigned j = 0; j < 16; ++j) { const unsigned c = xb_ld(&bar[XB_XCNT(j)]); sum += c; cnt += (c > 0u) ? 1u : 0u; mine = (j == x) ? c : mine; }
        if (sum == G) break;
        __builtin_amdgcn_s_sleep(1);
        if ((++sp & 255u) == 0u) { if (xb_ld(&bar[XB_TMO])) break; if (sp > XB_SPIN_CAP) { atomicAdd(&bar[XB_TMO], 1u); break; } }
    }
    nloc = mine > 0u ? mine : 1u; nx = cnt > 0u ? cnt : 1u;
}
__device__ __forceinline__ void xcd_barrier(const XcdBarrier& b) {
    asm volatile("s_waitcnt vmcnt(0)" ::: "memory");
    __syncthreads();
    if (threadIdx.x == 0) {
        unsigned* bar = b.bar;
        __builtin_amdgcn_s_waitcnt(0);
        unsigned nloc = b.st[0], nx = b.st[1];
        if (nloc == 0u) { xcd_barrier_complete(bar, b.x, nloc, nx); b.st[0] = nloc; b.st[1] = nx; }
        const unsigned old = xb_add(&bar[XB_XSUB(b.x)], 1u);
        const unsigned gen = old / nloc;
        if (old + 1u == (gen + 1u) * nloc) {
            __builtin_amdgcn_fence(__ATOMIC_RELEASE, "agent");
            asm volatile("s_waitcnt vmcnt(0)" ::: "memory");
            const unsigned og = xb_add(&bar[XB_TOP], 1u);
            const unsigned tg = og / nx;
            if (og + 1u == (tg + 1u) * nx) xb_add(&bar[XB_TOPGEN], 1u);
            else XB_SPIN(xb_ld(&bar[XB_TOPGEN]) == tg, bar);
            __builtin_amdgcn_fence(__ATOMIC_ACQUIRE, "agent");
            xb_add(&bar[XB_XGEN(b.x)], 1u);
            asm volatile("s_waitcnt vmcnt(0)" ::: "memory");
        } else {
            XB_SPIN(xb_ld(&bar[XB_XGEN(b.x)]) == gen, bar);
            __builtin_amdgcn_fence(__ATOMIC_ACQUIRE, "agent");
            asm volatile("s_waitcnt vmcnt(0)" ::: "memory");
        }
    }
    __syncthreads();
}

namespace pg8 {
constexpr int BM = 256, BK = 64, HALF = 128, HTB = HALF * BK * 2, STAGE_BYTES = 8 * HTB, NXCD = 8, WGM = 8;
__host__ __device__ __forceinline__ int lds_byte(int r, int c) { const int st = (r >> 4) * 2 + (c >> 5), rr = r & 15, cc = c & 31, ob = rr * 64 + cc * 2; return st * 1024 + (ob ^ (((ob >> 9) & 1) << 5)); }
__host__ __device__ __forceinline__ void stage_rc(int b, int& R, int& C) { const int st = b / 1024, sb = b % 1024, swz = sb ^ (((sb >> 9) & 1) << 5); R = (st >> 1) * 16 + swz / 64; C = (st & 1) * 32 + (swz % 64) / 2; }
__host__ __device__ __forceinline__ int perm32(int rho) { const int n = rho >> 4, i = rho & 15; return 8 * (i >> 2) + 4 * n + (i & 3); }

struct Unit { int pm, pn; const char* Ab; const char* Bb; int aux0, aux1; };

struct StaticOrder {
    static constexpr bool GATHER = false;
    int nM, nN, nwg, G, c; const char* A; const char* Bt; int lda, ldb;
    __device__ void init(const bf16* A_, int lda_, const bf16* Bt_, int ldb_, int M, int N, int G_, int c_) { A = (const char*)A_; Bt = (const char*)Bt_; lda = lda_; ldb = ldb_; nM = M / BM; nN = N / BM; nwg = nM * nN; G = G_; c = c_; }
    __device__ __forceinline__ bool next(int i, Unit& u) const {
        const long L = (long)i * G + c; if (L >= nwg) return false;
        int wgid = (int)L; { const int q = nwg / NXCD, r = nwg % NXCD, xcd = wgid % NXCD, off = wgid / NXCD; wgid = (xcd < r ? xcd * (q + 1) : r * (q + 1) + (xcd - r) * q) + off; }
        const int nig = WGM * nN, gid = wgid / nig, fm = gid * WGM, gsz = (nM - fm) < WGM ? (nM - fm) : WGM;
        u.pm = fm + ((wgid % nig) % gsz); u.pn = (wgid % nig) / gsz; u.Ab = A + (size_t)u.pm * BM * lda * 2; u.Bb = Bt + (size_t)u.pn * BM * ldb * 2; u.aux0 = 0; u.aux1 = 0; return true;
    }
    __device__ __forceinline__ unsigned arow(const Unit& u, int r) const { return (unsigned)r; }
};

#define PG8_ACC f32x4 (&acc)[2][2][4][2]
typedef int i32x4g __attribute__((ext_vector_type(4)));
template <class Epi, class Sched, bool I8 = false>
__device__ __forceinline__ void gemm_phase(LAS unsigned char* lds, const int K, const int lda, const int ldb, const Sched& S, const Epi& E) {
    const int tid = threadIdx.x, wid = __builtin_amdgcn_readfirstlane(tid >> 6), lane = tid & 63, wr = wid >> 2, wc = wid & 3, fr = lane & 15, fq = lane >> 4;
    const int nt = K / BK;
    int sR[2], sC[2]; unsigned voffB[2];
#pragma unroll
    for (int i = 0; i < 2; ++i) { stage_rc(tid * 16 + i * 8192, sR[i], sC[i]); const int Rb = Epi::PERM ? ((sR[i] & ~31) + perm32(sR[i] & 31)) : sR[i];
        voffB[i] = (unsigned)(Rb * ldb + sC[i]) * 2u; }
    const size_t kstep = (size_t)(BK * 2);
    const size_t hstepB = (size_t)HALF * ldb * 2;
    const unsigned ldsw = (unsigned)wid * 1024u;
    const int aoff = lds_byte(wr * 64 + fr, fq * 8), boff = lds_byte(wc * 32 + fr, fq * 8);
#define PG8_SA(b, h) (((b) * 2 + (h)) * HTB)
#define PG8_SB(b, h) ((4 + (b) * 2 + (h)) * HTB)
#define PG8_STAGE(bufoff, gbase, voff) do { _Pragma("unroll") for (int _i = 0; _i < 2; ++_i) \
        __builtin_amdgcn_global_load_lds((const unsigned*)((const char*)(gbase) + (voff)[_i]), (LAS unsigned*)(lds + (bufoff) + ldsw + _i * 8192), 16, 0, 0); } while (0)
#define PG8_LDA(dst, b, h) do { _Pragma("unroll") for (int m = 0; m < 4; ++m) _Pragma("unroll") for (int k = 0; k < 2; ++k) dst[m][k] = *(const LAS bf16x8*)(lds + PG8_SA(b, h) + aoff + m * 2048 + k * 1024); } while (0)
#define PG8_LDB(dst, b, h) do { _Pragma("unroll") for (int n = 0; n < 2; ++n) _Pragma("unroll") for (int k = 0; k < 2; ++k) dst[n][k] = *(const LAS bf16x8*)(lds + PG8_SB(b, h) + boff + n * 2048 + k * 1024); } while (0)
#define PG8_MMA(ai, bj, At, Bt) do { __builtin_amdgcn_s_setprio(1); _Pragma("unroll") for (int m = 0; m < 4; ++m) _Pragma("unroll") for (int n = 0; n < 2; ++n) _Pragma("unroll") for (int k = 0; k < 2; ++k) { \
        if constexpr (I8) acc[ai][bj][m][n] = __builtin_bit_cast(f32x4, __builtin_amdgcn_mfma_i32_16x16x64_i8(__builtin_bit_cast(i32x4g, Bt[n][k]), __builtin_bit_cast(i32x4g, At[m][k]), __builtin_bit_cast(i32x4g, acc[ai][bj][m][n]), 0, 0, 0)); \
        else acc[ai][bj][m][n] = __builtin_amdgcn_mfma_f32_16x16x32_bf16(Bt[n][k], At[m][k], acc[ai][bj][m][n], 0, 0, 0); } __builtin_amdgcn_s_setprio(0); } while (0)
#define PG8_WAIT_V(n) asm volatile("s_waitcnt vmcnt(" #n ")" ::: "memory")
#define PG8_WAIT_L(n) asm volatile("s_waitcnt lgkmcnt(" #n ")" ::: "memory")
#define PG8_BAR __builtin_amdgcn_s_barrier()
#define PG8_SCHED __builtin_amdgcn_sched_barrier(0)
#define PG8_SETVA(dst, u) do { _Pragma("unroll") for (int _h = 0; _h < 2; ++_h) _Pragma("unroll") for (int _i = 0; _i < 2; ++_i) \
        dst[_h][_i] = (S.arow(u, _h * HALF + sR[_i]) * (unsigned)lda + (unsigned)sC[_i]) * 2u; } while (0)
    Unit cur, nxt; int ui = 0;
    if (!S.next(0, cur)) return;
    f32x4 acc[2][2][4][2];
#pragma unroll
    for (int a = 0; a < 2; ++a)
#pragma unroll
        for (int b = 0; b < 2; ++b)
#pragma unroll
            for (int m = 0; m < 4; ++m)
#pragma unroll
                for (int n = 0; n < 2; ++n) acc[a][b][m][n] = (f32x4){0.f, 0.f, 0.f, 0.f};
    bf16x8 At[4][2], B0[2][2], B1[2][2];
    constexpr bool GA = Sched::GATHER;
    unsigned vA[2][2], nvA[2][2];
    PG8_SETVA(vA, cur);
    const char* cA = cur.Ab; const char* cB = cur.Bb;
    PG8_STAGE(PG8_SB(0, 0), cB, voffB); PG8_STAGE(PG8_SA(0, 0), cA, vA[0]); PG8_STAGE(PG8_SB(0, 1), cB + hstepB, voffB); PG8_STAGE(PG8_SA(0, 1), cA, vA[1]);
    if (wr == 1) PG8_BAR;
    PG8_WAIT_V(4); PG8_BAR;
    PG8_STAGE(PG8_SB(1, 0), cB + kstep, voffB); PG8_STAGE(PG8_SA(1, 0), cA + kstep, vA[0]); PG8_STAGE(PG8_SB(1, 1), cB + hstepB + kstep, voffB);
    PG8_WAIT_V(6); PG8_BAR;
    for (;;) {
        const bool has_next = S.next(ui + 1, nxt);
        const char* nA = cA; const char* nB = cB;
        if (has_next) { nA = nxt.Ab; nB = nxt.Bb; if (GA) PG8_SETVA(nvA, nxt); }
        else if (GA) {
#pragma unroll
            for (int h = 0; h < 2; ++h)
#pragma unroll
                for (int i = 0; i < 2; ++i) nvA[h][i] = vA[h][i]; }
#pragma unroll 1
        for (int t = 0; t < nt; t += 2) {
            const bool last = (t == nt - 2);
            const char* a1 = cA + (size_t)(t + 1) * kstep;
            const char* a2 = last ? nA : cA + (size_t)(t + 2) * kstep; const char* b2 = last ? nB : cB + (size_t)(t + 2) * kstep;
            const char* a3 = a2 + kstep; const char* b3 = b2 + kstep;
            unsigned s2[2][2];
#pragma unroll
            for (int h = 0; h < 2; ++h)
#pragma unroll
                for (int i = 0; i < 2; ++i) s2[h][i] = (GA && last) ? nvA[h][i] : vA[h][i];
            PG8_LDB(B0, 0, 0); PG8_SCHED; PG8_LDA(At, 0, 0); PG8_STAGE(PG8_SA(1, 1), a1, vA[1]);
            PG8_WAIT_L(8); PG8_BAR; PG8_WAIT_L(0); PG8_MMA(0, 0, At, B0); PG8_BAR; PG8_SCHED;
            PG8_LDB(B1, 0, 1); PG8_STAGE(PG8_SB(0, 0), b2, voffB);
            PG8_BAR; PG8_WAIT_L(0); PG8_MMA(0, 1, At, B1); PG8_BAR;
            PG8_LDA(At, 0, 1); PG8_STAGE(PG8_SA(0, 0), a2, s2[0]);
            PG8_BAR; PG8_WAIT_L(0); PG8_MMA(1, 0, At, B0); PG8_BAR; PG8_SCHED;
            PG8_STAGE(PG8_SB(0, 1), b2 + hstepB, voffB);
            PG8_WAIT_V(6); PG8_BAR; PG8_MMA(1, 1, At, B1); PG8_BAR;
            PG8_LDB(B0, 1, 0); PG8_SCHED; PG8_LDA(At, 1, 0); PG8_STAGE(PG8_SA(0, 1), a2, s2[1]);
            PG8_WAIT_L(8); PG8_BAR; PG8_WAIT_L(0); PG8_MMA(0, 0, At, B0); PG8_BAR; PG8_SCHED;
            PG8_LDB(B1, 1, 1); PG8_STAGE(PG8_SB(1, 0), b3, voffB);
            PG8_BAR; PG8_WAIT_L(0); PG8_MMA(0, 1, At, B1); PG8_BAR;
            PG8_LDA(At, 1, 1); PG8_STAGE(PG8_SA(1, 0), a3, s2[0]);
            PG8_BAR; PG8_WAIT_L(0); PG8_MMA(1, 0, At, B0); PG8_BAR; PG8_SCHED;
            PG8_STAGE(PG8_SB(1, 1), b3 + hstepB, voffB);
            PG8_WAIT_V(6); PG8_BAR; PG8_MMA(1, 1, At, B1); PG8_BAR;
        }
        { int fr_e = fr, fq_e = fq; asm volatile("" : "+v"(fr_e), "+v"(fq_e));
          E(acc, cur, wr, wc, fr_e, fq_e); }
        if (!has_next) break;
#pragma unroll
        for (int a = 0; a < 2; ++a)
#pragma unroll
            for (int b = 0; b < 2; ++b)
#pragma unroll
                for (int m = 0; m < 4; ++m)
#pragma unroll
                    for (int n = 0; n < 2; ++n) acc[a][b][m][n] = (f32x4){0.f, 0.f, 0.f, 0.f};
        cur = nxt; cA = nA; cB = nB; ++ui;
        if (GA) {
#pragma unroll
        for (int h = 0; h < 2; ++h)
#pragma unroll
            for (int i = 0; i < 2; ++i) vA[h][i] = nvA[h][i]; }
    }
    PG8_WAIT_V(0);
    if (wr == 0) PG8_BAR;
    PG8_BAR;
#undef PG8_SA
#undef PG8_SB
#undef PG8_STAGE
#undef PG8_LDA
#undef PG8_LDB
#undef PG8_MMA
#undef PG8_WAIT_V
#undef PG8_WAIT_L
#undef PG8_BAR
#undef PG8_SCHED
#undef PG8_SETVA
}
#define EPI_FOR(ai, m, bj) _Pragma("unroll") for (int ai = 0; ai < 2; ++ai) _Pragma("unroll") for (int m = 0; m < 4; ++m) _Pragma("unroll") for (int bj = 0; bj < 2; ++bj)
__device__ __forceinline__ u32x4 pack8(f32x4 v0, f32x4 v1) { u32x4 w; w.x = cvt_pk_bf16(v0[0], v0[1]); w.y = cvt_pk_bf16(v0[2], v0[3]); w.z = cvt_pk_bf16(v1[0], v1[1]); w.w = cvt_pk_bf16(v1[2], v1[3]); return w; }
}
using pg8::Unit;

struct EpiG1 {
    static constexpr bool PERM = true;
    const float* rstd; bf16 *zmla, *zrkv, *zlora, *zgate; const float* cmax;
    __device__ __forceinline__ void operator()(const PG8_ACC, const Unit& u, int wr, int wc, int fr, int fq) const {
        bf16* base; int ld, c0;
        if (u.pn < 4) { base = zmla; ld = ZM_LD; c0 = u.pn * 256; } else if (u.pn < 28) { base = zrkv; ld = ZR_LD; c0 = (u.pn - 4) * 256; }
        else if (u.pn < 31) { base = zlora; ld = ZL_LD; c0 = (u.pn - 28) * 256; } else { base = zgate; ld = ZG_LD; c0 = (u.pn - 31) * 256; }
        const int col0 = c0 + wc * 32 + 8 * fq;
        f32x4 cs[2][2];
#pragma unroll
        for (int bj = 0; bj < 2; ++bj) { const float* cp = cmax + u.pn * 256 + bj * 128 + wc * 32 + 8 * fq; cs[bj][0] = *(const f32x4*)cp * (1.0f / 127.0f); cs[bj][1] = *(const f32x4*)(cp + 4) * (1.0f / 127.0f); }
        EPI_FOR(ai, m, bj) { const int row = u.pm * 256 + ai * 128 + wr * 64 + m * 16 + fr; const float rs = rstd[row];
            const f32x4 v0 = __builtin_convertvector(__builtin_bit_cast(pg8::i32x4g, acc[ai][bj][m][0]), f32x4) * rs * cs[bj][0], v1 = __builtin_convertvector(__builtin_bit_cast(pg8::i32x4g, acc[ai][bj][m][1]), f32x4) * rs * cs[bj][1];
            *(u32x4*)(base + (size_t)row * ld + col0 + bj * 128) = pg8::pack8(v0, v1); }
    }
};
struct EpiPlain {
    static constexpr bool PERM = true;
    bf16* O; int ld; const float* rstd; float scale;
    __device__ __forceinline__ void operator()(const PG8_ACC, const Unit& u, int wr, int wc, int fr, int fq) const {
        const int col0 = u.pn * 256 + wc * 32 + 8 * fq;
        EPI_FOR(ai, m, bj) { const int row = u.pm * 256 + ai * 128 + wr * 64 + m * 16 + fr; const float rs = (rstd ? rstd[row] : 1.f) * scale;
            *(u32x4*)(O + (size_t)row * ld + col0 + bj * 128) = pg8::pack8(acc[ai][bj][m][0] * rs, acc[ai][bj][m][1] * rs); }
    }
};
struct EpiPlainI8 {
    static constexpr bool PERM = true;
    bf16* O; int ld; const float* rows; const float* cmax; float scale;
    __device__ __forceinline__ void operator()(const PG8_ACC, const Unit& u, int wr, int wc, int fr, int fq) const {
        const int col0 = u.pn * 256 + wc * 32 + 8 * fq; f32x4 cs[2][2];
#pragma unroll
        for (int bj = 0; bj < 2; ++bj) { const float* cp = cmax + col0 + bj * 128; cs[bj][0] = *(const f32x4*)cp * (scale / 127.0f); cs[bj][1] = *(const f32x4*)(cp + 4) * (scale / 127.0f); }
        EPI_FOR(ai, m, bj) { const int row = u.pm * 256 + ai * 128 + wr * 64 + m * 16 + fr; const float rs = rows[row];
            const f32x4 v0 = __builtin_convertvector(__builtin_bit_cast(pg8::i32x4g, acc[ai][bj][m][0]), f32x4) * rs * cs[bj][0], v1 = __builtin_convertvector(__builtin_bit_cast(pg8::i32x4g, acc[ai][bj][m][1]), f32x4) * rs * cs[bj][1];
            *(u32x4*)(O + (size_t)row * ld + col0 + bj * 128) = pg8::pack8(v0, v1); }
    }
};
constexpr float QSCALE = 0.07216878364870322f * 1.4426950408889634f;
constexpr float CSCALE = 0.08838834764831845f * 1.4426950408889634f;
__device__ __forceinline__ u32x2 pack8_fp8(f32x4 v0, f32x4 v1) {
    int a = __builtin_amdgcn_cvt_pk_fp8_f32(v0[0], v0[1], 0, false); a = __builtin_amdgcn_cvt_pk_fp8_f32(v0[2], v0[3], a, true);
    int b = __builtin_amdgcn_cvt_pk_fp8_f32(v1[0], v1[1], 0, false); b = __builtin_amdgcn_cvt_pk_fp8_f32(v1[2], v1[3], b, true);
    return (u32x2){(unsigned)a, (unsigned)b};
}
struct EpiQ {
    static constexpr bool PERM = true;
    unsigned char* Q; const float* rstd; const float* cs;
    __device__ __forceinline__ void operator()(const PG8_ACC, const Unit& u, int wr, int wc, int fr, int fq) const {
        EPI_FOR(ai, m, bj) { const int row = u.pm * 256 + ai * 128 + wr * 64 + m * 16 + fr; const int col = u.pn * 256 + bj * 128 + wc * 32 + 8 * fq;
            const float rs = rstd[row]; f32x4 v0 = acc[ai][bj][m][0] * rs, v1 = acc[ai][bj][m][1] * rs;
            const int cih = col % QKD;
            if (cih >= NOPE) { const int i0 = (cih - NOPE) >> 1; const f32x4* t = (const f32x4*)(cs + ((size_t)row * 32 + i0) * 2);
                const f32x4 a = t[0], b = t[1];
                f32x4 r0, r1;
                r0[0] = v0[0] * a[0] - v0[1] * a[1]; r0[1] = v0[1] * a[0] + v0[0] * a[1]; r0[2] = v0[2] * a[2] - v0[3] * a[3]; r0[3] = v0[3] * a[2] + v0[2] * a[3];
                r1[0] = v1[0] * b[0] - v1[1] * b[1]; r1[1] = v1[1] * b[0] + v1[0] * b[1]; r1[2] = v1[2] * b[2] - v1[3] * b[3]; r1[3] = v1[3] * b[2] + v1[2] * b[3];
                v0 = r0; v1 = r1; }
            *(u32x2*)(Q + (size_t)row * (MH * QKD) + col) = pack8_fp8(v0, v1); }
    }
};
struct EpiKV {
    static constexpr bool PERM = true;
    unsigned char* Kb; bf16* Vb; const float* rstd;
    __device__ __forceinline__ void operator()(const PG8_ACC, const Unit& u, int wr, int wc, int fr, int fq) const {
        const int c = wc * 32 + 8 * fq;
        EPI_FOR(ai, m, bj) { const int row = u.pm * 256 + ai * 128 + wr * 64 + m * 16 + fr; const float rs = rstd[row];
            if (bj == 0) *(u32x2*)(Kb + (size_t)row * (MH * QKD) + u.pn * QKD + c) = pack8_fp8(acc[ai][bj][m][0] * rs, acc[ai][bj][m][1] * rs);
            else *(u32x4*)(Vb + (size_t)row * (MH * VDIM) + u.pn * VDIM + c) = pg8::pack8(acc[ai][bj][m][0] * rs, acc[ai][bj][m][1] * rs); }
    }
};
template <int MODE> struct EpiLora {
    static constexpr bool PERM = true;
    bf16* O; const float* bias;
    __device__ __forceinline__ void operator()(const PG8_ACC, const Unit& u, int wr, int wc, int fr, int fq) const {
        EPI_FOR(ai, m, bj) { const int row = u.pm * 256 + ai * 128 + wr * 64 + m * 16 + fr; const int col = u.pn * 256 + bj * 128 + wc * 32 + 8 * fq;
            f32x4 v0 = acc[ai][bj][m][0], v1 = acc[ai][bj][m][1];
            if (MODE != 2) { const f32x4 b0 = *(const f32x4*)(bias + col), b1 = *(const f32x4*)(bias + col + 4);
#pragma unroll
                for (int j = 0; j < 4; ++j) { float s0 = sigmoidf_(v0[j] + b0[j]), s1 = sigmoidf_(v1[j] + b1[j]);
                    if (MODE == 0) { s0 *= -0.8750394f; s1 *= -0.8750394f; }
                    v0[j] = s0; v1[j] = s1; } }
            *(u32x4*)(O + (size_t)row * RW + col) = pg8::pack8(v0, v1); }
    }
};
template <int MODE> struct EpiLora2 {
    static constexpr bool PERM = true;
    bf16* O0; bf16* O1; const float* bias0; const float* bias1;
    __device__ __forceinline__ void operator()(const PG8_ACC, const Unit& u, int wr, int wc, int fr, int fq) const {
        const bool second = u.pn >= 8; bf16* O = second ? O1 : O0; const float* bias = second ? bias1 : bias0; const int pn = second ? u.pn - 8 : u.pn;
        EPI_FOR(ai, m, bj) { const int row = u.pm * 256 + ai * 128 + wr * 64 + m * 16 + fr; const int col = pn * 256 + bj * 128 + wc * 32 + 8 * fq;
            f32x4 v0 = acc[ai][bj][m][0], v1 = acc[ai][bj][m][1];
            const f32x4 b0 = *(const f32x4*)(bias + col), b1 = *(const f32x4*)(bias + col + 4);
#pragma unroll
            for (int j = 0; j < 4; ++j) { float s0 = sigmoidf_(v0[j] + b0[j]), s1 = sigmoidf_(v1[j] + b1[j]);
                if (MODE == 0) { s0 *= -0.8750394f; s1 *= -0.8750394f; }
                v0[j] = s0; v1[j] = s1; }
            *(u32x4*)(O + (size_t)row * RW + col) = pg8::pack8(v0, v1); }
    }
};
template <int SECOND, bool I8 = false> struct EpiUp {
    static constexpr bool PERM = true;
    bf16* O; const bf16* zg; int goff; const float* rows; const float* cmax;
    __device__ __forceinline__ void operator()(const PG8_ACC, const Unit& u, int wr, int wc, int fr, int fq) const {
        EPI_FOR(ai, m, bj) { const int row = u.pm * 256 + ai * 128 + wr * 64 + m * 16 + fr; const int col = u.pn * 256 + bj * 128 + wc * 32 + 8 * fq;
            const u32x4 g = *(const u32x4*)(zg + (size_t)row * ZG_LD + goff + col);
            f32x4 v0 = acc[ai][bj][m][0], v1 = acc[ai][bj][m][1];
            if (I8) { const float rs = rows[row] * (1.0f / 127.0f); const f32x4 c0 = *(const f32x4*)(cmax + col), c1 = *(const f32x4*)(cmax + col + 4);
                v0 = __builtin_convertvector(__builtin_bit_cast(pg8::i32x4g, v0), f32x4) * rs * c0; v1 = __builtin_convertvector(__builtin_bit_cast(pg8::i32x4g, v1), f32x4) * rs * c1; }
            v0[0] *= sigmoidf_(bflo(g.x)); v0[1] *= sigmoidf_(bfhi(g.x)); v0[2] *= sigmoidf_(bflo(g.y)); v0[3] *= sigmoidf_(bfhi(g.y));
            v1[0] *= sigmoidf_(bflo(g.z)); v1[1] *= sigmoidf_(bfhi(g.z)); v1[2] *= sigmoidf_(bflo(g.w)); v1[3] *= sigmoidf_(bfhi(g.w));
            bf16* dst = O + (size_t)row * DM + col;
            if (SECOND) { const u32x4 p = *(const u32x4*)dst;
                v0[0] += bflo(p.x); v0[1] += bfhi(p.x); v0[2] += bflo(p.y); v0[3] += bfhi(p.y); v1[0] += bflo(p.z); v1[1] += bfhi(p.z); v1[2] += bflo(p.w); v1[3] += bfhi(p.w); }
            *(u32x4*)dst = pg8::pack8(v0, v1); }
    }
};
struct EpiResid {
    static constexpr bool PERM = true;
    const float* base; float* out;
    __device__ __forceinline__ void operator()(const PG8_ACC, const Unit& u, int wr, int wc, int fr, int fq) const {
        EPI_FOR(ai, m, bj) { const int row = u.pm * 256 + ai * 128 + wr * 64 + m * 16 + fr; const int col = u.pn * 256 + bj * 128 + wc * 32 + 8 * fq;
            const size_t o = (size_t)row * DM + col; const f32x4 b0 = *(const f32x4*)(base + o), b1 = *(const f32x4*)(base + o + 4);
            *(f32x4*)(out + o) = b0 + acc[ai][bj][m][0]; *(f32x4*)(out + o + 4) = b1 + acc[ai][bj][m][1]; }
    }
};

namespace att {
constexpr int NW = 8, QBLK = 32, KVBLK = 64;
constexpr float THRL = 11.5f;
#define SBAR() __builtin_amdgcn_sched_barrier(0)
__device__ __forceinline__ int crow(int r, int hi) { return (r & 3) + 8 * (r >> 2) + 4 * hi; }
template <bool SCALED = false> __device__ __forceinline__ void partialSM(f32x16& p, float& m_reg, float& alpha, const float sc = 1.f) {
    float pmax = p[0];
#pragma unroll
    for (int r = 1; r < 16; ++r) pmax = fmaxf(pmax, p[r]);
    { auto rr = __builtin_amdgcn_permlane32_swap(__float_as_uint(pmax), __float_as_uint(pmax), false, false);
      pmax = fmaxf(__uint_as_float(rr[0]), __uint_as_float(rr[1])); }
    if (SCALED) pmax *= sc;
    float mn;
    if (__builtin_expect(__all(pmax - m_reg <= THRL), 1)) { mn = m_reg; alpha = 1.f; }
    else { mn = fmaxf(m_reg, pmax); alpha = __builtin_amdgcn_exp2f(m_reg - mn); m_reg = mn; }
#pragma unroll
    for (int r = 0; r < 16; ++r) p[r] = SCALED ? __builtin_fmaf(p[r], sc, -mn) : p[r] - mn;
#pragma unroll
    for (int r = 0; r < 8; ++r) p[r] = __builtin_amdgcn_exp2f(p[r]);
}
__device__ __forceinline__ void finishSM(f32x16& p, float alpha, float& l_reg, bf16x8& pa0, bf16x8& pa1) {
#pragma unroll
    for (int r = 8; r < 16; ++r) p[r] = __builtin_amdgcn_exp2f(p[r]);
    float ps = 0;
#pragma unroll
    for (int r = 0; r < 16; ++r) ps += p[r];
    { auto rr = __builtin_amdgcn_permlane32_swap(__float_as_uint(ps), __float_as_uint(ps), false, false);
      ps = __uint_as_float(rr[0]) + __uint_as_float(rr[1]); }
    l_reg = l_reg * alpha + ps;
#define PK4(P, BASE, OUT) do { unsigned a0 = cvt_pk_bf16(P[BASE + 0], P[BASE + 1]), a1 = cvt_pk_bf16(P[BASE + 2], P[BASE + 3]);   \
    unsigned b0 = cvt_pk_bf16(P[BASE + 4], P[BASE + 5]), b1 = cvt_pk_bf16(P[BASE + 6], P[BASE + 7]);                              \
    auto r0 = __builtin_amdgcn_permlane32_swap(a0, b0, false, false); auto r1 = __builtin_amdgcn_permlane32_swap(a1, b1, false, false); \
    u32x4 w = {r0[0], r1[0], r0[1], r1[1]}; OUT = *reinterpret_cast<bf16x8*>(&w); } while (0)
    PK4(p, 0, pa0); PK4(p, 8, pa1);
#undef PK4
}
template <int DQK> __device__ __forceinline__ int kswz(int row, int colB) { return row * (DQK * 2 + 16) + colB; }
template <int DQK> __device__ __forceinline__ void qkt(f32x16& p, const LAS char* Ks, const bf16x8* qr, int krow, int hi) {
    p = f32x16{};
#pragma unroll
    for (int d0 = 0; d0 < DQK / 16; ++d0) { const int cb = (d0 * 16 + hi * 8) * 2;
        bf16x8 b0 = *reinterpret_cast<const LAS bf16x8*>(Ks + kswz<DQK>(krow, cb));
        p = __builtin_amdgcn_mfma_f32_32x32x16_bf16(b0, qr[d0], p, 0, 0, 0); }
}
__device__ __forceinline__ int v_st(int k, int c) { const int kk = (k & ~0xC) | ((k & 4) << 1) | ((k & 8) >> 1); return ((kk >> 3) * 4 + (c >> 5)) * 512 + ((kk & 7) * 32 + (c & 31)) * 2; }
__device__ __forceinline__ int v_rd_base(int lane) { return ((lane & 3) << 3) | (((lane >> 2) & 3) << 6) | (((lane >> 4) & 1) << 5) | (((lane >> 5) & 1) << 8); }
constexpr int v_rd_off(int d0, int ks, int half) { return d0 * 512 + ks * 4096 + half * 2048; }
template <int OFF> __device__ __forceinline__ s16x4 tr_read(int vb) {
    s16x4 r; asm volatile("ds_read_b64_tr_b16 %0, %1 offset:%2" : "=&v"(r) : "v"(vb), "i"(OFF) : "memory"); return r;
}
template <int D0, int KH> __device__ __forceinline__ void pv_one(f32x16& od, int vb, bf16x8 pa0, bf16x8 pa1) {
    const s16x4 l0 = tr_read<v_rd_off(D0, 2 * KH, 0)>(vb), h0 = tr_read<v_rd_off(D0, 2 * KH, 1)>(vb), l1 = tr_read<v_rd_off(D0, 2 * KH + 1, 0)>(vb), h1 = tr_read<v_rd_off(D0, 2 * KH + 1, 1)>(vb);
    asm volatile("s_waitcnt lgkmcnt(0)" ::: "memory"); SBAR();
#define PK(L, H) (bf16x8){L[0], L[1], L[2], L[3], H[0], H[1], H[2], H[3]}
    od = __builtin_amdgcn_mfma_f32_32x32x16_bf16(pa0, PK(l0, h0), od, 0, 0, 0);
    od = __builtin_amdgcn_mfma_f32_32x32x16_bf16(pa1, PK(l1, h1), od, 0, 0, 0);
#undef PK
}
template <int KH> __device__ __forceinline__ void pv_d0(f32x16* o, int vb, bf16x8 pa0, bf16x8 pa1) {
    pv_one<0, KH>(o[0], vb, pa0, pa1); pv_one<1, KH>(o[1], vb, pa0, pa1); pv_one<2, KH>(o[2], vb, pa0, pa1); pv_one<3, KH>(o[3], vb, pa0, pa1);
}
template <int DQK, int LDQ, int LDK, int LDV, int LDO>
__device__ __forceinline__ void attn_unit(const bf16* __restrict__ Qb, const bf16* __restrict__ Kh, const bf16* __restrict__ Vh, bf16* __restrict__ Ob, const int seq, LAS char* lds) {
    constexpr int SHM_V = KVBLK * 128 * 2, SHM_K = KVBLK * (DQK * 2 + 16), KCH = DQK / 64;
    const int tid = threadIdx.x, wid = tid >> 6, lane = tid & 63, r32 = lane & 31, hi = lane >> 5;
    LAS char* V_lds = lds; LAS char* K_lds = lds + 2 * SHM_V;
    LAS float* wsf = (LAS float*)(lds + 2 * SHM_V + 2 * SHM_K) + wid * 64; LAS float* li_l = wsf; LAS float* al_l = wsf + 32;
    float m_reg = -1e30f, l_reg = 0; f32x16 o[4] = {}; bf16x8 qr[DQK / 16];
    const bf16* Qw = Qb + (long)(wid * QBLK + r32) * LDQ + hi * 8;
#pragma unroll
    for (int d0 = 0; d0 < DQK / 16; ++d0) qr[d0] = *reinterpret_cast<const bf16x8*>(Qw + d0 * 16);
    const int sr = tid >> 4, sc = (tid & 15) * 8, vst0 = v_st(sr, sc), vst1 = v_st(32 + sr, sc);
    unsigned kgo[KCH]; int klo[KCH];
#pragma unroll
    for (int i = 0; i < KCH; ++i) { const int id = tid + 512 * i, row = id / (DQK / 8), c8 = id % (DQK / 8); kgo[i] = (unsigned)(row * LDK + c8 * 8) * 2u; klo[i] = kswz<DQK>(row, c8 * 16); }
    const unsigned vgo0 = (unsigned)(sr * LDV + sc) * 2u, vgo1 = (unsigned)((32 + sr) * LDV + sc) * 2u;
    const int vb0 = (int)(uintptr_t)V_lds + v_rd_base(lane);
    bf16x8 vs0, vs1, ks[KCH];
#define SLOAD(k0) do { const char* _vt = (const char*)(Vh + (size_t)(k0) * LDV); const char* _kt = (const char*)(Kh + (size_t)(k0) * LDK); \
    vs0 = *reinterpret_cast<const bf16x8*>(_vt + vgo0); vs1 = *reinterpret_cast<const bf16x8*>(_vt + vgo1); \
    _Pragma("unroll") for (int _i = 0; _i < KCH; ++_i) ks[_i] = *reinterpret_cast<const bf16x8*>(_kt + kgo[_i]); } while (0)
#define SWRITE(b) do { *(LAS bf16x8*)(V_lds + (b) * SHM_V + vst0) = vs0; *(LAS bf16x8*)(V_lds + (b) * SHM_V + vst1) = vs1; \
    _Pragma("unroll") for (int _i = 0; _i < KCH; ++_i) *(LAS bf16x8*)(K_lds + (b) * SHM_K + klo[_i]) = ks[_i]; } while (0)
#define SWAIT() asm volatile("s_waitcnt vmcnt(0)" ::: "memory")
#define RESC(a) do { if (__any((a) < 1.f)) { if (hi == 0) al_l[r32] = (a); asm volatile("s_waitcnt lgkmcnt(0)" ::: "memory"); \
    _Pragma("unroll") for (int d = 0; d < 4; ++d) _Pragma("unroll") for (int r = 0; r < 16; ++r) o[d][r] *= al_l[crow(r, hi)]; } } while (0)
    f32x16 pA, pB; float alA, alB; bf16x8 pa0, pa1; const int NT = seq / KVBLK;
    SLOAD(0); SWAIT(); SWRITE(0); __syncthreads();
    if (1 < NT) SLOAD(KVBLK);
    qkt<DQK>(pA, K_lds, qr, r32, hi); partialSM(pA, m_reg, alA);
    if (1 < NT) { SWAIT(); SWRITE(1); } __syncthreads();
    if (2 < NT) SLOAD(2 * KVBLK);
    SBAR(); qkt<DQK>(pB, K_lds, qr, 32 + r32, hi);
    finishSM(pA, alA, l_reg, pa0, pa1); SBAR();
    pv_d0<0>(o, vb0, pa0, pa1); partialSM(pB, m_reg, alB); RESC(alB);
    for (int j = 1; j < NT; ++j) {
        const int cb = j & 1, pb = cb ^ 1;
        SBAR(); qkt<DQK>(pA, K_lds + cb * SHM_K, qr, r32, hi);
        finishSM(pB, alB, l_reg, pa0, pa1); SBAR();
        pv_d0<1>(o, vb0 + pb * SHM_V, pa0, pa1); partialSM(pA, m_reg, alA);
        __syncthreads(); if (j + 1 < NT) { SWAIT(); SWRITE(pb); }
        RESC(alA); __syncthreads();
        if (j + 2 < NT) SLOAD((j + 2) * KVBLK);
        SBAR(); qkt<DQK>(pB, K_lds + cb * SHM_K, qr, 32 + r32, hi);
        finishSM(pA, alA, l_reg, pa0, pa1); SBAR();
        pv_d0<0>(o, vb0 + cb * SHM_V, pa0, pa1); partialSM(pB, m_reg, alB); RESC(alB);
    }
    finishSM(pB, alB, l_reg, pa0, pa1); SBAR();
    pv_d0<1>(o, vb0 + ((NT - 1) & 1) * SHM_V, pa0, pa1);
    if (hi == 0) li_l[r32] = l_reg; asm volatile("s_waitcnt lgkmcnt(0)" ::: "memory");
    float rli[16];
#pragma unroll
    for (int r = 0; r < 16; ++r) rli[r] = __builtin_amdgcn_rcpf(li_l[crow(r, hi)]);
    bf16* Ow = Ob + (size_t)(wid * QBLK) * LDO;
    int r32e = r32, hie = hi; asm volatile("" : "+v"(r32e), "+v"(hie));
    const unsigned ob = (unsigned)(4 * hie * LDO + r32e);
#pragma unroll
    for (int r = 0; r < 16; ++r) {
#pragma unroll
        for (int d0 = 0; d0 < 4; ++d0) Ow[ob + (unsigned)(((r & 3) + 8 * (r >> 2)) * LDO + d0 * 32)] = f2bf(o[d0][r] * rli[r]); }
    __syncthreads();
#undef SLOAD
#undef SWRITE
#undef SWAIT
#undef RESC
}
typedef int i32x8 __attribute__((ext_vector_type(8)));
__device__ __forceinline__ void qkt_f8(f32x16& p, const LAS char* Ks, const i32x8* qr, int krow, int hi) {
    p = f32x16{};
#pragma unroll
    for (int d0 = 0; d0 < 3; ++d0) { const LAS char* a = Ks + krow * 208 + d0 * 64 + hi * 32;
        const u32x4 lo = *reinterpret_cast<const LAS u32x4*>(a), hh = *reinterpret_cast<const LAS u32x4*>(a + 16);
        const i32x8 av = {(int)lo.x, (int)lo.y, (int)lo.z, (int)lo.w, (int)hh.x, (int)hh.y, (int)hh.z, (int)hh.w};
        p = __builtin_amdgcn_mfma_scale_f32_32x32x64_f8f6f4(av, qr[d0], p, 0, 0, 0, 0, 0, 0); }
}
template <int LDQ, int LDK, int LDV, int LDO>
__device__ __forceinline__ void attn_unit_f8(const unsigned char* __restrict__ Qb, const unsigned char* __restrict__ Kh, const bf16* __restrict__ Vh, bf16* __restrict__ Ob, const int seq, const float SC, LAS char* lds) {
    constexpr int SHM_V = KVBLK * 128 * 2, SHM_K = KVBLK * 208;
    const int tid = threadIdx.x, wid = tid >> 6, lane = tid & 63, r32 = lane & 31, hi = lane >> 5;
    LAS char* V_lds = lds; LAS char* K_lds = lds + 2 * SHM_V;
    LAS float* wsf = (LAS float*)(lds + 2 * SHM_V + 2 * SHM_K) + wid * 64; LAS float* li_l = wsf; LAS float* al_l = wsf + 32;
    float m_reg = -1e30f, l_reg = 0; f32x16 o[4] = {}; i32x8 qr[3];
    { const unsigned char* Qw = Qb + (long)(wid * QBLK + r32) * LDQ + hi * 32;
#pragma unroll
      for (int d0 = 0; d0 < 3; ++d0) { const u32x4 lo = *reinterpret_cast<const u32x4*>(Qw + d0 * 64), hh = *reinterpret_cast<const u32x4*>(Qw + d0 * 64 + 16);
          qr[d0] = (i32x8){(int)lo.x, (int)lo.y, (int)lo.z, (int)lo.w, (int)hh.x, (int)hh.y, (int)hh.z, (int)hh.w}; } }
    const int sr = tid >> 4, sc = (tid & 15) * 8, vst0 = v_st(sr, sc), vst1 = v_st(32 + sr, sc);
    const bool k2 = wid < 4;
    const int id0 = tid, id1 = 512 + tid;
    const unsigned kgo0 = (unsigned)((id0 / 12) * LDK + (id0 % 12) * 16), kgo1 = (unsigned)((id1 / 12) * LDK + (id1 % 12) * 16);
    const int klo0 = (id0 / 12) * 208 + (id0 % 12) * 16, klo1 = (id1 / 12) * 208 + (id1 % 12) * 16;
    const unsigned vgo0 = (unsigned)(sr * LDV + sc) * 2u, vgo1 = (unsigned)((32 + sr) * LDV + sc) * 2u;
    const int vb0 = (int)(uintptr_t)V_lds + v_rd_base(lane);
    bf16x8 vs0, vs1; u32x4 ks0, ks1 = {0u, 0u, 0u, 0u};
#define SLOAD(k0) do { const char* _vt = (const char*)(Vh + (size_t)(k0) * LDV); const unsigned char* _kt = Kh + (size_t)(k0) * LDK; \
    vs0 = *reinterpret_cast<const bf16x8*>(_vt + vgo0); vs1 = *reinterpret_cast<const bf16x8*>(_vt + vgo1); \
    ks0 = *reinterpret_cast<const u32x4*>(_kt + kgo0); if (k2) ks1 = *reinterpret_cast<const u32x4*>(_kt + kgo1); } while (0)
#define SWRITE(b) do { *(LAS bf16x8*)(V_lds + (b) * SHM_V + vst0) = vs0; *(LAS bf16x8*)(V_lds + (b) * SHM_V + vst1) = vs1; \
    *(LAS u32x4*)(K_lds + (b) * SHM_K + klo0) = ks0; if (k2) *(LAS u32x4*)(K_lds + (b) * SHM_K + klo1) = ks1; } while (0)
#define SWAIT() asm volatile("s_waitcnt vmcnt(0)" ::: "memory")
#define RESC(a) do { if (__any((a) < 1.f)) { if (hi == 0) al_l[r32] = (a); asm volatile("s_waitcnt lgkmcnt(0)" ::: "memory"); \
    _Pragma("unroll") for (int d = 0; d < 4; ++d) _Pragma("unroll") for (int r = 0; r < 16; ++r) o[d][r] *= al_l[crow(r, hi)]; } } while (0)
    f32x16 pA, pB; float alA, alB; bf16x8 pa0, pa1; const int NT = seq / KVBLK;
    SLOAD(0); SWAIT(); SWRITE(0); __syncthreads();
    if (1 < NT) SLOAD(KVBLK);
    qkt_f8(pA, K_lds, qr, r32, hi); partialSM<true>(pA, m_reg, alA, SC);
    if (1 < NT) { SWAIT(); SWRITE(1); } __syncthreads();
    if (2 < NT) SLOAD(2 * KVBLK);
    SBAR(); qkt_f8(pB, K_lds, qr, 32 + r32, hi);
    finishSM(pA, alA, l_reg, pa0, pa1); SBAR();
    pv_d0<0>(o, vb0, pa0, pa1); partialSM<true>(pB, m_reg, alB, SC); RESC(alB);
    for (int j = 1; j < NT; ++j) {
        const int cb = j & 1, pb = cb ^ 1;
        SBAR(); qkt_f8(pA, K_lds + cb * SHM_K, qr, r32, hi);
        finishSM(pB, alB, l_reg, pa0, pa1); SBAR();
        pv_d0<1>(o, vb0 + pb * SHM_V, pa0, pa1); partialSM<true>(pA, m_reg, alA, SC);
        __syncthreads(); if (j + 1 < NT) { SWAIT(); SWRITE(pb); }
        RESC(alA); __syncthreads();
        if (j + 2 < NT) SLOAD((j + 2) * KVBLK);
        SBAR(); qkt_f8(pB, K_lds + cb * SHM_K, qr, 32 + r32, hi);
        finishSM(pA, alA, l_reg, pa0, pa1); SBAR();
        pv_d0<0>(o, vb0 + cb * SHM_V, pa0, pa1); partialSM<true>(pB, m_reg, alB, SC); RESC(alB);
    }
    finishSM(pB, alB, l_reg, pa0, pa1); SBAR();
    pv_d0<1>(o, vb0 + ((NT - 1) & 1) * SHM_V, pa0, pa1);
    if (hi == 0) li_l[r32] = l_reg; asm volatile("s_waitcnt lgkmcnt(0)" ::: "memory");
    float rli[16];
#pragma unroll
    for (int r = 0; r < 16; ++r) rli[r] = __builtin_amdgcn_rcpf(li_l[crow(r, hi)]);
    bf16* Ow = Ob + (size_t)(wid * QBLK) * LDO;
    int r32e = r32, hie = hi; asm volatile("" : "+v"(r32e), "+v"(hie));
    const unsigned ob = (unsigned)(4 * hie * LDO + r32e);
#pragma unroll
    for (int r = 0; r < 16; ++r) {
#pragma unroll
        for (int d0 = 0; d0 < 4; ++d0) Ow[ob + (unsigned)(((r & 3) + 8 * (r >> 2)) * LDO + d0 * 32)] = f2bf(o[d0][r] * rli[r]); }
    __syncthreads();
#undef SLOAD
#undef SWRITE
#undef SWAIT
#undef RESC
}
__device__ __forceinline__ float f8_map_probe(const int lane) {
    const int r = lane & 31, h = lane >> 5;
    const float am = 1.f + (float)((r >> 2) & 1), bm = 1.f + (float)((r >> 3) & 1);
    i32x8 a, b;
#pragma unroll
    for (int w = 0; w < 8; ++w) { const int k0 = 32 * h + 4 * w; int pa = 0, pb = 0;
        pa = __builtin_amdgcn_cvt_pk_fp8_f32((float)((k0 + 0) & 7) * am, (float)((k0 + 1) & 7) * am, pa, false); pa = __builtin_amdgcn_cvt_pk_fp8_f32((float)((k0 + 2) & 7) * am, (float)((k0 + 3) & 7) * am, pa, true);
        pb = __builtin_amdgcn_cvt_pk_fp8_f32((float)((3 * (k0 + 0) + 1) % 7) * bm, (float)((3 * (k0 + 1) + 1) % 7) * bm, pb, false); pb = __builtin_amdgcn_cvt_pk_fp8_f32((float)((3 * (k0 + 2) + 1) % 7) * bm, (float)((3 * (k0 + 3) + 1) % 7) * bm, pb, true);
        a[w] = pa; b[w] = pb; }
    f32x16 d = {};
    d = __builtin_amdgcn_mfma_scale_f32_32x32x64_f8f6f4(a, b, d, 0, 0, 0, 0, 0, 0);
    float e0 = 0.f;
    for (int k = 0; k < 64; ++k) e0 += (float)(k & 7) * (float)((3 * k + 1) % 7);
    float err = 0.f;
#pragma unroll
    for (int rr = 0; rr < 16; ++rr) { const int row = crow(rr, h), col = r; const float ex = e0 * (1.f + (float)((row >> 2) & 1)) * (1.f + (float)((col >> 3) & 1)); err = fmaxf(err, fabsf(d[rr] - ex)); }
#pragma unroll
    for (int o = 32; o >= 1; o >>= 1) err = fmaxf(err, __shfl_xor(err, o));
    return err;
}
}

struct Frame {
    LAS unsigned char* lds; volatile LAS unsigned* MISC; unsigned* ctl;
    int tid, lane, wave, vcu, G;
    unsigned char* ws; float* out;
    const float* in[41];
};
enum { I_X = 0, I_MEM, I_POS, I_GMIX, I_WIN, I_GQ, I_WUQ, I_GKV, I_WUKV, I_SHIFT, I_W0F, I_W2F, I_W0B, I_W2B, I_A0F, I_A2F, I_A0B, I_A2B, I_G2, I_KK, I_KA, I_RK,
       I_LNXG, I_LNXB, I_WUPM, I_WUPR, I_WOUT, I_GCROSS, I_GMEM, I_WQC, I_WKVC, I_WOC, I_GFFN, I_WRG, I_BRG, I_WRE, I_BRE, I_WEG, I_WEU, I_WED, I_GFINAL };

template <int MODE> __device__ __forceinline__ int rowmap(int n) {
    if (MODE == 1) {
        if (n < 768) return n;
        if (n < 832) { const int p = n - 768; return 768 + (p < 32 ? 2 * p : 2 * (p - 32) + 1); }
        if (n < 6976) return 1024 + (n - 832);
        if (n < 7616) return 7168 + (n - 6976);
        return 7936 + (n - 7616);
    }
    if (MODE == 2) {
        const int h = n / QKD, d = n % QKD; if (d < NOPE) return n; const int p = d - NOPE; return h * QKD + NOPE + (p < 32 ? 2 * p : 2 * (p - 32) + 1);
    }
    if (MODE == 3) return (n >> 7) * 256 + (n & 127);
    if (MODE == 4) return (n >> 7) * 256 + 128 + (n & 127);
    return n;
}
constexpr int CVT_SCR = 16640;
template <int MODE> __device__ __forceinline__ void cvt_item(const float* W, int K, int N, const float* gain, bf16* WT, int ldt, LAS float* scr, int item, int lane, int kofs = 0) {
    const int nblk = N / 64, kb = item / nblk, nb = item % nblk, k0 = 64 * kb, n0 = 64 * nb;
    const int kq = lane >> 4, nc = (lane & 15) * 4;
    f32x4 v[16];
#pragma unroll
    for (int i = 0; i < 16; ++i) { const int k = k0 + 4 * i + kq - kofs; v[i] = (f32x4){0.f, 0.f, 0.f, 0.f};
        if (k >= 0 && k < K) { v[i] = *(const f32x4*)(W + (size_t)k * N + n0 + nc); if (gain) v[i] = v[i] * gain[k]; } }
#pragma unroll
    for (int i = 0; i < 16; ++i) { const int kk = 4 * i + kq;
#pragma unroll
        for (int c = 0; c < 4; ++c) scr[(nc + c) * 65 + kk] = v[i][c]; }
    LDS_WAIT(); asm volatile("" ::: "memory");
    const int kc = (lane & 7) * 8;
#pragma unroll
    for (int jj = 0; jj < 8; ++jj) { const int n = (lane >> 3) + 8 * jj; const LAS float* s = scr + n * 65 + kc;
        u32x4 o; o.x = cvt_pk_bf16(s[0], s[1]); o.y = cvt_pk_bf16(s[2], s[3]); o.z = cvt_pk_bf16(s[4], s[5]); o.w = cvt_pk_bf16(s[6], s[7]);
        *(u32x4*)(WT + (size_t)rowmap<MODE>(n0 + n) * ldt + k0 + kc) = o; }
    LDS_WAIT(); asm volatile("" ::: "memory");
}
#define CVT_JOB(MODE, src, K, N, gain, dst, ldt) { const int _n = (((K) + 63) / 64) * ((N) / 64); if (r < _n) { cvt_item<MODE>(src, K, N, gain, dst, ldt, scr, r, F.lane); continue; } r -= _n; }
#define CVT_JOB_PAD(src, K, N, dst, KPAD, KOFS) { const int _n = ((KPAD) / 64) * ((N) / 64); if (r < _n) { cvt_item<0>(src, K, N, nullptr, dst, KPAD, scr, r, F.lane, KOFS); continue; } r -= _n; }
struct CvtD { const float* W; const float* gain; bf16* WT; int K, N, ldt, mode, kofs, item, q, cm; };
__device__ __forceinline__ unsigned pack4_i8(float a, float b, float c, float d) { const int i0 = (int)a, i1 = (int)b, i2 = (int)c, i3 = (int)d; return (unsigned)(i0 & 255) | ((unsigned)(i1 & 255) << 8) | ((unsigned)(i2 & 255) << 16) | ((unsigned)i3 << 24); }
__device__ __forceinline__ int rowmap_rt(int mode, int n) { return mode == 1 ? rowmap<1>(n) : mode == 2 ? rowmap<2>(n) : mode == 3 ? rowmap<3>(n) : mode == 4 ? rowmap<4>(n) : n; }
__device__ __forceinline__ void cvt_load(const CvtD& d, int lane, f32x4 (&v)[16], float (&g)[16]) {
    const int nblk = d.N / 64, kb = d.item / nblk, nb = d.item % nblk, k0 = 64 * kb, n0 = 64 * nb; const int kq = lane >> 4, nc = (lane & 15) * 4;
#pragma unroll
    for (int i = 0; i < 16; ++i) { const int k = k0 + 4 * i + kq - d.kofs; v[i] = (f32x4){0.f, 0.f, 0.f, 0.f}; g[i] = 1.f;
        if (k >= 0 && k < d.K) { v[i] = *(const f32x4*)(d.W + (size_t)k * d.N + n0 + nc); if (d.gain) g[i] = d.gain[k]; } }
}
__device__ __forceinline__ void cvt_process(const CvtD& d, int lane, f32x4 (&v)[16], float (&g)[16], LAS float* scr, const float* colmax) {
    const int nblk = d.N / 64, kb = d.item / nblk, nb = d.item % nblk, k0 = 64 * kb, n0 = 64 * nb; const int kq = lane >> 4, nc = (lane & 15) * 4;
#pragma unroll
    for (int i = 0; i < 16; ++i) { const int kk = 4 * i + kq;
#pragma unroll
        for (int c = 0; c < 4; ++c) scr[(nc + c) * 65 + kk] = v[i][c] * g[i]; }
    LDS_WAIT(); asm volatile("" ::: "memory");
    const int kc = (lane & 7) * 8;
#pragma unroll
    for (int jj = 0; jj < 8; ++jj) { const int n = (lane >> 3) + 8 * jj; const LAS float* s = scr + n * 65 + kc; const int rm = rowmap_rt(d.mode, n0 + n);
        { u32x4 o; o.x = cvt_pk_bf16(s[0], s[1]); o.y = cvt_pk_bf16(s[2], s[3]); o.z = cvt_pk_bf16(s[4], s[5]); o.w = cvt_pk_bf16(s[6], s[7]);
            *(u32x4*)(d.WT + (size_t)rm * d.ldt + k0 + kc) = o; } }
    LDS_WAIT(); asm volatile("" ::: "memory");
}
#define CVT_PIPE(TOTAL_, DESC_) do { CvtD dA, dB; f32x4 vA[16], vB[16]; float gA[16], gB[16]; int it = gw; \
        if (it < (TOTAL_)) { DESC_(it, dA); cvt_load(dA, F.lane, vA, gA); } \
        for (; it < (TOTAL_); it += 2 * NGW) { const int itn = it + NGW, itn2 = it + 2 * NGW; \
            if (itn < (TOTAL_)) { DESC_(itn, dB); cvt_load(dB, F.lane, vB, gB); } \
            cvt_process(dA, F.lane, vA, gA, scr, CVT_COLMAX); \
            if (itn2 < (TOTAL_)) { DESC_(itn2, dA); cvt_load(dA, F.lane, vA, gA); } \
            if (itn < (TOTAL_)) cvt_process(dB, F.lane, vB, gB, scr, CVT_COLMAX); } } while (0)

#define CVT_COLMAX ((const float*)F.ctl)
__device__ __forceinline__ void p0b_quant_rows(Frame& F) {
    const int gw = F.vcu * 8 + F.wave, NGW = F.G * 8, l = F.lane; unsigned char* ws = F.ws; float* ctlf = (float*)F.ctl;
    constexpr int NROWS = G1_N + CW + 2 * CW + DM;
    for (int it = gw; it < NROWS; it += NGW) {
        const unsigned char* src; unsigned char* dst; int cm, r = it;
        if (r < G1_N) { if ((r >= 832 && r < 1024) || (r >= 7808 && r < 7936)) continue;
            src = ws + WS_TMP_WIN; dst = ws + WS_WIN; cm = CW_COLMAX; }
        else if ((r -= G1_N) < CW) { src = ws + WS_TMP_WQC; dst = ws + WS_WQC; cm = CW_CM_QC; }
        else if ((r -= CW) < 2 * CW) { src = ws + WS_TMP_WKVC; dst = ws + WS_WKVC; cm = CW_CM_KVC; }
        else { r -= 2 * CW; src = ws + WS_TMP_WUPR; dst = ws + WS_WUPR; cm = CW_CM_UPR; }
        const u32x4* sp = (const u32x4*)(src + (size_t)r * (DM * 2)) + 4 * l;
        float v[32];
#pragma unroll
        for (int c = 0; c < 4; ++c) { const u32x4 a = sp[c]; v[8 * c + 0] = bflo(a.x); v[8 * c + 1] = bfhi(a.x); v[8 * c + 2] = bflo(a.y); v[8 * c + 3] = bfhi(a.y); v[8 * c + 4] = bflo(a.z); v[8 * c + 5] = bfhi(a.z); v[8 * c + 6] = bflo(a.w); v[8 * c + 7] = bfhi(a.w); }
        float am = 0.f;
#pragma unroll
        for (int e = 0; e < 32; ++e) am = fmaxf(am, fabsf(v[e]));
#pragma unroll
        for (int o = 32; o >= 1; o >>= 1) am = fmaxf(am, __shfl_xor(am, o));
        if (l == 0) ctlf[cm + r] = am;
        const float q = 127.0f / fmaxf(am, 1e-30f);
        u32x4* dp = (u32x4*)(dst + (size_t)r * DM) + 2 * l;
#pragma unroll
        for (int c = 0; c < 2; ++c) dp[c] = (u32x4){pack4_i8(rintf(v[16 * c + 0] * q), rintf(v[16 * c + 1] * q), rintf(v[16 * c + 2] * q), rintf(v[16 * c + 3] * q)), pack4_i8(rintf(v[16 * c + 4] * q), rintf(v[16 * c + 5] * q), rintf(v[16 * c + 6] * q), rintf(v[16 * c + 7] * q)),
                                         pack4_i8(rintf(v[16 * c + 8] * q), rintf(v[16 * c + 9] * q), rintf(v[16 * c + 10] * q), rintf(v[16 * c + 11] * q)), pack4_i8(rintf(v[16 * c + 12] * q), rintf(v[16 * c + 13] * q), rintf(v[16 * c + 14] * q), rintf(v[16 * c + 15] * q))};
    }
}
__device__ __forceinline__ void p0_prologue(Frame& F) {
    LAS float* scr = (LAS float*)(F.lds + F.wave * CVT_SCR);
    const int gw = F.vcu * 8 + F.wave, NGW = F.G * 8;
    unsigned char* ws = F.ws;
    constexpr int TOTAL = 32 * (IN_W / 64) + 8 * 48 + 4 * 64 + 4 * (4 * 32) + 4 * 32 + 3 * (32 * 32) + 32 * 8 + 32 * 16 + 8 * 32;
#define P0_SETD(d, mode_, src_, K_, N_, gain_, dst_, ldt_, KPAD_, KOFS_, Q_, CM_) { const int _n = ((KPAD_) / 64) * ((N_) / 64); if (r < _n) { d.W = src_; d.gain = gain_; d.WT = dst_; d.K = K_; d.N = N_; d.ldt = ldt_; d.mode = mode_; d.kofs = KOFS_; d.item = r; d.q = Q_; d.cm = CM_; break; } r -= _n; }
#define P0_DESC(it_, d) do { int r = (it_); \
        P0_SETD(d, 1, F.in[I_WIN], DM, IN_W, F.in[I_GMIX], (bf16*)(ws + WS_TMP_WIN), DM, DM, 0, 0, 0) \
        P0_SETD(d, 2, F.in[I_WUQ], QLORA, MH * QKD, F.in[I_GQ], (bf16*)(ws + WS_WUQ), QLORA, QLORA, 0, 0, 0) \
        P0_SETD(d, 0, F.in[I_WUKV], KVLORA, MH * 256, F.in[I_GKV], (bf16*)(ws + WS_WUKV), KVLORA, KVLORA, 0, 0, 0) \
        P0_SETD(d, 0, F.in[I_W2F], DLORA, RW, nullptr, (bf16*)(ws + WS_W2F), 256, 256, 0, 0, 0) \
        P0_SETD(d, 0, F.in[I_W2B], DLORA, RW, nullptr, (bf16*)(ws + WS_W2F + 1 * MiB), 256, 256, 128, 0, 0) \
        P0_SETD(d, 0, F.in[I_A2F], DLORA, RW, nullptr, (bf16*)(ws + WS_W2F + 2 * MiB), 256, 256, 0, 0, 0) \
        P0_SETD(d, 0, F.in[I_A2B], DLORA, RW, nullptr, (bf16*)(ws + WS_W2F + 3 * MiB), 256, 256, 128, 0, 0) \
        P0_SETD(d, 0, F.in[I_G2], GLORA, RW, nullptr, (bf16*)(ws + WS_G2), GLORA, GLORA, 0, 0, 0) \
        P0_SETD(d, 0, F.in[I_WUPM], DM, DM, nullptr, (bf16*)(ws + WS_WUPM), DM, DM, 0, 0, 0) \
        P0_SETD(d, 0, F.in[I_WUPR], DM, DM, nullptr, (bf16*)(ws + WS_TMP_WUPR), DM, DM, 0, 0, 0) \
        P0_SETD(d, 0, F.in[I_WOUT], DM, DM, nullptr, (bf16*)(ws + WS_WOUT), DM, DM, 0, 0, 0) \
        P0_SETD(d, 0, F.in[I_WQC], DM, CW, F.in[I_GCROSS], (bf16*)(ws + WS_TMP_WQC), DM, DM, 0, 0, 0) \
        P0_SETD(d, 0, F.in[I_WKVC], DM, 2 * CW, nullptr, (bf16*)(ws + WS_TMP_WKVC), DM, DM, 0, 0, 0) \
        P0_SETD(d, 0, F.in[I_WOC], CW, DM, nullptr, (bf16*)(ws + WS_WOC), CW, CW, 0, 0, 0) \
    } while (0)
    CVT_PIPE(TOTAL, P0_DESC);
#undef P0_SETD
#undef P0_DESC
    const float* x = F.in[I_X]; bf16* xb = (bf16*)(ws + WS_XB); float* rstd1 = (float*)(ws + WS_RSTD);
    for (int m = gw; m < MT + NB * MEMLEN; m += NGW) {
        const bool ismem = m >= MT; const int mm = ismem ? m - MT : m;
        const f32x4* xr = (const f32x4*)((ismem ? F.in[I_MEM] : x) + (size_t)mm * DM) + F.lane;
        f32x4 v[8]; float s = 0.f;
#pragma unroll
        for (int j = 0; j < 8; ++j) { v[j] = xr[64 * j]; s += (v[j].x * v[j].x + v[j].y * v[j].y) + (v[j].z * v[j].z + v[j].w * v[j].w); }
        const float rs = 1.0f / sqrtf(wave_sum(s) * (1.f / DM) + RMS_EPS);
        if (!ismem) {
            float am = 0.f;
#pragma unroll
            for (int j = 0; j < 8; ++j) am = fmaxf(am, fmaxf(fmaxf(fabsf(v[j].x), fabsf(v[j].y)), fmaxf(fabsf(v[j].z), fabsf(v[j].w))));
#pragma unroll
            for (int o = 32; o >= 1; o >>= 1) am = fmaxf(am, __shfl_xor(am, o));
            am = fmaxf(am, 1e-30f); const float qs = 127.f / am;
            if (F.lane == 0) rstd1[mm] = rs * am * (1.f / 127.f);
            unsigned* o8 = (unsigned*)((unsigned char*)xb + (size_t)mm * DM) + F.lane;
#pragma unroll
            for (int j = 0; j < 8; ++j) o8[64 * j] = pack4_i8(rintf(v[j].x * qs), rintf(v[j].y * qs), rintf(v[j].z * qs), rintf(v[j].w * qs));
        } else { const f32x4* gr = (const f32x4*)F.in[I_GMEM] + F.lane; float am = 0.f;
#pragma unroll
            for (int j = 0; j < 8; ++j) { const f32x4 g = gr[64 * j]; v[j] = (f32x4){v[j].x * rs * g.x, v[j].y * rs * g.y, v[j].z * rs * g.z, v[j].w * rs * g.w};
                am = fmaxf(am, fmaxf(fmaxf(fabsf(v[j].x), fabsf(v[j].y)), fmaxf(fabsf(v[j].z), fabsf(v[j].w)))); }
#pragma unroll
            for (int o = 32; o >= 1; o >>= 1) am = fmaxf(am, __shfl_xor(am, o));
            am = fmaxf(am, 1e-30f); const float qs = 127.f / am;
            if (F.lane == 0) ((float*)F.ctl)[CW_MEMSCALE + mm] = am * (1.f / 127.f);
            unsigned* o8 = (unsigned*)(ws + WS_MEMN + (size_t)mm * DM) + F.lane;
#pragma unroll
            for (int j = 0; j < 8; ++j) o8[64 * j] = pack4_i8(rintf(v[j].x * qs), rintf(v[j].y * qs), rintf(v[j].z * qs), rintf(v[j].w * qs));
        }
    }
    const int gt = F.vcu * 512 + F.tid, NGT = F.G * 512;
    { const int* pos = (const int*)F.in[I_POS]; f32x2* cs = (f32x2*)(ws + WS_ROPE);
      for (int i = gt; i < MT * 32; i += NGT) { const int t = i >> 5, f = i & 31;
          const float inv = exp2f(-(float)f * (13.287712379549449f / 32.0f));
          const float ang = (float)pos[t] * inv;
          const double a = (double)ang; const double k = rint(a * 0.15915494309189535); const float red = (float)(a - k * 6.283185307179586);
          cs[i] = (f32x2){cosf(red), sinf(red)}; } }
    { float* WR = (float*)(ws + WS_WR); const float* gf = F.in[I_GFFN];
      for (int i = gt; i < DM * 36; i += NGT) { const int k = i / 36, c = i % 36; float w;
          if (c < 4) w = F.in[I_WRG][k * 4 + c]; else { const int gi = (c - 4) >> 3, e = (c - 4) & 7; w = F.in[I_WRE][((size_t)gi * DM + k) * 8 + e]; }
          WR[i] = w * gf[k]; } }
}

__device__ __forceinline__ void p_final(Frame& F, bool with_moe) {
    const int gw = F.vcu * 8 + F.wave, NGW = F.G * 8;
    const f32x4* gr = (const f32x4*)F.in[I_GFINAL] + F.lane;
    const int* route = (const int*)(F.ws + WS_ROUTE); const bf16* ybuf = (const bf16*)(F.ws + WS_YBUF);
    const int* cnts = (const int*)(F.ctl + CW_CNT);
    for (int m = gw; m < MT; m += NGW) {
        f32x4* xr = (f32x4*)(F.out + (size_t)m * DM) + F.lane;
        f32x4 v[8];
#pragma unroll
        for (int j = 0; j < 8; ++j) v[j] = xr[64 * j];
        if (with_moe) {
#pragma unroll
            for (int kx = 0; kx < 2; ++kx) { const int e = route[m * 8 + 2 * kx], pos = route[m * 8 + 2 * kx + 1];
                int base = 0; for (int q = 0; q < e; ++q) base += (cnts[64 * q] + 255) & ~255;
                const u32x2* yr = (const u32x2*)(ybuf + (size_t)(base + pos) * DM) + F.lane;
#pragma unroll
                for (int j = 0; j < 8; ++j) { const u32x2 w = yr[64 * j]; v[j].x += bflo(w.x); v[j].y += bfhi(w.x); v[j].z += bflo(w.y); v[j].w += bfhi(w.y); } }
        }
        float s = 0.f;
#pragma unroll
        for (int j = 0; j < 8; ++j) s += (v[j].x * v[j].x + v[j].y * v[j].y) + (v[j].z * v[j].z + v[j].w * v[j].w);
        const float rs = 1.0f / sqrtf(wave_sum(s) * (1.f / DM) + RMS_EPS);
#pragma unroll
        for (int j = 0; j < 8; ++j) { const f32x4 g = gr[64 * j]; xr[64 * j] = (f32x4){v[j].x * rs * g.x, v[j].y * rs * g.y, v[j].z * rs * g.z, v[j].w * rs * g.w}; }
    }
}
__device__ __forceinline__ void p_copy_x(Frame& F) {
    const int gt = F.vcu * 512 + F.tid, NGT = F.G * 512; const f32x4* s = (const f32x4*)F.in[I_X]; f32x4* d = (f32x4*)F.out;
    for (int i = gt; i < MT * DM / 4; i += NGT) d[i] = s[i];
}

__device__ __forceinline__ void p2_rowpass(Frame& F) {
    const int gw = F.vcu * 8 + F.wave, NGW = F.G * 8, l = F.lane;
    unsigned char* ws = F.ws;
    const bf16* zm = (const bf16*)(ws + WS_ZMLA); const bf16* zl = (const bf16*)(ws + WS_ZLORA); bf16* la = (bf16*)(ws + WS_LORAA);
    float* rstd_q = (float*)(ws + WS_RSTD) + MT; float* rstd_kv = (float*)(ws + WS_RSTD) + 2 * MT;
    const f32x2* cs = (const f32x2*)(ws + WS_ROPE); unsigned char* Kb = ws + WS_K;
    const float* sh = F.in[I_SHIFT] + 6144;
    f32x2 s0[5], s1[5], s2[5];
#pragma unroll
    for (int i = 0; i < 5; ++i) { const int j = 2 * l + 128 * i; s0[i] = *(const f32x2*)(sh + j); s1[i] = *(const f32x2*)(sh + RWKV_IN + j); s2[i] = *(const f32x2*)(sh + 2 * RWKV_IN + j); }
    for (int t = gw; t < MT; t += NGW) {
        const bf16* zr = zm + (size_t)t * ZM_LD;
        { const u32x4 w = *((const u32x4*)zr + l); float s = 0.f;
          s += bflo(w.x) * bflo(w.x) + bfhi(w.x) * bfhi(w.x) + bflo(w.y) * bflo(w.y) + bfhi(w.y) * bfhi(w.y) + bflo(w.z) * bflo(w.z) + bfhi(w.z) * bfhi(w.z) + bflo(w.w) * bflo(w.w) + bfhi(w.w) * bfhi(w.w);
          s = wave_sum(s); if (l == 0) rstd_q[t] = 1.0f / sqrtf(s * (1.f / QLORA) + RMS_EPS); }
        { const u32x2 w = *((const u32x2*)(zr + QLORA) + l); float s = bflo(w.x) * bflo(w.x) + bfhi(w.x) * bfhi(w.x) + bflo(w.y) * bflo(w.y) + bfhi(w.y) * bfhi(w.y);
          s = wave_sum(s); if (l == 0) rstd_kv[t] = 1.0f / sqrtf(s * (1.f / KVLORA) + RMS_EPS); }
        { const int i = l & 31, hs = l >> 5; const unsigned w = *((const unsigned*)(zr + 768) + i); const float x1 = bflo(w), x2 = bfhi(w); const f32x2 c = cs[(size_t)t * 32 + i];
          const unsigned short o = (unsigned short)__builtin_amdgcn_cvt_pk_fp8_f32(x1 * c.x - x2 * c.y, x2 * c.x + x1 * c.y, 0, false);
#pragma unroll
          for (int hh = 0; hh < 8; ++hh) *((unsigned short*)(Kb + (size_t)t * (MH * QKD) + (hs * 8 + hh) * QKD + NOPE) + i) = o; }
        const int s = t % SEQ; const float fp = s > 0 ? 1.f : 0.f, fn = s < SEQ - 1 ? 1.f : 0.f;
        const bf16* z0 = zl + (size_t)t * ZL_LD; const bf16* zp = s > 0 ? z0 - ZL_LD : z0; const bf16* zn = s < SEQ - 1 ? z0 + ZL_LD : z0;
        bf16* lr = la + (size_t)t * LA_LD;
#pragma unroll
        for (int i = 0; i < 5; ++i) { const int j = 2 * l + 128 * i;
            const unsigned wp = *(const unsigned*)(zp + j), w0 = *(const unsigned*)(z0 + j), wn = *(const unsigned*)(zn + j);
            float va = s0[i].x * fp * bflo(wp) + s1[i].x * bflo(w0) + s2[i].x * fn * bflo(wn);
            float vb = s0[i].y * fp * bfhi(wp) + s1[i].y * bfhi(w0) + s2[i].y * fn * bfhi(wn);
            int dst;
            if (j < 192) { va = tanhf(va); vb = tanhf(vb); dst = (j / 96) * 128 + (j % 96); } else if (j < 384) { dst = (j / 96) * 128 + (j % 96); } else { va = sigmoidf_(va); vb = sigmoidf_(vb); dst = 512 + (j - 384); }
            *(unsigned*)(lr + dst) = cvt_pk_bf16(va, vb); }
        { const int p = 2 * l; *(unsigned*)(lr + (p >> 5) * 128 + 96 + (p & 31)) = 0u; }
    }
}

namespace scan {
constexpr int TC = 16, DATA_B = TC * 6 * 64 * 4, BUF_B = DATA_B + 64 + TC * 32 * 4;
template <int CTRL> __device__ __forceinline__ float dpp_add(float v) {
    return v + __builtin_bit_cast(float, __builtin_amdgcn_update_dpp(0, __builtin_bit_cast(int, v), CTRL, 0xF, 0xF, false));
}
__device__ __forceinline__ float red16(float v) { v = dpp_add<0xB1>(v); v = dpp_add<0x4E>(v); v = dpp_add<0x141>(v); v = dpp_add<0x140>(v); return v; }
struct Raw { unsigned short r[3], k[3], v[3], wl, ic; };
template <int VAR> __device__ __forceinline__ void scan_unit(Frame& F, const int b, const int h, const int dir, const int half) {
    unsigned char* ws = F.ws; const int l = F.lane, w = F.wave, tid = F.tid;
    const bf16* zr = (const bf16*)(ws + WS_ZRKV) + (size_t)b * SEQ * ZR_LD + h * 64 + l;
    const bf16* wlp = (const bf16*)(ws + (dir ? WS_WLB : WS_WLF)) + (size_t)b * SEQ * RW + h * 64 + l;
    const bf16* icp = (const bf16*)(ws + (dir ? WS_ICB : WS_ICF)) + (size_t)b * SEQ * RW + h * 64 + l;
    bf16* yout = (bf16*)(ws + (dir ? WS_YB : WS_YF)) + (size_t)b * SEQ * RW + h * 64 + half * 32;
    const int ch = h * 64 + l; const float* sh = F.in[I_SHIFT];
    const float sr0 = sh[ch], sr1 = sh[RWKV_IN + ch], sr2 = sh[2 * RWKV_IN + ch];
    const float sk0 = sh[2048 + ch], sk1 = sh[RWKV_IN + 2048 + ch], sk2 = sh[2 * RWKV_IN + 2048 + ch];
    const float sv0 = sh[4096 + ch], sv1 = sh[RWKV_IN + 4096 + ch], sv2 = sh[2 * RWKV_IN + 4096 + ch];
    const float kk_c = F.in[I_KK][ch], ka_c = F.in[I_KA][ch], rk_c = F.in[I_RK][ch];
    LAS unsigned char* L = F.lds;
    Raw raw[2];
#define SC_TOK(ci, i) (dir ? (SEQ - 1 - ((ci) * TC + (i))) : ((ci) * TC + (i)))
#define SC_LOAD(ci) do { _Pragma("unroll") for (int q = 0; q < 2; ++q) { const int s = SC_TOK(ci, 2 * w + q); const int sp = s > 0 ? s - 1 : s, sn = s < SEQ - 1 ? s + 1 : s; \
        const bf16* z0 = zr + (size_t)s * ZR_LD; const bf16* zp = zr + (size_t)sp * ZR_LD; const bf16* zn = zr + (size_t)sn * ZR_LD; \
        raw[q].r[0] = zp[0]; raw[q].r[1] = z0[0]; raw[q].r[2] = zn[0]; raw[q].k[0] = zp[2048]; raw[q].k[1] = z0[2048]; raw[q].k[2] = zn[2048]; \
        raw[q].v[0] = zp[4096]; raw[q].v[1] = z0[4096]; raw[q].v[2] = zn[4096]; raw[q].wl = wlp[(size_t)s * RW]; raw[q].ic = icp[(size_t)s * RW]; } } while (0)
#define SC_PREP(ci, bufi) do { _Pragma("unroll") for (int q = 0; q < 2; ++q) { const int i = 2 * w + q; const int s = SC_TOK(ci, i); const float fp = s > 0 ? 1.f : 0.f, fn = s < SEQ - 1 ? 1.f : 0.f; \
        const float r_s = sr0 * fp * bf2f(raw[q].r[0]) + sr1 * bf2f(raw[q].r[1]) + sr2 * fn * bf2f(raw[q].r[2]); \
        const float k_s = sk0 * fp * bf2f(raw[q].k[0]) + sk1 * bf2f(raw[q].k[1]) + sk2 * fn * bf2f(raw[q].k[2]); \
        const float v_s = sv0 * fp * bf2f(raw[q].v[0]) + sv1 * bf2f(raw[q].v[1]) + sv2 * fn * bf2f(raw[q].v[2]); \
        const float kkr = k_s * kk_c; const float ss = wave_sum(kkr * kkr); const float kk = kkr * (1.0f / sqrtf(ss + 1e-12f)); \
        const float icv = bf2f(raw[q].ic); const float kd = k_s * (1.0f + (icv - 1.0f) * ka_c); const float bb = kk * icv; const float wd = __builtin_amdgcn_exp2f(bf2f(raw[q].wl)); \
        const float bon = wave_sum(r_s * kd * rk_c); \
        LAS float* d = (LAS float*)(L + (bufi) * BUF_B) + i * 384 + l; d[0] = wd; d[64] = kk; d[128] = bb; d[192] = kd; d[256] = r_s; d[320] = v_s; \
        if (l == 0) ((LAS float*)(L + (bufi) * BUF_B + DATA_B))[i] = bon; } } while (0)
    const int g = l >> 4, j = l & 15, row = half * 32 + w * 4 + g;
    f32x2 Sa = {0.f, 0.f}, Sb = {0.f, 0.f};
    struct Ops { f32x4 w, a, b, k, r; float v, bon; };
#define SC_LD(O, i) do { O.w = p4[(i) * 96 + j]; O.a = p4[(i) * 96 + 16 + j]; O.b = p4[(i) * 96 + 32 + j]; O.k = p4[(i) * 96 + 48 + j]; O.r = p4[(i) * 96 + 64 + j]; \
        O.v = pf[(i) * 384 + 320 + row]; O.bon = pb[i]; } while (0)
#define SC_STEP(O, YP) do { f32x2 t = Sa * O.a.xy; t = Sb * O.a.zw + t; float sa = red16(t.x + t.y); \
        const f32x2 nsa = {-sa, -sa}; const f32x2 vv2 = {O.v, O.v}; \
        const f32x2 u0 = nsa * O.b.xy + vv2 * O.k.xy, u1 = nsa * O.b.zw + vv2 * O.k.zw; \
        Sa = Sa * O.w.xy + u0; Sb = Sb * O.w.zw + u1; \
        f32x2 ty = Sa * O.r.xy; ty = Sb * O.r.zw + ty; YP = ty.x + ty.y; } while (0)
    SC_LOAD(0); SC_PREP(0, 0); __syncthreads();
    constexpr int NCH = SEQ / TC;
    for (int ci = 0; ci < NCH; ++ci) {
        const int bi = ci & 1;
        if (VAR != 2 && ci + 1 < NCH) SC_LOAD(ci + 1);
        const LAS f32x4* p4 = (const LAS f32x4*)(L + bi * BUF_B); const LAS float* pf = (const LAS float*)(L + bi * BUF_B);
        const LAS float* pb = (const LAS float*)(L + bi * BUF_B + DATA_B);
        float ykeep = 0.f;
        Ops oA, oB; SC_LD(oA, 0);
        if (VAR != 1) {
#pragma unroll
        for (int i = 0; i < TC; i += 4) {
            float y0, y1, y2, y3; float v0, v1, v2, v3, b0, b1, b2, b3;
            SC_LD(oB, i + 1); v0 = oA.v; b0 = oA.bon; SC_STEP(oA, y0);
            SC_LD(oA, i + 2); v1 = oB.v; b1 = oB.bon; SC_STEP(oB, y1);
            SC_LD(oB, i + 3); v2 = oA.v; b2 = oA.bon; SC_STEP(oA, y2);
            if (i + 4 < TC) SC_LD(oA, i + 4);
            v3 = oB.v; b3 = oB.bon; SC_STEP(oB, y3);
            y0 = red16(y0); y1 = red16(y1); y2 = red16(y2); y3 = red16(y3);
            y0 += b0 * v0; y1 += b1 * v1; y2 += b2 * v2; y3 += b3 * v3;
            ykeep = (j == i) ? y0 : ykeep; ykeep = (j == i + 1) ? y1 : ykeep; ykeep = (j == i + 2) ? y2 : ykeep; ykeep = (j == i + 3) ? y3 : ykeep;
        }
        }
        ((LAS float*)(L + bi * BUF_B + DATA_B + 64))[j * 32 + w * 4 + g] = ykeep;
        if (VAR != 2 && ci + 1 < NCH) SC_PREP(ci + 1, bi ^ 1);
        __syncthreads();
        { const int st = tid >> 5, rw_ = tid & 31; const int s = SC_TOK(ci, st);
          const unsigned short yv = f2bf(((const LAS float*)(L + bi * BUF_B + DATA_B + 64))[st * 32 + rw_]);
          if (VAR == 0) yout[(size_t)s * RW + rw_] = yv; else asm volatile("" :: "v"(yv)); }
    }
    __syncthreads();
#undef SC_TOK
#undef SC_LOAD
#undef SC_PREP
#undef SC_LD
#undef SC_STEP
}
}

namespace scan2 {
constexpr int TC = 16, NS = 6, NPREP = 6, NREC = 2;
constexpr int ROWB = 144;
constexpr int P_ACAT = 0, P_BHAT = 4608, P_KHAT = 6656, P_VT = 8704, P_NCAT = 10752, P_MRF = 11776, P_PC = 12800, P_GINIT = 13056  , PKG_B = 15104;
constexpr int S_L1 = 0, S_L2 = 4608, S_MF = 9216, S_NF = 10240, SCR_B = 11264;
constexpr int OFF_PKG = 0, OFF_SCR = NS * PKG_B, OFF_FLAG = OFF_SCR + NPREP * SCR_B, TOTAL_B = OFF_FLAG + 64;
static_assert(TOTAL_B <= 156 * 1024, "scan2 LDS");
__device__ __forceinline__ int crow(int r, int hi) { return (r & 3) + 8 * (r >> 2) + 4 * hi; }
__device__ __forceinline__ void lds_st16(LAS unsigned char* p, float v) { *(LAS unsigned short*)p = f2bf(v); }
__device__ __forceinline__ bf16x8 pack_acc8(const f32x16& x, int base) {
    u32x4 w = {cvt_pk_bf16(x[base + 0], x[base + 1]), cvt_pk_bf16(x[base + 2], x[base + 3]), cvt_pk_bf16(x[base + 4], x[base + 5]), cvt_pk_bf16(x[base + 6], x[base + 7])};
    return *reinterpret_cast<bf16x8*>(&w);
}
__device__ __forceinline__ float wave_sum_b(float v) {
    v = scan::red16(v);
    v += __builtin_bit_cast(float, __builtin_amdgcn_update_dpp(0, __builtin_bit_cast(int, v), 0x142, 0xA, 0xF, false));
    v += __builtin_bit_cast(float, __builtin_amdgcn_update_dpp(0, __builtin_bit_cast(int, v), 0x143, 0xC, 0xF, false));
    return __builtin_bit_cast(float, __builtin_amdgcn_readlane(__builtin_bit_cast(int, v), 63));
}
__device__ __forceinline__ void spin_ge(volatile LAS int* p, int want) { while (*p < want) __builtin_amdgcn_s_sleep(1); }

template <int dir> __device__ __forceinline__ void scan_unit(Frame& F, const int b, const int h) {
    unsigned char* ws = F.ws; const int l = F.lane, w = F.wave;
    LAS unsigned char* L = F.lds;
    volatile LAS int* ready = (volatile LAS int*)(L + OFF_FLAG);
    volatile LAS int* consumed = ready + NS;
    if (F.tid < 16) ready[F.tid] = 0;
    __syncthreads();
    constexpr int NCH = SEQ / TC;
    if (w < NREC) {
        const int half = w; const int v = l & 31, hi = l >> 5, vg = 32 * half + v;
        __builtin_amdgcn_s_setprio(3);
        f32x16 X0 = {}, X1 = {}; unsigned long long rec_acc = 0ull;
        bf16* yout = (bf16*)(ws + (dir ? WS_YB : WS_YF)) + (size_t)b * SEQ * RW + h * 64 + half * 32 + v;
        for (int ci = 0; ci < NCH; ++ci) {
            const int slot = ci % NS; const LAS unsigned char* P = L + OFF_PKG + slot * PKG_B;
            const unsigned long long tr0 = (SCAN_SEC == 9) ? __builtin_amdgcn_s_memtime() : 0ull;
            spin_ge(ready + slot, ci + 1);
            if (SCAN_SEC == 9) rec_acc += __builtin_amdgcn_s_memtime() - tr0;
            const bf16x8 a00 = *(const LAS bf16x8*)(P + P_ACAT + v * ROWB + (0 + hi) * 16), a01 = *(const LAS bf16x8*)(P + P_ACAT + v * ROWB + (2 + hi) * 16);
            const bf16x8 a10 = *(const LAS bf16x8*)(P + P_ACAT + v * ROWB + (4 + hi) * 16), a11 = *(const LAS bf16x8*)(P + P_ACAT + v * ROWB + (6 + hi) * 16);
            const bf16x8 ncat = *(const LAS bf16x8*)(P + P_NCAT + v * 32 + hi * 16), vt = *(const LAS bf16x8*)(P + P_VT + vg * 32 + hi * 16);
            const bf16x8 mrf = *(const LAS bf16x8*)(P + P_MRF + l * 16);
            const bf16x8 bh0 = *(const LAS bf16x8*)(P + P_BHAT + v * 32 + hi * 16), bh1 = *(const LAS bf16x8*)(P + P_BHAT + (32 + v) * 32 + hi * 16);
            const bf16x8 kh0 = *(const LAS bf16x8*)(P + P_KHAT + v * 32 + hi * 16), kh1 = *(const LAS bf16x8*)(P + P_KHAT + (32 + v) * 32 + hi * 16);
            f32x16 G;
            { const u32x2 q0 = *(const LAS u32x2*)(P + P_GINIT + vg * 32 + hi * 8), q1 = *(const LAS u32x2*)(P + P_GINIT + vg * 32 + 16 + hi * 8);
              const f32x4 g0 = {bflo(q0.x), bfhi(q0.x), bflo(q0.y), bfhi(q0.y)}, g1 = {bflo(q1.x), bfhi(q1.x), bflo(q1.y), bfhi(q1.y)};
#pragma unroll
              for (int r = 0; r < 8; ++r) G[r] = 0.f;
#pragma unroll
              for (int r = 0; r < 4; ++r) { G[8 + r] = g0[r]; G[12 + r] = g1[r]; } }
            f32x4 pc[8];
#pragma unroll
            for (int q = 0; q < 8; ++q) pc[q] = *(const LAS f32x4*)(P + P_PC + (32 * (q >> 2) + 8 * (q & 3) + 4 * hi) * 4);
            const bf16x8 s00 = pack_acc8(X0, 0), s01 = pack_acc8(X0, 8), s10 = pack_acc8(X1, 0), s11 = pack_acc8(X1, 8);
            G = __builtin_amdgcn_mfma_f32_32x32x16_bf16(a00, s00, G, 0, 0, 0);
            G = __builtin_amdgcn_mfma_f32_32x32x16_bf16(a01, s01, G, 0, 0, 0);
            G = __builtin_amdgcn_mfma_f32_32x32x16_bf16(a10, s10, G, 0, 0, 0);
            G = __builtin_amdgcn_mfma_f32_32x32x16_bf16(a11, s11, G, 0, 0, 0);
            G = __builtin_amdgcn_mfma_f32_32x32x16_bf16(ncat, vt, G, 0, 0, 0);
            const bf16x8 uf = pack_acc8(G, 0);
#pragma unroll
            for (int r = 0; r < 16; ++r) { X0[r] *= pc[r >> 2][r & 3]; X1[r] *= pc[4 + (r >> 2)][r & 3]; }
            X0 = __builtin_amdgcn_mfma_f32_32x32x16_bf16(bh0, uf, X0, 0, 0, 0);
            X1 = __builtin_amdgcn_mfma_f32_32x32x16_bf16(bh1, uf, X1, 0, 0, 0);
            X0 = __builtin_amdgcn_mfma_f32_32x32x16_bf16(kh0, vt, X0, 0, 0, 0);
            X1 = __builtin_amdgcn_mfma_f32_32x32x16_bf16(kh1, vt, X1, 0, 0, 0);
            G = __builtin_amdgcn_mfma_f32_32x32x16_bf16(mrf, uf, G, 0, 0, 0);
            LDS_WAIT();
            if (l == 0) consumed[half] = ci + 1;
#pragma unroll
            for (int q = 0; q < 8; ++q) { const int t = crow(q, hi); const int s = dir ? (SEQ - 1 - (ci * TC + t)) : (ci * TC + t);
                yout[(size_t)s * RW] = f2bf(G[8 + q]); }
        }
        __builtin_amdgcn_s_setprio(0);
        if (SCAN_SEC == 9 && blockIdx.x == 0 && w == 0 && l == 0) { F.MISC[120] = (unsigned)rec_acc; F.MISC[121] = (unsigned)(rec_acc >> 32); }
    } else {
        const int pw = w - NREC; LAS unsigned char* SC = L + OFF_SCR + pw * SCR_B;
        const __amdgpu_buffer_rsrc_t rsZ = __builtin_amdgcn_make_buffer_rsrc((void*)(ws + WS_ZRKV + ((size_t)b * SEQ * ZR_LD + h * 64) * 2), (short)0, (int)(SEQ * ZR_LD * 2), 0x00020000);
        const __amdgpu_buffer_rsrc_t rsW = __builtin_amdgcn_make_buffer_rsrc((void*)(ws + (dir ? WS_WLB : WS_WLF) + ((size_t)b * SEQ * RW + h * 64) * 2), (short)0, (int)(SEQ * RW * 2), 0x00020000);
        const __amdgpu_buffer_rsrc_t rsI = __builtin_amdgcn_make_buffer_rsrc((void*)(ws + (dir ? WS_ICB : WS_ICF) + ((size_t)b * SEQ * RW + h * 64) * 2), (short)0, (int)(SEQ * RW * 2), 0x00020000);
        const unsigned vl2 = (unsigned)l * 2u;
        const int ch = h * 64 + l; const float* sh = F.in[I_SHIFT];
        const float sr0 = sh[ch], sr1 = sh[RWKV_IN + ch], sr2 = sh[2 * RWKV_IN + ch];
        const float sk0 = sh[2048 + ch], sk1 = sh[RWKV_IN + 2048 + ch], sk2 = sh[2 * RWKV_IN + 2048 + ch];
        const float sv0 = sh[4096 + ch], sv1 = sh[RWKV_IN + 4096 + ch], sv2 = sh[2 * RWKV_IN + 4096 + ch];
        const float kk_c = F.in[I_KK][ch], ka_c = F.in[I_KA][ch], rk_c = F.in[I_RK][ch];
        const int posk = (((l >> 5) * 2 + ((l >> 4) & 1)) * 2 + ((l >> 2) & 1)) * 8 + ((l >> 3) & 1) * 4 + (l & 3);
        unsigned long long sec_acc = 0ull;
#define S2_T() ((SCAN_SEC >= 0) ? __builtin_amdgcn_s_memtime() : 0ull)
        for (int ci = pw; ci < NCH; ci += NPREP) {
            const int slot = ci % NS; LAS unsigned char* P = L + OFF_PKG + slot * PKG_B;
            const unsigned long long ts0 = S2_T();
            const int s_lo = dir ? (SEQ - TC - ci * TC) : ci * TC;
            float rr[18], rk[18], rv[18], wl[16], ic[16];
            { unsigned short ur[18], uk[18], uv[18], uw[16], ui[16];
#pragma unroll
              for (int tau = 0; tau < 18; ++tau) { const int s = s_lo - 1 + tau; const int sc = (tau == 0 && s < 0) ? s_lo : (tau == 17 && s >= SEQ) ? s_lo : s;
                  const unsigned so = (unsigned)sc * (unsigned)(ZR_LD * 2);
                  ur[tau] = __builtin_amdgcn_raw_buffer_load_b16(rsZ, vl2, so, 0); uk[tau] = __builtin_amdgcn_raw_buffer_load_b16(rsZ, vl2, so + 4096u, 0); uv[tau] = __builtin_amdgcn_raw_buffer_load_b16(rsZ, vl2, so + 8192u, 0); }
#pragma unroll
              for (int i = 0; i < 16; ++i) { const int s = dir ? (s_lo + 15 - i) : (s_lo + i); const unsigned so = (unsigned)s * (unsigned)(RW * 2);
                  uw[i] = __builtin_amdgcn_raw_buffer_load_b16(rsW, vl2, so, 0); ui[i] = __builtin_amdgcn_raw_buffer_load_b16(rsI, vl2, so, 0); }
              __builtin_amdgcn_sched_barrier(0);
#pragma unroll
              for (int tau = 0; tau < 18; ++tau) { rr[tau] = bf2f(ur[tau]); rk[tau] = bf2f(uk[tau]); rv[tau] = bf2f(uv[tau]); }
              { const float f0 = (s_lo - 1 >= 0) ? 1.f : 0.f, f17 = (s_lo + 16 < SEQ) ? 1.f : 0.f;
                rr[0] *= f0; rk[0] *= f0; rv[0] *= f0; rr[17] *= f17; rk[17] *= f17; rv[17] *= f17; }
#pragma unroll
              for (int i = 0; i < 16; ++i) { wl[i] = bf2f(uw[i]); ic[i] = bf2f(ui[i]); } }
            float cum[16];
            cum[0] = wl[0];
#pragma unroll
            for (int i = 1; i < 16; ++i) cum[i] = cum[i - 1] + wl[i];
            const unsigned long long tsA = S2_T();
            float rs_[16], ks_[16], vs_[16], q1[16], q2[16];
#pragma unroll
            for (int i = 0; i < 16; ++i) { const int tau = dir ? (16 - i) : (i + 1);
                rs_[i] = sr0 * rr[tau - 1] + sr1 * rr[tau] + sr2 * rr[tau + 1];
                ks_[i] = sk0 * rk[tau - 1] + sk1 * rk[tau] + sk2 * rk[tau + 1];
                vs_[i] = sv0 * rv[tau - 1] + sv1 * rv[tau] + sv2 * rv[tau + 1];
                const float kkr = ks_[i] * kk_c; q1[i] = kkr * kkr; q2[i] = rs_[i] * (ks_[i] * (1.0f + (ic[i] - 1.0f) * ka_c)) * rk_c; }
#define S2_DPPSTEP(CTRL, RM) do { _Pragma("unroll") for (int i = 0; i < 16; ++i) { \
                q1[i] += __builtin_bit_cast(float, __builtin_amdgcn_update_dpp(0, __builtin_bit_cast(int, q1[i]), CTRL, RM, 0xF, false)); \
                q2[i] += __builtin_bit_cast(float, __builtin_amdgcn_update_dpp(0, __builtin_bit_cast(int, q2[i]), CTRL, RM, 0xF, false)); } } while (0)
            S2_DPPSTEP(0xB1, 0xF); S2_DPPSTEP(0x4E, 0xF); S2_DPPSTEP(0x141, 0xF); S2_DPPSTEP(0x140, 0xF);
            __builtin_amdgcn_sched_barrier(0);
            asm volatile("s_nop 1");
#define S2_BCAST(CTRL) do { _Pragma("unroll") for (int i = 0; i < 16; ++i) { \
                asm volatile("v_add_f32_dpp %0, %0, %0 " CTRL " bank_mask:0xf" : "+v"(q1[i])); asm volatile("v_add_f32_dpp %0, %0, %0 " CTRL " bank_mask:0xf" : "+v"(q2[i])); } } while (0)
            S2_BCAST("row_bcast:15 row_mask:0xa"); S2_BCAST("row_bcast:31 row_mask:0xc");
#undef S2_BCAST
            asm volatile("s_nop 1");
            __builtin_amdgcn_sched_barrier(0);
#undef S2_DPPSTEP
            const unsigned long long ts1 = S2_T();
            spin_ge(consumed, ci - NS + 1); spin_ge(consumed + 1, ci - NS + 1);
            const unsigned long long ts2 = S2_T();
            float at[16], bhv[16], khv[16], giv[16]; float pprev = 1.0f; const float pC = __builtin_amdgcn_exp2f(cum[15]);
#pragma unroll
            for (int i = 0; i < 16; ++i) {
                const float r_s = rs_[i], k_s = ks_[i], v_s = vs_[i];
                const float ss = __uint_as_float(__builtin_amdgcn_readlane(__float_as_uint(q1[i]), 63)), bon = __uint_as_float(__builtin_amdgcn_readlane(__float_as_uint(q2[i]), 63));
                const float kk = k_s * kk_c * __builtin_amdgcn_rsqf(ss + 1e-12f);
                const float kd = k_s * (1.0f + (ic[i] - 1.0f) * ka_c); const float bb = kk * ic[i];
                const float p = __builtin_amdgcn_exp2f(cum[i]), pm = pprev, pinv = __builtin_amdgcn_exp2f(-cum[i]), pr = pC * pinv; pprev = p;
                at[i] = -kk * pm;
                lds_st16(P + P_ACAT + i * ROWB + posk * 2, at[i]);
                const float rt = r_s * p;
                lds_st16(P + P_ACAT + (16 + i) * ROWB + posk * 2, rt);
                lds_st16(SC + S_L1 + i * ROWB + posk * 2, bb * pinv); lds_st16(SC + S_L1 + (16 + i) * ROWB + posk * 2, kd * pinv);
                bhv[((i >> 2) & 1) * 8 + (i & 3) + 4 * (i >> 3)] = bb * pr; khv[i] = kd * pr; giv[i] = bon * v_s;
            }
#pragma unroll
            for (int hf = 0; hf < 2; ++hf) {
                *(LAS u32x4*)(P + P_BHAT + l * 32 + hf * 16) = (u32x4){cvt_pk_bf16(bhv[hf * 8 + 0], bhv[hf * 8 + 1]), cvt_pk_bf16(bhv[hf * 8 + 2], bhv[hf * 8 + 3]), cvt_pk_bf16(bhv[hf * 8 + 4], bhv[hf * 8 + 5]), cvt_pk_bf16(bhv[hf * 8 + 6], bhv[hf * 8 + 7])};
                *(LAS u32x4*)(P + P_KHAT + l * 32 + hf * 16) = (u32x4){cvt_pk_bf16(khv[hf * 8 + 0], khv[hf * 8 + 1]), cvt_pk_bf16(khv[hf * 8 + 2], khv[hf * 8 + 3]), cvt_pk_bf16(khv[hf * 8 + 4], khv[hf * 8 + 5]), cvt_pk_bf16(khv[hf * 8 + 6], khv[hf * 8 + 7])};
                *(LAS u32x4*)(P + P_VT + l * 32 + hf * 16) = (u32x4){cvt_pk_bf16(vs_[hf * 8 + 0], vs_[hf * 8 + 1]), cvt_pk_bf16(vs_[hf * 8 + 2], vs_[hf * 8 + 3]), cvt_pk_bf16(vs_[hf * 8 + 4], vs_[hf * 8 + 5]), cvt_pk_bf16(vs_[hf * 8 + 6], vs_[hf * 8 + 7])};
                *(LAS u32x4*)(P + P_GINIT + l * 32 + hf * 16) = (u32x4){cvt_pk_bf16(giv[hf * 8 + 0], giv[hf * 8 + 1]), cvt_pk_bf16(giv[hf * 8 + 2], giv[hf * 8 + 3]), cvt_pk_bf16(giv[hf * 8 + 4], giv[hf * 8 + 5]), cvt_pk_bf16(giv[hf * 8 + 6], giv[hf * 8 + 7])}; }
            *(LAS float*)(P + P_PC + l * 4) = pC;
            LDS_WAIT();
            const unsigned long long ts3 = S2_T();
            f32x16 Z = {};
            { const int r = l & 31, hh = l >> 5;
#pragma unroll
              for (int ks = 0; ks < 4; ++ks) { const bf16x8 fa = *(const LAS bf16x8*)(SC + S_L1 + r * ROWB + (ks * 16 + hh * 8) * 2), fb = *(const LAS bf16x8*)(P + P_ACAT + r * ROWB + (ks * 16 + hh * 8) * 2);
                  Z = __builtin_amdgcn_mfma_f32_32x32x16_bf16(fa, fb, Z, 0, 0, 0); } }
            { const int c = l & 31, hh = l >> 5;
              if (c < 16) {
#pragma unroll
                  for (int r = 0; r < 8; ++r) { const int s = crow(r, hh); *(LAS float*)(SC + S_MF + (c * 16 + s) * 4) = (s < c) ? Z[r] : 0.f; }
#pragma unroll
                  for (int r = 8; r < 16; ++r) { const int s = crow(r, hh) - 16; *(LAS float*)(SC + S_NF + (s * 16 + c) * 4) = (s < c) ? Z[r] : 0.f; }
                  *(LAS u32x4*)(P + P_MRF + l * 16) = (u32x4){0u, 0u, 0u, 0u};
              } else { const int t = c - 16; f32x16 Zm = Z;
#pragma unroll
                  for (int r = 0; r < 8; ++r) { const int s = crow(r, hh); Zm[r] = (s <= t) ? Z[r] : 0.f; }
                  *(LAS bf16x8*)(P + P_MRF + l * 16) = pack_acc8(Zm, 0);
#pragma unroll
                  for (int r = 8; r < 16; ++r) { const int s = crow(r, hh) - 16; lds_st16(P + P_NCAT + c * 32 + s * 2, (s <= t) ? Z[r] : 0.f); }
              } }
            LDS_WAIT();
            const unsigned long long ts4 = S2_T();
            { f32x2 xy[16];
#pragma unroll
              for (int q = 0; q < 4; ++q) { const f32x4 nvv = *(const LAS f32x4*)(SC + S_NF + ((l & 15) * 16 + q * 4) * 4);
                  xy[q * 4 + 0] = (f32x2){at[q * 4 + 0], nvv[0]}; xy[q * 4 + 1] = (f32x2){at[q * 4 + 1], nvv[1]}; xy[q * 4 + 2] = (f32x2){at[q * 4 + 2], nvv[2]}; xy[q * 4 + 3] = (f32x2){at[q * 4 + 3], nvv[3]}; }
              f32x4 mrow[16][4];
#pragma unroll
              for (int t = 1; t < 16; ++t)
#pragma unroll
                  for (int s4 = 0; s4 < (t + 3) / 4; ++s4) mrow[t][s4] = *(const LAS f32x4*)(SC + S_MF + (t * 16 + s4 * 4) * 4);
#pragma unroll
              for (int t = 1; t < 16; ++t) { f32x2 a0 = xy[t], a1 = {0.f, 0.f};
#pragma unroll
                  for (int s = 0; s < t; ++s) { const float m = mrow[t][s >> 2][s & 3]; const f32x2 mm = {m, m}; if (s & 1) a1 += xy[s] * mm; else a0 += xy[s] * mm; }
                  xy[t] = a0 + a1; }
#pragma unroll
              for (int t = 0; t < 16; ++t) lds_st16(P + P_ACAT + t * ROWB + posk * 2, xy[t].x);
              if (l < 16) {
#pragma unroll
                  for (int t = 0; t < 16; ++t) lds_st16(P + P_NCAT + t * 32 + l * 2, xy[t].y); } }
            LDS_WAIT();
            if (l == 0) ready[slot] = ci + 1;
            if (SCAN_SEC >= 0) { const unsigned long long ts5 = S2_T(); sec_acc += SCAN_SEC == 0 ? ts1 - ts0 : SCAN_SEC == 1 ? ts2 - ts1 : SCAN_SEC == 2 ? ts3 - ts2 : SCAN_SEC == 3 ? ts4 - ts3 : SCAN_SEC == 4 ? ts5 - ts4 : SCAN_SEC == 6 ? tsA - ts0 : SCAN_SEC == 7 ? ts1 - tsA : ts5 - ts0; }
        }
        if (SCAN_SEC >= 0 && blockIdx.x == 0 && pw == SCAN_PW && SCAN_SEC != 9 && l == 0) { F.MISC[120] = (unsigned)sec_acc; F.MISC[121] = (unsigned)(sec_acc >> 32); }
    }
    __syncthreads();
}
}

__device__ __forceinline__ void p5_post(Frame& F) {
    const int gw = F.vcu * 8 + F.wave, NGW = F.G * 8, l = F.lane; unsigned char* ws = F.ws;
    const bf16* yf = (const bf16*)(ws + WS_YF); const bf16* yb = (const bf16*)(ws + WS_YB); const bf16* gg = (const bf16*)(ws + WS_G); bf16* o = (bf16*)(ws + WS_ORWKV);
    const float* lg = F.in[I_LNXG]; const float* lb = F.in[I_LNXB];
    float* rows = (float*)F.ctl + CW_ROWS_RWKV; unsigned char* o8 = (unsigned char*)o;
    for (int t = gw; t < MT; t += NGW) {
        const size_t base = (size_t)t * RW; float res[RH]; float am = 0.f;
#pragma unroll
        for (int h = 0; h < RH; ++h) { const int c = h * 64 + l;
            const float y = bf2f(yf[base + c]) + bf2f(yb[base + c]);
            const float mu = wave_sum(y) * (1.f / 64.f); const float d = y - mu; const float var = wave_sum(d * d) * (1.f / 64.f);
            const float yn = d * (1.0f / sqrtf(var + LNX_EPS));
            res[h] = (yn * lg[c] + lb[c]) * bf2f(gg[base + c]); am = fmaxf(am, fabsf(res[h])); }
#pragma unroll
        for (int o_ = 32; o_ >= 1; o_ >>= 1) am = fmaxf(am, __shfl_xor(am, o_));
        am = fmaxf(am, 1e-30f); const float qs = 127.f / am;
        if (l == 0) rows[t] = am * (1.f / 127.f);
        LAS unsigned char* tb = F.lds + F.wave * CVT_SCR;
#pragma unroll
        for (int h = 0; h < RH; ++h) tb[h * 64 + l] = (unsigned char)((int)rintf(res[h] * qs) & 255);
        LDS_WAIT();
        { const u32x4 a = *(const LAS u32x4*)(tb + l * 32), b = *(const LAS u32x4*)(tb + l * 32 + 16);
          *(u32x4*)(o8 + base + l * 32) = a; *(u32x4*)(o8 + base + l * 32 + 16) = b; }
    }
}

__device__ __forceinline__ void p8_rowpass(Frame& F) {
    const int gw = F.vcu * 8 + F.wave, NGW = F.G * 8; float* rstd2 = (float*)(F.ws + WS_RSTD) + 3 * MT; bf16* hb = (bf16*)(F.ws + WS_H1B);
    for (int m = gw; m < MT; m += NGW) {
        const f32x4* xr = (const f32x4*)(F.out + (size_t)m * DM) + F.lane; f32x4 v[8]; float s = 0.f;
#pragma unroll
        for (int j = 0; j < 8; ++j) { v[j] = xr[64 * j]; s += (v[j].x * v[j].x + v[j].y * v[j].y) + (v[j].z * v[j].z + v[j].w * v[j].w); }
        s = wave_sum(s); float am = 0.f;
#pragma unroll
        for (int j = 0; j < 8; ++j) am = fmaxf(am, fmaxf(fmaxf(fabsf(v[j].x), fabsf(v[j].y)), fmaxf(fabsf(v[j].z), fabsf(v[j].w))));
#pragma unroll
        for (int o = 32; o >= 1; o >>= 1) am = fmaxf(am, __shfl_xor(am, o));
        am = fmaxf(am, 1e-30f); const float qs = 127.f / am;
        if (F.lane == 0) rstd2[m] = am * (1.f / 127.f) / sqrtf(s * (1.f / DM) + RMS_EPS);
        unsigned* o8 = (unsigned*)((unsigned char*)hb + (size_t)m * DM) + F.lane;
#pragma unroll
        for (int j = 0; j < 8; ++j) o8[64 * j] = pack4_i8(rintf(v[j].x * qs), rintf(v[j].y * qs), rintf(v[j].z * qs), rintf(v[j].w * qs));
    }
}
__device__ __forceinline__ void p12_router(Frame& F) {
    const int gw = F.vcu * 8 + F.wave, NGW = F.G * 8, l = F.lane; unsigned char* ws = F.ws;
    float* rstd3 = (float*)(ws + WS_RSTD) + 4 * MT; bf16* n3 = (bf16*)(ws + WS_N3); const float* WR = (const float*)(ws + WS_WR);
    int* lists = (int*)(ws + WS_LIST); int* route = (int*)(ws + WS_ROUTE); float* slotw = (float*)(ws + WS_SLOTW);
    int* cnt = (int*)(F.ctl + CW_CNT);
    const float* brg = F.in[I_BRG]; const float* bre = F.in[I_BRE];
    LAS float* wl = (LAS float*)(F.lds + 16384);
    LAS float* lgt = (LAS float*)(F.lds + F.wave * 1024);
    for (int tb = F.vcu * 32; tb < MT; tb += F.G * 32) {
        const int t0 = tb + F.wave * 4;
        float ss[4] = {0.f, 0.f, 0.f, 0.f};
#pragma unroll
        for (int q = 0; q < 4; ++q) { const f32x4* xr = (const f32x4*)(F.out + (size_t)(t0 + q) * DM) + l; u32x2* o8 = (u32x2*)(n3 + (size_t)(t0 + q) * DM) + l;
#pragma unroll
            for (int j = 0; j < 8; ++j) { const f32x4 x = xr[64 * j]; ss[q] += (x.x * x.x + x.y * x.y) + (x.z * x.z + x.w * x.w);
                u32x2 w; w.x = cvt_pk_bf16(x.x, x.y); w.y = cvt_pk_bf16(x.z, x.w); o8[64 * j] = w; } }
#pragma unroll
        for (int q = 0; q < 4; ++q) ss[q] = wave_sum(ss[q]);
#pragma unroll 1
        for (int pass = 0; pass < 2; ++pass) {
            const float* x0p = F.out + (size_t)(t0 + 2 * pass) * DM + l; const float* x1p = x0p + DM;
            float acc[2][36];
#pragma unroll
            for (int q = 0; q < 2; ++q)
#pragma unroll
                for (int o = 0; o < 36; ++o) acc[q][o] = 0.f;
#pragma unroll 1
            for (int blk = 0; blk < 8; ++blk) {
                __syncthreads();
                { const f32x4* src4 = (const f32x4*)(WR + (size_t)blk * 256 * 36); LAS f32x4* dst4 = (LAS f32x4*)wl;
#pragma unroll
                  for (int i = 0; i < 5; ++i) { const int idx = F.tid + 512 * i; if (idx < 2304) dst4[idx] = src4[idx]; } }
                __syncthreads();
#pragma unroll
                for (int c4 = 0; c4 < 4; ++c4) { const int cl = l + 64 * c4; const float x0 = x0p[blk * 256 + 64 * c4], x1 = x1p[blk * 256 + 64 * c4];
                    const LAS f32x4* wr = (const LAS f32x4*)(wl + cl * 36);
#pragma unroll
                    for (int o4 = 0; o4 < 9; ++o4) { const f32x4 w = wr[o4];
#pragma unroll
                        for (int k = 0; k < 4; ++k) { acc[0][o4 * 4 + k] += x0 * w[k]; acc[1][o4 * 4 + k] += x1 * w[k]; } } }
            }
#pragma unroll
            for (int q = 0; q < 2; ++q)
#pragma unroll
                for (int o = 0; o < 36; ++o) { const float v = wave_sum(acc[q][o]); if (l == 0) lgt[(2 * pass + q) * 36 + o] = v; }
        }
        LDS_WAIT();
#pragma unroll
        for (int q = 0; q < 4; ++q) { const int t = t0 + q; const float rs = 1.0f / sqrtf(ss[q] * (1.f / DM) + RMS_EPS);
            float lg[4]; float gmax = -3.0e38f; int gsel = 0;
#pragma unroll
            for (int g = 0; g < 4; ++g) { lg[g] = lgt[q * 36 + g] * rs + brg[g]; if (lg[g] > gmax) { gmax = lg[g]; gsel = g; } }
            float gz = 0.f;
#pragma unroll
            for (int g = 0; g < 4; ++g) gz += __expf(lg[g] - gmax);
            const float pg = 1.0f / gz;
            float le[8];
#pragma unroll
            for (int e = 0; e < 8; ++e) { float a = lgt[q * 36 + 4 + e];
#pragma unroll
                for (int g = 1; g < 4; ++g) a = (gsel == g) ? lgt[q * 36 + 4 + g * 8 + e] : a;
                le[e] = a * rs + bre[gsel * 8 + e]; }
            float m1 = -3.0e38f, m2 = -3.0e38f; int e1 = 0, e2 = 0;
#pragma unroll
            for (int e = 0; e < 8; ++e) { if (le[e] > m1) { m2 = m1; e2 = e1; m1 = le[e]; e1 = e; } else if (le[e] > m2) { m2 = le[e]; e2 = e; } }
            const float xe = __expf(m2 - m1); const float w1 = pg / (1.0f + xe), w2 = pg * xe / (1.0f + xe);
            if (l == 0) { rstd3[t] = rs;
                const int E1 = gsel * 8 + e1, E2 = gsel * 8 + e2;
                const int p1 = atomicAdd(cnt + 64 * E1, 1), p2 = atomicAdd(cnt + 64 * E2, 1);
                lists[E1 * MT + p1] = t; lists[E2 * MT + p2] = t; slotw[E1 * MT + p1] = w1; slotw[E2 * MT + p2] = w2;
                route[t * 8 + 0] = E1; route[t * 8 + 1] = p1; route[t * 8 + 2] = E2; route[t * 8 + 3] = p2; }
        }
    }
}
struct MoeOrder {
    static constexpr bool GATHER = true;
    const volatile LAS int* tp; const int* cnt; const int* lists; const char* A; const char* B; int G, c, lognt; size_t bstride_e, bstride_t;
    bool gather;
    __device__ __forceinline__ bool next(int i, Unit& u) const {
        const int L = i * G + c; const int RT = tp[32]; if (L >= (RT << lognt)) return false;
        const int rt = L >> lognt, nt = L & ((1 << lognt) - 1); int e = 0;
        for (int q = 1; q < 32; ++q) e = (rt >= tp[q]) ? q : e;
        u.pm = rt; u.pn = nt; u.aux0 = e; u.aux1 = (rt - tp[e]) * 256;
        u.Ab = A; u.Bb = B + (size_t)e * bstride_e + (size_t)nt * bstride_t; return true;
    }
    __device__ __forceinline__ unsigned arow(const Unit& u, int r) const {
        if (!gather) return (unsigned)(u.pm * 256 + r);
        const int idx = u.aux1 + r; const int n = cnt[64 * u.aux0]; return idx < n ? (unsigned)lists[u.aux0 * MT + idx] : 0u;
    }
};
struct EpiMoe1 {
    static constexpr bool PERM = true;
    bf16* hid; const int* cnt; const int* lists; const float* slotw; const float* rstd;
    __device__ __forceinline__ void operator()(const PG8_ACC, const Unit& u, int wr, int wc, int fr, int fq) const {
        const int n = cnt[64 * u.aux0];
#pragma unroll
        for (int ai = 0; ai < 2; ++ai)
#pragma unroll
            for (int m = 0; m < 4; ++m) { const int r = ai * 128 + wr * 64 + m * 16 + fr; const int idx = u.aux1 + r; const bool ok = idx < n;
                const int tok = ok ? lists[u.aux0 * MT + idx] : 0; const float rs = rstd[tok]; const float wt = ok ? slotw[u.aux0 * MT + idx] : 0.f;
                f32x4 o0, o1;
#pragma unroll
                for (int j = 0; j < 4; ++j) { const float g0 = acc[ai][0][m][0][j] * rs, u0 = acc[ai][1][m][0][j] * rs, g1 = acc[ai][0][m][1][j] * rs, u1 = acc[ai][1][m][1][j] * rs;
                    o0[j] = g0 * sigmoidf_(g0) * u0 * wt; o1[j] = g1 * sigmoidf_(g1) * u1 * wt; }
                *(u32x4*)(hid + (size_t)(u.pm * 256 + r) * DE + u.pn * 128 + wc * 32 + 8 * fq) = pg8::pack8(o0, o1); }
    }
};
struct EpiMoe2 {
    static constexpr bool PERM = true;
    bf16* y;
    __device__ __forceinline__ void operator()(const PG8_ACC, const Unit& u, int wr, int wc, int fr, int fq) const {
        EPI_FOR(ai, m, bj) { const int row = u.pm * 256 + ai * 128 + wr * 64 + m * 16 + fr; const int col = u.pn * 256 + bj * 128 + wc * 32 + 8 * fq;
            *(u32x4*)(y + (size_t)row * DM + col) = pg8::pack8(acc[ai][bj][m][0], acc[ai][bj][m][1]); }
    }
};
__device__ __forceinline__ void moe_table(Frame& F) {
    if (F.tid == 0) { const int* cnt = (const int*)(F.ctl + CW_CNT); int acc = 0;
        for (int e = 0; e < 32; ++e) { F.MISC[16 + e] = (unsigned)acc; acc += (__hip_atomic_load(cnt + 64 * e, __ATOMIC_RELAXED, __HIP_MEMORY_SCOPE_AGENT) + 255) >> 8; }
        F.MISC[16 + 32] = (unsigned)acc; }
    __syncthreads();
}
__device__ __forceinline__ void p5_expert_cvt(Frame& F) {
    LAS float* scr = (LAS float*)(F.lds + F.wave * CVT_SCR); const int gw = F.vcu * 8 + F.wave, NGW = F.G * 8; unsigned char* ws = F.ws;
#define EX_DESC(it_, d) do { const int e = (it_) / 768, r = (it_) % 768; \
        if (r < 256) { d.W = F.in[I_WEG] + (size_t)e * DM * DE; d.gain = F.in[I_GFFN]; d.WT = (bf16*)(ws + WS_WGU) + (size_t)e * 1024 * DM; d.K = DM; d.N = DE; d.ldt = DM; d.mode = 3; d.kofs = 0; d.item = r; d.q = 0; d.cm = 0; } \
        else if (r < 512) { d.W = F.in[I_WEU] + (size_t)e * DM * DE; d.gain = F.in[I_GFFN]; d.WT = (bf16*)(ws + WS_WGU) + (size_t)e * 1024 * DM; d.K = DM; d.N = DE; d.ldt = DM; d.mode = 4; d.kofs = 0; d.item = r - 256; d.q = 0; d.cm = 0; } \
        else { d.W = F.in[I_WED] + (size_t)e * DE * DM; d.gain = nullptr; d.WT = (bf16*)(ws + WS_WD) + (size_t)e * DM * DE; d.K = DE; d.N = DM; d.ldt = DE; d.mode = 0; d.kofs = 0; d.item = r - 512; d.q = 0; d.cm = 0; } } while (0)
    CVT_PIPE(NE * 768, EX_DESC);
#undef EX_DESC
}

struct Args { const float* in[41]; float* out; unsigned char* ws; int ph_lo, ph_hi; };
constexpr int NPHASE = 16;
__global__ void __launch_bounds__(512, 2) fwd_kernel(Args args) {
    extern __shared__ __attribute__((aligned(16))) unsigned char lds_raw[];
    Frame F;
    F.lds = (LAS unsigned char*)lds_raw; F.MISC = (volatile LAS unsigned*)(F.lds + MISC_OFF);
    F.tid = threadIdx.x; F.lane = F.tid & 63; F.wave = __builtin_amdgcn_readfirstlane(F.tid >> 6);
    F.G = gridDim.x; { const int bx = blockIdx.x; F.vcu = (F.G % 8 == 0) ? (bx % 8) * (F.G / 8) + bx / 8 : bx; }
    F.ws = args.ws; F.out = args.out; F.ctl = (unsigned*)(args.ws + WS_CTL);
#pragma unroll
    for (int i = 0; i < 41; ++i) F.in[i] = args.in[i];
    for (int u = F.tid; u < (LDS_BYTES - LDSCTL_OFF) / 4; u += 512) ((LAS unsigned*)(F.lds + LDSCTL_OFF))[u] = 0u;
    __syncthreads();
    XcdBarrier bar; bar.bar = F.ctl + CW_BAR; bar.x = 0; bar.st = nullptr;
    const int lo = args.ph_lo, hi = args.ph_hi;
    if (hi - lo > 1) bar = xcd_barrier_post(F.ctl + CW_BAR, F.MISC + 8);
#ifndef ATT_DQK_TEST
#define ATT_DQK_TEST QKD
#endif
#define PROBE_N (MT * 768)
#ifndef LSEL
#define LSEL 31
#endif
#ifndef PH_MASK
#define PH_MASK 0xFFFFu
#endif
#ifndef SCAN_MFMA
#define SCAN_MFMA 1
#endif
#ifndef SCAN_DUMMY
#define SCAN_DUMMY 0
#endif
#ifndef REPEAT_MASK
#define REPEAT_MASK 0x0u
#endif
#define REP(k) _Pragma("unroll") for (int _rep = 0; _rep <= (int)(((REPEAT_MASK) >> (k)) & 1u); ++_rep)
#define IN(k) ((((PH_MASK) >> (k)) & 1u) && lo <= (k) && (k) < hi)
#ifndef PROBE_TIME
#define PROBE_TIME -1
#endif
#define SEAM(k) do { if (lo <= (k) && (k) + 1 < hi) xcd_barrier(bar); if (PROBE_TIME >= 0 && blockIdx.x == 0 && F.tid == 0) { const unsigned long long _t = wall_clock64(); F.MISC[64 + 2 * ((k) + 1)] = (unsigned)_t; F.MISC[65 + 2 * ((k) + 1)] = (unsigned)(_t >> 32); } } while (0)
    unsigned char* ws = args.ws;

    bf16* const zmla = (bf16*)(ws + WS_ZMLA); bf16* const loraA = (bf16*)(ws + WS_LORAA);
    float* const rstd1 = (float*)(ws + WS_RSTD); float* const rstd_q = rstd1 + MT; float* const rstd_kv = rstd1 + 2 * MT;
    const int bid = (int)blockIdx.x;
    if (PROBE_TIME >= 0 && blockIdx.x == 0 && F.tid == 0) { const unsigned long long _t = wall_clock64(); F.MISC[64] = (unsigned)_t; F.MISC[65] = (unsigned)(_t >> 32); }
    if (IN(0)) { REP(0) { p0_prologue(F); xcd_barrier(bar); p0b_quant_rows(F); } }
    SEAM(0);
    if (IN(1)) {
        if (EN_RWKV || EN_MLA) REP(1) { pg8::StaticOrder S; S.init((const bf16*)(ws + WS_XB), DM / 2, (const bf16*)(ws + WS_WIN), DM / 2, MT, G1_N, F.G, bid);
          EpiG1 E{rstd1, zmla, (bf16*)(ws + WS_ZRKV), (bf16*)(ws + WS_ZLORA), (bf16*)(ws + WS_ZGATE), (const float*)(F.ctl + CW_COLMAX)};
          pg8::gemm_phase<EpiG1, pg8::StaticOrder, true>(F.lds, DM / 2, DM / 2, DM / 2, S, E); }
        else p_copy_x(F);
    }
    SEAM(1);
    if (IN(2)) { if (EN_RWKV || EN_MLA) REP(2) p2_rowpass(F); }
    SEAM(2);
    if (IN(3)) REP(3) {
        if (EN_MLA) {
            { pg8::StaticOrder S; S.init(zmla, ZM_LD, (const bf16*)(ws + WS_WUQ), QLORA, MT, MH * QKD, F.G, bid);
              EpiQ E{ws + WS_Q, rstd_q, (const float*)(ws + WS_ROPE)};
              pg8::gemm_phase(F.lds, QLORA, ZM_LD, QLORA, S, E); }
            { pg8::StaticOrder S; S.init(zmla + QLORA, ZM_LD, (const bf16*)(ws + WS_WUKV), KVLORA, MT, MH * 256, F.G, bid);
              EpiKV E{ws + WS_K, (bf16*)(ws + WS_V), rstd_kv};
              pg8::gemm_phase(F.lds, KVLORA, ZM_LD, KVLORA, S, E); }
        }
        if (EN_RWKV) {
            { pg8::StaticOrder S; S.init(loraA, LA_LD, (const bf16*)(ws + WS_W2F), 256, MT, 2 * RW, F.G, bid);
              EpiLora2<0> E{(bf16*)(ws + WS_WLF), (bf16*)(ws + WS_WLB), F.in[I_W0F], F.in[I_W0B]}; pg8::gemm_phase(F.lds, 256, LA_LD, 256, S, E); }
            { pg8::StaticOrder S; S.init(loraA + 256, LA_LD, (const bf16*)(ws + WS_W2F + 2 * MiB), 256, MT, 2 * RW, F.G, bid);
              EpiLora2<1> E{(bf16*)(ws + WS_ICF), (bf16*)(ws + WS_ICB), F.in[I_A0F], F.in[I_A0B]}; pg8::gemm_phase(F.lds, 256, LA_LD, 256, S, E); }
            if (LSEL & 16) { pg8::StaticOrder S; S.init(loraA + 512, LA_LD, (const bf16*)(ws + WS_G2), GLORA, MT, RW, F.G, bid);
              EpiLora<2> E{(bf16*)(ws + WS_G), nullptr}; pg8::gemm_phase(F.lds, GLORA, LA_LD, GLORA, S, E); }
        }
    }
    SEAM(3);
    if (IN(4)) {
        constexpr int NSCAN = NB * RH * 2, NATT = NB * MH * (SEQ / 256);
        int s_begin = F.vcu, s_end = NSCAN, s_step = F.G, a_begin = F.vcu, a_step = F.G, a_cnt = (F.vcu < NATT) ? (NATT - 1 - F.vcu) / F.G + 1 : 0;
        if (EN_RWKV && EN_MLA && F.G == 256) { s_step = 1; a_step = 1;
            if (F.vcu < 128) { s_end = F.vcu + 1; a_begin = 384 + F.vcu; a_cnt = 1; } else { s_end = 0; a_begin = (F.vcu - 128) * 3; a_cnt = 3; } }
        if (EN_RWKV) for (int u = s_begin; u < s_end; u += s_step) { const int dir = u & 1, bh = u >> 1;
            if (dir) scan2::scan_unit<1>(F, bh >> 5, bh & 31); else scan2::scan_unit<0>(F, bh >> 5, bh & 31); }
        if (EN_MLA) for (int i = 0; i < a_cnt; ++i) { const int L = a_begin + i * a_step; const int qb = L & 15, bh = L >> 4, b = bh >> 4, h = bh & 15;
            att::attn_unit_f8<MH * QKD, MH * QKD, MH * VDIM, DM>(ws + WS_Q + ((size_t)(b * SEQ + qb * 256) * (MH * QKD) + h * QKD),
                                ws + WS_K + ((size_t)b * SEQ * (MH * QKD) + h * QKD),
                                (const bf16*)(ws + WS_V) + ((size_t)b * SEQ * (MH * VDIM) + h * VDIM),
                                (bf16*)(ws + WS_OMLA) + ((size_t)(b * SEQ + qb * 256) * DM + h * VDIM), SEQ, QSCALE, (LAS char*)F.lds); }
    }
    SEAM(4);
    if (IN(5)) { if (EN_RWKV) REP(5) p5_post(F); if (EN_MOE) REP(17) p5_expert_cvt(F); }
    SEAM(5);
    if (IN(6)) REP(6) {
        if (EN_MLA) { pg8::StaticOrder S; S.init((const bf16*)(ws + WS_OMLA), DM, (const bf16*)(ws + WS_WUPM), DM, MT, DM, F.G, bid);
            EpiUp<0> E{(bf16*)(ws + WS_MERGED), (const bf16*)(ws + WS_ZGATE), 0, nullptr, nullptr}; pg8::gemm_phase(F.lds, DM, DM, DM, S, E); }
        if (EN_RWKV) { pg8::StaticOrder S; S.init((const bf16*)(ws + WS_ORWKV), DM / 2, (const bf16*)(ws + WS_WUPR), DM / 2, MT, DM, F.G, bid);
            EpiUp<EN_MLA, true> E{(bf16*)(ws + WS_MERGED), (const bf16*)(ws + WS_ZGATE), DM, (const float*)F.ctl + CW_ROWS_RWKV, (const float*)F.ctl + CW_CM_UPR};
            pg8::gemm_phase<EpiUp<EN_MLA, true>, pg8::StaticOrder, true>(F.lds, DM / 2, DM / 2, DM / 2, S, E); }
    }
    SEAM(6);
    if (IN(7)) REP(7) {
        if (EN_RWKV || EN_MLA) { pg8::StaticOrder S; S.init((const bf16*)(ws + WS_MERGED), DM, (const bf16*)(ws + WS_WOUT), DM, MT, DM, F.G, bid);
            EpiResid E{F.in[I_X], F.out}; pg8::gemm_phase(F.lds, DM, DM, DM, S, E); }
    }
    SEAM(7);
    if (IN(8)) { if (EN_CROSS || EN_MOE) p8_rowpass(F); }
    SEAM(8);
    if (IN(9)) REP(9) {
        if (EN_CROSS) { pg8::StaticOrder S; S.init((const bf16*)(ws + WS_H1B), DM / 2, (const bf16*)(ws + WS_WQC), DM / 2, MT, CW, F.G, bid);
            EpiPlainI8 E{(bf16*)(ws + WS_QC), CW, rstd1 + 3 * MT, (const float*)F.ctl + CW_CM_QC, CSCALE}; pg8::gemm_phase<EpiPlainI8, pg8::StaticOrder, true>(F.lds, DM / 2, DM / 2, DM / 2, S, E); }
        if (EN_CROSS && bid >= 64) { pg8::StaticOrder S; S.init((const bf16*)(ws + WS_MEMN), DM / 2, (const bf16*)(ws + WS_WKVC), DM / 2, NB * MEMLEN, 2 * CW, F.G, bid - 64);
            EpiPlainI8 E{(bf16*)(ws + WS_KVC), 2 * CW, (const float*)F.ctl + CW_MEMSCALE, (const float*)F.ctl + CW_CM_KVC, 1.f}; pg8::gemm_phase<EpiPlainI8, pg8::StaticOrder, true>(F.lds, DM / 2, DM / 2, DM / 2, S, E); }
    }
    SEAM(9);
    if (IN(10)) REP(10) {
        if (EN_CROSS) {
            for (int i = 0; ; ++i) { const int L = i * F.G + F.vcu; if (L >= NB * CH * (SEQ / 256)) break;
                const int qb = L & 15, bh = L >> 4, b = bh >> 2, h = bh & 3;
                att::attn_unit<CHD, CW, 2 * CW, 2 * CW, CW>((const bf16*)(ws + WS_QC) + ((size_t)(b * SEQ + qb * 256) * CW + h * CHD),
                                    (const bf16*)(ws + WS_KVC) + ((size_t)b * MEMLEN * (2 * CW) + h * CHD),
                                    (const bf16*)(ws + WS_KVC) + ((size_t)b * MEMLEN * (2 * CW) + CW + h * CHD),
                                    (bf16*)(ws + WS_OC) + ((size_t)(b * SEQ + qb * 256) * CW + h * CHD), MEMLEN, (LAS char*)F.lds); }
        }
    }
    SEAM(10);
    if (IN(11)) {
        if (EN_CROSS) { pg8::StaticOrder S; S.init((const bf16*)(ws + WS_OC), CW, (const bf16*)(ws + WS_WOC), CW, MT, DM, F.G, bid);
            EpiResid E{F.out, F.out}; pg8::gemm_phase(F.lds, CW, CW, CW, S, E); }
    }
    SEAM(11);
    if (IN(12)) { if (EN_MOE) p12_router(F); }
    SEAM(12);
    if (IN(13)) REP(13) {
        if (EN_MOE) { moe_table(F);
            MoeOrder S{(const volatile LAS int*)(F.MISC + 16), (const int*)(F.ctl + CW_CNT), (const int*)(ws + WS_LIST), (const char*)(ws + WS_N3), (const char*)(ws + WS_WGU), F.G, F.vcu, 2,
                       (size_t)1024 * DM * 2, (size_t)256 * DM * 2, true};
            EpiMoe1 E{(bf16*)(ws + WS_HID), (const int*)(F.ctl + CW_CNT), (const int*)(ws + WS_LIST), (const float*)(ws + WS_SLOTW), rstd1 + 4 * MT};
            pg8::gemm_phase(F.lds, DM, DM, DM, S, E); }
    }
    SEAM(13);
    if (IN(14)) REP(14) {
        if (EN_MOE) { moe_table(F);
            MoeOrder S{(const volatile LAS int*)(F.MISC + 16), (const int*)(F.ctl + CW_CNT), (const int*)(ws + WS_LIST), (const char*)(ws + WS_HID), (const char*)(ws + WS_WD), F.G, F.vcu, 3,
                       (size_t)DM * DE * 2, (size_t)256 * DE * 2, false};
            EpiMoe2 E{(bf16*)(ws + WS_YBUF)};
            pg8::gemm_phase(F.lds, DE, DE, DE, S, E); }
    }
    SEAM(14);
#ifdef PROBE_OFF
    if (IN(15)) { const int gt = F.vcu * 512 + F.tid, NGT = F.G * 512; const bf16* sb = (const bf16*)(ws + (size_t)PROBE_OFF * MiB);
        for (int i = gt; i < MT * DM; i += NGT) F.out[i] = (i < PROBE_N) ? bf2f(sb[i]) : 0.f; }
#else
    if (IN(15)) { { int t_ = threadIdx.x; asm volatile("" : "+v"(t_)); F.tid = t_; F.lane = t_ & 63; }
        p_final(F, EN_MOE != 0); }
#endif
    if (SCAN_SEC == 20) { if (blockIdx.x == 0 && F.wave == 0) { const float e = att::f8_map_probe(F.lane); if (F.lane == 0) F.out[(size_t)(F.vcu * 8) * DM] += 10.f + e; } }
    if (SCAN_SEC >= 0 && SCAN_SEC < 20) { __syncthreads(); if (blockIdx.x == 0 && F.tid == 0) { const unsigned long long c = ((unsigned long long)F.MISC[121] << 32) | F.MISC[120]; F.out[(size_t)(F.vcu * 8) * DM] += (float)c * 1e-4f; } }
    if (PROBE_TIME >= 0) { __syncthreads(); if (blockIdx.x == 0 && F.tid == 0) {
        const unsigned long long a = ((unsigned long long)F.MISC[65 + 2 * PROBE_TIME] << 32) | F.MISC[64 + 2 * PROBE_TIME], b = ((unsigned long long)F.MISC[65 + 2 * (PROBE_TIME + 1)] << 32) | F.MISC[64 + 2 * (PROBE_TIME + 1)];
        F.out[(size_t)(F.vcu * 8) * DM] += (float)(b - a) * 0.001f; } }
#undef IN
#undef SEAM
}

extern "C" void kernel_launch(void* const* d_in, const int* in_sizes, int n_in, void* d_out, int out_size, void* d_ws, size_t ws_size, hipStream_t stream) {
    static int grid = 0;
    if (grid == 0) {
        if (n_in != 41 || out_size != MT * DM || ws_size < WS_END) { fprintf(stderr, "kernel_launch: unexpected shapes n_in %d out %d ws %zu (need %zu)\n", n_in, out_size, ws_size, (size_t)WS_END); grid = -1; return; }
        int dev = 0, cus = 0, per_cu = 0;
        if (hipGetDevice(&dev) != hipSuccess || hipDeviceGetAttribute(&cus, hipDeviceAttributeMultiprocessorCount, dev) != hipSuccess) { grid = -1; return; }
        if (hipFuncSetAttribute((const void*)fwd_kernel, hipFuncAttributeMaxDynamicSharedMemorySize, LDS_BYTES) != hipSuccess) { fprintf(stderr, "kernel_launch: hipFuncSetAttribute failed\n"); grid = -1; return; }
        if (hipOccupancyMaxActiveBlocksPerMultiprocessor(&per_cu, (const void*)fwd_kernel, 512, LDS_BYTES) != hipSuccess || per_cu < 1) { fprintf(stderr, "kernel_launch: occupancy query says %d\n", per_cu); }
        (void)hipGetLastError();
        grid = cus;
    }
    if (grid < 0) return;
    (void)hipMemsetAsync((char*)d_ws + WS_CTL, 0, CTL_BYTES, stream);
    Args a{};
    for (int i = 0; i < 41; ++i) a.in[i] = (const float*)d_in[i];
    a.out = (float*)d_out; a.ws = (unsigned char*)d_ws;
#if N_LAUNCH_SPLIT
    for (int p = 0; p < NPHASE; ++p) { a.ph_lo = p; a.ph_hi = p + 1; hipLaunchKernelGGL(fwd_kernel, dim3(grid), dim3(512), LDS_BYTES, stream, a); }
#else
    a.ph_lo = 0; a.ph_hi = NPHASE;
    hipLaunchKernelGGL(fwd_kernel, dim3(grid), dim3(512), LDS_BYTES, stream, a);
#endif
}
```

```cpp
#include <hip/hip_runtime.h>
#include <cstdio>
#include <cstdint>

#ifndef SCAN_PW
#define SCAN_PW 0
#endif
#ifndef SCAN_SEC
#define SCAN_SEC -1
#endif
#ifndef EN_RWKV
#define EN_RWKV 1
#endif
#ifndef EN_MLA
#define EN_MLA 1
#endif
#ifndef EN_CROSS
#define EN_CROSS 1
#endif
#ifndef EN_MOE
#define EN_MOE 1
#endif
#ifndef N_LAUNCH_SPLIT
#define N_LAUNCH_SPLIT 0
#endif

#define GAS __attribute__((address_space(1)))
#define LAS __attribute__((address_space(3)))
typedef unsigned short bf16;
typedef short bf16x8 __attribute__((ext_vector_type(8)));
typedef short s16x4 __attribute__((ext_vector_type(4)));
typedef float f32x4 __attribute__((ext_vector_type(4)));
typedef float f32x2 __attribute__((ext_vector_type(2)));
typedef float f32x16 __attribute__((ext_vector_type(16)));
typedef unsigned u32x4 __attribute__((ext_vector_type(4)));
typedef unsigned u32x2 __attribute__((ext_vector_type(2)));

constexpr int DM = 2048, NB = 2, SEQ = 4096, MT = NB * SEQ;
constexpr int MEMLEN = 256;
constexpr int QLORA = 512, KVLORA = 256, ROPE = 64, NOPE = 128, VDIM = 128, QKD = 192, MH = 16;
constexpr int RW = 2048, RH = 32, RHD = 64, DLORA = 96, GLORA = 256;
constexpr int MLA_IN = 832, RWKV_IN = 6784, GATE_IN = 4096, IN_W = MLA_IN + RWKV_IN + GATE_IN;
constexpr int CH = 4, CHD = 128, CW = 512;
constexpr int NG = 4, EPG = 8, NE = 32, DE = 512;
constexpr float RMS_EPS = 1e-6f, LNX_EPS = 64e-5f;
constexpr int G1_N = 12032;
constexpr int ZM_LD = 1024, ZR_LD = 6144, ZL_LD = 768, ZG_LD = 4096, LA_LD = 768;
constexpr int MOE_SLOTS = 2 * MT + NE * 256;

constexpr size_t MiB = 1u << 20;
constexpr size_t WS_CTL = 0, CTL_BYTES = 1 * MiB;
constexpr size_t WS_WUQ = 1 * MiB;
constexpr size_t WS_WUKV = 4 * MiB;
constexpr size_t WS_W2F = 6 * MiB;
constexpr size_t WS_G2 = 10 * MiB;
constexpr size_t WS_WUPM = 11 * MiB, WS_WUPR = 19 * MiB, WS_WOUT = 27 * MiB;
constexpr size_t WS_WQC = 35 * MiB;
constexpr size_t WS_WKVC = 37 * MiB;
constexpr size_t WS_WOC = 41 * MiB;
constexpr size_t WS_WIN = 43 * MiB;
constexpr size_t WS_MISC = 90 * MiB;
constexpr size_t WS_ROPE = WS_MISC;
constexpr size_t WS_MEMN = WS_MISC + 2 * MiB;
constexpr size_t WS_KVC = WS_MISC + 4 * MiB;
constexpr size_t WS_RSTD = WS_MISC + 5 * MiB;
constexpr size_t WS_WR = WS_RSTD + 256 * 1024;
constexpr size_t WS_LIST = WS_MISC + 6 * MiB;
constexpr size_t WS_ROUTE = WS_MISC + 7 * MiB;
constexpr size_t WS_SLOTW = WS_MISC + 8 * MiB;
constexpr size_t WS_XB = 100 * MiB;
constexpr size_t WS_ZMLA = 132 * MiB;
constexpr size_t WS_ZLORA = 148 * MiB;
constexpr size_t WS_LORAA = 160 * MiB;
constexpr size_t WS_ZRKV = 172 * MiB;
constexpr size_t WS_ZGATE = 268 * MiB;
constexpr size_t WS_Q = 332 * MiB;
constexpr size_t WS_K = 380 * MiB;
constexpr size_t WS_V = 428 * MiB;
constexpr size_t WS_WLF = 460 * MiB, WS_WLB = 492 * MiB, WS_ICF = 524 * MiB, WS_ICB = 556 * MiB;
constexpr size_t WS_G = 588 * MiB;
constexpr size_t WS_END = 620 * MiB;
constexpr size_t WS_YF = WS_WIN, WS_YB = WS_ZMLA, WS_ORWKV = WS_Q, WS_MERGED = WS_K, WS_QC = WS_V, WS_OC = WS_V + 8 * MiB;
constexpr size_t WS_WGU = WS_WLF, WS_WD = WS_ZRKV, WS_HID = WS_ZGATE, WS_YBUF = WS_Q;
constexpr size_t WS_OMLA = WS_XB, WS_H1B = WS_XB, WS_N3 = WS_XB;

constexpr int CW_BAR = 4096;
constexpr int CW_CM_QC = 45056, CW_CM_KVC = 45568, CW_MEMSCALE = 47104;
constexpr int CW_ROWS_RWKV = 49152, CW_CM_UPR = 57344;
constexpr int CW_COLMAX = 32768;
constexpr size_t WS_TMP_WIN = WS_ZRKV, WS_TMP_WQC = WS_ZGATE, WS_TMP_WKVC = WS_ZGATE + 2 * MiB, WS_TMP_WUPR = WS_ZGATE + 6 * MiB;
constexpr int CW_CNT = 16384;

constexpr int RING_BYTES = 159744;
constexpr int LDSCTL_OFF = RING_BYTES, MISC_OFF = LDSCTL_OFF + 320;
constexpr int LDS_BYTES = 161792;

#define LDS_WAIT() asm volatile("s_waitcnt lgkmcnt(0)" ::: "memory")
#define VM_WAIT() asm volatile("s_waitcnt vmcnt(0)" ::: "memory")
typedef __bf16 bf16x2_t __attribute__((ext_vector_type(2)));
__device__ __forceinline__ unsigned cvt_pk_bf16(float lo, float hi) { f32x2 v = {lo, hi}; bf16x2_t b = __builtin_convertvector(v, bf16x2_t); return __builtin_bit_cast(unsigned, b); }
__device__ __forceinline__ float bf2f(unsigned short b) { return __builtin_bit_cast(float, ((unsigned)b) << 16); }
__device__ __forceinline__ float bflo(unsigned w) { return __builtin_bit_cast(float, w << 16); }
__device__ __forceinline__ float bfhi(unsigned w) { return __builtin_bit_cast(float, w & 0xffff0000u); }
__device__ __forceinline__ unsigned short f2bf(float f) { return (unsigned short)(cvt_pk_bf16(f, 0.f) & 0xffffu); }
__device__ __forceinline__ float sigmoidf_(float x) { return __builtin_amdgcn_rcpf(1.0f + __builtin_amdgcn_exp2f(-1.4426950408889634f * x)); }
template <int CTRL> __device__ __forceinline__ float dpp_add_(float v) {
    return v + __builtin_bit_cast(float, __builtin_amdgcn_update_dpp(0, __builtin_bit_cast(int, v), CTRL, 0xF, 0xF, false));
}
__device__ __forceinline__ float wave_sum(float v) {
    v = dpp_add_<0xB1>(v); v = dpp_add_<0x4E>(v); v = dpp_add_<0x141>(v); v = dpp_add_<0x140>(v);
    const int iv = __builtin_bit_cast(int, v);
    const float s0 = __builtin_bit_cast(float, __builtin_amdgcn_readlane(iv, 0)), s1 = __builtin_bit_cast(float, __builtin_amdgcn_readlane(iv, 16));
    const float s2 = __builtin_bit_cast(float, __builtin_amdgcn_readlane(iv, 32)), s3 = __builtin_bit_cast(float, __builtin_amdgcn_readlane(iv, 48));
    return (s0 + s1) + (s2 + s3);
}

#define XB_TMO      128
#define XB_XCNT(j)  (256  + 64 * (j))
#define XB_XSUB(j)  (1280 + 64 * (j))
#define XB_XGEN(j)  (2304 + 64 * (j))
#define XB_TOP      3328
#define XB_TOPGEN   3392
#define XCD_BAR_WORDS 3456
#define XB_SPIN_CAP (1u << 18)
__device__ __forceinline__ unsigned xb_ld(unsigned* p)              { return __hip_atomic_load(p, __ATOMIC_RELAXED, __HIP_MEMORY_SCOPE_AGENT); }
__device__ __forceinline__ unsigned xb_add(unsigned* p, unsigned v) { return __hip_atomic_fetch_add(p, v, __ATOMIC_RELAXED, __HIP_MEMORY_SCOPE_AGENT); }
__device__ __forceinline__ unsigned xb_xcc_id() { return (unsigned)__builtin_amdgcn_s_getreg((3 << 11) | 20) & 0xFu; }
#define XB_SPIN(cond, bar) do { unsigned _sp = 0; while (cond) { __builtin_amdgcn_s_sleep(1); \
    if ((++_sp & 255u) == 0u) { if (xb_ld(&(bar)[XB_TMO])) break; if (_sp > XB_SPIN_CAP) { atomicAdd(&(bar)[XB_TMO], 1u); break; } } } } while (0)
struct XcdBarrier { unsigned* bar; unsigned x; volatile LAS unsigned* st; };
__device__ __forceinline__ XcdBarrier xcd_barrier_post(unsigned* bar, volatile LAS unsigned* st) {
    XcdBarrier b; b.bar = bar; b.x = xb_xcc_id(); b.st = st;
    if (threadIdx.x == 0) (void)xb_add(&bar[XB_XCNT(b.x)], 1u);
    return b;
}
__device__ __forceinline__ void xcd_barrier_complete(unsigned* bar, unsigned x, unsigned& nloc, unsigned& nx) {
    const unsigned G = gridDim.x * gridDim.y * gridDim.z;
    unsigned sum, cnt, mine, sp = 0u;
    for (;;) {
        sum = 0u; cnt = 0u; mine = 0u;
#pragma unroll
        for (unsigned j = 0; j < 16; ++j) { const unsigned c = xb_ld(&bar[XB_XCNT(j)]); sum += c; cnt += (c > 0u) ? 1u : 0u; mine = (j == x) ? c : mine; }
        if (sum == G) break;
        __builtin_amdgcn_s_sleep(1);
        if ((++sp & 255u) == 0u) { if (xb_ld(&bar[XB_TMO])) break; if (sp > XB_SPIN_CAP) { atomicAdd(&bar[XB_TMO], 1u); break; } }
    }
    nloc = mine > 0u ? mine : 1u; nx = cnt > 0u ? cnt : 1u;
}
__device__ __forceinline__ void xcd_barrier(const XcdBarrier& b) {
    asm volatile("s_waitcnt vmcnt(0)" ::: "memory");
    __syncthreads();
    if (threadIdx.x == 0) {
        unsigned* bar = b.bar;
        __builtin_amdgcn_s_waitcnt(0);
        unsigned nloc = b.st[0], nx = b.st[1];
        if (nloc == 0u) { xcd_barrier_complete(bar, b.x, nloc, nx); b.st[0] = nloc; b.st[1] = nx; }
        const unsigned old = xb_add(&bar[XB_XSUB(b.x)], 1u);
        const unsigned gen = old / nloc;
        if (old + 1u == (gen + 1u) * nloc) {
            __builtin_amdgcn_fence(__ATOMIC_RELEASE, "agent");
            asm volatile("s_waitcnt vmcnt(0)" ::: "memory");
            const unsigned og = xb_add(&bar[XB_TOP], 1u);
            const unsigned tg = og / nx;
            if (og + 1u == (tg + 1u) * nx) xb_add(&bar[XB_TOPGEN], 1u);
            else XB_SPIN(xb_ld(&bar[XB_TOPGEN]) == tg, bar);
            __builtin_amdgcn_fence(__ATOMIC_ACQUIRE, "agent");
            xb_add(&bar[XB_XGEN(b.x)], 1u);
            asm volatile("s_waitcnt vmcnt(0)" ::: "memory");
        } else {
            XB_SPIN(xb_ld(&bar[XB_XGEN(b.x)]) == gen, bar);
            __builtin_amdgcn_fence(__ATOMIC_ACQUIRE, "agent");
            asm volatile("s_waitcnt vmcnt(0)" ::: "memory");
        }
    }
    __syncthreads();
}

namespace pg8 {
constexpr int BM = 256, BK = 64, HALF = 128, HTB = HALF * BK * 2, STAGE_BYTES = 8 * HTB, NXCD = 8, WGM = 8;
__host__ __device__ __forceinline__ int lds_byte(int r, int c) { const int st = (r >> 4) * 2 + (c >> 5), rr = r & 15, cc = c & 31, ob = rr * 64 + cc * 2; return st * 1024 + (ob ^ (((ob >> 9) & 1) << 5)); }
__host__ __device__ __forceinline__ void stage_rc(int b, int& R, int& C) { const int st = b / 1024, sb = b % 1024, swz = sb ^ (((sb >> 9) & 1) << 5); R = (st >> 1) * 16 + swz / 64; C = (st & 1) * 32 + (swz % 64) / 2; }
__host__ __device__ __forceinline__ int perm32(int rho) { const int n = rho >> 4, i = rho & 15; return 8 * (i >> 2) + 4 * n + (i & 3); }

struct Unit { int pm, pn; const char* Ab; const char* Bb; int aux0, aux1; };

struct StaticOrder {
    static constexpr bool GATHER = false;
    int nM, nN, nwg, G, c; const char* A; const char* Bt; int lda, ldb;
    __device__ void init(const bf16* A_, int lda_, const bf16* Bt_, int ldb_, int M, int N, int G_, int c_) { A = (const char*)A_; Bt = (const char*)Bt_; lda = lda_; ldb = ldb_; nM = M / BM; nN = N / BM; nwg = nM * nN; G = G_; c = c_; }
    __device__ __forceinline__ bool next(int i, Unit& u) const {
        const long L = (long)i * G + c; if (L >= nwg) return false;
        int wgid = (int)L; { const int q = nwg / NXCD, r = nwg % NXCD, xcd = wgid % NXCD, off = wgid / NXCD; wgid = (xcd < r ? xcd * (q + 1) : r * (q + 1) + (xcd - r) * q) + off; }
        const int nig = WGM * nN, gid = wgid / nig, fm = gid * WGM, gsz = (nM - fm) < WGM ? (nM - fm) : WGM;
        u.pm = fm + ((wgid % nig) % gsz); u.pn = (wgid % nig) / gsz; u.Ab = A + (size_t)u.pm * BM * lda * 2; u.Bb = Bt + (size_t)u.pn * BM * ldb * 2; u.aux0 = 0; u.aux1 = 0; return true;
    }
    __device__ __forceinline__ unsigned arow(const Unit& u, int r) const { return (unsigned)r; }
};

#define PG8_ACC f32x4 (&acc)[2][2][4][2]
typedef int i32x4g __attribute__((ext_vector_type(4)));
template <class Epi, class Sched, bool I8 = false>
__device__ __forceinline__ void gemm_phase(LAS unsigned char* lds, const int K, const int lda, const int ldb, const Sched& S, const Epi& E) {
    const int tid = threadIdx.x, wid = __builtin_amdgcn_readfirstlane(tid >> 6), lane = tid & 63, wr = wid >> 2, wc = wid & 3, fr = lane & 15, fq = lane >> 4;
    const int nt = K / BK;
    int sR[2], sC[2]; unsigned voffB[2];
#pragma unroll
    for (int i = 0; i < 2; ++i) { stage_rc(tid * 16 + i * 8192, sR[i], sC[i]); const int Rb = Epi::PERM ? ((sR[i] & ~31) + perm32(sR[i] & 31)) : sR[i];
        voffB[i] = (unsigned)(Rb * ldb + sC[i]) * 2u; }
    const size_t kstep = (size_t)(BK * 2);
    const size_t hstepB = (size_t)HALF * ldb * 2;
    const unsigned ldsw = (unsigned)wid * 1024u;
    const int aoff = lds_byte(wr * 64 + fr, fq * 8), boff = lds_byte(wc * 32 + fr, fq * 8);
#define PG8_SA(b, h) (((b) * 2 + (h)) * HTB)
#define PG8_SB(b, h) ((4 + (b) * 2 + (h)) * HTB)
#define PG8_STAGE(bufoff, gbase, voff) do { _Pragma("unroll") for (int _i = 0; _i < 2; ++_i) \
        __builtin_amdgcn_global_load_lds((const unsigned*)((const char*)(gbase) + (voff)[_i]), (LAS unsigned*)(lds + (bufoff) + ldsw + _i * 8192), 16, 0, 0); } while (0)
#define PG8_LDA(dst, b, h) do { _Pragma("unroll") for (int m = 0; m < 4; ++m) _Pragma("unroll") for (int k = 0; k < 2; ++k) dst[m][k] = *(const LAS bf16x8*)(lds + PG8_SA(b, h) + aoff + m * 2048 + k * 1024); } while (0)
#define PG8_LDB(dst, b, h) do { _Pragma("unroll") for (int n = 0; n < 2; ++n) _Pragma("unroll") for (int k = 0; k < 2; ++k) dst[n][k] = *(const LAS bf16x8*)(lds + PG8_SB(b, h) + boff + n * 2048 + k * 1024); } while (0)
#define PG8_MMA(ai, bj, At, Bt) do { __builtin_amdgcn_s_setprio(1); _Pragma("unroll") for (int m = 0; m < 4; ++m) _Pragma("unroll") for (int n = 0; n < 2; ++n) _Pragma("unroll") for (int k = 0; k < 2; ++k) { \
        if constexpr (I8) acc[ai][bj][m][n] = __builtin_bit_cast(f32x4, __builtin_amdgcn_mfma_i32_16x16x64_i8(__builtin_bit_cast(i32x4g, Bt[n][k]), __builtin_bit_cast(i32x4g, At[m][k]), __builtin_bit_cast(i32x4g, acc[ai][bj][m][n]), 0, 0, 0)); \
        else acc[ai][bj][m][n] = __builtin_amdgcn_mfma_f32_16x16x32_bf16(Bt[n][k], At[m][k], acc[ai][bj][m][n], 0, 0, 0); } __builtin_amdgcn_s_setprio(0); } while (0)
#define PG8_WAIT_V(n) asm volatile("s_waitcnt vmcnt(" #n ")" ::: "memory")
#define PG8_WAIT_L(n) asm volatile("s_waitcnt lgkmcnt(" #n ")" ::: "memory")
#define PG8_BAR __builtin_amdgcn_s_barrier()
#define PG8_SCHED __builtin_amdgcn_sched_barrier(0)
#define PG8_SETVA(dst, u) do { _Pragma("unroll") for (int _h = 0; _h < 2; ++_h) _Pragma("unroll") for (int _i = 0; _i < 2; ++_i) \
        dst[_h][_i] = (S.arow(u, _h * HALF + sR[_i]) * (unsigned)lda + (unsigned)sC[_i]) * 2u; } while (0)
    Unit cur, nxt; int ui = 0;
    if (!S.next(0, cur)) return;
    f32x4 acc[2][2][4][2];
#pragma unroll
    for (int a = 0; a < 2; ++a)
#pragma unroll
        for (int b = 0; b < 2; ++b)
#pragma unroll
            for (int m = 0; m < 4; ++m)
#pragma unroll
                for (int n = 0; n < 2; ++n) acc[a][b][m][n] = (f32x4){0.f, 0.f, 0.f, 0.f};
    bf16x8 At[4][2], B0[2][2], B1[2][2];
    constexpr bool GA = Sched::GATHER;
    unsigned vA[2][2], nvA[2][2];
    PG8_SETVA(vA, cur);
    const char* cA = cur.Ab; const char* cB = cur.Bb;
    PG8_STAGE(PG8_SB(0, 0), cB, voffB); PG8_STAGE(PG8_SA(0, 0), cA, vA[0]); PG8_STAGE(PG8_SB(0, 1), cB + hstepB, voffB); PG8_STAGE(PG8_SA(0, 1), cA, vA[1]);
    if (wr == 1) PG8_BAR;
    PG8_WAIT_V(4); PG8_BAR;
    PG8_STAGE(PG8_SB(1, 0), cB + kstep, voffB); PG8_STAGE(PG8_SA(1, 0), cA + kstep, vA[0]); PG8_STAGE(PG8_SB(1, 1), cB + hstepB + kstep, voffB);
    PG8_WAIT_V(6); PG8_BAR;
    for (;;) {
        const bool has_next = S.next(ui + 1, nxt);
        const char* nA = cA; const char* nB = cB;
        if (has_next) { nA = nxt.Ab; nB = nxt.Bb; if (GA) PG8_SETVA(nvA, nxt); }
        else if (GA) {
#pragma unroll
            for (int h = 0; h < 2; ++h)
#pragma unroll
                for (int i = 0; i < 2; ++i) nvA[h][i] = vA[h][i]; }
#pragma unroll 1
        for (int t = 0; t < nt; t += 2) {
            const bool last = (t == nt - 2);
            const char* a1 = cA + (size_t)(t + 1) * kstep;
            const char* a2 = last ? nA : cA + (size_t)(t + 2) * kstep; const char* b2 = last ? nB : cB + (size_t)(t + 2) * kstep;
            const char* a3 = a2 + kstep; const char* b3 = b2 + kstep;
            unsigned s2[2][2];
#pragma unroll
            for (int h = 0; h < 2; ++h)
#pragma unroll
                for (int i = 0; i < 2; ++i) s2[h][i] = (GA && last) ? nvA[h][i] : vA[h][i];
            PG8_LDB(B0, 0, 0); PG8_SCHED; PG8_LDA(At, 0, 0); PG8_STAGE(PG8_SA(1, 1), a1, vA[1]);
            PG8_WAIT_L(8); PG8_BAR; PG8_WAIT_L(0); PG8_MMA(0, 0, At, B0); PG8_BAR; PG8_SCHED;
            PG8_LDB(B1, 0, 1); PG8_STAGE(PG8_SB(0, 0), b2, voffB);
            PG8_BAR; PG8_WAIT_L(0); PG8_MMA(0, 1, At, B1); PG8_BAR;
            PG8_LDA(At, 0, 1); PG8_STAGE(PG8_SA(0, 0), a2, s2[0]);
            PG8_BAR; PG8_WAIT_L(0); PG8_MMA(1, 0, At, B0); PG8_BAR; PG8_SCHED;
            PG8_STAGE(PG8_SB(0, 1), b2 + hstepB, voffB);
            PG8_WAIT_V(6); PG8_BAR; PG8_MMA(1, 1, At, B1); PG8_BAR;
            PG8_LDB(B0, 1, 0); PG8_SCHED; PG8_LDA(At, 1, 0); PG8_STAGE(PG8_SA(0, 1), a2, s2[1]);
            PG8_WAIT_L(8); PG8_BAR; PG8_WAIT_L(0); PG8_MMA(0, 0, At, B0); PG8_BAR; PG8_SCHED;
            PG8_LDB(B1, 1, 1); PG8_STAGE(PG8_SB(1, 0), b3, voffB);
            PG8_BAR; PG8_WAIT_L(0); PG8_MMA(0, 1, At, B1); PG8_BAR;
            PG8_LDA(At, 1, 1); PG8_STAGE(PG8_SA(1, 0), a3, s2[0]);
            PG8_BAR; PG8_WAIT_L(0); PG8_MMA(1, 0, At, B0); PG8_BAR; PG8_SCHED;
            PG8_STAGE(PG8_SB(1, 1), b3 + hstepB, voffB);
            PG8_WAIT_V(6); PG8_BAR; PG8_MMA(1, 1, At, B1); PG8_BAR;
        }
        { int fr_e = fr, fq_e = fq; asm volatile("" : "+v"(fr_e), "+v"(fq_e));
          E(acc, cur, wr, wc, fr_e, fq_e); }
        if (!has_next) break;
#pragma unroll
        for (int a = 0; a < 2; ++a)
#pragma unroll
            for (int b = 0; b < 2; ++b)
#pragma unroll
                for (int m = 0; m < 4; ++m)
#pragma unroll
                    for (int n = 0; n < 2; ++n) acc[a][b][m][n] = (f32x4){0.f, 0.f, 0.f, 0.f};
        cur = nxt; cA = nA; cB = nB; ++ui;
        if (GA) {
#pragma unroll
        for (int h = 0; h < 2; ++h)
#pragma unroll
            for (int i = 0; i < 2; ++i) vA[h][i] = nvA[h][i]; }
    }
    PG8_WAIT_V(0);
    if (wr == 0) PG8_BAR;
    PG8_BAR;
#undef PG8_SA
#undef PG8_SB
#undef PG8_STAGE
#undef PG8_LDA
#undef PG8_LDB
#undef PG8_MMA
#undef PG8_WAIT_V
#undef PG8_WAIT_L
#undef PG8_BAR
#undef PG8_SCHED
#undef PG8_SETVA
}
#define EPI_FOR(ai, m, bj) _Pragma("unroll") for (int ai = 0; ai < 2; ++ai) _Pragma("unroll") for (int m = 0; m < 4; ++m) _Pragma("unroll") for (int bj = 0; bj < 2; ++bj)
__device__ __forceinline__ u32x4 pack8(f32x4 v0, f32x4 v1) { u32x4 w; w.x = cvt_pk_bf16(v0[0], v0[1]); w.y = cvt_pk_bf16(v0[2], v0[3]); w.z = cvt_pk_bf16(v1[0], v1[1]); w.w = cvt_pk_bf16(v1[2], v1[3]); return w; }
}
using pg8::Unit;

struct EpiG1 {
    static constexpr bool PERM = true;
    const float* rstd; bf16 *zmla, *zrkv, *zlora, *zgate; const float* cmax;
    __device__ __forceinline__ void operator()(const PG8_ACC, const Unit& u, int wr, int wc, int fr, int fq) const {
        bf16* base; int ld, c0;
        if (u.pn < 4) { base = zmla; ld = ZM_LD; c0 = u.pn * 256; } else if (u.pn < 28) { base = zrkv; ld = ZR_LD; c0 = (u.pn - 4) * 256; }
        else if (u.pn < 31) { base = zlora; ld = ZL_LD; c0 = (u.pn - 28) * 256; } else { base = zgate; ld = ZG_LD; c0 = (u.pn - 31) * 256; }
        const int col0 = c0 + wc * 32 + 8 * fq;
        f32x4 cs[2][2];
#pragma unroll
        for (int bj = 0; bj < 2; ++bj) { const float* cp = cmax + u.pn * 256 + bj * 128 + wc * 32 + 8 * fq; cs[bj][0] = *(const f32x4*)cp * (1.0f / 127.0f); cs[bj][1] = *(const f32x4*)(cp + 4) * (1.0f / 127.0f); }
        EPI_FOR(ai, m, bj) { const int row = u.pm * 256 + ai * 128 + wr * 64 + m * 16 + fr; const float rs = rstd[row];
            const f32x4 v0 = __builtin_convertvector(__builtin_bit_cast(pg8::i32x4g, acc[ai][bj][m][0]), f32x4) * rs * cs[bj][0], v1 = __builtin_convertvector(__builtin_bit_cast(pg8::i32x4g, acc[ai][bj][m][1]), f32x4) * rs * cs[bj][1];
            *(u32x4*)(base + (size_t)row * ld + col0 + bj * 128) = pg8::pack8(v0, v1); }
    }
};
struct EpiPlain {
    static constexpr bool PERM = true;
    bf16* O; int ld; const float* rstd; float scale;
    __device__ __forceinline__ void operator()(const PG8_ACC, const Unit& u, int wr, int wc, int fr, int fq) const {
        const int col0 = u.pn * 256 + wc * 32 + 8 * fq;
        EPI_FOR(ai, m, bj) { const int row = u.pm * 256 + ai * 128 + wr * 64 + m * 16 + fr; const float rs = (rstd ? rstd[row] : 1.f) * scale;
            *(u32x4*)(O + (size_t)row * ld + col0 + bj * 128) = pg8::pack8(acc[ai][bj][m][0] * rs, acc[ai][bj][m][1] * rs); }
    }
};
struct EpiPlainI8 {
    static constexpr bool PERM = true;
    bf16* O; int ld; const float* rows; const float* cmax; float scale;
    __device__ __forceinline__ void operator()(const PG8_ACC, const Unit& u, int wr, int wc, int fr, int fq) const {
        const int col0 = u.pn * 256 + wc * 32 + 8 * fq; f32x4 cs[2][2];
#pragma unroll
        for (int bj = 0; bj < 2; ++bj) { const float* cp = cmax + col0 + bj * 128; cs[bj][0] = *(const f32x4*)cp * (scale / 127.0f); cs[bj][1] = *(const f32x4*)(cp + 4) * (scale / 127.0f); }
        EPI_FOR(ai, m, bj) { const int row = u.pm * 256 + ai * 128 + wr * 64 + m * 16 + fr; const float rs = rows[row];
            const f32x4 v0 = __builtin_convertvector(__builtin_bit_cast(pg8::i32x4g, acc[ai][bj][m][0]), f32x4) * rs * cs[bj][0], v1 = __builtin_convertvector(__builtin_bit_cast(pg8::i32x4g, acc[ai][bj][m][1]), f32x4) * rs * cs[bj][1];
            *(u32x4*)(O + (size_t)row * ld + col0 + bj * 128) = pg8::pack8(v0, v1); }
    }
};
constexpr float QSCALE = 0.07216878364870322f * 1.4426950408889634f;
constexpr float CSCALE = 0.08838834764831845f * 1.4426950408889634f;
__device__ __forceinline__ u32x2 pack8_fp8(f32x4 v0, f32x4 v1) {
    int a = __builtin_amdgcn_cvt_pk_fp8_f32(v0[0], v0[1], 0, false); a = __builtin_amdgcn_cvt_pk_fp8_f32(v0[2], v0[3], a, true);
    int b = __builtin_amdgcn_cvt_pk_fp8_f32(v1[0], v1[1], 0, false); b = __builtin_amdgcn_cvt_pk_fp8_f32(v1[2], v1[3], b, true);
    return (u32x2){(unsigned)a, (unsigned)b};
}
struct EpiQ {
    static constexpr bool PERM = true;
    unsigned char* Q; const float* rstd; const float* cs;
    __device__ __forceinline__ void operator()(const PG8_ACC, const Unit& u, int wr, int wc, int fr, int fq) const {
        EPI_FOR(ai, m, bj) { const int row = u.pm * 256 + ai * 128 + wr * 64 + m * 16 + fr; const int col = u.pn * 256 + bj * 128 + wc * 32 + 8 * fq;
            const float rs = rstd[row]; f32x4 v0 = acc[ai][bj][m][0] * rs, v1 = acc[ai][bj][m][1] * rs;
            const int cih = col % QKD;
            if (cih >= NOPE) { const int i0 = (cih - NOPE) >> 1; const f32x4* t = (const f32x4*)(cs + ((size_t)row * 32 + i0) * 2);
                const f32x4 a = t[0], b = t[1];
                f32x4 r0, r1;
                r0[0] = v0[0] * a[0] - v0[1] * a[1]; r0[1] = v0[1] * a[0] + v0[0] * a[1]; r0[2] = v0[2] * a[2] - v0[3] * a[3]; r0[3] = v0[3] * a[2] + v0[2] * a[3];
                r1[0] = v1[0] * b[0] - v1[1] * b[1]; r1[1] = v1[1] * b[0] + v1[0] * b[1]; r1[2] = v1[2] * b[2] - v1[3] * b[3]; r1[3] = v1[3] * b[2] + v1[2] * b[3];
                v0 = r0; v1 = r1; }
            *(u32x2*)(Q + (size_t)row * (MH * QKD) + col) = pack8_fp8(v0, v1); }
    }
};
struct EpiKV {
    static constexpr bool PERM = true;
    unsigned char* Kb; bf16* Vb; const float* rstd;
    __device__ __forceinline__ void operator()(const PG8_ACC, const Unit& u, int wr, int wc, int fr, int fq) const {
        const int c = wc * 32 + 8 * fq;
        EPI_FOR(ai, m, bj) { const int row = u.pm * 256 + ai * 128 + wr * 64 + m * 16 + fr; const float rs = rstd[row];
            if (bj == 0) *(u32x2*)(Kb + (size_t)row * (MH * QKD) + u.pn * QKD + c) = pack8_fp8(acc[ai][bj][m][0] * rs, acc[ai][bj][m][1] * rs);
            else *(u32x4*)(Vb + (size_t)row * (MH * VDIM) + u.pn * VDIM + c) = pg8::pack8(acc[ai][bj][m][0] * rs, acc[ai][bj][m][1] * rs); }
    }
};
template <int MODE> struct EpiLora {
    static constexpr bool PERM = true;
    bf16* O; const float* bias;
    __device__ __forceinline__ void operator()(const PG8_ACC, const Unit& u, int wr, int wc, int fr, int fq) const {
        EPI_FOR(ai, m, bj) { const int row = u.pm * 256 + ai * 128 + wr * 64 + m * 16 + fr; const int col = u.pn * 256 + bj * 128 + wc * 32 + 8 * fq;
            f32x4 v0 = acc[ai][bj][m][0], v1 = acc[ai][bj][m][1];
            if (MODE != 2) { const f32x4 b0 = *(const f32x4*)(bias + col), b1 = *(const f32x4*)(bias + col + 4);
#pragma unroll
                for (int j = 0; j < 4; ++j) { float s0 = sigmoidf_(v0[j] + b0[j]), s1 = sigmoidf_(v1[j] + b1[j]);
                    if (MODE == 0) { s0 *= -0.8750394f; s1 *= -0.8750394f; }
                    v0[j] = s0; v1[j] = s1; } }
            *(u32x4*)(O + (size_t)row * RW + col) = pg8::pack8(v0, v1); }
    }
};
template <int MODE> struct EpiLora2 {
    static constexpr bool PERM = true;
    bf16* O0; bf16* O1; const float* bias0; const float* bias1;
    __device__ __forceinline__ void operator()(const PG8_ACC, const Unit& u, int wr, int wc, int fr, int fq) const {
        const bool second = u.pn >= 8; bf16* O = second ? O1 : O0; const float* bias = second ? bias1 : bias0; const int pn = second ? u.pn - 8 : u.pn;
        EPI_FOR(ai, m, bj) { const int row = u.pm * 256 + ai * 128 + wr * 64 + m * 16 + fr; const int col = pn * 256 + bj * 128 + wc * 32 + 8 * fq;
            f32x4 v0 = acc[ai][bj][m][0], v1 = acc[ai][bj][m][1];
            const f32x4 b0 = *(const f32x4*)(bias + col), b1 = *(const f32x4*)(bias + col + 4);
#pragma unroll
            for (int j = 0; j < 4; ++j) { float s0 = sigmoidf_(v0[j] + b0[j]), s1 = sigmoidf_(v1[j] + b1[j]);
                if (MODE == 0) { s0 *= -0.8750394f; s1 *= -0.8750394f; }
                v0[j] = s0; v1[j] = s1; }
            *(u32x4*)(O + (size_t)row * RW + col) = pg8::pack8(v0, v1); }
    }
};
template <int SECOND, bool I8 = false> struct EpiUp {
    static constexpr bool PERM = true;
    bf16* O; const bf16* zg; int goff; const float* rows; const float* cmax;
    __device__ __forceinline__ void operator()(const PG8_ACC, const Unit& u, int wr, int wc, int fr, int fq) const {
        EPI_FOR(ai, m, bj) { const int row = u.pm * 256 + ai * 128 + wr * 64 + m * 16 + fr; const int col = u.pn * 256 + bj * 128 + wc * 32 + 8 * fq;
            const u32x4 g = *(const u32x4*)(zg + (size_t)row * ZG_LD + goff + col);
            f32x4 v0 = acc[ai][bj][m][0], v1 = acc[ai][bj][m][1];
            if (I8) { const float rs = rows[row] * (1.0f / 127.0f); const f32x4 c0 = *(const f32x4*)(cmax + col), c1 = *(const f32x4*)(cmax + col + 4);
                v0 = __builtin_convertvector(__builtin_bit_cast(pg8::i32x4g, v0), f32x4) * rs * c0; v1 = __builtin_convertvector(__builtin_bit_cast(pg8::i32x4g, v1), f32x4) * rs * c1; }
            v0[0] *= sigmoidf_(bflo(g.x)); v0[1] *= sigmoidf_(bfhi(g.x)); v0[2] *= sigmoidf_(bflo(g.y)); v0[3] *= sigmoidf_(bfhi(g.y));
            v1[0] *= sigmoidf_(bflo(g.z)); v1[1] *= sigmoidf_(bfhi(g.z)); v1[2] *= sigmoidf_(bflo(g.w)); v1[3] *= sigmoidf_(bfhi(g.w));
            bf16* dst = O + (size_t)row * DM + col;
            if (SECOND) { const u32x4 p = *(const u32x4*)dst;
                v0[0] += bflo(p.x); v0[1] += bfhi(p.x); v0[2] += bflo(p.y); v0[3] += bfhi(p.y); v1[0] += bflo(p.z); v1[1] += bfhi(p.z); v1[2] += bflo(p.w); v1[3] += bfhi(p.w); }
            *(u32x4*)dst = pg8::pack8(v0, v1); }
    }
};
struct EpiResid {
    static constexpr bool PERM = true;
    const float* base; float* out;
    __device__ __forceinline__ void operator()(const PG8_ACC, const Unit& u, int wr, int wc, int fr, int fq) const {
        EPI_FOR(ai, m, bj) { const int row = u.pm * 256 + ai * 128 + wr * 64 + m * 16 + fr; const int col = u.pn * 256 + bj * 128 + wc * 32 + 8 * fq;
            const size_t o = (size_t)row * DM + col; const f32x4 b0 = *(const f32x4*)(base + o), b1 = *(const f32x4*)(base + o + 4);
            *(f32x4*)(out + o) = b0 + acc[ai][bj][m][0]; *(f32x4*)(out + o + 4) = b1 + acc[ai][bj][m][1]; }
    }
};

namespace att {
constexpr int NW = 8, QBLK = 32, KVBLK = 64;
constexpr float THRL = 11.5f;
#define SBAR() __builtin_amdgcn_sched_barrier(0)
__device__ __forceinline__ int crow(int r, int hi) { return (r & 3) + 8 * (r >> 2) + 4 * hi; }
template <bool SCALED = false> __device__ __forceinline__ void partialSM(f32x16& p, float& m_reg, float& alpha, const float sc = 1.f) {
    float pmax = p[0];
#pragma unroll
    for (int r = 1; r < 16; ++r) pmax = fmaxf(pmax, p[r]);
    { auto rr = __builtin_amdgcn_permlane32_swap(__float_as_uint(pmax), __float_as_uint(pmax), false, false);
      pmax = fmaxf(__uint_as_float(rr[0]), __uint_as_float(rr[1])); }
    if (SCALED) pmax *= sc;
    float mn;
    if (__builtin_expect(__all(pmax - m_reg <= THRL), 1)) { mn = m_reg; alpha = 1.f; }
    else { mn = fmaxf(m_reg, pmax); alpha = __builtin_amdgcn_exp2f(m_reg - mn); m_reg = mn; }
#pragma unroll
    for (int r = 0; r < 16; ++r) p[r] = SCALED ? __builtin_fmaf(p[r], sc, -mn) : p[r] - mn;
#pragma unroll
    for (int r = 0; r < 8; ++r) p[r] = __builtin_amdgcn_exp2f(p[r]);
}
__device__ __forceinline__ void finishSM(f32x16& p, float alpha, float& l_reg, bf16x8& pa0, bf16x8& pa1) {
#pragma unroll
    for (int r = 8; r < 16; ++r) p[r] = __builtin_amdgcn_exp2f(p[r]);
    float ps = 0;
#pragma unroll
    for (int r = 0; r < 16; ++r) ps += p[r];
    { auto rr = __builtin_amdgcn_permlane32_swap(__float_as_uint(ps), __float_as_uint(ps), false, false);
      ps = __uint_as_float(rr[0]) + __uint_as_float(rr[1]); }
    l_reg = l_reg * alpha + ps;
#define PK4(P, BASE, OUT) do { unsigned a0 = cvt_pk_bf16(P[BASE + 0], P[BASE + 1]), a1 = cvt_pk_bf16(P[BASE + 2], P[BASE + 3]);   \
    unsigned b0 = cvt_pk_bf16(P[BASE + 4], P[BASE + 5]), b1 = cvt_pk_bf16(P[BASE + 6], P[BASE + 7]);                              \
    auto r0 = __builtin_amdgcn_permlane32_swap(a0, b0, false, false); auto r1 = __builtin_amdgcn_permlane32_swap(a1, b1, false, false); \
    u32x4 w = {r0[0], r1[0], r0[1], r1[1]}; OUT = *reinterpret_cast<bf16x8*>(&w); } while (0)
    PK4(p, 0, pa0); PK4(p, 8, pa1);
#undef PK4
}
template <int DQK> __device__ __forceinline__ int kswz(int row, int colB) { return row * (DQK * 2 + 16) + colB; }
template <int DQK> __device__ __forceinline__ void qkt(f32x16& p, const LAS char* Ks, const bf16x8* qr, int krow, int hi) {
    p = f32x16{};
#pragma unroll
    for (int d0 = 0; d0 < DQK / 16; ++d0) { const int cb = (d0 * 16 + hi * 8) * 2;
        bf16x8 b0 = *reinterpret_cast<const LAS bf16x8*>(Ks + kswz<DQK>(krow, cb));
        p = __builtin_amdgcn_mfma_f32_32x32x16_bf16(b0, qr[d0], p, 0, 0, 0); }
}
__device__ __forceinline__ int v_st(int k, int c) { const int kk = (k & ~0xC) | ((k & 4) << 1) | ((k & 8) >> 1); return ((kk >> 3) * 4 + (c >> 5)) * 512 + ((kk & 7) * 32 + (c & 31)) * 2; }
__device__ __forceinline__ int v_rd_base(int lane) { return ((lane & 3) << 3) | (((lane >> 2) & 3) << 6) | (((lane >> 4) & 1) << 5) | (((lane >> 5) & 1) << 8); }
constexpr int v_rd_off(int d0, int ks, int half) { return d0 * 512 + ks * 4096 + half * 2048; }
template <int OFF> __device__ __forceinline__ s16x4 tr_read(int vb) {
    s16x4 r; asm volatile("ds_read_b64_tr_b16 %0, %1 offset:%2" : "=&v"(r) : "v"(vb), "i"(OFF) : "memory"); return r;
}
template <int D0, int KH> __device__ __forceinline__ void pv_one(f32x16& od, int vb, bf16x8 pa0, bf16x8 pa1) {
    const s16x4 l0 = tr_read<v_rd_off(D0, 2 * KH, 0)>(vb), h0 = tr_read<v_rd_off(D0, 2 * KH, 1)>(vb), l1 = tr_read<v_rd_off(D0, 2 * KH + 1, 0)>(vb), h1 = tr_read<v_rd_off(D0, 2 * KH + 1, 1)>(vb);
    asm volatile("s_waitcnt lgkmcnt(0)" ::: "memory"); SBAR();
#define PK(L, H) (bf16x8){L[0], L[1], L[2], L[3], H[0], H[1], H[2], H[3]}
    od = __builtin_amdgcn_mfma_f32_32x32x16_bf16(pa0, PK(l0, h0), od, 0, 0, 0);
    od = __builtin_amdgcn_mfma_f32_32x32x16_bf16(pa1, PK(l1, h1), od, 0, 0, 0);
#undef PK
}
template <int KH> __device__ __forceinline__ void pv_d0(f32x16* o, int vb, bf16x8 pa0, bf16x8 pa1) {
    pv_one<0, KH>(o[0], vb, pa0, pa1); pv_one<1, KH>(o[1], vb, pa0, pa1); pv_one<2, KH>(o[2], vb, pa0, pa1); pv_one<3, KH>(o[3], vb, pa0, pa1);
}
template <int DQK, int LDQ, int LDK, int LDV, int LDO>
__device__ __forceinline__ void attn_unit(const bf16* __restrict__ Qb, const bf16* __restrict__ Kh, const bf16* __restrict__ Vh, bf16* __restrict__ Ob, const int seq, LAS char* lds) {
    constexpr int SHM_V = KVBLK * 128 * 2, SHM_K = KVBLK * (DQK * 2 + 16), KCH = DQK / 64;
    const int tid = threadIdx.x, wid = tid >> 6, lane = tid & 63, r32 = lane & 31, hi = lane >> 5;
    LAS char* V_lds = lds; LAS char* K_lds = lds + 2 * SHM_V;
    LAS float* wsf = (LAS float*)(lds + 2 * SHM_V + 2 * SHM_K) + wid * 64; LAS float* li_l = wsf; LAS float* al_l = wsf + 32;
    float m_reg = -1e30f, l_reg = 0; f32x16 o[4] = {}; bf16x8 qr[DQK / 16];
    const bf16* Qw = Qb + (long)(wid * QBLK + r32) * LDQ + hi * 8;
#pragma unroll
    for (int d0 = 0; d0 < DQK / 16; ++d0) qr[d0] = *reinterpret_cast<const bf16x8*>(Qw + d0 * 16);
    const int sr = tid >> 4, sc = (tid & 15) * 8, vst0 = v_st(sr, sc), vst1 = v_st(32 + sr, sc);
    unsigned kgo[KCH]; int klo[KCH];
#pragma unroll
    for (int i = 0; i < KCH; ++i) { const int id = tid + 512 * i, row = id / (DQK / 8), c8 = id % (DQK / 8); kgo[i] = (unsigned)(row * LDK + c8 * 8) * 2u; klo[i] = kswz<DQK>(row, c8 * 16); }
    const unsigned vgo0 = (unsigned)(sr * LDV + sc) * 2u, vgo1 = (unsigned)((32 + sr) * LDV + sc) * 2u;
    const int vb0 = (int)(uintptr_t)V_lds + v_rd_base(lane);
    bf16x8 vs0, vs1, ks[KCH];
#define SLOAD(k0) do { const char* _vt = (const char*)(Vh + (size_t)(k0) * LDV); const char* _kt = (const char*)(Kh + (size_t)(k0) * LDK); \
    vs0 = *reinterpret_cast<const bf16x8*>(_vt + vgo0); vs1 = *reinterpret_cast<const bf16x8*>(_vt + vgo1); \
    _Pragma("unroll") for (int _i = 0; _i < KCH; ++_i) ks[_i] = *reinterpret_cast<const bf16x8*>(_kt + kgo[_i]); } while (0)
#define SWRITE(b) do { *(LAS bf16x8*)(V_lds + (b) * SHM_V + vst0) = vs0; *(LAS bf16x8*)(V_lds + (b) * SHM_V + vst1) = vs1; \
    _Pragma("unroll") for (int _i = 0; _i < KCH; ++_i) *(LAS bf16x8*)(K_lds + (b) * SHM_K + klo[_i]) = ks[_i]; } while (0)
#define SWAIT() asm volatile("s_waitcnt vmcnt(0)" ::: "memory")
#define RESC(a) do { if (__any((a) < 1.f)) { if (hi == 0) al_l[r32] = (a); asm volatile("s_waitcnt lgkmcnt(0)" ::: "memory"); \
    _Pragma("unroll") for (int d = 0; d < 4; ++d) _Pragma("unroll") for (int r = 0; r < 16; ++r) o[d][r] *= al_l[crow(r, hi)]; } } while (0)
    f32x16 pA, pB; float alA, alB; bf16x8 pa0, pa1; const int NT = seq / KVBLK;
    SLOAD(0); SWAIT(); SWRITE(0); __syncthreads();
    if (1 < NT) SLOAD(KVBLK);
    qkt<DQK>(pA, K_lds, qr, r32, hi); partialSM(pA, m_reg, alA);
    if (1 < NT) { SWAIT(); SWRITE(1); } __syncthreads();
    if (2 < NT) SLOAD(2 * KVBLK);
    SBAR(); qkt<DQK>(pB, K_lds, qr, 32 + r32, hi);
    finishSM(pA, alA, l_reg, pa0, pa1); SBAR();
    pv_d0<0>(o, vb0, pa0, pa1); partialSM(pB, m_reg, alB); RESC(alB);
    for (int j = 1; j < NT; ++j) {
        const int cb = j & 1, pb = cb ^ 1;
        SBAR(); qkt<DQK>(pA, K_lds + cb * SHM_K, qr, r32, hi);
        finishSM(pB, alB, l_reg, pa0, pa1); SBAR();
        pv_d0<1>(o, vb0 + pb * SHM_V, pa0, pa1); partialSM(pA, m_reg, alA);
        __syncthreads(); if (j + 1 < NT) { SWAIT(); SWRITE(pb); }
        RESC(alA); __syncthreads();
        if (j + 2 < NT) SLOAD((j + 2) * KVBLK);
        SBAR(); qkt<DQK>(pB, K_lds + cb * SHM_K, qr, 32 + r32, hi);
        finishSM(pA, alA, l_reg, pa0, pa1); SBAR();
        pv_d0<0>(o, vb0 + cb * SHM_V, pa0, pa1); partialSM(pB, m_reg, alB); RESC(alB);
    }
    finishSM(pB, alB, l_reg, pa0, pa1); SBAR();
    pv_d0<1>(o, vb0 + ((NT - 1) & 1) * SHM_V, pa0, pa1);
    if (hi == 0) li_l[r32] = l_reg; asm volatile("s_waitcnt lgkmcnt(0)" ::: "memory");
    float rli[16];
#pragma unroll
    for (int r = 0; r < 16; ++r) rli[r] = __builtin_amdgcn_rcpf(li_l[crow(r, hi)]);
    bf16* Ow = Ob + (size_t)(wid * QBLK) * LDO;
    int r32e = r32, hie = hi; asm volatile("" : "+v"(r32e), "+v"(hie));
    const unsigned ob = (unsigned)(4 * hie * LDO + r32e);
#pragma unroll
    for (int r = 0; r < 16; ++r) {
#pragma unroll
        for (int d0 = 0; d0 < 4; ++d0) Ow[ob + (unsigned)(((r & 3) + 8 * (r >> 2)) * LDO + d0 * 32)] = f2bf(o[d0][r] * rli[r]); }
    __syncthreads();
#undef SLOAD
#undef SWRITE
#undef SWAIT
#undef RESC
}
typedef int i32x8 __attribute__((ext_vector_type(8)));
__device__ __forceinline__ void qkt_f8(f32x16& p, const LAS char* Ks, const i32x8* qr, int krow, int hi) {
    p = f32x16{};
#pragma unroll
    for (int d0 = 0; d0 < 3; ++d0) { const LAS char* a = Ks + krow * 208 + d0 * 64 + hi * 32;
        const u32x4 lo = *reinterpret_cast<const LAS u32x4*>(a), hh = *reinterpret_cast<const LAS u32x4*>(a + 16);
        const i32x8 av = {(int)lo.x, (int)lo.y, (int)lo.z, (int)lo.w, (int)hh.x, (int)hh.y, (int)hh.z, (int)hh.w};
        p = __builtin_amdgcn_mfma_scale_f32_32x32x64_f8f6f4(av, qr[d0], p, 0, 0, 0, 0, 0, 0); }
}
template <int LDQ, int LDK, int LDV, int LDO>
__device__ __forceinline__ void attn_unit_f8(const unsigned char* __restrict__ Qb, const unsigned char* __restrict__ Kh, const bf16* __restrict__ Vh, bf16* __restrict__ Ob, const int seq, const float SC, LAS char* lds) {
    constexpr int SHM_V = KVBLK * 128 * 2, SHM_K = KVBLK * 208;
    const int tid = threadIdx.x, wid = tid >> 6, lane = tid & 63, r32 = lane & 31, hi = lane >> 5;
    LAS char* V_lds = lds; LAS char* K_lds = lds + 2 * SHM_V;
    LAS float* wsf = (LAS float*)(lds + 2 * SHM_V + 2 * SHM_K) + wid * 64; LAS float* li_l = wsf; LAS float* al_l = wsf + 32;
    float m_reg = -1e30f, l_reg = 0; f32x16 o[4] = {}; i32x8 qr[3];
    { const unsigned char* Qw = Qb + (long)(wid * QBLK + r32) * LDQ + hi * 32;
#pragma unroll
      for (int d0 = 0; d0 < 3; ++d0) { const u32x4 lo = *reinterpret_cast<const u32x4*>(Qw + d0 * 64), hh = *reinterpret_cast<const u32x4*>(Qw + d0 * 64 + 16);
          qr[d0] = (i32x8){(int)lo.x, (int)lo.y, (int)lo.z, (int)lo.w, (int)hh.x, (int)hh.y, (int)hh.z, (int)hh.w}; } }
    const int sr = tid >> 4, sc = (tid & 15) * 8, vst0 = v_st(sr, sc), vst1 = v_st(32 + sr, sc);
    const bool k2 = wid < 4;
    const int id0 = tid, id1 = 512 + tid;
    const unsigned kgo0 = (unsigned)((id0 / 12) * LDK + (id0 % 12) * 16), kgo1 = (unsigned)((id1 / 12) * LDK + (id1 % 12) * 16);
    const int klo0 = (id0 / 12) * 208 + (id0 % 12) * 16, klo1 = (id1 / 12) * 208 + (id1 % 12) * 16;
    const unsigned vgo0 = (unsigned)(sr * LDV + sc) * 2u, vgo1 = (unsigned)((32 + sr) * LDV + sc) * 2u;
    const int vb0 = (int)(uintptr_t)V_lds + v_rd_base(lane);
    bf16x8 vs0, vs1; u32x4 ks0, ks1 = {0u, 0u, 0u, 0u};
#define SLOAD(k0) do { const char* _vt = (const char*)(Vh + (size_t)(k0) * LDV); const unsigned char* _kt = Kh + (size_t)(k0) * LDK; \
    vs0 = *reinterpret_cast<const bf16x8*>(_vt + vgo0); vs1 = *reinterpret_cast<const bf16x8*>(_vt + vgo1); \
    ks0 = *reinterpret_cast<const u32x4*>(_kt + kgo0); if (k2) ks1 = *reinterpret_cast<const u32x4*>(_kt + kgo1); } while (0)
#define SWRITE(b) do { *(LAS bf16x8*)(V_lds + (b) * SHM_V + vst0) = vs0; *(LAS bf16x8*)(V_lds + (b) * SHM_V + vst1) = vs1; \
    *(LAS u32x4*)(K_lds + (b) * SHM_K + klo0) = ks0; if (k2) *(LAS u32x4*)(K_lds + (b) * SHM_K + klo1) = ks1; } while (0)
#define SWAIT() asm volatile("s_waitcnt vmcnt(0)" ::: "memory")
#define RESC(a) do { if (__any((a) < 1.f)) { if (hi == 0) al_l[r32] = (a); asm volatile("s_waitcnt lgkmcnt(0)" ::: "memory"); \
    _Pragma("unroll") for (int d = 0; d < 4; ++d) _Pragma("unroll") for (int r = 0; r < 16; ++r) o[d][r] *= al_l[crow(r, hi)]; } } while (0)
    f32x16 pA, pB; float alA, alB; bf16x8 pa0, pa1; const int NT = seq / KVBLK;
    SLOAD(0); SWAIT(); SWRITE(0); __syncthreads();
    if (1 < NT) SLOAD(KVBLK);
    qkt_f8(pA, K_lds, qr, r32, hi); partialSM<true>(pA, m_reg, alA, SC);
    if (1 < NT) { SWAIT(); SWRITE(1); } __syncthreads();
    if (2 < NT) SLOAD(2 * KVBLK);
    SBAR(); qkt_f8(pB, K_lds, qr, 32 + r32, hi);
    finishSM(pA, alA, l_reg, pa0, pa1); SBAR();
    pv_d0<0>(o, vb0, pa0, pa1); partialSM<true>(pB, m_reg, alB, SC); RESC(alB);
    for (int j = 1; j < NT; ++j) {
        const int cb = j & 1, pb = cb ^ 1;
        SBAR(); qkt_f8(pA, K_lds + cb * SHM_K, qr, r32, hi);
        finishSM(pB, alB, l_reg, pa0, pa1); SBAR();
        pv_d0<1>(o, vb0 + pb * SHM_V, pa0, pa1); partialSM<true>(pA, m_reg, alA, SC);
        __syncthreads(); if (j + 1 < NT) { SWAIT(); SWRITE(pb); }
        RESC(alA); __syncthreads();
        if (j + 2 < NT) SLOAD((j + 2) * KVBLK);
        SBAR(); qkt_f8(pB, K_lds + cb * SHM_K, qr, 32 + r32, hi);
        finishSM(pA, alA, l_reg, pa0, pa1); SBAR();
        pv_d0<0>(o, vb0 + cb * SHM_V, pa0, pa1); partialSM<true>(pB, m_reg, alB, SC); RESC(alB);
    }
    finishSM(pB, alB, l_reg, pa0, pa1); SBAR();
    pv_d0<1>(o, vb0 + ((NT - 1) & 1) * SHM_V, pa0, pa1);
    if (hi == 0) li_l[r32] = l_reg; asm volatile("s_waitcnt lgkmcnt(0)" ::: "memory");
    float rli[16];
#pragma unroll
    for (int r = 0; r < 16; ++r) rli[r] = __builtin_amdgcn_rcpf(li_l[crow(r, hi)]);
    bf16* Ow = Ob + (size_t)(wid * QBLK) * LDO;
    int r32e = r32, hie = hi; asm volatile("" : "+v"(r32e), "+v"(hie));
    const unsigned ob = (unsigned)(4 * hie * LDO + r32e);
#pragma unroll
    for (int r = 0; r < 16; ++r) {
#pragma unroll
        for (int d0 = 0; d0 < 4; ++d0) Ow[ob + (unsigned)(((r & 3) + 8 * (r >> 2)) * LDO + d0 * 32)] = f2bf(o[d0][r] * rli[r]); }
    __syncthreads();
#undef SLOAD
#undef SWRITE
#undef SWAIT
#undef RESC
}
__device__ __forceinline__ float f8_map_probe(const int lane) {
    const int r = lane & 31, h = lane >> 5;
    const float am = 1.f + (float)((r >> 2) & 1), bm = 1.f + (float)((r >> 3) & 1);
    i32x8 a, b;
#pragma unroll
    for (int w = 0; w < 8; ++w) { const int k0 = 32 * h + 4 * w; int pa = 0, pb = 0;
        pa = __builtin_amdgcn_cvt_pk_fp8_f32((float)((k0 + 0) & 7) * am, (float)((k0 + 1) & 7) * am, pa, false); pa = __builtin_amdgcn_cvt_pk_fp8_f32((float)((k0 + 2) & 7) * am, (float)((k0 + 3) & 7) * am, pa, true);
        pb = __builtin_amdgcn_cvt_pk_fp8_f32((float)((3 * (k0 + 0) + 1) % 7) * bm, (float)((3 * (k0 + 1) + 1) % 7) * bm, pb, false); pb = __builtin_amdgcn_cvt_pk_fp8_f32((float)((3 * (k0 + 2) + 1) % 7) * bm, (float)((3 * (k0 + 3) + 1) % 7) * bm, pb, true);
        a[w] = pa; b[w] = pb; }
    f32x16 d = {};
    d = __builtin_amdgcn_mfma_scale_f32_32x32x64_f8f6f4(a, b, d, 0, 0, 0, 0, 0, 0);
    float e0 = 0.f;
    for (int k = 0; k < 64; ++k) e0 += (float)(k & 7) * (float)((3 * k + 1) % 7);
    float err = 0.f;
#pragma unroll
    for (int rr = 0; rr < 16; ++rr) { const int row = crow(rr, h), col = r; const float ex = e0 * (1.f + (float)((row >> 2) & 1)) * (1.f + (float)((col >> 3) & 1)); err = fmaxf(err, fabsf(d[rr] - ex)); }
#pragma unroll
    for (int o = 32; o >= 1; o >>= 1) err = fmaxf(err, __shfl_xor(err, o));
    return err;
}
}

struct Frame {
    LAS unsigned char* lds; volatile LAS unsigned* MISC; unsigned* ctl;
    int tid, lane, wave, vcu, G;
    unsigned char* ws; float* out;
    const float* in[41];
};
enum { I_X = 0, I_MEM, I_POS, I_GMIX, I_WIN, I_GQ, I_WUQ, I_GKV, I_WUKV, I_SHIFT, I_W0F, I_W2F, I_W0B, I_W2B, I_A0F, I_A2F, I_A0B, I_A2B, I_G2, I_KK, I_KA, I_RK,
       I_LNXG, I_LNXB, I_WUPM, I_WUPR, I_WOUT, I_GCROSS, I_GMEM, I_WQC, I_WKVC, I_WOC, I_GFFN, I_WRG, I_BRG, I_WRE, I_BRE, I_WEG, I_WEU, I_WED, I_GFINAL };

template <int MODE> __device__ __forceinline__ int rowmap(int n) {
    if (MODE == 1) {
        if (n < 768) return n;
        if (n < 832) { const int p = n - 768; return 768 + (p < 32 ? 2 * p : 2 * (p - 32) + 1); }
        if (n < 6976) return 1024 + (n - 832);
        if (n < 7616) return 7168 + (n - 6976);
        return 7936 + (n - 7616);
    }
    if (MODE == 2) {
        const int h = n / QKD, d = n % QKD; if (d < NOPE) return n; const int p = d - NOPE; return h * QKD + NOPE + (p < 32 ? 2 * p : 2 * (p - 32) + 1);
    }
    if (MODE == 3) return (n >> 7) * 256 + (n & 127);
    if (MODE == 4) return (n >> 7) * 256 + 128 + (n & 127);
    return n;
}
constexpr int CVT_SCR = 16640;
template <int MODE> __device__ __forceinline__ void cvt_item(const float* W, int K, int N, const float* gain, bf16* WT, int ldt, LAS float* scr, int item, int lane, int kofs = 0) {
    const int nblk = N / 64, kb = item / nblk, nb = item % nblk, k0 = 64 * kb, n0 = 64 * nb;
    const int kq = lane >> 4, nc = (lane & 15) * 4;
    f32x4 v[16];
#pragma unroll
    for (int i = 0; i < 16; ++i) { const int k = k0 + 4 * i + kq - kofs; v[i] = (f32x4){0.f, 0.f, 0.f, 0.f};
        if (k >= 0 && k < K) { v[i] = *(const f32x4*)(W + (size_t)k * N + n0 + nc); if (gain) v[i] = v[i] * gain[k]; } }
#pragma unroll
    for (int i = 0; i < 16; ++i) { const int kk = 4 * i + kq;
#pragma unroll
        for (int c = 0; c < 4; ++c) scr[(nc + c) * 65 + kk] = v[i][c]; }
    LDS_WAIT(); asm volatile("" ::: "memory");
    const int kc = (lane & 7) * 8;
#pragma unroll
    for (int jj = 0; jj < 8; ++jj) { const int n = (lane >> 3) + 8 * jj; const LAS float* s = scr + n * 65 + kc;
        u32x4 o; o.x = cvt_pk_bf16(s[0], s[1]); o.y = cvt_pk_bf16(s[2], s[3]); o.z = cvt_pk_bf16(s[4], s[5]); o.w = cvt_pk_bf16(s[6], s[7]);
        *(u32x4*)(WT + (size_t)rowmap<MODE>(n0 + n) * ldt + k0 + kc) = o; }
    LDS_WAIT(); asm volatile("" ::: "memory");
}
#define CVT_JOB(MODE, src, K, N, gain, dst, ldt) { const int _n = (((K) + 63) / 64) * ((N) / 64); if (r < _n) { cvt_item<MODE>(src, K, N, gain, dst, ldt, scr, r, F.lane); continue; } r -= _n; }
#define CVT_JOB_PAD(src, K, N, dst, KPAD, KOFS) { const int _n = ((KPAD) / 64) * ((N) / 64); if (r < _n) { cvt_item<0>(src, K, N, nullptr, dst, KPAD, scr, r, F.lane, KOFS); continue; } r -= _n; }
struct CvtD { const float* W; const float* gain; bf16* WT; int K, N, ldt, mode, kofs, item, q, cm; };
__device__ __forceinline__ unsigned pack4_i8(float a, float b, float c, float d) { const int i0 = (int)a, i1 = (int)b, i2 = (int)c, i3 = (int)d; return (unsigned)(i0 & 255) | ((unsigned)(i1 & 255) << 8) | ((unsigned)(i2 & 255) << 16) | ((unsigned)i3 << 24); }
__device__ __forceinline__ int rowmap_rt(int mode, int n) { return mode == 1 ? rowmap<1>(n) : mode == 2 ? rowmap<2>(n) : mode == 3 ? rowmap<3>(n) : mode == 4 ? rowmap<4>(n) : n; }
__device__ __forceinline__ void cvt_load(const CvtD& d, int lane, f32x4 (&v)[16], float (&g)[16]) {
    const int nblk = d.N / 64, kb = d.item / nblk, nb = d.item % nblk, k0 = 64 * kb, n0 = 64 * nb; const int kq = lane >> 4, nc = (lane & 15) * 4;
#pragma unroll
    for (int i = 0; i < 16; ++i) { const int k = k0 + 4 * i + kq - d.kofs; v[i] = (f32x4){0.f, 0.f, 0.f, 0.f}; g[i] = 1.f;
        if (k >= 0 && k < d.K) { v[i] = *(const f32x4*)(d.W + (size_t)k * d.N + n0 + nc); if (d.gain) g[i] = d.gain[k]; } }
}
__device__ __forceinline__ void cvt_process(const CvtD& d, int lane, f32x4 (&v)[16], float (&g)[16], LAS float* scr, const float* colmax) {
    const int nblk = d.N / 64, kb = d.item / nblk, nb = d.item % nblk, k0 = 64 * kb, n0 = 64 * nb; const int kq = lane >> 4, nc = (lane & 15) * 4;
#pragma unroll
    for (int i = 0; i < 16; ++i) { const int kk = 4 * i + kq;
#pragma unroll
        for (int c = 0; c < 4; ++c) scr[(nc + c) * 65 + kk] = v[i][c] * g[i]; }
    LDS_WAIT(); asm volatile("" ::: "memory");
    const int kc = (lane & 7) * 8;
#pragma unroll
    for (int jj = 0; jj < 8; ++jj) { const int n = (lane >> 3) + 8 * jj; const LAS float* s = scr + n * 65 + kc; const int rm = rowmap_rt(d.mode, n0 + n);
        { u32x4 o; o.x = cvt_pk_bf16(s[0], s[1]); o.y = cvt_pk_bf16(s[2], s[3]); o.z = cvt_pk_bf16(s[4], s[5]); o.w = cvt_pk_bf16(s[6], s[7]);
            *(u32x4*)(d.WT + (size_t)rm * d.ldt + k0 + kc) = o; } }
    LDS_WAIT(); asm volatile("" ::: "memory");
}
#define CVT_PIPE(TOTAL_, DESC_) do { CvtD dA, dB; f32x4 vA[16], vB[16]; float gA[16], gB[16]; int it = gw; \
        if (it < (TOTAL_)) { DESC_(it, dA); cvt_load(dA, F.lane, vA, gA); } \
        for (; it < (TOTAL_); it += 2 * NGW) { const int itn = it + NGW, itn2 = it + 2 * NGW; \
            if (itn < (TOTAL_)) { DESC_(itn, dB); cvt_load(dB, F.lane, vB, gB); } \
            cvt_process(dA, F.lane, vA, gA, scr, CVT_COLMAX); \
            if (itn2 < (TOTAL_)) { DESC_(itn2, dA); cvt_load(dA, F.lane, vA, gA); } \
            if (itn < (TOTAL_)) cvt_process(dB, F.lane, vB, gB, scr, CVT_COLMAX); } } while (0)

#define CVT_COLMAX ((const float*)F.ctl)
__device__ __forceinline__ void p0b_quant_rows(Frame& F) {
    const int gw = F.vcu * 8 + F.wave, NGW = F.G * 8, l = F.lane; unsigned char* ws = F.ws; float* ctlf = (float*)F.ctl;
    constexpr int NROWS = G1_N + CW + 2 * CW + DM;
    for (int it = gw; it < NROWS; it += NGW) {
        const unsigned char* src; unsigned char* dst; int cm, r = it;
        if (r < G1_N) { if ((r >= 832 && r < 1024) || (r >= 7808 && r < 7936)) continue;
            src = ws + WS_TMP_WIN; dst = ws + WS_WIN; cm = CW_COLMAX; }
        else if ((r -= G1_N) < CW) { src = ws + WS_TMP_WQC; dst = ws + WS_WQC; cm = CW_CM_QC; }
        else if ((r -= CW) < 2 * CW) { src = ws + WS_TMP_WKVC; dst = ws + WS_WKVC; cm = CW_CM_KVC; }
        else { r -= 2 * CW; src = ws + WS_TMP_WUPR; dst = ws + WS_WUPR; cm = CW_CM_UPR; }
        const u32x4* sp = (const u32x4*)(src + (size_t)r * (DM * 2)) + 4 * l;
        float v[32];
#pragma unroll
        for (int c = 0; c < 4; ++c) { const u32x4 a = sp[c]; v[8 * c + 0] = bflo(a.x); v[8 * c + 1] = bfhi(a.x); v[8 * c + 2] = bflo(a.y); v[8 * c + 3] = bfhi(a.y); v[8 * c + 4] = bflo(a.z); v[8 * c + 5] = bfhi(a.z); v[8 * c + 6] = bflo(a.w); v[8 * c + 7] = bfhi(a.w); }
        float am = 0.f;
#pragma unroll
        for (int e = 0; e < 32; ++e) am = fmaxf(am, fabsf(v[e]));
#pragma unroll
        for (int o = 32; o >= 1; o >>= 1) am = fmaxf(am, __shfl_xor(am, o));
        if (l == 0) ctlf[cm + r] = am;
        const float q = 127.0f / fmaxf(am, 1e-30f);
        u32x4* dp = (u32x4*)(dst + (size_t)r * DM) + 2 * l;
#pragma unroll
        for (int c = 0; c < 2; ++c) dp[c] = (u32x4){pack4_i8(rintf(v[16 * c + 0] * q), rintf(v[16 * c + 1] * q), rintf(v[16 * c + 2] * q), rintf(v[16 * c + 3] * q)), pack4_i8(rintf(v[16 * c + 4] * q), rintf(v[16 * c + 5] * q), rintf(v[16 * c + 6] * q), rintf(v[16 * c + 7] * q)),
                                         pack4_i8(rintf(v[16 * c + 8] * q), rintf(v[16 * c + 9] * q), rintf(v[16 * c + 10] * q), rintf(v[16 * c + 11] * q)), pack4_i8(rintf(v[16 * c + 12] * q), rintf(v[16 * c + 13] * q), rintf(v[16 * c + 14] * q), rintf(v[16 * c + 15] * q))};
    }
}
__device__ __forceinline__ void p0_prologue(Frame& F) {
    LAS float* scr = (LAS float*)(F.lds + F.wave * CVT_SCR);
    const int gw = F.vcu * 8 + F.wave, NGW = F.G * 8;
    unsigned char* ws = F.ws;
    constexpr int TOTAL = 32 * (IN_W / 64) + 8 * 48 + 4 * 64 + 4 * (4 * 32) + 4 * 32 + 3 * (32 * 32) + 32 * 8 + 32 * 16 + 8 * 32;
#define P0_SETD(d, mode_, src_, K_, N_, gain_, dst_, ldt_, KPAD_, KOFS_, Q_, CM_) { const int _n = ((KPAD_) / 64) * ((N_) / 64); if (r < _n) { d.W = src_; d.gain = gain_; d.WT = dst_; d.K = K_; d.N = N_; d.ldt = ldt_; d.mode = mode_; d.kofs = KOFS_; d.item = r; d.q = Q_; d.cm = CM_; break; } r -= _n; }
#define P0_DESC(it_, d) do { int r = (it_); \
        P0_SETD(d, 1, F.in[I_WIN], DM, IN_W, F.in[I_GMIX], (bf16*)(ws + WS_TMP_WIN), DM, DM, 0, 0, 0) \
        P0_SETD(d, 2, F.in[I_WUQ], QLORA, MH * QKD, F.in[I_GQ], (bf16*)(ws + WS_WUQ), QLORA, QLORA, 0, 0, 0) \
        P0_SETD(d, 0, F.in[I_WUKV], KVLORA, MH * 256, F.in[I_GKV], (bf16*)(ws + WS_WUKV), KVLORA, KVLORA, 0, 0, 0) \
        P0_SETD(d, 0, F.in[I_W2F], DLORA, RW, nullptr, (bf16*)(ws + WS_W2F), 256, 256, 0, 0, 0) \
        P0_SETD(d, 0, F.in[I_W2B], DLORA, RW, nullptr, (bf16*)(ws + WS_W2F + 1 * MiB), 256, 256, 128, 0, 0) \
        P0_SETD(d, 0, F.in[I_A2F], DLORA, RW, nullptr, (bf16*)(ws + WS_W2F + 2 * MiB), 256, 256, 0, 0, 0) \
        P0_SETD(d, 0, F.in[I_A2B], DLORA, RW, nullptr, (bf16*)(ws + WS_W2F + 3 * MiB), 256, 256, 128, 0, 0) \
        P0_SETD(d, 0, F.in[I_G2], GLORA, RW, nullptr, (bf16*)(ws + WS_G2), GLORA, GLORA, 0, 0, 0) \
        P0_SETD(d, 0, F.in[I_WUPM], DM, DM, nullptr, (bf16*)(ws + WS_WUPM), DM, DM, 0, 0, 0) \
        P0_SETD(d, 0, F.in[I_WUPR], DM, DM, nullptr, (bf16*)(ws + WS_TMP_WUPR), DM, DM, 0, 0, 0) \
        P0_SETD(d, 0, F.in[I_WOUT], DM, DM, nullptr, (bf16*)(ws + WS_WOUT), DM, DM, 0, 0, 0) \
        P0_SETD(d, 0, F.in[I_WQC], DM, CW, F.in[I_GCROSS], (bf16*)(ws + WS_TMP_WQC), DM, DM, 0, 0, 0) \
        P0_SETD(d, 0, F.in[I_WKVC], DM, 2 * CW, nullptr, (bf16*)(ws + WS_TMP_WKVC), DM, DM, 0, 0, 0) \
        P0_SETD(d, 0, F.in[I_WOC], CW, DM, nullptr, (bf16*)(ws + WS_WOC), CW, CW, 0, 0, 0) \
    } while (0)
    CVT_PIPE(TOTAL, P0_DESC);
#undef P0_SETD
#undef P0_DESC
    const float* x = F.in[I_X]; bf16* xb = (bf16*)(ws + WS_XB); float* rstd1 = (float*)(ws + WS_RSTD);
    for (int m = gw; m < MT + NB * MEMLEN; m += NGW) {
        const bool ismem = m >= MT; const int mm = ismem ? m - MT : m;
        const f32x4* xr = (const f32x4*)((ismem ? F.in[I_MEM] : x) + (size_t)mm * DM) + F.lane;
        f32x4 v[8]; float s = 0.f;
#pragma unroll
        for (int j = 0; j < 8; ++j) { v[j] = xr[64 * j]; s += (v[j].x * v[j].x + v[j].y * v[j].y) + (v[j].z * v[j].z + v[j].w * v[j].w); }
        const float rs = 1.0f / sqrtf(wave_sum(s) * (1.f / DM) + RMS_EPS);
        if (!ismem) {
            float am = 0.f;
#pragma unroll
            for (int j = 0; j < 8; ++j) am = fmaxf(am, fmaxf(fmaxf(fabsf(v[j].x), fabsf(v[j].y)), fmaxf(fabsf(v[j].z), fabsf(v[j].w))));
#pragma unroll
            for (int o = 32; o >= 1; o >>= 1) am = fmaxf(am, __shfl_xor(am, o));
            am = fmaxf(am, 1e-30f); const float qs = 127.f / am;
            if (F.lane == 0) rstd1[mm] = rs * am * (1.f / 127.f);
            unsigned* o8 = (unsigned*)((unsigned char*)xb + (size_t)mm * DM) + F.lane;
#pragma unroll
            for (int j = 0; j < 8; ++j) o8[64 * j] = pack4_i8(rintf(v[j].x * qs), rintf(v[j].y * qs), rintf(v[j].z * qs), rintf(v[j].w * qs));
        } else { const f32x4* gr = (const f32x4*)F.in[I_GMEM] + F.lane; float am = 0.f;
#pragma unroll
            for (int j = 0; j < 8; ++j) { const f32x4 g = gr[64 * j]; v[j] = (f32x4){v[j].x * rs * g.x, v[j].y * rs * g.y, v[j].z * rs * g.z, v[j].w * rs * g.w};
                am = fmaxf(am, fmaxf(fmaxf(fabsf(v[j].x), fabsf(v[j].y)), fmaxf(fabsf(v[j].z), fabsf(v[j].w)))); }
#pragma unroll
            for (int o = 32; o >= 1; o >>= 1) am = fmaxf(am, __shfl_xor(am, o));
            am = fmaxf(am, 1e-30f); const float qs = 127.f / am;
            if (F.lane == 0) ((float*)F.ctl)[CW_MEMSCALE + mm] = am * (1.f / 127.f);
            unsigned* o8 = (unsigned*)(ws + WS_MEMN + (size_t)mm * DM) + F.lane;
#pragma unroll
            for (int j = 0; j < 8; ++j) o8[64 * j] = pack4_i8(rintf(v[j].x * qs), rintf(v[j].y * qs), rintf(v[j].z * qs), rintf(v[j].w * qs));
        }
    }
    const int gt = F.vcu * 512 + F.tid, NGT = F.G * 512;
    { const int* pos = (const int*)F.in[I_POS]; f32x2* cs = (f32x2*)(ws + WS_ROPE);
      for (int i = gt; i < MT * 32; i += NGT) { const int t = i >> 5, f = i & 31;
          const float inv = exp2f(-(float)f * (13.287712379549449f / 32.0f));
          const float ang = (float)pos[t] * inv;
          const double a = (double)ang; const double k = rint(a * 0.15915494309189535); const float red = (float)(a - k * 6.283185307179586);
          cs[i] = (f32x2){cosf(red), sinf(red)}; } }
    { float* WR = (float*)(ws + WS_WR); const float* gf = F.in[I_GFFN];
      for (int i = gt; i < DM * 36; i += NGT) { const int k = i / 36, c = i % 36; float w;
          if (c < 4) w = F.in[I_WRG][k * 4 + c]; else { const int gi = (c - 4) >> 3, e = (c - 4) & 7; w = F.in[I_WRE][((size_t)gi * DM + k) * 8 + e]; }
          WR[i] = w * gf[k]; } }
}

__device__ __forceinline__ void p_final(Frame& F, bool with_moe) {
    const int gw = F.vcu * 8 + F.wave, NGW = F.G * 8;
    const f32x4* gr = (const f32x4*)F.in[I_GFINAL] + F.lane;
    const int* route = (const int*)(F.ws + WS_ROUTE); const bf16* ybuf = (const bf16*)(F.ws + WS_YBUF);
    const int* cnts = (const int*)(F.ctl + CW_CNT);
    for (int m = gw; m < MT; m += NGW) {
        f32x4* xr = (f32x4*)(F.out + (size_t)m * DM) + F.lane;
        f32x4 v[8];
#pragma unroll
        for (int j = 0; j < 8; ++j) v[j] = xr[64 * j];
        if (with_moe) {
#pragma unroll
            for (int kx = 0; kx < 2; ++kx) { const int e = route[m * 8 + 2 * kx], pos = route[m * 8 + 2 * kx + 1];
                int base = 0; for (int q = 0; q < e; ++q) base += (cnts[64 * q] + 255) & ~255;
                const u32x2* yr = (const u32x2*)(ybuf + (size_t)(base + pos) * DM) + F.lane;
#pragma unroll
                for (int j = 0; j < 8; ++j) { const u32x2 w = yr[64 * j]; v[j].x += bflo(w.x); v[j].y += bfhi(w.x); v[j].z += bflo(w.y); v[j].w += bfhi(w.y); } }
        }
        float s = 0.f;
#pragma unroll
        for (int j = 0; j < 8; ++j) s += (v[j].x * v[j].x + v[j].y * v[j].y) + (v[j].z * v[j].z + v[j].w * v[j].w);
        const float rs = 1.0f / sqrtf(wave_sum(s) * (1.f / DM) + RMS_EPS);
#pragma unroll
        for (int j = 0; j < 8; ++j) { const f32x4 g = gr[64 * j]; xr[64 * j] = (f32x4){v[j].x * rs * g.x, v[j].y * rs * g.y, v[j].z * rs * g.z, v[j].w * rs * g.w}; }
    }
}
__device__ __forceinline__ void p_copy_x(Frame& F) {
    const int gt = F.vcu * 512 + F.tid, NGT = F.G * 512; const f32x4* s = (const f32x4*)F.in[I_X]; f32x4* d = (f32x4*)F.out;
    for (int i = gt; i < MT * DM / 4; i += NGT) d[i] = s[i];
}

__device__ __forceinline__ void p2_rowpass(Frame& F) {
    const int gw = F.vcu * 8 + F.wave, NGW = F.G * 8, l = F.lane;
    unsigned char* ws = F.ws;
    const bf16* zm = (const bf16*)(ws + WS_ZMLA); const bf16* zl = (const bf16*)(ws + WS_ZLORA); bf16* la = (bf16*)(ws + WS_LORAA);
    float* rstd_q = (float*)(ws + WS_RSTD) + MT; float* rstd_kv = (float*)(ws + WS_RSTD) + 2 * MT;
    const f32x2* cs = (const f32x2*)(ws + WS_ROPE); unsigned char* Kb = ws + WS_K;
    const float* sh = F.in[I_SHIFT] + 6144;
    f32x2 s0[5], s1[5], s2[5];
#pragma unroll
    for (int i = 0; i < 5; ++i) { const int j = 2 * l + 128 * i; s0[i] = *(const f32x2*)(sh + j); s1[i] = *(const f32x2*)(sh + RWKV_IN + j); s2[i] = *(const f32x2*)(sh + 2 * RWKV_IN + j); }
    for (int t = gw; t < MT; t += NGW) {
        const bf16* zr = zm + (size_t)t * ZM_LD;
        { const u32x4 w = *((const u32x4*)zr + l); float s = 0.f;
          s += bflo(w.x) * bflo(w.x) + bfhi(w.x) * bfhi(w.x) + bflo(w.y) * bflo(w.y) + bfhi(w.y) * bfhi(w.y) + bflo(w.z) * bflo(w.z) + bfhi(w.z) * bfhi(w.z) + bflo(w.w) * bflo(w.w) + bfhi(w.w) * bfhi(w.w);
          s = wave_sum(s); if (l == 0) rstd_q[t] = 1.0f / sqrtf(s * (1.f / QLORA) + RMS_EPS); }
        { const u32x2 w = *((const u32x2*)(zr + QLORA) + l); float s = bflo(w.x) * bflo(w.x) + bfhi(w.x) * bfhi(w.x) + bflo(w.y) * bflo(w.y) + bfhi(w.y) * bfhi(w.y);
          s = wave_sum(s); if (l == 0) rstd_kv[t] = 1.0f / sqrtf(s * (1.f / KVLORA) + RMS_EPS); }
        { const int i = l & 31, hs = l >> 5; const unsigned w = *((const unsigned*)(zr + 768) + i); const float x1 = bflo(w), x2 = bfhi(w); const f32x2 c = cs[(size_t)t * 32 + i];
          const unsigned short o = (unsigned short)__builtin_amdgcn_cvt_pk_fp8_f32(x1 * c.x - x2 * c.y, x2 * c.x + x1 * c.y, 0, false);
#pragma unroll
          for (int hh = 0; hh < 8; ++hh) *((unsigned short*)(Kb + (size_t)t * (MH * QKD) + (hs * 8 + hh) * QKD + NOPE) + i) = o; }
        const int s = t % SEQ; const float fp = s > 0 ? 1.f : 0.f, fn = s < SEQ - 1 ? 1.f : 0.f;
        const bf16* z0 = zl + (size_t)t * ZL_LD; const bf16* zp = s > 0 ? z0 - ZL_LD : z0; const bf16* zn = s < SEQ - 1 ? z0 + ZL_LD : z0;
        bf16* lr = la + (size_t)t * LA_LD;
#pragma unroll
        for (int i = 0; i < 5; ++i) { const int j = 2 * l + 128 * i;
            const unsigned wp = *(const unsigned*)(zp + j), w0 = *(const unsigned*)(z0 + j), wn = *(const unsigned*)(zn + j);
            float va = s0[i].x * fp * bflo(wp) + s1[i].x * bflo(w0) + s2[i].x * fn * bflo(wn);
            float vb = s0[i].y * fp * bfhi(wp) + s1[i].y * bfhi(w0) + s2[i].y * fn * bfhi(wn);
            int dst;
            if (j < 192) { va = tanhf(va); vb = tanhf(vb); dst = (j / 96) * 128 + (j % 96); } else if (j < 384) { dst = (j / 96) * 128 + (j % 96); } else { va = sigmoidf_(va); vb = sigmoidf_(vb); dst = 512 + (j - 384); }
            *(unsigned*)(lr + dst) = cvt_pk_bf16(va, vb); }
        { const int p = 2 * l; *(unsigned*)(lr + (p >> 5) * 128 + 96 + (p & 31)) = 0u; }
    }
}

namespace scan {
constexpr int TC = 16, DATA_B = TC * 6 * 64 * 4, BUF_B = DATA_B + 64 + TC * 32 * 4;
template <int CTRL> __device__ __forceinline__ float dpp_add(float v) {
    return v + __builtin_bit_cast(float, __builtin_amdgcn_update_dpp(0, __builtin_bit_cast(int, v), CTRL, 0xF, 0xF, false));
}
__device__ __forceinline__ float red16(float v) { v = dpp_add<0xB1>(v); v = dpp_add<0x4E>(v); v = dpp_add<0x141>(v); v = dpp_add<0x140>(v); return v; }
struct Raw { unsigned short r[3], k[3], v[3], wl, ic; };
template <int VAR> __device__ __forceinline__ void scan_unit(Frame& F, const int b, const int h, const int dir, const int half) {
    unsigned char* ws = F.ws; const int l = F.lane, w = F.wave, tid = F.tid;
    const bf16* zr = (const bf16*)(ws + WS_ZRKV) + (size_t)b * SEQ * ZR_LD + h * 64 + l;
    const bf16* wlp = (const bf16*)(ws + (dir ? WS_WLB : WS_WLF)) + (size_t)b * SEQ * RW + h * 64 + l;
    const bf16* icp = (const bf16*)(ws + (dir ? WS_ICB : WS_ICF)) + (size_t)b * SEQ * RW + h * 64 + l;
    bf16* yout = (bf16*)(ws + (dir ? WS_YB : WS_YF)) + (size_t)b * SEQ * RW + h * 64 + half * 32;
    const int ch = h * 64 + l; const float* sh = F.in[I_SHIFT];
    const float sr0 = sh[ch], sr1 = sh[RWKV_IN + ch], sr2 = sh[2 * RWKV_IN + ch];
    const float sk0 = sh[2048 + ch], sk1 = sh[RWKV_IN + 2048 + ch], sk2 = sh[2 * RWKV_IN + 2048 + ch];
    const float sv0 = sh[4096 + ch], sv1 = sh[RWKV_IN + 4096 + ch], sv2 = sh[2 * RWKV_IN + 4096 + ch];
    const float kk_c = F.in[I_KK][ch], ka_c = F.in[I_KA][ch], rk_c = F.in[I_RK][ch];
    LAS unsigned char* L = F.lds;
    Raw raw[2];
#define SC_TOK(ci, i) (dir ? (SEQ - 1 - ((ci) * TC + (i))) : ((ci) * TC + (i)))
#define SC_LOAD(ci) do { _Pragma("unroll") for (int q = 0; q < 2; ++q) { const int s = SC_TOK(ci, 2 * w + q); const int sp = s > 0 ? s - 1 : s, sn = s < SEQ - 1 ? s + 1 : s; \
        const bf16* z0 = zr + (size_t)s * ZR_LD; const bf16* zp = zr + (size_t)sp * ZR_LD; const bf16* zn = zr + (size_t)sn * ZR_LD; \
        raw[q].r[0] = zp[0]; raw[q].r[1] = z0[0]; raw[q].r[2] = zn[0]; raw[q].k[0] = zp[2048]; raw[q].k[1] = z0[2048]; raw[q].k[2] = zn[2048]; \
        raw[q].v[0] = zp[4096]; raw[q].v[1] = z0[4096]; raw[q].v[2] = zn[4096]; raw[q].wl = wlp[(size_t)s * RW]; raw[q].ic = icp[(size_t)s * RW]; } } while (0)
#define SC_PREP(ci, bufi) do { _Pragma("unroll") for (int q = 0; q < 2; ++q) { const int i = 2 * w + q; const int s = SC_TOK(ci, i); const float fp = s > 0 ? 1.f : 0.f, fn = s < SEQ - 1 ? 1.f : 0.f; \
        const float r_s = sr0 * fp * bf2f(raw[q].r[0]) + sr1 * bf2f(raw[q].r[1]) + sr2 * fn * bf2f(raw[q].r[2]); \
        const float k_s = sk0 * fp * bf2f(raw[q].k[0]) + sk1 * bf2f(raw[q].k[1]) + sk2 * fn * bf2f(raw[q].k[2]); \
        const float v_s = sv0 * fp * bf2f(raw[q].v[0]) + sv1 * bf2f(raw[q].v[1]) + sv2 * fn * bf2f(raw[q].v[2]); \
        const float kkr = k_s * kk_c; const float ss = wave_sum(kkr * kkr); const float kk = kkr * (1.0f / sqrtf(ss + 1e-12f)); \
        const float icv = bf2f(raw[q].ic); const float kd = k_s * (1.0f + (icv - 1.0f) * ka_c); const float bb = kk * icv; const float wd = __builtin_amdgcn_exp2f(bf2f(raw[q].wl)); \
        const float bon = wave_sum(r_s * kd * rk_c); \
        LAS float* d = (LAS float*)(L + (bufi) * BUF_B) + i * 384 + l; d[0] = wd; d[64] = kk; d[128] = bb; d[192] = kd; d[256] = r_s; d[320] = v_s; \
        if (l == 0) ((LAS float*)(L + (bufi) * BUF_B + DATA_B))[i] = bon; } } while (0)
    const int g = l >> 4, j = l & 15, row = half * 32 + w * 4 + g;
    f32x2 Sa = {0.f, 0.f}, Sb = {0.f, 0.f};
    struct Ops { f32x4 w, a, b, k, r; float v, bon; };
#define SC_LD(O, i) do { O.w = p4[(i) * 96 + j]; O.a = p4[(i) * 96 + 16 + j]; O.b = p4[(i) * 96 + 32 + j]; O.k = p4[(i) * 96 + 48 + j]; O.r = p4[(i) * 96 + 64 + j]; \
        O.v = pf[(i) * 384 + 320 + row]; O.bon = pb[i]; } while (0)
#define SC_STEP(O, YP) do { f32x2 t = Sa * O.a.xy; t = Sb * O.a.zw + t; float sa = red16(t.x + t.y); \
        const f32x2 nsa = {-sa, -sa}; const f32x2 vv2 = {O.v, O.v}; \
        const f32x2 u0 = nsa * O.b.xy + vv2 * O.k.xy, u1 = nsa * O.b.zw + vv2 * O.k.zw; \
        Sa = Sa * O.w.xy + u0; Sb = Sb * O.w.zw + u1; \
        f32x2 ty = Sa * O.r.xy; ty = Sb * O.r.zw + ty; YP = ty.x + ty.y; } while (0)
    SC_LOAD(0); SC_PREP(0, 0); __syncthreads();
    constexpr int NCH = SEQ / TC;
    for (int ci = 0; ci < NCH; ++ci) {
        const int bi = ci & 1;
        if (VAR != 2 && ci + 1 < NCH) SC_LOAD(ci + 1);
        const LAS f32x4* p4 = (const LAS f32x4*)(L + bi * BUF_B); const LAS float* pf = (const LAS float*)(L + bi * BUF_B);
        const LAS float* pb = (const LAS float*)(L + bi * BUF_B + DATA_B);
        float ykeep = 0.f;
        Ops oA, oB; SC_LD(oA, 0);
        if (VAR != 1) {
#pragma unroll
        for (int i = 0; i < TC; i += 4) {
            float y0, y1, y2, y3; float v0, v1, v2, v3, b0, b1, b2, b3;
            SC_LD(oB, i + 1); v0 = oA.v; b0 = oA.bon; SC_STEP(oA, y0);
            SC_LD(oA, i + 2); v1 = oB.v; b1 = oB.bon; SC_STEP(oB, y1);
            SC_LD(oB, i + 3); v2 = oA.v; b2 = oA.bon; SC_STEP(oA, y2);
            if (i + 4 < TC) SC_LD(oA, i + 4);
            v3 = oB.v; b3 = oB.bon; SC_STEP(oB, y3);
            y0 = red16(y0); y1 = red16(y1); y2 = red16(y2); y3 = red16(y3);
            y0 += b0 * v0; y1 += b1 * v1; y2 += b2 * v2; y3 += b3 * v3;
            ykeep = (j == i) ? y0 : ykeep; ykeep = (j == i + 1) ? y1 : ykeep; ykeep = (j == i + 2) ? y2 : ykeep; ykeep = (j == i + 3) ? y3 : ykeep;
        }
        }
        ((LAS float*)(L + bi * BUF_B + DATA_B + 64))[j * 32 + w * 4 + g] = ykeep;
        if (VAR != 2 && ci + 1 < NCH) SC_PREP(ci + 1, bi ^ 1);
        __syncthreads();
        { const int st = tid >> 5, rw_ = tid & 31; const int s = SC_TOK(ci, st);
          const unsigned short yv = f2bf(((const LAS float*)(L + bi * BUF_B + DATA_B + 64))[st * 32 + rw_]);
          if (VAR == 0) yout[(size_t)s * RW + rw_] = yv; else asm volatile("" :: "v"(yv)); }
    }
    __syncthreads();
#undef SC_TOK
#undef SC_LOAD
#undef SC_PREP
#undef SC_LD
#undef SC_STEP
}
}

namespace scan2 {
constexpr int TC = 16, NS = 6, NPREP = 6, NREC = 2;
constexpr int ROWB = 144;
constexpr int P_ACAT = 0, P_BHAT = 4608, P_KHAT = 6656, P_VT = 8704, P_NCAT = 10752, P_MRF = 11776, P_PC = 12800, P_GINIT = 13056  , PKG_B = 15104;
constexpr int S_L1 = 0, S_L2 = 4608, S_MF = 9216, S_NF = 10240, SCR_B = 11264;
constexpr int OFF_PKG = 0, OFF_SCR = NS * PKG_B, OFF_FLAG = OFF_SCR + NPREP * SCR_B, TOTAL_B = OFF_FLAG + 64;
static_assert(TOTAL_B <= 156 * 1024, "scan2 LDS");
__device__ __forceinline__ int crow(int r, int hi) { return (r & 3) + 8 * (r >> 2) + 4 * hi; }
__device__ __forceinline__ void lds_st16(LAS unsigned char* p, float v) { *(LAS unsigned short*)p = f2bf(v); }
__device__ __forceinline__ bf16x8 pack_acc8(const f32x16& x, int base) {
    u32x4 w = {cvt_pk_bf16(x[base + 0], x[base + 1]), cvt_pk_bf16(x[base + 2], x[base + 3]), cvt_pk_bf16(x[base + 4], x[base + 5]), cvt_pk_bf16(x[base + 6], x[base + 7])};
    return *reinterpret_cast<bf16x8*>(&w);
}
__device__ __forceinline__ float wave_sum_b(float v) {
    v = scan::red16(v);
    v += __builtin_bit_cast(float, __builtin_amdgcn_update_dpp(0, __builtin_bit_cast(int, v), 0x142, 0xA, 0xF, false));
    v += __builtin_bit_cast(float, __builtin_amdgcn_update_dpp(0, __builtin_bit_cast(int, v), 0x143, 0xC, 0xF, false));
    return __builtin_bit_cast(float, __builtin_amdgcn_readlane(__builtin_bit_cast(int, v), 63));
}
__device__ __forceinline__ void spin_ge(volatile LAS int* p, int want) { while (*p < want) __builtin_amdgcn_s_sleep(1); }

template <int dir> __device__ __forceinline__ void scan_unit(Frame& F, const int b, const int h) {
    unsigned char* ws = F.ws; const int l = F.lane, w = F.wave;
    LAS unsigned char* L = F.lds;
    volatile LAS int* ready = (volatile LAS int*)(L + OFF_FLAG);
    volatile LAS int* consumed = ready + NS;
    if (F.tid < 16) ready[F.tid] = 0;
    __syncthreads();
    constexpr int NCH = SEQ / TC;
    if (w < NREC) {
        const int half = w; const int v = l & 31, hi = l >> 5, vg = 32 * half + v;
        __builtin_amdgcn_s_setprio(3);
        f32x16 X0 = {}, X1 = {}; unsigned long long rec_acc = 0ull;
        bf16* yout = (bf16*)(ws + (dir ? WS_YB : WS_YF)) + (size_t)b * SEQ * RW + h * 64 + half * 32 + v;
        for (int ci = 0; ci < NCH; ++ci) {
            const int slot = ci % NS; const LAS unsigned char* P = L + OFF_PKG + slot * PKG_B;
            const unsigned long long tr0 = (SCAN_SEC == 9) ? __builtin_amdgcn_s_memtime() : 0ull;
            spin_ge(ready + slot, ci + 1);
            if (SCAN_SEC == 9) rec_acc += __builtin_amdgcn_s_memtime() - tr0;
            const bf16x8 a00 = *(const LAS bf16x8*)(P + P_ACAT + v * ROWB + (0 + hi) * 16), a01 = *(const LAS bf16x8*)(P + P_ACAT + v * ROWB + (2 + hi) * 16);
            const bf16x8 a10 = *(const LAS bf16x8*)(P + P_ACAT + v * ROWB + (4 + hi) * 16), a11 = *(const LAS bf16x8*)(P + P_ACAT + v * ROWB + (6 + hi) * 16);
            const bf16x8 ncat = *(const LAS bf16x8*)(P + P_NCAT + v * 32 + hi * 16), vt = *(const LAS bf16x8*)(P + P_VT + vg * 32 + hi * 16);
            const bf16x8 mrf = *(const LAS bf16x8*)(P + P_MRF + l * 16);
            const bf16x8 bh0 = *(const LAS bf16x8*)(P + P_BHAT + v * 32 + hi * 16), bh1 = *(const LAS bf16x8*)(P + P_BHAT + (32 + v) * 32 + hi * 16);
            const bf16x8 kh0 = *(const LAS bf16x8*)(P + P_KHAT + v * 32 + hi * 16), kh1 = *(const LAS bf16x8*)(P + P_KHAT + (32 + v) * 32 + hi * 16);
            f32x16 G;
            { const u32x2 q0 = *(const LAS u32x2*)(P + P_GINIT + vg * 32 + hi * 8), q1 = *(const LAS u32x2*)(P + P_GINIT + vg * 32 + 16 + hi * 8);
              const f32x4 g0 = {bflo(q0.x), bfhi(q0.x), bflo(q0.y), bfhi(q0.y)}, g1 = {bflo(q1.x), bfhi(q1.x), bflo(q1.y), bfhi(q1.y)};
#pragma unroll
              for (int r = 0; r < 8; ++r) G[r] = 0.f;
#pragma unroll
              for (int r = 0; r < 4; ++r) { G[8 + r] = g0[r]; G[12 + r] = g1[r]; } }
            f32x4 pc[8];
#pragma unroll
            for (int q = 0; q < 8; ++q) pc[q] = *(const LAS f32x4*)(P + P_PC + (32 * (q >> 2) + 8 * (q & 3) + 4 * hi) * 4);
            const bf16x8 s00 = pack_acc8(X0, 0), s01 = pack_acc8(X0, 8), s10 = pack_acc8(X1, 0), s11 = pack_acc8(X1, 8);
            G = __builtin_amdgcn_mfma_f32_32x32x16_bf16(a00, s00, G, 0, 0, 0);
            G = __builtin_amdgcn_mfma_f32_32x32x16_bf16(a01, s01, G, 0, 0, 0);
            G = __builtin_amdgcn_mfma_f32_32x32x16_bf16(a10, s10, G, 0, 0, 0);
            G = __builtin_amdgcn_mfma_f32_32x32x16_bf16(a11, s11, G, 0, 0, 0);
            G = __builtin_amdgcn_mfma_f32_32x32x16_bf16(ncat, vt, G, 0, 0, 0);
            const bf16x8 uf = pack_acc8(G, 0);
#pragma unroll
            for (int r = 0; r < 16; ++r) { X0[r] *= pc[r >> 2][r & 3]; X1[r] *= pc[4 + (r >> 2)][r & 3]; }
            X0 = __builtin_amdgcn_mfma_f32_32x32x16_bf16(bh0, uf, X0, 0, 0, 0);
            X1 = __builtin_amdgcn_mfma_f32_32x32x16_bf16(bh1, uf, X1, 0, 0, 0);
            X0 = __builtin_amdgcn_mfma_f32_32x32x16_bf16(kh0, vt, X0, 0, 0, 0);
            X1 = __builtin_amdgcn_mfma_f32_32x32x16_bf16(kh1, vt, X1, 0, 0, 0);
            G = __builtin_amdgcn_mfma_f32_32x32x16_bf16(mrf, uf, G, 0, 0, 0);
            LDS_WAIT();
            if (l == 0) consumed[half] = ci + 1;
#pragma unroll
            for (int q = 0; q < 8; ++q) { const int t = crow(q, hi); const int s = dir ? (SEQ - 1 - (ci * TC + t)) : (ci * TC + t);
                yout[(size_t)s * RW] = f2bf(G[8 + q]); }
        }
        __builtin_amdgcn_s_setprio(0);
        if (SCAN_SEC == 9 && blockIdx.x == 0 && w == 0 && l == 0) { F.MISC[120] = (unsigned)rec_acc; F.MISC[121] = (unsigned)(rec_acc >> 32); }
    } else {
        const int pw = w - NREC; LAS unsigned char* SC = L + OFF_SCR + pw * SCR_B;
        const __amdgpu_buffer_rsrc_t rsZ = __builtin_amdgcn_make_buffer_rsrc((void*)(ws + WS_ZRKV + ((size_t)b * SEQ * ZR_LD + h * 64) * 2), (short)0, (int)(SEQ * ZR_LD * 2), 0x00020000);
        const __amdgpu_buffer_rsrc_t rsW = __builtin_amdgcn_make_buffer_rsrc((void*)(ws + (dir ? WS_WLB : WS_WLF) + ((size_t)b * SEQ * RW + h * 64) * 2), (short)0, (int)(SEQ * RW * 2), 0x00020000);
        const __amdgpu_buffer_rsrc_t rsI = __builtin_amdgcn_make_buffer_rsrc((void*)(ws + (dir ? WS_ICB : WS_ICF) + ((size_t)b * SEQ * RW + h * 64) * 2), (short)0, (int)(SEQ * RW * 2), 0x00020000);
        const unsigned vl2 = (unsigned)l * 2u;
        const int ch = h * 64 + l; const float* sh = F.in[I_SHIFT];
        const float sr0 = sh[ch], sr1 = sh[RWKV_IN + ch], sr2 = sh[2 * RWKV_IN + ch];
        const float sk0 = sh[2048 + ch], sk1 = sh[RWKV_IN + 2048 + ch], sk2 = sh[2 * RWKV_IN + 2048 + ch];
        const float sv0 = sh[4096 + ch], sv1 = sh[RWKV_IN + 4096 + ch], sv2 = sh[2 * RWKV_IN + 4096 + ch];
        const float kk_c = F.in[I_KK][ch], ka_c = F.in[I_KA][ch], rk_c = F.in[I_RK][ch];
        const int posk = (((l >> 5) * 2 + ((l >> 4) & 1)) * 2 + ((l >> 2) & 1)) * 8 + ((l >> 3) & 1) * 4 + (l & 3);
        unsigned long long sec_acc = 0ull;
#define S2_T() ((SCAN_SEC >= 0) ? __builtin_amdgcn_s_memtime() : 0ull)
        for (int ci = pw; ci < NCH; ci += NPREP) {
            const int slot = ci % NS; LAS unsigned char* P = L + OFF_PKG + slot * PKG_B;
            const unsigned long long ts0 = S2_T();
            const int s_lo = dir ? (SEQ - TC - ci * TC) : ci * TC;
            float rr[18], rk[18], rv[18], wl[16], ic[16];
            { unsigned short ur[18], uk[18], uv[18], uw[16], ui[16];
#pragma unroll
              for (int tau = 0; tau < 18; ++tau) { const int s = s_lo - 1 + tau; const int sc = (tau == 0 && s < 0) ? s_lo : (tau == 17 && s >= SEQ) ? s_lo : s;
                  const unsigned so = (unsigned)sc * (unsigned)(ZR_LD * 2);
                  ur[tau] = __builtin_amdgcn_raw_buffer_load_b16(rsZ, vl2, so, 0); uk[tau] = __builtin_amdgcn_raw_buffer_load_b16(rsZ, vl2, so + 4096u, 0); uv[tau] = __builtin_amdgcn_raw_buffer_load_b16(rsZ, vl2, so + 8192u, 0); }
#pragma unroll
              for (int i = 0; i < 16; ++i) { const int s = dir ? (s_lo + 15 - i) : (s_lo + i); const unsigned so = (unsigned)s * (unsigned)(RW * 2);
                  uw[i] = __builtin_amdgcn_raw_buffer_load_b16(rsW, vl2, so, 0); ui[i] = __builtin_amdgcn_raw_buffer_load_b16(rsI, vl2, so, 0); }
              __builtin_amdgcn_sched_barrier(0);
#pragma unroll
              for (int tau = 0; tau < 18; ++tau) { rr[tau] = bf2f(ur[tau]); rk[tau] = bf2f(uk[tau]); rv[tau] = bf2f(uv[tau]); }
              { const float f0 = (s_lo - 1 >= 0) ? 1.f : 0.f, f17 = (s_lo + 16 < SEQ) ? 1.f : 0.f;
                rr[0] *= f0; rk[0] *= f0; rv[0] *= f0; rr[17] *= f17; rk[17] *= f17; rv[17] *= f17; }
#pragma unroll
              for (int i = 0; i < 16; ++i) { wl[i] = bf2f(uw[i]); ic[i] = bf2f(ui[i]); } }
            float cum[16];
            cum[0] = wl[0];
#pragma unroll
            for (int i = 1; i < 16; ++i) cum[i] = cum[i - 1] + wl[i];
            const unsigned long long tsA = S2_T();
            float rs_[16], ks_[16], vs_[16], q1[16], q2[16];
#pragma unroll
            for (int i = 0; i < 16; ++i) { const int tau = dir ? (16 - i) : (i + 1);
                rs_[i] = sr0 * rr[tau - 1] + sr1 * rr[tau] + sr2 * rr[tau + 1];
                ks_[i] = sk0 * rk[tau - 1] + sk1 * rk[tau] + sk2 * rk[tau + 1];
                vs_[i] = sv0 * rv[tau - 1] + sv1 * rv[tau] + sv2 * rv[tau + 1];
                const float kkr = ks_[i] * kk_c; q1[i] = kkr * kkr; q2[i] = rs_[i] * (ks_[i] * (1.0f + (ic[i] - 1.0f) * ka_c)) * rk_c; }
#define S2_DPPSTEP(CTRL, RM) do { _Pragma("unroll") for (int i = 0; i < 16; ++i) { \
                q1[i] += __builtin_bit_cast(float, __builtin_amdgcn_update_dpp(0, __builtin_bit_cast(int, q1[i]), CTRL, RM, 0xF, false)); \
                q2[i] += __builtin_bit_cast(float, __builtin_amdgcn_update_dpp(0, __builtin_bit_cast(int, q2[i]), CTRL, RM, 0xF, false)); } } while (0)
            S2_DPPSTEP(0xB1, 0xF); S2_DPPSTEP(0x4E, 0xF); S2_DPPSTEP(0x141, 0xF); S2_DPPSTEP(0x140, 0xF);
            __builtin_amdgcn_sched_barrier(0);
            asm volatile("s_nop 1");
#define S2_BCAST(CTRL) do { _Pragma("unroll") for (int i = 0; i < 16; ++i) { \
                asm volatile("v_add_f32_dpp %0, %0, %0 " CTRL " bank_mask:0xf" : "+v"(q1[i])); asm volatile("v_add_f32_dpp %0, %0, %0 " CTRL " bank_mask:0xf" : "+v"(q2[i])); } } while (0)
            S2_BCAST("row_bcast:15 row_mask:0xa"); S2_BCAST("row_bcast:31 row_mask:0xc");
#undef S2_BCAST
            asm volatile("s_nop 1");
            __builtin_amdgcn_sched_barrier(0);
#undef S2_DPPSTEP
            const unsigned long long ts1 = S2_T();
            spin_ge(consumed, ci - NS + 1); spin_ge(consumed + 1, ci - NS + 1);
            const unsigned long long ts2 = S2_T();
            float at[16], bhv[16], khv[16], giv[16]; float pprev = 1.0f; const float pC = __builtin_amdgcn_exp2f(cum[15]);
#pragma unroll
            for (int i = 0; i < 16; ++i) {
                const float r_s = rs_[i], k_s = ks_[i], v_s = vs_[i];
                const float ss = __uint_as_float(__builtin_amdgcn_readlane(__float_as_uint(q1[i]), 63)), bon = __uint_as_float(__builtin_amdgcn_readlane(__float_as_uint(q2[i]), 63));
                const float kk = k_s * kk_c * __builtin_amdgcn_rsqf(ss + 1e-12f);
                const float kd = k_s * (1.0f + (ic[i] - 1.0f) * ka_c); const float bb = kk * ic[i];
                const float p = __builtin_amdgcn_exp2f(cum[i]), pm = pprev, pinv = __builtin_amdgcn_exp2f(-cum[i]), pr = pC * pinv; pprev = p;
                at[i] = -kk * pm;
                lds_st16(P + P_ACAT + i * ROWB + posk * 2, at[i]);
                const float rt = r_s * p;
                lds_st16(P + P_ACAT + (16 + i) * ROWB + posk * 2, rt);
                lds_st16(SC + S_L1 + i * ROWB + posk * 2, bb * pinv); lds_st16(SC + S_L1 + (16 + i) * ROWB + posk * 2, kd * pinv);
                bhv[((i >> 2) & 1) * 8 + (i & 3) + 4 * (i >> 3)] = bb * pr; khv[i] = kd * pr; giv[i] = bon * v_s;
            }
#pragma unroll
            for (int hf = 0; hf < 2; ++hf) {
                *(LAS u32x4*)(P + P_BHAT + l * 32 + hf * 16) = (u32x4){cvt_pk_bf16(bhv[hf * 8 + 0], bhv[hf * 8 + 1]), cvt_pk_bf16(bhv[hf * 8 + 2], bhv[hf * 8 + 3]), cvt_pk_bf16(bhv[hf * 8 + 4], bhv[hf * 8 + 5]), cvt_pk_bf16(bhv[hf * 8 + 6], bhv[hf * 8 + 7])};
                *(LAS u32x4*)(P + P_KHAT + l * 32 + hf * 16) = (u32x4){cvt_pk_bf16(khv[hf * 8 + 0], khv[hf * 8 + 1]), cvt_pk_bf16(khv[hf * 8 + 2], khv[hf * 8 + 3]), cvt_pk_bf16(khv[hf * 8 + 4], khv[hf * 8 + 5]), cvt_pk_bf16(khv[hf * 8 + 6], khv[hf * 8 + 7])};
                *(LAS u32x4*)(P + P_VT + l * 32 + hf * 16) = (u32x4){cvt_pk_bf16(vs_[hf * 8 + 0], vs_[hf * 8 + 1]), cvt_pk_bf16(vs_[hf * 8 + 2], vs_[hf * 8 + 3]), cvt_pk_bf16(vs_[hf * 8 + 4], vs_[hf * 8 + 5]), cvt_pk_bf16(vs_[hf * 8 + 6], vs_[hf * 8 + 7])};
                *(LAS u32x4*)(P + P_GINIT + l * 32 + hf * 16) = (u32x4){cvt_pk_bf16(giv[hf * 8 + 0], giv[hf * 8 + 1]), cvt_pk_bf16(giv[hf * 8 + 2], giv[hf * 8 + 3]), cvt_pk_bf16(giv[hf * 8 + 4], giv[hf * 8 + 5]), cvt_pk_bf16(giv[hf * 8 + 6], giv[hf * 8 + 7])}; }
            *(LAS float*)(P + P_PC + l * 4) = pC;
            LDS_WAIT();
            const unsigned long long ts3 = S2_T();
            f32x16 Z = {};
            { const int r = l & 31, hh = l >> 5;
#pragma unroll
              for (int ks = 0; ks < 4; ++ks) { const bf16x8 fa = *(const LAS bf16x8*)(SC + S_L1 + r * ROWB + (ks * 16 + hh * 8) * 2), fb = *(const LAS bf16x8*)(P + P_ACAT + r * ROWB + (ks * 16 + hh * 8) * 2);
                  Z = __builtin_amdgcn_mfma_f32_32x32x16_bf16(fa, fb, Z, 0, 0, 0); } }
            { const int c = l & 31, hh = l >> 5;
              if (c < 16) {
#pragma unroll
                  for (int r = 0; r < 8; ++r) { const int s = crow(r, hh); *(LAS float*)(SC + S_MF + (c * 16 + s) * 4) = (s < c) ? Z[r] : 0.f; }
#pragma unroll
                  for (int r = 8; r < 16; ++r) { const int s = crow(r, hh) - 16; *(LAS float*)(SC + S_NF + (s * 16 + c) * 4) = (s < c) ? Z[r] : 0.f; }
                  *(LAS u32x4*)(P + P_MRF + l * 16) = (u32x4){0u, 0u, 0u, 0u};
              } else { const int t = c - 16; f32x16 Zm = Z;
#pragma unroll
                  for (int r = 0; r < 8; ++r) { const int s = crow(r, hh); Zm[r] = (s <= t) ? Z[r] : 0.f; }
                  *(LAS bf16x8*)(P + P_MRF + l * 16) = pack_acc8(Zm, 0);
#pragma unroll
                  for (int r = 8; r < 16; ++r) { const int s = crow(r, hh) - 16; lds_st16(P + P_NCAT + c * 32 + s * 2, (s <= t) ? Z[r] : 0.f); }
              } }
            LDS_WAIT();
            const unsigned long long ts4 = S2_T();
            { f32x2 xy[16];
#pragma unroll
              for (int q = 0; q < 4; ++q) { const f32x4 nvv = *(const LAS f32x4*)(SC + S_NF + ((l & 15) * 16 + q * 4) * 4);
                  xy[q * 4 + 0] = (f32x2){at[q * 4 + 0], nvv[0]}; xy[q * 4 + 1] = (f32x2){at[q * 4 + 1], nvv[1]}; xy[q * 4 + 2] = (f32x2){at[q * 4 + 2], nvv[2]}; xy[q * 4 + 3] = (f32x2){at[q * 4 + 3], nvv[3]}; }
              f32x4 mrow[16][4];
#pragma unroll
              for (int t = 1; t < 16; ++t)
#pragma unroll
                  for (int s4 = 0; s4 < (t + 3) / 4; ++s4) mrow[t][s4] = *(const LAS f32x4*)(SC + S_MF + (t * 16 + s4 * 4) * 4);
#pragma unroll
              for (int t = 1; t < 16; ++t) { f32x2 a0 = xy[t], a1 = {0.f, 0.f};
#pragma unroll
                  for (int s = 0; s < t; ++s) { const float m = mrow[t][s >> 2][s & 3]; const f32x2 mm = {m, m}; if (s & 1) a1 += xy[s] * mm; else a0 += xy[s] * mm; }
                  xy[t] = a0 + a1; }
#pragma unroll
              for (int t = 0; t < 16; ++t) lds_st16(P + P_ACAT + t * ROWB + posk * 2, xy[t].x);
              if (l < 16) {
#pragma unroll
                  for (int t = 0; t < 16; ++t) lds_st16(P + P_NCAT + t * 32 + l * 2, xy[t].y); } }
            LDS_WAIT();
            if (l == 0) ready[slot] = ci + 1;
            if (SCAN_SEC >= 0) { const unsigned long long ts5 = S2_T(); sec_acc += SCAN_SEC == 0 ? ts1 - ts0 : SCAN_SEC == 1 ? ts2 - ts1 : SCAN_SEC == 2 ? ts3 - ts2 : SCAN_SEC == 3 ? ts4 - ts3 : SCAN_SEC == 4 ? ts5 - ts4 : SCAN_SEC == 6 ? tsA - ts0 : SCAN_SEC == 7 ? ts1 - tsA : ts5 - ts0; }
        }
        if (SCAN_SEC >= 0 && blockIdx.x == 0 && pw == SCAN_PW && SCAN_SEC != 9 && l == 0) { F.MISC[120] = (unsigned)sec_acc; F.MISC[121] = (unsigned)(sec_acc >> 32); }
    }
    __syncthreads();
}
}

__device__ __forceinline__ void p5_post(Frame& F) {
    const int gw = F.vcu * 8 + F.wave, NGW = F.G * 8, l = F.lane; unsigned char* ws = F.ws;
    const bf16* yf = (const bf16*)(ws + WS_YF); const bf16* yb = (const bf16*)(ws + WS_YB); const bf16* gg = (const bf16*)(ws + WS_G); unsigned char* o8 = ws + WS_ORWKV;
    const float* lg = F.in[I_LNXG]; const float* lb = F.in[I_LNXB];
    float* rows = (float*)F.ctl + CW_ROWS_RWKV;
#define P5_GSUM(v) do { v += __builtin_bit_cast(float, __builtin_amdgcn_update_dpp(0, __builtin_bit_cast(int, v), 0xB1, 0xF, 0xF, false)); \
        v += __builtin_bit_cast(float, __builtin_amdgcn_update_dpp(0, __builtin_bit_cast(int, v), 0x4E, 0xF, 0xF, false)); \
        v += __builtin_bit_cast(float, __builtin_amdgcn_update_dpp(0, __builtin_bit_cast(int, v), 0x141, 0xF, 0xF, false)); } while (0)
    for (int t = gw; t < MT; t += NGW) {
        const size_t base = (size_t)t * RW; float res[4][8]; float am = 0.f;
        u32x4 wf[4], wb[4], wg[4];
#pragma unroll
        for (int it = 0; it < 4; ++it) { const size_t c0 = base + it * 512 + l * 8; wf[it] = *(const u32x4*)(yf + c0); wb[it] = *(const u32x4*)(yb + c0); wg[it] = *(const u32x4*)(gg + c0); }
#pragma unroll
        for (int it = 0; it < 4; ++it) { const int c = it * 512 + l * 8;
            const unsigned uf[4] = {wf[it].x, wf[it].y, wf[it].z, wf[it].w}, ub[4] = {wb[it].x, wb[it].y, wb[it].z, wb[it].w}, ug[4] = {wg[it].x, wg[it].y, wg[it].z, wg[it].w};
            float y[8], g[8];
#pragma unroll
            for (int e = 0; e < 4; ++e) { y[2 * e] = bflo(uf[e]) + bflo(ub[e]); y[2 * e + 1] = bfhi(uf[e]) + bfhi(ub[e]); g[2 * e] = bflo(ug[e]); g[2 * e + 1] = bfhi(ug[e]); }
            float sm = ((y[0] + y[1]) + (y[2] + y[3])) + ((y[4] + y[5]) + (y[6] + y[7])); P5_GSUM(sm);
            const float mu = sm * (1.f / 64.f); float vs = 0.f;
#pragma unroll
            for (int e = 0; e < 8; ++e) { y[e] -= mu; vs += y[e] * y[e]; }
            P5_GSUM(vs);
            const float rsd = 1.0f / sqrtf(vs * (1.f / 64.f) + LNX_EPS);
            const f32x4 g0 = *(const f32x4*)(lg + c), g1 = *(const f32x4*)(lg + c + 4), b0 = *(const f32x4*)(lb + c), b1 = *(const f32x4*)(lb + c + 4);
#pragma unroll
            for (int e = 0; e < 8; ++e) { const float r = (y[e] * rsd * (e < 4 ? g0[e & 3] : g1[e & 3]) + (e < 4 ? b0[e & 3] : b1[e & 3])) * g[e]; res[it][e] = r; am = fmaxf(am, fabsf(r)); } }
#pragma unroll
        for (int o_ = 32; o_ >= 1; o_ >>= 1) am = fmaxf(am, __shfl_xor(am, o_));
        am = fmaxf(am, 1e-30f); const float qs = 127.f / am;
        if (l == 0) rows[t] = am * (1.f / 127.f);
#pragma unroll
        for (int it = 0; it < 4; ++it)
            *(u32x2*)(o8 + base + it * 512 + l * 8) = (u32x2){pack4_i8(rintf(res[it][0] * qs), rintf(res[it][1] * qs), rintf(res[it][2] * qs), rintf(res[it][3] * qs)), pack4_i8(rintf(res[it][4] * qs), rintf(res[it][5] * qs), rintf(res[it][6] * qs), rintf(res[it][7] * qs))};
    }
#undef P5_GSUM
}

__device__ __forceinline__ void p8_rowpass(Frame& F) {
    const int gw = F.vcu * 8 + F.wave, NGW = F.G * 8; float* rstd2 = (float*)(F.ws + WS_RSTD) + 3 * MT; bf16* hb = (bf16*)(F.ws + WS_H1B);
    for (int m = gw; m < MT; m += NGW) {
        const f32x4* xr = (const f32x4*)(F.out + (size_t)m * DM) + F.lane; f32x4 v[8]; float s = 0.f;
#pragma unroll
        for (int j = 0; j < 8; ++j) { v[j] = xr[64 * j]; s += (v[j].x * v[j].x + v[j].y * v[j].y) + (v[j].z * v[j].z + v[j].w * v[j].w); }
        s = wave_sum(s); float am = 0.f;
#pragma unroll
        for (int j = 0; j < 8; ++j) am = fmaxf(am, fmaxf(fmaxf(fabsf(v[j].x), fabsf(v[j].y)), fmaxf(fabsf(v[j].z), fabsf(v[j].w))));
#pragma unroll
        for (int o = 32; o >= 1; o >>= 1) am = fmaxf(am, __shfl_xor(am, o));
        am = fmaxf(am, 1e-30f); const float qs = 127.f / am;
        if (F.lane == 0) rstd2[m] = am * (1.f / 127.f) / sqrtf(s * (1.f / DM) + RMS_EPS);
        unsigned* o8 = (unsigned*)((unsigned char*)hb + (size_t)m * DM) + F.lane;
#pragma unroll
        for (int j = 0; j < 8; ++j) o8[64 * j] = pack4_i8(rintf(v[j].x * qs), rintf(v[j].y * qs), rintf(v[j].z * qs), rintf(v[j].w * qs));
    }
}
__device__ __forceinline__ void p12_router(Frame& F) {
    const int gw = F.vcu * 8 + F.wave, NGW = F.G * 8, l = F.lane; unsigned char* ws = F.ws;
    float* rstd3 = (float*)(ws + WS_RSTD) + 4 * MT; bf16* n3 = (bf16*)(ws + WS_N3); const float* WR = (const float*)(ws + WS_WR);
    int* lists = (int*)(ws + WS_LIST); int* route = (int*)(ws + WS_ROUTE); float* slotw = (float*)(ws + WS_SLOTW);
    int* cnt = (int*)(F.ctl + CW_CNT);
    const float* brg = F.in[I_BRG]; const float* bre = F.in[I_BRE];
    LAS float* wl = (LAS float*)(F.lds + 16384);
    LAS float* lgt = (LAS float*)(F.lds + F.wave * 1024);
    for (int tb = F.vcu * 32; tb < MT; tb += F.G * 32) {
        const int t0 = tb + F.wave * 4;
        float ss[4] = {0.f, 0.f, 0.f, 0.f};
#pragma unroll
        for (int q = 0; q < 4; ++q) { const f32x4* xr = (const f32x4*)(F.out + (size_t)(t0 + q) * DM) + l; u32x2* o8 = (u32x2*)(n3 + (size_t)(t0 + q) * DM) + l;
#pragma unroll
            for (int j = 0; j < 8; ++j) { const f32x4 x = xr[64 * j]; ss[q] += (x.x * x.x + x.y * x.y) + (x.z * x.z + x.w * x.w);
                u32x2 w; w.x = cvt_pk_bf16(x.x, x.y); w.y = cvt_pk_bf16(x.z, x.w); o8[64 * j] = w; } }
#pragma unroll
        for (int q = 0; q < 4; ++q) ss[q] = wave_sum(ss[q]);
#pragma unroll 1
        for (int pass = 0; pass < 2; ++pass) {
            const float* x0p = F.out + (size_t)(t0 + 2 * pass) * DM + l; const float* x1p = x0p + DM;
            float acc[2][36];
#pragma unroll
            for (int q = 0; q < 2; ++q)
#pragma unroll
                for (int o = 0; o < 36; ++o) acc[q][o] = 0.f;
#pragma unroll 1
            for (int blk = 0; blk < 8; ++blk) {
                __syncthreads();
                { const f32x4* src4 = (const f32x4*)(WR + (size_t)blk * 256 * 36); LAS f32x4* dst4 = (LAS f32x4*)wl;
#pragma unroll
                  for (int i = 0; i < 5; ++i) { const int idx = F.tid + 512 * i; if (idx < 2304) dst4[idx] = src4[idx]; } }
                __syncthreads();
#pragma unroll
                for (int c4 = 0; c4 < 4; ++c4) { const int cl = l + 64 * c4; const float x0 = x0p[blk * 256 + 64 * c4], x1 = x1p[blk * 256 + 64 * c4];
                    const LAS f32x4* wr = (const LAS f32x4*)(wl + cl * 36);
#pragma unroll
                    for (int o4 = 0; o4 < 9; ++o4) { const f32x4 w = wr[o4];
#pragma unroll
                        for (int k = 0; k < 4; ++k) { acc[0][o4 * 4 + k] += x0 * w[k]; acc[1][o4 * 4 + k] += x1 * w[k]; } } }
            }
#pragma unroll
            for (int q = 0; q < 2; ++q)
#pragma unroll
                for (int o = 0; o < 36; ++o) { const float v = wave_sum(acc[q][o]); if (l == 0) lgt[(2 * pass + q) * 36 + o] = v; }
        }
        LDS_WAIT();
#pragma unroll
        for (int q = 0; q < 4; ++q) { const int t = t0 + q; const float rs = 1.0f / sqrtf(ss[q] * (1.f / DM) + RMS_EPS);
            float lg[4]; float gmax = -3.0e38f; int gsel = 0;
#pragma unroll
            for (int g = 0; g < 4; ++g) { lg[g] = lgt[q * 36 + g] * rs + brg[g]; if (lg[g] > gmax) { gmax = lg[g]; gsel = g; } }
            float gz = 0.f;
#pragma unroll
            for (int g = 0; g < 4; ++g) gz += __expf(lg[g] - gmax);
            const float pg = 1.0f / gz;
            float le[8];
#pragma unroll
            for (int e = 0; e < 8; ++e) { float a = lgt[q * 36 + 4 + e];
#pragma unroll
                for (int g = 1; g < 4; ++g) a = (gsel == g) ? lgt[q * 36 + 4 + g * 8 + e] : a;
                le[e] = a * rs + bre[gsel * 8 + e]; }
            float m1 = -3.0e38f, m2 = -3.0e38f; int e1 = 0, e2 = 0;
#pragma unroll
            for (int e = 0; e < 8; ++e) { if (le[e] > m1) { m2 = m1; e2 = e1; m1 = le[e]; e1 = e; } else if (le[e] > m2) { m2 = le[e]; e2 = e; } }
            const float xe = __expf(m2 - m1); const float w1 = pg / (1.0f + xe), w2 = pg * xe / (1.0f + xe);
            if (l == 0) { rstd3[t] = rs;
                const int E1 = gsel * 8 + e1, E2 = gsel * 8 + e2;
                const int p1 = atomicAdd(cnt + 64 * E1, 1), p2 = atomicAdd(cnt + 64 * E2, 1);
                lists[E1 * MT + p1] = t; lists[E2 * MT + p2] = t; slotw[E1 * MT + p1] = w1; slotw[E2 * MT + p2] = w2;
                route[t * 8 + 0] = E1; route[t * 8 + 1] = p1; route[t * 8 + 2] = E2; route[t * 8 + 3] = p2; }
        }
    }
}
struct MoeOrder {
    static constexpr bool GATHER = true;
    const volatile LAS int* tp; const int* cnt; const int* lists; const char* A; const char* B; int G, c, lognt; size_t bstride_e, bstride_t;
    bool gather;
    __device__ __forceinline__ bool next(int i, Unit& u) const {
        const int L = i * G + c; const int RT = tp[32]; if (L >= (RT << lognt)) return false;
        const int rt = L >> lognt, nt = L & ((1 << lognt) - 1); int e = 0;
        for (int q = 1; q < 32; ++q) e = (rt >= tp[q]) ? q : e;
        u.pm = rt; u.pn = nt; u.aux0 = e; u.aux1 = (rt - tp[e]) * 256;
        u.Ab = A; u.Bb = B + (size_t)e * bstride_e + (size_t)nt * bstride_t; return true;
    }
    __device__ __forceinline__ unsigned arow(const Unit& u, int r) const {
        if (!gather) return (unsigned)(u.pm * 256 + r);
        const int idx = u.aux1 + r; const int n = cnt[64 * u.aux0]; return idx < n ? (unsigned)lists[u.aux0 * MT + idx] : 0u;
    }
};
struct EpiMoe1 {
    static constexpr bool PERM = true;
    bf16* hid; const int* cnt; const int* lists; const float* slotw; const float* rstd;
    __device__ __forceinline__ void operator()(const PG8_ACC, const Unit& u, int wr, int wc, int fr, int fq) const {
        const int n = cnt[64 * u.aux0];
#pragma unroll
        for (int ai = 0; ai < 2; ++ai)
#pragma unroll
            for (int m = 0; m < 4; ++m) { const int r = ai * 128 + wr * 64 + m * 16 + fr; const int idx = u.aux1 + r; const bool ok = idx < n;
                const int tok = ok ? lists[u.aux0 * MT + idx] : 0; const float rs = rstd[tok]; const float wt = ok ? slotw[u.aux0 * MT + idx] : 0.f;
                f32x4 o0, o1;
#pragma unroll
                for (int j = 0; j < 4; ++j) { const float g0 = acc[ai][0][m][0][j] * rs, u0 = acc[ai][1][m][0][j] * rs, g1 = acc[ai][0][m][1][j] * rs, u1 = acc[ai][1][m][1][j] * rs;
                    o0[j] = g0 * sigmoidf_(g0) * u0 * wt; o1[j] = g1 * sigmoidf_(g1) * u1 * wt; }
                *(u32x4*)(hid + (size_t)(u.pm * 256 + r) * DE + u.pn * 128 + wc * 32 + 8 * fq) = pg8::pack8(o0, o1); }
    }
};
struct EpiMoe2 {
    static constexpr bool PERM = true;
    bf16* y;
    __device__ __forceinline__ void operator()(const PG8_ACC, const Unit& u, int wr, int wc, int fr, int fq) const {
        EPI_FOR(ai, m, bj) { const int row = u.pm * 256 + ai * 128 + wr * 64 + m * 16 + fr; const int col = u.pn * 256 + bj * 128 + wc * 32 + 8 * fq;
            *(u32x4*)(y + (size_t)row * DM + col) = pg8::pack8(acc[ai][bj][m][0], acc[ai][bj][m][1]); }
    }
};
__device__ __forceinline__ void moe_table(Frame& F) {
    if (F.tid == 0) { const int* cnt = (const int*)(F.ctl + CW_CNT); int acc = 0;
        for (int e = 0; e < 32; ++e) { F.MISC[16 + e] = (unsigned)acc; acc += (__hip_atomic_load(cnt + 64 * e, __ATOMIC_RELAXED, __HIP_MEMORY_SCOPE_AGENT) + 255) >> 8; }
        F.MISC[16 + 32] = (unsigned)acc; }
    __syncthreads();
}
__device__ __forceinline__ void p5_expert_cvt(Frame& F) {
    LAS float* scr = (LAS float*)(F.lds + F.wave * CVT_SCR); const int gw = F.vcu * 8 + F.wave, NGW = F.G * 8; unsigned char* ws = F.ws;
#define EX_DESC(it_, d) do { const int e = (it_) / 768, r = (it_) % 768; \
        if (r < 256) { d.W = F.in[I_WEG] + (size_t)e * DM * DE; d.gain = F.in[I_GFFN]; d.WT = (bf16*)(ws + WS_WGU) + (size_t)e * 1024 * DM; d.K = DM; d.N = DE; d.ldt = DM; d.mode = 3; d.kofs = 0; d.item = r; d.q = 0; d.cm = 0; } \
        else if (r < 512) { d.W = F.in[I_WEU] + (size_t)e * DM * DE; d.gain = F.in[I_GFFN]; d.WT = (bf16*)(ws + WS_WGU) + (size_t)e * 1024 * DM; d.K = DM; d.N = DE; d.ldt = DM; d.mode = 4; d.kofs = 0; d.item = r - 256; d.q = 0; d.cm = 0; } \
        else { d.W = F.in[I_WED] + (size_t)e * DE * DM; d.gain = nullptr; d.WT = (bf16*)(ws + WS_WD) + (size_t)e * DM * DE; d.K = DE; d.N = DM; d.ldt = DE; d.mode = 0; d.kofs = 0; d.item = r - 512; d.q = 0; d.cm = 0; } } while (0)
    CVT_PIPE(NE * 768, EX_DESC);
#undef EX_DESC
}

struct Args { const float* in[41]; float* out; unsigned char* ws; int ph_lo, ph_hi; };
constexpr int NPHASE = 16;
__global__ void __launch_bounds__(512, 2) fwd_kernel(Args args) {
    extern __shared__ __attribute__((aligned(16))) unsigned char lds_raw[];
    Frame F;
    F.lds = (LAS unsigned char*)lds_raw; F.MISC = (volatile LAS unsigned*)(F.lds + MISC_OFF);
    F.tid = threadIdx.x; F.lane = F.tid & 63; F.wave = __builtin_amdgcn_readfirstlane(F.tid >> 6);
    F.G = gridDim.x; { const int bx = blockIdx.x; F.vcu = (F.G % 8 == 0) ? (bx % 8) * (F.G / 8) + bx / 8 : bx; }
    F.ws = args.ws; F.out = args.out; F.ctl = (unsigned*)(args.ws + WS_CTL);
#pragma unroll
    for (int i = 0; i < 41; ++i) F.in[i] = args.in[i];
    for (int u = F.tid; u < (LDS_BYTES - LDSCTL_OFF) / 4; u += 512) ((LAS unsigned*)(F.lds + LDSCTL_OFF))[u] = 0u;
    __syncthreads();
    XcdBarrier bar; bar.bar = F.ctl + CW_BAR; bar.x = 0; bar.st = nullptr;
    const int lo = args.ph_lo, hi = args.ph_hi;
    if (hi - lo > 1) bar = xcd_barrier_post(F.ctl + CW_BAR, F.MISC + 8);
#ifndef ATT_DQK_TEST
#define ATT_DQK_TEST QKD
#endif
#define PROBE_N (MT * 768)
#ifndef LSEL
#define LSEL 31
#endif
#ifndef PH_MASK
#define PH_MASK 0xFFFFu
#endif
#ifndef SCAN_MFMA
#define SCAN_MFMA 1
#endif
#ifndef SCAN_DUMMY
#define SCAN_DUMMY 0
#endif
#ifndef REPEAT_MASK
#define REPEAT_MASK 0x0u
#endif
#define REP(k) _Pragma("unroll") for (int _rep = 0; _rep <= (int)(((REPEAT_MASK) >> (k)) & 1u); ++_rep)
#define IN(k) ((((PH_MASK) >> (k)) & 1u) && lo <= (k) && (k) < hi)
#ifndef PROBE_TIME
#define PROBE_TIME -1
#endif
#define SEAM(k) do { if (lo <= (k) && (k) + 1 < hi) xcd_barrier(bar); if (PROBE_TIME >= 0 && blockIdx.x == 0 && F.tid == 0) { const unsigned long long _t = wall_clock64(); F.MISC[64 + 2 * ((k) + 1)] = (unsigned)_t; F.MISC[65 + 2 * ((k) + 1)] = (unsigned)(_t >> 32); } } while (0)
    unsigned char* ws = args.ws;

    bf16* const zmla = (bf16*)(ws + WS_ZMLA); bf16* const loraA = (bf16*)(ws + WS_LORAA);
    float* const rstd1 = (float*)(ws + WS_RSTD); float* const rstd_q = rstd1 + MT; float* const rstd_kv = rstd1 + 2 * MT;
    const int bid = (int)blockIdx.x;
    if (PROBE_TIME >= 0 && blockIdx.x == 0 && F.tid == 0) { const unsigned long long _t = wall_clock64(); F.MISC[64] = (unsigned)_t; F.MISC[65] = (unsigned)(_t >> 32); }
    if (IN(0)) { REP(0) { p0_prologue(F); xcd_barrier(bar); p0b_quant_rows(F); } }
    SEAM(0);
    if (IN(1)) {
        if (EN_RWKV || EN_MLA) REP(1) { pg8::StaticOrder S; S.init((const bf16*)(ws + WS_XB), DM / 2, (const bf16*)(ws + WS_WIN), DM / 2, MT, G1_N, F.G, bid);
          EpiG1 E{rstd1, zmla, (bf16*)(ws + WS_ZRKV), (bf16*)(ws + WS_ZLORA), (bf16*)(ws + WS_ZGATE), (const float*)(F.ctl + CW_COLMAX)};
          pg8::gemm_phase<EpiG1, pg8::StaticOrder, true>(F.lds, DM / 2, DM / 2, DM / 2, S, E); }
        else p_copy_x(F);
    }
    SEAM(1);
    if (IN(2)) { if (EN_RWKV || EN_MLA) REP(2) p2_rowpass(F); }
    SEAM(2);
    if (IN(3)) REP(3) {
        if (EN_MLA) {
            { pg8::StaticOrder S; S.init(zmla, ZM_LD, (const bf16*)(ws + WS_WUQ), QLORA, MT, MH * QKD, F.G, bid);
              EpiQ E{ws + WS_Q, rstd_q, (const float*)(ws + WS_ROPE)};
              pg8::gemm_phase(F.lds, QLORA, ZM_LD, QLORA, S, E); }
            { pg8::StaticOrder S; S.init(zmla + QLORA, ZM_LD, (const bf16*)(ws + WS_WUKV), KVLORA, MT, MH * 256, F.G, bid);
              EpiKV E{ws + WS_K, (bf16*)(ws + WS_V), rstd_kv};
              pg8::gemm_phase(F.lds, KVLORA, ZM_LD, KVLORA, S, E); }
        }
        if (EN_RWKV) {
            { pg8::StaticOrder S; S.init(loraA, LA_LD, (const bf16*)(ws + WS_W2F), 256, MT, 2 * RW, F.G, bid);
              EpiLora2<0> E{(bf16*)(ws + WS_WLF), (bf16*)(ws + WS_WLB), F.in[I_W0F], F.in[I_W0B]}; pg8::gemm_phase(F.lds, 256, LA_LD, 256, S, E); }
            { pg8::StaticOrder S; S.init(loraA + 256, LA_LD, (const bf16*)(ws + WS_W2F + 2 * MiB), 256, MT, 2 * RW, F.G, bid);
              EpiLora2<1> E{(bf16*)(ws + WS_ICF), (bf16*)(ws + WS_ICB), F.in[I_A0F], F.in[I_A0B]}; pg8::gemm_phase(F.lds, 256, LA_LD, 256, S, E); }
            if (LSEL & 16) { pg8::StaticOrder S; S.init(loraA + 512, LA_LD, (const bf16*)(ws + WS_G2), GLORA, MT, RW, F.G, bid);
              EpiLora<2> E{(bf16*)(ws + WS_G), nullptr}; pg8::gemm_phase(F.lds, GLORA, LA_LD, GLORA, S, E); }
        }
    }
    SEAM(3);
    if (IN(4)) {
        constexpr int NSCAN = NB * RH * 2, NATT = NB * MH * (SEQ / 256);
        int s_begin = F.vcu, s_end = NSCAN, s_step = F.G, a_begin = F.vcu, a_step = F.G, a_cnt = (F.vcu < NATT) ? (NATT - 1 - F.vcu) / F.G + 1 : 0;
        if (EN_RWKV && EN_MLA && F.G == 256) { s_step = 1; a_step = 1;
            if (F.vcu < 128) { s_end = F.vcu + 1; a_begin = 384 + F.vcu; a_cnt = 1; } else { s_end = 0; a_begin = (F.vcu - 128) * 3; a_cnt = 3; } }
        if (EN_RWKV) for (int u = s_begin; u < s_end; u += s_step) { const int dir = u & 1, bh = u >> 1;
            if (dir) scan2::scan_unit<1>(F, bh >> 5, bh & 31); else scan2::scan_unit<0>(F, bh >> 5, bh & 31); }
        if (EN_MLA) for (int i = 0; i < a_cnt; ++i) { const int L = a_begin + i * a_step; const int qb = L & 15, bh = L >> 4, b = bh >> 4, h = bh & 15;
            att::attn_unit_f8<MH * QKD, MH * QKD, MH * VDIM, DM>(ws + WS_Q + ((size_t)(b * SEQ + qb * 256) * (MH * QKD) + h * QKD),
                                ws + WS_K + ((size_t)b * SEQ * (MH * QKD) + h * QKD),
                                (const bf16*)(ws + WS_V) + ((size_t)b * SEQ * (MH * VDIM) + h * VDIM),
                                (bf16*)(ws + WS_OMLA) + ((size_t)(b * SEQ + qb * 256) * DM + h * VDIM), SEQ, QSCALE, (LAS char*)F.lds); }
    }
    SEAM(4);
    if (IN(5)) { if (EN_RWKV) REP(5) p5_post(F); if (EN_MOE) REP(17) p5_expert_cvt(F); }
    SEAM(5);
    if (IN(6)) REP(6) {
        if (EN_MLA) { pg8::StaticOrder S; S.init((const bf16*)(ws + WS_OMLA), DM, (const bf16*)(ws + WS_WUPM), DM, MT, DM, F.G, bid);
            EpiUp<0> E{(bf16*)(ws + WS_MERGED), (const bf16*)(ws + WS_ZGATE), 0, nullptr, nullptr}; pg8::gemm_phase(F.lds, DM, DM, DM, S, E); }
        if (EN_RWKV) { pg8::StaticOrder S; S.init((const bf16*)(ws + WS_ORWKV), DM / 2, (const bf16*)(ws + WS_WUPR), DM / 2, MT, DM, F.G, bid);
            EpiUp<EN_MLA, true> E{(bf16*)(ws + WS_MERGED), (const bf16*)(ws + WS_ZGATE), DM, (const float*)F.ctl + CW_ROWS_RWKV, (const float*)F.ctl + CW_CM_UPR};
            pg8::gemm_phase<EpiUp<EN_MLA, true>, pg8::StaticOrder, true>(F.lds, DM / 2, DM / 2, DM / 2, S, E); }
    }
    SEAM(6);
    if (IN(7)) REP(7) {
        if (EN_RWKV || EN_MLA) { pg8::StaticOrder S; S.init((const bf16*)(ws + WS_MERGED), DM, (const bf16*)(ws + WS_WOUT), DM, MT, DM, F.G, bid);
            EpiResid E{F.in[I_X], F.out}; pg8::gemm_phase(F.lds, DM, DM, DM, S, E); }
    }
    SEAM(7);
    if (IN(8)) { if (EN_CROSS || EN_MOE) p8_rowpass(F); }
    SEAM(8);
    if (IN(9)) REP(9) {
        if (EN_CROSS) { pg8::StaticOrder S; S.init((const bf16*)(ws + WS_H1B), DM / 2, (const bf16*)(ws + WS_WQC), DM / 2, MT, CW, F.G, bid);
            EpiPlainI8 E{(bf16*)(ws + WS_QC), CW, rstd1 + 3 * MT, (const float*)F.ctl + CW_CM_QC, CSCALE}; pg8::gemm_phase<EpiPlainI8, pg8::StaticOrder, true>(F.lds, DM / 2, DM / 2, DM / 2, S, E); }
        if (EN_CROSS && bid >= 64) { pg8::StaticOrder S; S.init((const bf16*)(ws + WS_MEMN), DM / 2, (const bf16*)(ws + WS_WKVC), DM / 2, NB * MEMLEN, 2 * CW, F.G, bid - 64);
            EpiPlainI8 E{(bf16*)(ws + WS_KVC), 2 * CW, (const float*)F.ctl + CW_MEMSCALE, (const float*)F.ctl + CW_CM_KVC, 1.f}; pg8::gemm_phase<EpiPlainI8, pg8::StaticOrder, true>(F.lds, DM / 2, DM / 2, DM / 2, S, E); }
    }
    SEAM(9);
    if (IN(10)) REP(10) {
        if (EN_CROSS) {
            for (int i = 0; ; ++i) { const int L = i * F.G + F.vcu; if (L >= NB * CH * (SEQ / 256)) break;
                const int qb = L & 15, bh = L >> 4, b = bh >> 2, h = bh & 3;
                att::attn_unit<CHD, CW, 2 * CW, 2 * CW, CW>((const bf16*)(ws + WS_QC) + ((size_t)(b * SEQ + qb * 256) * CW + h * CHD),
                                    (const bf16*)(ws + WS_KVC) + ((size_t)b * MEMLEN * (2 * CW) + h * CHD),
                                    (const bf16*)(ws + WS_KVC) + ((size_t)b * MEMLEN * (2 * CW) + CW + h * CHD),
                                    (bf16*)(ws + WS_OC) + ((size_t)(b * SEQ + qb * 256) * CW + h * CHD), MEMLEN, (LAS char*)F.lds); }
        }
    }
    SEAM(10);
    if (IN(11)) {
        if (EN_CROSS) { pg8::StaticOrder S; S.init((const bf16*)(ws + WS_OC), CW, (const bf16*)(ws + WS_WOC), CW, MT, DM, F.G, bid);
            EpiResid E{F.out, F.out}; pg8::gemm_phase(F.lds, CW, CW, CW, S, E); }
    }
    SEAM(11);
    if (IN(12)) { if (EN_MOE) p12_router(F); }
    SEAM(12);
    if (IN(13)) REP(13) {
        if (EN_MOE) { moe_table(F);
            MoeOrder S{(const volatile LAS int*)(F.MISC + 16), (const int*)(F.ctl + CW_CNT), (const int*)(ws + WS_LIST), (const char*)(ws + WS_N3), (const char*)(ws + WS_WGU), F.G, F.vcu, 2,
                       (size_t)1024 * DM * 2, (size_t)256 * DM * 2, true};
            EpiMoe1 E{(bf16*)(ws + WS_HID), (const int*)(F.ctl + CW_CNT), (const int*)(ws + WS_LIST), (const float*)(ws + WS_SLOTW), rstd1 + 4 * MT};
            pg8::gemm_phase(F.lds, DM, DM, DM, S, E); }
    }
    SEAM(13);
    if (IN(14)) REP(14) {
        if (EN_MOE) { moe_table(F);
            MoeOrder S{(const volatile LAS int*)(F.MISC + 16), (const int*)(F.ctl + CW_CNT), (const int*)(ws + WS_LIST), (const char*)(ws + WS_HID), (const char*)(ws + WS_WD), F.G, F.vcu, 3,
                       (size_t)DM * DE * 2, (size_t)256 * DE * 2, false};
            EpiMoe2 E{(bf16*)(ws + WS_YBUF)};
            pg8::gemm_phase(F.lds, DE, DE, DE, S, E); }
    }
    SEAM(14);
#ifdef PROBE_OFF
    if (IN(15)) { const int gt = F.vcu * 512 + F.tid, NGT = F.G * 512; const bf16* sb = (const bf16*)(ws + (size_t)PROBE_OFF * MiB);
        for (int i = gt; i < MT * DM; i += NGT) F.out[i] = (i < PROBE_N) ? bf2f(sb[i]) : 0.f; }
#else
    if (IN(15)) { { int t_ = threadIdx.x; asm volatile("" : "+v"(t_)); F.tid = t_; F.lane = t_ & 63; }
        p_final(F, EN_MOE != 0); }
#endif
    if (SCAN_SEC == 20) { if (blockIdx.x == 0 && F.wave == 0) { const float e = att::f8_map_probe(F.lane); if (F.lane == 0) F.out[(size_t)(F.vcu * 8) * DM] += 10.f + e; } }
    if (SCAN_SEC >= 0 && SCAN_SEC < 20) { __syncthreads(); if (blockIdx.x == 0 && F.tid == 0) { const unsigned long long c = ((unsigned long long)F.MISC[121] << 32) | F.MISC[120]; F.out[(size_t)(F.vcu * 8) * DM] += (float)c * 1e-4f; } }
    if (PROBE_TIME >= 0) { __syncthreads(); if (blockIdx.x == 0 && F.tid == 0) {
        const unsigned long long a = ((unsigned long long)F.MISC[65 + 2 * PROBE_TIME] << 32) | F.MISC[64 + 2 * PROBE_TIME], b = ((unsigned long long)F.MISC[65 + 2 * (PROBE_TIME + 1)] << 32) | F.MISC[64 + 2 * (PROBE_TIME + 1)];
        F.out[(size_t)(F.vcu * 8) * DM] += (float)(b - a) * 0.001f; } }
#undef IN
#undef SEAM
}

extern "C" void kernel_launch(void* const* d_in, const int* in_sizes, int n_in, void* d_out, int out_size, void* d_ws, size_t ws_size, hipStream_t stream) {
    static int grid = 0;
    if (grid == 0) {
        if (n_in != 41 || out_size != MT * DM || ws_size < WS_END) { fprintf(stderr, "kernel_launch: unexpected shapes n_in %d out %d ws %zu (need %zu)\n", n_in, out_size, ws_size, (size_t)WS_END); grid = -1; return; }
        int dev = 0, cus = 0, per_cu = 0;
        if (hipGetDevice(&dev) != hipSuccess || hipDeviceGetAttribute(&cus, hipDeviceAttributeMultiprocessorCount, dev) != hipSuccess) { grid = -1; return; }
        if (hipFuncSetAttribute((const void*)fwd_kernel, hipFuncAttributeMaxDynamicSharedMemorySize, LDS_BYTES) != hipSuccess) { fprintf(stderr, "kernel_launch: hipFuncSetAttribute failed\n"); grid = -1; return; }
        if (hipOccupancyMaxActiveBlocksPerMultiprocessor(&per_cu, (const void*)fwd_kernel, 512, LDS_BYTES) != hipSuccess || per_cu < 1) { fprintf(stderr, "kernel_launch: occupancy query says %d\n", per_cu); }
        (void)hipGetLastError();
        grid = cus;
    }
    if (grid < 0) return;
    (void)hipMemsetAsync((char*)d_ws + WS_CTL, 0, CTL_BYTES, stream);
    Args a{};
    for (int i = 0; i < 41; ++i) a.in[i] = (const float*)d_in[i];
    a.out = (float*)d_out; a.ws = (unsigned char*)d_ws;
#if N_LAUNCH_SPLIT
    for (int p = 0; p < NPHASE; ++p) { a.ph_lo = p; a.ph_hi = p + 1; hipLaunchKernelGGL(fwd_kernel, dim3(grid), dim3(512), LDS_BYTES, stream, a); }
#else
    a.ph_lo = 0; a.ph_hi = NPHASE;
    hipLaunchKernelGGL(fwd_kernel, dim3(grid), dim3(512), LDS_BYTES, stream, a);
#endif
}
```
